# Optimizing an MI355X kernel written in HIP

```python
import jax
import jax.numpy as jnp
from jax import lax
import numpy as np


D_MODEL = 1024
BATCH = 2
SEQ = 16384
DEPTH = 4

GRID_W = 64
CTX_LEN = 256
CHUNK = 64
EPS = 1e-6
MIX_WIDTH = D_MODEL
HG_DK = 128
HG_DV = 128
HG_HEADS = (MIX_WIDTH // 2) // HG_DV
RET_DK = 128
RET_DV = 128
RET_HEADS = (MIX_WIDTH - HG_HEADS * HG_DV) // RET_DV
ROPE_BASE = 10000.0
N_EXPERTS = 16
CAPACITY_FACTOR = 2
EXPERT_FF = 2 * D_MODEL
IN_SPLITS = (HG_HEADS * HG_DK,) * 3 + (HG_HEADS * HG_DV,) * 2 + (RET_HEADS * RET_DK,) * 2 + (RET_HEADS * RET_DV,) * 2
IN_WIDTH = sum(IN_SPLITS)

kernel_name = 'hybrid_hgrn2_retention_ecmoe_prefix_dit'


def rms_norm(x, g=None):
    xf = x.astype(jnp.float32)
    y = xf * lax.rsqrt(jnp.mean(xf * xf, axis=-1, keepdims=True) + EPS)
    if g is not None:
        y = y * g.astype(jnp.float32)
    return y.astype(x.dtype)


def adaln(cond, w, b):
    m = jax.nn.silu(cond) @ w + b
    return jnp.split(m[:, None, :], 6, axis=-1)


def modulate(h, shift, scale):
    return h * (1 + scale) + shift


def to_bwd(z, lc):
    return jnp.concatenate([jnp.flip(z[:, :lc], axis=1), jnp.flip(z[:, lc:], axis=1)], axis=1)


def axial_rope_angles(rows, lc):
    n_freq = RET_DK // 4
    inv = ROPE_BASE ** (-jnp.arange(n_freq, dtype=jnp.float32) / n_freq)
    row = jnp.repeat(jnp.arange(rows, dtype=jnp.float32), GRID_W)
    col = jnp.tile(jnp.arange(GRID_W, dtype=jnp.float32), rows)
    lat = jnp.concatenate([row[:, None] * inv, col[:, None] * inv], axis=-1)
    return jnp.concatenate([jnp.zeros((lc, 2 * n_freq), jnp.float32), lat], axis=0)


def apply_rope(z, ang):
    cos = jnp.cos(ang)[None, :, None, :]
    sin = jnp.sin(ang)[None, :, None, :]
    z1, z2 = z[..., 0::2], z[..., 1::2]
    return jnp.stack([z1 * cos - z2 * sin, z1 * sin + z2 * cos], axis=-1).reshape(z.shape)


def to_chunks(z):
    b, l, h, d = z.shape
    return z.reshape(b, l // CHUNK, CHUNK, h, d).transpose(1, 0, 3, 2, 4)


def from_chunks(o):
    n, b, h, c, d = o.shape
    return o.transpose(1, 0, 3, 2, 4).reshape(b, n * c, h, d)


def hgrn2_scan(q, k, v, log_f):
    b, _, h, dk = q.shape
    dv = v.shape[-1]
    causal = jnp.tril(jnp.ones((CHUNK, CHUNK), dtype=bool))[:, :, None]

    def step(state, inp):
        qc, kc, vc, lfc = inp
        cum = jnp.cumsum(lfc, axis=2)
        diff = cum[:, :, :, None, :] - cum[:, :, None, :, :]
        dec = jnp.exp(jnp.where(causal, diff, -jnp.inf))
        scores = jnp.einsum('bhtk,bhsk,bhtsk->bhts', qc, kc, dec)
        out = (jnp.einsum('bhts,bhsv->bhtv', scores, vc)
               + jnp.einsum('bhtk,bhkv->bhtv', qc * jnp.exp(cum), state))
        last = cum[:, :, -1:, :]
        state = (jnp.exp(last[:, :, 0, :])[..., None] * state
                 + jnp.einsum('bhsk,bhsv->bhkv', kc * jnp.exp(last - cum), vc))
        return state, out

    s0 = jnp.zeros((b, h, dk, dv), jnp.float32)
    _, o = lax.scan(step, s0, (to_chunks(q), to_chunks(k), to_chunks(v), to_chunks(log_f)))
    return from_chunks(o)


def retention_scan(q, k, v, log_gamma):
    b, _, h, dk = q.shape
    dv = v.shape[-1]
    idx = jnp.arange(CHUNK, dtype=jnp.float32)
    rel = idx[:, None] - idx[None, :]
    dmat = jnp.where(rel >= 0, jnp.exp(jnp.maximum(rel, 0.0) * log_gamma[:, None, None]), 0.0)
    into = jnp.exp((idx + 1.0) * log_gamma[:, None])[None, :, :, None]
    tail = jnp.exp((CHUNK - 1.0 - idx) * log_gamma[:, None])[None, :, :, None]
    carry = jnp.exp(CHUNK * log_gamma)[None, :, None, None]

    def step(state, inp):
        qc, kc, vc = inp
        scores = jnp.einsum('bhtk,bhsk->bhts', qc, kc) * dmat[None]
        out = (jnp.einsum('bhts,bhsv->bhtv', scores, vc)
               + jnp.einsum('bhtk,bhkv->bhtv', qc, state) * into)
        state = carry * state + jnp.einsum('bhsk,bhsv->bhkv', kc * tail, vc)
        return state, out

    s0 = jnp.zeros((b, h, dk, dv), jnp.float32)
    _, o = lax.scan(step, s0, (to_chunks(q), to_chunks(k), to_chunks(v)))
    return from_chunks(o)


def token_mixers(h, lc, w_in, lb, onorm, log_gamma, ang):
    b, l, _ = h.shape
    p = (h @ w_in).astype(jnp.float32)
    bounds = [int(i) for i in np.cumsum(IN_SPLITS)[:-1]]
    hq, hff, hfb, hi, hgt, rq, rk, rv, rgt = jnp.split(p, bounds, axis=-1)

    def split_heads(z, d):
        return z.reshape(b, l, z.shape[-1] // d, d)

    lb = lb.reshape(HG_HEADS, HG_DK)
    log_lb, log_1mlb = jnp.log(lb), jnp.log1p(-lb)
    q = split_heads(hq, HG_DK)
    i = split_heads(hi, HG_DV)
    lf_f = jnp.logaddexp(log_lb, log_1mlb + jax.nn.log_sigmoid(split_heads(hff, HG_DK)))
    lf_b = to_bwd(jnp.logaddexp(log_lb, log_1mlb + jax.nn.log_sigmoid(split_heads(hfb, HG_DK))), lc)
    o_hg = (hgrn2_scan(q, -jnp.expm1(lf_f), i, lf_f)
            + to_bwd(hgrn2_scan(to_bwd(q, lc), -jnp.expm1(lf_b), to_bwd(i, lc), lf_b), lc))
    o_hg = rms_norm(o_hg, onorm) * jax.nn.silu(split_heads(hgt, HG_DV))

    rq = apply_rope(split_heads(rq, RET_DK), ang)
    rk = apply_rope(split_heads(rk, RET_DK), ang) * RET_DK ** -0.5
    rv = split_heads(rv, RET_DV)
    o_ret = (retention_scan(rq, rk, rv, log_gamma[0])
             + to_bwd(retention_scan(to_bwd(rq, lc), to_bwd(rk, lc), to_bwd(rv, lc), log_gamma[1]), lc))
    o_ret = rms_norm(o_ret) * jax.nn.silu(split_heads(rgt, RET_DV))

    out = jnp.concatenate([o_hg.reshape(b, l, -1), o_ret.reshape(b, l, -1)], axis=-1)
    return out.astype(h.dtype)


def expert_choice_ffn(h, w_router, w_gate, w_up, w_down):
    b, n, d = h.shape
    cap = CAPACITY_FACTOR * n // N_EXPERTS
    aff = jax.nn.softmax((h @ w_router).astype(jnp.float32), axis=-1)
    gates, idx = lax.top_k(jnp.swapaxes(aff, 1, 2), cap)
    flat = idx.reshape(b, -1)
    bidx = jnp.arange(b)[:, None]
    xs = h[bidx, flat].reshape(b, N_EXPERTS, cap, d)
    hid = (jax.nn.silu(jnp.einsum('becd,edf->becf', xs, w_gate))
           * jnp.einsum('becd,edf->becf', xs, w_up))
    ys = jnp.einsum('becf,efd->becd', hid, w_down) * gates[..., None].astype(h.dtype)
    return jnp.zeros_like(h).at[bidx, flat].add(ys.reshape(b, -1, d))


def setup_inputs(seed: int = 0) -> dict:
    key = jax.random.key(seed)
    ks = jax.random.split(key, 20)
    nrm = jax.random.normal
    s = D_MODEL ** -0.5
    base_decay = jnp.log(-jnp.log1p(-(2.0 ** (-5.0 - jnp.arange(RET_HEADS, dtype=jnp.float32)))))
    return {
        'x': nrm(ks[0], (BATCH, SEQ, D_MODEL), jnp.float32),
        'c': nrm(ks[1], (BATCH, D_MODEL), jnp.float32),
        'ctx': nrm(ks[2], (BATCH, CTX_LEN, D_MODEL), jnp.float32),
        'c_ctx': nrm(ks[3], (D_MODEL,), jnp.float32),
        'w_ada': nrm(ks[4], (DEPTH, D_MODEL, 6 * D_MODEL), jnp.float32) * (0.5 * s),
        'b_ada': nrm(ks[5], (DEPTH, 6 * D_MODEL), jnp.float32) * 0.02,
        'g_mix': 1.0 + 0.02 * nrm(ks[6], (DEPTH, D_MODEL), jnp.float32),
        'g_ffn': 1.0 + 0.02 * nrm(ks[7], (DEPTH, D_MODEL), jnp.float32),
        'w_in': nrm(ks[8], (DEPTH, D_MODEL, IN_WIDTH), jnp.float32) * s,
        'w_out': nrm(ks[9], (DEPTH, MIX_WIDTH, D_MODEL), jnp.float32) * MIX_WIDTH ** -0.5,
        'hg_lb_logits': nrm(ks[10], (DEPTH, HG_HEADS * HG_DK), jnp.float32) * 0.5,
        'hg_onorm': 1.0 + 0.02 * nrm(ks[11], (DEPTH, HG_DV), jnp.float32),
        'ret_decay': base_decay[None, None, :] + 0.01 * nrm(ks[12], (DEPTH, 2, RET_HEADS), jnp.float32),
        'w_router': nrm(ks[13], (DEPTH, D_MODEL, N_EXPERTS), jnp.float32) * s,
        'w_e_gate': nrm(ks[14], (DEPTH, N_EXPERTS, D_MODEL, EXPERT_FF), jnp.float32) * s,
        'w_e_up': nrm(ks[15], (DEPTH, N_EXPERTS, D_MODEL, EXPERT_FF), jnp.float32) * s,
        'w_e_down': nrm(ks[16], (DEPTH, N_EXPERTS, EXPERT_FF, D_MODEL), jnp.float32) * EXPERT_FF ** -0.5,
        'g_final': 1.0 + 0.02 * nrm(ks[17], (D_MODEL,), jnp.float32),
    }


def reference(x, c, ctx, c_ctx, w_ada, b_ada, g_mix, g_ffn, w_in, w_out, hg_lb_logits, hg_onorm,
              ret_decay, w_router, w_e_gate, w_e_up, w_e_down, g_final):
    n = x.shape[1]
    lc = ctx.shape[1]
    rows = n // GRID_W
    ang = axial_rope_angles(rows, lc)
    gamma_cum = jnp.cumsum(jax.nn.softmax(hg_lb_logits.astype(jnp.float32), axis=0), axis=0)
    lbs = gamma_cum - gamma_cum[0:1]
    log_gammas = -jnp.exp(ret_decay.astype(jnp.float32))
    xl, xc = x, ctx
    for l in range(DEPTH):
        last = l == DEPTH - 1
        sh1, sc1, gt1, sh2, sc2, gt2 = adaln(c, w_ada[l], b_ada[l])
        csh1, csc1, cgt1, csh2, csc2, cgt2 = adaln(c_ctx[None], w_ada[l], b_ada[l])
        h = jnp.concatenate([modulate(rms_norm(xc, g_mix[l]), csh1, csc1),
                             modulate(rms_norm(xl, g_mix[l]), sh1, sc1)], axis=1)
        mix = token_mixers(h, lc, w_in[l], lbs[l], hg_onorm[l], log_gammas[l], ang)
        xl = xl + gt1 * (mix[:, lc:] @ w_out[l])
        xl = xl + gt2 * expert_choice_ffn(modulate(rms_norm(xl, g_ffn[l]), sh2, sc2),
                                          w_router[l], w_e_gate[l], w_e_up[l], w_e_down[l])
        if not last:
            xc = xc + cgt1 * (mix[:, :lc] @ w_out[l])
            xc = xc + cgt2 * expert_choice_ffn(modulate(rms_norm(xc, g_ffn[l]), csh2, csc2),
                                               w_router[l], w_e_gate[l], w_e_up[l], w_e_down[l])
    return rms_norm(xl, g_final)
```

```cpp
#include <hip/hip_runtime.h>
#include <cstdio>
#include <cstdint>

constexpr int D = 1024, NB = 2, SEQ = 16384, CTX = 256, LTOT = SEQ + CTX, MROWS = NB * LTOT;
constexpr int DEPTH = 4, INW = 4608, NE = 16, FF = 2048;
constexpr int CAP_LAT = 2048, CAP_CTX = 32;
constexpr int MOE_ROWS_E = 4352, MOE_ROWS = NE * MOE_ROWS_E;
constexpr int NSLOT = NB * 8 * 2 * 65;
constexpr float EPS = 1e-6f;

constexpr size_t MiB = 1u << 20;
constexpr size_t WS_CTL = 0, CTL_ZERO_BYTES = 64 * 1024;
constexpr size_t WS_MODP = 1 * MiB;
constexpr size_t WS_MODS = 4 * MiB;
constexpr size_t WS_LBS = 5 * MiB;
constexpr size_t WS_ROPE = 5 * MiB + 65536;
constexpr size_t WS_WIN = 8 * MiB;
constexpr size_t WS_WOUT = 44 * MiB;
constexpr size_t WS_WGU = 52 * MiB;
constexpr size_t WS_WD = 564 * MiB;
constexpr size_t WS_X = 820 * MiB;
constexpr size_t WS_H = 950 * MiB;
constexpr size_t WS_MIX = 1015 * MiB;
constexpr size_t WS_P = 1080 * MiB;
constexpr size_t WS_XS = 1080 * MiB;
constexpr size_t WS_HID = 1216 * MiB;
constexpr size_t WS_YS = 1488 * MiB;
constexpr size_t WS_UB = 1624 * MiB;
constexpr size_t WS_SB = 1689 * MiB;
constexpr size_t WS_AB = 1754 * MiB;
constexpr size_t WS_OB = 1756 * MiB;
constexpr size_t WS_AFF = 1788 * MiB;
constexpr size_t WS_ROWMAP = 1791 * MiB;
constexpr size_t WS_INV = 1792 * MiB;
constexpr size_t WS_END = 1800 * MiB;

constexpr int LDS_BYTES = 155648;
constexpr int MISC_OFF = LDS_BYTES - 64;
constexpr int PTR_OFF = LDS_BYTES - 256;

#define GAS __attribute__((address_space(1)))
#define LAS __attribute__((address_space(3)))
typedef float f32x2 __attribute__((ext_vector_type(2)));
typedef unsigned u32x2 __attribute__((ext_vector_type(2)));

__device__ __forceinline__ int opaque_tid() { int t = threadIdx.x; asm volatile("" : "+v"(t)); return t; }
__device__ __forceinline__ LAS unsigned char* launder_lds(LAS unsigned char* p) { unsigned v = (unsigned)(size_t)p; asm volatile("" : "+s"(v)); return (LAS unsigned char*)(size_t)v; }
__device__ __forceinline__ const float* ldptr(LAS unsigned char* lds0, int i) {
    LAS unsigned char* lds = launder_lds(lds0);
    const u32x2 v = *(volatile LAS u32x2*)(lds + PTR_OFF + 8 * i);
    const unsigned lo = __builtin_amdgcn_readfirstlane(v.x), hi = __builtin_amdgcn_readfirstlane(v.y);
    return (const float*)(((unsigned long long)hi << 32) | lo);
}
namespace pg8 {
#define PG8_LAS __attribute__((address_space(3)))
typedef unsigned short bf16_t;
typedef short bf16x8 __attribute__((ext_vector_type(8)));
typedef float f32x4 __attribute__((ext_vector_type(4)));
typedef unsigned u32x4 __attribute__((ext_vector_type(4)));
constexpr int BM = 256, BK = 64, HALF = 128, HTB = HALF * BK * 2  , STAGE_BYTES = 8 * HTB, NXCD = 8, WGM = 8;

__host__ __device__ __forceinline__ int lds_byte(int r, int c) { const int st = (r >> 4) * 2 + (c >> 5), rr = r & 15, cc = c & 31, ob = rr * 64 + cc * 2; return st * 1024 + (ob ^ (((ob >> 9) & 1) << 5)); }
__host__ __device__ __forceinline__ void stage_rc(int b, int& R, int& C) { const int st = b / 1024, sb = b % 1024, swz = sb ^ (((sb >> 9) & 1) << 5); R = (st >> 1) * 16 + swz / 64; C = (st & 1) * 32 + (swz % 64) / 2; }
__host__ __device__ __forceinline__ int perm32(int rho) { const int n = rho >> 4, i = rho & 15; return 8 * (i >> 2) + 4 * n + (i & 3); }

struct Unit { int pm, pn; };
struct Gemm { const bf16_t* A; const bf16_t* Bt; int M, N, K; };

struct StaticOrder {
    int nM, nN, nwg, G, c;
    __host__ __device__ void init(int M, int N, int G_, int c_) { nM = M / BM; nN = N / BM; nwg = nM * nN; G = G_; c = c_; }
    __host__ __device__ bool next(int i, Unit& u) const {
        const long L = (long)i * G + c; if (L >= nwg) return false;
        int wgid = (int)L; { const int q = nwg / NXCD, r = nwg % NXCD, xcd = wgid % NXCD, off = wgid / NXCD; wgid = (xcd < r ? xcd * (q + 1) : r * (q + 1) + (xcd - r) * q) + off; }
        const int nig = WGM * nN, gid = wgid / nig, fm = gid * WGM, gsz = (nM - fm) < WGM ? (nM - fm) : WGM;
        u.pm = fm + ((wgid % nig) % gsz); u.pn = (wgid % nig) / gsz; return true;
    }
    __device__ __forceinline__ void a_ready(const Unit&) const {}
    __device__ __forceinline__ void done(const Unit&) const {}
};
__device__ __forceinline__ unsigned cvt_pk_bf16(float lo, float hi) { unsigned r; asm volatile("v_cvt_pk_bf16_f32 %0, %1, %2" : "=v"(r) : "v"(lo), "v"(hi)); return r; }

struct MoeOrder {
    int NT, NC, G, c;
    __device__ __forceinline__ bool next(int i, Unit& u) const {
        const int L = i * G + c, per = NT * NC; if (L >= 16 * per) return false;
        const int e = L / per, q = L - e * per; u.pm = e * 17 + q / NC; u.pn = e * NC + q % NC; return true;
    }
    __device__ __forceinline__ void a_ready(const Unit&) const {}
    __device__ __forceinline__ void done(const Unit&) const {}
};

__device__ __forceinline__ float fast_exp(float x) { return __builtin_amdgcn_exp2f(x * 1.4426950408889634f); }
__device__ __forceinline__ float fast_sigmoid(float x) { return __builtin_amdgcn_rcpf(1.0f + fast_exp(-x)); }

struct EpiIn {
    static constexpr bool PERM = true, AFTER_DRAIN = false;
    bf16_t* P; const float* lb; const float* cs;
    __device__ __forceinline__ void operator()(const f32x4 (&acc)[2][2][4][2], const Unit& u, int wr, int wc, int fr, int fq) const {
        const int grp = u.pn >> 1;
        const int row0 = u.pm * BM + wr * 64 + fr, col0 = u.pn * BM + wc * 32 + 8 * fq;
        if (grp == 0 || grp == 3 || grp == 7) {
#pragma unroll
            for (int ai = 0; ai < 2; ++ai)
#pragma unroll
                for (int m = 0; m < 4; ++m) { bf16_t* rowp = P + (size_t)(row0 + ai * HALF + m * 16) * INW + col0;
#pragma unroll
                    for (int bj = 0; bj < 2; ++bj) { const f32x4 v0 = acc[ai][bj][m][0], v1 = acc[ai][bj][m][1];
                        u32x4 w; w.x = cvt_pk_bf16(v0[0], v0[1]); w.y = cvt_pk_bf16(v0[2], v0[3]); w.z = cvt_pk_bf16(v1[0], v1[1]); w.w = cvt_pk_bf16(v1[2], v1[3]);
                        *(u32x4*)(rowp + bj * HALF) = w; } }
        } else if (grp == 1 || grp == 2) {
            const int cg = col0 - grp * 512;
            f32x4 lbv[2][2];
#pragma unroll
            for (int bj = 0; bj < 2; ++bj)
#pragma unroll
                for (int n = 0; n < 2; ++n) lbv[bj][n] = *(const f32x4*)(lb + cg + bj * HALF + 4 * n);
#pragma unroll
            for (int ai = 0; ai < 2; ++ai)
#pragma unroll
                for (int m = 0; m < 4; ++m) { bf16_t* rowp = P + (size_t)(row0 + ai * HALF + m * 16) * INW + col0;
#pragma unroll
                    for (int bj = 0; bj < 2; ++bj) { f32x4 v[2];
#pragma unroll
                        for (int n = 0; n < 2; ++n)
#pragma unroll
                            for (int j = 0; j < 4; ++j) { const float l0 = lbv[bj][n][j]; const float f = l0 + (1.0f - l0) * fast_sigmoid(acc[ai][bj][m][n][j]);
                                v[n][j] = __builtin_amdgcn_logf(fmaxf(f, 1e-30f)) * 0.6931471805599453f; }
                        u32x4 w; w.x = cvt_pk_bf16(v[0][0], v[0][1]); w.y = cvt_pk_bf16(v[0][2], v[0][3]); w.z = cvt_pk_bf16(v[1][0], v[1][1]); w.w = cvt_pk_bf16(v[1][2], v[1][3]);
                        *(u32x4*)(rowp + bj * HALF) = w; } }
        } else if (grp == 4 || grp == 8) {
#pragma unroll
            for (int ai = 0; ai < 2; ++ai)
#pragma unroll
                for (int m = 0; m < 4; ++m) { bf16_t* rowp = P + (size_t)(row0 + ai * HALF + m * 16) * INW + col0;
#pragma unroll
                    for (int bj = 0; bj < 2; ++bj) { f32x4 v[2];
#pragma unroll
                        for (int n = 0; n < 2; ++n)
#pragma unroll
                            for (int j = 0; j < 4; ++j) { const float z = acc[ai][bj][m][n][j]; v[n][j] = z * fast_sigmoid(z); }
                        u32x4 w; w.x = cvt_pk_bf16(v[0][0], v[0][1]); w.y = cvt_pk_bf16(v[0][2], v[0][3]); w.z = cvt_pk_bf16(v[1][0], v[1][1]); w.w = cvt_pk_bf16(v[1][2], v[1][3]);
                        *(u32x4*)(rowp + bj * HALF) = w; } }
        } else {
            const float sc = (grp == 6) ? 0.08838834764831845f : 1.0f;
            const int f0 = 16 * (wc & 1) + 4 * fq;
#pragma unroll
            for (int ai = 0; ai < 2; ++ai)
#pragma unroll
                for (int m = 0; m < 4; ++m) { const int row = row0 + ai * HALF + m * 16; bf16_t* rowp = P + (size_t)row * INW + col0;
                    int g = row; if (g >= LTOT) g -= LTOT;
                    int pos = 0; if (g >= CTX) { const int nn = g - CTX; pos = (wc < 2) ? (nn >> 6) : (nn & 63); }
                    const f32x4 t0 = *(const f32x4*)(cs + (size_t)(pos * 32 + f0) * 2), t1 = *(const f32x4*)(cs + (size_t)(pos * 32 + f0) * 2 + 4);
#pragma unroll
                    for (int bj = 0; bj < 2; ++bj) { const f32x4 v0 = acc[ai][bj][m][0] * sc, v1 = acc[ai][bj][m][1] * sc;
                        const float a0 = v0[0] * t0[0] - v0[1] * t0[1], a1 = v0[0] * t0[1] + v0[1] * t0[0];
                        const float a2 = v0[2] * t0[2] - v0[3] * t0[3], a3 = v0[2] * t0[3] + v0[3] * t0[2];
                        const float b0 = v1[0] * t1[0] - v1[1] * t1[1], b1 = v1[0] * t1[1] + v1[1] * t1[0];
                        const float b2 = v1[2] * t1[2] - v1[3] * t1[3], b3 = v1[2] * t1[3] + v1[3] * t1[2];
                        u32x4 w; w.x = cvt_pk_bf16(a0, a1); w.y = cvt_pk_bf16(a2, a3); w.z = cvt_pk_bf16(b0, b1); w.w = cvt_pk_bf16(b2, b3);
                        *(u32x4*)(rowp + bj * HALF) = w; } }
        }
    }
};

struct EpiOut {
    static constexpr bool PERM = false, AFTER_DRAIN = false;
    float* X; const float* xin; const float* cin; const float* gt;
    __device__ __forceinline__ void operator()(const f32x4 (&acc)[2][2][4][2], const Unit& u, int wr, int wc, int fr, int fq) const {
        const int b = u.pm / 65, tb = u.pm - b * 65, which = (tb == 0) ? 2 : b;
        const int row0 = u.pm * BM + wr * 64 + fr, col0 = u.pn * BM + wc * 32 + 4 * fq;
        f32x4 gv[2][2];
#pragma unroll
        for (int bj = 0; bj < 2; ++bj)
#pragma unroll
            for (int n = 0; n < 2; ++n) gv[bj][n] = *(const f32x4*)(gt + which * 6144 + col0 + bj * HALF + n * 16);
#pragma unroll
        for (int ai = 0; ai < 2; ++ai)
#pragma unroll
            for (int m = 0; m < 4; ++m) { const int row = row0 + ai * HALF + m * 16; float* op = X + (size_t)row * D + col0;
                const float* bp = op;
                if (xin) { const int g = row - b * LTOT; bp = (g < CTX ? cin + (size_t)(b * CTX + g) * D : xin + (size_t)(b * SEQ + g - CTX) * D) + col0; }
#pragma unroll
                for (int bj = 0; bj < 2; ++bj)
#pragma unroll
                    for (int n = 0; n < 2; ++n) { const f32x4 bs = *(const f32x4*)(bp + bj * HALF + n * 16); *(f32x4*)(op + bj * HALF + n * 16) = bs + gv[bj][n] * acc[ai][bj][m][n]; } }
    }
};

struct EpiGU {
    static constexpr bool PERM = true, AFTER_DRAIN = false;
    bf16_t* HID;
    __device__ __forceinline__ void operator()(const f32x4 (&acc)[2][2][4][2], const Unit& u, int wr, int wc, int fr, int fq) const {
        const int row0 = u.pm * BM + wr * 64 + fr, col0 = (u.pn & 15) * HALF + wc * 32 + 8 * fq;
#pragma unroll
        for (int ai = 0; ai < 2; ++ai)
#pragma unroll
            for (int m = 0; m < 4; ++m) { bf16_t* rowp = HID + (size_t)(row0 + ai * HALF + m * 16) * FF + col0; f32x4 v[2];
#pragma unroll
                for (int n = 0; n < 2; ++n)
#pragma unroll
                    for (int j = 0; j < 4; ++j) { const float g = acc[ai][0][m][n][j]; v[n][j] = g * fast_sigmoid(g) * acc[ai][1][m][n][j]; }
                u32x4 w; w.x = cvt_pk_bf16(v[0][0], v[0][1]); w.y = cvt_pk_bf16(v[0][2], v[0][3]); w.z = cvt_pk_bf16(v[1][0], v[1][1]); w.w = cvt_pk_bf16(v[1][2], v[1][3]);
                *(u32x4*)rowp = w; }
    }
};

struct EpiDown {
    static constexpr bool PERM = true, AFTER_DRAIN = false;
    bf16_t* YS; const float* gate;
    __device__ __forceinline__ void operator()(const f32x4 (&acc)[2][2][4][2], const Unit& u, int wr, int wc, int fr, int fq) const {
        const int row0 = u.pm * BM + wr * 64 + fr, col0 = (u.pn & 3) * BM + wc * 32 + 8 * fq;
#pragma unroll
        for (int ai = 0; ai < 2; ++ai)
#pragma unroll
            for (int m = 0; m < 4; ++m) { const int row = row0 + ai * HALF + m * 16; const float gg = gate[row]; bf16_t* rowp = YS + (size_t)row * D + col0;
#pragma unroll
                for (int bj = 0; bj < 2; ++bj) { const f32x4 v0 = acc[ai][bj][m][0] * gg, v1 = acc[ai][bj][m][1] * gg;
                    u32x4 w; w.x = cvt_pk_bf16(v0[0], v0[1]); w.y = cvt_pk_bf16(v0[2], v0[3]); w.z = cvt_pk_bf16(v1[0], v1[1]); w.w = cvt_pk_bf16(v1[2], v1[3]);
                    *(u32x4*)(rowp + bj * HALF) = w; } }
    }
};

template <class Epi, class Sched, bool ALIGN_EPI = false, bool SP2 = false>
__device__ __forceinline__ void gemm_phase(PG8_LAS unsigned char* lds, const Gemm g, const Sched& S, const Epi& E) {
    const int tid = opaque_tid(), wid = __builtin_amdgcn_readfirstlane(tid >> 6), lane = tid & 63, wr = wid >> 2, wc = wid & 3, fr = lane & 15, fq = lane >> 4;
    const int K = g.K, nt = K / BK;
    unsigned voffA[2], voffB[2];
#pragma unroll
    for (int i = 0; i < 2; ++i) { int R, C; stage_rc(tid * 16 + i * 8192, R, C); const int Rb = Epi::PERM ? ((R & ~31) + perm32(R & 31)) : R;
        voffA[i] = (unsigned)(R * K + C) * 2u; voffB[i] = (unsigned)(Rb * K + C) * 2u; }
    const size_t kstep = (size_t)(BK * 2);
    const size_t hstep = (size_t)HALF * K * 2;
    const size_t tstep = 2 * hstep;
    const unsigned ldsw = (unsigned)wid * 1024u;
    const int aoff = lds_byte(wr * 64 + fr, fq * 8), boff = lds_byte(wc * 32 + fr, fq * 8);
#define PG8_SA(b, h) (((b) * 2 + (h)) * HTB)
#define PG8_SB(b, h) ((4 + (b) * 2 + (h)) * HTB)
#define PG8_STAGE(bufoff, gbase, voff) do { _Pragma("unroll") for (int _i = 0; _i < 2; ++_i) \
        __builtin_amdgcn_global_load_lds((const unsigned*)((const char*)(gbase) + (voff)[_i]), (PG8_LAS unsigned*)(lds + (bufoff) + ldsw + _i * 8192), 16, 0, 0); } while (0)
#define PG8_LDA(dst, b, h) do { _Pragma("unroll") for (int m = 0; m < 4; ++m) _Pragma("unroll") for (int k = 0; k < 2; ++k) dst[m][k] = *(const PG8_LAS bf16x8*)(lds + PG8_SA(b, h) + aoff + m * 2048 + k * 1024); } while (0)
#define PG8_LDB(dst, b, h) do { _Pragma("unroll") for (int n = 0; n < 2; ++n) _Pragma("unroll") for (int k = 0; k < 2; ++k) dst[n][k] = *(const PG8_LAS bf16x8*)(lds + PG8_SB(b, h) + boff + n * 2048 + k * 1024); } while (0)
#define PG8_MMA(ai, bj, At, Bt) do { __builtin_amdgcn_s_setprio(1); _Pragma("unroll") for (int m = 0; m < 4; ++m) _Pragma("unroll") for (int n = 0; n < 2; ++n) _Pragma("unroll") for (int k = 0; k < 2; ++k) \
        acc[ai][bj][m][n] = __builtin_amdgcn_mfma_f32_16x16x32_bf16(Bt[n][k], At[m][k], acc[ai][bj][m][n], 0, 0, 0); __builtin_amdgcn_s_setprio(0); } while (0)
#define PG8_WAIT_V(n) asm volatile("s_waitcnt vmcnt(" #n ")" ::: "memory")
#define PG8_WAIT_L(n) asm volatile("s_waitcnt lgkmcnt(" #n ")" ::: "memory")
#define PG8_BAR __builtin_amdgcn_s_barrier()
#define PG8_SCHED __builtin_amdgcn_sched_barrier(0)
    Unit cur, nxt; int ui = 0;
    if (!S.next(0, cur)) return;
    f32x4 acc[2][2][4][2];
#pragma unroll
    for (int a = 0; a < 2; ++a)
#pragma unroll
        for (int b = 0; b < 2; ++b)
#pragma unroll
            for (int m = 0; m < 4; ++m)
#pragma unroll
                for (int n = 0; n < 2; ++n) acc[a][b][m][n] = (f32x4){0.f, 0.f, 0.f, 0.f};
    bf16x8 At[4][2], B0[2][2], B1[2][2];
    const char* cA = (const char*)g.A + (size_t)cur.pm * tstep; const char* cB = (const char*)g.Bt + (size_t)cur.pn * tstep;
    S.a_ready(cur);
    if constexpr (SP2) {
        PG8_STAGE(PG8_SB(0, 0), cB, voffB); PG8_STAGE(PG8_SB(0, 1), cB + hstep, voffB); PG8_STAGE(PG8_SA(0, 0), cA, voffA); PG8_STAGE(PG8_SA(0, 1), cA + hstep, voffA);
        if (wr == 1) PG8_BAR;
        PG8_WAIT_V(2); PG8_BAR;
        PG8_STAGE(PG8_SB(1, 0), cB + kstep, voffB); PG8_STAGE(PG8_SA(1, 0), cA + kstep, voffA); PG8_STAGE(PG8_SB(1, 1), cB + hstep + kstep, voffB);
        PG8_WAIT_V(6); PG8_BAR;
    } else {
        PG8_STAGE(PG8_SB(0, 0), cB, voffB); PG8_STAGE(PG8_SA(0, 0), cA, voffA); PG8_STAGE(PG8_SB(0, 1), cB + hstep, voffB); PG8_STAGE(PG8_SA(0, 1), cA + hstep, voffA);
        if (wr == 1) PG8_BAR;
        PG8_WAIT_V(4); PG8_BAR;
        PG8_STAGE(PG8_SB(1, 0), cB + kstep, voffB); PG8_STAGE(PG8_SA(1, 0), cA + kstep, voffA); PG8_STAGE(PG8_SB(1, 1), cB + hstep + kstep, voffB);
        PG8_WAIT_V(6); PG8_BAR;
    }
    for (;;) {
        const bool has_next = S.next(ui + 1, nxt);
        const char* nA = has_next ? (const char*)g.A + (size_t)nxt.pm * tstep : cA; const char* nB = has_next ? (const char*)g.Bt + (size_t)nxt.pn * tstep : cB;
        for (int t = 0; t < nt; t += 2) {
            const bool last = (t == nt - 2);
            const char* a1 = cA + (size_t)(t + 1) * kstep;
            const char* a2 = last ? nA : cA + (size_t)(t + 2) * kstep; const char* b2 = last ? nB : cB + (size_t)(t + 2) * kstep;
            const char* a3 = a2 + kstep; const char* b3 = b2 + kstep;
            if (last && has_next) S.a_ready(nxt);
            if constexpr (SP2) {
            PG8_LDB(B0, 0, 0); PG8_LDB(B1, 0, 1); PG8_SCHED; PG8_LDA(At, 0, 0); PG8_STAGE(PG8_SA(1, 1), a1 + hstep, voffA);
            PG8_WAIT_V(8); PG8_WAIT_L(0); PG8_BAR; PG8_MMA(0, 0, At, B0); PG8_MMA(0, 1, At, B1); PG8_BAR; PG8_SCHED;
            PG8_LDA(At, 0, 1); PG8_STAGE(PG8_SB(0, 0), b2, voffB); PG8_STAGE(PG8_SB(0, 1), b2 + hstep, voffB); PG8_STAGE(PG8_SA(0, 0), a2, voffA);
            PG8_WAIT_V(8); PG8_WAIT_L(0); PG8_BAR; PG8_MMA(1, 0, At, B0); PG8_MMA(1, 1, At, B1); PG8_BAR; PG8_SCHED;
            PG8_LDB(B0, 1, 0); PG8_LDB(B1, 1, 1); PG8_SCHED; PG8_LDA(At, 1, 0); PG8_STAGE(PG8_SA(0, 1), a2 + hstep, voffA);
            PG8_WAIT_V(8); PG8_WAIT_L(0); PG8_BAR; PG8_MMA(0, 0, At, B0); PG8_MMA(0, 1, At, B1); PG8_BAR; PG8_SCHED;
            PG8_LDA(At, 1, 1); PG8_STAGE(PG8_SB(1, 0), b3, voffB); PG8_STAGE(PG8_SB(1, 1), b3 + hstep, voffB); PG8_STAGE(PG8_SA(1, 0), a3, voffA);
            PG8_WAIT_V(8); PG8_WAIT_L(0); PG8_BAR; PG8_MMA(1, 0, At, B0); PG8_MMA(1, 1, At, B1); PG8_BAR; PG8_SCHED;
            } else {
            PG8_LDB(B0, 0, 0); PG8_SCHED; PG8_LDA(At, 0, 0); PG8_STAGE(PG8_SA(1, 1), a1 + hstep, voffA);
            PG8_WAIT_L(8); PG8_BAR; PG8_WAIT_L(0); PG8_MMA(0, 0, At, B0); PG8_BAR; PG8_SCHED;
            PG8_LDB(B1, 0, 1); PG8_STAGE(PG8_SB(0, 0), b2, voffB);
            PG8_BAR; PG8_WAIT_L(0); PG8_MMA(0, 1, At, B1); PG8_BAR;
            PG8_LDA(At, 0, 1); PG8_STAGE(PG8_SA(0, 0), a2, voffA);
            PG8_BAR; PG8_WAIT_L(0); PG8_MMA(1, 0, At, B0); PG8_BAR; PG8_SCHED;
            PG8_STAGE(PG8_SB(0, 1), b2 + hstep, voffB);
            PG8_WAIT_V(6); PG8_BAR; PG8_MMA(1, 1, At, B1); PG8_BAR;
            PG8_LDB(B0, 1, 0); PG8_SCHED; PG8_LDA(At, 1, 0); PG8_STAGE(PG8_SA(0, 1), a2 + hstep, voffA);
            PG8_WAIT_L(8); PG8_BAR; PG8_WAIT_L(0); PG8_MMA(0, 0, At, B0); PG8_BAR; PG8_SCHED;
            PG8_LDB(B1, 1, 1); PG8_STAGE(PG8_SB(1, 0), b3, voffB);
            PG8_BAR; PG8_WAIT_L(0); PG8_MMA(0, 1, At, B1); PG8_BAR;
            PG8_LDA(At, 1, 1); PG8_STAGE(PG8_SA(1, 0), a3, voffA);
            PG8_BAR; PG8_WAIT_L(0); PG8_MMA(1, 0, At, B0); PG8_BAR; PG8_SCHED;
            PG8_STAGE(PG8_SB(1, 1), b3 + hstep, voffB);
            PG8_WAIT_V(6); PG8_BAR; PG8_MMA(1, 1, At, B1); PG8_BAR;
            }
        }
        if constexpr (ALIGN_EPI) { if (wr == 0) PG8_BAR; }
        if constexpr (!Epi::AFTER_DRAIN) { E(acc, cur, wr, wc, fr, fq); S.done(cur); }
        if (!has_next) break;
#pragma unroll
        for (int a = 0; a < 2; ++a)
#pragma unroll
            for (int b = 0; b < 2; ++b)
#pragma unroll
                for (int m = 0; m < 4; ++m)
#pragma unroll
                    for (int n = 0; n < 2; ++n) acc[a][b][m][n] = (f32x4){0.f, 0.f, 0.f, 0.f};
        cur = nxt; cA = nA; cB = nB; ++ui;
        if constexpr (ALIGN_EPI) { if (wr == 1) PG8_BAR; }
    }
    PG8_WAIT_V(0);
    if constexpr (!ALIGN_EPI) { if (wr == 0) PG8_BAR; }
    PG8_BAR;
    if constexpr (Epi::AFTER_DRAIN) { E.fused(acc, cur, wr, wc, fr, fq, lds, wid, lane); S.done(cur); }
#undef PG8_SA
#undef PG8_SB
#undef PG8_STAGE
#undef PG8_LDA
#undef PG8_LDB
#undef PG8_MMA
#undef PG8_WAIT_V
#undef PG8_WAIT_L
#undef PG8_BAR
#undef PG8_SCHED
}
}
#define XB_TMO      128
#define XB_XCNT(j)  (256  + 64 * (j))
#define XB_XSUB(j)  (1280 + 64 * (j))
#define XB_XGEN(j)  (2304 + 64 * (j))
#define XB_TOP      3328
#define XB_TOPGEN   3392
#define XCD_BAR_WORDS 3456
#define XB_SPIN_CAP (1u << 18)

__device__ __forceinline__ unsigned xb_ld(unsigned* p)              { return __hip_atomic_load(p, __ATOMIC_RELAXED, __HIP_MEMORY_SCOPE_AGENT); }
__device__ __forceinline__ unsigned xb_add(unsigned* p, unsigned v) { return __hip_atomic_fetch_add(p, v, __ATOMIC_RELAXED, __HIP_MEMORY_SCOPE_AGENT); }
__device__ __forceinline__ unsigned xb_xcc_id() { return (unsigned)__builtin_amdgcn_s_getreg((3 << 11) | 20) & 0xFu; }
#define XB_SPIN(cond, bar) do { unsigned _sp = 0; while (cond) { __builtin_amdgcn_s_sleep(1); \
    if ((++_sp & 255u) == 0u) { if (xb_ld(&(bar)[XB_TMO])) break; if (_sp > XB_SPIN_CAP) { atomicAdd(&(bar)[XB_TMO], 1u); break; } } } } while (0)

struct XcdBarrier {
    unsigned* bar; unsigned x;
    volatile LAS unsigned* st;
};

__device__ __forceinline__ XcdBarrier xcd_barrier_post(unsigned* bar, volatile LAS unsigned* st) {
    XcdBarrier b; b.bar = bar; b.x = xb_xcc_id(); b.st = st;
    if (threadIdx.x == 0) (void)xb_add(&bar[XB_XCNT(b.x)], 1u);
    return b;
}
__device__ __forceinline__ void xcd_barrier_complete(unsigned* bar, unsigned x, unsigned& nloc, unsigned& nx) {
    const unsigned G = gridDim.x * gridDim.y * gridDim.z;
    unsigned sum, cnt, mine, sp = 0u;
    for (;;) {
        sum = 0u; cnt = 0u; mine = 0u;
#pragma unroll
        for (unsigned j = 0; j < 16; ++j) { const unsigned c = xb_ld(&bar[XB_XCNT(j)]); sum += c; cnt += (c > 0u) ? 1u : 0u; mine = (j == x) ? c : mine; }
        if (sum == G) break;
        __builtin_amdgcn_s_sleep(1);
        if ((++sp & 255u) == 0u) { if (xb_ld(&bar[XB_TMO])) break; if (sp > XB_SPIN_CAP) { atomicAdd(&bar[XB_TMO], 1u); break; } }
    }
    nloc = mine > 0u ? mine : 1u; nx = cnt > 0u ? cnt : 1u;
}

__device__ __forceinline__ void xcd_barrier(const XcdBarrier& b) {
    asm volatile("s_waitcnt vmcnt(0)" ::: "memory");
    __syncthreads();
    if (threadIdx.x == 0) {
        unsigned* bar = b.bar;
        __builtin_amdgcn_s_waitcnt(0);
        unsigned nloc = b.st[0], nx = b.st[1];
        if (nloc == 0u) { xcd_barrier_complete(bar, b.x, nloc, nx); b.st[0] = nloc; b.st[1] = nx; }
        const unsigned old = xb_add(&bar[XB_XSUB(b.x)], 1u);
        const unsigned gen = old / nloc;
        if (old + 1u == (gen + 1u) * nloc) {
            __builtin_amdgcn_fence(__ATOMIC_RELEASE, "agent");
            asm volatile("s_waitcnt vmcnt(0)" ::: "memory");
            const unsigned og = xb_add(&bar[XB_TOP], 1u);
            const unsigned tg = og / nx;
            if (og + 1u == (tg + 1u) * nx) xb_add(&bar[XB_TOPGEN], 1u);
            else XB_SPIN(xb_ld(&bar[XB_TOPGEN]) == tg, bar);
            __builtin_amdgcn_fence(__ATOMIC_ACQUIRE, "agent");
            xb_add(&bar[XB_XGEN(b.x)], 1u);
            asm volatile("s_waitcnt vmcnt(0)" ::: "memory");
        } else {
            XB_SPIN(xb_ld(&bar[XB_XGEN(b.x)]) == gen, bar);
            __builtin_amdgcn_fence(__ATOMIC_ACQUIRE, "agent");
            asm volatile("s_waitcnt vmcnt(0)" ::: "memory");
        }
    }
    __syncthreads();
}

using pg8::bf16_t; using pg8::bf16x8; using pg8::f32x4; using pg8::u32x4; using pg8::cvt_pk_bf16; using pg8::fast_exp;

#define BAR_LDS() do { asm volatile("s_waitcnt lgkmcnt(0)" ::: "memory"); __builtin_amdgcn_s_barrier(); asm volatile("" ::: "memory"); } while (0)
#define BAR_ALL() do { asm volatile("s_waitcnt vmcnt(0) lgkmcnt(0)" ::: "memory"); __builtin_amdgcn_s_barrier(); asm volatile("" ::: "memory"); } while (0)

__device__ __forceinline__ float wave_sum(float v) {
#pragma unroll
    for (int o = 1; o < 64; o <<= 1) v += __shfl_xor(v, o);
    return v;
}
__device__ __forceinline__ float bf_lo(unsigned u) { return __uint_as_float(u << 16); }
__device__ __forceinline__ float bf_hi(unsigned u) { return __uint_as_float(u & 0xffff0000u); }

struct Args { const float* in[18]; float* out; unsigned char* ws; };
struct Ctx { LAS unsigned char* lds;
    __device__ __forceinline__ const float* in(int i) const { return ldptr(lds, i); }
    __device__ __forceinline__ float* out() const { return (float*)ldptr(lds, 18); }
    __device__ __forceinline__ unsigned char* ws() const { return (unsigned char*)ldptr(lds, 19); } };
#define PHASE_IDS() const int tid = opaque_tid(), lane = tid & 63, wave = __builtin_amdgcn_readfirstlane(tid >> 6); (void)tid; (void)lane; (void)wave
enum { I_X = 0, I_C, I_CTX, I_CCTX, I_WADA, I_BADA, I_GMIX, I_GFFN, I_WIN, I_WOUT, I_LBL, I_ONORM, I_RDEC, I_WR, I_WEG, I_WEU, I_WED, I_GFIN };

__device__ __forceinline__ void tr_item(const float* W, int N, bf16_t* WT, int Kd, int k0, int n0, int drow0, LAS float* scr, int lane) {
    f32x4 v[16];
    const float* src = W + (size_t)(k0 + (lane >> 4)) * N + n0 + (lane & 15) * 4;
#pragma unroll
    for (int i = 0; i < 16; ++i) v[i] = *(const f32x4*)(src + (size_t)(i * 4) * N);
#pragma unroll
    for (int i = 0; i < 16; ++i) { LAS float* d = scr + (i * 4 + (lane >> 4)) * 65 + (lane & 15) * 4; d[0] = v[i][0]; d[1] = v[i][1]; d[2] = v[i][2]; d[3] = v[i][3]; }
    asm volatile("s_waitcnt lgkmcnt(0)" ::: "memory");
    const int c = lane & 7;
#pragma unroll
    for (int j = 0; j < 8; ++j) { const int n = j * 8 + (lane >> 3); const LAS float* s = scr + (8 * c) * 65 + n;
        u32x4 o; o.x = cvt_pk_bf16(s[0], s[65]); o.y = cvt_pk_bf16(s[2 * 65], s[3 * 65]); o.z = cvt_pk_bf16(s[4 * 65], s[5 * 65]); o.w = cvt_pk_bf16(s[6 * 65], s[7 * 65]);
        *(u32x4*)(WT + (size_t)(drow0 + n) * Kd + k0 + 8 * c) = o; }
    asm volatile("s_waitcnt lgkmcnt(0)" ::: "memory");
}

__device__ __forceinline__ void p0_prologue(const Ctx& a) {
    PHASE_IDS(); LAS unsigned char* lds = launder_lds(a.lds); unsigned char* ws = a.ws(); const float* cin_ = a.in(I_C); const float* cctx_ = a.in(I_CCTX);
    LAS float* scr = (LAS float*)(lds + wave * 16640);
    LAS float* scond = (LAS float*)(lds + 8 * 16640);
    for (int i = tid; i < 3 * D; i += 512) { const int w = i >> 10, k = i & 1023; const float cv = (w < 2) ? cin_[w * D + k] : cctx_[k]; scond[i] = cv * pg8::fast_sigmoid(cv); }
    if (blockIdx.x == 0) { const int c = tid; const float* lg = a.in(I_LBL);
        const float l0 = lg[c], l1 = lg[512 + c], l2 = lg[1024 + c], l3 = lg[1536 + c]; const float mx = fmaxf(fmaxf(l0, l1), fmaxf(l2, l3));
        const float e0 = expf(l0 - mx), e1 = expf(l1 - mx), e2 = expf(l2 - mx), e3 = expf(l3 - mx), inv = 1.0f / (e0 + e1 + e2 + e3);
        float* lbs = (float*)(ws + WS_LBS); lbs[c] = 0.f; lbs[512 + c] = e1 * inv; lbs[1024 + c] = (e1 + e2) * inv; lbs[1536 + c] = (e1 + e2 + e3) * inv; }
    if (blockIdx.x >= 1 && blockIdx.x <= 16) { const int idx = (blockIdx.x - 1) * 512 + tid, pos = idx >> 5, f = idx & 31;
        const float invf = powf(10000.0f, -(float)f / 32.0f), ang = (float)pos * invf; float* cs = (float*)(ws + WS_ROPE); cs[idx * 2] = cosf(ang); cs[idx * 2 + 1] = sinf(ang); }
    BAR_LDS();
    const int gw = blockIdx.x * 8 + wave, NGW = gridDim.x * 8;
    for (int it = gw; it < 4 * 24 * 8; it += NGW) { const int l = it / 192, r = it % 192, cg = r >> 3, ks = r & 7; const int cols = cg * 256 + lane * 4;
        const float* wp = a.in(I_WADA) + ((size_t)l * D + ks * 128) * 6144 + cols; f32x4 a0 = {0, 0, 0, 0}, a1 = a0, a2 = a0;
#pragma unroll 8
        for (int kk = 0; kk < 128; ++kk) { const f32x4 w = *(const f32x4*)(wp + (size_t)kk * 6144); const int k = ks * 128 + kk; a0 += w * scond[k]; a1 += w * scond[D + k]; a2 += w * scond[2 * D + k]; }
        float* pp = (float*)(ws + WS_MODP) + (size_t)((l * 8 + ks) * 3) * 6144 + cols; *(f32x4*)pp = a0; *(f32x4*)(pp + 6144) = a1; *(f32x4*)(pp + 2 * 6144) = a2; }
    constexpr int I_IN = 16 * 72, I_OUT = 16 * 16, I_E = 512;
    constexpr int NIT = 4 * (I_IN + I_OUT) + 64 * 3 * I_E;
    for (int it = gw; it < NIT; it += NGW) {
        int r = it;
        if (r < 4 * I_IN) { const int l = r / I_IN, q = r % I_IN, kb = q / 72, nb = q % 72;
            tr_item(a.in(I_WIN) + (size_t)l * D * INW, INW, (bf16_t*)(ws + WS_WIN) + (size_t)l * INW * D, D, kb * 64, nb * 64, nb * 64, scr, lane); continue; }
        r -= 4 * I_IN;
        if (r < 4 * I_OUT) { const int l = r / I_OUT, q = r % I_OUT, kb = q / 16, nb = q % 16;
            tr_item(a.in(I_WOUT) + (size_t)l * D * D, D, (bf16_t*)(ws + WS_WOUT) + (size_t)l * D * D, D, kb * 64, nb * 64, nb * 64, scr, lane); continue; }
        r -= 4 * I_OUT;
        const int le = r / (3 * I_E), q3 = r % (3 * I_E), kind = q3 / I_E, q = q3 % I_E;
        if (kind < 2) { const int kb = q / 32, nb = q % 32, n0 = nb * 64;
            const int drow = 256 * (n0 >> 7) + (n0 & 127) + kind * 128;
            tr_item(a.in(kind == 0 ? I_WEG : I_WEU) + (size_t)le * D * FF, FF, (bf16_t*)(ws + WS_WGU) + (size_t)le * 4096 * D, D, kb * 64, n0, drow, scr, lane);
        } else { const int kb = q / 16, nb = q % 16;
            tr_item(a.in(I_WED) + (size_t)le * FF * D, D, (bf16_t*)(ws + WS_WD) + (size_t)le * D * FF, FF, kb * 64, nb * 64, nb * 64, scr, lane); }
    }
}

__device__ __forceinline__ void p0_finalize(const Ctx& a) {
    PHASE_IDS(); unsigned char* ws = a.ws(); const float* bada = a.in(I_BADA); const float* part = (const float*)(ws + WS_MODP); float* mods = (float*)(ws + WS_MODS);
    for (int i = blockIdx.x * 512 + tid; i < 4 * 3 * 6144; i += gridDim.x * 512) { const int l = i / (3 * 6144), r = i % (3 * 6144), w = r / 6144, j = r % 6144;
        float s = bada[l * 6144 + j];
#pragma unroll
        for (int ks = 0; ks < 8; ++ks) s += part[(size_t)((l * 8 + ks) * 3 + w) * 6144 + j];
        mods[i] = s; }
}

template <int MODE>
__device__ __forceinline__ void norm1_phase(const Ctx& a, int l) {
    PHASE_IDS(); unsigned char* ws = a.ws(); const float* in_x = a.in(I_X); const float* in_ctx = a.in(I_CTX); const float* gm = (MODE == 0) ? a.in(I_GMIX) + l * D : a.in(I_GFIN); float* outp = a.out(); const int gw = blockIdx.x * 8 + wave, NGW = gridDim.x * 8;
    const float* mods = (const float*)(ws + WS_MODS); float* X = (float*)(ws + WS_X); bf16_t* H = (bf16_t*)(ws + WS_H);
    const int* inv = (const int*)(ws + WS_INV); const bf16_t* YS = (const bf16_t*)(ws + WS_YS);
    for (int row = gw; row < MROWS; row += NGW) {
        const int b = row >= LTOT ? 1 : 0, g = row - b * LTOT; const bool isctx = g < CTX; const int which = isctx ? 2 : b;
        if (MODE == 1 && isctx) continue;
        f32x4 v[4];
        if (l == 0) { const float* src = isctx ? in_ctx + (size_t)(b * CTX + g) * D : in_x + (size_t)(b * SEQ + g - CTX) * D;
#pragma unroll
            for (int j = 0; j < 4; ++j) v[j] = *(const f32x4*)(src + lane * 4 + 256 * j);
        } else {
            float* xr = X + (size_t)row * D;
#pragma unroll
            for (int j = 0; j < 4; ++j) v[j] = *(const f32x4*)(xr + lane * 4 + 256 * j);
            const int iv = inv[row * 16 + (lane & 15)];
            f32x4 s[4] = {{0, 0, 0, 0}, {0, 0, 0, 0}, {0, 0, 0, 0}, {0, 0, 0, 0}};
#pragma unroll 1
            for (int e = 0; e < 16; ++e) { const int mr = __builtin_amdgcn_readlane(iv, e);
                if (mr >= 0) { const bf16_t* yr = YS + (size_t)mr * D + lane * 4;
#pragma unroll
                    for (int j = 0; j < 4; ++j) { const u32x2 y = *(const u32x2*)(yr + 256 * j); s[j][0] += bf_lo(y.x); s[j][1] += bf_hi(y.x); s[j][2] += bf_lo(y.y); s[j][3] += bf_hi(y.y); } } }
            const float* gt2 = mods + (size_t)((l - 1) * 3 + which) * 6144 + 5 * D;
#pragma unroll
            for (int j = 0; j < 4; ++j) { v[j] += *(const f32x4*)(gt2 + lane * 4 + 256 * j) * s[j]; if (MODE == 0) *(f32x4*)(xr + lane * 4 + 256 * j) = v[j]; }
        }
        float ss = 0.f;
#pragma unroll
        for (int j = 0; j < 4; ++j) ss += (v[j][0] * v[j][0] + v[j][1] * v[j][1]) + (v[j][2] * v[j][2] + v[j][3] * v[j][3]);
        const float rinv = __builtin_amdgcn_rsqf(wave_sum(ss) * (1.0f / D) + EPS);
        if (MODE == 0) {
            const float* sh = mods + (size_t)(l * 3 + which) * 6144; const float* sc = sh + D;
            bf16_t* hr = H + (size_t)row * D + lane * 4;
#pragma unroll
            for (int j = 0; j < 4; ++j) { const int c = lane * 4 + 256 * j; const f32x4 gg = *(const f32x4*)(gm + c), s1 = *(const f32x4*)(sc + c), s0 = *(const f32x4*)(sh + c);
                const f32x4 y = v[j] * rinv * gg * (s1 + 1.0f) + s0; u32x2 w; w.x = cvt_pk_bf16(y[0], y[1]); w.y = cvt_pk_bf16(y[2], y[3]); *(u32x2*)(hr + 256 * j) = w; }
        } else {
            const float* gf = gm; float* orow = outp + (size_t)(b * SEQ + g - CTX) * D + lane * 4;
#pragma unroll
            for (int j = 0; j < 4; ++j) *(f32x4*)(orow + 256 * j) = v[j] * rinv * *(const f32x4*)(gf + lane * 4 + 256 * j);
        }
    }
}

__device__ __forceinline__ void norm2_phase(const Ctx& a, int l) {
    PHASE_IDS(); LAS unsigned char* lds = launder_lds(a.lds); unsigned char* ws = a.ws(); const float* gm = a.in(I_GFFN) + l * D; const int gw = blockIdx.x * 8 + wave, NGW = gridDim.x * 8;
    const float* mods = (const float*)(ws + WS_MODS); const float* X = (const float*)(ws + WS_X); bf16_t* H = (bf16_t*)(ws + WS_H);
    int* inv = (int*)(ws + WS_INV); float* afl = (float*)(ws + WS_AFF); float* afc = afl + 2 * 16 * SEQ;
    LAS float* wrT = (LAS float*)lds;
    { const float* src = a.in(I_WR) + (size_t)l * D * NE; for (int i = tid; i < D * NE / 4; i += 512) { const f32x4 w = *(const f32x4*)(src + i * 4); const int d = i >> 2, e0 = (i & 3) * 4;
        wrT[(e0 + 0) * D + d] = w[0]; wrT[(e0 + 1) * D + d] = w[1]; wrT[(e0 + 2) * D + d] = w[2]; wrT[(e0 + 3) * D + d] = w[3]; } }
    BAR_LDS();
    const bool last = (l == DEPTH - 1);
    for (int row = gw; row < MROWS; row += NGW) {
        const int b = row >= LTOT ? 1 : 0, g = row - b * LTOT; const bool isctx = g < CTX; const int which = isctx ? 2 : b;
        if (last && isctx) continue;
        const float* xr = X + (size_t)row * D; f32x4 v[4];
#pragma unroll
        for (int j = 0; j < 4; ++j) v[j] = *(const f32x4*)(xr + lane * 4 + 256 * j);
        float ss = 0.f;
#pragma unroll
        for (int j = 0; j < 4; ++j) ss += (v[j][0] * v[j][0] + v[j][1] * v[j][1]) + (v[j][2] * v[j][2] + v[j][3] * v[j][3]);
        const float rinv = __builtin_amdgcn_rsqf(wave_sum(ss) * (1.0f / D) + EPS);
        const float* sh = mods + (size_t)(l * 3 + which) * 6144 + 3 * D; const float* sc = sh + D;
        bf16_t* hr = H + (size_t)row * D + lane * 4;
        float p[16];
#pragma unroll
        for (int e = 0; e < 16; ++e) p[e] = 0.f;
#pragma unroll
        for (int j = 0; j < 4; ++j) { const int c = lane * 4 + 256 * j; const f32x4 gg = *(const f32x4*)(gm + c), s1 = *(const f32x4*)(sc + c), s0 = *(const f32x4*)(sh + c);
            const f32x4 y = v[j] * rinv * gg * (s1 + 1.0f) + s0; u32x2 w; w.x = cvt_pk_bf16(y[0], y[1]); w.y = cvt_pk_bf16(y[2], y[3]); *(u32x2*)(hr + 256 * j) = w;
#pragma unroll
            for (int e = 0; e < 16; ++e) { const f32x4 w = *(const LAS f32x4*)(wrT + e * D + c); p[e] += (y[0] * w[0] + y[1] * w[1]) + (y[2] * w[2] + y[3] * w[3]); } }
        { const bool hi = (lane & 32) != 0;
#pragma unroll
          for (int i = 0; i < 8; ++i) { const float send = hi ? p[i] : p[i + 8], keep = hi ? p[i + 8] : p[i]; p[i] = keep + __shfl_xor(send, 32); } }
        { const bool hi = (lane & 16) != 0;
#pragma unroll
          for (int i = 0; i < 4; ++i) { const float send = hi ? p[i] : p[i + 4], keep = hi ? p[i + 4] : p[i]; p[i] = keep + __shfl_xor(send, 16); } }
        { const bool hi = (lane & 8) != 0;
#pragma unroll
          for (int i = 0; i < 2; ++i) { const float send = hi ? p[i] : p[i + 2], keep = hi ? p[i + 2] : p[i]; p[i] = keep + __shfl_xor(send, 8); } }
        { const bool hi = (lane & 4) != 0; const float send = hi ? p[0] : p[1], keep = hi ? p[1] : p[0]; p[0] = keep + __shfl_xor(send, 4); }
        float lg = p[0]; lg += __shfl_xor(lg, 2); lg += __shfl_xor(lg, 1);
        float mx = lg; mx = fmaxf(mx, __shfl_xor(mx, 4)); mx = fmaxf(mx, __shfl_xor(mx, 8)); mx = fmaxf(mx, __shfl_xor(mx, 16)); mx = fmaxf(mx, __shfl_xor(mx, 32));
        const float ex = expf(lg - mx); float sm = ex; sm += __shfl_xor(sm, 4); sm += __shfl_xor(sm, 8); sm += __shfl_xor(sm, 16); sm += __shfl_xor(sm, 32);
        const float aff = ex / sm; const int e = lane >> 2;
        if ((lane & 3) == 0) { if (isctx) afc[(b * 16 + e) * CTX + g] = aff; else afl[(size_t)(b * 16 + e) * SEQ + (g - CTX)] = aff; }
        if (lane < 16) inv[row * 16 + lane] = -1;
    }
}

__device__ __forceinline__ void topk_phase(const Ctx& a, int l) {
    PHASE_IDS(); LAS unsigned char* lds = launder_lds(a.lds); unsigned char* ws = a.ws(); const float* afl = (const float*)(ws + WS_AFF); const float* afc = afl + 2 * 16 * SEQ;
    int* rowmap = (int*)(ws + WS_ROWMAP); float* gate = (float*)(ws + WS_ROWMAP) + MOE_ROWS; int* inv = (int*)(ws + WS_INV);
    LAS unsigned* wcnt = (LAS unsigned*)lds;
    const int nitems = (l == DEPTH - 1) ? 32 : 64;
    for (int it = blockIdx.x; it < nitems; it += gridDim.x) {
        const bool isctx = it >= 32; const int be = it & 31, b = be >> 4, e = be & 15;
        const int n = isctx ? CTX : SEQ, k = isctx ? CAP_CTX : CAP_LAT;
        const float* src = isctx ? afc + be * CTX : afl + (size_t)be * SEQ;
        unsigned key[32];
#pragma unroll
        for (int i = 0; i < 32; ++i) { const int idx = i * 512 + tid; key[i] = idx < n ? __float_as_uint(src[idx]) : 0u; }
        unsigned T = 0u;
        for (int bit = 30; bit >= 0; --bit) { const unsigned cand = T | (1u << bit); unsigned cnt = 0;
#pragma unroll
            for (int i = 0; i < 32; ++i) cnt += (key[i] >= cand) ? 1u : 0u;
#pragma unroll
            for (int o = 1; o < 64; o <<= 1) cnt += __shfl_xor(cnt, o);
            LAS unsigned* wc = wcnt + (bit & 1) * 8; if (lane == 0) wc[wave] = cnt;
            BAR_LDS();
            unsigned tot = 0;
#pragma unroll
            for (int w = 0; w < 8; ++w) tot += wc[w];
            if (tot >= (unsigned)k) T = cand; }
        unsigned mine = 0;
#pragma unroll
        for (int i = 0; i < 32; ++i) mine += (key[i] > T ? 1u : 0u) + (key[i] == T ? 65536u : 0u);
        unsigned incl = mine;
#pragma unroll
        for (int o = 1; o < 64; o <<= 1) { const unsigned t = __shfl_up(incl, o); if (lane >= o) incl += t; }
        LAS unsigned* wt = wcnt + 16; BAR_LDS();
        if (lane == 63) wt[wave] = incl;
        BAR_LDS();
        unsigned base = 0, total = 0;
#pragma unroll
        for (int w = 0; w < 8; ++w) { const unsigned t = wt[w]; total += t; if (w < wave) base += t; }
        const unsigned excl = base + incl - mine; const unsigned cgt = total & 0xffffu; const unsigned need = (unsigned)k - cgt;
        unsigned sg = excl & 0xffffu, se = excl >> 16;
        const int mrbase = e * MOE_ROWS_E + (isctx ? 4096 + b * CAP_CTX : b * CAP_LAT);
        const int rbase = b * LTOT + (isctx ? 0 : CTX);
#pragma unroll
        for (int i = 0; i < 32; ++i) { const int idx = i * 512 + tid; const unsigned kk = key[i]; int slot = -1;
            if (kk > T) { slot = (int)sg; ++sg; } else if (kk == T) { if (se < need) slot = (int)(cgt + se); ++se; }
            if (slot >= 0) { const int mr = mrbase + slot, r = rbase + idx; rowmap[mr] = r; gate[mr] = __uint_as_float(kk); inv[r * 16 + e] = mr; } }
        if (isctx && b == 0 && tid < 192) { const int mr = e * MOE_ROWS_E + 4160 + tid; rowmap[mr] = 0; gate[mr] = 0.f; }
        BAR_LDS();
    }
}

__device__ __forceinline__ void gather_phase(const Ctx& a, int l) {
    PHASE_IDS(); unsigned char* ws = a.ws(); const int gw = blockIdx.x * 8 + wave, NGW = gridDim.x * 8;
    const bf16_t* H = (const bf16_t*)(ws + WS_H); bf16_t* XS = (bf16_t*)(ws + WS_XS); const int* rowmap = (const int*)(ws + WS_ROWMAP);
    const int per = (l == DEPTH - 1) ? 4096 : MOE_ROWS_E;
    for (int i = gw; i < 16 * per; i += NGW) { const int e = i / per, mr = e * MOE_ROWS_E + (i - e * per); const int r = rowmap[mr];
        const u32x4* s = (const u32x4*)(H + (size_t)r * D) + lane; u32x4* d = (u32x4*)(XS + (size_t)mr * D) + lane;
        const u32x4 v0 = s[0], v1 = s[64]; d[0] = v0; d[64] = v1; }
}

constexpr int SC_QI = 0, SC_KI = 17408, SC_KT = 34816, SC_VT = 53248, SC_PI = 71680, SC_SM = 80896, SC_PART = 115712, SC_VA = 119808, SC_VB = 120320, SC_VM = 120832, SC_RED = 121344;
constexpr int ST_Q = 272, ST_T = 144;

__device__ __forceinline__ bf16x8 ldfrag(const LAS unsigned char* base, int row, int stride, int kelem) { return *(const LAS bf16x8*)(base + row * stride + kelem * 2); }
#define MFMA16(a, b, c) __builtin_amdgcn_mfma_f32_16x16x32_bf16((a), (b), (c), 0, 0, 0)

struct ScanItem { int is_ret, colq, colk, colv, colg, mixcol; float lg; };

template <bool FULL>
__device__ __forceinline__ void scan_estage(LAS unsigned char* lds, const unsigned (&kraw)[8], const unsigned (&qraw)[8], const unsigned (&vraw)[8], bool is_ret, float lg, int lane, int wave, float& la_out, float& lb_out) {
    const int cp = lane, to = wave;
    float ca[8], cb[8]; float ra = 0.f, rb = 0.f;
#pragma unroll
    for (int tt = 0; tt < 8; ++tt) { const float lfa = is_ret ? lg : bf_lo(kraw[tt]), lfb = is_ret ? lg : bf_hi(kraw[tt]); ra += lfa; rb += lfb; ca[tt] = ra; cb[tt] = rb; }
    *(LAS f32x2*)(lds + SC_PART + (to * 128 + 2 * cp) * 4) = (f32x2){ra, rb};
    BAR_LDS();
    float pa = 0.f, pb = 0.f, ma = 0.f, mb = 0.f, la = 0.f, lb = 0.f;
#pragma unroll
    for (int t8 = 0; t8 < 8; ++t8) { const f32x2 pp = *(const LAS f32x2*)(lds + SC_PART + (t8 * 128 + 2 * cp) * 4);
        if (t8 < to) { pa += pp.x; pb += pp.y; } if (t8 < 4) { ma += pp.x; mb += pp.y; } la += pp.x; lb += pp.y; }
    unsigned kd[8];
#pragma unroll
    for (int tt = 0; tt < 8; ++tt) { const int rr = 8 * to + tt;
        const float cua = pa + ca[tt], cub = pb + cb[tt];
        const float lfa = is_ret ? lg : bf_lo(kraw[tt]), lfb = is_ret ? lg : bf_hi(kraw[tt]);
        const float ka = is_ret ? bf_lo(kraw[tt]) : 1.0f - fast_exp(lfa), kb = is_ret ? bf_hi(kraw[tt]) : 1.0f - fast_exp(lfb);
        kd[tt] = cvt_pk_bf16(ka * fast_exp(ma - cua), kb * fast_exp(mb - cub));
        if (FULL) { const unsigned qd = cvt_pk_bf16(bf_lo(qraw[tt]) * fast_exp(cua - ma), bf_hi(qraw[tt]) * fast_exp(cub - mb));
            *(LAS unsigned*)(lds + SC_QI + rr * ST_Q + cp * 4) = qd; *(LAS unsigned*)(lds + SC_KI + rr * ST_Q + cp * 4) = kd[tt]; } }
    { u32x4 wa, wb;
      wa.x = (kd[0] & 0xffffu) | (kd[1] << 16); wa.y = (kd[2] & 0xffffu) | (kd[3] << 16); wa.z = (kd[4] & 0xffffu) | (kd[5] << 16); wa.w = (kd[6] & 0xffffu) | (kd[7] << 16);
      wb.x = (kd[0] >> 16) | (kd[1] & 0xffff0000u); wb.y = (kd[2] >> 16) | (kd[3] & 0xffff0000u); wb.z = (kd[4] >> 16) | (kd[5] & 0xffff0000u); wb.w = (kd[6] >> 16) | (kd[7] & 0xffff0000u);
      *(LAS u32x4*)(lds + SC_KT + (2 * cp) * ST_T + to * 16) = wa; *(LAS u32x4*)(lds + SC_KT + (2 * cp + 1) * ST_T + to * 16) = wb; }
    { u32x4 wa, wb;
      wa.x = (vraw[0] & 0xffffu) | (vraw[1] << 16); wa.y = (vraw[2] & 0xffffu) | (vraw[3] << 16); wa.z = (vraw[4] & 0xffffu) | (vraw[5] << 16); wa.w = (vraw[6] & 0xffffu) | (vraw[7] << 16);
      wb.x = (vraw[0] >> 16) | (vraw[1] & 0xffff0000u); wb.y = (vraw[2] >> 16) | (vraw[3] & 0xffff0000u); wb.z = (vraw[4] >> 16) | (vraw[5] & 0xffff0000u); wb.w = (vraw[6] >> 16) | (vraw[7] & 0xffff0000u);
      *(LAS u32x4*)(lds + SC_VT + (2 * cp) * ST_T + to * 16) = wa; *(LAS u32x4*)(lds + SC_VT + (2 * cp + 1) * ST_T + to * 16) = wb; }
    if (to == 0) { *(LAS f32x2*)(lds + SC_VA + 8 * cp) = (f32x2){fast_exp(la), fast_exp(lb)}; *(LAS f32x2*)(lds + SC_VB + 8 * cp) = (f32x2){fast_exp(la - ma), fast_exp(lb - mb)};
        *(LAS f32x2*)(lds + SC_VM + 8 * cp) = (f32x2){fast_exp(ma), fast_exp(mb)}; }
    la_out = la; lb_out = lb;
}

__device__ __forceinline__ void scan_state_update(LAS unsigned char* lds, f32x4 (&ST)[8], int wave, int fr, int fq) {
    const bf16x8 a0 = ldfrag(lds + SC_KT, 16 * wave + fr, ST_T, 8 * fq), a1 = ldfrag(lds + SC_KT, 16 * wave + fr, ST_T, 32 + 8 * fq);
    const f32x4 av = *(const LAS f32x4*)(lds + SC_VA + (16 * wave + 4 * fq) * 4), bv = *(const LAS f32x4*)(lds + SC_VB + (16 * wave + 4 * fq) * 4);
#pragma unroll
    for (int vi = 0; vi < 8; ++vi) { const bf16x8 b0 = ldfrag(lds + SC_VT, 16 * vi + fr, ST_T, 8 * fq), b1 = ldfrag(lds + SC_VT, 16 * vi + fr, ST_T, 32 + 8 * fq);
        f32x4 u = {0.f, 0.f, 0.f, 0.f}; u = MFMA16(a0, b0, u); u = MFMA16(a1, b1, u); ST[vi] = av * ST[vi] + bv * u; }
}

#define SCAN_LOAD_CHUNK(crow_, dir_) do { _Pragma("unroll") for (int tt = 0; tt < 8; ++tt) { const int rr_ = 8 * wave + tt; const size_t ro_ = (size_t)((crow_) + ((dir_) ? 63 - rr_ : rr_)) * INW + 2 * lane; \
        kraw[tt] = *(const unsigned*)(P + ro_ + colk); vraw[tt] = *(const unsigned*)(P + ro_ + colv); if (LOADQ) qraw[tt] = *(const unsigned*)(P + ro_ + colq); } } while (0)

__device__ __forceinline__ void scan1_phase(const Ctx& a, int l) {
    PHASE_IDS(); LAS unsigned char* lds = launder_lds(a.lds); unsigned char* ws = a.ws(); const bf16_t* P = (const bf16_t*)(ws + WS_P); bf16_t* UB = (bf16_t*)(ws + WS_UB); float* AB = (float*)(ws + WS_AB);
    const float* rdec = a.in(I_RDEC) + l * 8; const int fr = lane & 15, fq = lane >> 4; constexpr bool LOADQ = false;
    for (int it = blockIdx.x; it < 2048; it += gridDim.x) {
        const int seq = it >> 6, j = it & 63, b = seq >> 4, hh = (seq >> 1) & 7, dir = seq & 1, tb = dir ? (j == 0 ? 0 : 65 - j) : j;
        const bool is_ret = hh >= 4; const int h = hh & 3;
        const int colk = is_ret ? 6 * 512 + h * 128 : (dir ? 2 * 512 : 512) + h * 128, colv = (is_ret ? 7 * 512 : 3 * 512) + h * 128, colq = 0;
        const float lg = is_ret ? -expf(rdec[dir * 4 + h]) : 0.f;
        const int rowbase = b * LTOT + tb * 256;
        f32x4 ST[8];
#pragma unroll
        for (int vi = 0; vi < 8; ++vi) ST[vi] = (f32x4){0.f, 0.f, 0.f, 0.f};
        float ata = 0.f, atb = 0.f; unsigned kraw[8], qraw[8], vraw[8];
#pragma unroll
        for (int tt = 0; tt < 8; ++tt) qraw[tt] = 0u;
        SCAN_LOAD_CHUNK(rowbase + (dir ? 3 : 0) * 64, dir);
#pragma unroll 1
        for (int ci = 0; ci < 4; ++ci) {
            float la, lb; scan_estage<false>(lds, kraw, qraw, vraw, is_ret, lg, lane, wave, la, lb); ata += la; atb += lb;
            if (ci < 3) { const int tc = dir ? 2 - ci : ci + 1; SCAN_LOAD_CHUNK(rowbase + tc * 64, dir); }
            BAR_LDS();
            scan_state_update(lds, ST, wave, fr, fq);
            BAR_LDS();
        }
        const int slot = seq * 65 + tb;
#pragma unroll
        for (int vi = 0; vi < 8; ++vi) { u32x2 w; w.x = cvt_pk_bf16(ST[vi][0], ST[vi][1]); w.y = cvt_pk_bf16(ST[vi][2], ST[vi][3]); *(u32x2*)(UB + (size_t)slot * 16384 + (size_t)(vi * 512 + tid) * 4) = w; }
        if (wave == 0) *(f32x2*)(AB + (size_t)slot * 128 + 2 * lane) = (f32x2){fast_exp(ata), fast_exp(atb)};
    }
}

__device__ __forceinline__ void scan2_phase(const Ctx& a) {
    PHASE_IDS(); unsigned char* ws = a.ws(); const bf16_t* UB = (const bf16_t*)(ws + WS_UB); bf16_t* SB = (bf16_t*)(ws + WS_SB); const float* AB = (const float*)(ws + WS_AB);
    const int c0 = 16 * (tid >> 6) + 4 * ((tid >> 4) & 3);
    for (int p = blockIdx.x; p < 256; p += gridDim.x) { const int seq = p >> 3, vi = p & 7, dir = seq & 1; const size_t eo = (size_t)(vi * 512 + tid) * 4;
        f32x4 s = {0.f, 0.f, 0.f, 0.f};
#pragma unroll 1
        for (int j0 = 0; j0 < 64; j0 += 8) { u32x2 u[8]; f32x4 av[8];
#pragma unroll
            for (int q = 0; q < 8; ++q) { const int j = j0 + q, tb = dir ? (j == 0 ? 0 : 65 - j) : j; const size_t slot = (size_t)seq * 65 + tb; u[q] = *(const u32x2*)(UB + slot * 16384 + eo); av[q] = *(const f32x4*)(AB + slot * 128 + c0); }
#pragma unroll
            for (int q = 0; q < 8; ++q) { const int j = j0 + q, tb = dir ? (j == 0 ? 0 : 65 - j) : j; const size_t slot = (size_t)seq * 65 + tb;
                u32x2 w; w.x = cvt_pk_bf16(s[0], s[1]); w.y = cvt_pk_bf16(s[2], s[3]); *(u32x2*)(SB + slot * 16384 + eo) = w;
                s = av[q] * s + (f32x4){bf_lo(u[q].x), bf_hi(u[q].x), bf_lo(u[q].y), bf_hi(u[q].y)}; } }
        { const int tb = dir ? 1 : 64; const size_t slot = (size_t)seq * 65 + tb; u32x2 w; w.x = cvt_pk_bf16(s[0], s[1]); w.y = cvt_pk_bf16(s[2], s[3]); *(u32x2*)(SB + slot * 16384 + eo) = w; }
    }
}

__device__ __forceinline__ void scan3_phase(const Ctx& a, int l) {
    PHASE_IDS(); LAS unsigned char* lds = launder_lds(a.lds); unsigned char* ws = a.ws(); const bf16_t* P = (const bf16_t*)(ws + WS_P); const bf16_t* SB = (const bf16_t*)(ws + WS_SB); bf16_t* MIX = (bf16_t*)(ws + WS_MIX);
    float* OB = (float*)(ws + WS_OB) + (size_t)blockIdx.x * 32768;
    const float* rdec = a.in(I_RDEC) + l * 8; const float* onorm = a.in(I_ONORM) + l * 128;
    const int fr = lane & 15, fq = lane >> 4, ti = wave & 3, vh = wave >> 2; constexpr bool LOADQ = true;
    const bool last = (l == DEPTH - 1); const int nitems = last ? 1024 : 1040;
    for (int it = blockIdx.x; it < nitems; it += gridDim.x) {
        int bh, tb; if (last) { bh = it >> 6; tb = 1 + (it & 63); } else { bh = it / 65; tb = it - bh * 65; }
        const int b = bh >> 3, hh = bh & 7; const bool is_ret = hh >= 4; const int h = hh & 3;
        const int colq = (is_ret ? 5 * 512 : 0) + h * 128, colv = (is_ret ? 7 * 512 : 3 * 512) + h * 128, colg = (is_ret ? 8 * 512 : 4 * 512) + h * 128, mixcol = hh * 128;
        const int rowbase = b * LTOT + tb * 256;
#pragma unroll 1
        for (int dir = 1; dir >= 0; --dir) {
            const int colk = is_ret ? 6 * 512 + h * 128 : (dir ? 2 * 512 : 512) + h * 128;
            const float lg = is_ret ? -expf(rdec[dir * 4 + h]) : 0.f;
            f32x4 ST[8];
            if (tb == 0) {
#pragma unroll
                for (int vi = 0; vi < 8; ++vi) ST[vi] = (f32x4){0.f, 0.f, 0.f, 0.f};
            } else { const size_t slot = (size_t)(bh * 2 + dir) * 65 + tb;
#pragma unroll
                for (int vi = 0; vi < 8; ++vi) { const u32x2 w = *(const u32x2*)(SB + slot * 16384 + (size_t)(vi * 512 + tid) * 4); ST[vi] = (f32x4){bf_lo(w.x), bf_hi(w.x), bf_lo(w.y), bf_hi(w.y)}; } }
            unsigned kraw[8], qraw[8], vraw[8];
            SCAN_LOAD_CHUNK(rowbase + (dir ? 3 : 0) * 64, dir);
#pragma unroll 1
            for (int ci = 0; ci < 4; ++ci) {
                const int tc = dir ? 3 - ci : ci, crow = rowbase + tc * 64;
                float la, lb; scan_estage<true>(lds, kraw, qraw, vraw, is_ret, lg, lane, wave, la, lb);
                if (ci < 3) { const int tcn = dir ? 2 - ci : ci + 1; SCAN_LOAD_CHUNK(rowbase + tcn * 64, dir); }
                const int t = 16 * ti + fr, tok = tc * 64 + (dir ? 63 - t : t), grow = rowbase + tok;
                BAR_LDS();
                { const f32x4 em = *(const LAS f32x4*)(lds + SC_VM + (16 * wave + 4 * fq) * 4);
#pragma unroll
                  for (int vi = 0; vi < 8; ++vi) { const f32x4 x = ST[vi] * em; u32x2 w; w.x = cvt_pk_bf16(x[0], x[1]); w.y = cvt_pk_bf16(x[2], x[3]); *(LAS u32x2*)(lds + SC_SM + (16 * vi + fr) * ST_Q + (16 * wave + 4 * fq) * 2) = w; } }
#pragma unroll
                for (int sii = 0; sii < 2; ++sii) { const int si = 2 * vh + sii; f32x4 sc = {0.f, 0.f, 0.f, 0.f};
                    if (si <= ti) {
#pragma unroll
                        for (int ks = 0; ks < 4; ++ks) sc = MFMA16(ldfrag(lds + SC_KI, 16 * si + fr, ST_Q, 32 * ks + 8 * fq), ldfrag(lds + SC_QI, 16 * ti + fr, ST_Q, 32 * ks + 8 * fq), sc);
                        const int s0 = 16 * si + 4 * fq;
#pragma unroll
                        for (int r = 0; r < 4; ++r) sc[r] = (s0 + r <= t) ? sc[r] : 0.f; }
                    u32x2 w; w.x = cvt_pk_bf16(sc[0], sc[1]); w.y = cvt_pk_bf16(sc[2], sc[3]); *(LAS u32x2*)(lds + SC_PI + t * ST_T + (16 * si + 4 * fq) * 2) = w; }
                BAR_LDS();
                f32x4 obv[4]; u32x2 gv[4];
                if (dir == 0) {
#pragma unroll
                    for (int j = 0; j < 4; ++j) { obv[j] = *(const f32x4*)(OB + tok * 128 + 16 * (4 * vh + j) + 4 * fq); gv[j] = *(const u32x2*)(P + (size_t)grow * INW + colg + 16 * (4 * vh + j) + 4 * fq); } }
                f32x4 o[4];
#pragma unroll
                for (int j = 0; j < 4; ++j) o[j] = (f32x4){0.f, 0.f, 0.f, 0.f};
#pragma unroll
                for (int ks = 0; ks < 2; ++ks) { const bf16x8 bf = ldfrag(lds + SC_PI, 16 * ti + fr, ST_T, 32 * ks + 8 * fq);
#pragma unroll
                    for (int j = 0; j < 4; ++j) o[j] = MFMA16(ldfrag(lds + SC_VT, 16 * (4 * vh + j) + fr, ST_T, 32 * ks + 8 * fq), bf, o[j]); }
#pragma unroll
                for (int ks = 0; ks < 4; ++ks) { const bf16x8 bf = ldfrag(lds + SC_QI, 16 * ti + fr, ST_Q, 32 * ks + 8 * fq);
#pragma unroll
                    for (int j = 0; j < 4; ++j) o[j] = MFMA16(ldfrag(lds + SC_SM, 16 * (4 * vh + j) + fr, ST_Q, 32 * ks + 8 * fq), bf, o[j]); }
                scan_state_update(lds, ST, wave, fr, fq);
                if (dir == 1) {
#pragma unroll
                    for (int j = 0; j < 4; ++j) *(f32x4*)(OB + tok * 128 + 16 * (4 * vh + j) + 4 * fq) = o[j];
                    BAR_LDS();
                } else {
                    float ss = 0.f;
#pragma unroll
                    for (int j = 0; j < 4; ++j) { o[j] += obv[j]; ss += (o[j][0] * o[j][0] + o[j][1] * o[j][1]) + (o[j][2] * o[j][2] + o[j][3] * o[j][3]); }
                    ss += __shfl_xor(ss, 16); ss += __shfl_xor(ss, 32);
                    if (fq == 0) *(LAS float*)(lds + SC_RED + (vh * 64 + t) * 4) = ss;
                    BAR_LDS();
                    const float tot = ss + *(const LAS float*)(lds + SC_RED + ((vh ^ 1) * 64 + t) * 4);
                    const float rinv = __builtin_amdgcn_rsqf(tot * (1.0f / 128.0f) + EPS);
#pragma unroll
                    for (int j = 0; j < 4; ++j) { const f32x4 onv = is_ret ? (f32x4){1.f, 1.f, 1.f, 1.f} : *(const f32x4*)(onorm + 16 * (4 * vh + j) + 4 * fq);
                        const f32x4 y = o[j] * rinv * onv * (f32x4){bf_lo(gv[j].x), bf_hi(gv[j].x), bf_lo(gv[j].y), bf_hi(gv[j].y)};
                        u32x2 w; w.x = cvt_pk_bf16(y[0], y[1]); w.y = cvt_pk_bf16(y[2], y[3]); *(u32x2*)(MIX + (size_t)grow * D + mixcol + 16 * (4 * vh + j) + 4 * fq) = w; }
                    BAR_LDS();
                }
            }
            BAR_ALL();
        }
    }
}

struct OutOrder {
    int nrt, skipctx, G, c;
    __device__ __forceinline__ bool next(int i, pg8::Unit& u) const {
        const int L = i * G + c; if (L >= nrt * 4) return false;
        const int r = L >> 2; u.pn = L & 3; u.pm = skipctx ? r + 1 + (r >= 64 ? 1 : 0) : r; return true;
    }
    __device__ __forceinline__ void a_ready(const pg8::Unit&) const {}
    __device__ __forceinline__ void done(const pg8::Unit&) const {}
};

#ifndef PH
#define PH 0xffff
#endif
__global__ void __launch_bounds__(512, 2) mega_fwd(Args a) {
    extern __shared__ __attribute__((aligned(16))) unsigned char lds_raw[];
    LAS unsigned char* lds = (LAS unsigned char*)lds_raw;
    const int tid = threadIdx.x;
    const int G = gridDim.x; const int bx = blockIdx.x; const int vcu = (G % 8 == 0) ? (bx % 8) * (G / 8) + bx / 8 : bx;
    volatile LAS unsigned* MISC = (volatile LAS unsigned*)(lds + MISC_OFF);
    if (tid < 16) MISC[tid] = 0u;
    if (tid == 0) { LAS unsigned long long* pt = (LAS unsigned long long*)(lds + PTR_OFF);
#pragma unroll
        for (int i = 0; i < 18; ++i) pt[i] = (unsigned long long)a.in[i];
        pt[18] = (unsigned long long)a.out; pt[19] = (unsigned long long)a.ws; }
    __syncthreads();
    const Ctx cx{lds};
    XcdBarrier bar = xcd_barrier_post((unsigned*)(cx.ws() + WS_CTL) + 1024, MISC + 8);
#define GRID_BAR() xcd_barrier(bar)

#if PH & 1
    p0_prologue(cx);
#endif
    GRID_BAR();
#if PH & 1
    p0_finalize(cx);
#endif
    GRID_BAR();

#pragma unroll 1
    for (int l = 0; l < DEPTH; ++l) {
        const bool last = (l == DEPTH - 1); unsigned char* ws = cx.ws();
#if PH & 2
        norm1_phase<0>(cx, l);
#endif
        GRID_BAR();
#if PH & 4
        {
            pg8::Gemm g{(const bf16_t*)(ws + WS_H), (const bf16_t*)(ws + WS_WIN) + (size_t)l * INW * D, MROWS, INW, D};
            pg8::StaticOrder S; S.init(MROWS, INW, G, bx);
            pg8::EpiIn E{(bf16_t*)(ws + WS_P), (const float*)(ws + WS_LBS) + l * 512, (const float*)(ws + WS_ROPE)};
            pg8::gemm_phase<pg8::EpiIn, pg8::StaticOrder, true, true>(launder_lds(lds), g, S, E);
        }
#endif
        GRID_BAR();
#if PH & 8
        scan1_phase(cx, l);
#endif
        GRID_BAR();
#if PH & 16
        scan2_phase(cx);
#endif
        GRID_BAR();
#if PH & 32
        scan3_phase(cx, l);
#endif
        GRID_BAR();
#if PH & 64
        {
            pg8::Gemm g{(const bf16_t*)(ws + WS_MIX), (const bf16_t*)(ws + WS_WOUT) + (size_t)l * D * D, MROWS, D, D};
            OutOrder S{last ? 128 : 130, last ? 1 : 0, G, vcu};
            pg8::EpiOut E{(float*)(ws + WS_X), l == 0 ? cx.in(I_X) : nullptr, l == 0 ? cx.in(I_CTX) : nullptr, (const float*)(ws + WS_MODS) + (size_t)(l * 3) * 6144 + 2 * D};
            pg8::gemm_phase<pg8::EpiOut, OutOrder, true, true>(launder_lds(lds), g, S, E);
        }
#endif
        GRID_BAR();
#if PH & 128
        norm2_phase(cx, l);
#endif
        GRID_BAR();
#if PH & 256
        topk_phase(cx, l);
#endif
        GRID_BAR();
#if PH & 512
        gather_phase(cx, l);
#endif
        GRID_BAR();
#if PH & 1024
        {
            pg8::Gemm g{(const bf16_t*)(ws + WS_XS), (const bf16_t*)(ws + WS_WGU) + (size_t)l * 65536 * D, MOE_ROWS, 65536, D};
            pg8::MoeOrder S{last ? 16 : 17, 16, G, vcu};
            pg8::EpiGU E{(bf16_t*)(ws + WS_HID)};
            pg8::gemm_phase<pg8::EpiGU, pg8::MoeOrder, true, true>(launder_lds(lds), g, S, E);
        }
#endif
        GRID_BAR();
#if PH & 2048
        {
            pg8::Gemm g{(const bf16_t*)(ws + WS_HID), (const bf16_t*)(ws + WS_WD) + (size_t)l * 16384 * FF, MOE_ROWS, 16384, FF};
            pg8::MoeOrder S{last ? 16 : 17, 4, G, vcu};
            pg8::EpiDown E{(bf16_t*)(ws + WS_YS), (const float*)(ws + WS_ROWMAP) + MOE_ROWS};
            pg8::gemm_phase<pg8::EpiDown, pg8::MoeOrder, true, true>(launder_lds(lds), g, S, E);
        }
#endif
        GRID_BAR();
    }
#if PH & 4096
    norm1_phase<1>(cx, DEPTH);
#endif
}

extern "C" void kernel_launch(void* const* d_in, const int* in_sizes, int n_in, void* d_out, int out_size, void* d_ws, size_t ws_size, hipStream_t stream) {
    static int grid = 0;
    if (grid == 0) {
        if (n_in != 18 || out_size != NB * SEQ * D || ws_size < WS_END) { fprintf(stderr, "kernel_launch: unexpected problem shape (n_in %d, out %d, ws %zu)\n", n_in, out_size, ws_size); grid = -1; return; }
        int dev = 0, cus = 0, per_cu = 0;
        if (hipGetDevice(&dev) != hipSuccess || hipDeviceGetAttribute(&cus, hipDeviceAttributeMultiprocessorCount, dev) != hipSuccess) { grid = -1; return; }
        if (hipFuncSetAttribute((const void*)mega_fwd, hipFuncAttributeMaxDynamicSharedMemorySize, LDS_BYTES) != hipSuccess) { fprintf(stderr, "kernel_launch: hipFuncSetAttribute failed\n"); grid = -1; return; }
        if (hipOccupancyMaxActiveBlocksPerMultiprocessor(&per_cu, (const void*)mega_fwd, 512, LDS_BYTES) != hipSuccess || per_cu < 1) { fprintf(stderr, "kernel_launch: occupancy query reports %d workgroups per CU\n", per_cu); per_cu = 1; }
        (void)hipGetLastError();
        grid = cus;
    }
    if (grid < 0) return;
    (void)in_sizes;
    if (hipMemsetAsync((char*)d_ws + WS_CTL, 0, CTL_ZERO_BYTES, stream) != hipSuccess) return;
    Args a{};
    for (int i = 0; i < 18; ++i) a.in[i] = (const float*)d_in[i];
    a.out = (float*)d_out; a.ws = (unsigned char*)d_ws;
    hipLaunchKernelGGL(mega_fwd, dim3(grid), dim3(512), LDS_BYTES, stream, a);
}
```

```cpp
#include <hip/hip_runtime.h>
#include <cstdio>
#include <cstdint>

constexpr int D = 1024, NB = 2, SEQ = 16384, CTX = 256, LTOT = SEQ + CTX, MROWS = NB * LTOT;
constexpr int DEPTH = 4, INW = 4608, NE = 16, FF = 2048;
constexpr int CAP_LAT = 2048, CAP_CTX = 32;
constexpr int MOE_ROWS_E = 4352, MOE_ROWS = NE * MOE_ROWS_E;
constexpr int NSLOT = NB * 8 * 2 * 65;
constexpr float EPS = 1e-6f;

constexpr size_t MiB = 1u << 20;
constexpr size_t WS_CTL = 0, CTL_ZERO_BYTES = 64 * 1024;
constexpr size_t WS_MODP = 1 * MiB;
constexpr size_t WS_MODS = 4 * MiB;
constexpr size_t WS_LBS = 5 * MiB;
constexpr size_t WS_ROPE = 5 * MiB + 65536;
constexpr size_t WS_WIN = 8 * MiB;
constexpr size_t WS_WOUT = 44 * MiB;
constexpr size_t WS_WGU = 52 * MiB;
constexpr size_t WS_WD = 564 * MiB;
constexpr size_t WS_X = 820 * MiB;
constexpr size_t WS_H = 950 * MiB;
constexpr size_t WS_MIX = 1015 * MiB;
constexpr size_t WS_P = 1080 * MiB;
constexpr size_t WS_XS = 1080 * MiB;
constexpr size_t WS_HID = 1216 * MiB;
constexpr size_t WS_YS = 1488 * MiB;
constexpr size_t WS_UB = 1624 * MiB;
constexpr size_t WS_SB = 1689 * MiB;
constexpr size_t WS_AB = 1754 * MiB;
constexpr size_t WS_OB = 1756 * MiB;
constexpr size_t WS_AFF = 1788 * MiB;
constexpr size_t WS_ROWMAP = 1791 * MiB;
constexpr size_t WS_INV = 1792 * MiB;
constexpr size_t WS_END = 1800 * MiB;

constexpr int LDS_BYTES = 155648;
constexpr int MISC_OFF = LDS_BYTES - 64;
constexpr int PTR_OFF = LDS_BYTES - 256;

#define GAS __attribute__((address_space(1)))
#define LAS __attribute__((address_space(3)))
typedef float f32x2 __attribute__((ext_vector_type(2)));
typedef unsigned u32x2 __attribute__((ext_vector_type(2)));

__device__ __forceinline__ int opaque_tid() { int t = threadIdx.x; asm volatile("" : "+v"(t)); return t; }
__device__ __forceinline__ LAS unsigned char* launder_lds(LAS unsigned char* p) { unsigned v = (unsigned)(size_t)p; asm volatile("" : "+s"(v)); return (LAS unsigned char*)(size_t)v; }
__device__ __forceinline__ const float* ldptr(LAS unsigned char* lds0, int i) {
    LAS unsigned char* lds = launder_lds(lds0);
    const u32x2 v = *(volatile LAS u32x2*)(lds + PTR_OFF + 8 * i);
    const unsigned lo = __builtin_amdgcn_readfirstlane(v.x), hi = __builtin_amdgcn_readfirstlane(v.y);
    return (const float*)(((unsigned long long)hi << 32) | lo);
}
namespace pg8 {
#define PG8_LAS __attribute__((address_space(3)))
typedef unsigned short bf16_t;
typedef short bf16x8 __attribute__((ext_vector_type(8)));
typedef float f32x4 __attribute__((ext_vector_type(4)));
typedef unsigned u32x4 __attribute__((ext_vector_type(4)));
constexpr int BM = 256, BK = 64, HALF = 128, HTB = HALF * BK * 2  , STAGE_BYTES = 8 * HTB, NXCD = 8, WGM = 8;

__host__ __device__ __forceinline__ int lds_byte(int r, int c) { const int st = (r >> 4) * 2 + (c >> 5), rr = r & 15, cc = c & 31, ob = rr * 64 + cc * 2; return st * 1024 + (ob ^ (((ob >> 9) & 1) << 5)); }
__host__ __device__ __forceinline__ void stage_rc(int b, int& R, int& C) { const int st = b / 1024, sb = b % 1024, swz = sb ^ (((sb >> 9) & 1) << 5); R = (st >> 1) * 16 + swz / 64; C = (st & 1) * 32 + (swz % 64) / 2; }
__host__ __device__ __forceinline__ int perm32(int rho) { const int n = rho >> 4, i = rho & 15; return 8 * (i >> 2) + 4 * n + (i & 3); }

struct Unit { int pm, pn; };
struct Gemm { const bf16_t* A; const bf16_t* Bt; int M, N, K; };

struct StaticOrder {
    int nM, nN, nwg, G, c;
    __host__ __device__ void init(int M, int N, int G_, int c_) { nM = M / BM; nN = N / BM; nwg = nM * nN; G = G_; c = c_; }
    __host__ __device__ bool next(int i, Unit& u) const {
        const long L = (long)i * G + c; if (L >= nwg) return false;
        int wgid = (int)L; { const int q = nwg / NXCD, r = nwg % NXCD, xcd = wgid % NXCD, off = wgid / NXCD; wgid = (xcd < r ? xcd * (q + 1) : r * (q + 1) + (xcd - r) * q) + off; }
        const int nig = WGM * nN, gid = wgid / nig, fm = gid * WGM, gsz = (nM - fm) < WGM ? (nM - fm) : WGM;
        u.pm = fm + ((wgid % nig) % gsz); u.pn = (wgid % nig) / gsz; return true;
    }
    __device__ __forceinline__ void a_ready(const Unit&) const {}
    __device__ __forceinline__ void done(const Unit&) const {}
};
__device__ __forceinline__ unsigned cvt_pk_bf16(float lo, float hi) { unsigned r; asm volatile("v_cvt_pk_bf16_f32 %0, %1, %2" : "=v"(r) : "v"(lo), "v"(hi)); return r; }

struct MoeOrder {
    int NT, NC, G, c;
    __device__ __forceinline__ bool next(int i, Unit& u) const {
        const int L = i * G + c, per = NT * NC; if (L >= 16 * per) return false;
        const int e = L / per, q = L - e * per; u.pm = e * 17 + q / NC; u.pn = e * NC + q % NC; return true;
    }
    __device__ __forceinline__ void a_ready(const Unit&) const {}
    __device__ __forceinline__ void done(const Unit&) const {}
};

__device__ __forceinline__ float fast_exp(float x) { return __builtin_amdgcn_exp2f(x * 1.4426950408889634f); }
__device__ __forceinline__ float fast_sigmoid(float x) { return __builtin_amdgcn_rcpf(1.0f + fast_exp(-x)); }

struct EpiIn {
    static constexpr bool PERM = true, AFTER_DRAIN = false;
    bf16_t* P; const float* lb; const float* cs;
    __device__ __forceinline__ void operator()(const f32x4 (&acc)[2][2][4][2], const Unit& u, int wr, int wc, int fr, int fq) const {
        const int grp = u.pn >> 1;
        const int row0 = u.pm * BM + wr * 64 + fr, col0 = u.pn * BM + wc * 32 + 8 * fq;
        if (grp == 0 || grp == 3 || grp == 7) {
#pragma unroll
            for (int ai = 0; ai < 2; ++ai)
#pragma unroll
                for (int m = 0; m < 4; ++m) { bf16_t* rowp = P + (size_t)(row0 + ai * HALF + m * 16) * INW + col0;
#pragma unroll
                    for (int bj = 0; bj < 2; ++bj) { const f32x4 v0 = acc[ai][bj][m][0], v1 = acc[ai][bj][m][1];
                        u32x4 w; w.x = cvt_pk_bf16(v0[0], v0[1]); w.y = cvt_pk_bf16(v0[2], v0[3]); w.z = cvt_pk_bf16(v1[0], v1[1]); w.w = cvt_pk_bf16(v1[2], v1[3]);
                        *(u32x4*)(rowp + bj * HALF) = w; } }
        } else if (grp == 1 || grp == 2) {
            const int cg = col0 - grp * 512;
            f32x4 lbv[2][2];
#pragma unroll
            for (int bj = 0; bj < 2; ++bj)
#pragma unroll
                for (int n = 0; n < 2; ++n) lbv[bj][n] = *(const f32x4*)(lb + cg + bj * HALF + 4 * n);
#pragma unroll
            for (int ai = 0; ai < 2; ++ai)
#pragma unroll
                for (int m = 0; m < 4; ++m) { bf16_t* rowp = P + (size_t)(row0 + ai * HALF + m * 16) * INW + col0;
#pragma unroll
                    for (int bj = 0; bj < 2; ++bj) { f32x4 v[2];
#pragma unroll
                        for (int n = 0; n < 2; ++n)
#pragma unroll
                            for (int j = 0; j < 4; ++j) { const float l0 = lbv[bj][n][j]; const float f = l0 + (1.0f - l0) * fast_sigmoid(acc[ai][bj][m][n][j]);
                                v[n][j] = __builtin_amdgcn_logf(fmaxf(f, 1e-30f)) * 0.6931471805599453f; }
                        u32x4 w; w.x = cvt_pk_bf16(v[0][0], v[0][1]); w.y = cvt_pk_bf16(v[0][2], v[0][3]); w.z = cvt_pk_bf16(v[1][0], v[1][1]); w.w = cvt_pk_bf16(v[1][2], v[1][3]);
                        *(u32x4*)(rowp + bj * HALF) = w; } }
        } else if (grp == 4 || grp == 8) {
#pragma unroll
            for (int ai = 0; ai < 2; ++ai)
#pragma unroll
                for (int m = 0; m < 4; ++m) { bf16_t* rowp = P + (size_t)(row0 + ai * HALF + m * 16) * INW + col0;
#pragma unroll
                    for (int bj = 0; bj < 2; ++bj) { f32x4 v[2];
#pragma unroll
                        for (int n = 0; n < 2; ++n)
#pragma unroll
                            for (int j = 0; j < 4; ++j) { const float z = acc[ai][bj][m][n][j]; v[n][j] = z * fast_sigmoid(z); }
                        u32x4 w; w.x = cvt_pk_bf16(v[0][0], v[0][1]); w.y = cvt_pk_bf16(v[0][2], v[0][3]); w.z = cvt_pk_bf16(v[1][0], v[1][1]); w.w = cvt_pk_bf16(v[1][2], v[1][3]);
                        *(u32x4*)(rowp + bj * HALF) = w; } }
        } else {
            const float sc = (grp == 6) ? 0.08838834764831845f : 1.0f;
            const int f0 = 16 * (wc & 1) + 4 * fq;
#pragma unroll
            for (int ai = 0; ai < 2; ++ai)
#pragma unroll
                for (int m = 0; m < 4; ++m) { const int row = row0 + ai * HALF + m * 16; bf16_t* rowp = P + (size_t)row * INW + col0;
                    int g = row; if (g >= LTOT) g -= LTOT;
                    int pos = 0; if (g >= CTX) { const int nn = g - CTX; pos = (wc < 2) ? (nn >> 6) : (nn & 63); }
                    const f32x4 t0 = *(const f32x4*)(cs + (size_t)(pos * 32 + f0) * 2), t1 = *(const f32x4*)(cs + (size_t)(pos * 32 + f0) * 2 + 4);
#pragma unroll
                    for (int bj = 0; bj < 2; ++bj) { const f32x4 v0 = acc[ai][bj][m][0] * sc, v1 = acc[ai][bj][m][1] * sc;
                        const float a0 = v0[0] * t0[0] - v0[1] * t0[1], a1 = v0[0] * t0[1] + v0[1] * t0[0];
                        const float a2 = v0[2] * t0[2] - v0[3] * t0[3], a3 = v0[2] * t0[3] + v0[3] * t0[2];
                        const float b0 = v1[0] * t1[0] - v1[1] * t1[1], b1 = v1[0] * t1[1] + v1[1] * t1[0];
                        const float b2 = v1[2] * t1[2] - v1[3] * t1[3], b3 = v1[2] * t1[3] + v1[3] * t1[2];
                        u32x4 w; w.x = cvt_pk_bf16(a0, a1); w.y = cvt_pk_bf16(a2, a3); w.z = cvt_pk_bf16(b0, b1); w.w = cvt_pk_bf16(b2, b3);
                        *(u32x4*)(rowp + bj * HALF) = w; } }
        }
    }
};

struct EpiOut {
    static constexpr bool PERM = false, AFTER_DRAIN = false;
    float* X; const float* xin; const float* cin; const float* gt;
    __device__ __forceinline__ void operator()(const f32x4 (&acc)[2][2][4][2], const Unit& u, int wr, int wc, int fr, int fq) const {
        const int b = u.pm / 65, tb = u.pm - b * 65, which = (tb == 0) ? 2 : b;
        const int row0 = u.pm * BM + wr * 64 + fr, col0 = u.pn * BM + wc * 32 + 4 * fq;
        f32x4 gv[2][2];
#pragma unroll
        for (int bj = 0; bj < 2; ++bj)
#pragma unroll
            for (int n = 0; n < 2; ++n) gv[bj][n] = *(const f32x4*)(gt + which * 6144 + col0 + bj * HALF + n * 16);
#pragma unroll
        for (int ai = 0; ai < 2; ++ai)
#pragma unroll
            for (int m = 0; m < 4; ++m) { const int row = row0 + ai * HALF + m * 16; float* op = X + (size_t)row * D + col0;
                const float* bp = op;
                if (xin) { const int g = row - b * LTOT; bp = (g < CTX ? cin + (size_t)(b * CTX + g) * D : xin + (size_t)(b * SEQ + g - CTX) * D) + col0; }
#pragma unroll
                for (int bj = 0; bj < 2; ++bj)
#pragma unroll
                    for (int n = 0; n < 2; ++n) { const f32x4 bs = *(const f32x4*)(bp + bj * HALF + n * 16); *(f32x4*)(op + bj * HALF + n * 16) = bs + gv[bj][n] * acc[ai][bj][m][n]; } }
    }
};

constexpr float F8_SA = 8.0f, F8_SW = 64.0f, F8_SH = 4.0f;
__device__ __forceinline__ unsigned pk4_fp8(float a, float b, float c, float d) {
    a = __builtin_amdgcn_fmed3f(a, -448.f, 448.f); b = __builtin_amdgcn_fmed3f(b, -448.f, 448.f); c = __builtin_amdgcn_fmed3f(c, -448.f, 448.f); d = __builtin_amdgcn_fmed3f(d, -448.f, 448.f);
    unsigned w = 0; w = __builtin_amdgcn_cvt_pk_fp8_f32(a, b, w, false); w = __builtin_amdgcn_cvt_pk_fp8_f32(c, d, w, true); return w; }
struct EpiGU {
    static constexpr bool PERM = true, AFTER_DRAIN = false;
    unsigned char* HID;
    __device__ __forceinline__ void operator()(const f32x4 (&acc)[2][2][4][2], const Unit& u, int wr, int wc, int fr, int fq) const {
        const int row0 = u.pm * BM + wr * 64 + fr, col0 = (u.pn & 15) * HALF + wc * 32 + 8 * fq;
        constexpr float inv = 1.0f / (F8_SA * F8_SW);
#pragma unroll
        for (int ai = 0; ai < 2; ++ai)
#pragma unroll
            for (int m = 0; m < 4; ++m) { unsigned char* rowp = HID + (size_t)(row0 + ai * HALF + m * 16) * FF + col0; f32x4 v[2];
#pragma unroll
                for (int n = 0; n < 2; ++n)
#pragma unroll
                    for (int j = 0; j < 4; ++j) { const float g = acc[ai][0][m][n][j] * inv; v[n][j] = g * fast_sigmoid(g) * (acc[ai][1][m][n][j] * (inv * F8_SH)); }
                u32x2 w; w.x = pk4_fp8(v[0][0], v[0][1], v[0][2], v[0][3]); w.y = pk4_fp8(v[1][0], v[1][1], v[1][2], v[1][3]);
                *(u32x2*)rowp = w; }
    }
};

struct EpiDown {
    static constexpr bool PERM = true, AFTER_DRAIN = false;
    bf16_t* YS;
    __device__ __forceinline__ void operator()(const f32x4 (&acc)[2][2][4][2], const Unit& u, int wr, int wc, int fr, int fq) const {
        const int row0 = u.pm * BM + wr * 64 + fr, col0 = (u.pn & 3) * BM + wc * 32 + 8 * fq;
        constexpr float gg = 1.0f / (F8_SH * F8_SW);
#pragma unroll
        for (int ai = 0; ai < 2; ++ai)
#pragma unroll
            for (int m = 0; m < 4; ++m) { bf16_t* rowp = YS + (size_t)(row0 + ai * HALF + m * 16) * D + col0;
#pragma unroll
                for (int bj = 0; bj < 2; ++bj) { const f32x4 v0 = acc[ai][bj][m][0] * gg, v1 = acc[ai][bj][m][1] * gg;
                    u32x4 w; w.x = cvt_pk_bf16(v0[0], v0[1]); w.y = cvt_pk_bf16(v0[2], v0[3]); w.z = cvt_pk_bf16(v1[0], v1[1]); w.w = cvt_pk_bf16(v1[2], v1[3]);
                    *(u32x4*)(rowp + bj * HALF) = w; } }
    }
};

typedef int i32x4v __attribute__((ext_vector_type(4)));
typedef int i32x8v __attribute__((ext_vector_type(8)));
__device__ __forceinline__ i32x8v cat8(bf16x8 lo, bf16x8 hi) { const i32x4v a = __builtin_bit_cast(i32x4v, lo), b = __builtin_bit_cast(i32x4v, hi); return __builtin_shufflevector(a, b, 0, 1, 2, 3, 4, 5, 6, 7); }
template <class Epi, class Sched, bool GATHER>
__device__ __forceinline__ void gemm_phase_f8(PG8_LAS unsigned char* lds, const Gemm g, const Sched& S, const Epi& E, const int* rowmap) {
    const int tid = opaque_tid(), wid = __builtin_amdgcn_readfirstlane(tid >> 6), lane = tid & 63, wr = wid >> 2, wc = wid & 3, fr = lane & 15, fq = lane >> 4;
    const int rowb = g.K, nt = rowb / 128;
    unsigned vA0[2], vA1[2], voffB[2];
#pragma unroll
    for (int i = 0; i < 2; ++i) { int R, C; stage_rc(tid * 16 + i * 8192, R, C); const int Rb = Epi::PERM ? ((R & ~31) + perm32(R & 31)) : R;
        voffB[i] = (unsigned)(Rb * rowb + 2 * C); vA0[i] = (unsigned)(R * rowb + 2 * C); vA1[i] = vA0[i]; }
    const size_t kstep = 128;
    const size_t hstep = (size_t)HALF * rowb;
    const size_t tstep = 2 * hstep;
    const unsigned ldsw = (unsigned)wid * 1024u;
    const int aoff = lds_byte(wr * 64 + fr, fq * 8), boff = lds_byte(wc * 32 + fr, fq * 8);
    constexpr int GOFF = STAGE_BYTES;
#define PG8_SA(b, h) (((b) * 2 + (h)) * HTB)
#define PG8_SB(b, h) ((4 + (b) * 2 + (h)) * HTB)
#define PG8_STAGE(bufoff, gbase, voff) do { _Pragma("unroll") for (int _i = 0; _i < 2; ++_i) { unsigned _o = (voff)[_i]; asm volatile("" : "+v"(_o)); \
        __builtin_amdgcn_global_load_lds((const unsigned*)((const char*)(gbase) + _o), (PG8_LAS unsigned*)(lds + (bufoff) + ldsw + _i * 8192), 16, 0, 0); } } while (0)
#define PG8_STAGE_A(bufoff, kbase, h) do { if constexpr (GATHER) { if (h) PG8_STAGE(bufoff, kbase, vA1); else PG8_STAGE(bufoff, kbase, vA0); } else PG8_STAGE(bufoff, (kbase) + (h) * hstep, vA0); } while (0)
#define PG8_GIDX_ISSUE(pm_) do { const int _t = opaque_tid(); _Pragma("unroll") for (int _i = 0; _i < 2; ++_i) { int R, C; stage_rc(_t * 16 + _i * 8192, R, C); _Pragma("unroll") for (int _h = 0; _h < 2; ++_h) \
        __builtin_amdgcn_global_load_lds((const unsigned*)(rowmap + (pm_) * BM + _h * HALF + R), (PG8_LAS unsigned*)(lds + GOFF + ldsw + (_h * 2 + _i) * 256), 4, 0, 0); } } while (0)
#define PG8_GIDX_TAKE() do { const int _t = opaque_tid(); _Pragma("unroll") for (int _i = 0; _i < 2; ++_i) { int R, C; stage_rc(_t * 16 + _i * 8192, R, C); \
        vA0[_i] = *(const PG8_LAS unsigned*)(lds + GOFF + ldsw + (0 * 2 + _i) * 256 + (_t & 63) * 4) * (unsigned)rowb + (unsigned)(2 * C); \
        vA1[_i] = *(const PG8_LAS unsigned*)(lds + GOFF + ldsw + (1 * 2 + _i) * 256 + (_t & 63) * 4) * (unsigned)rowb + (unsigned)(2 * C); } } while (0)
#define PG8_LDA(dst, b, h) do { _Pragma("unroll") for (int m = 0; m < 4; ++m) _Pragma("unroll") for (int k = 0; k < 2; ++k) dst[m][k] = *(const PG8_LAS bf16x8*)(lds + PG8_SA(b, h) + aoff + m * 2048 + k * 1024); } while (0)
#define PG8_LDB(dst, b, h) do { _Pragma("unroll") for (int n = 0; n < 2; ++n) _Pragma("unroll") for (int k = 0; k < 2; ++k) dst[n][k] = *(const PG8_LAS bf16x8*)(lds + PG8_SB(b, h) + boff + n * 2048 + k * 1024); } while (0)
#define PG8_MMA(ai, bj, At, Bt) do { __builtin_amdgcn_s_setprio(1); _Pragma("unroll") for (int m = 0; m < 4; ++m) _Pragma("unroll") for (int n = 0; n < 2; ++n) \
        acc[ai][bj][m][n] = __builtin_amdgcn_mfma_scale_f32_16x16x128_f8f6f4(cat8(Bt[n][0], Bt[n][1]), cat8(At[m][0], At[m][1]), acc[ai][bj][m][n], 0, 0, 0, 0x7f7f7f7f, 0, 0x7f7f7f7f); __builtin_amdgcn_s_setprio(0); } while (0)
#define PG8_WAIT_V(n) asm volatile("s_waitcnt vmcnt(" #n ")" ::: "memory")
#define PG8_WAIT_L(n) asm volatile("s_waitcnt lgkmcnt(" #n ")" ::: "memory")
#define PG8_BAR __builtin_amdgcn_s_barrier()
#define PG8_SCHED __builtin_amdgcn_sched_barrier(0)
    Unit cur, nxt; int ui = 0;
    if (!S.next(0, cur)) return;
    f32x4 acc[2][2][4][2];
#pragma unroll
    for (int a = 0; a < 2; ++a)
#pragma unroll
        for (int b = 0; b < 2; ++b)
#pragma unroll
            for (int m = 0; m < 4; ++m)
#pragma unroll
                for (int n = 0; n < 2; ++n) acc[a][b][m][n] = (f32x4){0.f, 0.f, 0.f, 0.f};
    bf16x8 At[4][2], B0[2][2], B1[2][2];
    const char* cA; const char* cB = (const char*)g.Bt + (size_t)cur.pn * tstep;
    if constexpr (GATHER) { cA = (const char*)g.A; PG8_GIDX_ISSUE(cur.pm); PG8_WAIT_V(0); PG8_GIDX_TAKE(); }
    else cA = (const char*)g.A + (size_t)cur.pm * tstep;
    PG8_STAGE(PG8_SB(0, 0), cB, voffB); PG8_STAGE(PG8_SB(0, 1), cB + hstep, voffB); PG8_STAGE_A(PG8_SA(0, 0), cA, 0); PG8_STAGE_A(PG8_SA(0, 1), cA, 1);
    if (wr == 1) PG8_BAR;
    PG8_WAIT_V(2); PG8_BAR;
    PG8_STAGE(PG8_SB(1, 0), cB + kstep, voffB); PG8_STAGE_A(PG8_SA(1, 0), cA + kstep, 0); PG8_STAGE(PG8_SB(1, 1), cB + hstep + kstep, voffB);
    PG8_WAIT_V(6); PG8_BAR;
    for (;;) {
        const bool has_next = S.next(ui + 1, nxt);
        const char* nA; const char* nB = has_next ? (const char*)g.Bt + (size_t)nxt.pn * tstep : cB;
        if constexpr (GATHER) { nA = cA; if (has_next) PG8_GIDX_ISSUE(nxt.pm); }
        else nA = has_next ? (const char*)g.A + (size_t)nxt.pm * tstep : cA;
#pragma unroll 1
        for (int t = 0; t < nt; t += 2) {
            const bool last = (t == nt - 2);
            const char* a1 = cA + (size_t)(t + 1) * kstep;
            const char* a2 = last ? nA : cA + (size_t)(t + 2) * kstep; const char* b2 = last ? nB : cB + (size_t)(t + 2) * kstep;
            const char* a3 = a2 + kstep; const char* b3 = b2 + kstep;
            PG8_LDB(B0, 0, 0); PG8_LDB(B1, 0, 1); PG8_SCHED; PG8_LDA(At, 0, 0); PG8_STAGE_A(PG8_SA(1, 1), a1, 1);
            if constexpr (GATHER) { if (last && has_next) PG8_GIDX_TAKE(); }
            PG8_WAIT_V(8); PG8_WAIT_L(0); PG8_BAR; PG8_MMA(0, 0, At, B0); PG8_MMA(0, 1, At, B1); PG8_BAR; PG8_SCHED;
            PG8_LDA(At, 0, 1); PG8_STAGE(PG8_SB(0, 0), b2, voffB); PG8_STAGE(PG8_SB(0, 1), b2 + hstep, voffB); PG8_STAGE_A(PG8_SA(0, 0), a2, 0);
            PG8_WAIT_V(8); PG8_WAIT_L(0); PG8_BAR; PG8_MMA(1, 0, At, B0); PG8_MMA(1, 1, At, B1); PG8_BAR; PG8_SCHED;
            PG8_LDB(B0, 1, 0); PG8_LDB(B1, 1, 1); PG8_SCHED; PG8_LDA(At, 1, 0); PG8_STAGE_A(PG8_SA(0, 1), a2, 1);
            PG8_WAIT_V(8); PG8_WAIT_L(0); PG8_BAR; PG8_MMA(0, 0, At, B0); PG8_MMA(0, 1, At, B1); PG8_BAR; PG8_SCHED;
            PG8_LDA(At, 1, 1); PG8_STAGE(PG8_SB(1, 0), b3, voffB); PG8_STAGE(PG8_SB(1, 1), b3 + hstep, voffB); PG8_STAGE_A(PG8_SA(1, 0), a3, 0);
            PG8_WAIT_V(8); PG8_WAIT_L(0); PG8_BAR; PG8_MMA(1, 0, At, B0); PG8_MMA(1, 1, At, B1); PG8_BAR; PG8_SCHED;
        }
        if (wr == 0) PG8_BAR;
        { const int l2_ = opaque_tid() & 63; E(acc, cur, wr, wc, l2_ & 15, l2_ >> 4); }
        if (!has_next) break;
#pragma unroll
        for (int a = 0; a < 2; ++a)
#pragma unroll
            for (int b = 0; b < 2; ++b)
#pragma unroll
                for (int m = 0; m < 4; ++m)
#pragma unroll
                    for (int n = 0; n < 2; ++n) acc[a][b][m][n] = (f32x4){0.f, 0.f, 0.f, 0.f};
        cur = nxt; cA = nA; cB = nB; ++ui;
        if (wr == 1) PG8_BAR;
    }
    PG8_WAIT_V(0);
    PG8_BAR;
#undef PG8_SA
#undef PG8_SB
#undef PG8_STAGE
#undef PG8_STAGE_A
#undef PG8_GIDX_ISSUE
#undef PG8_GIDX_TAKE
#undef PG8_LDA
#undef PG8_LDB
#undef PG8_MMA
#undef PG8_WAIT_V
#undef PG8_WAIT_L
#undef PG8_BAR
#undef PG8_SCHED
}
template <class Epi, class Sched, bool ALIGN_EPI = false, bool SP2 = false>
__device__ __forceinline__ void gemm_phase(PG8_LAS unsigned char* lds, const Gemm g, const Sched& S, const Epi& E) {
    const int tid = opaque_tid(), wid = __builtin_amdgcn_readfirstlane(tid >> 6), lane = tid & 63, wr = wid >> 2, wc = wid & 3, fr = lane & 15, fq = lane >> 4;
    const int K = g.K, nt = K / BK;
    unsigned voffA[2], voffB[2];
#pragma unroll
    for (int i = 0; i < 2; ++i) { int R, C; stage_rc(tid * 16 + i * 8192, R, C); const int Rb = Epi::PERM ? ((R & ~31) + perm32(R & 31)) : R;
        voffA[i] = (unsigned)(R * K + C) * 2u; voffB[i] = (unsigned)(Rb * K + C) * 2u; }
    const size_t kstep = (size_t)(BK * 2);
    const size_t hstep = (size_t)HALF * K * 2;
    const size_t tstep = 2 * hstep;
    const unsigned ldsw = (unsigned)wid * 1024u;
    const int aoff = lds_byte(wr * 64 + fr, fq * 8), boff = lds_byte(wc * 32 + fr, fq * 8);
#define PG8_SA(b, h) (((b) * 2 + (h)) * HTB)
#define PG8_SB(b, h) ((4 + (b) * 2 + (h)) * HTB)
#define PG8_STAGE(bufoff, gbase, voff) do { _Pragma("unroll") for (int _i = 0; _i < 2; ++_i) \
        __builtin_amdgcn_global_load_lds((const unsigned*)((const char*)(gbase) + (voff)[_i]), (PG8_LAS unsigned*)(lds + (bufoff) + ldsw + _i * 8192), 16, 0, 0); } while (0)
#define PG8_LDA(dst, b, h) do { _Pragma("unroll") for (int m = 0; m < 4; ++m) _Pragma("unroll") for (int k = 0; k < 2; ++k) dst[m][k] = *(const PG8_LAS bf16x8*)(lds + PG8_SA(b, h) + aoff + m * 2048 + k * 1024); } while (0)
#define PG8_LDB(dst, b, h) do { _Pragma("unroll") for (int n = 0; n < 2; ++n) _Pragma("unroll") for (int k = 0; k < 2; ++k) dst[n][k] = *(const PG8_LAS bf16x8*)(lds + PG8_SB(b, h) + boff + n * 2048 + k * 1024); } while (0)
#define PG8_MMA(ai, bj, At, Bt) do { __builtin_amdgcn_s_setprio(1); _Pragma("unroll") for (int m = 0; m < 4; ++m) _Pragma("unroll") for (int n = 0; n < 2; ++n) _Pragma("unroll") for (int k = 0; k < 2; ++k) \
        acc[ai][bj][m][n] = __builtin_amdgcn_mfma_f32_16x16x32_bf16(Bt[n][k], At[m][k], acc[ai][bj][m][n], 0, 0, 0); __builtin_amdgcn_s_setprio(0); } while (0)
#define PG8_WAIT_V(n) asm volatile("s_waitcnt vmcnt(" #n ")" ::: "memory")
#define PG8_WAIT_L(n) asm volatile("s_waitcnt lgkmcnt(" #n ")" ::: "memory")
#define PG8_BAR __builtin_amdgcn_s_barrier()
#define PG8_SCHED __builtin_amdgcn_sched_barrier(0)
    Unit cur, nxt; int ui = 0;
    if (!S.next(0, cur)) return;
    f32x4 acc[2][2][4][2];
#pragma unroll
    for (int a = 0; a < 2; ++a)
#pragma unroll
        for (int b = 0; b < 2; ++b)
#pragma unroll
            for (int m = 0; m < 4; ++m)
#pragma unroll
                for (int n = 0; n < 2; ++n) acc[a][b][m][n] = (f32x4){0.f, 0.f, 0.f, 0.f};
    bf16x8 At[4][2], B0[2][2], B1[2][2];
    const char* cA = (const char*)g.A + (size_t)cur.pm * tstep; const char* cB = (const char*)g.Bt + (size_t)cur.pn * tstep;
    S.a_ready(cur);
    if constexpr (SP2) {
        PG8_STAGE(PG8_SB(0, 0), cB, voffB); PG8_STAGE(PG8_SB(0, 1), cB + hstep, voffB); PG8_STAGE(PG8_SA(0, 0), cA, voffA); PG8_STAGE(PG8_SA(0, 1), cA + hstep, voffA);
        if (wr == 1) PG8_BAR;
        PG8_WAIT_V(2); PG8_BAR;
        PG8_STAGE(PG8_SB(1, 0), cB + kstep, voffB); PG8_STAGE(PG8_SA(1, 0), cA + kstep, voffA); PG8_STAGE(PG8_SB(1, 1), cB + hstep + kstep, voffB);
        PG8_WAIT_V(6); PG8_BAR;
    } else {
        PG8_STAGE(PG8_SB(0, 0), cB, voffB); PG8_STAGE(PG8_SA(0, 0), cA, voffA); PG8_STAGE(PG8_SB(0, 1), cB + hstep, voffB); PG8_STAGE(PG8_SA(0, 1), cA + hstep, voffA);
        if (wr == 1) PG8_BAR;
        PG8_WAIT_V(4); PG8_BAR;
        PG8_STAGE(PG8_SB(1, 0), cB + kstep, voffB); PG8_STAGE(PG8_SA(1, 0), cA + kstep, voffA); PG8_STAGE(PG8_SB(1, 1), cB + hstep + kstep, voffB);
        PG8_WAIT_V(6); PG8_BAR;
    }
    for (;;) {
        const bool has_next = S.next(ui + 1, nxt);
        const char* nA = has_next ? (const char*)g.A + (size_t)nxt.pm * tstep : cA; const char* nB = has_next ? (const char*)g.Bt + (size_t)nxt.pn * tstep : cB;
        for (int t = 0; t < nt; t += 2) {
            const bool last = (t == nt - 2);
            const char* a1 = cA + (size_t)(t + 1) * kstep;
            const char* a2 = last ? nA : cA + (size_t)(t + 2) * kstep; const char* b2 = last ? nB : cB + (size_t)(t + 2) * kstep;
            const char* a3 = a2 + kstep; const char* b3 = b2 + kstep;
            if (last && has_next) S.a_ready(nxt);
            if constexpr (SP2) {
            PG8_LDB(B0, 0, 0); PG8_LDB(B1, 0, 1); PG8_SCHED; PG8_LDA(At, 0, 0); PG8_STAGE(PG8_SA(1, 1), a1 + hstep, voffA);
            PG8_WAIT_V(8); PG8_WAIT_L(0); PG8_BAR; PG8_MMA(0, 0, At, B0); PG8_MMA(0, 1, At, B1); PG8_BAR; PG8_SCHED;
            PG8_LDA(At, 0, 1); PG8_STAGE(PG8_SB(0, 0), b2, voffB); PG8_STAGE(PG8_SB(0, 1), b2 + hstep, voffB); PG8_STAGE(PG8_SA(0, 0), a2, voffA);
            PG8_WAIT_V(8); PG8_WAIT_L(0); PG8_BAR; PG8_MMA(1, 0, At, B0); PG8_MMA(1, 1, At, B1); PG8_BAR; PG8_SCHED;
            PG8_LDB(B0, 1, 0); PG8_LDB(B1, 1, 1); PG8_SCHED; PG8_LDA(At, 1, 0); PG8_STAGE(PG8_SA(0, 1), a2 + hstep, voffA);
            PG8_WAIT_V(8); PG8_WAIT_L(0); PG8_BAR; PG8_MMA(0, 0, At, B0); PG8_MMA(0, 1, At, B1); PG8_BAR; PG8_SCHED;
            PG8_LDA(At, 1, 1); PG8_STAGE(PG8_SB(1, 0), b3, voffB); PG8_STAGE(PG8_SB(1, 1), b3 + hstep, voffB); PG8_STAGE(PG8_SA(1, 0), a3, voffA);
            PG8_WAIT_V(8); PG8_WAIT_L(0); PG8_BAR; PG8_MMA(1, 0, At, B0); PG8_MMA(1, 1, At, B1); PG8_BAR; PG8_SCHED;
            } else {
            PG8_LDB(B0, 0, 0); PG8_SCHED; PG8_LDA(At, 0, 0); PG8_STAGE(PG8_SA(1, 1), a1 + hstep, voffA);
            PG8_WAIT_L(8); PG8_BAR; PG8_WAIT_L(0); PG8_MMA(0, 0, At, B0); PG8_BAR; PG8_SCHED;
            PG8_LDB(B1, 0, 1); PG8_STAGE(PG8_SB(0, 0), b2, voffB);
            PG8_BAR; PG8_WAIT_L(0); PG8_MMA(0, 1, At, B1); PG8_BAR;
            PG8_LDA(At, 0, 1); PG8_STAGE(PG8_SA(0, 0), a2, voffA);
            PG8_BAR; PG8_WAIT_L(0); PG8_MMA(1, 0, At, B0); PG8_BAR; PG8_SCHED;
            PG8_STAGE(PG8_SB(0, 1), b2 + hstep, voffB);
            PG8_WAIT_V(6); PG8_BAR; PG8_MMA(1, 1, At, B1); PG8_BAR;
            PG8_LDB(B0, 1, 0); PG8_SCHED; PG8_LDA(At, 1, 0); PG8_STAGE(PG8_SA(0, 1), a2 + hstep, voffA);
            PG8_WAIT_L(8); PG8_BAR; PG8_WAIT_L(0); PG8_MMA(0, 0, At, B0); PG8_BAR; PG8_SCHED;
            PG8_LDB(B1, 1, 1); PG8_STAGE(PG8_SB(1, 0), b3, voffB);
            PG8_BAR; PG8_WAIT_L(0); PG8_MMA(0, 1, At, B1); PG8_BAR;
            PG8_LDA(At, 1, 1); PG8_STAGE(PG8_SA(1, 0), a3, voffA);
            PG8_BAR; PG8_WAIT_L(0); PG8_MMA(1, 0, At, B0); PG8_BAR; PG8_SCHED;
            PG8_STAGE(PG8_SB(1, 1), b3 + hstep, voffB);
            PG8_WAIT_V(6); PG8_BAR; PG8_MMA(1, 1, At, B1); PG8_BAR;
            }
        }
        if constexpr (ALIGN_EPI) { if (wr == 0) PG8_BAR; }
        if constexpr (!Epi::AFTER_DRAIN) { E(acc, cur, wr, wc, fr, fq); S.done(cur); }
        if (!has_next) break;
#pragma unroll
        for (int a = 0; a < 2; ++a)
#pragma unroll
            for (int b = 0; b < 2; ++b)
#pragma unroll
                for (int m = 0; m < 4; ++m)
#pragma unroll
                    for (int n = 0; n < 2; ++n) acc[a][b][m][n] = (f32x4){0.f, 0.f, 0.f, 0.f};
        cur = nxt; cA = nA; cB = nB; ++ui;
        if constexpr (ALIGN_EPI) { if (wr == 1) PG8_BAR; }
    }
    PG8_WAIT_V(0);
    if constexpr (!ALIGN_EPI) { if (wr == 0) PG8_BAR; }
    PG8_BAR;
    if constexpr (Epi::AFTER_DRAIN) { E.fused(acc, cur, wr, wc, fr, fq, lds, wid, lane); S.done(cur); }
#undef PG8_SA
#undef PG8_SB
#undef PG8_STAGE
#undef PG8_LDA
#undef PG8_LDB
#undef PG8_MMA
#undef PG8_WAIT_V
#undef PG8_WAIT_L
#undef PG8_BAR
#undef PG8_SCHED
}
}
#define XB_TMO      128
#define XB_XCNT(j)  (256  + 64 * (j))
#define XB_XSUB(j)  (1280 + 64 * (j))
#define XB_XGEN(j)  (2304 + 64 * (j))
#define XB_TOP      3328
#define XB_TOPGEN   3392
#define XCD_BAR_WORDS 3456
#define XB_SPIN_CAP (1u << 18)

__device__ __forceinline__ unsigned xb_ld(unsigned* p)              { return __hip_atomic_load(p, __ATOMIC_RELAXED, __HIP_MEMORY_SCOPE_AGENT); }
__device__ __forceinline__ unsigned xb_add(unsigned* p, unsigned v) { return __hip_atomic_fetch_add(p, v, __ATOMIC_RELAXED, __HIP_MEMORY_SCOPE_AGENT); }
__device__ __forceinline__ unsigned xb_xcc_id() { return (unsigned)__builtin_amdgcn_s_getreg((3 << 11) | 20) & 0xFu; }
#define XB_SPIN(cond, bar) do { unsigned _sp = 0; while (cond) { __builtin_amdgcn_s_sleep(1); \
    if ((++_sp & 255u) == 0u) { if (xb_ld(&(bar)[XB_TMO])) break; if (_sp > XB_SPIN_CAP) { atomicAdd(&(bar)[XB_TMO], 1u); break; } } } } while (0)

struct XcdBarrier {
    unsigned* bar; unsigned x;
    volatile LAS unsigned* st;
};

__device__ __forceinline__ XcdBarrier xcd_barrier_post(unsigned* bar, volatile LAS unsigned* st) {
    XcdBarrier b; b.bar = bar; b.x = xb_xcc_id(); b.st = st;
    if (threadIdx.x == 0) (void)xb_add(&bar[XB_XCNT(b.x)], 1u);
    return b;
}
__device__ __forceinline__ void xcd_barrier_complete(unsigned* bar, unsigned x, unsigned& nloc, unsigned& nx) {
    const unsigned G = gridDim.x * gridDim.y * gridDim.z;
    unsigned sum, cnt, mine, sp = 0u;
    for (;;) {
        sum = 0u; cnt = 0u; mine = 0u;
#pragma unroll
        for (unsigned j = 0; j < 16; ++j) { const unsigned c = xb_ld(&bar[XB_XCNT(j)]); sum += c; cnt += (c > 0u) ? 1u : 0u; mine = (j == x) ? c : mine; }
        if (sum == G) break;
        __builtin_amdgcn_s_sleep(1);
        if ((++sp & 255u) == 0u) { if (xb_ld(&bar[XB_TMO])) break; if (sp > XB_SPIN_CAP) { atomicAdd(&bar[XB_TMO], 1u); break; } }
    }
    nloc = mine > 0u ? mine : 1u; nx = cnt > 0u ? cnt : 1u;
}

__device__ __forceinline__ void xcd_barrier(const XcdBarrier& b) {
    asm volatile("s_waitcnt vmcnt(0)" ::: "memory");
    __syncthreads();
    if (threadIdx.x == 0) {
        unsigned* bar = b.bar;
        __builtin_amdgcn_s_waitcnt(0);
        unsigned nloc = b.st[0], nx = b.st[1];
        if (nloc == 0u) { xcd_barrier_complete(bar, b.x, nloc, nx); b.st[0] = nloc; b.st[1] = nx; }
        const unsigned old = xb_add(&bar[XB_XSUB(b.x)], 1u);
        const unsigned gen = old / nloc;
        if (old + 1u == (gen + 1u) * nloc) {
            __builtin_amdgcn_fence(__ATOMIC_RELEASE, "agent");
            asm volatile("s_waitcnt vmcnt(0)" ::: "memory");
            const unsigned og = xb_add(&bar[XB_TOP], 1u);
            const unsigned tg = og / nx;
            if (og + 1u == (tg + 1u) * nx) xb_add(&bar[XB_TOPGEN], 1u);
            else XB_SPIN(xb_ld(&bar[XB_TOPGEN]) == tg, bar);
            __builtin_amdgcn_fence(__ATOMIC_ACQUIRE, "agent");
            xb_add(&bar[XB_XGEN(b.x)], 1u);
            asm volatile("s_waitcnt vmcnt(0)" ::: "memory");
        } else {
            XB_SPIN(xb_ld(&bar[XB_XGEN(b.x)]) == gen, bar);
            __builtin_amdgcn_fence(__ATOMIC_ACQUIRE, "agent");
            asm volatile("s_waitcnt vmcnt(0)" ::: "memory");
        }
    }
    __syncthreads();
}

using pg8::bf16_t; using pg8::bf16x8; using pg8::f32x4; using pg8::u32x4; using pg8::cvt_pk_bf16; using pg8::fast_exp;

#define BAR_LDS() do { asm volatile("s_waitcnt lgkmcnt(0)" ::: "memory"); __builtin_amdgcn_s_barrier(); asm volatile("" ::: "memory"); } while (0)
#define BAR_ALL() do { asm volatile("s_waitcnt vmcnt(0) lgkmcnt(0)" ::: "memory"); __builtin_amdgcn_s_barrier(); asm volatile("" ::: "memory"); } while (0)

__device__ __forceinline__ float wave_sum(float v) {
#pragma unroll
    for (int o = 1; o < 64; o <<= 1) v += __shfl_xor(v, o);
    return v;
}
__device__ __forceinline__ float bf_lo(unsigned u) { return __uint_as_float(u << 16); }
__device__ __forceinline__ float bf_hi(unsigned u) { return __uint_as_float(u & 0xffff0000u); }

struct Args { const float* in[18]; float* out; unsigned char* ws; };
struct Ctx { LAS unsigned char* lds;
    __device__ __forceinline__ const float* in(int i) const { return ldptr(lds, i); }
    __device__ __forceinline__ float* out() const { return (float*)ldptr(lds, 18); }
    __device__ __forceinline__ unsigned char* ws() const { return (unsigned char*)ldptr(lds, 19); } };
#define PHASE_IDS() const int tid = opaque_tid(), lane = tid & 63, wave = __builtin_amdgcn_readfirstlane(tid >> 6); (void)tid; (void)lane; (void)wave
enum { I_X = 0, I_C, I_CTX, I_CCTX, I_WADA, I_BADA, I_GMIX, I_GFFN, I_WIN, I_WOUT, I_LBL, I_ONORM, I_RDEC, I_WR, I_WEG, I_WEU, I_WED, I_GFIN };

__device__ __forceinline__ void tr_item(const float* W, int N, bf16_t* WT, int Kd, int k0, int n0, int drow0, LAS float* scr, int lane) {
    f32x4 v[16];
    const float* src = W + (size_t)(k0 + (lane >> 4)) * N + n0 + (lane & 15) * 4;
#pragma unroll
    for (int i = 0; i < 16; ++i) v[i] = *(const f32x4*)(src + (size_t)(i * 4) * N);
#pragma unroll
    for (int i = 0; i < 16; ++i) { LAS float* d = scr + (i * 4 + (lane >> 4)) * 65 + (lane & 15) * 4; d[0] = v[i][0]; d[1] = v[i][1]; d[2] = v[i][2]; d[3] = v[i][3]; }
    asm volatile("s_waitcnt lgkmcnt(0)" ::: "memory");
    const int c = lane & 7;
#pragma unroll
    for (int j = 0; j < 8; ++j) { const int n = j * 8 + (lane >> 3); const LAS float* s = scr + (8 * c) * 65 + n;
        u32x4 o; o.x = cvt_pk_bf16(s[0], s[65]); o.y = cvt_pk_bf16(s[2 * 65], s[3 * 65]); o.z = cvt_pk_bf16(s[4 * 65], s[5 * 65]); o.w = cvt_pk_bf16(s[6 * 65], s[7 * 65]);
        *(u32x4*)(WT + (size_t)(drow0 + n) * Kd + k0 + 8 * c) = o; }
    asm volatile("s_waitcnt lgkmcnt(0)" ::: "memory");
}

__device__ __forceinline__ void tr_item8(const float* W, int N, unsigned char* WT, int Kd, int k0, int n0, int drow0, LAS float* scr, int lane, float scale) {
    f32x4 v[16];
    const float* src = W + (size_t)(k0 + (lane >> 4)) * N + n0 + (lane & 15) * 4;
#pragma unroll
    for (int i = 0; i < 16; ++i) v[i] = *(const f32x4*)(src + (size_t)(i * 4) * N);
#pragma unroll
    for (int i = 0; i < 16; ++i) { LAS float* d = scr + (i * 4 + (lane >> 4)) * 65 + (lane & 15) * 4; d[0] = v[i][0] * scale; d[1] = v[i][1] * scale; d[2] = v[i][2] * scale; d[3] = v[i][3] * scale; }
    asm volatile("s_waitcnt lgkmcnt(0)" ::: "memory");
    const int c = lane & 3;
#pragma unroll
    for (int j = 0; j < 4; ++j) { const int n = j * 16 + (lane >> 2); const LAS float* s = scr + (16 * c) * 65 + n;
        u32x4 o; o.x = pg8::pk4_fp8(s[0], s[65], s[2 * 65], s[3 * 65]); o.y = pg8::pk4_fp8(s[4 * 65], s[5 * 65], s[6 * 65], s[7 * 65]);
        o.z = pg8::pk4_fp8(s[8 * 65], s[9 * 65], s[10 * 65], s[11 * 65]); o.w = pg8::pk4_fp8(s[12 * 65], s[13 * 65], s[14 * 65], s[15 * 65]);
        *(u32x4*)(WT + (size_t)(drow0 + n) * Kd + k0 + 16 * c) = o; }
    asm volatile("s_waitcnt lgkmcnt(0)" ::: "memory");
}

__device__ __forceinline__ void p0_prologue(const Ctx& a) {
    PHASE_IDS(); LAS unsigned char* lds = launder_lds(a.lds); unsigned char* ws = a.ws(); const float* cin_ = a.in(I_C); const float* cctx_ = a.in(I_CCTX);
    LAS float* scr = (LAS float*)(lds + wave * 16640);
    LAS float* scond = (LAS float*)(lds + 8 * 16640);
    for (int i = tid; i < 3 * D; i += 512) { const int w = i >> 10, k = i & 1023; const float cv = (w < 2) ? cin_[w * D + k] : cctx_[k]; scond[i] = cv * pg8::fast_sigmoid(cv); }
    if (blockIdx.x == 0) { const int c = tid; const float* lg = a.in(I_LBL);
        const float l0 = lg[c], l1 = lg[512 + c], l2 = lg[1024 + c], l3 = lg[1536 + c]; const float mx = fmaxf(fmaxf(l0, l1), fmaxf(l2, l3));
        const float e0 = expf(l0 - mx), e1 = expf(l1 - mx), e2 = expf(l2 - mx), e3 = expf(l3 - mx), inv = 1.0f / (e0 + e1 + e2 + e3);
        float* lbs = (float*)(ws + WS_LBS); lbs[c] = 0.f; lbs[512 + c] = e1 * inv; lbs[1024 + c] = (e1 + e2) * inv; lbs[1536 + c] = (e1 + e2 + e3) * inv; }
    if (blockIdx.x >= 1 && blockIdx.x <= 16) { const int idx = (blockIdx.x - 1) * 512 + tid, pos = idx >> 5, f = idx & 31;
        const float invf = powf(10000.0f, -(float)f / 32.0f), ang = (float)pos * invf; float* cs = (float*)(ws + WS_ROPE); cs[idx * 2] = cosf(ang); cs[idx * 2 + 1] = sinf(ang); }
    BAR_LDS();
    const int gw = blockIdx.x * 8 + wave, NGW = gridDim.x * 8;
    for (int it = gw; it < 4 * 24 * 8; it += NGW) { const int l = it / 192, r = it % 192, cg = r >> 3, ks = r & 7; const int cols = cg * 256 + lane * 4;
        const float* wp = a.in(I_WADA) + ((size_t)l * D + ks * 128) * 6144 + cols; f32x4 a0 = {0, 0, 0, 0}, a1 = a0, a2 = a0;
#pragma unroll 8
        for (int kk = 0; kk < 128; ++kk) { const f32x4 w = *(const f32x4*)(wp + (size_t)kk * 6144); const int k = ks * 128 + kk; a0 += w * scond[k]; a1 += w * scond[D + k]; a2 += w * scond[2 * D + k]; }
        float* pp = (float*)(ws + WS_MODP) + (size_t)((l * 8 + ks) * 3) * 6144 + cols; *(f32x4*)pp = a0; *(f32x4*)(pp + 6144) = a1; *(f32x4*)(pp + 2 * 6144) = a2; }
    constexpr int I_IN = 16 * 72, I_OUT = 16 * 16, I_E = 512;
    constexpr int NIT = 4 * (I_IN + I_OUT) + 64 * 3 * I_E;
    for (int it = gw; it < NIT; it += NGW) {
        int r = it;
        if (r < 4 * I_IN) { const int l = r / I_IN, q = r % I_IN, kb = q / 72, nb = q % 72;
            tr_item(a.in(I_WIN) + (size_t)l * D * INW, INW, (bf16_t*)(ws + WS_WIN) + (size_t)l * INW * D, D, kb * 64, nb * 64, nb * 64, scr, lane); continue; }
        r -= 4 * I_IN;
        if (r < 4 * I_OUT) { const int l = r / I_OUT, q = r % I_OUT, kb = q / 16, nb = q % 16;
            tr_item(a.in(I_WOUT) + (size_t)l * D * D, D, (bf16_t*)(ws + WS_WOUT) + (size_t)l * D * D, D, kb * 64, nb * 64, nb * 64, scr, lane); continue; }
        r -= 4 * I_OUT;
        const int le = r / (3 * I_E), q3 = r % (3 * I_E), kind = q3 / I_E, q = q3 % I_E;
        if (kind < 2) { const int kb = q / 32, nb = q % 32, n0 = nb * 64;
            const int drow = 256 * (n0 >> 7) + (n0 & 127) + kind * 128;
            tr_item8(a.in(kind == 0 ? I_WEG : I_WEU) + (size_t)le * D * FF, FF, (unsigned char*)(ws + WS_WGU) + (size_t)le * 4096 * D, D, kb * 64, n0, drow, scr, lane, pg8::F8_SW);
        } else { const int kb = q / 16, nb = q % 16;
            tr_item8(a.in(I_WED) + (size_t)le * FF * D, D, (unsigned char*)(ws + WS_WD) + (size_t)le * D * FF, FF, kb * 64, nb * 64, nb * 64, scr, lane, pg8::F8_SW); }
    }
}

__device__ __forceinline__ void p0_finalize(const Ctx& a) {
    PHASE_IDS(); unsigned char* ws = a.ws(); const float* bada = a.in(I_BADA); const float* part = (const float*)(ws + WS_MODP); float* mods = (float*)(ws + WS_MODS);
    for (int i = blockIdx.x * 512 + tid; i < 4 * 3 * 6144; i += gridDim.x * 512) { const int l = i / (3 * 6144), r = i % (3 * 6144), w = r / 6144, j = r % 6144;
        float s = bada[l * 6144 + j];
#pragma unroll
        for (int ks = 0; ks < 8; ++ks) s += part[(size_t)((l * 8 + ks) * 3 + w) * 6144 + j];
        mods[i] = s; }
}

template <int MODE>
__device__ __forceinline__ void norm1_phase(const Ctx& a, int l) {
    PHASE_IDS(); unsigned char* ws = a.ws(); const float* in_x = a.in(I_X); const float* in_ctx = a.in(I_CTX); const float* gm = (MODE == 0) ? a.in(I_GMIX) + l * D : a.in(I_GFIN); float* outp = a.out(); const int gw = blockIdx.x * 8 + wave, NGW = gridDim.x * 8;
    const float* mods = (const float*)(ws + WS_MODS); float* X = (float*)(ws + WS_X); bf16_t* H = (bf16_t*)(ws + WS_H);
    const int* inv = (const int*)(ws + WS_INV); const bf16_t* YS = (const bf16_t*)(ws + WS_YS); const float* gate = (const float*)(ws + WS_ROWMAP) + MOE_ROWS;
    for (int row = gw; row < MROWS; row += NGW) {
        const int b = row >= LTOT ? 1 : 0, g = row - b * LTOT; const bool isctx = g < CTX; const int which = isctx ? 2 : b;
        if (MODE == 1 && isctx) continue;
        f32x4 v[4];
        if (l == 0) { const float* src = isctx ? in_ctx + (size_t)(b * CTX + g) * D : in_x + (size_t)(b * SEQ + g - CTX) * D;
#pragma unroll
            for (int j = 0; j < 4; ++j) v[j] = *(const f32x4*)(src + lane * 4 + 256 * j);
        } else {
            float* xr = X + (size_t)row * D;
#pragma unroll
            for (int j = 0; j < 4; ++j) v[j] = *(const f32x4*)(xr + lane * 4 + 256 * j);
            const int iv = inv[row * 16 + (lane & 15)];
            f32x4 s[4] = {{0, 0, 0, 0}, {0, 0, 0, 0}, {0, 0, 0, 0}, {0, 0, 0, 0}};
#pragma unroll 1
            for (int e = 0; e < 16; ++e) { const int mr = __builtin_amdgcn_readlane(iv, e);
                if (mr >= 0) { const bf16_t* yr = YS + (size_t)mr * D + lane * 4; const float gg = gate[mr];
#pragma unroll
                    for (int j = 0; j < 4; ++j) { const u32x2 y = *(const u32x2*)(yr + 256 * j); s[j][0] += gg * bf_lo(y.x); s[j][1] += gg * bf_hi(y.x); s[j][2] += gg * bf_lo(y.y); s[j][3] += gg * bf_hi(y.y); } } }
            const float* gt2 = mods + (size_t)((l - 1) * 3 + which) * 6144 + 5 * D;
#pragma unroll
            for (int j = 0; j < 4; ++j) { v[j] += *(const f32x4*)(gt2 + lane * 4 + 256 * j) * s[j]; if (MODE == 0) *(f32x4*)(xr + lane * 4 + 256 * j) = v[j]; }
        }
        float ss = 0.f;
#pragma unroll
        for (int j = 0; j < 4; ++j) ss += (v[j][0] * v[j][0] + v[j][1] * v[j][1]) + (v[j][2] * v[j][2] + v[j][3] * v[j][3]);
        const float rinv = __builtin_amdgcn_rsqf(wave_sum(ss) * (1.0f / D) + EPS);
        if (MODE == 0) {
            const float* sh = mods + (size_t)(l * 3 + which) * 6144; const float* sc = sh + D;
            bf16_t* hr = H + (size_t)row * D + lane * 4;
#pragma unroll
            for (int j = 0; j < 4; ++j) { const int c = lane * 4 + 256 * j; const f32x4 gg = *(const f32x4*)(gm + c), s1 = *(const f32x4*)(sc + c), s0 = *(const f32x4*)(sh + c);
                const f32x4 y = v[j] * rinv * gg * (s1 + 1.0f) + s0; u32x2 w; w.x = cvt_pk_bf16(y[0], y[1]); w.y = cvt_pk_bf16(y[2], y[3]); *(u32x2*)(hr + 256 * j) = w; }
        } else {
            const float* gf = gm; float* orow = outp + (size_t)(b * SEQ + g - CTX) * D + lane * 4;
#pragma unroll
            for (int j = 0; j < 4; ++j) *(f32x4*)(orow + 256 * j) = v[j] * rinv * *(const f32x4*)(gf + lane * 4 + 256 * j);
        }
    }
}

__device__ __forceinline__ void norm2_phase(const Ctx& a, int l) {
    PHASE_IDS(); LAS unsigned char* lds = launder_lds(a.lds); unsigned char* ws = a.ws(); const float* gm = a.in(I_GFFN) + l * D; const int gw = blockIdx.x * 8 + wave, NGW = gridDim.x * 8;
    const float* mods = (const float*)(ws + WS_MODS); const float* X = (const float*)(ws + WS_X); unsigned char* H8 = (unsigned char*)(ws + WS_H);
    int* inv = (int*)(ws + WS_INV); float* afl = (float*)(ws + WS_AFF); float* afc = afl + 2 * 16 * SEQ;
    LAS float* wrT = (LAS float*)lds;
    { const float* src = a.in(I_WR) + (size_t)l * D * NE; for (int i = tid; i < D * NE / 4; i += 512) { const f32x4 w = *(const f32x4*)(src + i * 4); const int d = i >> 2, e0 = (i & 3) * 4;
        wrT[(e0 + 0) * D + d] = w[0]; wrT[(e0 + 1) * D + d] = w[1]; wrT[(e0 + 2) * D + d] = w[2]; wrT[(e0 + 3) * D + d] = w[3]; } }
    BAR_LDS();
    const bool last = (l == DEPTH - 1);
    for (int row = gw; row < MROWS; row += NGW) {
        const int b = row >= LTOT ? 1 : 0, g = row - b * LTOT; const bool isctx = g < CTX; const int which = isctx ? 2 : b;
        if (last && isctx) continue;
        const float* xr = X + (size_t)row * D; f32x4 v[4];
#pragma unroll
        for (int j = 0; j < 4; ++j) v[j] = *(const f32x4*)(xr + lane * 4 + 256 * j);
        float ss = 0.f;
#pragma unroll
        for (int j = 0; j < 4; ++j) ss += (v[j][0] * v[j][0] + v[j][1] * v[j][1]) + (v[j][2] * v[j][2] + v[j][3] * v[j][3]);
        const float rinv = __builtin_amdgcn_rsqf(wave_sum(ss) * (1.0f / D) + EPS);
        const float* sh = mods + (size_t)(l * 3 + which) * 6144 + 3 * D; const float* sc = sh + D;
        unsigned char* hr = H8 + (size_t)row * D + lane * 4;
        float p[16];
#pragma unroll
        for (int e = 0; e < 16; ++e) p[e] = 0.f;
#pragma unroll
        for (int j = 0; j < 4; ++j) { const int c = lane * 4 + 256 * j; const f32x4 gg = *(const f32x4*)(gm + c), s1 = *(const f32x4*)(sc + c), s0 = *(const f32x4*)(sh + c);
            const f32x4 y = v[j] * rinv * gg * (s1 + 1.0f) + s0; *(unsigned*)(hr + 256 * j) = pg8::pk4_fp8(y[0] * pg8::F8_SA, y[1] * pg8::F8_SA, y[2] * pg8::F8_SA, y[3] * pg8::F8_SA);
#pragma unroll
            for (int e = 0; e < 16; ++e) { const f32x4 w = *(const LAS f32x4*)(wrT + e * D + c); p[e] += (y[0] * w[0] + y[1] * w[1]) + (y[2] * w[2] + y[3] * w[3]); } }
        { const bool hi = (lane & 32) != 0;
#pragma unroll
          for (int i = 0; i < 8; ++i) { const float send = hi ? p[i] : p[i + 8], keep = hi ? p[i + 8] : p[i]; p[i] = keep + __shfl_xor(send, 32); } }
        { const bool hi = (lane & 16) != 0;
#pragma unroll
          for (int i = 0; i < 4; ++i) { const float send = hi ? p[i] : p[i + 4], keep = hi ? p[i + 4] : p[i]; p[i] = keep + __shfl_xor(send, 16); } }
        { const bool hi = (lane & 8) != 0;
#pragma unroll
          for (int i = 0; i < 2; ++i) { const float send = hi ? p[i] : p[i + 2], keep = hi ? p[i + 2] : p[i]; p[i] = keep + __shfl_xor(send, 8); } }
        { const bool hi = (lane & 4) != 0; const float send = hi ? p[0] : p[1], keep = hi ? p[1] : p[0]; p[0] = keep + __shfl_xor(send, 4); }
        float lg = p[0]; lg += __shfl_xor(lg, 2); lg += __shfl_xor(lg, 1);
        float mx = lg; mx = fmaxf(mx, __shfl_xor(mx, 4)); mx = fmaxf(mx, __shfl_xor(mx, 8)); mx = fmaxf(mx, __shfl_xor(mx, 16)); mx = fmaxf(mx, __shfl_xor(mx, 32));
        const float ex = expf(lg - mx); float sm = ex; sm += __shfl_xor(sm, 4); sm += __shfl_xor(sm, 8); sm += __shfl_xor(sm, 16); sm += __shfl_xor(sm, 32);
        const float aff = ex / sm; const int e = lane >> 2;
        if ((lane & 3) == 0) { if (isctx) afc[(b * 16 + e) * CTX + g] = aff; else afl[(size_t)(b * 16 + e) * SEQ + (g - CTX)] = aff; }
        if (lane < 16) inv[row * 16 + lane] = -1;
    }
}

__device__ __forceinline__ void topk_phase(const Ctx& a, int l) {
    PHASE_IDS(); LAS unsigned char* lds = launder_lds(a.lds); unsigned char* ws = a.ws(); const float* afl = (const float*)(ws + WS_AFF); const float* afc = afl + 2 * 16 * SEQ;
    int* rowmap = (int*)(ws + WS_ROWMAP); float* gate = (float*)(ws + WS_ROWMAP) + MOE_ROWS; int* inv = (int*)(ws + WS_INV);
    LAS unsigned* wcnt = (LAS unsigned*)lds;
    const int nitems = (l == DEPTH - 1) ? 32 : 64;
    for (int it = blockIdx.x; it < nitems; it += gridDim.x) {
        const bool isctx = it >= 32; const int be = it & 31, b = be >> 4, e = be & 15;
        const int n = isctx ? CTX : SEQ, k = isctx ? CAP_CTX : CAP_LAT;
        const float* src = isctx ? afc + be * CTX : afl + (size_t)be * SEQ;
        unsigned key[32];
#pragma unroll
        for (int i = 0; i < 32; ++i) { const int idx = i * 512 + tid; key[i] = idx < n ? __float_as_uint(src[idx]) : 0u; }
        unsigned T = 0u;
        for (int bit = 30; bit >= 0; --bit) { const unsigned cand = T | (1u << bit); unsigned cnt = 0;
#pragma unroll
            for (int i = 0; i < 32; ++i) cnt += (key[i] >= cand) ? 1u : 0u;
#pragma unroll
            for (int o = 1; o < 64; o <<= 1) cnt += __shfl_xor(cnt, o);
            LAS unsigned* wc = wcnt + (bit & 1) * 8; if (lane == 0) wc[wave] = cnt;
            BAR_LDS();
            unsigned tot = 0;
#pragma unroll
            for (int w = 0; w < 8; ++w) tot += wc[w];
            if (tot >= (unsigned)k) T = cand; }
        unsigned mine = 0;
#pragma unroll
        for (int i = 0; i < 32; ++i) mine += (key[i] > T ? 1u : 0u) + (key[i] == T ? 65536u : 0u);
        unsigned incl = mine;
#pragma unroll
        for (int o = 1; o < 64; o <<= 1) { const unsigned t = __shfl_up(incl, o); if (lane >= o) incl += t; }
        LAS unsigned* wt = wcnt + 16; BAR_LDS();
        if (lane == 63) wt[wave] = incl;
        BAR_LDS();
        unsigned base = 0, total = 0;
#pragma unroll
        for (int w = 0; w < 8; ++w) { const unsigned t = wt[w]; total += t; if (w < wave) base += t; }
        const unsigned excl = base + incl - mine; const unsigned cgt = total & 0xffffu; const unsigned need = (unsigned)k - cgt;
        unsigned sg = excl & 0xffffu, se = excl >> 16;
        const int mrbase = e * MOE_ROWS_E + (isctx ? 4096 + b * CAP_CTX : b * CAP_LAT);
        const int rbase = b * LTOT + (isctx ? 0 : CTX);
#pragma unroll
        for (int i = 0; i < 32; ++i) { const int idx = i * 512 + tid; const unsigned kk = key[i]; int slot = -1;
            if (kk > T) { slot = (int)sg; ++sg; } else if (kk == T) { if (se < need) slot = (int)(cgt + se); ++se; }
            if (slot >= 0) { const int mr = mrbase + slot, r = rbase + idx; rowmap[mr] = r; gate[mr] = __uint_as_float(kk); inv[r * 16 + e] = mr; } }
        if (isctx && b == 0 && tid < 192) { const int mr = e * MOE_ROWS_E + 4160 + tid; rowmap[mr] = 0; gate[mr] = 0.f; }
        BAR_LDS();
    }
}


constexpr int SC_QI = 0, SC_KI = 17408, SC_KT = 34816, SC_VT = 53248, SC_PI = 71680, SC_SM = 80896, SC_PART = 115712, SC_VA = 119808, SC_VB = 120320, SC_VM = 120832, SC_RED = 121344;
constexpr int ST_Q = 272, ST_T = 144;

__device__ __forceinline__ bf16x8 ldfrag(const LAS unsigned char* base, int row, int stride, int kelem) { return *(const LAS bf16x8*)(base + row * stride + kelem * 2); }
#define MFMA16(a, b, c) __builtin_amdgcn_mfma_f32_16x16x32_bf16((a), (b), (c), 0, 0, 0)

struct ScanItem { int is_ret, colq, colk, colv, colg, mixcol; float lg; };

template <bool FULL>
__device__ __forceinline__ void scan_estage(LAS unsigned char* lds, const unsigned (&kraw)[8], const unsigned (&qraw)[8], const unsigned (&vraw)[8], bool is_ret, float lg, int lane, int wave, float& la_out, float& lb_out) {
    const int cp = lane, to = wave;
    float ca[8], cb[8]; float ra = 0.f, rb = 0.f;
#pragma unroll
    for (int tt = 0; tt < 8; ++tt) { const float lfa = is_ret ? lg : bf_lo(kraw[tt]), lfb = is_ret ? lg : bf_hi(kraw[tt]); ra += lfa; rb += lfb; ca[tt] = ra; cb[tt] = rb; }
    *(LAS f32x2*)(lds + SC_PART + (to * 128 + 2 * cp) * 4) = (f32x2){ra, rb};
    BAR_LDS();
    float pa = 0.f, pb = 0.f, ma = 0.f, mb = 0.f, la = 0.f, lb = 0.f;
#pragma unroll
    for (int t8 = 0; t8 < 8; ++t8) { const f32x2 pp = *(const LAS f32x2*)(lds + SC_PART + (t8 * 128 + 2 * cp) * 4);
        if (t8 < to) { pa += pp.x; pb += pp.y; } if (t8 < 4) { ma += pp.x; mb += pp.y; } la += pp.x; lb += pp.y; }
    unsigned kd[8];
#pragma unroll
    for (int tt = 0; tt < 8; ++tt) { const int rr = 8 * to + tt;
        const float cua = pa + ca[tt], cub = pb + cb[tt];
        const float lfa = is_ret ? lg : bf_lo(kraw[tt]), lfb = is_ret ? lg : bf_hi(kraw[tt]);
        const float ka = is_ret ? bf_lo(kraw[tt]) : 1.0f - fast_exp(lfa), kb = is_ret ? bf_hi(kraw[tt]) : 1.0f - fast_exp(lfb);
        kd[tt] = cvt_pk_bf16(ka * fast_exp(ma - cua), kb * fast_exp(mb - cub));
        if (FULL) { const unsigned qd = cvt_pk_bf16(bf_lo(qraw[tt]) * fast_exp(cua - ma), bf_hi(qraw[tt]) * fast_exp(cub - mb));
            *(LAS unsigned*)(lds + SC_QI + rr * ST_Q + cp * 4) = qd; *(LAS unsigned*)(lds + SC_KI + rr * ST_Q + cp * 4) = kd[tt]; } }
    { u32x4 wa, wb;
      wa.x = (kd[0] & 0xffffu) | (kd[1] << 16); wa.y = (kd[2] & 0xffffu) | (kd[3] << 16); wa.z = (kd[4] & 0xffffu) | (kd[5] << 16); wa.w = (kd[6] & 0xffffu) | (kd[7] << 16);
      wb.x = (kd[0] >> 16) | (kd[1] & 0xffff0000u); wb.y = (kd[2] >> 16) | (kd[3] & 0xffff0000u); wb.z = (kd[4] >> 16) | (kd[5] & 0xffff0000u); wb.w = (kd[6] >> 16) | (kd[7] & 0xffff0000u);
      *(LAS u32x4*)(lds + SC_KT + (2 * cp) * ST_T + to * 16) = wa; *(LAS u32x4*)(lds + SC_KT + (2 * cp + 1) * ST_T + to * 16) = wb; }
    { u32x4 wa, wb;
      wa.x = (vraw[0] & 0xffffu) | (vraw[1] << 16); wa.y = (vraw[2] & 0xffffu) | (vraw[3] << 16); wa.z = (vraw[4] & 0xffffu) | (vraw[5] << 16); wa.w = (vraw[6] & 0xffffu) | (vraw[7] << 16);
      wb.x = (vraw[0] >> 16) | (vraw[1] & 0xffff0000u); wb.y = (vraw[2] >> 16) | (vraw[3] & 0xffff0000u); wb.z = (vraw[4] >> 16) | (vraw[5] & 0xffff0000u); wb.w = (vraw[6] >> 16) | (vraw[7] & 0xffff0000u);
      *(LAS u32x4*)(lds + SC_VT + (2 * cp) * ST_T + to * 16) = wa; *(LAS u32x4*)(lds + SC_VT + (2 * cp + 1) * ST_T + to * 16) = wb; }
    if (to == 0) { *(LAS f32x2*)(lds + SC_VA + 8 * cp) = (f32x2){fast_exp(la), fast_exp(lb)}; *(LAS f32x2*)(lds + SC_VB + 8 * cp) = (f32x2){fast_exp(la - ma), fast_exp(lb - mb)};
        *(LAS f32x2*)(lds + SC_VM + 8 * cp) = (f32x2){fast_exp(ma), fast_exp(mb)}; }
    la_out = la; lb_out = lb;
}

__device__ __forceinline__ void scan_state_update(LAS unsigned char* lds, f32x4 (&ST)[8], int wave, int fr, int fq) {
    const bf16x8 a0 = ldfrag(lds + SC_KT, 16 * wave + fr, ST_T, 8 * fq), a1 = ldfrag(lds + SC_KT, 16 * wave + fr, ST_T, 32 + 8 * fq);
    const f32x4 av = *(const LAS f32x4*)(lds + SC_VA + (16 * wave + 4 * fq) * 4), bv = *(const LAS f32x4*)(lds + SC_VB + (16 * wave + 4 * fq) * 4);
#pragma unroll
    for (int vi = 0; vi < 8; ++vi) { const bf16x8 b0 = ldfrag(lds + SC_VT, 16 * vi + fr, ST_T, 8 * fq), b1 = ldfrag(lds + SC_VT, 16 * vi + fr, ST_T, 32 + 8 * fq);
        f32x4 u = {0.f, 0.f, 0.f, 0.f}; u = MFMA16(a0, b0, u); u = MFMA16(a1, b1, u); ST[vi] = av * ST[vi] + bv * u; }
}

#define SCAN_LOAD_CHUNK(crow_, dir_) do { _Pragma("unroll") for (int tt = 0; tt < 8; ++tt) { const int rr_ = 8 * wave + tt; const size_t ro_ = (size_t)((crow_) + ((dir_) ? 63 - rr_ : rr_)) * INW + 2 * lane; \
        kraw[tt] = *(const unsigned*)(P + ro_ + colk); vraw[tt] = *(const unsigned*)(P + ro_ + colv); if (LOADQ) qraw[tt] = *(const unsigned*)(P + ro_ + colq); } } while (0)

__device__ __forceinline__ void scan1_phase(const Ctx& a, int l) {
    PHASE_IDS(); LAS unsigned char* lds = launder_lds(a.lds); unsigned char* ws = a.ws(); const bf16_t* P = (const bf16_t*)(ws + WS_P); bf16_t* UB = (bf16_t*)(ws + WS_UB); float* AB = (float*)(ws + WS_AB);
    const float* rdec = a.in(I_RDEC) + l * 8; const int fr = lane & 15, fq = lane >> 4; constexpr bool LOADQ = false;
    for (int it = blockIdx.x; it < 2048; it += gridDim.x) {
        const int seq = it >> 6, j = it & 63, b = seq >> 4, hh = (seq >> 1) & 7, dir = seq & 1, tb = dir ? (j == 0 ? 0 : 65 - j) : j;
        const bool is_ret = hh >= 4; const int h = hh & 3;
        const int colk = is_ret ? 6 * 512 + h * 128 : (dir ? 2 * 512 : 512) + h * 128, colv = (is_ret ? 7 * 512 : 3 * 512) + h * 128, colq = 0;
        const float lg = is_ret ? -expf(rdec[dir * 4 + h]) : 0.f;
        const int rowbase = b * LTOT + tb * 256;
        f32x4 ST[8];
#pragma unroll
        for (int vi = 0; vi < 8; ++vi) ST[vi] = (f32x4){0.f, 0.f, 0.f, 0.f};
        float ata = 0.f, atb = 0.f; unsigned kraw[8], qraw[8], vraw[8];
#pragma unroll
        for (int tt = 0; tt < 8; ++tt) qraw[tt] = 0u;
        SCAN_LOAD_CHUNK(rowbase + (dir ? 3 : 0) * 64, dir);
#pragma unroll 1
        for (int ci = 0; ci < 4; ++ci) {
            float la, lb; scan_estage<false>(lds, kraw, qraw, vraw, is_ret, lg, lane, wave, la, lb); ata += la; atb += lb;
            if (ci < 3) { const int tc = dir ? 2 - ci : ci + 1; SCAN_LOAD_CHUNK(rowbase + tc * 64, dir); }
            BAR_LDS();
            scan_state_update(lds, ST, wave, fr, fq);
            BAR_LDS();
        }
        const int slot = seq * 65 + tb;
#pragma unroll
        for (int vi = 0; vi < 8; ++vi) { u32x2 w; w.x = cvt_pk_bf16(ST[vi][0], ST[vi][1]); w.y = cvt_pk_bf16(ST[vi][2], ST[vi][3]); *(u32x2*)(UB + (size_t)slot * 16384 + (size_t)(vi * 512 + tid) * 4) = w; }
        if (wave == 0) *(f32x2*)(AB + (size_t)slot * 128 + 2 * lane) = (f32x2){fast_exp(ata), fast_exp(atb)};
    }
}

__device__ __forceinline__ void scan2_phase(const Ctx& a) {
    PHASE_IDS(); unsigned char* ws = a.ws(); const bf16_t* UB = (const bf16_t*)(ws + WS_UB); bf16_t* SB = (bf16_t*)(ws + WS_SB); const float* AB = (const float*)(ws + WS_AB);
    const int c0 = 16 * (tid >> 6) + 4 * ((tid >> 4) & 3);
    for (int p = blockIdx.x; p < 256; p += gridDim.x) { const int seq = p >> 3, vi = p & 7, dir = seq & 1; const size_t eo = (size_t)(vi * 512 + tid) * 4;
        f32x4 s = {0.f, 0.f, 0.f, 0.f};
#pragma unroll 1
        for (int j0 = 0; j0 < 64; j0 += 8) { u32x2 u[8]; f32x4 av[8];
#pragma unroll
            for (int q = 0; q < 8; ++q) { const int j = j0 + q, tb = dir ? (j == 0 ? 0 : 65 - j) : j; const size_t slot = (size_t)seq * 65 + tb; u[q] = *(const u32x2*)(UB + slot * 16384 + eo); av[q] = *(const f32x4*)(AB + slot * 128 + c0); }
#pragma unroll
            for (int q = 0; q < 8; ++q) { const int j = j0 + q, tb = dir ? (j == 0 ? 0 : 65 - j) : j; const size_t slot = (size_t)seq * 65 + tb;
                u32x2 w; w.x = cvt_pk_bf16(s[0], s[1]); w.y = cvt_pk_bf16(s[2], s[3]); *(u32x2*)(SB + slot * 16384 + eo) = w;
                s = av[q] * s + (f32x4){bf_lo(u[q].x), bf_hi(u[q].x), bf_lo(u[q].y), bf_hi(u[q].y)}; } }
        { const int tb = dir ? 1 : 64; const size_t slot = (size_t)seq * 65 + tb; u32x2 w; w.x = cvt_pk_bf16(s[0], s[1]); w.y = cvt_pk_bf16(s[2], s[3]); *(u32x2*)(SB + slot * 16384 + eo) = w; }
    }
}

__device__ __forceinline__ void scan3_phase(const Ctx& a, int l) {
    PHASE_IDS(); LAS unsigned char* lds = launder_lds(a.lds); unsigned char* ws = a.ws(); const bf16_t* P = (const bf16_t*)(ws + WS_P); const bf16_t* SB = (const bf16_t*)(ws + WS_SB); bf16_t* MIX = (bf16_t*)(ws + WS_MIX);
    float* OB = (float*)(ws + WS_OB) + (size_t)blockIdx.x * 32768;
    const float* rdec = a.in(I_RDEC) + l * 8; const float* onorm = a.in(I_ONORM) + l * 128;
    const int fr = lane & 15, fq = lane >> 4, ti = wave & 3, vh = wave >> 2; constexpr bool LOADQ = true;
    const bool last = (l == DEPTH - 1); const int nitems = last ? 1024 : 1040;
    for (int it = blockIdx.x; it < nitems; it += gridDim.x) {
        int bh, tb; if (last) { bh = it >> 6; tb = 1 + (it & 63); } else { bh = it / 65; tb = it - bh * 65; }
        const int b = bh >> 3, hh = bh & 7; const bool is_ret = hh >= 4; const int h = hh & 3;
        const int colq = (is_ret ? 5 * 512 : 0) + h * 128, colv = (is_ret ? 7 * 512 : 3 * 512) + h * 128, colg = (is_ret ? 8 * 512 : 4 * 512) + h * 128, mixcol = hh * 128;
        const int rowbase = b * LTOT + tb * 256;
#pragma unroll 1
        for (int dir = 1; dir >= 0; --dir) {
            const int colk = is_ret ? 6 * 512 + h * 128 : (dir ? 2 * 512 : 512) + h * 128;
            const float lg = is_ret ? -expf(rdec[dir * 4 + h]) : 0.f;
            f32x4 ST[8];
            if (tb == 0) {
#pragma unroll
                for (int vi = 0; vi < 8; ++vi) ST[vi] = (f32x4){0.f, 0.f, 0.f, 0.f};
            } else { const size_t slot = (size_t)(bh * 2 + dir) * 65 + tb;
#pragma unroll
                for (int vi = 0; vi < 8; ++vi) { const u32x2 w = *(const u32x2*)(SB + slot * 16384 + (size_t)(vi * 512 + tid) * 4); ST[vi] = (f32x4){bf_lo(w.x), bf_hi(w.x), bf_lo(w.y), bf_hi(w.y)}; } }
            unsigned kraw[8], qraw[8], vraw[8];
            SCAN_LOAD_CHUNK(rowbase + (dir ? 3 : 0) * 64, dir);
#pragma unroll 1
            for (int ci = 0; ci < 4; ++ci) {
                const int tc = dir ? 3 - ci : ci, crow = rowbase + tc * 64;
                float la, lb; scan_estage<true>(lds, kraw, qraw, vraw, is_ret, lg, lane, wave, la, lb);
                if (ci < 3) { const int tcn = dir ? 2 - ci : ci + 1; SCAN_LOAD_CHUNK(rowbase + tcn * 64, dir); }
                const int t = 16 * ti + fr, tok = tc * 64 + (dir ? 63 - t : t), grow = rowbase + tok;
                BAR_LDS();
                { const f32x4 em = *(const LAS f32x4*)(lds + SC_VM + (16 * wave + 4 * fq) * 4);
#pragma unroll
                  for (int vi = 0; vi < 8; ++vi) { const f32x4 x = ST[vi] * em; u32x2 w; w.x = cvt_pk_bf16(x[0], x[1]); w.y = cvt_pk_bf16(x[2], x[3]); *(LAS u32x2*)(lds + SC_SM + (16 * vi + fr) * ST_Q + (16 * wave + 4 * fq) * 2) = w; } }
#pragma unroll
                for (int sii = 0; sii < 2; ++sii) { const int si = 2 * vh + sii; f32x4 sc = {0.f, 0.f, 0.f, 0.f};
                    if (si <= ti) {
#pragma unroll
                        for (int ks = 0; ks < 4; ++ks) sc = MFMA16(ldfrag(lds + SC_KI, 16 * si + fr, ST_Q, 32 * ks + 8 * fq), ldfrag(lds + SC_QI, 16 * ti + fr, ST_Q, 32 * ks + 8 * fq), sc);
                        const int s0 = 16 * si + 4 * fq;
#pragma unroll
                        for (int r = 0; r < 4; ++r) sc[r] = (s0 + r <= t) ? sc[r] : 0.f; }
                    u32x2 w; w.x = cvt_pk_bf16(sc[0], sc[1]); w.y = cvt_pk_bf16(sc[2], sc[3]); *(LAS u32x2*)(lds + SC_PI + t * ST_T + (16 * si + 4 * fq) * 2) = w; }
                BAR_LDS();
                f32x4 obv[4]; u32x2 gv[4];
                if (dir == 0) {
#pragma unroll
                    for (int j = 0; j < 4; ++j) { obv[j] = *(const f32x4*)(OB + tok * 128 + 16 * (4 * vh + j) + 4 * fq); gv[j] = *(const u32x2*)(P + (size_t)grow * INW + colg + 16 * (4 * vh + j) + 4 * fq); } }
                f32x4 o[4];
#pragma unroll
                for (int j = 0; j < 4; ++j) o[j] = (f32x4){0.f, 0.f, 0.f, 0.f};
#pragma unroll
                for (int ks = 0; ks < 2; ++ks) { const bf16x8 bf = ldfrag(lds + SC_PI, 16 * ti + fr, ST_T, 32 * ks + 8 * fq);
#pragma unroll
                    for (int j = 0; j < 4; ++j) o[j] = MFMA16(ldfrag(lds + SC_VT, 16 * (4 * vh + j) + fr, ST_T, 32 * ks + 8 * fq), bf, o[j]); }
#pragma unroll
                for (int ks = 0; ks < 4; ++ks) { const bf16x8 bf = ldfrag(lds + SC_QI, 16 * ti + fr, ST_Q, 32 * ks + 8 * fq);
#pragma unroll
                    for (int j = 0; j < 4; ++j) o[j] = MFMA16(ldfrag(lds + SC_SM, 16 * (4 * vh + j) + fr, ST_Q, 32 * ks + 8 * fq), bf, o[j]); }
                scan_state_update(lds, ST, wave, fr, fq);
                if (dir == 1) {
#pragma unroll
                    for (int j = 0; j < 4; ++j) *(f32x4*)(OB + tok * 128 + 16 * (4 * vh + j) + 4 * fq) = o[j];
                    BAR_LDS();
                } else {
                    float ss = 0.f;
#pragma unroll
                    for (int j = 0; j < 4; ++j) { o[j] += obv[j]; ss += (o[j][0] * o[j][0] + o[j][1] * o[j][1]) + (o[j][2] * o[j][2] + o[j][3] * o[j][3]); }
                    ss += __shfl_xor(ss, 16); ss += __shfl_xor(ss, 32);
                    if (fq == 0) *(LAS float*)(lds + SC_RED + (vh * 64 + t) * 4) = ss;
                    BAR_LDS();
                    const float tot = ss + *(const LAS float*)(lds + SC_RED + ((vh ^ 1) * 64 + t) * 4);
                    const float rinv = __builtin_amdgcn_rsqf(tot * (1.0f / 128.0f) + EPS);
#pragma unroll
                    for (int j = 0; j < 4; ++j) { const f32x4 onv = is_ret ? (f32x4){1.f, 1.f, 1.f, 1.f} : *(const f32x4*)(onorm + 16 * (4 * vh + j) + 4 * fq);
                        const f32x4 y = o[j] * rinv * onv * (f32x4){bf_lo(gv[j].x), bf_hi(gv[j].x), bf_lo(gv[j].y), bf_hi(gv[j].y)};
                        u32x2 w; w.x = cvt_pk_bf16(y[0], y[1]); w.y = cvt_pk_bf16(y[2], y[3]); *(u32x2*)(MIX + (size_t)grow * D + mixcol + 16 * (4 * vh + j) + 4 * fq) = w; }
                    BAR_LDS();
                }
            }
            BAR_ALL();
        }
    }
}

struct OutOrder {
    int nrt, skipctx, G, c;
    __device__ __forceinline__ bool next(int i, pg8::Unit& u) const {
        const int L = i * G + c; if (L >= nrt * 4) return false;
        const int r = L >> 2; u.pn = L & 3; u.pm = skipctx ? r + 1 + (r >= 64 ? 1 : 0) : r; return true;
    }
    __device__ __forceinline__ void a_ready(const pg8::Unit&) const {}
    __device__ __forceinline__ void done(const pg8::Unit&) const {}
};

#ifndef PH
#define PH 0xffff
#endif
#ifndef DBL
#define DBL 0
#endif
__global__ void __launch_bounds__(512, 2) mega_fwd(Args a) {
    extern __shared__ __attribute__((aligned(16))) unsigned char lds_raw[];
    LAS unsigned char* lds = (LAS unsigned char*)lds_raw;
    const int tid = threadIdx.x;
    const int G = gridDim.x; const int bx = blockIdx.x; const int vcu = (G % 8 == 0) ? (bx % 8) * (G / 8) + bx / 8 : bx;
    volatile LAS unsigned* MISC = (volatile LAS unsigned*)(lds + MISC_OFF);
    if (tid < 16) MISC[tid] = 0u;
    if (tid == 0) { LAS unsigned long long* pt = (LAS unsigned long long*)(lds + PTR_OFF);
#pragma unroll
        for (int i = 0; i < 18; ++i) pt[i] = (unsigned long long)a.in[i];
        pt[18] = (unsigned long long)a.out; pt[19] = (unsigned long long)a.ws; }
    __syncthreads();
    const Ctx cx{lds};
    XcdBarrier bar = xcd_barrier_post((unsigned*)(cx.ws() + WS_CTL) + 1024, MISC + 8);
#define GRID_BAR() do { XcdBarrier b2_ = bar; asm volatile("" : "+s"(b2_.x)); xcd_barrier(b2_); } while (0)

#if PH & 1
    p0_prologue(cx);
#endif
    GRID_BAR();
#if DBL & 1
    p0_prologue(cx);
    GRID_BAR();
#endif
#if PH & 1
    p0_finalize(cx);
#endif
    GRID_BAR();

#pragma unroll 1
    for (int l = 0; l < DEPTH; ++l) {
        const bool last = (l == DEPTH - 1); unsigned char* ws = cx.ws();
#if PH & 2
        norm1_phase<0>(cx, l);
#endif
        GRID_BAR();
#if PH & 4
        {
            pg8::Gemm g{(const bf16_t*)(ws + WS_H), (const bf16_t*)(ws + WS_WIN) + (size_t)l * INW * D, MROWS, INW, D};
            pg8::StaticOrder S; S.init(MROWS, INW, G, bx);
            pg8::EpiIn E{(bf16_t*)(ws + WS_P), (const float*)(ws + WS_LBS) + l * 512, (const float*)(ws + WS_ROPE)};
            pg8::gemm_phase<pg8::EpiIn, pg8::StaticOrder, true, true>(launder_lds(lds), g, S, E);
        }
#endif
        GRID_BAR();
#if PH & 8
        scan1_phase(cx, l);
#endif
        GRID_BAR();
#if PH & 16
        scan2_phase(cx);
#endif
        GRID_BAR();
#if PH & 32
        scan3_phase(cx, l);
#endif
        GRID_BAR();
#if DBL & 2
        scan1_phase(cx, l);
        GRID_BAR();
        scan2_phase(cx);
        GRID_BAR();
        scan3_phase(cx, l);
        GRID_BAR();
#endif
#if PH & 64
        {
            pg8::Gemm g{(const bf16_t*)(ws + WS_MIX), (const bf16_t*)(ws + WS_WOUT) + (size_t)l * D * D, MROWS, D, D};
            OutOrder S{last ? 128 : 130, last ? 1 : 0, G, vcu};
            pg8::EpiOut E{(float*)(ws + WS_X), l == 0 ? cx.in(I_X) : nullptr, l == 0 ? cx.in(I_CTX) : nullptr, (const float*)(ws + WS_MODS) + (size_t)(l * 3) * 6144 + 2 * D};
            pg8::gemm_phase<pg8::EpiOut, OutOrder, true, true>(launder_lds(lds), g, S, E);
        }
#endif
        GRID_BAR();
#if PH & 128
        norm2_phase(cx, l);
#endif
        GRID_BAR();
#if PH & 256
        topk_phase(cx, l);
#endif
        GRID_BAR();
#if PH & 1024
        {
            pg8::Gemm g{(const bf16_t*)(ws + WS_H), (const bf16_t*)(ws + WS_WGU + (size_t)l * 65536 * D), MOE_ROWS, 65536, D};
            pg8::MoeOrder S{last ? 16 : 17, 16, G, vcu};
            pg8::EpiGU E{(unsigned char*)(ws + WS_HID)};
            pg8::gemm_phase_f8<pg8::EpiGU, pg8::MoeOrder, true>(launder_lds(lds), g, S, E, (const int*)(ws + WS_ROWMAP));
        }
#endif
        GRID_BAR();
#if PH & 2048
        {
            pg8::Gemm g{(const bf16_t*)(ws + WS_HID), (const bf16_t*)(ws + WS_WD + (size_t)l * 16384 * FF), MOE_ROWS, 16384, FF};
            pg8::MoeOrder S{last ? 16 : 17, 4, G, vcu};
            pg8::EpiDown E{(bf16_t*)(ws + WS_YS)};
            pg8::gemm_phase_f8<pg8::EpiDown, pg8::MoeOrder, false>(launder_lds(lds), g, S, E, nullptr);
        }
#endif
        GRID_BAR();
    }
#if PH & 4096
    norm1_phase<1>(cx, DEPTH);
#endif
}

extern "C" void kernel_launch(void* const* d_in, const int* in_sizes, int n_in, void* d_out, int out_size, void* d_ws, size_t ws_size, hipStream_t stream) {
    static int grid = 0;
    if (grid == 0) {
        if (n_in != 18 || out_size != NB * SEQ * D || ws_size < WS_END) { fprintf(stderr, "kernel_launch: unexpected problem shape (n_in %d, out %d, ws %zu)\n", n_in, out_size, ws_size); grid = -1; return; }
        int dev = 0, cus = 0, per_cu = 0;
        if (hipGetDevice(&dev) != hipSuccess || hipDeviceGetAttribute(&cus, hipDeviceAttributeMultiprocessorCount, dev) != hipSuccess) { grid = -1; return; }
        if (hipFuncSetAttribute((const void*)mega_fwd, hipFuncAttributeMaxDynamicSharedMemorySize, LDS_BYTES) != hipSuccess) { fprintf(stderr, "kernel_launch: hipFuncSetAttribute failed\n"); grid = -1; return; }
        if (hipOccupancyMaxActiveBlocksPerMultiprocessor(&per_cu, (const void*)mega_fwd, 512, LDS_BYTES) != hipSuccess || per_cu < 1) { fprintf(stderr, "kernel_launch: occupancy query reports %d workgroups per CU\n", per_cu); per_cu = 1; }
        (void)hipGetLastError();
        grid = cus;
    }
    if (grid < 0) return;
    (void)in_sizes;
    if (hipMemsetAsync((char*)d_ws + WS_CTL, 0, CTL_ZERO_BYTES, stream) != hipSuccess) return;
    Args a{};
    for (int i = 0; i < 18; ++i) a.in[i] = (const float*)d_in[i];
    a.out = (float*)d_out; a.ws = (unsigned char*)d_ws;
    hipLaunchKernelGGL(mega_fwd, dim3(grid), dim3(512), LDS_BYTES, stream, a);
}
```

```cpp
#include <hip/hip_runtime.h>
#include <cstdio>
#include <cstdint>

constexpr int D = 1024, NB = 2, SEQ = 16384, CTX = 256, LTOT = SEQ + CTX, MROWS = NB * LTOT;
constexpr int DEPTH = 4, INW = 4608, NE = 16, FF = 2048;
constexpr int CAP_LAT = 2048, CAP_CTX = 32;
constexpr int MOE_ROWS_E = 4352, MOE_ROWS = NE * MOE_ROWS_E;
constexpr int NSLOT = NB * 8 * 2 * 65;
constexpr float EPS = 1e-6f;

constexpr size_t MiB = 1u << 20;
constexpr size_t WS_CTL = 0, CTL_ZERO_BYTES = 64 * 1024;
constexpr size_t WS_MODP = 1 * MiB;
constexpr size_t WS_MODS = 4 * MiB;
constexpr size_t WS_LBS = 5 * MiB;
constexpr size_t WS_ROPE = 5 * MiB + 65536;
constexpr size_t WS_WIN = 8 * MiB;
constexpr size_t WS_WOUT = 44 * MiB;
constexpr size_t WS_WGU = 52 * MiB;
constexpr size_t WS_WD = 564 * MiB;
constexpr size_t WS_X = 820 * MiB;
constexpr size_t WS_H = 950 * MiB;
constexpr size_t WS_MIX = 1015 * MiB;
constexpr size_t WS_P = 1080 * MiB;
constexpr size_t WS_XS = 1080 * MiB;
constexpr size_t WS_HID = 1216 * MiB;
constexpr size_t WS_YS = 1488 * MiB;
constexpr size_t WS_UB = 1624 * MiB;
constexpr size_t WS_SB = 1689 * MiB;
constexpr size_t WS_AB = 1754 * MiB;
constexpr size_t WS_OB = 1756 * MiB;
constexpr size_t WS_AFF = 1788 * MiB;
constexpr size_t WS_ROWMAP = 1791 * MiB;
constexpr size_t WS_INV = 1792 * MiB;
constexpr size_t WS_END = 1800 * MiB;

constexpr int LDS_BYTES = 155648;
constexpr int MISC_OFF = LDS_BYTES - 64;
constexpr int PTR_OFF = LDS_BYTES - 256;

#define GAS __attribute__((address_space(1)))
#define LAS __attribute__((address_space(3)))
typedef float f32x2 __attribute__((ext_vector_type(2)));
typedef unsigned u32x2 __attribute__((ext_vector_type(2)));

__device__ __forceinline__ int lane_id() { return (int)__builtin_amdgcn_mbcnt_hi(~0u, __builtin_amdgcn_mbcnt_lo(~0u, 0u)); }
__device__ __forceinline__ int opaque_tid(int w0) { (void)w0; int t = threadIdx.x; asm volatile("" : "+v"(t)); return t; }
__device__ __forceinline__ LAS unsigned char* launder_lds(LAS unsigned char* p) { unsigned v = (unsigned)(size_t)p; asm volatile("" : "+s"(v)); return (LAS unsigned char*)(size_t)v; }
__device__ __forceinline__ const float* ldptr(LAS unsigned char* lds0, int i) {
    LAS unsigned char* lds = launder_lds(lds0);
    const u32x2 v = *(volatile LAS u32x2*)(lds + PTR_OFF + 8 * i);
    const unsigned lo = __builtin_amdgcn_readfirstlane(v.x), hi = __builtin_amdgcn_readfirstlane(v.y);
    return (const float*)(((unsigned long long)hi << 32) | lo);
}
namespace pg8 {
#define PG8_LAS __attribute__((address_space(3)))
typedef unsigned short bf16_t;
typedef short bf16x8 __attribute__((ext_vector_type(8)));
typedef float f32x4 __attribute__((ext_vector_type(4)));
typedef unsigned u32x4 __attribute__((ext_vector_type(4)));
constexpr int BM = 256, BK = 64, HALF = 128, HTB = HALF * BK * 2  , STAGE_BYTES = 8 * HTB, NXCD = 8, WGM = 8;

__host__ __device__ __forceinline__ int lds_byte(int r, int c) { const int st = (r >> 4) * 2 + (c >> 5), rr = r & 15, cc = c & 31, ob = rr * 64 + cc * 2; return st * 1024 + (ob ^ (((ob >> 9) & 1) << 5)); }
__host__ __device__ __forceinline__ void stage_rc(int b, int& R, int& C) { const int st = b / 1024, sb = b % 1024, swz = sb ^ (((sb >> 9) & 1) << 5); R = (st >> 1) * 16 + swz / 64; C = (st & 1) * 32 + (swz % 64) / 2; }
__host__ __device__ __forceinline__ int perm32(int rho) { const int n = rho >> 4, i = rho & 15; return 8 * (i >> 2) + 4 * n + (i & 3); }

struct Unit { int pm, pn; };
struct Gemm { const bf16_t* A; const bf16_t* Bt; int M, N, K, w0; };

struct StaticOrder {
    int nM, nN, nwg, G, c;
    __host__ __device__ void init(int M, int N, int G_, int c_) { nM = M / BM; nN = N / BM; nwg = nM * nN; G = G_; c = c_; }
    __host__ __device__ bool next(int i, Unit& u) const {
        const long L = (long)i * G + c; if (L >= nwg) return false;
        int wgid = (int)L; { const int q = nwg / NXCD, r = nwg % NXCD, xcd = wgid % NXCD, off = wgid / NXCD; wgid = (xcd < r ? xcd * (q + 1) : r * (q + 1) + (xcd - r) * q) + off; }
        const int nig = WGM * nN, gid = wgid / nig, fm = gid * WGM, gsz = (nM - fm) < WGM ? (nM - fm) : WGM;
        u.pm = fm + ((wgid % nig) % gsz); u.pn = (wgid % nig) / gsz; return true;
    }
    __device__ __forceinline__ void a_ready(const Unit&) const {}
    __device__ __forceinline__ void done(const Unit&) const {}
};
__device__ __forceinline__ unsigned cvt_pk_bf16(float lo, float hi) { unsigned r; asm volatile("v_cvt_pk_bf16_f32 %0, %1, %2" : "=v"(r) : "v"(lo), "v"(hi)); return r; }

struct MoeOrder {
    int NT, NC, G, c;
    __device__ __forceinline__ bool next(int i, Unit& u) const {
        const int L = i * G + c, per = NT * NC; if (L >= 16 * per) return false;
        const int e = L / per, q = L - e * per; u.pm = e * 17 + q / NC; u.pn = e * NC + q % NC; return true;
    }
    __device__ __forceinline__ void a_ready(const Unit&) const {}
    __device__ __forceinline__ void done(const Unit&) const {}
};

__device__ __forceinline__ float fast_exp(float x) { return __builtin_amdgcn_exp2f(x * 1.4426950408889634f); }
__device__ __forceinline__ float fast_sigmoid(float x) { return __builtin_amdgcn_rcpf(1.0f + fast_exp(-x)); }

struct EpiIn {
    static constexpr bool PERM = true, AFTER_DRAIN = false;
    bf16_t* P; const float* lb; const float* cs;
    __device__ __forceinline__ void operator()(const f32x4 (&acc)[2][2][4][2], const Unit& u, int wr, int wc, int fr, int fq) const {
        const int grp = u.pn >> 1;
        const int row0 = u.pm * BM + wr * 64 + fr, col0 = u.pn * BM + wc * 32 + 8 * fq;
        if (grp == 0 || grp == 3 || grp == 7) {
#pragma unroll
            for (int ai = 0; ai < 2; ++ai)
#pragma unroll
                for (int m = 0; m < 4; ++m) { bf16_t* rowp = P + (size_t)(row0 + ai * HALF + m * 16) * INW + col0;
#pragma unroll
                    for (int bj = 0; bj < 2; ++bj) { const f32x4 v0 = acc[ai][bj][m][0], v1 = acc[ai][bj][m][1];
                        u32x4 w; w.x = cvt_pk_bf16(v0[0], v0[1]); w.y = cvt_pk_bf16(v0[2], v0[3]); w.z = cvt_pk_bf16(v1[0], v1[1]); w.w = cvt_pk_bf16(v1[2], v1[3]);
                        *(u32x4*)(rowp + bj * HALF) = w; } }
        } else if (grp == 1 || grp == 2) {
            const int cg = col0 - grp * 512;
            f32x4 lbv[2][2];
#pragma unroll
            for (int bj = 0; bj < 2; ++bj)
#pragma unroll
                for (int n = 0; n < 2; ++n) lbv[bj][n] = *(const f32x4*)(lb + cg + bj * HALF + 4 * n);
#pragma unroll
            for (int ai = 0; ai < 2; ++ai)
#pragma unroll
                for (int m = 0; m < 4; ++m) { bf16_t* rowp = P + (size_t)(row0 + ai * HALF + m * 16) * INW + col0;
#pragma unroll
                    for (int bj = 0; bj < 2; ++bj) { f32x4 v[2];
#pragma unroll
                        for (int n = 0; n < 2; ++n)
#pragma unroll
                            for (int j = 0; j < 4; ++j) { const float l0 = lbv[bj][n][j]; const float f = l0 + (1.0f - l0) * fast_sigmoid(acc[ai][bj][m][n][j]);
                                #ifndef SCAN_LOG2
                                v[n][j] = __builtin_amdgcn_logf(fmaxf(f, 1e-30f)) * 0.6931471805599453f; }
#else
                                v[n][j] = __builtin_amdgcn_logf(fmaxf(f, 1e-30f)); }
#endif
                        u32x4 w; w.x = cvt_pk_bf16(v[0][0], v[0][1]); w.y = cvt_pk_bf16(v[0][2], v[0][3]); w.z = cvt_pk_bf16(v[1][0], v[1][1]); w.w = cvt_pk_bf16(v[1][2], v[1][3]);
                        *(u32x4*)(rowp + bj * HALF) = w; } }
        } else if (grp == 4 || grp == 8) {
#pragma unroll
            for (int ai = 0; ai < 2; ++ai)
#pragma unroll
                for (int m = 0; m < 4; ++m) { bf16_t* rowp = P + (size_t)(row0 + ai * HALF + m * 16) * INW + col0;
#pragma unroll
                    for (int bj = 0; bj < 2; ++bj) { f32x4 v[2];
#pragma unroll
                        for (int n = 0; n < 2; ++n)
#pragma unroll
                            for (int j = 0; j < 4; ++j) { const float z = acc[ai][bj][m][n][j]; v[n][j] = z * fast_sigmoid(z); }
                        u32x4 w; w.x = cvt_pk_bf16(v[0][0], v[0][1]); w.y = cvt_pk_bf16(v[0][2], v[0][3]); w.z = cvt_pk_bf16(v[1][0], v[1][1]); w.w = cvt_pk_bf16(v[1][2], v[1][3]);
                        *(u32x4*)(rowp + bj * HALF) = w; } }
        } else {
            const float sc = (grp == 6) ? 0.08838834764831845f : 1.0f;
            const int f0 = 16 * (wc & 1) + 4 * fq;
#pragma unroll
            for (int ai = 0; ai < 2; ++ai)
#pragma unroll
                for (int m = 0; m < 4; ++m) { const int row = row0 + ai * HALF + m * 16; bf16_t* rowp = P + (size_t)row * INW + col0;
                    int g = row; if (g >= LTOT) g -= LTOT;
                    int pos = 0; if (g >= CTX) { const int nn = g - CTX; pos = (wc < 2) ? (nn >> 6) : (nn & 63); }
                    const f32x4 t0 = *(const f32x4*)(cs + (size_t)(pos * 32 + f0) * 2), t1 = *(const f32x4*)(cs + (size_t)(pos * 32 + f0) * 2 + 4);
#pragma unroll
                    for (int bj = 0; bj < 2; ++bj) { const f32x4 v0 = acc[ai][bj][m][0] * sc, v1 = acc[ai][bj][m][1] * sc;
                        const float a0 = v0[0] * t0[0] - v0[1] * t0[1], a1 = v0[0] * t0[1] + v0[1] * t0[0];
                        const float a2 = v0[2] * t0[2] - v0[3] * t0[3], a3 = v0[2] * t0[3] + v0[3] * t0[2];
                        const float b0 = v1[0] * t1[0] - v1[1] * t1[1], b1 = v1[0] * t1[1] + v1[1] * t1[0];
                        const float b2 = v1[2] * t1[2] - v1[3] * t1[3], b3 = v1[2] * t1[3] + v1[3] * t1[2];
                        u32x4 w; w.x = cvt_pk_bf16(a0, a1); w.y = cvt_pk_bf16(a2, a3); w.z = cvt_pk_bf16(b0, b1); w.w = cvt_pk_bf16(b2, b3);
                        *(u32x4*)(rowp + bj * HALF) = w; } }
        }
    }
};

struct EpiOut {
    static constexpr bool PERM = false, AFTER_DRAIN = false;
    float* X; const float* xin; const float* cin; const float* gt;
    __device__ __forceinline__ void operator()(const f32x4 (&acc)[2][2][4][2], const Unit& u, int wr, int wc, int fr, int fq) const {
        const int b = u.pm / 65, tb = u.pm - b * 65, which = (tb == 0) ? 2 : b;
        const int row0 = u.pm * BM + wr * 64 + fr, col0 = u.pn * BM + wc * 32 + 4 * fq;
        f32x4 gv[2][2];
#pragma unroll
        for (int bj = 0; bj < 2; ++bj)
#pragma unroll
            for (int n = 0; n < 2; ++n) gv[bj][n] = *(const f32x4*)(gt + which * 6144 + col0 + bj * HALF + n * 16);
#pragma unroll
        for (int ai = 0; ai < 2; ++ai)
#pragma unroll
            for (int m = 0; m < 4; ++m) { const int row = row0 + ai * HALF + m * 16; float* op = X + (size_t)row * D + col0;
                const float* bp = op;
                if (xin) { const int g = row - b * LTOT; bp = (g < CTX ? cin + (size_t)(b * CTX + g) * D : xin + (size_t)(b * SEQ + g - CTX) * D) + col0; }
#pragma unroll
                for (int bj = 0; bj < 2; ++bj)
#pragma unroll
                    for (int n = 0; n < 2; ++n) { const f32x4 bs = *(const f32x4*)(bp + bj * HALF + n * 16); *(f32x4*)(op + bj * HALF + n * 16) = bs + gv[bj][n] * acc[ai][bj][m][n]; } }
    }
};

constexpr float F8_SA = 8.0f, F8_SW = 64.0f, F8_SH = 4.0f;
__device__ __forceinline__ unsigned pk4_fp8(float a, float b, float c, float d) {
    a = __builtin_amdgcn_fmed3f(a, -448.f, 448.f); b = __builtin_amdgcn_fmed3f(b, -448.f, 448.f); c = __builtin_amdgcn_fmed3f(c, -448.f, 448.f); d = __builtin_amdgcn_fmed3f(d, -448.f, 448.f);
    unsigned w = 0; w = __builtin_amdgcn_cvt_pk_fp8_f32(a, b, w, false); w = __builtin_amdgcn_cvt_pk_fp8_f32(c, d, w, true); return w; }
struct EpiGU {
    static constexpr bool PERM = true, AFTER_DRAIN = false;
    unsigned char* HID;
    __device__ __forceinline__ void operator()(const f32x4 (&acc)[2][2][4][2], const Unit& u, int wr, int wc, int fr, int fq) const {
        const int row0 = u.pm * BM + wr * 64 + fr, col0 = (u.pn & 15) * HALF + wc * 32 + 8 * fq;
        constexpr float inv = 1.0f / (F8_SA * F8_SW);
#pragma unroll
        for (int ai = 0; ai < 2; ++ai)
#pragma unroll
            for (int m = 0; m < 4; ++m) { unsigned char* rowp = HID + (size_t)(row0 + ai * HALF + m * 16) * FF + col0; f32x4 v[2];
#pragma unroll
                for (int n = 0; n < 2; ++n)
#pragma unroll
                    for (int j = 0; j < 4; ++j) { const float g = acc[ai][0][m][n][j] * inv; v[n][j] = g * fast_sigmoid(g) * (acc[ai][1][m][n][j] * (inv * F8_SH)); }
                u32x2 w; w.x = pk4_fp8(v[0][0], v[0][1], v[0][2], v[0][3]); w.y = pk4_fp8(v[1][0], v[1][1], v[1][2], v[1][3]);
                *(u32x2*)rowp = w; }
    }
};

struct EpiDown {
    static constexpr bool PERM = true, AFTER_DRAIN = false;
    bf16_t* YS;
    __device__ __forceinline__ void operator()(const f32x4 (&acc)[2][2][4][2], const Unit& u, int wr, int wc, int fr, int fq) const {
        const int row0 = u.pm * BM + wr * 64 + fr, col0 = (u.pn & 3) * BM + wc * 32 + 8 * fq;
        constexpr float gg = 1.0f / (F8_SH * F8_SW);
#pragma unroll
        for (int ai = 0; ai < 2; ++ai)
#pragma unroll
            for (int m = 0; m < 4; ++m) { bf16_t* rowp = YS + (size_t)(row0 + ai * HALF + m * 16) * D + col0;
#pragma unroll
                for (int bj = 0; bj < 2; ++bj) { const f32x4 v0 = acc[ai][bj][m][0] * gg, v1 = acc[ai][bj][m][1] * gg;
                    u32x4 w; w.x = cvt_pk_bf16(v0[0], v0[1]); w.y = cvt_pk_bf16(v0[2], v0[3]); w.z = cvt_pk_bf16(v1[0], v1[1]); w.w = cvt_pk_bf16(v1[2], v1[3]);
                    *(u32x4*)(rowp + bj * HALF) = w; } }
    }
};

typedef int i32x4v __attribute__((ext_vector_type(4)));
typedef int i32x8v __attribute__((ext_vector_type(8)));
__device__ __forceinline__ i32x8v cat8(bf16x8 lo, bf16x8 hi) { const i32x4v a = __builtin_bit_cast(i32x4v, lo), b = __builtin_bit_cast(i32x4v, hi); return __builtin_shufflevector(a, b, 0, 1, 2, 3, 4, 5, 6, 7); }
template <class Epi, class Sched, bool GATHER>
__device__ __forceinline__ void gemm_phase_f8(PG8_LAS unsigned char* lds, const Gemm g, const Sched& S, const Epi& E, const int* rowmap) {
    const int tid = opaque_tid(g.w0), wid = __builtin_amdgcn_readfirstlane(tid >> 6), lane = tid & 63, wr = wid >> 2, wc = wid & 3, fr = lane & 15, fq = lane >> 4;
    const int rowb = g.K, nt = rowb / 128;
    unsigned vA0[2], vA1[2], voffB[2];
#pragma unroll
    for (int i = 0; i < 2; ++i) { int R, C; stage_rc(tid * 16 + i * 8192, R, C); const int Rb = Epi::PERM ? ((R & ~31) + perm32(R & 31)) : R;
        voffB[i] = (unsigned)(Rb * rowb + 2 * C); vA0[i] = (unsigned)(R * rowb + 2 * C); vA1[i] = vA0[i]; }
    const size_t kstep = 128;
    const size_t hstep = (size_t)HALF * rowb;
    const size_t tstep = 2 * hstep;
    const unsigned ldsw = (unsigned)wid * 1024u;
    const int aoff = lds_byte(wr * 64 + fr, fq * 8), boff = lds_byte(wc * 32 + fr, fq * 8);
    constexpr int GOFF = STAGE_BYTES;
#define PG8_SA(b, h) (((b) * 2 + (h)) * HTB)
#define PG8_SB(b, h) ((4 + (b) * 2 + (h)) * HTB)
#define PG8_STAGE(bufoff, gbase, voff) do { _Pragma("unroll") for (int _i = 0; _i < 2; ++_i) { unsigned _o = (voff)[_i]; asm volatile("" : "+v"(_o)); \
        __builtin_amdgcn_global_load_lds((const unsigned*)((const char*)(gbase) + _o), (PG8_LAS unsigned*)(lds + (bufoff) + ldsw + _i * 8192), 16, 0, 0); } } while (0)
#define PG8_STAGE_A(bufoff, kbase, h) do { if constexpr (GATHER) { if (h) PG8_STAGE(bufoff, kbase, vA1); else PG8_STAGE(bufoff, kbase, vA0); } else PG8_STAGE(bufoff, (kbase) + (h) * hstep, vA0); } while (0)
#define PG8_GIDX_ISSUE(pm_) do { const int _t = opaque_tid(g.w0); _Pragma("unroll") for (int _i = 0; _i < 2; ++_i) { int R, C; stage_rc(_t * 16 + _i * 8192, R, C); _Pragma("unroll") for (int _h = 0; _h < 2; ++_h) \
        __builtin_amdgcn_global_load_lds((const unsigned*)(rowmap + (pm_) * BM + _h * HALF + R), (PG8_LAS unsigned*)(lds + GOFF + ldsw + (_h * 2 + _i) * 256), 4, 0, 0); } } while (0)
#define PG8_GIDX_TAKE() do { const int _t = opaque_tid(g.w0); _Pragma("unroll") for (int _i = 0; _i < 2; ++_i) { int R, C; stage_rc(_t * 16 + _i * 8192, R, C); \
        vA0[_i] = *(const PG8_LAS unsigned*)(lds + GOFF + ldsw + (0 * 2 + _i) * 256 + (_t & 63) * 4) * (unsigned)rowb + (unsigned)(2 * C); \
        vA1[_i] = *(const PG8_LAS unsigned*)(lds + GOFF + ldsw + (1 * 2 + _i) * 256 + (_t & 63) * 4) * (unsigned)rowb + (unsigned)(2 * C); } } while (0)
#define PG8_LDA(dst, b, h) do { _Pragma("unroll") for (int m = 0; m < 4; ++m) _Pragma("unroll") for (int k = 0; k < 2; ++k) dst[m][k] = *(const PG8_LAS bf16x8*)(lds + PG8_SA(b, h) + aoff + m * 2048 + k * 1024); } while (0)
#define PG8_LDB(dst, b, h) do { _Pragma("unroll") for (int n = 0; n < 2; ++n) _Pragma("unroll") for (int k = 0; k < 2; ++k) dst[n][k] = *(const PG8_LAS bf16x8*)(lds + PG8_SB(b, h) + boff + n * 2048 + k * 1024); } while (0)
#define PG8_MMA(ai, bj, At, Bt) do { __builtin_amdgcn_s_setprio(1); _Pragma("unroll") for (int m = 0; m < 4; ++m) _Pragma("unroll") for (int n = 0; n < 2; ++n) \
        acc[ai][bj][m][n] = __builtin_amdgcn_mfma_scale_f32_16x16x128_f8f6f4(cat8(Bt[n][0], Bt[n][1]), cat8(At[m][0], At[m][1]), acc[ai][bj][m][n], 0, 0, 0, 0x7f7f7f7f, 0, 0x7f7f7f7f); __builtin_amdgcn_s_setprio(0); } while (0)
#define PG8_WAIT_V(n) asm volatile("s_waitcnt vmcnt(" #n ")" ::: "memory")
#define PG8_WAIT_L(n) asm volatile("s_waitcnt lgkmcnt(" #n ")" ::: "memory")
#define PG8_BAR __builtin_amdgcn_s_barrier()
#define PG8_SCHED __builtin_amdgcn_sched_barrier(0)
    Unit cur, nxt; int ui = 0;
    if (!S.next(0, cur)) return;
    f32x4 acc[2][2][4][2];
#pragma unroll
    for (int a = 0; a < 2; ++a)
#pragma unroll
        for (int b = 0; b < 2; ++b)
#pragma unroll
            for (int m = 0; m < 4; ++m)
#pragma unroll
                for (int n = 0; n < 2; ++n) acc[a][b][m][n] = (f32x4){0.f, 0.f, 0.f, 0.f};
    bf16x8 At[4][2], B0[2][2], B1[2][2];
    const char* cA; const char* cB = (const char*)g.Bt + (size_t)cur.pn * tstep;
    if constexpr (GATHER) { cA = (const char*)g.A; PG8_GIDX_ISSUE(cur.pm); PG8_WAIT_V(0); PG8_GIDX_TAKE(); }
    else cA = (const char*)g.A + (size_t)cur.pm * tstep;
    PG8_STAGE(PG8_SB(0, 0), cB, voffB); PG8_STAGE(PG8_SB(0, 1), cB + hstep, voffB); PG8_STAGE_A(PG8_SA(0, 0), cA, 0); PG8_STAGE_A(PG8_SA(0, 1), cA, 1);
    if (wr == 1) PG8_BAR;
    PG8_WAIT_V(2); PG8_BAR;
    PG8_STAGE(PG8_SB(1, 0), cB + kstep, voffB); PG8_STAGE_A(PG8_SA(1, 0), cA + kstep, 0); PG8_STAGE(PG8_SB(1, 1), cB + hstep + kstep, voffB);
    PG8_WAIT_V(6); PG8_BAR;
    for (;;) {
        const bool has_next = S.next(ui + 1, nxt);
        const char* nA; const char* nB = has_next ? (const char*)g.Bt + (size_t)nxt.pn * tstep : cB;
        if constexpr (GATHER) { nA = cA; if (has_next) PG8_GIDX_ISSUE(nxt.pm); }
        else nA = has_next ? (const char*)g.A + (size_t)nxt.pm * tstep : cA;
#pragma unroll 1
        for (int t = 0; t < nt; t += 2) {
            const bool last = (t == nt - 2);
            const char* a1 = cA + (size_t)(t + 1) * kstep;
            const char* a2 = last ? nA : cA + (size_t)(t + 2) * kstep; const char* b2 = last ? nB : cB + (size_t)(t + 2) * kstep;
            const char* a3 = a2 + kstep; const char* b3 = b2 + kstep;
            PG8_LDB(B0, 0, 0); PG8_LDB(B1, 0, 1); PG8_SCHED; PG8_LDA(At, 0, 0); PG8_STAGE_A(PG8_SA(1, 1), a1, 1);
            if constexpr (GATHER) { if (last && has_next) PG8_GIDX_TAKE(); }
            PG8_WAIT_V(8); PG8_WAIT_L(0); PG8_BAR; PG8_MMA(0, 0, At, B0); PG8_MMA(0, 1, At, B1); PG8_BAR; PG8_SCHED;
            PG8_LDA(At, 0, 1); PG8_STAGE(PG8_SB(0, 0), b2, voffB); PG8_STAGE(PG8_SB(0, 1), b2 + hstep, voffB); PG8_STAGE_A(PG8_SA(0, 0), a2, 0);
            PG8_WAIT_V(8); PG8_WAIT_L(0); PG8_BAR; PG8_MMA(1, 0, At, B0); PG8_MMA(1, 1, At, B1); PG8_BAR; PG8_SCHED;
            PG8_LDB(B0, 1, 0); PG8_LDB(B1, 1, 1); PG8_SCHED; PG8_LDA(At, 1, 0); PG8_STAGE_A(PG8_SA(0, 1), a2, 1);
            PG8_WAIT_V(8); PG8_WAIT_L(0); PG8_BAR; PG8_MMA(0, 0, At, B0); PG8_MMA(0, 1, At, B1); PG8_BAR; PG8_SCHED;
            PG8_LDA(At, 1, 1); PG8_STAGE(PG8_SB(1, 0), b3, voffB); PG8_STAGE(PG8_SB(1, 1), b3 + hstep, voffB); PG8_STAGE_A(PG8_SA(1, 0), a3, 0);
            PG8_WAIT_V(8); PG8_WAIT_L(0); PG8_BAR; PG8_MMA(1, 0, At, B0); PG8_MMA(1, 1, At, B1); PG8_BAR; PG8_SCHED;
        }
        if (wr == 0) PG8_BAR;
        { const int l2_ = opaque_tid(g.w0) & 63; E(acc, cur, wr, wc, l2_ & 15, l2_ >> 4); }
        if (!has_next) break;
#pragma unroll
        for (int a = 0; a < 2; ++a)
#pragma unroll
            for (int b = 0; b < 2; ++b)
#pragma unroll
                for (int m = 0; m < 4; ++m)
#pragma unroll
                    for (int n = 0; n < 2; ++n) acc[a][b][m][n] = (f32x4){0.f, 0.f, 0.f, 0.f};
        cur = nxt; cA = nA; cB = nB; ++ui;
        if (wr == 1) PG8_BAR;
    }
    PG8_WAIT_V(0);
    PG8_BAR;
#undef PG8_SA
#undef PG8_SB
#undef PG8_STAGE
#undef PG8_STAGE_A
#undef PG8_GIDX_ISSUE
#undef PG8_GIDX_TAKE
#undef PG8_LDA
#undef PG8_LDB
#undef PG8_MMA
#undef PG8_WAIT_V
#undef PG8_WAIT_L
#undef PG8_BAR
#undef PG8_SCHED
}
template <class Epi, class Sched, bool ALIGN_EPI = false, bool SP2 = false>
__device__ __forceinline__ void gemm_phase(PG8_LAS unsigned char* lds, const Gemm g, const Sched& S, const Epi& E) {
    const int tid = opaque_tid(g.w0), wid = __builtin_amdgcn_readfirstlane(tid >> 6), lane = tid & 63, wr = wid >> 2, wc = wid & 3, fr = lane & 15, fq = lane >> 4;
    const int K = g.K, nt = K / BK;
    unsigned voffA[2], voffB[2];
#pragma unroll
    for (int i = 0; i < 2; ++i) { int R, C; stage_rc(tid * 16 + i * 8192, R, C); const int Rb = Epi::PERM ? ((R & ~31) + perm32(R & 31)) : R;
        voffA[i] = (unsigned)(R * K + C) * 2u; voffB[i] = (unsigned)(Rb * K + C) * 2u; }
    const size_t kstep = (size_t)(BK * 2);
    const size_t hstep = (size_t)HALF * K * 2;
    const size_t tstep = 2 * hstep;
    const unsigned ldsw = (unsigned)wid * 1024u;
    const int aoff = lds_byte(wr * 64 + fr, fq * 8), boff = lds_byte(wc * 32 + fr, fq * 8);
#define PG8_SA(b, h) (((b) * 2 + (h)) * HTB)
#define PG8_SB(b, h) ((4 + (b) * 2 + (h)) * HTB)
#define PG8_STAGE(bufoff, gbase, voff) do { _Pragma("unroll") for (int _i = 0; _i < 2; ++_i) \
        __builtin_amdgcn_global_load_lds((const unsigned*)((const char*)(gbase) + (voff)[_i]), (PG8_LAS unsigned*)(lds + (bufoff) + ldsw + _i * 8192), 16, 0, 0); } while (0)
#define PG8_LDA(dst, b, h) do { _Pragma("unroll") for (int m = 0; m < 4; ++m) _Pragma("unroll") for (int k = 0; k < 2; ++k) dst[m][k] = *(const PG8_LAS bf16x8*)(lds + PG8_SA(b, h) + aoff + m * 2048 + k * 1024); } while (0)
#define PG8_LDB(dst, b, h) do { _Pragma("unroll") for (int n = 0; n < 2; ++n) _Pragma("unroll") for (int k = 0; k < 2; ++k) dst[n][k] = *(const PG8_LAS bf16x8*)(lds + PG8_SB(b, h) + boff + n * 2048 + k * 1024); } while (0)
#define PG8_MMA(ai, bj, At, Bt) do { __builtin_amdgcn_s_setprio(1); _Pragma("unroll") for (int m = 0; m < 4; ++m) _Pragma("unroll") for (int n = 0; n < 2; ++n) _Pragma("unroll") for (int k = 0; k < 2; ++k) \
        acc[ai][bj][m][n] = __builtin_amdgcn_mfma_f32_16x16x32_bf16(Bt[n][k], At[m][k], acc[ai][bj][m][n], 0, 0, 0); __builtin_amdgcn_s_setprio(0); } while (0)
#define PG8_WAIT_V(n) asm volatile("s_waitcnt vmcnt(" #n ")" ::: "memory")
#define PG8_WAIT_L(n) asm volatile("s_waitcnt lgkmcnt(" #n ")" ::: "memory")
#define PG8_BAR __builtin_amdgcn_s_barrier()
#define PG8_SCHED __builtin_amdgcn_sched_barrier(0)
    Unit cur, nxt; int ui = 0;
    if (!S.next(0, cur)) return;
    f32x4 acc[2][2][4][2];
#pragma unroll
    for (int a = 0; a < 2; ++a)
#pragma unroll
        for (int b = 0; b < 2; ++b)
#pragma unroll
            for (int m = 0; m < 4; ++m)
#pragma unroll
                for (int n = 0; n < 2; ++n) acc[a][b][m][n] = (f32x4){0.f, 0.f, 0.f, 0.f};
    bf16x8 At[4][2], B0[2][2], B1[2][2];
    const char* cA = (const char*)g.A + (size_t)cur.pm * tstep; const char* cB = (const char*)g.Bt + (size_t)cur.pn * tstep;
    S.a_ready(cur);
    if constexpr (SP2) {
        PG8_STAGE(PG8_SB(0, 0), cB, voffB); PG8_STAGE(PG8_SB(0, 1), cB + hstep, voffB); PG8_STAGE(PG8_SA(0, 0), cA, voffA); PG8_STAGE(PG8_SA(0, 1), cA + hstep, voffA);
        if (wr == 1) PG8_BAR;
        PG8_WAIT_V(2); PG8_BAR;
        PG8_STAGE(PG8_SB(1, 0), cB + kstep, voffB); PG8_STAGE(PG8_SA(1, 0), cA + kstep, voffA); PG8_STAGE(PG8_SB(1, 1), cB + hstep + kstep, voffB);
        PG8_WAIT_V(6); PG8_BAR;
    } else {
        PG8_STAGE(PG8_SB(0, 0), cB, voffB); PG8_STAGE(PG8_SA(0, 0), cA, voffA); PG8_STAGE(PG8_SB(0, 1), cB + hstep, voffB); PG8_STAGE(PG8_SA(0, 1), cA + hstep, voffA);
        if (wr == 1) PG8_BAR;
        PG8_WAIT_V(4); PG8_BAR;
        PG8_STAGE(PG8_SB(1, 0), cB + kstep, voffB); PG8_STAGE(PG8_SA(1, 0), cA + kstep, voffA); PG8_STAGE(PG8_SB(1, 1), cB + hstep + kstep, voffB);
        PG8_WAIT_V(6); PG8_BAR;
    }
    for (;;) {
        const bool has_next = S.next(ui + 1, nxt);
        const char* nA = has_next ? (const char*)g.A + (size_t)nxt.pm * tstep : cA; const char* nB = has_next ? (const char*)g.Bt + (size_t)nxt.pn * tstep : cB;
        for (int t = 0; t < nt; t += 2) {
            const bool last = (t == nt - 2);
            const char* a1 = cA + (size_t)(t + 1) * kstep;
            const char* a2 = last ? nA : cA + (size_t)(t + 2) * kstep; const char* b2 = last ? nB : cB + (size_t)(t + 2) * kstep;
            const char* a3 = a2 + kstep; const char* b3 = b2 + kstep;
            if (last && has_next) S.a_ready(nxt);
            if constexpr (SP2) {
            PG8_LDB(B0, 0, 0); PG8_LDB(B1, 0, 1); PG8_SCHED; PG8_LDA(At, 0, 0); PG8_STAGE(PG8_SA(1, 1), a1 + hstep, voffA);
            PG8_WAIT_V(8); PG8_WAIT_L(0); PG8_BAR; PG8_MMA(0, 0, At, B0); PG8_MMA(0, 1, At, B1); PG8_BAR; PG8_SCHED;
            PG8_LDA(At, 0, 1); PG8_STAGE(PG8_SB(0, 0), b2, voffB); PG8_STAGE(PG8_SB(0, 1), b2 + hstep, voffB); PG8_STAGE(PG8_SA(0, 0), a2, voffA);
            PG8_WAIT_V(8); PG8_WAIT_L(0); PG8_BAR; PG8_MMA(1, 0, At, B0); PG8_MMA(1, 1, At, B1); PG8_BAR; PG8_SCHED;
            PG8_LDB(B0, 1, 0); PG8_LDB(B1, 1, 1); PG8_SCHED; PG8_LDA(At, 1, 0); PG8_STAGE(PG8_SA(0, 1), a2 + hstep, voffA);
            PG8_WAIT_V(8); PG8_WAIT_L(0); PG8_BAR; PG8_MMA(0, 0, At, B0); PG8_MMA(0, 1, At, B1); PG8_BAR; PG8_SCHED;
            PG8_LDA(At, 1, 1); PG8_STAGE(PG8_SB(1, 0), b3, voffB); PG8_STAGE(PG8_SB(1, 1), b3 + hstep, voffB); PG8_STAGE(PG8_SA(1, 0), a3, voffA);
            PG8_WAIT_V(8); PG8_WAIT_L(0); PG8_BAR; PG8_MMA(1, 0, At, B0); PG8_MMA(1, 1, At, B1); PG8_BAR; PG8_SCHED;
            } else {
            PG8_LDB(B0, 0, 0); PG8_SCHED; PG8_LDA(At, 0, 0); PG8_STAGE(PG8_SA(1, 1), a1 + hstep, voffA);
            PG8_WAIT_L(8); PG8_BAR; PG8_WAIT_L(0); PG8_MMA(0, 0, At, B0); PG8_BAR; PG8_SCHED;
            PG8_LDB(B1, 0, 1); PG8_STAGE(PG8_SB(0, 0), b2, voffB);
            PG8_BAR; PG8_WAIT_L(0); PG8_MMA(0, 1, At, B1); PG8_BAR;
            PG8_LDA(At, 0, 1); PG8_STAGE(PG8_SA(0, 0), a2, voffA);
            PG8_BAR; PG8_WAIT_L(0); PG8_MMA(1, 0, At, B0); PG8_BAR; PG8_SCHED;
            PG8_STAGE(PG8_SB(0, 1), b2 + hstep, voffB);
            PG8_WAIT_V(6); PG8_BAR; PG8_MMA(1, 1, At, B1); PG8_BAR;
            PG8_LDB(B0, 1, 0); PG8_SCHED; PG8_LDA(At, 1, 0); PG8_STAGE(PG8_SA(0, 1), a2 + hstep, voffA);
            PG8_WAIT_L(8); PG8_BAR; PG8_WAIT_L(0); PG8_MMA(0, 0, At, B0); PG8_BAR; PG8_SCHED;
            PG8_LDB(B1, 1, 1); PG8_STAGE(PG8_SB(1, 0), b3, voffB);
            PG8_BAR; PG8_WAIT_L(0); PG8_MMA(0, 1, At, B1); PG8_BAR;
            PG8_LDA(At, 1, 1); PG8_STAGE(PG8_SA(1, 0), a3, voffA);
            PG8_BAR; PG8_WAIT_L(0); PG8_MMA(1, 0, At, B0); PG8_BAR; PG8_SCHED;
            PG8_STAGE(PG8_SB(1, 1), b3 + hstep, voffB);
            PG8_WAIT_V(6); PG8_BAR; PG8_MMA(1, 1, At, B1); PG8_BAR;
            }
        }
        if constexpr (ALIGN_EPI) { if (wr == 0) PG8_BAR; }
        if constexpr (!Epi::AFTER_DRAIN) { E(acc, cur, wr, wc, fr, fq); S.done(cur); }
        if (!has_next) break;
#pragma unroll
        for (int a = 0; a < 2; ++a)
#pragma unroll
            for (int b = 0; b < 2; ++b)
#pragma unroll
                for (int m = 0; m < 4; ++m)
#pragma unroll
                    for (int n = 0; n < 2; ++n) acc[a][b][m][n] = (f32x4){0.f, 0.f, 0.f, 0.f};
        cur = nxt; cA = nA; cB = nB; ++ui;
        if constexpr (ALIGN_EPI) { if (wr == 1) PG8_BAR; }
    }
    PG8_WAIT_V(0);
    if constexpr (!ALIGN_EPI) { if (wr == 0) PG8_BAR; }
    PG8_BAR;
    if constexpr (Epi::AFTER_DRAIN) { E.fused(acc, cur, wr, wc, fr, fq, lds, wid, lane); S.done(cur); }
#undef PG8_SA
#undef PG8_SB
#undef PG8_STAGE
#undef PG8_LDA
#undef PG8_LDB
#undef PG8_MMA
#undef PG8_WAIT_V
#undef PG8_WAIT_L
#undef PG8_BAR
#undef PG8_SCHED
}
}
#define XB_TMO      128
#define XB_XCNT(j)  (256  + 64 * (j))
#define XB_XSUB(j)  (1280 + 64 * (j))
#define XB_XGEN(j)  (2304 + 64 * (j))
#define XB_TOP      3328
#define XB_TOPGEN   3392
#define XCD_BAR_WORDS 3456
#define XB_SPIN_CAP (1u << 18)

__device__ __forceinline__ unsigned xb_ld(unsigned* p)              { return __hip_atomic_load(p, __ATOMIC_RELAXED, __HIP_MEMORY_SCOPE_AGENT); }
__device__ __forceinline__ unsigned xb_add(unsigned* p, unsigned v) { return __hip_atomic_fetch_add(p, v, __ATOMIC_RELAXED, __HIP_MEMORY_SCOPE_AGENT); }
__device__ __forceinline__ unsigned xb_xcc_id() { return (unsigned)__builtin_amdgcn_s_getreg((3 << 11) | 20) & 0xFu; }
#define XB_SPIN(cond, bar) do { unsigned _sp = 0; while (cond) { __builtin_amdgcn_s_sleep(1); \
    if ((++_sp & 255u) == 0u) { if (xb_ld(&(bar)[XB_TMO])) break; if (_sp > XB_SPIN_CAP) { atomicAdd(&(bar)[XB_TMO], 1u); break; } } } } while (0)

struct XcdBarrier {
    unsigned* bar; unsigned x;
    volatile LAS unsigned* st;
};

__device__ __forceinline__ XcdBarrier xcd_barrier_post(unsigned* bar, volatile LAS unsigned* st) {
    XcdBarrier b; b.bar = bar; b.x = xb_xcc_id(); b.st = st;
    if (threadIdx.x == 0) (void)xb_add(&bar[XB_XCNT(b.x)], 1u);
    return b;
}
__device__ __forceinline__ void xcd_barrier_complete(unsigned* bar, unsigned x, unsigned& nloc, unsigned& nx) {
    const unsigned G = gridDim.x * gridDim.y * gridDim.z;
    unsigned sum, cnt, mine, sp = 0u;
    for (;;) {
        sum = 0u; cnt = 0u; mine = 0u;
#pragma unroll
        for (unsigned j = 0; j < 16; ++j) { const unsigned c = xb_ld(&bar[XB_XCNT(j)]); sum += c; cnt += (c > 0u) ? 1u : 0u; mine = (j == x) ? c : mine; }
        if (sum == G) break;
        __builtin_amdgcn_s_sleep(1);
        if ((++sp & 255u) == 0u) { if (xb_ld(&bar[XB_TMO])) break; if (sp > XB_SPIN_CAP) { atomicAdd(&bar[XB_TMO], 1u); break; } }
    }
    nloc = mine > 0u ? mine : 1u; nx = cnt > 0u ? cnt : 1u;
}

__device__ __forceinline__ void xcd_barrier(const XcdBarrier& b) {
    asm volatile("s_waitcnt vmcnt(0)" ::: "memory");
    __syncthreads();
    if (threadIdx.x == 0) {
        unsigned* bar = b.bar;
        __builtin_amdgcn_s_waitcnt(0);
        unsigned nloc = b.st[0], nx = b.st[1];
        if (nloc == 0u) { xcd_barrier_complete(bar, b.x, nloc, nx); b.st[0] = nloc; b.st[1] = nx; }
        const unsigned old = xb_add(&bar[XB_XSUB(b.x)], 1u);
        const unsigned gen = old / nloc;
        if (old + 1u == (gen + 1u) * nloc) {
            __builtin_amdgcn_fence(__ATOMIC_RELEASE, "agent");
            asm volatile("s_waitcnt vmcnt(0)" ::: "memory");
            const unsigned og = xb_add(&bar[XB_TOP], 1u);
            const unsigned tg = og / nx;
            if (og + 1u == (tg + 1u) * nx) xb_add(&bar[XB_TOPGEN], 1u);
            else XB_SPIN(xb_ld(&bar[XB_TOPGEN]) == tg, bar);
            __builtin_amdgcn_fence(__ATOMIC_ACQUIRE, "agent");
            xb_add(&bar[XB_XGEN(b.x)], 1u);
            asm volatile("s_waitcnt vmcnt(0)" ::: "memory");
        } else {
            XB_SPIN(xb_ld(&bar[XB_XGEN(b.x)]) == gen, bar);
            __builtin_amdgcn_fence(__ATOMIC_ACQUIRE, "agent");
            asm volatile("s_waitcnt vmcnt(0)" ::: "memory");
        }
    }
    __syncthreads();
}

using pg8::bf16_t; using pg8::bf16x8; using pg8::f32x4; using pg8::u32x4; using pg8::cvt_pk_bf16; using pg8::fast_exp;

#define BAR_LDS() do { asm volatile("s_waitcnt lgkmcnt(0)" ::: "memory"); __builtin_amdgcn_s_barrier(); asm volatile("" ::: "memory"); } while (0)
#define BAR_ALL() do { asm volatile("s_waitcnt vmcnt(0) lgkmcnt(0)" ::: "memory"); __builtin_amdgcn_s_barrier(); asm volatile("" ::: "memory"); } while (0)

#ifdef PROBE_SHFL
__device__ __forceinline__ float shx(float v, int mask, int lane) { (void)lane; return __shfl_xor(v, mask); }
__device__ __forceinline__ unsigned shxu(unsigned v, int mask, int lane) { (void)lane; return __shfl_xor(v, mask); }
__device__ __forceinline__ unsigned shupu(unsigned v, int d, int lane) { (void)lane; return __shfl_up(v, d); }
#else
__device__ __forceinline__ float shx(float v, int mask, int lane) { return __builtin_bit_cast(float, __builtin_amdgcn_ds_bpermute((lane ^ mask) << 2, __builtin_bit_cast(int, v))); }
__device__ __forceinline__ unsigned shxu(unsigned v, int mask, int lane) { return (unsigned)__builtin_amdgcn_ds_bpermute((lane ^ mask) << 2, (int)v); }
__device__ __forceinline__ unsigned shupu(unsigned v, int d, int lane) { return (unsigned)__builtin_amdgcn_ds_bpermute((lane - d) << 2, (int)v); }
#endif
__device__ __forceinline__ float wave_sum(float v, int lane) {
#pragma unroll
    for (int o = 1; o < 64; o <<= 1) v += shx(v, o, lane);
    return v;
}
__device__ __forceinline__ float bf_lo(unsigned u) { return __uint_as_float(u << 16); }
__device__ __forceinline__ float bf_hi(unsigned u) { return __uint_as_float(u & 0xffff0000u); }

struct Args { const float* in[18]; float* out; unsigned char* ws; };
struct Ctx { LAS unsigned char* lds; int w0;
    __device__ __forceinline__ const float* in(int i) const { return ldptr(lds, i); }
    __device__ __forceinline__ float* out() const { return (float*)ldptr(lds, 18); }
    __device__ __forceinline__ unsigned char* ws() const { return (unsigned char*)ldptr(lds, 19); } };
#define PHASE_IDS() const int tid = opaque_tid(a.w0), lane = tid & 63, wave = __builtin_amdgcn_readfirstlane(tid >> 6); (void)tid; (void)lane; (void)wave
enum { I_X = 0, I_C, I_CTX, I_CCTX, I_WADA, I_BADA, I_GMIX, I_GFFN, I_WIN, I_WOUT, I_LBL, I_ONORM, I_RDEC, I_WR, I_WEG, I_WEU, I_WED, I_GFIN };

__device__ __forceinline__ void tr_item(const float* W, int N, bf16_t* WT, int Kd, int k0, int n0, int drow0, LAS float* scr, int lane) {
    f32x4 v[16];
    const float* src = W + (size_t)(k0 + (lane >> 4)) * N + n0 + (lane & 15) * 4;
#pragma unroll
    for (int i = 0; i < 16; ++i) v[i] = *(const f32x4*)(src + (size_t)(i * 4) * N);
#pragma unroll
    for (int i = 0; i < 16; ++i) { LAS float* d = scr + (i * 4 + (lane >> 4)) * 65 + (lane & 15) * 4; d[0] = v[i][0]; d[1] = v[i][1]; d[2] = v[i][2]; d[3] = v[i][3]; }
    asm volatile("s_waitcnt lgkmcnt(0)" ::: "memory");
    const int c = lane & 7;
#pragma unroll
    for (int j = 0; j < 8; ++j) { const int n = j * 8 + (lane >> 3); const LAS float* s = scr + (8 * c) * 65 + n;
        u32x4 o; o.x = cvt_pk_bf16(s[0], s[65]); o.y = cvt_pk_bf16(s[2 * 65], s[3 * 65]); o.z = cvt_pk_bf16(s[4 * 65], s[5 * 65]); o.w = cvt_pk_bf16(s[6 * 65], s[7 * 65]);
        *(u32x4*)(WT + (size_t)(drow0 + n) * Kd + k0 + 8 * c) = o; }
    asm volatile("s_waitcnt lgkmcnt(0)" ::: "memory");
}

__device__ __forceinline__ void tr_item8(const float* W, int N, unsigned char* WT, int Kd, int k0, int n0, int drow0, LAS float* scr, int lane, float scale) {
    f32x4 v[16];
    const float* src = W + (size_t)(k0 + (lane >> 4)) * N + n0 + (lane & 15) * 4;
#pragma unroll
    for (int i = 0; i < 16; ++i) v[i] = *(const f32x4*)(src + (size_t)(i * 4) * N);
#pragma unroll
    for (int i = 0; i < 16; ++i) { LAS float* d = scr + (i * 4 + (lane >> 4)) * 65 + (lane & 15) * 4; d[0] = v[i][0] * scale; d[1] = v[i][1] * scale; d[2] = v[i][2] * scale; d[3] = v[i][3] * scale; }
    asm volatile("s_waitcnt lgkmcnt(0)" ::: "memory");
    const int c = lane & 3;
#pragma unroll
    for (int j = 0; j < 4; ++j) { const int n = j * 16 + (lane >> 2); const LAS float* s = scr + (16 * c) * 65 + n;
        u32x4 o; o.x = pg8::pk4_fp8(s[0], s[65], s[2 * 65], s[3 * 65]); o.y = pg8::pk4_fp8(s[4 * 65], s[5 * 65], s[6 * 65], s[7 * 65]);
        o.z = pg8::pk4_fp8(s[8 * 65], s[9 * 65], s[10 * 65], s[11 * 65]); o.w = pg8::pk4_fp8(s[12 * 65], s[13 * 65], s[14 * 65], s[15 * 65]);
        *(u32x4*)(WT + (size_t)(drow0 + n) * Kd + k0 + 16 * c) = o; }
    asm volatile("s_waitcnt lgkmcnt(0)" ::: "memory");
}

__device__ __forceinline__ void p0_prologue(const Ctx& a) {
    PHASE_IDS(); LAS unsigned char* lds = launder_lds(a.lds); unsigned char* ws = a.ws(); const float* cin_ = a.in(I_C); const float* cctx_ = a.in(I_CCTX);
    LAS float* scr = (LAS float*)(lds + wave * 16640);
    LAS float* scond = (LAS float*)(lds + 8 * 16640);
    for (int i = tid; i < 3 * D; i += 512) { const int w = i >> 10, k = i & 1023; const float cv = (w < 2) ? cin_[w * D + k] : cctx_[k]; scond[i] = cv * pg8::fast_sigmoid(cv); }
    if (blockIdx.x == 0) { const int c = tid; const float* lg = a.in(I_LBL);
        const float l0 = lg[c], l1 = lg[512 + c], l2 = lg[1024 + c], l3 = lg[1536 + c]; const float mx = fmaxf(fmaxf(l0, l1), fmaxf(l2, l3));
        const float e0 = expf(l0 - mx), e1 = expf(l1 - mx), e2 = expf(l2 - mx), e3 = expf(l3 - mx), inv = 1.0f / (e0 + e1 + e2 + e3);
        float* lbs = (float*)(ws + WS_LBS); lbs[c] = 0.f; lbs[512 + c] = e1 * inv; lbs[1024 + c] = (e1 + e2) * inv; lbs[1536 + c] = (e1 + e2 + e3) * inv; }
    if (blockIdx.x >= 1 && blockIdx.x <= 16) { const int idx = (blockIdx.x - 1) * 512 + tid, pos = idx >> 5, f = idx & 31;
        const float invf = powf(10000.0f, -(float)f / 32.0f), ang = (float)pos * invf; float* cs = (float*)(ws + WS_ROPE); cs[idx * 2] = cosf(ang); cs[idx * 2 + 1] = sinf(ang); }
    BAR_LDS();
    const int gw = blockIdx.x * 8 + wave, NGW = gridDim.x * 8;
    for (int it = gw; it < 4 * 24 * 8; it += NGW) { const int l = it / 192, r = it % 192, cg = r >> 3, ks = r & 7; const int cols = cg * 256 + lane * 4;
        const float* wp = a.in(I_WADA) + ((size_t)l * D + ks * 128) * 6144 + cols; f32x4 a0 = {0, 0, 0, 0}, a1 = a0, a2 = a0;
#pragma unroll 8
        for (int kk = 0; kk < 128; ++kk) { const f32x4 w = *(const f32x4*)(wp + (size_t)kk * 6144); const int k = ks * 128 + kk; a0 += w * scond[k]; a1 += w * scond[D + k]; a2 += w * scond[2 * D + k]; }
        float* pp = (float*)(ws + WS_MODP) + (size_t)((l * 8 + ks) * 3) * 6144 + cols; *(f32x4*)pp = a0; *(f32x4*)(pp + 6144) = a1; *(f32x4*)(pp + 2 * 6144) = a2; }
    constexpr int I_IN = 16 * 72, I_OUT = 16 * 16, I_E = 512;
    constexpr int NIT = 4 * (I_IN + I_OUT) + 64 * 3 * I_E;
    for (int it = gw; it < NIT; it += NGW) {
        int r = it;
        if (r < 4 * I_IN) { const int l = r / I_IN, q = r % I_IN, kb = q / 72, nb = q % 72;
            tr_item(a.in(I_WIN) + (size_t)l * D * INW, INW, (bf16_t*)(ws + WS_WIN) + (size_t)l * INW * D, D, kb * 64, nb * 64, nb * 64, scr, lane); continue; }
        r -= 4 * I_IN;
        if (r < 4 * I_OUT) { const int l = r / I_OUT, q = r % I_OUT, kb = q / 16, nb = q % 16;
            tr_item(a.in(I_WOUT) + (size_t)l * D * D, D, (bf16_t*)(ws + WS_WOUT) + (size_t)l * D * D, D, kb * 64, nb * 64, nb * 64, scr, lane); continue; }
        r -= 4 * I_OUT;
        const int le = r / (3 * I_E), q3 = r % (3 * I_E), kind = q3 / I_E, q = q3 % I_E;
        if (kind < 2) { const int kb = q / 32, nb = q % 32, n0 = nb * 64;
            const int drow = 256 * (n0 >> 7) + (n0 & 127) + kind * 128;
            tr_item8(a.in(kind == 0 ? I_WEG : I_WEU) + (size_t)le * D * FF, FF, (unsigned char*)(ws + WS_WGU) + (size_t)le * 4096 * D, D, kb * 64, n0, drow, scr, lane, pg8::F8_SW);
        } else { const int kb = q / 16, nb = q % 16;
            tr_item8(a.in(I_WED) + (size_t)le * FF * D, D, (unsigned char*)(ws + WS_WD) + (size_t)le * D * FF, FF, kb * 64, nb * 64, nb * 64, scr, lane, pg8::F8_SW); }
    }
}

__device__ __forceinline__ void p0_finalize(const Ctx& a) {
    PHASE_IDS(); unsigned char* ws = a.ws(); const float* bada = a.in(I_BADA); const float* part = (const float*)(ws + WS_MODP); float* mods = (float*)(ws + WS_MODS);
    for (int i = blockIdx.x * 512 + tid; i < 4 * 3 * 6144; i += gridDim.x * 512) { const int l = i / (3 * 6144), r = i % (3 * 6144), w = r / 6144, j = r % 6144;
        float s = bada[l * 6144 + j];
#pragma unroll
        for (int ks = 0; ks < 8; ++ks) s += part[(size_t)((l * 8 + ks) * 3 + w) * 6144 + j];
        mods[i] = s; }
}

template <int MODE>
__device__ __forceinline__ void norm1_phase(const Ctx& a, int l) {
    PHASE_IDS(); unsigned char* ws = a.ws(); const float* in_x = a.in(I_X); const float* in_ctx = a.in(I_CTX); const float* gm = (MODE == 0) ? a.in(I_GMIX) + l * D : a.in(I_GFIN); float* outp = a.out(); const int gw = blockIdx.x * 8 + wave, NGW = gridDim.x * 8;
    const float* mods = (const float*)(ws + WS_MODS); float* X = (float*)(ws + WS_X); bf16_t* H = (bf16_t*)(ws + WS_H);
    const int* inv = (const int*)(ws + WS_INV); const bf16_t* YS = (const bf16_t*)(ws + WS_YS); const float* gate = (const float*)(ws + WS_ROWMAP) + MOE_ROWS;
    for (int row = gw; row < MROWS; row += NGW) {
        const int b = row >= LTOT ? 1 : 0, g = row - b * LTOT; const bool isctx = g < CTX; const int which = isctx ? 2 : b;
        if (MODE == 1 && isctx) continue;
        f32x4 v[4];
        if (l == 0) { const float* src = isctx ? in_ctx + (size_t)(b * CTX + g) * D : in_x + (size_t)(b * SEQ + g - CTX) * D;
#pragma unroll
            for (int j = 0; j < 4; ++j) v[j] = *(const f32x4*)(src + lane * 4 + 256 * j);
        } else {
            float* xr = X + (size_t)row * D;
#pragma unroll
            for (int j = 0; j < 4; ++j) v[j] = *(const f32x4*)(xr + lane * 4 + 256 * j);
            const int iv = inv[row * 16 + (lane & 15)];
            f32x4 s[4] = {{0, 0, 0, 0}, {0, 0, 0, 0}, {0, 0, 0, 0}, {0, 0, 0, 0}};
#pragma unroll 1
            for (int e = 0; e < 16; ++e) { const int mr = __builtin_amdgcn_readlane(iv, e);
                if (mr >= 0) { const bf16_t* yr = YS + (size_t)mr * D + lane * 4; const float gg = gate[mr];
#pragma unroll
                    for (int j = 0; j < 4; ++j) { const u32x2 y = *(const u32x2*)(yr + 256 * j); s[j][0] += gg * bf_lo(y.x); s[j][1] += gg * bf_hi(y.x); s[j][2] += gg * bf_lo(y.y); s[j][3] += gg * bf_hi(y.y); } } }
            const float* gt2 = mods + (size_t)((l - 1) * 3 + which) * 6144 + 5 * D;
#pragma unroll
            for (int j = 0; j < 4; ++j) { v[j] += *(const f32x4*)(gt2 + lane * 4 + 256 * j) * s[j]; if (MODE == 0) *(f32x4*)(xr + lane * 4 + 256 * j) = v[j]; }
        }
        float ss = 0.f;
#pragma unroll
        for (int j = 0; j < 4; ++j) ss += (v[j][0] * v[j][0] + v[j][1] * v[j][1]) + (v[j][2] * v[j][2] + v[j][3] * v[j][3]);
        const float rinv = __builtin_amdgcn_rsqf(wave_sum(ss, lane) * (1.0f / D) + EPS);
        if (MODE == 0) {
            const float* sh = mods + (size_t)(l * 3 + which) * 6144; const float* sc = sh + D;
            bf16_t* hr = H + (size_t)row * D + lane * 4;
#pragma unroll
            for (int j = 0; j < 4; ++j) { const int c = lane * 4 + 256 * j; const f32x4 gg = *(const f32x4*)(gm + c), s1 = *(const f32x4*)(sc + c), s0 = *(const f32x4*)(sh + c);
                const f32x4 y = v[j] * rinv * gg * (s1 + 1.0f) + s0; u32x2 w; w.x = cvt_pk_bf16(y[0], y[1]); w.y = cvt_pk_bf16(y[2], y[3]); *(u32x2*)(hr + 256 * j) = w; }
        } else {
            const float* gf = gm; float* orow = outp + (size_t)(b * SEQ + g - CTX) * D + lane * 4;
#pragma unroll
            for (int j = 0; j < 4; ++j) *(f32x4*)(orow + 256 * j) = v[j] * rinv * *(const f32x4*)(gf + lane * 4 + 256 * j);
        }
    }
}

__device__ __forceinline__ void norm2_phase(const Ctx& a, int l) {
    PHASE_IDS(); LAS unsigned char* lds = launder_lds(a.lds); unsigned char* ws = a.ws(); const float* gm = a.in(I_GFFN) + l * D; const int gw = blockIdx.x * 8 + wave, NGW = gridDim.x * 8;
    const float* mods = (const float*)(ws + WS_MODS); const float* X = (const float*)(ws + WS_X); unsigned char* H8 = (unsigned char*)(ws + WS_H);
    int* inv = (int*)(ws + WS_INV); float* afl = (float*)(ws + WS_AFF); float* afc = afl + 2 * 16 * SEQ;
    LAS float* wrT = (LAS float*)lds;
    { const float* src = a.in(I_WR) + (size_t)l * D * NE; for (int i = tid; i < D * NE / 4; i += 512) { const f32x4 w = *(const f32x4*)(src + i * 4); const int d = i >> 2, e0 = (i & 3) * 4;
        wrT[(e0 + 0) * D + d] = w[0]; wrT[(e0 + 1) * D + d] = w[1]; wrT[(e0 + 2) * D + d] = w[2]; wrT[(e0 + 3) * D + d] = w[3]; } }
    BAR_LDS();
    const bool last = (l == DEPTH - 1);
    for (int row = gw; row < MROWS; row += NGW) {
        const int b = row >= LTOT ? 1 : 0, g = row - b * LTOT; const bool isctx = g < CTX; const int which = isctx ? 2 : b;
        if (last && isctx) continue;
        const float* xr = X + (size_t)row * D; f32x4 v[4];
#pragma unroll
        for (int j = 0; j < 4; ++j) v[j] = *(const f32x4*)(xr + lane * 4 + 256 * j);
        float ss = 0.f;
#pragma unroll
        for (int j = 0; j < 4; ++j) ss += (v[j][0] * v[j][0] + v[j][1] * v[j][1]) + (v[j][2] * v[j][2] + v[j][3] * v[j][3]);
        const float rinv = __builtin_amdgcn_rsqf(wave_sum(ss, lane) * (1.0f / D) + EPS);
        const float* sh = mods + (size_t)(l * 3 + which) * 6144 + 3 * D; const float* sc = sh + D;
        unsigned char* hr = H8 + (size_t)row * D + lane * 4;
        float p[16];
#pragma unroll
        for (int e = 0; e < 16; ++e) p[e] = 0.f;
#pragma unroll
        for (int j = 0; j < 4; ++j) { const int c = lane * 4 + 256 * j; const f32x4 gg = *(const f32x4*)(gm + c), s1 = *(const f32x4*)(sc + c), s0 = *(const f32x4*)(sh + c);
            const f32x4 y = v[j] * rinv * gg * (s1 + 1.0f) + s0; *(unsigned*)(hr + 256 * j) = pg8::pk4_fp8(y[0] * pg8::F8_SA, y[1] * pg8::F8_SA, y[2] * pg8::F8_SA, y[3] * pg8::F8_SA);
#pragma unroll
            for (int e = 0; e < 16; ++e) { const f32x4 w = *(const LAS f32x4*)(wrT + e * D + c); p[e] += (y[0] * w[0] + y[1] * w[1]) + (y[2] * w[2] + y[3] * w[3]); } }
        { const bool hi = (lane & 32) != 0;
#pragma unroll
          for (int i = 0; i < 8; ++i) { const float send = hi ? p[i] : p[i + 8], keep = hi ? p[i + 8] : p[i]; p[i] = keep + shx(send, 32, lane); } }
        { const bool hi = (lane & 16) != 0;
#pragma unroll
          for (int i = 0; i < 4; ++i) { const float send = hi ? p[i] : p[i + 4], keep = hi ? p[i + 4] : p[i]; p[i] = keep + shx(send, 16, lane); } }
        { const bool hi = (lane & 8) != 0;
#pragma unroll
          for (int i = 0; i < 2; ++i) { const float send = hi ? p[i] : p[i + 2], keep = hi ? p[i + 2] : p[i]; p[i] = keep + shx(send, 8, lane); } }
        { const bool hi = (lane & 4) != 0; const float send = hi ? p[0] : p[1], keep = hi ? p[1] : p[0]; p[0] = keep + shx(send, 4, lane); }
        float lg = p[0]; lg += shx(lg, 2, lane); lg += shx(lg, 1, lane);
        float mx = lg; mx = fmaxf(mx, shx(mx, 4, lane)); mx = fmaxf(mx, shx(mx, 8, lane)); mx = fmaxf(mx, shx(mx, 16, lane)); mx = fmaxf(mx, shx(mx, 32, lane));
        const float ex = expf(lg - mx); float sm = ex; sm += shx(sm, 4, lane); sm += shx(sm, 8, lane); sm += shx(sm, 16, lane); sm += shx(sm, 32, lane);
        const float aff = ex / sm; const int e = lane >> 2;
        if ((lane & 3) == 0) { if (isctx) afc[(b * 16 + e) * CTX + g] = aff; else afl[(size_t)(b * 16 + e) * SEQ + (g - CTX)] = aff; }
        if (lane < 16) inv[row * 16 + lane] = -1;
    }
}

__device__ __forceinline__ void topk_phase(const Ctx& a, int l) {
    PHASE_IDS(); LAS unsigned char* lds = launder_lds(a.lds); unsigned char* ws = a.ws(); const float* afl = (const float*)(ws + WS_AFF); const float* afc = afl + 2 * 16 * SEQ;
    int* rowmap = (int*)(ws + WS_ROWMAP); float* gate = (float*)(ws + WS_ROWMAP) + MOE_ROWS; int* inv = (int*)(ws + WS_INV);
    LAS unsigned* wcnt = (LAS unsigned*)lds;
    const int nitems = (l == DEPTH - 1) ? 32 : 64;
    for (int it = blockIdx.x; it < nitems; it += gridDim.x) {
        const bool isctx = it >= 32; const int be = it & 31, b = be >> 4, e = be & 15;
        const int n = isctx ? CTX : SEQ, k = isctx ? CAP_CTX : CAP_LAT;
        const float* src = isctx ? afc + be * CTX : afl + (size_t)be * SEQ;
        unsigned key[32];
#pragma unroll
        for (int i = 0; i < 32; ++i) { const int idx = i * 512 + tid; key[i] = idx < n ? __float_as_uint(src[idx]) : 0u; }
        unsigned T = 0u;
        for (int bit = 30; bit >= 0; --bit) { const unsigned cand = T | (1u << bit); unsigned cnt = 0;
#pragma unroll
            for (int i = 0; i < 32; ++i) cnt += (key[i] >= cand) ? 1u : 0u;
#pragma unroll
            for (int o = 1; o < 64; o <<= 1) cnt += shxu(cnt, o, lane);
            LAS unsigned* wc = wcnt + (bit & 1) * 8; if (lane == 0) wc[wave] = cnt;
            BAR_LDS();
            unsigned tot = 0;
#pragma unroll
            for (int w = 0; w < 8; ++w) tot += wc[w];
            if (tot >= (unsigned)k) T = cand; }
        unsigned mine = 0;
#pragma unroll
        for (int i = 0; i < 32; ++i) mine += (key[i] > T ? 1u : 0u) + (key[i] == T ? 65536u : 0u);
        unsigned incl = mine;
#pragma unroll
        for (int o = 1; o < 64; o <<= 1) { const unsigned t = shupu(incl, o, lane); if (lane >= o) incl += t; }
        LAS unsigned* wt = wcnt + 16; BAR_LDS();
        if (lane == 63) wt[wave] = incl;
        BAR_LDS();
        unsigned base = 0, total = 0;
#pragma unroll
        for (int w = 0; w < 8; ++w) { const unsigned t = wt[w]; total += t; if (w < wave) base += t; }
        const unsigned excl = base + incl - mine; const unsigned cgt = total & 0xffffu; const unsigned need = (unsigned)k - cgt;
        unsigned sg = excl & 0xffffu, se = excl >> 16;
        const int mrbase = e * MOE_ROWS_E + (isctx ? 4096 + b * CAP_CTX : b * CAP_LAT);
        const int rbase = b * LTOT + (isctx ? 0 : CTX);
#pragma unroll
        for (int i = 0; i < 32; ++i) { const int idx = i * 512 + tid; const unsigned kk = key[i]; int slot = -1;
            if (kk > T) { slot = (int)sg; ++sg; } else if (kk == T) { if (se < need) slot = (int)(cgt + se); ++se; }
            if (slot >= 0) { const int mr = mrbase + slot, r = rbase + idx; rowmap[mr] = r; gate[mr] = __uint_as_float(kk); inv[r * 16 + e] = mr; } }
        if (isctx && b == 0 && tid < 192) { const int mr = e * MOE_ROWS_E + 4160 + tid; rowmap[mr] = 0; gate[mr] = 0.f; }
        BAR_LDS();
    }
}


constexpr int SC_QI = 0, SC_KI = 17408, SC_KT = 34816, SC_VT = 53248, SC_PI = 71680, SC_SM = 80896, SC_PART = 115712, SC_VA = 119808, SC_VB = 120320, SC_VM = 120832, SC_RED = 121344;
constexpr int ST_Q = 272, ST_T = 144;

__device__ __forceinline__ bf16x8 ldfrag(const LAS unsigned char* base, int row, int stride, int kelem) { return *(const LAS bf16x8*)(base + row * stride + kelem * 2); }
#define MFMA16(a, b, c) __builtin_amdgcn_mfma_f32_16x16x32_bf16((a), (b), (c), 0, 0, 0)
#ifndef SCAN_LOG2
__device__ __forceinline__ float ex2(float x) { return __builtin_amdgcn_exp2f(x * 1.4426950408889634f); }
#define LOG2E_ 1.0f
#else
__device__ __forceinline__ float ex2(float x) { return __builtin_amdgcn_exp2f(x); }
#define LOG2E_ 1.4426950408889634f
#endif

__device__ __forceinline__ void scan_write_T(LAS unsigned char* img, const unsigned (&d)[8], int cp, int to) {
    u32x4 wa, wb;
    wa.x = (d[0] & 0xffffu) | (d[1] << 16); wa.y = (d[2] & 0xffffu) | (d[3] << 16); wa.z = (d[4] & 0xffffu) | (d[5] << 16); wa.w = (d[6] & 0xffffu) | (d[7] << 16);
    wb.x = (d[0] >> 16) | (d[1] & 0xffff0000u); wb.y = (d[2] >> 16) | (d[3] & 0xffff0000u); wb.z = (d[4] >> 16) | (d[5] & 0xffff0000u); wb.w = (d[6] >> 16) | (d[7] & 0xffff0000u);
    *(LAS u32x4*)(img + (2 * cp) * ST_T + to * 16) = wa; *(LAS u32x4*)(img + (2 * cp + 1) * ST_T + to * 16) = wb;
}

template <bool FULL>
__device__ __forceinline__ void scan_estage_hg(LAS unsigned char* lds, const unsigned (&kraw)[8], const unsigned (&qraw)[8], const unsigned (&vraw)[8], int lane, int wave, float& la_out, float& lb_out) {
    const int cp = lane, to = wave;
    float ca[8], cb[8]; float ra = 0.f, rb = 0.f;
#pragma unroll
    for (int tt = 0; tt < 8; ++tt) { ra += bf_lo(kraw[tt]); rb += bf_hi(kraw[tt]); ca[tt] = ra; cb[tt] = rb; }
    *(LAS f32x2*)(lds + SC_PART + (to * 128 + 2 * cp) * 4) = (f32x2){ra, rb};
    BAR_LDS();
    float pa = 0.f, pb = 0.f, ma = 0.f, mb = 0.f, la = 0.f, lb = 0.f;
#pragma unroll
    for (int t8 = 0; t8 < 8; ++t8) { const f32x2 pp = *(const LAS f32x2*)(lds + SC_PART + (t8 * 128 + 2 * cp) * 4);
        if (t8 < to) { pa += pp.x; pb += pp.y; } if (t8 < 4) { ma += pp.x; mb += pp.y; } la += pp.x; lb += pp.y; }
    pa -= ma; pb -= mb;
    unsigned kd[8];
#pragma unroll
    for (int tt = 0; tt < 8; ++tt) { const int rr = 8 * to + tt;
        const float da = pa + ca[tt], db = pb + cb[tt];
        const float ka = 1.0f - ex2(bf_lo(kraw[tt])), kb = 1.0f - ex2(bf_hi(kraw[tt]));
        kd[tt] = cvt_pk_bf16(ka * ex2(-da), kb * ex2(-db));
        if (FULL) { *(LAS unsigned*)(lds + SC_QI + rr * ST_Q + cp * 4) = cvt_pk_bf16(bf_lo(qraw[tt]) * ex2(da), bf_hi(qraw[tt]) * ex2(db));
            *(LAS unsigned*)(lds + SC_KI + rr * ST_Q + cp * 4) = kd[tt]; } }
    scan_write_T(lds + SC_KT, kd, cp, to); scan_write_T(lds + SC_VT, vraw, cp, to);
    if (to == 0) { *(LAS f32x2*)(lds + SC_VA + 8 * cp) = (f32x2){ex2(la), ex2(lb)}; *(LAS f32x2*)(lds + SC_VB + 8 * cp) = (f32x2){ex2(la - ma), ex2(lb - mb)};
        *(LAS f32x2*)(lds + SC_VM + 8 * cp) = (f32x2){ex2(ma), ex2(mb)}; }
    la_out = la; lb_out = lb;
}
template <bool FULL>
__device__ __forceinline__ void scan_estage_ret(LAS unsigned char* lds, const unsigned (&kraw)[8], const unsigned (&qraw)[8], const unsigned (&vraw)[8], int lane, int wave, float lg2) {
    const int cp = lane, to = wave; unsigned kd[8];
#pragma unroll
    for (int tt = 0; tt < 8; ++tt) { const int rr = 8 * to + tt; const float wk = ex2((float)(63 - rr) * lg2); kd[tt] = cvt_pk_bf16(bf_lo(kraw[tt]) * wk, bf_hi(kraw[tt]) * wk);
        if (FULL) { *(LAS unsigned*)(lds + SC_QI + rr * ST_Q + cp * 4) = qraw[tt]; *(LAS unsigned*)(lds + SC_KI + rr * ST_Q + cp * 4) = kraw[tt]; } }
    scan_write_T(lds + SC_KT, kd, cp, to); scan_write_T(lds + SC_VT, vraw, cp, to);
}

template <bool RET>
__device__ __forceinline__ void scan_state_update(LAS unsigned char* lds, f32x4 (&ST)[8], int wave, int fr, int fq, float g64) {
    const bf16x8 a0 = ldfrag(lds + SC_KT, 16 * wave + fr, ST_T, 8 * fq), a1 = ldfrag(lds + SC_KT, 16 * wave + fr, ST_T, 32 + 8 * fq);
    f32x4 av = {g64, g64, g64, g64}, bv = {1.f, 1.f, 1.f, 1.f};
    if (!RET) { av = *(const LAS f32x4*)(lds + SC_VA + (16 * wave + 4 * fq) * 4); bv = *(const LAS f32x4*)(lds + SC_VB + (16 * wave + 4 * fq) * 4); }
#pragma unroll
    for (int vi = 0; vi < 8; ++vi) { const bf16x8 b0 = ldfrag(lds + SC_VT, 16 * vi + fr, ST_T, 8 * fq), b1 = ldfrag(lds + SC_VT, 16 * vi + fr, ST_T, 32 + 8 * fq);
        f32x4 u = {0.f, 0.f, 0.f, 0.f}; u = MFMA16(a0, b0, u); u = MFMA16(a1, b1, u); ST[vi] = RET ? (av * ST[vi] + u) : (av * ST[vi] + bv * u); }
}

#define SCAN_LOAD_CHUNK(crow_, dir_) do { _Pragma("unroll") for (int tt = 0; tt < 8; ++tt) { const int rr_ = 8 * wave + tt; const size_t ro_ = (size_t)((crow_) + ((dir_) ? 63 - rr_ : rr_)) * INW + 2 * lane; \
        kraw[tt] = *(const unsigned*)(P + ro_ + colk); vraw[tt] = *(const unsigned*)(P + ro_ + colv); if (LOADQ) qraw[tt] = *(const unsigned*)(P + ro_ + colq); } } while (0)
#define SCAN_STORE_STATE(slot_) do { _Pragma("unroll") for (int vi = 0; vi < 8; ++vi) { u32x2 w; w.x = cvt_pk_bf16(ST[vi][0], ST[vi][1]); w.y = cvt_pk_bf16(ST[vi][2], ST[vi][3]); \
        *(u32x2*)(UB + (size_t)(slot_) * 16384 + (size_t)(vi * 512 + tid) * 4) = w; } } while (0)

struct ScanPtrs { const bf16_t* P; const bf16_t* SB; bf16_t* UB; float* AB; bf16_t* MIX; float* OB; const float* rdec; const float* onorm; };

template <bool RET>
__device__ __forceinline__ void scan1_item(const ScanPtrs& sp, LAS unsigned char* lds, int tid, int lane, int wave, int seq, int tb) {
    const bf16_t* P = sp.P; bf16_t* UB = sp.UB; const int fr = lane & 15, fq = lane >> 4; constexpr bool LOADQ = false;
    const int b = seq >> 4, hh = (seq >> 1) & 7, dir = seq & 1, h = hh & 3;
    const int colk = RET ? 6 * 512 + h * 128 : (dir ? 2 * 512 : 512) + h * 128, colv = (RET ? 7 * 512 : 3 * 512) + h * 128, colq = 0;
    const float lg2 = RET ? -expf(sp.rdec[dir * 4 + h]) * LOG2E_ : 0.f, g64 = ex2(64.f * lg2);
    const int rowbase = b * LTOT + tb * 256;
    f32x4 ST[8];
#pragma unroll
    for (int vi = 0; vi < 8; ++vi) ST[vi] = (f32x4){0.f, 0.f, 0.f, 0.f};
    float ata = 0.f, atb = 0.f; unsigned kraw[8], qraw[8], vraw[8];
#pragma unroll
    for (int tt = 0; tt < 8; ++tt) qraw[tt] = 0u;
    SCAN_LOAD_CHUNK(rowbase + (dir ? 3 : 0) * 64, dir);
#pragma unroll 1
    for (int ci = 0; ci < 4; ++ci) {
        if (RET) scan_estage_ret<false>(lds, kraw, qraw, vraw, lane, wave, lg2);
        else { float la, lb; scan_estage_hg<false>(lds, kraw, qraw, vraw, lane, wave, la, lb); ata += la; atb += lb; }
        if (ci < 3) { const int tc = dir ? 2 - ci : ci + 1; SCAN_LOAD_CHUNK(rowbase + tc * 64, dir); }
        BAR_LDS();
        scan_state_update<RET>(lds, ST, wave, fr, fq, g64);
        BAR_LDS();
    }
    const int slot = seq * 65 + tb;
    SCAN_STORE_STATE(slot);
    if (wave == 0) *(f32x2*)(sp.AB + (size_t)slot * 128 + 2 * lane) = RET ? (f32x2){ex2(256.f * lg2), ex2(256.f * lg2)} : (f32x2){ex2(ata), ex2(atb)};
}

template <bool RET>
__device__ __forceinline__ void scan3_item(const ScanPtrs& sp, LAS unsigned char* lds, int tid, int lane, int wave, int bh, int tb, bool store_state) {
#ifdef PROBE_SKIP
    if ((PROBE_SKIP == 1 && RET) || (PROBE_SKIP == 2 && !RET)) return;
#endif
    const bf16_t* P = sp.P; bf16_t* UB = sp.UB; float* OB = sp.OB;
    const int ti = wave & 3, vh = wave >> 2; constexpr bool LOADQ = true;
    const int b = bh >> 3, hh = bh & 7, h = hh & 3;
    const int colq = (RET ? 5 * 512 : 0) + h * 128, colv = (RET ? 7 * 512 : 3 * 512) + h * 128, colg = (RET ? 8 * 512 : 4 * 512) + h * 128, mixcol = hh * 128;
    const int rowbase = b * LTOT + tb * 256;
#pragma unroll 1
    for (int dir = 1; dir >= 0; --dir) {
        const int colk = RET ? 6 * 512 + h * 128 : (dir ? 2 * 512 : 512) + h * 128;
        const float lg2 = RET ? -expf(sp.rdec[dir * 4 + h]) * LOG2E_ : 0.f, g64 = ex2(64.f * lg2);
        f32x4 ST[8];
        if (tb == 0) {
#pragma unroll
            for (int vi = 0; vi < 8; ++vi) ST[vi] = (f32x4){0.f, 0.f, 0.f, 0.f};
        } else { const size_t slot = (size_t)(bh * 2 + dir) * 65 + tb;
#pragma unroll
            for (int vi = 0; vi < 8; ++vi) { const u32x2 w = *(const u32x2*)(sp.SB + slot * 16384 + (size_t)(vi * 512 + tid) * 4); ST[vi] = (f32x4){bf_lo(w.x), bf_hi(w.x), bf_lo(w.y), bf_hi(w.y)}; } }
        float ata = 0.f, atb = 0.f; unsigned kraw[8], qraw[8], vraw[8];
        SCAN_LOAD_CHUNK(rowbase + (dir ? 3 : 0) * 64, dir);
#pragma unroll 1
        for (int ci = 0; ci < 4; ++ci) {
            const int tc = dir ? 3 - ci : ci;
            int lane_ = lane; asm volatile("" : "+v"(lane_));
            const int fr = lane_ & 15, fq = lane_ >> 4, t = 16 * ti + fr; const float gt1 = ex2((float)(t + 1) * lg2);
            if (RET) scan_estage_ret<true>(lds, kraw, qraw, vraw, lane, wave, lg2);
            else { float la, lb; scan_estage_hg<true>(lds, kraw, qraw, vraw, lane, wave, la, lb); ata += la; atb += lb; }
            if (ci < 3) { const int tcn = dir ? 2 - ci : ci + 1; SCAN_LOAD_CHUNK(rowbase + tcn * 64, dir); }
            const int tok = tc * 64 + (dir ? 63 - t : t), grow = rowbase + tok;
            if (!RET) BAR_LDS();
            { f32x4 em = {1.f, 1.f, 1.f, 1.f}; if (!RET) em = *(const LAS f32x4*)(lds + SC_VM + (16 * wave + 4 * fq) * 4);
#pragma unroll
              for (int vi = 0; vi < 8; ++vi) { const f32x4 x = RET ? ST[vi] : ST[vi] * em; u32x2 w; w.x = cvt_pk_bf16(x[0], x[1]); w.y = cvt_pk_bf16(x[2], x[3]); *(LAS u32x2*)(lds + SC_SM + (16 * vi + fr) * ST_Q + (16 * wave + 4 * fq) * 2) = w; } }
            if (RET) BAR_LDS();
#pragma unroll
            for (int sii = 0; sii < 2; ++sii) { const int si = 2 * vh + sii; f32x4 sc = {0.f, 0.f, 0.f, 0.f};
                if (si <= ti) {
#pragma unroll
                    for (int ks = 0; ks < 4; ++ks) sc = MFMA16(ldfrag(lds + SC_KI, 16 * si + fr, ST_Q, 32 * ks + 8 * fq), ldfrag(lds + SC_QI, 16 * ti + fr, ST_Q, 32 * ks + 8 * fq), sc);
                    const int s0 = 16 * si + 4 * fq;
#pragma unroll
                    for (int r = 0; r < 4; ++r) { const float dm = RET ? ex2((float)(t - s0 - r) * lg2) : 1.0f; sc[r] = (s0 + r <= t) ? sc[r] * dm : 0.f; } }
                u32x2 w; w.x = cvt_pk_bf16(sc[0], sc[1]); w.y = cvt_pk_bf16(sc[2], sc[3]); *(LAS u32x2*)(lds + SC_PI + t * ST_T + (16 * si + 4 * fq) * 2) = w; }
            BAR_LDS();
            f32x4 o[4]; u32x2 gv[4];
            if (dir == 0) {
#pragma unroll
                for (int j = 0; j < 4; ++j) gv[j] = *(const u32x2*)(P + (size_t)grow * INW + colg + 16 * (4 * vh + j) + 4 * fq); }
            {
                f32x4 obv[4];
#pragma unroll
                for (int j = 0; j < 4; ++j) { obv[j] = (f32x4){0.f, 0.f, 0.f, 0.f}; if (dir == 0) obv[j] = *(const f32x4*)(OB + tok * 128 + 16 * (4 * vh + j) + 4 * fq); o[j] = (f32x4){0.f, 0.f, 0.f, 0.f}; }
#pragma unroll
                for (int ks = 0; ks < 4; ++ks) { const bf16x8 bf = ldfrag(lds + SC_QI, 16 * ti + fr, ST_Q, 32 * ks + 8 * fq);
#pragma unroll
                    for (int j = 0; j < 4; ++j) o[j] = MFMA16(ldfrag(lds + SC_SM, 16 * (4 * vh + j) + fr, ST_Q, 32 * ks + 8 * fq), bf, o[j]); }
#pragma unroll
                for (int j = 0; j < 4; ++j) o[j] = RET ? (o[j] * gt1 + obv[j]) : (o[j] + obv[j]);
            }
#pragma unroll
            for (int ks = 0; ks < 2; ++ks) { const bf16x8 bf = ldfrag(lds + SC_PI, 16 * ti + fr, ST_T, 32 * ks + 8 * fq);
#pragma unroll
                for (int j = 0; j < 4; ++j) o[j] = MFMA16(ldfrag(lds + SC_VT, 16 * (4 * vh + j) + fr, ST_T, 32 * ks + 8 * fq), bf, o[j]); }
            scan_state_update<RET>(lds, ST, wave, fr, fq, g64);
            if (dir == 1) {
#pragma unroll
                for (int j = 0; j < 4; ++j) *(f32x4*)(OB + tok * 128 + 16 * (4 * vh + j) + 4 * fq) = o[j];
                BAR_LDS();
            } else {
                float ss = 0.f;
#pragma unroll
                for (int j = 0; j < 4; ++j) { ss += (o[j][0] * o[j][0] + o[j][1] * o[j][1]) + (o[j][2] * o[j][2] + o[j][3] * o[j][3]); }
                ss += shx(ss, 16, lane_); ss += shx(ss, 32, lane_);
                if (fq == 0) *(LAS float*)(lds + SC_RED + ((ci & 1) * 128 + vh * 64 + t) * 4) = ss;
                BAR_LDS();
                const float tot = ss + *(const LAS float*)(lds + SC_RED + ((ci & 1) * 128 + (vh ^ 1) * 64 + t) * 4);
                const float rinv = __builtin_amdgcn_rsqf(tot * (1.0f / 128.0f) + EPS);
#pragma unroll
                for (int j = 0; j < 4; ++j) { const f32x4 onv = RET ? (f32x4){1.f, 1.f, 1.f, 1.f} : *(const f32x4*)(sp.onorm + 16 * (4 * vh + j) + 4 * fq);
                    const f32x4 y = o[j] * rinv * onv * (f32x4){bf_lo(gv[j].x), bf_hi(gv[j].x), bf_lo(gv[j].y), bf_hi(gv[j].y)};
                    u32x2 w; w.x = cvt_pk_bf16(y[0], y[1]); w.y = cvt_pk_bf16(y[2], y[3]); *(u32x2*)(sp.MIX + (size_t)grow * D + mixcol + 16 * (4 * vh + j) + 4 * fq) = w; }
#ifdef PROBE_BAR
                BAR_LDS();
#endif
            }
        }
        if (store_state) { const int slot = (bh * 2 + dir) * 65 + tb; SCAN_STORE_STATE(slot);
            if (wave == 0) *(f32x2*)(sp.AB + (size_t)slot * 128 + 2 * lane) = RET ? (f32x2){ex2(256.f * lg2), ex2(256.f * lg2)} : (f32x2){ex2(ata), ex2(atb)}; }
        BAR_ALL();
    }
}

__device__ __forceinline__ ScanPtrs scan_ptrs(const Ctx& a, int l) {
    unsigned char* ws = a.ws(); ScanPtrs sp; sp.P = (const bf16_t*)(ws + WS_P); sp.SB = (const bf16_t*)(ws + WS_SB); sp.UB = (bf16_t*)(ws + WS_UB); sp.AB = (float*)(ws + WS_AB); sp.MIX = (bf16_t*)(ws + WS_MIX);
    sp.OB = (float*)(ws + WS_OB) + (size_t)blockIdx.x * 32768; sp.rdec = a.in(I_RDEC) + l * 8; sp.onorm = a.in(I_ONORM) + l * 128; return sp;
}

__device__ __forceinline__ void scan1_phase(const Ctx& a, int l) {
    PHASE_IDS(); LAS unsigned char* lds = launder_lds(a.lds); const ScanPtrs sp = scan_ptrs(a, l);
#ifdef PROBE_NOMERGE
    const bool last = true; const int c = blockIdx.x, G = gridDim.x;
#else
    const bool last = (l == DEPTH - 1); const int c = blockIdx.x, G = gridDim.x;
#endif
    if (last || G < 32) {
        if (!last) for (int bh = c; bh < 16; bh += G) { if ((bh & 7) >= 4) scan3_item<true>(sp, lds, tid, lane, wave, bh, 0, true); else scan3_item<false>(sp, lds, tid, lane, wave, bh, 0, true); }
        for (int it = c; it < 2048; it += G) { const int seq = it >> 6, j = it & 63; if (!last && j == 0) continue; const int dir = seq & 1, tb = dir ? (j == 0 ? 0 : 65 - j) : j;
            if (((seq >> 1) & 7) >= 4) scan1_item<true>(sp, lds, tid, lane, wave, seq, tb); else scan1_item<false>(sp, lds, tid, lane, wave, seq, tb); }
        return;
    }
    if (c < 16) { if ((c & 7) >= 4) scan3_item<true>(sp, lds, tid, lane, wave, c, 0, true); else scan3_item<false>(sp, lds, tid, lane, wave, c, 0, true); }
    for (int k = (c < 16 ? 5 : 0);; ++k) {
        const int li = k < 5 ? k * (G - 16) + (c - 16) : 5 * (G - 16) + (k - 5) * G + c;
        if (li >= 2016) break;
        const int seq = li / 63, j = 1 + li % 63, dir = seq & 1, tb = dir ? 65 - j : j;
        if (((seq >> 1) & 7) >= 4) scan1_item<true>(sp, lds, tid, lane, wave, seq, tb); else scan1_item<false>(sp, lds, tid, lane, wave, seq, tb);
    }
}

__device__ __forceinline__ void scan2_phase(const Ctx& a) {
    PHASE_IDS(); unsigned char* ws = a.ws(); const bf16_t* UB = (const bf16_t*)(ws + WS_UB); bf16_t* SB = (bf16_t*)(ws + WS_SB); const float* AB = (const float*)(ws + WS_AB);
    const int c0 = 16 * (tid >> 6) + 4 * ((tid >> 4) & 3);
    for (int p = blockIdx.x; p < 256; p += gridDim.x) { const int seq = p >> 3, vi = p & 7, dir = seq & 1; const size_t eo = (size_t)(vi * 512 + tid) * 4;
        f32x4 s = {0.f, 0.f, 0.f, 0.f};
#pragma unroll 1
        for (int j0 = 0; j0 < 64; j0 += 8) { u32x2 u[8]; f32x4 av[8];
#pragma unroll
            for (int q = 0; q < 8; ++q) { const int j = j0 + q, tb = dir ? (j == 0 ? 0 : 65 - j) : j; const size_t slot = (size_t)seq * 65 + tb; u[q] = *(const u32x2*)(UB + slot * 16384 + eo); av[q] = *(const f32x4*)(AB + slot * 128 + c0); }
#pragma unroll
            for (int q = 0; q < 8; ++q) { const int j = j0 + q, tb = dir ? (j == 0 ? 0 : 65 - j) : j; const size_t slot = (size_t)seq * 65 + tb;
                u32x2 w; w.x = cvt_pk_bf16(s[0], s[1]); w.y = cvt_pk_bf16(s[2], s[3]); *(u32x2*)(SB + slot * 16384 + eo) = w;
                s = av[q] * s + (f32x4){bf_lo(u[q].x), bf_hi(u[q].x), bf_lo(u[q].y), bf_hi(u[q].y)}; } }
        { const int tb = dir ? 1 : 64; const size_t slot = (size_t)seq * 65 + tb; u32x2 w; w.x = cvt_pk_bf16(s[0], s[1]); w.y = cvt_pk_bf16(s[2], s[3]); *(u32x2*)(SB + slot * 16384 + eo) = w; }
    }
}

__device__ __forceinline__ void scan3_phase(const Ctx& a, int l) {
    PHASE_IDS(); LAS unsigned char* lds = launder_lds(a.lds); const ScanPtrs sp = scan_ptrs(a, l);
#ifdef PROBE_NOMERGE
    if (l != DEPTH - 1) for (int bh = blockIdx.x; bh < 16; bh += gridDim.x) { if ((bh & 7) >= 4) scan3_item<true>(sp, lds, tid, lane, wave, bh, 0, false); else scan3_item<false>(sp, lds, tid, lane, wave, bh, 0, false); }
#endif
    for (int it = blockIdx.x; it < 1024; it += gridDim.x) { const int bh = it >> 6, tb = 1 + (it & 63);
        if ((bh & 7) >= 4) scan3_item<true>(sp, lds, tid, lane, wave, bh, tb, false); else scan3_item<false>(sp, lds, tid, lane, wave, bh, tb, false); }
}

struct OutOrder {
    int nrt, skipctx, G, c;
    __device__ __forceinline__ bool next(int i, pg8::Unit& u) const {
        const int L = i * G + c; if (L >= nrt * 4) return false;
        const int r = L >> 2; u.pn = L & 3; u.pm = skipctx ? r + 1 + (r >= 64 ? 1 : 0) : r; return true;
    }
    __device__ __forceinline__ void a_ready(const pg8::Unit&) const {}
    __device__ __forceinline__ void done(const pg8::Unit&) const {}
};

#ifndef PH
#define PH 0xffff
#endif
#ifndef DBL
#define DBL 0
#endif
__global__ void __launch_bounds__(512, 2) mega_fwd(Args a) {
    extern __shared__ __attribute__((aligned(16))) unsigned char lds_raw[];
    LAS unsigned char* lds = (LAS unsigned char*)lds_raw;
    const int tid = threadIdx.x;
    const int G = gridDim.x; const int bx = blockIdx.x; const int vcu = (G % 8 == 0) ? (bx % 8) * (G / 8) + bx / 8 : bx;
    volatile LAS unsigned* MISC = (volatile LAS unsigned*)(lds + MISC_OFF);
    if (tid < 16) MISC[tid] = 0u;
    if (tid == 0) { LAS unsigned long long* pt = (LAS unsigned long long*)(lds + PTR_OFF);
#pragma unroll
        for (int i = 0; i < 18; ++i) pt[i] = (unsigned long long)a.in[i];
        pt[18] = (unsigned long long)a.out; pt[19] = (unsigned long long)a.ws; }
    __syncthreads();
    const Ctx cx{lds, __builtin_amdgcn_readfirstlane(tid >> 6)};
    XcdBarrier bar = xcd_barrier_post((unsigned*)(cx.ws() + WS_CTL) + 1024, MISC + 8);
#define GRID_BAR() do { XcdBarrier b2_ = bar; asm volatile("" : "+s"(b2_.x)); xcd_barrier(b2_); } while (0)

#if PH & 1
    p0_prologue(cx);
#endif
    GRID_BAR();
#if DBL & 1
    p0_prologue(cx);
    GRID_BAR();
#endif
#if PH & 1
    p0_finalize(cx);
#endif
    GRID_BAR();

#pragma unroll 1
    for (int l = 0; l < DEPTH; ++l) {
        const bool last = (l == DEPTH - 1); unsigned char* ws = cx.ws();
#if PH & 2
        norm1_phase<0>(cx, l);
#endif
        GRID_BAR();
#if PH & 4
        {
            pg8::Gemm g{(const bf16_t*)(ws + WS_H), (const bf16_t*)(ws + WS_WIN) + (size_t)l * INW * D, MROWS, INW, D, cx.w0};
            pg8::StaticOrder S; S.init(MROWS, INW, G, bx);
            pg8::EpiIn E{(bf16_t*)(ws + WS_P), (const float*)(ws + WS_LBS) + l * 512, (const float*)(ws + WS_ROPE)};
            pg8::gemm_phase<pg8::EpiIn, pg8::StaticOrder, true, true>(launder_lds(lds), g, S, E);
        }
#endif
        GRID_BAR();
#if PH & 8
        scan1_phase(cx, l);
#endif
        GRID_BAR();
#if PH & 16
        scan2_phase(cx);
#endif
        GRID_BAR();
#if PH & 32
        scan3_phase(cx, l);
#endif
        GRID_BAR();
#if DBL & 2
        scan1_phase(cx, l);
        GRID_BAR();
        scan2_phase(cx);
        GRID_BAR();
        scan3_phase(cx, l);
        GRID_BAR();
#endif
#if DBL & 8
        scan1_phase(cx, l);
        GRID_BAR();
#endif
#if DBL & 16
        scan2_phase(cx);
        GRID_BAR();
#endif
#if DBL & 32
        scan3_phase(cx, l);
        GRID_BAR();
#endif
#if PH & 64
        {
            pg8::Gemm g{(const bf16_t*)(ws + WS_MIX), (const bf16_t*)(ws + WS_WOUT) + (size_t)l * D * D, MROWS, D, D, cx.w0};
            OutOrder S{last ? 128 : 130, last ? 1 : 0, G, vcu};
            pg8::EpiOut E{(float*)(ws + WS_X), l == 0 ? cx.in(I_X) : nullptr, l == 0 ? cx.in(I_CTX) : nullptr, (const float*)(ws + WS_MODS) + (size_t)(l * 3) * 6144 + 2 * D};
            pg8::gemm_phase<pg8::EpiOut, OutOrder, true, true>(launder_lds(lds), g, S, E);
        }
#endif
        GRID_BAR();
#if PH & 128
        norm2_phase(cx, l);
#endif
        GRID_BAR();
#if PH & 256
        topk_phase(cx, l);
#endif
        GRID_BAR();
#if PH & 1024
        {
            pg8::Gemm g{(const bf16_t*)(ws + WS_H), (const bf16_t*)(ws + WS_WGU + (size_t)l * 65536 * D), MOE_ROWS, 65536, D, cx.w0};
            pg8::MoeOrder S{last ? 16 : 17, 16, G, vcu};
            pg8::EpiGU E{(unsigned char*)(ws + WS_HID)};
            pg8::gemm_phase_f8<pg8::EpiGU, pg8::MoeOrder, true>(launder_lds(lds), g, S, E, (const int*)(ws + WS_ROWMAP));
        }
#endif
        GRID_BAR();
#if PH & 2048
        {
            pg8::Gemm g{(const bf16_t*)(ws + WS_HID), (const bf16_t*)(ws + WS_WD + (size_t)l * 16384 * FF), MOE_ROWS, 16384, FF, cx.w0};
            pg8::MoeOrder S{last ? 16 : 17, 4, G, vcu};
            pg8::EpiDown E{(bf16_t*)(ws + WS_YS)};
            pg8::gemm_phase_f8<pg8::EpiDown, pg8::MoeOrder, false>(launder_lds(lds), g, S, E, nullptr);
        }
#endif
        GRID_BAR();
    }
#if PH & 4096
    norm1_phase<1>(cx, DEPTH);
#endif
}

extern "C" void kernel_launch(void* const* d_in, const int* in_sizes, int n_in, void* d_out, int out_size, void* d_ws, size_t ws_size, hipStream_t stream) {
    static int grid = 0;
    if (grid == 0) {
        if (n_in != 18 || out_size != NB * SEQ * D || ws_size < WS_END) { fprintf(stderr, "kernel_launch: unexpected problem shape (n_in %d, out %d, ws %zu)\n", n_in, out_size, ws_size); grid = -1; return; }
        int dev = 0, cus = 0, per_cu = 0;
        if (hipGetDevice(&dev) != hipSuccess || hipDeviceGetAttribute(&cus, hipDeviceAttributeMultiprocessorCount, dev) != hipSuccess) { grid = -1; return; }
        if (hipFuncSetAttribute((const void*)mega_fwd, hipFuncAttributeMaxDynamicSharedMemorySize, LDS_BYTES) != hipSuccess) { fprintf(stderr, "kernel_launch: hipFuncSetAttribute failed\n"); grid = -1; return; }
        if (hipOccupancyMaxActiveBlocksPerMultiprocessor(&per_cu, (const void*)mega_fwd, 512, LDS_BYTES) != hipSuccess || per_cu < 1) { fprintf(stderr, "kernel_launch: occupancy query reports %d workgroups per CU\n", per_cu); per_cu = 1; }
        (void)hipGetLastError();
        grid = cus;
    }
    if (grid < 0) return;
    (void)in_sizes;
    if (hipMemsetAsync((char*)d_ws + WS_CTL, 0, CTL_ZERO_BYTES, stream) != hipSuccess) return;
    Args a{};
    for (int i = 0; i < 18; ++i) a.in[i] = (const float*)d_in[i];
    a.out = (float*)d_out; a.ws = (unsigned char*)d_ws;
    hipLaunchKernelGGL(mega_fwd, dim3(grid), dim3(512), LDS_BYTES, stream, a);
}
```

```cpp
#include <hip/hip_runtime.h>
#include <cstdio>
#include <cstdint>

constexpr int D = 1024, NB = 2, SEQ = 16384, CTX = 256, LTOT = SEQ + CTX, MROWS = NB * LTOT;
constexpr int DEPTH = 4, INW = 4608, NE = 16, FF = 2048;
constexpr int CAP_LAT = 2048, CAP_CTX = 32;
constexpr int MOE_ROWS_E = 4352, MOE_ROWS = NE * MOE_ROWS_E;
constexpr int NSLOT = NB * 8 * 2 * 65;
constexpr float EPS = 1e-6f;

constexpr size_t MiB = 1u << 20;
constexpr size_t WS_CTL = 0, CTL_ZERO_BYTES = 64 * 1024;
constexpr size_t WS_MODP = 1 * MiB;
constexpr size_t WS_MODS = 4 * MiB;
constexpr size_t WS_LBS = 5 * MiB;
constexpr size_t WS_ROPE = 5 * MiB + 65536;
constexpr size_t WS_WIN = 8 * MiB;
constexpr size_t WS_WOUT = 44 * MiB;
constexpr size_t WS_WGU = 52 * MiB;
constexpr size_t WS_WD = 564 * MiB;
constexpr size_t WS_X = 820 * MiB;
constexpr size_t WS_H = 950 * MiB;
constexpr size_t WS_MIX = 1015 * MiB;
constexpr size_t WS_P = 1080 * MiB;
constexpr size_t WS_XS = 1080 * MiB;
constexpr size_t WS_HID = 1216 * MiB;
constexpr size_t WS_YS = 1488 * MiB;
constexpr size_t WS_UB = 1624 * MiB;
constexpr size_t WS_SB = 1689 * MiB;
constexpr size_t WS_AB = 1754 * MiB;
constexpr size_t WS_OB = 1756 * MiB;
constexpr size_t WS_AFF = 1788 * MiB;
constexpr size_t WS_ROWMAP = 1791 * MiB;
constexpr size_t WS_INV = 1792 * MiB;
constexpr size_t WS_END = 1800 * MiB;

constexpr int LDS_BYTES = 155648;
constexpr int MISC_OFF = LDS_BYTES - 64;
constexpr int PTR_OFF = LDS_BYTES - 256;

#define GAS __attribute__((address_space(1)))
#define LAS __attribute__((address_space(3)))
typedef float f32x2 __attribute__((ext_vector_type(2)));
typedef unsigned u32x2 __attribute__((ext_vector_type(2)));

__device__ __forceinline__ int lane_id() { return (int)__builtin_amdgcn_mbcnt_hi(~0u, __builtin_amdgcn_mbcnt_lo(~0u, 0u)); }
__device__ __forceinline__ int opaque_tid(int w0) { (void)w0; int t = threadIdx.x; asm volatile("" : "+v"(t)); return t; }
__device__ __forceinline__ LAS unsigned char* launder_lds(LAS unsigned char* p) { unsigned v = (unsigned)(size_t)p; asm volatile("" : "+s"(v)); return (LAS unsigned char*)(size_t)v; }
__device__ __forceinline__ const float* ldptr(LAS unsigned char* lds0, int i) {
    LAS unsigned char* lds = launder_lds(lds0);
    const u32x2 v = *(volatile LAS u32x2*)(lds + PTR_OFF + 8 * i);
    const unsigned lo = __builtin_amdgcn_readfirstlane(v.x), hi = __builtin_amdgcn_readfirstlane(v.y);
    return (const float*)(((unsigned long long)hi << 32) | lo);
}
namespace pg8 {
#define PG8_LAS __attribute__((address_space(3)))
typedef unsigned short bf16_t;
typedef short bf16x8 __attribute__((ext_vector_type(8)));
typedef float f32x4 __attribute__((ext_vector_type(4)));
typedef unsigned u32x4 __attribute__((ext_vector_type(4)));
constexpr int BM = 256, BK = 64, HALF = 128, HTB = HALF * BK * 2  , STAGE_BYTES = 8 * HTB, NXCD = 8, WGM = 8;

__host__ __device__ __forceinline__ int lds_byte(int r, int c) { const int st = (r >> 4) * 2 + (c >> 5), rr = r & 15, cc = c & 31, ob = rr * 64 + cc * 2; return st * 1024 + (ob ^ (((ob >> 9) & 1) << 5)); }
__host__ __device__ __forceinline__ void stage_rc(int b, int& R, int& C) { const int st = b / 1024, sb = b % 1024, swz = sb ^ (((sb >> 9) & 1) << 5); R = (st >> 1) * 16 + swz / 64; C = (st & 1) * 32 + (swz % 64) / 2; }
__host__ __device__ __forceinline__ int perm32(int rho) { const int n = rho >> 4, i = rho & 15; return 8 * (i >> 2) + 4 * n + (i & 3); }

struct Unit { int pm, pn; };
struct Gemm { const bf16_t* A; const bf16_t* Bt; int M, N, K, w0; };

struct StaticOrder {
    int nM, nN, nwg, G, c;
    __host__ __device__ void init(int M, int N, int G_, int c_) { nM = M / BM; nN = N / BM; nwg = nM * nN; G = G_; c = c_; }
    __host__ __device__ bool next(int i, Unit& u) const {
        const long L = (long)i * G + c; if (L >= nwg) return false;
        int wgid = (int)L; { const int q = nwg / NXCD, r = nwg % NXCD, xcd = wgid % NXCD, off = wgid / NXCD; wgid = (xcd < r ? xcd * (q + 1) : r * (q + 1) + (xcd - r) * q) + off; }
        const int nig = WGM * nN, gid = wgid / nig, fm = gid * WGM, gsz = (nM - fm) < WGM ? (nM - fm) : WGM;
        u.pm = fm + ((wgid % nig) % gsz); u.pn = (wgid % nig) / gsz; return true;
    }
    __device__ __forceinline__ void a_ready(const Unit&) const {}
    __device__ __forceinline__ void done(const Unit&) const {}
};
__device__ __forceinline__ unsigned cvt_pk_bf16(float lo, float hi) { unsigned r; asm volatile("v_cvt_pk_bf16_f32 %0, %1, %2" : "=v"(r) : "v"(lo), "v"(hi)); return r; }

struct MoeOrder {
    int NT, NC, G, c;
    __device__ __forceinline__ bool next(int i, Unit& u) const {
        const int L = i * G + c, per = NT * NC; if (L >= 16 * per) return false;
        const int e = L / per, q = L - e * per; u.pm = e * 17 + q / NC; u.pn = e * NC + q % NC; return true;
    }
    __device__ __forceinline__ void a_ready(const Unit&) const {}
    __device__ __forceinline__ void done(const Unit&) const {}
};

__device__ __forceinline__ float fast_exp(float x) { return __builtin_amdgcn_exp2f(x * 1.4426950408889634f); }
__device__ __forceinline__ float fast_sigmoid(float x) { return __builtin_amdgcn_rcpf(1.0f + fast_exp(-x)); }

struct EpiIn {
    static constexpr bool PERM = true, AFTER_DRAIN = false;
    bf16_t* P; const float* lb; const float* cs;
    __device__ __forceinline__ void operator()(const f32x4 (&acc)[2][2][4][2], const Unit& u, int wr, int wc, int fr, int fq) const {
        const int grp = u.pn >> 1;
        const int row0 = u.pm * BM + wr * 64 + fr, col0 = u.pn * BM + wc * 32 + 8 * fq;
        if (grp == 0 || grp == 3 || grp == 7) {
#pragma unroll
            for (int ai = 0; ai < 2; ++ai)
#pragma unroll
                for (int m = 0; m < 4; ++m) { bf16_t* rowp = P + (size_t)(row0 + ai * HALF + m * 16) * INW + col0;
#pragma unroll
                    for (int bj = 0; bj < 2; ++bj) { const f32x4 v0 = acc[ai][bj][m][0], v1 = acc[ai][bj][m][1];
                        u32x4 w; w.x = cvt_pk_bf16(v0[0], v0[1]); w.y = cvt_pk_bf16(v0[2], v0[3]); w.z = cvt_pk_bf16(v1[0], v1[1]); w.w = cvt_pk_bf16(v1[2], v1[3]);
                        *(u32x4*)(rowp + bj * HALF) = w; } }
        } else if (grp == 1 || grp == 2) {
            const int cg = col0 - grp * 512;
            f32x4 lbv[2][2];
#pragma unroll
            for (int bj = 0; bj < 2; ++bj)
#pragma unroll
                for (int n = 0; n < 2; ++n) lbv[bj][n] = *(const f32x4*)(lb + cg + bj * HALF + 4 * n);
#pragma unroll
            for (int ai = 0; ai < 2; ++ai)
#pragma unroll
                for (int m = 0; m < 4; ++m) { bf16_t* rowp = P + (size_t)(row0 + ai * HALF + m * 16) * INW + col0;
#pragma unroll
                    for (int bj = 0; bj < 2; ++bj) { f32x4 v[2];
#pragma unroll
                        for (int n = 0; n < 2; ++n)
#pragma unroll
                            for (int j = 0; j < 4; ++j) { const float l0 = lbv[bj][n][j]; const float f = l0 + (1.0f - l0) * fast_sigmoid(acc[ai][bj][m][n][j]);
                                #ifndef SCAN_LOG2
                                v[n][j] = __builtin_amdgcn_logf(fmaxf(f, 1e-30f)) * 0.6931471805599453f; }
#else
                                v[n][j] = __builtin_amdgcn_logf(fmaxf(f, 1e-30f)); }
#endif
                        u32x4 w; w.x = cvt_pk_bf16(v[0][0], v[0][1]); w.y = cvt_pk_bf16(v[0][2], v[0][3]); w.z = cvt_pk_bf16(v[1][0], v[1][1]); w.w = cvt_pk_bf16(v[1][2], v[1][3]);
                        *(u32x4*)(rowp + bj * HALF) = w; } }
        } else if (grp == 4 || grp == 8) {
#pragma unroll
            for (int ai = 0; ai < 2; ++ai)
#pragma unroll
                for (int m = 0; m < 4; ++m) { bf16_t* rowp = P + (size_t)(row0 + ai * HALF + m * 16) * INW + col0;
#pragma unroll
                    for (int bj = 0; bj < 2; ++bj) { f32x4 v[2];
#pragma unroll
                        for (int n = 0; n < 2; ++n)
#pragma unroll
                            for (int j = 0; j < 4; ++j) { const float z = acc[ai][bj][m][n][j]; v[n][j] = z * fast_sigmoid(z); }
                        u32x4 w; w.x = cvt_pk_bf16(v[0][0], v[0][1]); w.y = cvt_pk_bf16(v[0][2], v[0][3]); w.z = cvt_pk_bf16(v[1][0], v[1][1]); w.w = cvt_pk_bf16(v[1][2], v[1][3]);
                        *(u32x4*)(rowp + bj * HALF) = w; } }
        } else {
            const float sc = (grp == 6) ? 0.08838834764831845f : 1.0f;
            const int f0 = 16 * (wc & 1) + 4 * fq;
#pragma unroll
            for (int ai = 0; ai < 2; ++ai)
#pragma unroll
                for (int m = 0; m < 4; ++m) { const int row = row0 + ai * HALF + m * 16; bf16_t* rowp = P + (size_t)row * INW + col0;
                    int g = row; if (g >= LTOT) g -= LTOT;
                    int pos = 0; if (g >= CTX) { const int nn = g - CTX; pos = (wc < 2) ? (nn >> 6) : (nn & 63); }
                    const f32x4 t0 = *(const f32x4*)(cs + (size_t)(pos * 32 + f0) * 2), t1 = *(const f32x4*)(cs + (size_t)(pos * 32 + f0) * 2 + 4);
#pragma unroll
                    for (int bj = 0; bj < 2; ++bj) { const f32x4 v0 = acc[ai][bj][m][0] * sc, v1 = acc[ai][bj][m][1] * sc;
                        const float a0 = v0[0] * t0[0] - v0[1] * t0[1], a1 = v0[0] * t0[1] + v0[1] * t0[0];
                        const float a2 = v0[2] * t0[2] - v0[3] * t0[3], a3 = v0[2] * t0[3] + v0[3] * t0[2];
                        const float b0 = v1[0] * t1[0] - v1[1] * t1[1], b1 = v1[0] * t1[1] + v1[1] * t1[0];
                        const float b2 = v1[2] * t1[2] - v1[3] * t1[3], b3 = v1[2] * t1[3] + v1[3] * t1[2];
                        u32x4 w; w.x = cvt_pk_bf16(a0, a1); w.y = cvt_pk_bf16(a2, a3); w.z = cvt_pk_bf16(b0, b1); w.w = cvt_pk_bf16(b2, b3);
                        *(u32x4*)(rowp + bj * HALF) = w; } }
        }
    }
};

struct EpiOut {
    static constexpr bool PERM = false, AFTER_DRAIN = false;
    float* X; const float* xin; const float* cin; const float* gt;
    __device__ __forceinline__ void operator()(const f32x4 (&acc)[2][2][4][2], const Unit& u, int wr, int wc, int fr, int fq) const {
        const int b = u.pm / 65, tb = u.pm - b * 65, which = (tb == 0) ? 2 : b;
        const int row0 = u.pm * BM + wr * 64 + fr, col0 = u.pn * BM + wc * 32 + 4 * fq;
        f32x4 gv[2][2];
#pragma unroll
        for (int bj = 0; bj < 2; ++bj)
#pragma unroll
            for (int n = 0; n < 2; ++n) gv[bj][n] = *(const f32x4*)(gt + which * 6144 + col0 + bj * HALF + n * 16);
#pragma unroll
        for (int ai = 0; ai < 2; ++ai)
#pragma unroll
            for (int m = 0; m < 4; ++m) { const int row = row0 + ai * HALF + m * 16; float* op = X + (size_t)row * D + col0;
                const float* bp = op;
                if (xin) { const int g = row - b * LTOT; bp = (g < CTX ? cin + (size_t)(b * CTX + g) * D : xin + (size_t)(b * SEQ + g - CTX) * D) + col0; }
#pragma unroll
                for (int bj = 0; bj < 2; ++bj)
#pragma unroll
                    for (int n = 0; n < 2; ++n) { const f32x4 bs = *(const f32x4*)(bp + bj * HALF + n * 16); *(f32x4*)(op + bj * HALF + n * 16) = bs + gv[bj][n] * acc[ai][bj][m][n]; } }
    }
};

constexpr float F8_SA = 8.0f, F8_SW = 64.0f, F8_SH = 4.0f;
__device__ __forceinline__ unsigned pk4_fp8(float a, float b, float c, float d) {
    a = __builtin_amdgcn_fmed3f(a, -448.f, 448.f); b = __builtin_amdgcn_fmed3f(b, -448.f, 448.f); c = __builtin_amdgcn_fmed3f(c, -448.f, 448.f); d = __builtin_amdgcn_fmed3f(d, -448.f, 448.f);
    unsigned w = 0; w = __builtin_amdgcn_cvt_pk_fp8_f32(a, b, w, false); w = __builtin_amdgcn_cvt_pk_fp8_f32(c, d, w, true); return w; }
struct EpiGU {
    static constexpr bool PERM = true, AFTER_DRAIN = false;
    unsigned char* HID;
    __device__ __forceinline__ void operator()(const f32x4 (&acc)[2][2][4][2], const Unit& u, int wr, int wc, int fr, int fq) const {
        const int row0 = u.pm * BM + wr * 64 + fr, col0 = (u.pn & 15) * HALF + wc * 32 + 8 * fq;
        constexpr float inv = 1.0f / (F8_SA * F8_SW);
#pragma unroll
        for (int ai = 0; ai < 2; ++ai)
#pragma unroll
            for (int m = 0; m < 4; ++m) { unsigned char* rowp = HID + (size_t)(row0 + ai * HALF + m * 16) * FF + col0; f32x4 v[2];
#pragma unroll
                for (int n = 0; n < 2; ++n)
#pragma unroll
                    for (int j = 0; j < 4; ++j) { const float g = acc[ai][0][m][n][j] * inv; v[n][j] = g * fast_sigmoid(g) * (acc[ai][1][m][n][j] * (inv * F8_SH)); }
                u32x2 w; w.x = pk4_fp8(v[0][0], v[0][1], v[0][2], v[0][3]); w.y = pk4_fp8(v[1][0], v[1][1], v[1][2], v[1][3]);
                *(u32x2*)rowp = w; }
    }
};

struct EpiDown {
    static constexpr bool PERM = true, AFTER_DRAIN = false;
    bf16_t* YS;
    __device__ __forceinline__ void operator()(const f32x4 (&acc)[2][2][4][2], const Unit& u, int wr, int wc, int fr, int fq) const {
        const int row0 = u.pm * BM + wr * 64 + fr, col0 = (u.pn & 3) * BM + wc * 32 + 8 * fq;
        constexpr float gg = 1.0f / (F8_SH * F8_SW);
#pragma unroll
        for (int ai = 0; ai < 2; ++ai)
#pragma unroll
            for (int m = 0; m < 4; ++m) { bf16_t* rowp = YS + (size_t)(row0 + ai * HALF + m * 16) * D + col0;
#pragma unroll
                for (int bj = 0; bj < 2; ++bj) { const f32x4 v0 = acc[ai][bj][m][0] * gg, v1 = acc[ai][bj][m][1] * gg;
                    u32x4 w; w.x = cvt_pk_bf16(v0[0], v0[1]); w.y = cvt_pk_bf16(v0[2], v0[3]); w.z = cvt_pk_bf16(v1[0], v1[1]); w.w = cvt_pk_bf16(v1[2], v1[3]);
                    *(u32x4*)(rowp + bj * HALF) = w; } }
    }
};

typedef int i32x4v __attribute__((ext_vector_type(4)));
typedef int i32x8v __attribute__((ext_vector_type(8)));
__device__ __forceinline__ i32x8v cat8(bf16x8 lo, bf16x8 hi) { const i32x4v a = __builtin_bit_cast(i32x4v, lo), b = __builtin_bit_cast(i32x4v, hi); return __builtin_shufflevector(a, b, 0, 1, 2, 3, 4, 5, 6, 7); }
template <class Epi, class Sched, bool GATHER>
__device__ __forceinline__ void gemm_phase_f8(PG8_LAS unsigned char* lds, const Gemm g, const Sched& S, const Epi& E, const int* rowmap) {
    const int tid = opaque_tid(g.w0), wid = __builtin_amdgcn_readfirstlane(tid >> 6), lane = tid & 63, wr = wid >> 2, wc = wid & 3, fr = lane & 15, fq = lane >> 4;
    const int rowb = g.K, nt = rowb / 128;
    unsigned vA0[2], vA1[2], voffB[2];
#pragma unroll
    for (int i = 0; i < 2; ++i) { int R, C; stage_rc(tid * 16 + i * 8192, R, C); const int Rb = Epi::PERM ? ((R & ~31) + perm32(R & 31)) : R;
        voffB[i] = (unsigned)(Rb * rowb + 2 * C); vA0[i] = (unsigned)(R * rowb + 2 * C); vA1[i] = vA0[i]; }
    const size_t kstep = 128;
    const size_t hstep = (size_t)HALF * rowb;
    const size_t tstep = 2 * hstep;
    const unsigned ldsw = (unsigned)wid * 1024u;
    const int aoff = lds_byte(wr * 64 + fr, fq * 8), boff = lds_byte(wc * 32 + fr, fq * 8);
    constexpr int GOFF = STAGE_BYTES;
#define PG8_SA(b, h) (((b) * 2 + (h)) * HTB)
#define PG8_SB(b, h) ((4 + (b) * 2 + (h)) * HTB)
#define PG8_STAGE(bufoff, gbase, voff) do { _Pragma("unroll") for (int _i = 0; _i < 2; ++_i) { unsigned _o = (voff)[_i]; asm volatile("" : "+v"(_o)); \
        __builtin_amdgcn_global_load_lds((const unsigned*)((const char*)(gbase) + _o), (PG8_LAS unsigned*)(lds + (bufoff) + ldsw + _i * 8192), 16, 0, 0); } } while (0)
#define PG8_STAGE_A(bufoff, kbase, h) do { if constexpr (GATHER) { if (h) PG8_STAGE(bufoff, kbase, vA1); else PG8_STAGE(bufoff, kbase, vA0); } else PG8_STAGE(bufoff, (kbase) + (h) * hstep, vA0); } while (0)
#define PG8_GIDX_ISSUE(pm_) do { const int _t = opaque_tid(g.w0); _Pragma("unroll") for (int _i = 0; _i < 2; ++_i) { int R, C; stage_rc(_t * 16 + _i * 8192, R, C); _Pragma("unroll") for (int _h = 0; _h < 2; ++_h) \
        __builtin_amdgcn_global_load_lds((const unsigned*)(rowmap + (pm_) * BM + _h * HALF + R), (PG8_LAS unsigned*)(lds + GOFF + ldsw + (_h * 2 + _i) * 256), 4, 0, 0); } } while (0)
#define PG8_GIDX_TAKE() do { const int _t = opaque_tid(g.w0); _Pragma("unroll") for (int _i = 0; _i < 2; ++_i) { int R, C; stage_rc(_t * 16 + _i * 8192, R, C); \
        vA0[_i] = *(const PG8_LAS unsigned*)(lds + GOFF + ldsw + (0 * 2 + _i) * 256 + (_t & 63) * 4) * (unsigned)rowb + (unsigned)(2 * C); \
        vA1[_i] = *(const PG8_LAS unsigned*)(lds + GOFF + ldsw + (1 * 2 + _i) * 256 + (_t & 63) * 4) * (unsigned)rowb + (unsigned)(2 * C); } } while (0)
#define PG8_LDA(dst, b, h) do { _Pragma("unroll") for (int m = 0; m < 4; ++m) _Pragma("unroll") for (int k = 0; k < 2; ++k) dst[m][k] = *(const PG8_LAS bf16x8*)(lds + PG8_SA(b, h) + aoff + m * 2048 + k * 1024); } while (0)
#define PG8_LDB(dst, b, h) do { _Pragma("unroll") for (int n = 0; n < 2; ++n) _Pragma("unroll") for (int k = 0; k < 2; ++k) dst[n][k] = *(const PG8_LAS bf16x8*)(lds + PG8_SB(b, h) + boff + n * 2048 + k * 1024); } while (0)
#define PG8_MMA(ai, bj, At, Bt) do { __builtin_amdgcn_s_setprio(1); _Pragma("unroll") for (int m = 0; m < 4; ++m) _Pragma("unroll") for (int n = 0; n < 2; ++n) \
        acc[ai][bj][m][n] = __builtin_amdgcn_mfma_scale_f32_16x16x128_f8f6f4(cat8(Bt[n][0], Bt[n][1]), cat8(At[m][0], At[m][1]), acc[ai][bj][m][n], 0, 0, 0, 0x7f7f7f7f, 0, 0x7f7f7f7f); __builtin_amdgcn_s_setprio(0); } while (0)
#define PG8_WAIT_V(n) asm volatile("s_waitcnt vmcnt(" #n ")" ::: "memory")
#define PG8_WAIT_L(n) asm volatile("s_waitcnt lgkmcnt(" #n ")" ::: "memory")
#define PG8_BAR __builtin_amdgcn_s_barrier()
#define PG8_SCHED __builtin_amdgcn_sched_barrier(0)
    Unit cur, nxt; int ui = 0;
    if (!S.next(0, cur)) return;
    f32x4 acc[2][2][4][2];
#pragma unroll
    for (int a = 0; a < 2; ++a)
#pragma unroll
        for (int b = 0; b < 2; ++b)
#pragma unroll
            for (int m = 0; m < 4; ++m)
#pragma unroll
                for (int n = 0; n < 2; ++n) acc[a][b][m][n] = (f32x4){0.f, 0.f, 0.f, 0.f};
    bf16x8 At[4][2], B0[2][2], B1[2][2];
    const char* cA; const char* cB = (const char*)g.Bt + (size_t)cur.pn * tstep;
    if constexpr (GATHER) { cA = (const char*)g.A; PG8_GIDX_ISSUE(cur.pm); PG8_WAIT_V(0); PG8_GIDX_TAKE(); }
    else cA = (const char*)g.A + (size_t)cur.pm * tstep;
    PG8_STAGE(PG8_SB(0, 0), cB, voffB); PG8_STAGE(PG8_SB(0, 1), cB + hstep, voffB); PG8_STAGE_A(PG8_SA(0, 0), cA, 0); PG8_STAGE_A(PG8_SA(0, 1), cA, 1);
    if (wr == 1) PG8_BAR;
    PG8_WAIT_V(2); PG8_BAR;
    PG8_STAGE(PG8_SB(1, 0), cB + kstep, voffB); PG8_STAGE_A(PG8_SA(1, 0), cA + kstep, 0); PG8_STAGE(PG8_SB(1, 1), cB + hstep + kstep, voffB);
    PG8_WAIT_V(6); PG8_BAR;
    for (;;) {
        const bool has_next = S.next(ui + 1, nxt);
        const char* nA; const char* nB = has_next ? (const char*)g.Bt + (size_t)nxt.pn * tstep : cB;
        if constexpr (GATHER) { nA = cA; if (has_next) PG8_GIDX_ISSUE(nxt.pm); }
        else nA = has_next ? (const char*)g.A + (size_t)nxt.pm * tstep : cA;
#pragma unroll 1
        for (int t = 0; t < nt; t += 2) {
            const bool last = (t == nt - 2);
            const char* a1 = cA + (size_t)(t + 1) * kstep;
            const char* a2 = last ? nA : cA + (size_t)(t + 2) * kstep; const char* b2 = last ? nB : cB + (size_t)(t + 2) * kstep;
            const char* a3 = a2 + kstep; const char* b3 = b2 + kstep;
            PG8_LDB(B0, 0, 0); PG8_LDB(B1, 0, 1); PG8_SCHED; PG8_LDA(At, 0, 0); PG8_STAGE_A(PG8_SA(1, 1), a1, 1);
            if constexpr (GATHER) { if (last && has_next) PG8_GIDX_TAKE(); }
            PG8_WAIT_V(8); PG8_WAIT_L(0); PG8_BAR; PG8_MMA(0, 0, At, B0); PG8_MMA(0, 1, At, B1); PG8_BAR; PG8_SCHED;
            PG8_LDA(At, 0, 1); PG8_STAGE(PG8_SB(0, 0), b2, voffB); PG8_STAGE(PG8_SB(0, 1), b2 + hstep, voffB); PG8_STAGE_A(PG8_SA(0, 0), a2, 0);
            PG8_WAIT_V(8); PG8_WAIT_L(0); PG8_BAR; PG8_MMA(1, 0, At, B0); PG8_MMA(1, 1, At, B1); PG8_BAR; PG8_SCHED;
            PG8_LDB(B0, 1, 0); PG8_LDB(B1, 1, 1); PG8_SCHED; PG8_LDA(At, 1, 0); PG8_STAGE_A(PG8_SA(0, 1), a2, 1);
            PG8_WAIT_V(8); PG8_WAIT_L(0); PG8_BAR; PG8_MMA(0, 0, At, B0); PG8_MMA(0, 1, At, B1); PG8_BAR; PG8_SCHED;
            PG8_LDA(At, 1, 1); PG8_STAGE(PG8_SB(1, 0), b3, voffB); PG8_STAGE(PG8_SB(1, 1), b3 + hstep, voffB); PG8_STAGE_A(PG8_SA(1, 0), a3, 0);
            PG8_WAIT_V(8); PG8_WAIT_L(0); PG8_BAR; PG8_MMA(1, 0, At, B0); PG8_MMA(1, 1, At, B1); PG8_BAR; PG8_SCHED;
        }
        if (wr == 0) PG8_BAR;
        { const int l2_ = opaque_tid(g.w0) & 63; E(acc, cur, wr, wc, l2_ & 15, l2_ >> 4); }
        if (!has_next) break;
#pragma unroll
        for (int a = 0; a < 2; ++a)
#pragma unroll
            for (int b = 0; b < 2; ++b)
#pragma unroll
                for (int m = 0; m < 4; ++m)
#pragma unroll
                    for (int n = 0; n < 2; ++n) acc[a][b][m][n] = (f32x4){0.f, 0.f, 0.f, 0.f};
        cur = nxt; cA = nA; cB = nB; ++ui;
        if (wr == 1) PG8_BAR;
    }
    PG8_WAIT_V(0);
    PG8_BAR;
#undef PG8_SA
#undef PG8_SB
#undef PG8_STAGE
#undef PG8_STAGE_A
#undef PG8_GIDX_ISSUE
#undef PG8_GIDX_TAKE
#undef PG8_LDA
#undef PG8_LDB
#undef PG8_MMA
#undef PG8_WAIT_V
#undef PG8_WAIT_L
#undef PG8_BAR
#undef PG8_SCHED
}
template <class Epi, class Sched, bool ALIGN_EPI = false, bool SP2 = false>
__device__ __forceinline__ void gemm_phase(PG8_LAS unsigned char* lds, const Gemm g, const Sched& S, const Epi& E) {
    const int tid = opaque_tid(g.w0), wid = __builtin_amdgcn_readfirstlane(tid >> 6), lane = tid & 63, wr = wid >> 2, wc = wid & 3, fr = lane & 15, fq = lane >> 4;
    const int K = g.K, nt = K / BK;
    unsigned voffA[2], voffB[2];
#pragma unroll
    for (int i = 0; i < 2; ++i) { int R, C; stage_rc(tid * 16 + i * 8192, R, C); const int Rb = Epi::PERM ? ((R & ~31) + perm32(R & 31)) : R;
        voffA[i] = (unsigned)(R * K + C) * 2u; voffB[i] = (unsigned)(Rb * K + C) * 2u; }
    const size_t kstep = (size_t)(BK * 2);
    const size_t hstep = (size_t)HALF * K * 2;
    const size_t tstep = 2 * hstep;
    const unsigned ldsw = (unsigned)wid * 1024u;
    const int aoff = lds_byte(wr * 64 + fr, fq * 8), boff = lds_byte(wc * 32 + fr, fq * 8);
#define PG8_SA(b, h) (((b) * 2 + (h)) * HTB)
#define PG8_SB(b, h) ((4 + (b) * 2 + (h)) * HTB)
#define PG8_STAGE(bufoff, gbase, voff) do { _Pragma("unroll") for (int _i = 0; _i < 2; ++_i) \
        __builtin_amdgcn_global_load_lds((const unsigned*)((const char*)(gbase) + (voff)[_i]), (PG8_LAS unsigned*)(lds + (bufoff) + ldsw + _i * 8192), 16, 0, 0); } while (0)
#define PG8_LDA(dst, b, h) do { _Pragma("unroll") for (int m = 0; m < 4; ++m) _Pragma("unroll") for (int k = 0; k < 2; ++k) dst[m][k] = *(const PG8_LAS bf16x8*)(lds + PG8_SA(b, h) + aoff + m * 2048 + k * 1024); } while (0)
#define PG8_LDB(dst, b, h) do { _Pragma("unroll") for (int n = 0; n < 2; ++n) _Pragma("unroll") for (int k = 0; k < 2; ++k) dst[n][k] = *(const PG8_LAS bf16x8*)(lds + PG8_SB(b, h) + boff + n * 2048 + k * 1024); } while (0)
#define PG8_MMA(ai, bj, At, Bt) do { __builtin_amdgcn_s_setprio(1); _Pragma("unroll") for (int m = 0; m < 4; ++m) _Pragma("unroll") for (int n = 0; n < 2; ++n) _Pragma("unroll") for (int k = 0; k < 2; ++k) \
        acc[ai][bj][m][n] = __builtin_amdgcn_mfma_f32_16x16x32_bf16(Bt[n][k], At[m][k], acc[ai][bj][m][n], 0, 0, 0); __builtin_amdgcn_s_setprio(0); } while (0)
#define PG8_WAIT_V(n) asm volatile("s_waitcnt vmcnt(" #n ")" ::: "memory")
#define PG8_WAIT_L(n) asm volatile("s_waitcnt lgkmcnt(" #n ")" ::: "memory")
#define PG8_BAR __builtin_amdgcn_s_barrier()
#define PG8_SCHED __builtin_amdgcn_sched_barrier(0)
    Unit cur, nxt; int ui = 0;
    if (!S.next(0, cur)) return;
    f32x4 acc[2][2][4][2];
#pragma unroll
    for (int a = 0; a < 2; ++a)
#pragma unroll
        for (int b = 0; b < 2; ++b)
#pragma unroll
            for (int m = 0; m < 4; ++m)
#pragma unroll
                for (int n = 0; n < 2; ++n) acc[a][b][m][n] = (f32x4){0.f, 0.f, 0.f, 0.f};
    bf16x8 At[4][2], B0[2][2], B1[2][2];
    const char* cA = (const char*)g.A + (size_t)cur.pm * tstep; const char* cB = (const char*)g.Bt + (size_t)cur.pn * tstep;
    S.a_ready(cur);
    if constexpr (SP2) {
        PG8_STAGE(PG8_SB(0, 0), cB, voffB); PG8_STAGE(PG8_SB(0, 1), cB + hstep, voffB); PG8_STAGE(PG8_SA(0, 0), cA, voffA); PG8_STAGE(PG8_SA(0, 1), cA + hstep, voffA);
        if (wr == 1) PG8_BAR;
        PG8_WAIT_V(2); PG8_BAR;
        PG8_STAGE(PG8_SB(1, 0), cB + kstep, voffB); PG8_STAGE(PG8_SA(1, 0), cA + kstep, voffA); PG8_STAGE(PG8_SB(1, 1), cB + hstep + kstep, voffB);
        PG8_WAIT_V(6); PG8_BAR;
    } else {
        PG8_STAGE(PG8_SB(0, 0), cB, voffB); PG8_STAGE(PG8_SA(0, 0), cA, voffA); PG8_STAGE(PG8_SB(0, 1), cB + hstep, voffB); PG8_STAGE(PG8_SA(0, 1), cA + hstep, voffA);
        if (wr == 1) PG8_BAR;
        PG8_WAIT_V(4); PG8_BAR;
        PG8_STAGE(PG8_SB(1, 0), cB + kstep, voffB); PG8_STAGE(PG8_SA(1, 0), cA + kstep, voffA); PG8_STAGE(PG8_SB(1, 1), cB + hstep + kstep, voffB);
        PG8_WAIT_V(6); PG8_BAR;
    }
    for (;;) {
        const bool has_next = S.next(ui + 1, nxt);
        const char* nA = has_next ? (const char*)g.A + (size_t)nxt.pm * tstep : cA; const char* nB = has_next ? (const char*)g.Bt + (size_t)nxt.pn * tstep : cB;
        for (int t = 0; t < nt; t += 2) {
            const bool last = (t == nt - 2);
            const char* a1 = cA + (size_t)(t + 1) * kstep;
            const char* a2 = last ? nA : cA + (size_t)(t + 2) * kstep; const char* b2 = last ? nB : cB + (size_t)(t + 2) * kstep;
            const char* a3 = a2 + kstep; const char* b3 = b2 + kstep;
            if (last && has_next) S.a_ready(nxt);
            if constexpr (SP2) {
            PG8_LDB(B0, 0, 0); PG8_LDB(B1, 0, 1); PG8_SCHED; PG8_LDA(At, 0, 0); PG8_STAGE(PG8_SA(1, 1), a1 + hstep, voffA);
            PG8_WAIT_V(8); PG8_WAIT_L(0); PG8_BAR; PG8_MMA(0, 0, At, B0); PG8_MMA(0, 1, At, B1); PG8_BAR; PG8_SCHED;
            PG8_LDA(At, 0, 1); PG8_STAGE(PG8_SB(0, 0), b2, voffB); PG8_STAGE(PG8_SB(0, 1), b2 + hstep, voffB); PG8_STAGE(PG8_SA(0, 0), a2, voffA);
            PG8_WAIT_V(8); PG8_WAIT_L(0); PG8_BAR; PG8_MMA(1, 0, At, B0); PG8_MMA(1, 1, At, B1); PG8_BAR; PG8_SCHED;
            PG8_LDB(B0, 1, 0); PG8_LDB(B1, 1, 1); PG8_SCHED; PG8_LDA(At, 1, 0); PG8_STAGE(PG8_SA(0, 1), a2 + hstep, voffA);
            PG8_WAIT_V(8); PG8_WAIT_L(0); PG8_BAR; PG8_MMA(0, 0, At, B0); PG8_MMA(0, 1, At, B1); PG8_BAR; PG8_SCHED;
            PG8_LDA(At, 1, 1); PG8_STAGE(PG8_SB(1, 0), b3, voffB); PG8_STAGE(PG8_SB(1, 1), b3 + hstep, voffB); PG8_STAGE(PG8_SA(1, 0), a3, voffA);
            PG8_WAIT_V(8); PG8_WAIT_L(0); PG8_BAR; PG8_MMA(1, 0, At, B0); PG8_MMA(1, 1, At, B1); PG8_BAR; PG8_SCHED;
            } else {
            PG8_LDB(B0, 0, 0); PG8_SCHED; PG8_LDA(At, 0, 0); PG8_STAGE(PG8_SA(1, 1), a1 + hstep, voffA);
            PG8_WAIT_L(8); PG8_BAR; PG8_WAIT_L(0); PG8_MMA(0, 0, At, B0); PG8_BAR; PG8_SCHED;
            PG8_LDB(B1, 0, 1); PG8_STAGE(PG8_SB(0, 0), b2, voffB);
            PG8_BAR; PG8_WAIT_L(0); PG8_MMA(0, 1, At, B1); PG8_BAR;
            PG8_LDA(At, 0, 1); PG8_STAGE(PG8_SA(0, 0), a2, voffA);
            PG8_BAR; PG8_WAIT_L(0); PG8_MMA(1, 0, At, B0); PG8_BAR; PG8_SCHED;
            PG8_STAGE(PG8_SB(0, 1), b2 + hstep, voffB);
            PG8_WAIT_V(6); PG8_BAR; PG8_MMA(1, 1, At, B1); PG8_BAR;
            PG8_LDB(B0, 1, 0); PG8_SCHED; PG8_LDA(At, 1, 0); PG8_STAGE(PG8_SA(0, 1), a2 + hstep, voffA);
            PG8_WAIT_L(8); PG8_BAR; PG8_WAIT_L(0); PG8_MMA(0, 0, At, B0); PG8_BAR; PG8_SCHED;
            PG8_LDB(B1, 1, 1); PG8_STAGE(PG8_SB(1, 0), b3, voffB);
            PG8_BAR; PG8_WAIT_L(0); PG8_MMA(0, 1, At, B1); PG8_BAR;
            PG8_LDA(At, 1, 1); PG8_STAGE(PG8_SA(1, 0), a3, voffA);
            PG8_BAR; PG8_WAIT_L(0); PG8_MMA(1, 0, At, B0); PG8_BAR; PG8_SCHED;
            PG8_STAGE(PG8_SB(1, 1), b3 + hstep, voffB);
            PG8_WAIT_V(6); PG8_BAR; PG8_MMA(1, 1, At, B1); PG8_BAR;
            }
        }
        if constexpr (ALIGN_EPI) { if (wr == 0) PG8_BAR; }
        if constexpr (!Epi::AFTER_DRAIN) { E(acc, cur, wr, wc, fr, fq); S.done(cur); }
        if (!has_next) break;
#pragma unroll
        for (int a = 0; a < 2; ++a)
#pragma unroll
            for (int b = 0; b < 2; ++b)
#pragma unroll
                for (int m = 0; m < 4; ++m)
#pragma unroll
                    for (int n = 0; n < 2; ++n) acc[a][b][m][n] = (f32x4){0.f, 0.f, 0.f, 0.f};
        cur = nxt; cA = nA; cB = nB; ++ui;
        if constexpr (ALIGN_EPI) { if (wr == 1) PG8_BAR; }
    }
    PG8_WAIT_V(0);
    if constexpr (!ALIGN_EPI) { if (wr == 0) PG8_BAR; }
    PG8_BAR;
    if constexpr (Epi::AFTER_DRAIN) { E.fused(acc, cur, wr, wc, fr, fq, lds, wid, lane); S.done(cur); }
#undef PG8_SA
#undef PG8_SB
#undef PG8_STAGE
#undef PG8_LDA
#undef PG8_LDB
#undef PG8_MMA
#undef PG8_WAIT_V
#undef PG8_WAIT_L
#undef PG8_BAR
#undef PG8_SCHED
}
}
#define XB_TMO      128
#define XB_XCNT(j)  (256  + 64 * (j))
#define XB_XSUB(j)  (1280 + 64 * (j))
#define XB_XGEN(j)  (2304 + 64 * (j))
#define XB_TOP      3328
#define XB_TOPGEN   3392
#define XCD_BAR_WORDS 3456
#define XB_SPIN_CAP (1u << 18)

__device__ __forceinline__ unsigned xb_ld(unsigned* p)              { return __hip_atomic_load(p, __ATOMIC_RELAXED, __HIP_MEMORY_SCOPE_AGENT); }
__device__ __forceinline__ unsigned xb_add(unsigned* p, unsigned v) { return __hip_atomic_fetch_add(p, v, __ATOMIC_RELAXED, __HIP_MEMORY_SCOPE_AGENT); }
__device__ __forceinline__ unsigned xb_xcc_id() { return (unsigned)__builtin_amdgcn_s_getreg((3 << 11) | 20) & 0xFu; }
#define XB_SPIN(cond, bar) do { unsigned _sp = 0; while (cond) { __builtin_amdgcn_s_sleep(1); \
    if ((++_sp & 255u) == 0u) { if (xb_ld(&(bar)[XB_TMO])) break; if (_sp > XB_SPIN_CAP) { atomicAdd(&(bar)[XB_TMO], 1u); break; } } } } while (0)

struct XcdBarrier {
    unsigned* bar; unsigned x;
    volatile LAS unsigned* st;
};

__device__ __forceinline__ XcdBarrier xcd_barrier_post(unsigned* bar, volatile LAS unsigned* st) {
    XcdBarrier b; b.bar = bar; b.x = xb_xcc_id(); b.st = st;
    if (threadIdx.x == 0) (void)xb_add(&bar[XB_XCNT(b.x)], 1u);
    return b;
}
__device__ __forceinline__ void xcd_barrier_complete(unsigned* bar, unsigned x, unsigned& nloc, unsigned& nx) {
    const unsigned G = gridDim.x * gridDim.y * gridDim.z;
    unsigned sum, cnt, mine, sp = 0u;
    for (;;) {
        sum = 0u; cnt = 0u; mine = 0u;
#pragma unroll
        for (unsigned j = 0; j < 16; ++j) { const unsigned c = xb_ld(&bar[XB_XCNT(j)]); sum += c; cnt += (c > 0u) ? 1u : 0u; mine = (j == x) ? c : mine; }
        if (sum == G) break;
        __builtin_amdgcn_s_sleep(1);
        if ((++sp & 255u) == 0u) { if (xb_ld(&bar[XB_TMO])) break; if (sp > XB_SPIN_CAP) { atomicAdd(&bar[XB_TMO], 1u); break; } }
    }
    nloc = mine > 0u ? mine : 1u; nx = cnt > 0u ? cnt : 1u;
}

__device__ __forceinline__ void xcd_barrier(const XcdBarrier& b) {
    asm volatile("s_waitcnt vmcnt(0)" ::: "memory");
    __syncthreads();
    if (threadIdx.x == 0) {
        unsigned* bar = b.bar;
        __builtin_amdgcn_s_waitcnt(0);
        unsigned nloc = b.st[0], nx = b.st[1];
        if (nloc == 0u) { xcd_barrier_complete(bar, b.x, nloc, nx); b.st[0] = nloc; b.st[1] = nx; }
        const unsigned old = xb_add(&bar[XB_XSUB(b.x)], 1u);
        const unsigned gen = old / nloc;
        if (old + 1u == (gen + 1u) * nloc) {
            __builtin_amdgcn_fence(__ATOMIC_RELEASE, "agent");
            asm volatile("s_waitcnt vmcnt(0)" ::: "memory");
            const unsigned og = xb_add(&bar[XB_TOP], 1u);
            const unsigned tg = og / nx;
            if (og + 1u == (tg + 1u) * nx) xb_add(&bar[XB_TOPGEN], 1u);
            else XB_SPIN(xb_ld(&bar[XB_TOPGEN]) == tg, bar);
            __builtin_amdgcn_fence(__ATOMIC_ACQUIRE, "agent");
            xb_add(&bar[XB_XGEN(b.x)], 1u);
            asm volatile("s_waitcnt vmcnt(0)" ::: "memory");
        } else {
            XB_SPIN(xb_ld(&bar[XB_XGEN(b.x)]) == gen, bar);
            __builtin_amdgcn_fence(__ATOMIC_ACQUIRE, "agent");
            asm volatile("s_waitcnt vmcnt(0)" ::: "memory");
        }
    }
    __syncthreads();
}

using pg8::bf16_t; using pg8::bf16x8; using pg8::f32x4; using pg8::u32x4; using pg8::cvt_pk_bf16; using pg8::fast_exp;

#define BAR_LDS() do { asm volatile("s_waitcnt lgkmcnt(0)" ::: "memory"); __builtin_amdgcn_s_barrier(); asm volatile("" ::: "memory"); } while (0)
#define BAR_ALL() do { asm volatile("s_waitcnt vmcnt(0) lgkmcnt(0)" ::: "memory"); __builtin_amdgcn_s_barrier(); asm volatile("" ::: "memory"); } while (0)

#ifdef PROBE_SHFL
__device__ __forceinline__ float shx(float v, int mask, int lane) { (void)lane; return __shfl_xor(v, mask); }
__device__ __forceinline__ unsigned shxu(unsigned v, int mask, int lane) { (void)lane; return __shfl_xor(v, mask); }
__device__ __forceinline__ unsigned shupu(unsigned v, int d, int lane) { (void)lane; return __shfl_up(v, d); }
#else
__device__ __forceinline__ float shx(float v, int mask, int lane) { return __builtin_bit_cast(float, __builtin_amdgcn_ds_bpermute((lane ^ mask) << 2, __builtin_bit_cast(int, v))); }
__device__ __forceinline__ unsigned shxu(unsigned v, int mask, int lane) { return (unsigned)__builtin_amdgcn_ds_bpermute((lane ^ mask) << 2, (int)v); }
__device__ __forceinline__ unsigned shupu(unsigned v, int d, int lane) { return (unsigned)__builtin_amdgcn_ds_bpermute((lane - d) << 2, (int)v); }
#endif
__device__ __forceinline__ float wave_sum(float v, int lane) {
#pragma unroll
    for (int o = 1; o < 64; o <<= 1) v += shx(v, o, lane);
    return v;
}
__device__ __forceinline__ float bf_lo(unsigned u) { return __uint_as_float(u << 16); }
__device__ __forceinline__ float bf_hi(unsigned u) { return __uint_as_float(u & 0xffff0000u); }

struct Args { const float* in[18]; float* out; unsigned char* ws; };
struct Ctx { LAS unsigned char* lds; int w0;
    __device__ __forceinline__ const float* in(int i) const { return ldptr(lds, i); }
    __device__ __forceinline__ float* out() const { return (float*)ldptr(lds, 18); }
    __device__ __forceinline__ unsigned char* ws() const { return (unsigned char*)ldptr(lds, 19); } };
#define PHASE_IDS() const int tid = opaque_tid(a.w0), lane = tid & 63, wave = __builtin_amdgcn_readfirstlane(tid >> 6); (void)tid; (void)lane; (void)wave
enum { I_X = 0, I_C, I_CTX, I_CCTX, I_WADA, I_BADA, I_GMIX, I_GFFN, I_WIN, I_WOUT, I_LBL, I_ONORM, I_RDEC, I_WR, I_WEG, I_WEU, I_WED, I_GFIN };

__device__ __forceinline__ void tr_item(const float* W, int N, bf16_t* WT, int Kd, int k0, int n0, int drow0, LAS float* scr, int lane) {
    f32x4 v[16];
    const float* src = W + (size_t)(k0 + (lane >> 4)) * N + n0 + (lane & 15) * 4;
#pragma unroll
    for (int i = 0; i < 16; ++i) v[i] = *(const f32x4*)(src + (size_t)(i * 4) * N);
#pragma unroll
    for (int i = 0; i < 16; ++i) { LAS float* d = scr + (i * 4 + (lane >> 4)) * 65 + (lane & 15) * 4; d[0] = v[i][0]; d[1] = v[i][1]; d[2] = v[i][2]; d[3] = v[i][3]; }
    asm volatile("s_waitcnt lgkmcnt(0)" ::: "memory");
    const int c = lane & 7;
#pragma unroll
    for (int j = 0; j < 8; ++j) { const int n = j * 8 + (lane >> 3); const LAS float* s = scr + (8 * c) * 65 + n;
        u32x4 o; o.x = cvt_pk_bf16(s[0], s[65]); o.y = cvt_pk_bf16(s[2 * 65], s[3 * 65]); o.z = cvt_pk_bf16(s[4 * 65], s[5 * 65]); o.w = cvt_pk_bf16(s[6 * 65], s[7 * 65]);
        *(u32x4*)(WT + (size_t)(drow0 + n) * Kd + k0 + 8 * c) = o; }
    asm volatile("s_waitcnt lgkmcnt(0)" ::: "memory");
}

__device__ __forceinline__ void tr_item8(const float* W, int N, unsigned char* WT, int Kd, int k0, int n0, int drow0, LAS float* scr, int lane, float scale) {
    f32x4 v[16];
    const float* src = W + (size_t)(k0 + (lane >> 4)) * N + n0 + (lane & 15) * 4;
#pragma unroll
    for (int i = 0; i < 16; ++i) v[i] = *(const f32x4*)(src + (size_t)(i * 4) * N);
#pragma unroll
    for (int i = 0; i < 16; ++i) { LAS float* d = scr + (i * 4 + (lane >> 4)) * 65 + (lane & 15) * 4; d[0] = v[i][0] * scale; d[1] = v[i][1] * scale; d[2] = v[i][2] * scale; d[3] = v[i][3] * scale; }
    asm volatile("s_waitcnt lgkmcnt(0)" ::: "memory");
    const int c = lane & 3;
#pragma unroll
    for (int j = 0; j < 4; ++j) { const int n = j * 16 + (lane >> 2); const LAS float* s = scr + (16 * c) * 65 + n;
        u32x4 o; o.x = pg8::pk4_fp8(s[0], s[65], s[2 * 65], s[3 * 65]); o.y = pg8::pk4_fp8(s[4 * 65], s[5 * 65], s[6 * 65], s[7 * 65]);
        o.z = pg8::pk4_fp8(s[8 * 65], s[9 * 65], s[10 * 65], s[11 * 65]); o.w = pg8::pk4_fp8(s[12 * 65], s[13 * 65], s[14 * 65], s[15 * 65]);
        *(u32x4*)(WT + (size_t)(drow0 + n) * Kd + k0 + 16 * c) = o; }
    asm volatile("s_waitcnt lgkmcnt(0)" ::: "memory");
}

__device__ __forceinline__ void p0_prologue(const Ctx& a) {
    PHASE_IDS(); LAS unsigned char* lds = launder_lds(a.lds); unsigned char* ws = a.ws(); const float* cin_ = a.in(I_C); const float* cctx_ = a.in(I_CCTX);
    LAS float* scr = (LAS float*)(lds + wave * 16640);
    LAS float* scond = (LAS float*)(lds + 8 * 16640);
    for (int i = tid; i < 3 * D; i += 512) { const int w = i >> 10, k = i & 1023; const float cv = (w < 2) ? cin_[w * D + k] : cctx_[k]; scond[i] = cv * pg8::fast_sigmoid(cv); }
    if (blockIdx.x == 0) { const int c = tid; const float* lg = a.in(I_LBL);
        const float l0 = lg[c], l1 = lg[512 + c], l2 = lg[1024 + c], l3 = lg[1536 + c]; const float mx = fmaxf(fmaxf(l0, l1), fmaxf(l2, l3));
        const float e0 = expf(l0 - mx), e1 = expf(l1 - mx), e2 = expf(l2 - mx), e3 = expf(l3 - mx), inv = 1.0f / (e0 + e1 + e2 + e3);
        float* lbs = (float*)(ws + WS_LBS); lbs[c] = 0.f; lbs[512 + c] = e1 * inv; lbs[1024 + c] = (e1 + e2) * inv; lbs[1536 + c] = (e1 + e2 + e3) * inv; }
    if (blockIdx.x >= 1 && blockIdx.x <= 16) { const int idx = (blockIdx.x - 1) * 512 + tid, pos = idx >> 5, f = idx & 31;
        const float invf = powf(10000.0f, -(float)f / 32.0f), ang = (float)pos * invf; float* cs = (float*)(ws + WS_ROPE); cs[idx * 2] = cosf(ang); cs[idx * 2 + 1] = sinf(ang); }
    BAR_LDS();
    const int gw = blockIdx.x * 8 + wave, NGW = gridDim.x * 8;
    for (int it = gw; it < 4 * 24 * 8; it += NGW) { const int l = it / 192, r = it % 192, cg = r >> 3, ks = r & 7; const int cols = cg * 256 + lane * 4;
        const float* wp = a.in(I_WADA) + ((size_t)l * D + ks * 128) * 6144 + cols; f32x4 a0 = {0, 0, 0, 0}, a1 = a0, a2 = a0;
#pragma unroll 8
        for (int kk = 0; kk < 128; ++kk) { const f32x4 w = *(const f32x4*)(wp + (size_t)kk * 6144); const int k = ks * 128 + kk; a0 += w * scond[k]; a1 += w * scond[D + k]; a2 += w * scond[2 * D + k]; }
        float* pp = (float*)(ws + WS_MODP) + (size_t)((l * 8 + ks) * 3) * 6144 + cols; *(f32x4*)pp = a0; *(f32x4*)(pp + 6144) = a1; *(f32x4*)(pp + 2 * 6144) = a2; }
    constexpr int I_IN = 16 * 72, I_OUT = 16 * 16, I_E = 512;
    constexpr int NIT = 4 * (I_IN + I_OUT) + 64 * 3 * I_E;
    for (int it = gw; it < NIT; it += NGW) {
        int r = it;
        if (r < 4 * I_IN) { const int l = r / I_IN, q = r % I_IN, kb = q / 72, nb = q % 72;
            tr_item(a.in(I_WIN) + (size_t)l * D * INW, INW, (bf16_t*)(ws + WS_WIN) + (size_t)l * INW * D, D, kb * 64, nb * 64, nb * 64, scr, lane); continue; }
        r -= 4 * I_IN;
        if (r < 4 * I_OUT) { const int l = r / I_OUT, q = r % I_OUT, kb = q / 16, nb = q % 16;
            tr_item(a.in(I_WOUT) + (size_t)l * D * D, D, (bf16_t*)(ws + WS_WOUT) + (size_t)l * D * D, D, kb * 64, nb * 64, nb * 64, scr, lane); continue; }
        r -= 4 * I_OUT;
        const int le = r / (3 * I_E), q3 = r % (3 * I_E), kind = q3 / I_E, q = q3 % I_E;
        if (kind < 2) { const int kb = q / 32, nb = q % 32, n0 = nb * 64;
            const int drow = 256 * (n0 >> 7) + (n0 & 127) + kind * 128;
            tr_item8(a.in(kind == 0 ? I_WEG : I_WEU) + (size_t)le * D * FF, FF, (unsigned char*)(ws + WS_WGU) + (size_t)le * 4096 * D, D, kb * 64, n0, drow, scr, lane, pg8::F8_SW);
        } else { const int kb = q / 16, nb = q % 16;
            tr_item8(a.in(I_WED) + (size_t)le * FF * D, D, (unsigned char*)(ws + WS_WD) + (size_t)le * D * FF, FF, kb * 64, nb * 64, nb * 64, scr, lane, pg8::F8_SW); }
    }
}

__device__ __forceinline__ void p0_finalize(const Ctx& a) {
    PHASE_IDS(); unsigned char* ws = a.ws(); const float* bada = a.in(I_BADA); const float* part = (const float*)(ws + WS_MODP); float* mods = (float*)(ws + WS_MODS);
    for (int i = blockIdx.x * 512 + tid; i < 4 * 3 * 6144; i += gridDim.x * 512) { const int l = i / (3 * 6144), r = i % (3 * 6144), w = r / 6144, j = r % 6144;
        float s = bada[l * 6144 + j];
#pragma unroll
        for (int ks = 0; ks < 8; ++ks) s += part[(size_t)((l * 8 + ks) * 3 + w) * 6144 + j];
        mods[i] = s; }
}

template <int MODE>
__device__ __forceinline__ void norm1_phase(const Ctx& a, int l) {
    PHASE_IDS(); unsigned char* ws = a.ws(); const float* in_x = a.in(I_X); const float* in_ctx = a.in(I_CTX); const float* gm = (MODE == 0) ? a.in(I_GMIX) + l * D : a.in(I_GFIN); float* outp = a.out(); const int gw = blockIdx.x * 8 + wave, NGW = gridDim.x * 8;
    const float* mods = (const float*)(ws + WS_MODS); float* X = (float*)(ws + WS_X); bf16_t* H = (bf16_t*)(ws + WS_H);
    const int* inv = (const int*)(ws + WS_INV); const bf16_t* YS = (const bf16_t*)(ws + WS_YS); const float* gate = (const float*)(ws + WS_ROWMAP) + MOE_ROWS;
    constexpr int NTOT = (MODE == 1) ? NB * SEQ : MROWS;
#define N1_ROWOF(n_) ((MODE == 1) ? (((n_) >> 14) * LTOT + CTX + ((n_) & (SEQ - 1))) : (n_))
#define N1_LOADROW(n_, v_, iv_) do { const int r_ = N1_ROWOF(n_); const int b_ = r_ >= LTOT ? 1 : 0, g_ = r_ - b_ * LTOT; \
        const float* src_ = (l == 0) ? (g_ < CTX ? in_ctx + (size_t)(b_ * CTX + g_) * D : in_x + (size_t)(b_ * SEQ + g_ - CTX) * D) : X + (size_t)r_ * D; \
        _Pragma("unroll") for (int j = 0; j < 4; ++j) v_[j] = *(const f32x4*)(src_ + lane * 4 + 256 * j); if (l != 0) iv_ = inv[r_ * 16 + (lane & 15)]; } while (0)
    f32x4 v[4]; int iv = -1; int n = gw;
    if (n < NTOT) N1_LOADROW(n, v, iv);
    for (; n < NTOT; n += NGW) {
        const int row = N1_ROWOF(n); const int b = row >= LTOT ? 1 : 0, g = row - b * LTOT; const bool isctx = g < CTX; const int which = isctx ? 2 : b;
        f32x4 vn[4]; int ivn = -1; const int nn = n + NGW;
        if (nn < NTOT) N1_LOADROW(nn, vn, ivn);
        if (l != 0) {
            unsigned vm = (unsigned)__builtin_amdgcn_ballot_w64(iv >= 0) & 0xffffu;
            f32x4 s[4] = {{0, 0, 0, 0}, {0, 0, 0, 0}, {0, 0, 0, 0}, {0, 0, 0, 0}};
            while (vm) {
                const int e0 = __builtin_ctz(vm); vm &= vm - 1; const bool has1 = vm != 0u; const int e1 = has1 ? __builtin_ctz(vm) : e0; if (has1) vm &= vm - 1;
                const int mr0 = __builtin_amdgcn_readlane(iv, e0), mr1 = __builtin_amdgcn_readlane(iv, e1);
                const float g0 = gate[mr0], g1 = has1 ? gate[mr1] : 0.f;
                const bf16_t* y0r = YS + (size_t)mr0 * D + lane * 4; const bf16_t* y1r = YS + (size_t)mr1 * D + lane * 4; u32x2 y0[4], y1[4];
#pragma unroll
                for (int j = 0; j < 4; ++j) { y0[j] = *(const u32x2*)(y0r + 256 * j); y1[j] = *(const u32x2*)(y1r + 256 * j); }
#pragma unroll
                for (int j = 0; j < 4; ++j) { s[j][0] += g0 * bf_lo(y0[j].x) + g1 * bf_lo(y1[j].x); s[j][1] += g0 * bf_hi(y0[j].x) + g1 * bf_hi(y1[j].x);
                    s[j][2] += g0 * bf_lo(y0[j].y) + g1 * bf_lo(y1[j].y); s[j][3] += g0 * bf_hi(y0[j].y) + g1 * bf_hi(y1[j].y); } }
            const float* gt2 = mods + (size_t)((l - 1) * 3 + which) * 6144 + 5 * D; float* xr = X + (size_t)row * D;
#pragma unroll
            for (int j = 0; j < 4; ++j) { v[j] += *(const f32x4*)(gt2 + lane * 4 + 256 * j) * s[j]; if (MODE == 0) *(f32x4*)(xr + lane * 4 + 256 * j) = v[j]; }
        }
        float ss = 0.f;
#pragma unroll
        for (int j = 0; j < 4; ++j) ss += (v[j][0] * v[j][0] + v[j][1] * v[j][1]) + (v[j][2] * v[j][2] + v[j][3] * v[j][3]);
        const float rinv = __builtin_amdgcn_rsqf(wave_sum(ss, lane) * (1.0f / D) + EPS);
        if (MODE == 0) {
            const float* sh = mods + (size_t)(l * 3 + which) * 6144; const float* sc = sh + D;
            bf16_t* hr = H + (size_t)row * D + lane * 4;
#pragma unroll
            for (int j = 0; j < 4; ++j) { const int c = lane * 4 + 256 * j; const f32x4 gg = *(const f32x4*)(gm + c), s1 = *(const f32x4*)(sc + c), s0 = *(const f32x4*)(sh + c);
                const f32x4 y = v[j] * rinv * gg * (s1 + 1.0f) + s0; u32x2 w; w.x = cvt_pk_bf16(y[0], y[1]); w.y = cvt_pk_bf16(y[2], y[3]); *(u32x2*)(hr + 256 * j) = w; }
        } else {
            float* orow = outp + (size_t)(b * SEQ + g - CTX) * D + lane * 4;
#pragma unroll
            for (int j = 0; j < 4; ++j) *(f32x4*)(orow + 256 * j) = v[j] * rinv * *(const f32x4*)(gm + lane * 4 + 256 * j);
        }
#pragma unroll
        for (int j = 0; j < 4; ++j) v[j] = vn[j];
        iv = ivn;
    }
#undef N1_ROWOF
#undef N1_LOADROW
}

__device__ __forceinline__ void norm2_phase(const Ctx& a, int l) {
    PHASE_IDS(); LAS unsigned char* lds = launder_lds(a.lds); unsigned char* ws = a.ws(); const float* gm = a.in(I_GFFN) + l * D; const int gw = blockIdx.x * 8 + wave, NGW = gridDim.x * 8;
    const float* mods = (const float*)(ws + WS_MODS); const float* X = (const float*)(ws + WS_X); unsigned char* H8 = (unsigned char*)(ws + WS_H);
    int* inv = (int*)(ws + WS_INV); float* afl = (float*)(ws + WS_AFF); float* afc = afl + 2 * 16 * SEQ;
    LAS float* wrT = (LAS float*)lds;
    { const float* src = a.in(I_WR) + (size_t)l * D * NE; for (int i = tid; i < D * NE / 4; i += 512) { const f32x4 w = *(const f32x4*)(src + i * 4); const int d = i >> 2, e0 = (i & 3) * 4;
        wrT[(e0 + 0) * D + d] = w[0]; wrT[(e0 + 1) * D + d] = w[1]; wrT[(e0 + 2) * D + d] = w[2]; wrT[(e0 + 3) * D + d] = w[3]; } }
    BAR_LDS();
    const bool last = (l == DEPTH - 1);
    const int NTOT = last ? NB * SEQ : MROWS;
#define N2_ROWOF(n_) (last ? (((n_) >> 14) * LTOT + CTX + ((n_) & (SEQ - 1))) : (n_))
    f32x4 v[4]; int n = gw;
    if (n < NTOT) { const float* xr0 = X + (size_t)N2_ROWOF(n) * D;
#pragma unroll
        for (int j = 0; j < 4; ++j) v[j] = *(const f32x4*)(xr0 + lane * 4 + 256 * j); }
    for (; n < NTOT; n += NGW) {
        const int row = N2_ROWOF(n); const int b = row >= LTOT ? 1 : 0, g = row - b * LTOT; const bool isctx = g < CTX; const int which = isctx ? 2 : b;
        f32x4 vn[4]; const int nn = n + NGW;
        if (nn < NTOT) { const float* xr1 = X + (size_t)N2_ROWOF(nn) * D;
#pragma unroll
            for (int j = 0; j < 4; ++j) vn[j] = *(const f32x4*)(xr1 + lane * 4 + 256 * j); }
        float ss = 0.f;
#pragma unroll
        for (int j = 0; j < 4; ++j) ss += (v[j][0] * v[j][0] + v[j][1] * v[j][1]) + (v[j][2] * v[j][2] + v[j][3] * v[j][3]);
        const float rinv = __builtin_amdgcn_rsqf(wave_sum(ss, lane) * (1.0f / D) + EPS);
        const float* sh = mods + (size_t)(l * 3 + which) * 6144 + 3 * D; const float* sc = sh + D;
        unsigned char* hr = H8 + (size_t)row * D + lane * 4;
        float p[16];
#pragma unroll
        for (int e = 0; e < 16; ++e) p[e] = 0.f;
#pragma unroll
        for (int j = 0; j < 4; ++j) { const int c = lane * 4 + 256 * j; const f32x4 gg = *(const f32x4*)(gm + c), s1 = *(const f32x4*)(sc + c), s0 = *(const f32x4*)(sh + c);
            const f32x4 y = v[j] * rinv * gg * (s1 + 1.0f) + s0; *(unsigned*)(hr + 256 * j) = pg8::pk4_fp8(y[0] * pg8::F8_SA, y[1] * pg8::F8_SA, y[2] * pg8::F8_SA, y[3] * pg8::F8_SA);
#pragma unroll
            for (int e = 0; e < 16; ++e) { const f32x4 w = *(const LAS f32x4*)(wrT + e * D + c); p[e] += (y[0] * w[0] + y[1] * w[1]) + (y[2] * w[2] + y[3] * w[3]); } }
        { const bool hi = (lane & 32) != 0;
#pragma unroll
          for (int i = 0; i < 8; ++i) { const float send = hi ? p[i] : p[i + 8], keep = hi ? p[i + 8] : p[i]; p[i] = keep + shx(send, 32, lane); } }
        { const bool hi = (lane & 16) != 0;
#pragma unroll
          for (int i = 0; i < 4; ++i) { const float send = hi ? p[i] : p[i + 4], keep = hi ? p[i + 4] : p[i]; p[i] = keep + shx(send, 16, lane); } }
        { const bool hi = (lane & 8) != 0;
#pragma unroll
          for (int i = 0; i < 2; ++i) { const float send = hi ? p[i] : p[i + 2], keep = hi ? p[i + 2] : p[i]; p[i] = keep + shx(send, 8, lane); } }
        { const bool hi = (lane & 4) != 0; const float send = hi ? p[0] : p[1], keep = hi ? p[1] : p[0]; p[0] = keep + shx(send, 4, lane); }
        float lg = p[0]; lg += shx(lg, 2, lane); lg += shx(lg, 1, lane);
        float mx = lg; mx = fmaxf(mx, shx(mx, 4, lane)); mx = fmaxf(mx, shx(mx, 8, lane)); mx = fmaxf(mx, shx(mx, 16, lane)); mx = fmaxf(mx, shx(mx, 32, lane));
        const float ex = expf(lg - mx); float sm = ex; sm += shx(sm, 4, lane); sm += shx(sm, 8, lane); sm += shx(sm, 16, lane); sm += shx(sm, 32, lane);
        const float aff = ex / sm; const int e = lane >> 2;
        if ((lane & 3) == 0) { if (isctx) afc[(b * 16 + e) * CTX + g] = aff; else afl[(size_t)(b * 16 + e) * SEQ + (g - CTX)] = aff; }
        if (lane < 16) inv[row * 16 + lane] = -1;
#pragma unroll
        for (int j = 0; j < 4; ++j) v[j] = vn[j];
    }
#undef N2_ROWOF
}

__device__ __forceinline__ void topk_phase(const Ctx& a, int l) {
    PHASE_IDS(); LAS unsigned char* lds = launder_lds(a.lds); unsigned char* ws = a.ws(); const float* afl = (const float*)(ws + WS_AFF); const float* afc = afl + 2 * 16 * SEQ;
    int* rowmap = (int*)(ws + WS_ROWMAP); float* gate = (float*)(ws + WS_ROWMAP) + MOE_ROWS; int* inv = (int*)(ws + WS_INV);
    LAS unsigned* wcnt = (LAS unsigned*)lds;
    const int nitems = (l == DEPTH - 1) ? 32 : 64;
    for (int it = blockIdx.x; it < nitems; it += gridDim.x) {
        const bool isctx = it >= 32; const int be = it & 31, b = be >> 4, e = be & 15;
        const int n = isctx ? CTX : SEQ, k = isctx ? CAP_CTX : CAP_LAT;
        const float* src = isctx ? afc + be * CTX : afl + (size_t)be * SEQ;
        unsigned key[32];
#pragma unroll
        for (int i = 0; i < 32; ++i) { const int idx = i * 512 + tid; key[i] = idx < n ? __float_as_uint(src[idx]) : 0u; }
        unsigned T = 0u;
        for (int bit = 30; bit >= 0; --bit) { const unsigned cand = T | (1u << bit); unsigned cnt = 0;
#pragma unroll
            for (int i = 0; i < 32; ++i) cnt += (key[i] >= cand) ? 1u : 0u;
#pragma unroll
            for (int o = 1; o < 64; o <<= 1) cnt += shxu(cnt, o, lane);
            LAS unsigned* wc = wcnt + (bit & 1) * 8; if (lane == 0) wc[wave] = cnt;
            BAR_LDS();
            unsigned tot = 0;
#pragma unroll
            for (int w = 0; w < 8; ++w) tot += wc[w];
            if (tot >= (unsigned)k) T = cand; }
        unsigned mine = 0;
#pragma unroll
        for (int i = 0; i < 32; ++i) mine += (key[i] > T ? 1u : 0u) + (key[i] == T ? 65536u : 0u);
        unsigned incl = mine;
#pragma unroll
        for (int o = 1; o < 64; o <<= 1) { const unsigned t = shupu(incl, o, lane); if (lane >= o) incl += t; }
        LAS unsigned* wt = wcnt + 16; BAR_LDS();
        if (lane == 63) wt[wave] = incl;
        BAR_LDS();
        unsigned base = 0, total = 0;
#pragma unroll
        for (int w = 0; w < 8; ++w) { const unsigned t = wt[w]; total += t; if (w < wave) base += t; }
        const unsigned excl = base + incl - mine; const unsigned cgt = total & 0xffffu; const unsigned need = (unsigned)k - cgt;
        unsigned sg = excl & 0xffffu, se = excl >> 16;
        const int mrbase = e * MOE_ROWS_E + (isctx ? 4096 + b * CAP_CTX : b * CAP_LAT);
        const int rbase = b * LTOT + (isctx ? 0 : CTX);
#pragma unroll
        for (int i = 0; i < 32; ++i) { const int idx = i * 512 + tid; const unsigned kk = key[i]; int slot = -1;
            if (kk > T) { slot = (int)sg; ++sg; } else if (kk == T) { if (se < need) slot = (int)(cgt + se); ++se; }
            if (slot >= 0) { const int mr = mrbase + slot, r = rbase + idx; rowmap[mr] = r; gate[mr] = __uint_as_float(kk); inv[r * 16 + e] = mr; } }
        if (isctx && b == 0 && tid < 192) { const int mr = e * MOE_ROWS_E + 4160 + tid; rowmap[mr] = 0; gate[mr] = 0.f; }
        BAR_LDS();
    }
}


constexpr int SC_QI = 0, SC_KI = 17408, SC_KT = 34816, SC_VT = 53248, SC_PI = 71680, SC_SM = 80896, SC_PART = 115712, SC_VA = 119808, SC_VB = 120320, SC_VM = 120832, SC_RED = 121344;
constexpr int ST_Q = 272, ST_T = 144;

__device__ __forceinline__ bf16x8 ldfrag(const LAS unsigned char* base, int row, int stride, int kelem) { return *(const LAS bf16x8*)(base + row * stride + kelem * 2); }
#define MFMA16(a, b, c) __builtin_amdgcn_mfma_f32_16x16x32_bf16((a), (b), (c), 0, 0, 0)
#ifndef SCAN_LOG2
__device__ __forceinline__ float ex2(float x) { return __builtin_amdgcn_exp2f(x * 1.4426950408889634f); }
#define LOG2E_ 1.0f
#else
__device__ __forceinline__ float ex2(float x) { return __builtin_amdgcn_exp2f(x); }
#define LOG2E_ 1.4426950408889634f
#endif

__device__ __forceinline__ void scan_write_T(LAS unsigned char* img, const unsigned (&d)[8], int cp, int to) {
    u32x4 wa, wb;
    wa.x = (d[0] & 0xffffu) | (d[1] << 16); wa.y = (d[2] & 0xffffu) | (d[3] << 16); wa.z = (d[4] & 0xffffu) | (d[5] << 16); wa.w = (d[6] & 0xffffu) | (d[7] << 16);
    wb.x = (d[0] >> 16) | (d[1] & 0xffff0000u); wb.y = (d[2] >> 16) | (d[3] & 0xffff0000u); wb.z = (d[4] >> 16) | (d[5] & 0xffff0000u); wb.w = (d[6] >> 16) | (d[7] & 0xffff0000u);
    *(LAS u32x4*)(img + (2 * cp) * ST_T + to * 16) = wa; *(LAS u32x4*)(img + (2 * cp + 1) * ST_T + to * 16) = wb;
}

template <bool FULL>
__device__ __forceinline__ void scan_estage_hg(LAS unsigned char* lds, const unsigned (&kraw)[8], const unsigned (&qraw)[8], const unsigned (&vraw)[8], int lane, int wave, float& la_out, float& lb_out) {
    const int cp = lane, to = wave;
    float ca[8], cb[8]; float ra = 0.f, rb = 0.f;
#pragma unroll
    for (int tt = 0; tt < 8; ++tt) { ra += bf_lo(kraw[tt]); rb += bf_hi(kraw[tt]); ca[tt] = ra; cb[tt] = rb; }
    *(LAS f32x2*)(lds + SC_PART + (to * 128 + 2 * cp) * 4) = (f32x2){ra, rb};
    BAR_LDS();
    float pa = 0.f, pb = 0.f, ma = 0.f, mb = 0.f, la = 0.f, lb = 0.f;
#pragma unroll
    for (int t8 = 0; t8 < 8; ++t8) { const f32x2 pp = *(const LAS f32x2*)(lds + SC_PART + (t8 * 128 + 2 * cp) * 4);
        if (t8 < to) { pa += pp.x; pb += pp.y; } if (t8 < 4) { ma += pp.x; mb += pp.y; } la += pp.x; lb += pp.y; }
    pa -= ma; pb -= mb;
    unsigned kd[8];
#pragma unroll
    for (int tt = 0; tt < 8; ++tt) { const int rr = 8 * to + tt;
        const float da = pa + ca[tt], db = pb + cb[tt];
        const float ka = 1.0f - ex2(bf_lo(kraw[tt])), kb = 1.0f - ex2(bf_hi(kraw[tt]));
        kd[tt] = cvt_pk_bf16(ka * ex2(-da), kb * ex2(-db));
        if (FULL) { *(LAS unsigned*)(lds + SC_QI + rr * ST_Q + cp * 4) = cvt_pk_bf16(bf_lo(qraw[tt]) * ex2(da), bf_hi(qraw[tt]) * ex2(db));
            *(LAS unsigned*)(lds + SC_KI + rr * ST_Q + cp * 4) = kd[tt]; } }
    scan_write_T(lds + SC_KT, kd, cp, to); scan_write_T(lds + SC_VT, vraw, cp, to);
    if (to == 0) { *(LAS f32x2*)(lds + SC_VA + 8 * cp) = (f32x2){ex2(la), ex2(lb)}; *(LAS f32x2*)(lds + SC_VB + 8 * cp) = (f32x2){ex2(la - ma), ex2(lb - mb)};
        *(LAS f32x2*)(lds + SC_VM + 8 * cp) = (f32x2){ex2(ma), ex2(mb)}; }
    la_out = la; lb_out = lb;
}
template <bool FULL>
__device__ __forceinline__ void scan_estage_ret(LAS unsigned char* lds, const unsigned (&kraw)[8], const unsigned (&qraw)[8], const unsigned (&vraw)[8], int lane, int wave, float lg2) {
    const int cp = lane, to = wave; unsigned kd[8];
#pragma unroll
    for (int tt = 0; tt < 8; ++tt) { const int rr = 8 * to + tt; const float wk = ex2((float)(63 - rr) * lg2); kd[tt] = cvt_pk_bf16(bf_lo(kraw[tt]) * wk, bf_hi(kraw[tt]) * wk);
        if (FULL) { *(LAS unsigned*)(lds + SC_QI + rr * ST_Q + cp * 4) = qraw[tt]; *(LAS unsigned*)(lds + SC_KI + rr * ST_Q + cp * 4) = kraw[tt]; } }
    scan_write_T(lds + SC_KT, kd, cp, to); scan_write_T(lds + SC_VT, vraw, cp, to);
}

template <bool RET>
__device__ __forceinline__ void scan_state_update(LAS unsigned char* lds, f32x4 (&ST)[8], int wave, int fr, int fq, float g64) {
    const bf16x8 a0 = ldfrag(lds + SC_KT, 16 * wave + fr, ST_T, 8 * fq), a1 = ldfrag(lds + SC_KT, 16 * wave + fr, ST_T, 32 + 8 * fq);
    f32x4 av = {g64, g64, g64, g64}, bv = {1.f, 1.f, 1.f, 1.f};
    if (!RET) { av = *(const LAS f32x4*)(lds + SC_VA + (16 * wave + 4 * fq) * 4); bv = *(const LAS f32x4*)(lds + SC_VB + (16 * wave + 4 * fq) * 4); }
#pragma unroll
    for (int vi = 0; vi < 8; ++vi) { const bf16x8 b0 = ldfrag(lds + SC_VT, 16 * vi + fr, ST_T, 8 * fq), b1 = ldfrag(lds + SC_VT, 16 * vi + fr, ST_T, 32 + 8 * fq);
        f32x4 u = {0.f, 0.f, 0.f, 0.f}; u = MFMA16(a0, b0, u); u = MFMA16(a1, b1, u); ST[vi] = RET ? (av * ST[vi] + u) : (av * ST[vi] + bv * u); }
}

#define SCAN_LOAD_CHUNK(crow_, dir_) do { _Pragma("unroll") for (int tt = 0; tt < 8; ++tt) { const int rr_ = 8 * wave + tt; const size_t ro_ = (size_t)((crow_) + ((dir_) ? 63 - rr_ : rr_)) * INW + 2 * lane; \
        kraw[tt] = *(const unsigned*)(P + ro_ + colk); vraw[tt] = *(const unsigned*)(P + ro_ + colv); if (LOADQ) qraw[tt] = *(const unsigned*)(P + ro_ + colq); } } while (0)
#define SCAN_STORE_STATE(slot_) do { _Pragma("unroll") for (int vi = 0; vi < 8; ++vi) { u32x2 w; w.x = cvt_pk_bf16(ST[vi][0], ST[vi][1]); w.y = cvt_pk_bf16(ST[vi][2], ST[vi][3]); \
        *(u32x2*)(UB + (size_t)(slot_) * 16384 + (size_t)(vi * 512 + tid) * 4) = w; } } while (0)

struct ScanPtrs { const bf16_t* P; const bf16_t* SB; bf16_t* UB; float* AB; bf16_t* MIX; float* OB; const float* rdec; const float* onorm; };

template <bool RET>
__device__ __forceinline__ void scan1_item(const ScanPtrs& sp, LAS unsigned char* lds, int tid, int lane, int wave, int seq, int tb) {
    const bf16_t* P = sp.P; bf16_t* UB = sp.UB; const int fr = lane & 15, fq = lane >> 4; constexpr bool LOADQ = false;
    const int b = seq >> 4, hh = (seq >> 1) & 7, dir = seq & 1, h = hh & 3;
    const int colk = RET ? 6 * 512 + h * 128 : (dir ? 2 * 512 : 512) + h * 128, colv = (RET ? 7 * 512 : 3 * 512) + h * 128, colq = 0;
    const float lg2 = RET ? -expf(sp.rdec[dir * 4 + h]) * LOG2E_ : 0.f, g64 = ex2(64.f * lg2);
    const int rowbase = b * LTOT + tb * 256;
    f32x4 ST[8];
#pragma unroll
    for (int vi = 0; vi < 8; ++vi) ST[vi] = (f32x4){0.f, 0.f, 0.f, 0.f};
    float ata = 0.f, atb = 0.f; unsigned kraw[8], qraw[8], vraw[8];
#pragma unroll
    for (int tt = 0; tt < 8; ++tt) qraw[tt] = 0u;
    SCAN_LOAD_CHUNK(rowbase + (dir ? 3 : 0) * 64, dir);
#pragma unroll 1
    for (int ci = 0; ci < 4; ++ci) {
        if (RET) scan_estage_ret<false>(lds, kraw, qraw, vraw, lane, wave, lg2);
        else { float la, lb; scan_estage_hg<false>(lds, kraw, qraw, vraw, lane, wave, la, lb); ata += la; atb += lb; }
        if (ci < 3) { const int tc = dir ? 2 - ci : ci + 1; SCAN_LOAD_CHUNK(rowbase + tc * 64, dir); }
        BAR_LDS();
        scan_state_update<RET>(lds, ST, wave, fr, fq, g64);
        BAR_LDS();
    }
    const int slot = seq * 65 + tb;
    SCAN_STORE_STATE(slot);
    if (wave == 0) *(f32x2*)(sp.AB + (size_t)slot * 128 + 2 * lane) = RET ? (f32x2){ex2(256.f * lg2), ex2(256.f * lg2)} : (f32x2){ex2(ata), ex2(atb)};
}

template <bool RET>
__device__ __forceinline__ void scan3_item(const ScanPtrs& sp, LAS unsigned char* lds, int tid, int lane, int wave, int bh, int tb, bool store_state) {
#ifdef PROBE_SKIP
    if ((PROBE_SKIP == 1 && RET) || (PROBE_SKIP == 2 && !RET)) return;
#endif
    const bf16_t* P = sp.P; bf16_t* UB = sp.UB; float* OB = sp.OB;
    const int ti = wave & 3, vh = wave >> 2; constexpr bool LOADQ = true;
    const int b = bh >> 3, hh = bh & 7, h = hh & 3;
    const int colq = (RET ? 5 * 512 : 0) + h * 128, colv = (RET ? 7 * 512 : 3 * 512) + h * 128, colg = (RET ? 8 * 512 : 4 * 512) + h * 128, mixcol = hh * 128;
    const int rowbase = b * LTOT + tb * 256;
#pragma unroll 1
    for (int dir = 1; dir >= 0; --dir) {
        const int colk = RET ? 6 * 512 + h * 128 : (dir ? 2 * 512 : 512) + h * 128;
        const float lg2 = RET ? -expf(sp.rdec[dir * 4 + h]) * LOG2E_ : 0.f, g64 = ex2(64.f * lg2);
        f32x4 ST[8];
        if (tb == 0) {
#pragma unroll
            for (int vi = 0; vi < 8; ++vi) ST[vi] = (f32x4){0.f, 0.f, 0.f, 0.f};
        } else { const size_t slot = (size_t)(bh * 2 + dir) * 65 + tb;
#pragma unroll
            for (int vi = 0; vi < 8; ++vi) { const u32x2 w = *(const u32x2*)(sp.SB + slot * 16384 + (size_t)(vi * 512 + tid) * 4); ST[vi] = (f32x4){bf_lo(w.x), bf_hi(w.x), bf_lo(w.y), bf_hi(w.y)}; } }
        float ata = 0.f, atb = 0.f; unsigned kraw[8], qraw[8], vraw[8];
        SCAN_LOAD_CHUNK(rowbase + (dir ? 3 : 0) * 64, dir);
#pragma unroll 1
        for (int ci = 0; ci < 4; ++ci) {
            const int tc = dir ? 3 - ci : ci;
            int lane_ = lane; asm volatile("" : "+v"(lane_));
            const int fr = lane_ & 15, fq = lane_ >> 4, t = 16 * ti + fr; const float gt1 = ex2((float)(t + 1) * lg2);
            if (RET) scan_estage_ret<true>(lds, kraw, qraw, vraw, lane, wave, lg2);
            else { float la, lb; scan_estage_hg<true>(lds, kraw, qraw, vraw, lane, wave, la, lb); ata += la; atb += lb; }
            if (ci < 3) { const int tcn = dir ? 2 - ci : ci + 1; SCAN_LOAD_CHUNK(rowbase + tcn * 64, dir); }
            const int tok = tc * 64 + (dir ? 63 - t : t), grow = rowbase + tok;
            f32x4 obv[4]; u32x2 gv[4];
            if (dir == 0) {
#pragma unroll
                for (int j = 0; j < 4; ++j) { obv[j] = *(const f32x4*)(OB + tok * 128 + 16 * (4 * vh + j) + 4 * fq); gv[j] = *(const u32x2*)(P + (size_t)grow * INW + colg + 16 * (4 * vh + j) + 4 * fq); } }
            if (!RET) BAR_LDS();
            { f32x4 em = {1.f, 1.f, 1.f, 1.f}; if (!RET) em = *(const LAS f32x4*)(lds + SC_VM + (16 * wave + 4 * fq) * 4);
#pragma unroll
              for (int vi = 0; vi < 8; ++vi) { const f32x4 x = RET ? ST[vi] : ST[vi] * em; u32x2 w; w.x = cvt_pk_bf16(x[0], x[1]); w.y = cvt_pk_bf16(x[2], x[3]); *(LAS u32x2*)(lds + SC_SM + (16 * vi + fr) * ST_Q + (16 * wave + 4 * fq) * 2) = w; } }
            if (RET) BAR_LDS();
#pragma unroll
            for (int sii = 0; sii < 2; ++sii) { const int si = 2 * vh + sii; f32x4 sc = {0.f, 0.f, 0.f, 0.f};
                if (si <= ti) {
#pragma unroll
                    for (int ks = 0; ks < 4; ++ks) sc = MFMA16(ldfrag(lds + SC_KI, 16 * si + fr, ST_Q, 32 * ks + 8 * fq), ldfrag(lds + SC_QI, 16 * ti + fr, ST_Q, 32 * ks + 8 * fq), sc);
                    const int s0 = 16 * si + 4 * fq;
#pragma unroll
                    for (int r = 0; r < 4; ++r) { const float dm = RET ? ex2((float)(t - s0 - r) * lg2) : 1.0f; sc[r] = (s0 + r <= t) ? sc[r] * dm : 0.f; } }
                u32x2 w; w.x = cvt_pk_bf16(sc[0], sc[1]); w.y = cvt_pk_bf16(sc[2], sc[3]); *(LAS u32x2*)(lds + SC_PI + t * ST_T + (16 * si + 4 * fq) * 2) = w; }
            BAR_LDS();
            f32x4 o[4];
#pragma unroll
            for (int j = 0; j < 4; ++j) o[j] = (f32x4){0.f, 0.f, 0.f, 0.f};
#pragma unroll
            for (int ks = 0; ks < 4; ++ks) { const bf16x8 bf = ldfrag(lds + SC_QI, 16 * ti + fr, ST_Q, 32 * ks + 8 * fq);
#pragma unroll
                for (int j = 0; j < 4; ++j) o[j] = MFMA16(ldfrag(lds + SC_SM, 16 * (4 * vh + j) + fr, ST_Q, 32 * ks + 8 * fq), bf, o[j]); }
            if (RET) {
#pragma unroll
                for (int j = 0; j < 4; ++j) o[j] *= gt1; }
#pragma unroll
            for (int ks = 0; ks < 2; ++ks) { const bf16x8 bf = ldfrag(lds + SC_PI, 16 * ti + fr, ST_T, 32 * ks + 8 * fq);
#pragma unroll
                for (int j = 0; j < 4; ++j) o[j] = MFMA16(ldfrag(lds + SC_VT, 16 * (4 * vh + j) + fr, ST_T, 32 * ks + 8 * fq), bf, o[j]); }
            scan_state_update<RET>(lds, ST, wave, fr, fq, g64);
            if (dir == 1) {
#pragma unroll
                for (int j = 0; j < 4; ++j) *(f32x4*)(OB + tok * 128 + 16 * (4 * vh + j) + 4 * fq) = o[j];
                BAR_LDS();
            } else {
                float ss = 0.f;
#pragma unroll
                for (int j = 0; j < 4; ++j) { o[j] += obv[j]; ss += (o[j][0] * o[j][0] + o[j][1] * o[j][1]) + (o[j][2] * o[j][2] + o[j][3] * o[j][3]); }
                ss += shx(ss, 16, lane_); ss += shx(ss, 32, lane_);
                if (fq == 0) *(LAS float*)(lds + SC_RED + ((ci & 1) * 128 + vh * 64 + t) * 4) = ss;
                BAR_LDS();
                const float tot = ss + *(const LAS float*)(lds + SC_RED + ((ci & 1) * 128 + (vh ^ 1) * 64 + t) * 4);
                const float rinv = __builtin_amdgcn_rsqf(tot * (1.0f / 128.0f) + EPS);
#pragma unroll
                for (int j = 0; j < 4; ++j) { const f32x4 onv = RET ? (f32x4){1.f, 1.f, 1.f, 1.f} : *(const f32x4*)(sp.onorm + 16 * (4 * vh + j) + 4 * fq);
                    const f32x4 y = o[j] * rinv * onv * (f32x4){bf_lo(gv[j].x), bf_hi(gv[j].x), bf_lo(gv[j].y), bf_hi(gv[j].y)};
                    u32x2 w; w.x = cvt_pk_bf16(y[0], y[1]); w.y = cvt_pk_bf16(y[2], y[3]); *(u32x2*)(sp.MIX + (size_t)grow * D + mixcol + 16 * (4 * vh + j) + 4 * fq) = w; }
#ifdef PROBE_BAR
                BAR_LDS();
#endif
            }
        }
        if (store_state) { const int slot = (bh * 2 + dir) * 65 + tb; SCAN_STORE_STATE(slot);
            if (wave == 0) *(f32x2*)(sp.AB + (size_t)slot * 128 + 2 * lane) = RET ? (f32x2){ex2(256.f * lg2), ex2(256.f * lg2)} : (f32x2){ex2(ata), ex2(atb)}; }
        BAR_ALL();
    }
}

__device__ __forceinline__ ScanPtrs scan_ptrs(const Ctx& a, int l) {
    unsigned char* ws = a.ws(); ScanPtrs sp; sp.P = (const bf16_t*)(ws + WS_P); sp.SB = (const bf16_t*)(ws + WS_SB); sp.UB = (bf16_t*)(ws + WS_UB); sp.AB = (float*)(ws + WS_AB); sp.MIX = (bf16_t*)(ws + WS_MIX);
    sp.OB = (float*)(ws + WS_OB) + (size_t)blockIdx.x * 32768; sp.rdec = a.in(I_RDEC) + l * 8; sp.onorm = a.in(I_ONORM) + l * 128; return sp;
}

__device__ __forceinline__ void scan1_phase(const Ctx& a, int l) {
    PHASE_IDS(); LAS unsigned char* lds = launder_lds(a.lds); const ScanPtrs sp = scan_ptrs(a, l);
#ifdef PROBE_NOMERGE
    const bool last = true; const int c = blockIdx.x, G = gridDim.x;
#else
    const bool last = (l == DEPTH - 1); const int c = blockIdx.x, G = gridDim.x;
#endif
    if (last || G < 32) {
        if (!last) for (int bh = c; bh < 16; bh += G) { if ((bh & 7) >= 4) scan3_item<true>(sp, lds, tid, lane, wave, bh, 0, true); else scan3_item<false>(sp, lds, tid, lane, wave, bh, 0, true); }
        for (int it = c; it < 2048; it += G) { const int seq = it >> 6, j = it & 63; if (!last && j == 0) continue; const int dir = seq & 1, tb = dir ? (j == 0 ? 0 : 65 - j) : j;
            if (((seq >> 1) & 7) >= 4) scan1_item<true>(sp, lds, tid, lane, wave, seq, tb); else scan1_item<false>(sp, lds, tid, lane, wave, seq, tb); }
        return;
    }
    if (c < 16) { if ((c & 7) >= 4) scan3_item<true>(sp, lds, tid, lane, wave, c, 0, true); else scan3_item<false>(sp, lds, tid, lane, wave, c, 0, true); }
    for (int k = (c < 16 ? 5 : 0);; ++k) {
        const int li = k < 5 ? k * (G - 16) + (c - 16) : 5 * (G - 16) + (k - 5) * G + c;
        if (li >= 2016) break;
        const int seq = li / 63, j = 1 + li % 63, dir = seq & 1, tb = dir ? 65 - j : j;
        if (((seq >> 1) & 7) >= 4) scan1_item<true>(sp, lds, tid, lane, wave, seq, tb); else scan1_item<false>(sp, lds, tid, lane, wave, seq, tb);
    }
}

__device__ __forceinline__ void scan2_phase(const Ctx& a) {
    PHASE_IDS(); unsigned char* ws = a.ws(); const bf16_t* UB = (const bf16_t*)(ws + WS_UB); bf16_t* SB = (bf16_t*)(ws + WS_SB); const float* AB = (const float*)(ws + WS_AB);
    const int c0 = 16 * (tid >> 6) + 4 * ((tid >> 4) & 3);
    for (int p = blockIdx.x; p < 256; p += gridDim.x) { const int seq = p >> 3, vi = p & 7, dir = seq & 1; const size_t eo = (size_t)(vi * 512 + tid) * 4;
        f32x4 s = {0.f, 0.f, 0.f, 0.f};
#pragma unroll 1
        for (int j0 = 0; j0 < 64; j0 += 8) { u32x2 u[8]; f32x4 av[8];
#pragma unroll
            for (int q = 0; q < 8; ++q) { const int j = j0 + q, tb = dir ? (j == 0 ? 0 : 65 - j) : j; const size_t slot = (size_t)seq * 65 + tb; u[q] = *(const u32x2*)(UB + slot * 16384 + eo); av[q] = *(const f32x4*)(AB + slot * 128 + c0); }
#pragma unroll
            for (int q = 0; q < 8; ++q) { const int j = j0 + q, tb = dir ? (j == 0 ? 0 : 65 - j) : j; const size_t slot = (size_t)seq * 65 + tb;
                u32x2 w; w.x = cvt_pk_bf16(s[0], s[1]); w.y = cvt_pk_bf16(s[2], s[3]); *(u32x2*)(SB + slot * 16384 + eo) = w;
                s = av[q] * s + (f32x4){bf_lo(u[q].x), bf_hi(u[q].x), bf_lo(u[q].y), bf_hi(u[q].y)}; } }
        { const int tb = dir ? 1 : 64; const size_t slot = (size_t)seq * 65 + tb; u32x2 w; w.x = cvt_pk_bf16(s[0], s[1]); w.y = cvt_pk_bf16(s[2], s[3]); *(u32x2*)(SB + slot * 16384 + eo) = w; }
    }
}

__device__ __forceinline__ void scan3_phase(const Ctx& a, int l) {
    PHASE_IDS(); LAS unsigned char* lds = launder_lds(a.lds); const ScanPtrs sp = scan_ptrs(a, l);
#ifdef PROBE_NOMERGE
    if (l != DEPTH - 1) for (int bh = blockIdx.x; bh < 16; bh += gridDim.x) { if ((bh & 7) >= 4) scan3_item<true>(sp, lds, tid, lane, wave, bh, 0, false); else scan3_item<false>(sp, lds, tid, lane, wave, bh, 0, false); }
#endif
    for (int it = blockIdx.x; it < 1024; it += gridDim.x) { const int bh = it >> 6, tb = 1 + (it & 63);
        if ((bh & 7) >= 4) scan3_item<true>(sp, lds, tid, lane, wave, bh, tb, false); else scan3_item<false>(sp, lds, tid, lane, wave, bh, tb, false); }
}

struct OutOrder {
    int nrt, skipctx, G, c;
    __device__ __forceinline__ bool next(int i, pg8::Unit& u) const {
        const int L = i * G + c; if (L >= nrt * 4) return false;
        const int r = L >> 2; u.pn = L & 3; u.pm = skipctx ? r + 1 + (r >= 64 ? 1 : 0) : r; return true;
    }
    __device__ __forceinline__ void a_ready(const pg8::Unit&) const {}
    __device__ __forceinline__ void done(const pg8::Unit&) const {}
};

#ifndef PH
#define PH 0xffff
#endif
#ifndef DBL
#define DBL 0
#endif
__global__ void __launch_bounds__(512, 2) mega_fwd(Args a) {
    extern __shared__ __attribute__((aligned(16))) unsigned char lds_raw[];
    LAS unsigned char* lds = (LAS unsigned char*)lds_raw;
    const int tid = threadIdx.x;
    const int G = gridDim.x; const int bx = blockIdx.x; const int vcu = (G % 8 == 0) ? (bx % 8) * (G / 8) + bx / 8 : bx;
    volatile LAS unsigned* MISC = (volatile LAS unsigned*)(lds + MISC_OFF);
    if (tid < 16) MISC[tid] = 0u;
    if (tid == 0) { LAS unsigned long long* pt = (LAS unsigned long long*)(lds + PTR_OFF);
#pragma unroll
        for (int i = 0; i < 18; ++i) pt[i] = (unsigned long long)a.in[i];
        pt[18] = (unsigned long long)a.out; pt[19] = (unsigned long long)a.ws; }
    __syncthreads();
    const Ctx cx{lds, __builtin_amdgcn_readfirstlane(tid >> 6)};
    XcdBarrier bar = xcd_barrier_post((unsigned*)(cx.ws() + WS_CTL) + 1024, MISC + 8);
#define GRID_BAR() do { XcdBarrier b2_ = bar; asm volatile("" : "+s"(b2_.x)); xcd_barrier(b2_); } while (0)

#if PH & 1
    p0_prologue(cx);
#endif
    GRID_BAR();
#if DBL & 1
    p0_prologue(cx);
    GRID_BAR();
#endif
#if PH & 1
    p0_finalize(cx);
#endif
    GRID_BAR();

#pragma unroll 1
    for (int l = 0; l < DEPTH; ++l) {
        const bool last = (l == DEPTH - 1); unsigned char* ws = cx.ws();
#if PH & 2
        norm1_phase<0>(cx, l);
#endif
        GRID_BAR();
#if PH & 4
        {
            pg8::Gemm g{(const bf16_t*)(ws + WS_H), (const bf16_t*)(ws + WS_WIN) + (size_t)l * INW * D, MROWS, INW, D, cx.w0};
            pg8::StaticOrder S; S.init(MROWS, INW, G, bx);
            pg8::EpiIn E{(bf16_t*)(ws + WS_P), (const float*)(ws + WS_LBS) + l * 512, (const float*)(ws + WS_ROPE)};
            pg8::gemm_phase<pg8::EpiIn, pg8::StaticOrder, true, true>(launder_lds(lds), g, S, E);
        }
#endif
        GRID_BAR();
#if PH & 8
        scan1_phase(cx, l);
#endif
        GRID_BAR();
#if PH & 16
        scan2_phase(cx);
#endif
        GRID_BAR();
#if PH & 32
        scan3_phase(cx, l);
#endif
        GRID_BAR();
#if DBL & 2
        scan1_phase(cx, l);
        GRID_BAR();
        scan2_phase(cx);
        GRID_BAR();
        scan3_phase(cx, l);
        GRID_BAR();
#endif
#if DBL & 8
        scan1_phase(cx, l);
        GRID_BAR();
#endif
#if DBL & 16
        scan2_phase(cx);
        GRID_BAR();
#endif
#if DBL & 32
        scan3_phase(cx, l);
        GRID_BAR();
#endif
#if PH & 64
        {
            pg8::Gemm g{(const bf16_t*)(ws + WS_MIX), (const bf16_t*)(ws + WS_WOUT) + (size_t)l * D * D, MROWS, D, D, cx.w0};
            OutOrder S{last ? 128 : 130, last ? 1 : 0, G, vcu};
            pg8::EpiOut E{(float*)(ws + WS_X), l == 0 ? cx.in(I_X) : nullptr, l == 0 ? cx.in(I_CTX) : nullptr, (const float*)(ws + WS_MODS) + (size_t)(l * 3) * 6144 + 2 * D};
            pg8::gemm_phase<pg8::EpiOut, OutOrder, true, true>(launder_lds(lds), g, S, E);
        }
#endif
        GRID_BAR();
#if PH & 128
        norm2_phase(cx, l);
#endif
        GRID_BAR();
#if PH & 256
        topk_phase(cx, l);
#endif
        GRID_BAR();
#if PH & 1024
        {
            pg8::Gemm g{(const bf16_t*)(ws + WS_H), (const bf16_t*)(ws + WS_WGU + (size_t)l * 65536 * D), MOE_ROWS, 65536, D, cx.w0};
            pg8::MoeOrder S{last ? 16 : 17, 16, G, vcu};
            pg8::EpiGU E{(unsigned char*)(ws + WS_HID)};
            pg8::gemm_phase_f8<pg8::EpiGU, pg8::MoeOrder, true>(launder_lds(lds), g, S, E, (const int*)(ws + WS_ROWMAP));
        }
#endif
        GRID_BAR();
#if PH & 2048
        {
            pg8::Gemm g{(const bf16_t*)(ws + WS_HID), (const bf16_t*)(ws + WS_WD + (size_t)l * 16384 * FF), MOE_ROWS, 16384, FF, cx.w0};
            pg8::MoeOrder S{last ? 16 : 17, 4, G, vcu};
            pg8::EpiDown E{(bf16_t*)(ws + WS_YS)};
            pg8::gemm_phase_f8<pg8::EpiDown, pg8::MoeOrder, false>(launder_lds(lds), g, S, E, nullptr);
        }
#endif
        GRID_BAR();
    }
#if PH & 4096
    norm1_phase<1>(cx, DEPTH);
#endif
}

extern "C" void kernel_launch(void* const* d_in, const int* in_sizes, int n_in, void* d_out, int out_size, void* d_ws, size_t ws_size, hipStream_t stream) {
    static int grid = 0;
    if (grid == 0) {
        if (n_in != 18 || out_size != NB * SEQ * D || ws_size < WS_END) { fprintf(stderr, "kernel_launch: unexpected problem shape (n_in %d, out %d, ws %zu)\n", n_in, out_size, ws_size); grid = -1; return; }
        int dev = 0, cus = 0, per_cu = 0;
        if (hipGetDevice(&dev) != hipSuccess || hipDeviceGetAttribute(&cus, hipDeviceAttributeMultiprocessorCount, dev) != hipSuccess) { grid = -1; return; }
        if (hipFuncSetAttribute((const void*)mega_fwd, hipFuncAttributeMaxDynamicSharedMemorySize, LDS_BYTES) != hipSuccess) { fprintf(stderr, "kernel_launch: hipFuncSetAttribute failed\n"); grid = -1; return; }
        if (hipOccupancyMaxActiveBlocksPerMultiprocessor(&per_cu, (const void*)mega_fwd, 512, LDS_BYTES) != hipSuccess || per_cu < 1) { fprintf(stderr, "kernel_launch: occupancy query reports %d workgroups per CU\n", per_cu); per_cu = 1; }
        (void)hipGetLastError();
        grid = cus;
    }
    if (grid < 0) return;
    (void)in_sizes;
    if (hipMemsetAsync((char*)d_ws + WS_CTL, 0, CTL_ZERO_BYTES, stream) != hipSuccess) return;
    Args a{};
    for (int i = 0; i < 18; ++i) a.in[i] = (const float*)d_in[i];
    a.out = (float*)d_out; a.ws = (unsigned char*)d_ws;
    hipLaunchKernelGGL(mega_fwd, dim3(grid), dim3(512), LDS_BYTES, stream, a);
}
```

```cpp
#include <hip/hip_runtime.h>
#include <cstdio>
#include <cstdint>

constexpr int D = 1024, NB = 2, SEQ = 16384, CTX = 256, LTOT = SEQ + CTX, MROWS = NB * LTOT;
constexpr int DEPTH = 4, INW = 4608, NE = 16, FF = 2048;
constexpr int CAP_LAT = 2048, CAP_CTX = 32;
constexpr int MOE_ROWS_E = 4352, MOE_ROWS = NE * MOE_ROWS_E;
constexpr int NSLOT = NB * 8 * 2 * 65;
constexpr float EPS = 1e-6f;

constexpr size_t MiB = 1u << 20;
constexpr size_t WS_CTL = 0, CTL_ZERO_BYTES = 64 * 1024;
constexpr size_t WS_MODP = 1 * MiB;
constexpr size_t WS_MODS = 4 * MiB;
constexpr size_t WS_LBS = 5 * MiB;
constexpr size_t WS_ROPE = 5 * MiB + 65536;
constexpr size_t WS_WIN = 8 * MiB;
constexpr size_t WS_WOUT = 44 * MiB;
constexpr size_t WS_WGU = 52 * MiB;
constexpr size_t WS_WD = 564 * MiB;
constexpr size_t WS_X = 820 * MiB;
constexpr size_t WS_H = 950 * MiB;
constexpr size_t WS_MIX = 1015 * MiB;
constexpr size_t WS_P = 1080 * MiB;
constexpr size_t WS_XS = 1080 * MiB;
constexpr size_t WS_HID = 1216 * MiB;
constexpr size_t WS_YS = 1488 * MiB;
constexpr size_t WS_UB = 1624 * MiB;
constexpr size_t WS_SB = 1689 * MiB;
constexpr size_t WS_AB = 1754 * MiB;
constexpr size_t WS_OB = 1756 * MiB;
constexpr size_t WS_AFF = 1788 * MiB;
constexpr size_t WS_ROWMAP = 1791 * MiB;
constexpr size_t WS_INV = 1792 * MiB;
constexpr size_t WS_END = 1800 * MiB;

constexpr int LDS_BYTES = 155648;
constexpr int MISC_OFF = LDS_BYTES - 64;
constexpr int PTR_OFF = LDS_BYTES - 256;

#define GAS __attribute__((address_space(1)))
#define LAS __attribute__((address_space(3)))
typedef float f32x2 __attribute__((ext_vector_type(2)));
typedef unsigned u32x2 __attribute__((ext_vector_type(2)));

__device__ __forceinline__ int lane_id() { return (int)__builtin_amdgcn_mbcnt_hi(~0u, __builtin_amdgcn_mbcnt_lo(~0u, 0u)); }
__device__ __forceinline__ int opaque_tid(int w0) { (void)w0; int t = threadIdx.x; asm volatile("" : "+v"(t)); return t; }
__device__ __forceinline__ LAS unsigned char* launder_lds(LAS unsigned char* p) { unsigned v = (unsigned)(size_t)p; asm volatile("" : "+s"(v)); return (LAS unsigned char*)(size_t)v; }
__device__ __forceinline__ const float* ldptr(LAS unsigned char* lds0, int i) {
    LAS unsigned char* lds = launder_lds(lds0);
    const u32x2 v = *(volatile LAS u32x2*)(lds + PTR_OFF + 8 * i);
    const unsigned lo = __builtin_amdgcn_readfirstlane(v.x), hi = __builtin_amdgcn_readfirstlane(v.y);
    return (const float*)(((unsigned long long)hi << 32) | lo);
}
namespace pg8 {
#define PG8_LAS __attribute__((address_space(3)))
typedef unsigned short bf16_t;
typedef short bf16x8 __attribute__((ext_vector_type(8)));
typedef float f32x4 __attribute__((ext_vector_type(4)));
typedef unsigned u32x4 __attribute__((ext_vector_type(4)));
constexpr int BM = 256, BK = 64, HALF = 128, HTB = HALF * BK * 2  , STAGE_BYTES = 8 * HTB, NXCD = 8, WGM = 8;

__host__ __device__ __forceinline__ int lds_byte(int r, int c) { const int st = (r >> 4) * 2 + (c >> 5), rr = r & 15, cc = c & 31, ob = rr * 64 + cc * 2; return st * 1024 + (ob ^ (((ob >> 9) & 1) << 5)); }
__host__ __device__ __forceinline__ void stage_rc(int b, int& R, int& C) { const int st = b / 1024, sb = b % 1024, swz = sb ^ (((sb >> 9) & 1) << 5); R = (st >> 1) * 16 + swz / 64; C = (st & 1) * 32 + (swz % 64) / 2; }
__host__ __device__ __forceinline__ int perm32(int rho) { const int n = rho >> 4, i = rho & 15; return 8 * (i >> 2) + 4 * n + (i & 3); }

struct Unit { int pm, pn; };
struct Gemm { const bf16_t* A; const bf16_t* Bt; int M, N, K, w0; };

struct StaticOrder {
    int nM, nN, nwg, G, c;
    __host__ __device__ void init(int M, int N, int G_, int c_) { nM = M / BM; nN = N / BM; nwg = nM * nN; G = G_; c = c_; }
    __host__ __device__ bool next(int i, Unit& u) const {
        const long L = (long)i * G + c; if (L >= nwg) return false;
        int wgid = (int)L; { const int q = nwg / NXCD, r = nwg % NXCD, xcd = wgid % NXCD, off = wgid / NXCD; wgid = (xcd < r ? xcd * (q + 1) : r * (q + 1) + (xcd - r) * q) + off; }
        const int nig = WGM * nN, gid = wgid / nig, fm = gid * WGM, gsz = (nM - fm) < WGM ? (nM - fm) : WGM;
        u.pm = fm + ((wgid % nig) % gsz); u.pn = (wgid % nig) / gsz; return true;
    }
    __device__ __forceinline__ void a_ready(const Unit&) const {}
    __device__ __forceinline__ void done(const Unit&) const {}
};
__device__ __forceinline__ unsigned cvt_pk_bf16(float lo, float hi) { unsigned r; asm volatile("v_cvt_pk_bf16_f32 %0, %1, %2" : "=v"(r) : "v"(lo), "v"(hi)); return r; }

struct MoeOrder {
    int NT, NC, G, c;
    __device__ __forceinline__ bool next(int i, Unit& u) const {
        const int L = i * G + c, per = NT * NC; if (L >= 16 * per) return false;
        const int e = L / per, q = L - e * per; u.pm = e * 17 + q / NC; u.pn = e * NC + q % NC; return true;
    }
    __device__ __forceinline__ void a_ready(const Unit&) const {}
    __device__ __forceinline__ void done(const Unit&) const {}
};

__device__ __forceinline__ float fast_exp(float x) { return __builtin_amdgcn_exp2f(x * 1.4426950408889634f); }
__device__ __forceinline__ float fast_sigmoid(float x) { return __builtin_amdgcn_rcpf(1.0f + fast_exp(-x)); }

struct EpiIn {
    static constexpr bool PERM = true, AFTER_DRAIN = false;
    bf16_t* P; const float* lb; const float* cs;
    __device__ __forceinline__ void operator()(const f32x4 (&acc)[2][2][4][2], const Unit& u, int wr, int wc, int fr, int fq) const {
        const int grp = u.pn >> 1;
        const int row0 = u.pm * BM + wr * 64 + fr, col0 = u.pn * BM + wc * 32 + 8 * fq;
        if (grp == 0 || grp == 3 || grp == 7) {
#pragma unroll
            for (int ai = 0; ai < 2; ++ai)
#pragma unroll
                for (int m = 0; m < 4; ++m) { bf16_t* rowp = P + (size_t)(row0 + ai * HALF + m * 16) * INW + col0;
#pragma unroll
                    for (int bj = 0; bj < 2; ++bj) { const f32x4 v0 = acc[ai][bj][m][0], v1 = acc[ai][bj][m][1];
                        u32x4 w; w.x = cvt_pk_bf16(v0[0], v0[1]); w.y = cvt_pk_bf16(v0[2], v0[3]); w.z = cvt_pk_bf16(v1[0], v1[1]); w.w = cvt_pk_bf16(v1[2], v1[3]);
                        *(u32x4*)(rowp + bj * HALF) = w; } }
        } else if (grp == 1 || grp == 2) {
            const int cg = col0 - grp * 512;
            f32x4 lbv[2][2];
#pragma unroll
            for (int bj = 0; bj < 2; ++bj)
#pragma unroll
                for (int n = 0; n < 2; ++n) lbv[bj][n] = *(const f32x4*)(lb + cg + bj * HALF + 4 * n);
#pragma unroll
            for (int ai = 0; ai < 2; ++ai)
#pragma unroll
                for (int m = 0; m < 4; ++m) { bf16_t* rowp = P + (size_t)(row0 + ai * HALF + m * 16) * INW + col0;
#pragma unroll
                    for (int bj = 0; bj < 2; ++bj) { f32x4 v[2];
#pragma unroll
                        for (int n = 0; n < 2; ++n)
#pragma unroll
                            for (int j = 0; j < 4; ++j) { const float l0 = lbv[bj][n][j]; const float f = l0 + (1.0f - l0) * fast_sigmoid(acc[ai][bj][m][n][j]);
                                #ifndef SCAN_LOG2
                                v[n][j] = __builtin_amdgcn_logf(fmaxf(f, 1e-30f)) * 0.6931471805599453f; }
#else
                                v[n][j] = __builtin_amdgcn_logf(fmaxf(f, 1e-30f)); }
#endif
                        u32x4 w; w.x = cvt_pk_bf16(v[0][0], v[0][1]); w.y = cvt_pk_bf16(v[0][2], v[0][3]); w.z = cvt_pk_bf16(v[1][0], v[1][1]); w.w = cvt_pk_bf16(v[1][2], v[1][3]);
                        *(u32x4*)(rowp + bj * HALF) = w; } }
        } else if (grp == 4 || grp == 8) {
#pragma unroll
            for (int ai = 0; ai < 2; ++ai)
#pragma unroll
                for (int m = 0; m < 4; ++m) { bf16_t* rowp = P + (size_t)(row0 + ai * HALF + m * 16) * INW + col0;
#pragma unroll
                    for (int bj = 0; bj < 2; ++bj) { f32x4 v[2];
#pragma unroll
                        for (int n = 0; n < 2; ++n)
#pragma unroll
                            for (int j = 0; j < 4; ++j) { const float z = acc[ai][bj][m][n][j]; v[n][j] = z * fast_sigmoid(z); }
                        u32x4 w; w.x = cvt_pk_bf16(v[0][0], v[0][1]); w.y = cvt_pk_bf16(v[0][2], v[0][3]); w.z = cvt_pk_bf16(v[1][0], v[1][1]); w.w = cvt_pk_bf16(v[1][2], v[1][3]);
                        *(u32x4*)(rowp + bj * HALF) = w; } }
        } else {
            const float sc = (grp == 6) ? 0.08838834764831845f : 1.0f;
            const int f0 = 16 * (wc & 1) + 4 * fq;
#pragma unroll
            for (int ai = 0; ai < 2; ++ai)
#pragma unroll
                for (int m = 0; m < 4; ++m) { const int row = row0 + ai * HALF + m * 16; bf16_t* rowp = P + (size_t)row * INW + col0;
                    int g = row; if (g >= LTOT) g -= LTOT;
                    int pos = 0; if (g >= CTX) { const int nn = g - CTX; pos = (wc < 2) ? (nn >> 6) : (nn & 63); }
                    const f32x4 t0 = *(const f32x4*)(cs + (size_t)(pos * 32 + f0) * 2), t1 = *(const f32x4*)(cs + (size_t)(pos * 32 + f0) * 2 + 4);
#pragma unroll
                    for (int bj = 0; bj < 2; ++bj) { const f32x4 v0 = acc[ai][bj][m][0] * sc, v1 = acc[ai][bj][m][1] * sc;
                        const float a0 = v0[0] * t0[0] - v0[1] * t0[1], a1 = v0[0] * t0[1] + v0[1] * t0[0];
                        const float a2 = v0[2] * t0[2] - v0[3] * t0[3], a3 = v0[2] * t0[3] + v0[3] * t0[2];
                        const float b0 = v1[0] * t1[0] - v1[1] * t1[1], b1 = v1[0] * t1[1] + v1[1] * t1[0];
                        const float b2 = v1[2] * t1[2] - v1[3] * t1[3], b3 = v1[2] * t1[3] + v1[3] * t1[2];
                        u32x4 w; w.x = cvt_pk_bf16(a0, a1); w.y = cvt_pk_bf16(a2, a3); w.z = cvt_pk_bf16(b0, b1); w.w = cvt_pk_bf16(b2, b3);
                        *(u32x4*)(rowp + bj * HALF) = w; } }
        }
    }
};

struct EpiOut {
    static constexpr bool PERM = true, AFTER_DRAIN = false;
    bf16_t* X; const float* xin; const float* cin; const float* gt;
    __device__ __forceinline__ void operator()(const f32x4 (&acc)[2][2][4][2], const Unit& u, int wr, int wc, int fr, int fq) const {
        const int b = u.pm / 65, tb = u.pm - b * 65, which = (tb == 0) ? 2 : b;
        const int row0 = u.pm * BM + wr * 64 + fr, col0 = u.pn * BM + wc * 32 + 8 * fq;
        f32x4 gv[2][2];
#pragma unroll
        for (int bj = 0; bj < 2; ++bj)
#pragma unroll
            for (int n = 0; n < 2; ++n) gv[bj][n] = *(const f32x4*)(gt + which * 6144 + col0 + bj * HALF + 4 * n);
#pragma unroll
        for (int ai = 0; ai < 2; ++ai)
#pragma unroll
            for (int m = 0; m < 4; ++m) { const int row = row0 + ai * HALF + m * 16; bf16_t* op = X + (size_t)row * D + col0;
#pragma unroll
                for (int bj = 0; bj < 2; ++bj) { f32x4 b0, b1;
                    if (xin) { const int g = row - b * LTOT; const float* bp = (g < CTX ? cin + (size_t)(b * CTX + g) * D : xin + (size_t)(b * SEQ + g - CTX) * D) + col0 + bj * HALF; b0 = *(const f32x4*)bp; b1 = *(const f32x4*)(bp + 4); }
                    else { const u32x4 w = *(const u32x4*)(op + bj * HALF); b0 = (f32x4){__uint_as_float(w.x << 16), __uint_as_float(w.x & 0xffff0000u), __uint_as_float(w.y << 16), __uint_as_float(w.y & 0xffff0000u)};
                        b1 = (f32x4){__uint_as_float(w.z << 16), __uint_as_float(w.z & 0xffff0000u), __uint_as_float(w.w << 16), __uint_as_float(w.w & 0xffff0000u)}; }
                    const f32x4 v0 = b0 + gv[bj][0] * acc[ai][bj][m][0], v1 = b1 + gv[bj][1] * acc[ai][bj][m][1];
                    u32x4 o; o.x = cvt_pk_bf16(v0[0], v0[1]); o.y = cvt_pk_bf16(v0[2], v0[3]); o.z = cvt_pk_bf16(v1[0], v1[1]); o.w = cvt_pk_bf16(v1[2], v1[3]);
                    *(u32x4*)(op + bj * HALF) = o; } }
    }
};

constexpr float F8_SA = 8.0f, F8_SW = 64.0f, F8_SH = 4.0f;
__device__ __forceinline__ unsigned pk4_fp8(float a, float b, float c, float d) {
    a = __builtin_amdgcn_fmed3f(a, -448.f, 448.f); b = __builtin_amdgcn_fmed3f(b, -448.f, 448.f); c = __builtin_amdgcn_fmed3f(c, -448.f, 448.f); d = __builtin_amdgcn_fmed3f(d, -448.f, 448.f);
    unsigned w = 0; w = __builtin_amdgcn_cvt_pk_fp8_f32(a, b, w, false); w = __builtin_amdgcn_cvt_pk_fp8_f32(c, d, w, true); return w; }
struct EpiGU {
    static constexpr bool PERM = true, AFTER_DRAIN = false;
    unsigned char* HID;
    __device__ __forceinline__ void operator()(const f32x4 (&acc)[2][2][4][2], const Unit& u, int wr, int wc, int fr, int fq) const {
        const int row0 = u.pm * BM + wr * 64 + fr, col0 = (u.pn & 15) * HALF + wc * 32 + 8 * fq;
        constexpr float inv = 1.0f / (F8_SA * F8_SW);
#pragma unroll
        for (int ai = 0; ai < 2; ++ai)
#pragma unroll
            for (int m = 0; m < 4; ++m) { unsigned char* rowp = HID + (size_t)(row0 + ai * HALF + m * 16) * FF + col0; f32x4 v[2];
#pragma unroll
                for (int n = 0; n < 2; ++n)
#pragma unroll
                    for (int j = 0; j < 4; ++j) { const float g = acc[ai][0][m][n][j] * inv; v[n][j] = g * fast_sigmoid(g) * (acc[ai][1][m][n][j] * (inv * F8_SH)); }
                u32x2 w; w.x = pk4_fp8(v[0][0], v[0][1], v[0][2], v[0][3]); w.y = pk4_fp8(v[1][0], v[1][1], v[1][2], v[1][3]);
                *(u32x2*)rowp = w; }
    }
};

struct EpiDown {
    static constexpr bool PERM = true, AFTER_DRAIN = false;
    bf16_t* YS;
    __device__ __forceinline__ void operator()(const f32x4 (&acc)[2][2][4][2], const Unit& u, int wr, int wc, int fr, int fq) const {
        const int row0 = u.pm * BM + wr * 64 + fr, col0 = (u.pn & 3) * BM + wc * 32 + 8 * fq;
        constexpr float gg = 1.0f / (F8_SH * F8_SW);
#pragma unroll
        for (int ai = 0; ai < 2; ++ai)
#pragma unroll
            for (int m = 0; m < 4; ++m) { bf16_t* rowp = YS + (size_t)(row0 + ai * HALF + m * 16) * D + col0;
#pragma unroll
                for (int bj = 0; bj < 2; ++bj) { const f32x4 v0 = acc[ai][bj][m][0] * gg, v1 = acc[ai][bj][m][1] * gg;
                    u32x4 w; w.x = cvt_pk_bf16(v0[0], v0[1]); w.y = cvt_pk_bf16(v0[2], v0[3]); w.z = cvt_pk_bf16(v1[0], v1[1]); w.w = cvt_pk_bf16(v1[2], v1[3]);
                    *(u32x4*)(rowp + bj * HALF) = w; } }
    }
};

typedef int i32x4v __attribute__((ext_vector_type(4)));
typedef int i32x8v __attribute__((ext_vector_type(8)));
__device__ __forceinline__ i32x8v cat8(bf16x8 lo, bf16x8 hi) { const i32x4v a = __builtin_bit_cast(i32x4v, lo), b = __builtin_bit_cast(i32x4v, hi); return __builtin_shufflevector(a, b, 0, 1, 2, 3, 4, 5, 6, 7); }
template <class Epi, class Sched, bool GATHER>
__device__ __forceinline__ void gemm_phase_f8(PG8_LAS unsigned char* lds, const Gemm g, const Sched& S, const Epi& E, const int* rowmap) {
    const int tid = opaque_tid(g.w0), wid = __builtin_amdgcn_readfirstlane(tid >> 6), lane = tid & 63, wr = wid >> 2, wc = wid & 3, fr = lane & 15, fq = lane >> 4;
    const int rowb = g.K, nt = rowb / 128;
    unsigned vA0[2], vA1[2], voffB[2];
#pragma unroll
    for (int i = 0; i < 2; ++i) { int R, C; stage_rc(tid * 16 + i * 8192, R, C); const int Rb = Epi::PERM ? ((R & ~31) + perm32(R & 31)) : R;
        voffB[i] = (unsigned)(Rb * rowb + 2 * C); vA0[i] = (unsigned)(R * rowb + 2 * C); vA1[i] = vA0[i]; }
    const size_t kstep = 128;
    const size_t hstep = (size_t)HALF * rowb;
    const size_t tstep = 2 * hstep;
    const unsigned ldsw = (unsigned)wid * 1024u;
    const int aoff = lds_byte(wr * 64 + fr, fq * 8), boff = lds_byte(wc * 32 + fr, fq * 8);
    constexpr int GOFF = STAGE_BYTES;
#define PG8_SA(b, h) (((b) * 2 + (h)) * HTB)
#define PG8_SB(b, h) ((4 + (b) * 2 + (h)) * HTB)
#define PG8_STAGE(bufoff, gbase, voff) do { _Pragma("unroll") for (int _i = 0; _i < 2; ++_i) { unsigned _o = (voff)[_i]; asm volatile("" : "+v"(_o)); \
        __builtin_amdgcn_global_load_lds((const unsigned*)((const char*)(gbase) + _o), (PG8_LAS unsigned*)(lds + (bufoff) + ldsw + _i * 8192), 16, 0, 0); } } while (0)
#define PG8_STAGE_A(bufoff, kbase, h) do { if constexpr (GATHER) { if (h) PG8_STAGE(bufoff, kbase, vA1); else PG8_STAGE(bufoff, kbase, vA0); } else PG8_STAGE(bufoff, (kbase) + (h) * hstep, vA0); } while (0)
#define PG8_GIDX_ISSUE(pm_) do { const int _t = opaque_tid(g.w0); _Pragma("unroll") for (int _i = 0; _i < 2; ++_i) { int R, C; stage_rc(_t * 16 + _i * 8192, R, C); _Pragma("unroll") for (int _h = 0; _h < 2; ++_h) \
        __builtin_amdgcn_global_load_lds((const unsigned*)(rowmap + (pm_) * BM + _h * HALF + R), (PG8_LAS unsigned*)(lds + GOFF + ldsw + (_h * 2 + _i) * 256), 4, 0, 0); } } while (0)
#define PG8_GIDX_TAKE() do { const int _t = opaque_tid(g.w0); _Pragma("unroll") for (int _i = 0; _i < 2; ++_i) { int R, C; stage_rc(_t * 16 + _i * 8192, R, C); \
        vA0[_i] = *(const PG8_LAS unsigned*)(lds + GOFF + ldsw + (0 * 2 + _i) * 256 + (_t & 63) * 4) * (unsigned)rowb + (unsigned)(2 * C); \
        vA1[_i] = *(const PG8_LAS unsigned*)(lds + GOFF + ldsw + (1 * 2 + _i) * 256 + (_t & 63) * 4) * (unsigned)rowb + (unsigned)(2 * C); } } while (0)
#define PG8_LDA(dst, b, h) do { _Pragma("unroll") for (int m = 0; m < 4; ++m) _Pragma("unroll") for (int k = 0; k < 2; ++k) dst[m][k] = *(const PG8_LAS bf16x8*)(lds + PG8_SA(b, h) + aoff + m * 2048 + k * 1024); } while (0)
#define PG8_LDB(dst, b, h) do { _Pragma("unroll") for (int n = 0; n < 2; ++n) _Pragma("unroll") for (int k = 0; k < 2; ++k) dst[n][k] = *(const PG8_LAS bf16x8*)(lds + PG8_SB(b, h) + boff + n * 2048 + k * 1024); } while (0)
#define PG8_MMA(ai, bj, At, Bt) do { __builtin_amdgcn_s_setprio(1); _Pragma("unroll") for (int m = 0; m < 4; ++m) _Pragma("unroll") for (int n = 0; n < 2; ++n) \
        acc[ai][bj][m][n] = __builtin_amdgcn_mfma_scale_f32_16x16x128_f8f6f4(cat8(Bt[n][0], Bt[n][1]), cat8(At[m][0], At[m][1]), acc[ai][bj][m][n], 0, 0, 0, 0x7f7f7f7f, 0, 0x7f7f7f7f); __builtin_amdgcn_s_setprio(0); } while (0)
#define PG8_WAIT_V(n) asm volatile("s_waitcnt vmcnt(" #n ")" ::: "memory")
#define PG8_WAIT_L(n) asm volatile("s_waitcnt lgkmcnt(" #n ")" ::: "memory")
#define PG8_BAR __builtin_amdgcn_s_barrier()
#define PG8_SCHED __builtin_amdgcn_sched_barrier(0)
    Unit cur, nxt; int ui = 0;
    if (!S.next(0, cur)) return;
    f32x4 acc[2][2][4][2];
#pragma unroll
    for (int a = 0; a < 2; ++a)
#pragma unroll
        for (int b = 0; b < 2; ++b)
#pragma unroll
            for (int m = 0; m < 4; ++m)
#pragma unroll
                for (int n = 0; n < 2; ++n) acc[a][b][m][n] = (f32x4){0.f, 0.f, 0.f, 0.f};
    bf16x8 At[4][2], B0[2][2], B1[2][2];
    const char* cA; const char* cB = (const char*)g.Bt + (size_t)cur.pn * tstep;
    if constexpr (GATHER) { cA = (const char*)g.A; PG8_GIDX_ISSUE(cur.pm); PG8_WAIT_V(0); PG8_GIDX_TAKE(); }
    else cA = (const char*)g.A + (size_t)cur.pm * tstep;
    PG8_STAGE(PG8_SB(0, 0), cB, voffB); PG8_STAGE(PG8_SB(0, 1), cB + hstep, voffB); PG8_STAGE_A(PG8_SA(0, 0), cA, 0); PG8_STAGE_A(PG8_SA(0, 1), cA, 1);
    if (wr == 1) PG8_BAR;
    PG8_WAIT_V(2); PG8_BAR;
    PG8_STAGE(PG8_SB(1, 0), cB + kstep, voffB); PG8_STAGE_A(PG8_SA(1, 0), cA + kstep, 0); PG8_STAGE(PG8_SB(1, 1), cB + hstep + kstep, voffB);
    PG8_WAIT_V(6); PG8_BAR;
    for (;;) {
        const bool has_next = S.next(ui + 1, nxt);
        const char* nA; const char* nB = has_next ? (const char*)g.Bt + (size_t)nxt.pn * tstep : cB;
        if constexpr (GATHER) { nA = cA; if (has_next) PG8_GIDX_ISSUE(nxt.pm); }
        else nA = has_next ? (const char*)g.A + (size_t)nxt.pm * tstep : cA;
#pragma unroll 1
        for (int t = 0; t < nt; t += 2) {
            const bool last = (t == nt - 2);
            const char* a1 = cA + (size_t)(t + 1) * kstep;
            const char* a2 = last ? nA : cA + (size_t)(t + 2) * kstep; const char* b2 = last ? nB : cB + (size_t)(t + 2) * kstep;
            const char* a3 = a2 + kstep; const char* b3 = b2 + kstep;
            PG8_LDB(B0, 0, 0); PG8_LDB(B1, 0, 1); PG8_SCHED; PG8_LDA(At, 0, 0); PG8_STAGE_A(PG8_SA(1, 1), a1, 1);
            if constexpr (GATHER) { if (last && has_next) PG8_GIDX_TAKE(); }
            PG8_WAIT_V(8); PG8_WAIT_L(0); PG8_BAR; PG8_MMA(0, 0, At, B0); PG8_MMA(0, 1, At, B1); PG8_BAR; PG8_SCHED;
            PG8_LDA(At, 0, 1); PG8_STAGE(PG8_SB(0, 0), b2, voffB); PG8_STAGE(PG8_SB(0, 1), b2 + hstep, voffB); PG8_STAGE_A(PG8_SA(0, 0), a2, 0);
            PG8_WAIT_V(8); PG8_WAIT_L(0); PG8_BAR; PG8_MMA(1, 0, At, B0); PG8_MMA(1, 1, At, B1); PG8_BAR; PG8_SCHED;
            PG8_LDB(B0, 1, 0); PG8_LDB(B1, 1, 1); PG8_SCHED; PG8_LDA(At, 1, 0); PG8_STAGE_A(PG8_SA(0, 1), a2, 1);
            PG8_WAIT_V(8); PG8_WAIT_L(0); PG8_BAR; PG8_MMA(0, 0, At, B0); PG8_MMA(0, 1, At, B1); PG8_BAR; PG8_SCHED;
            PG8_LDA(At, 1, 1); PG8_STAGE(PG8_SB(1, 0), b3, voffB); PG8_STAGE(PG8_SB(1, 1), b3 + hstep, voffB); PG8_STAGE_A(PG8_SA(1, 0), a3, 0);
            PG8_WAIT_V(8); PG8_WAIT_L(0); PG8_BAR; PG8_MMA(1, 0, At, B0); PG8_MMA(1, 1, At, B1); PG8_BAR; PG8_SCHED;
        }
        if (wr == 0) PG8_BAR;
        { const int l2_ = opaque_tid(g.w0) & 63; E(acc, cur, wr, wc, l2_ & 15, l2_ >> 4); }
        if (!has_next) break;
#pragma unroll
        for (int a = 0; a < 2; ++a)
#pragma unroll
            for (int b = 0; b < 2; ++b)
#pragma unroll
                for (int m = 0; m < 4; ++m)
#pragma unroll
                    for (int n = 0; n < 2; ++n) acc[a][b][m][n] = (f32x4){0.f, 0.f, 0.f, 0.f};
        cur = nxt; cA = nA; cB = nB; ++ui;
        if (wr == 1) PG8_BAR;
    }
    PG8_WAIT_V(0);
    PG8_BAR;
#undef PG8_SA
#undef PG8_SB
#undef PG8_STAGE
#undef PG8_STAGE_A
#undef PG8_GIDX_ISSUE
#undef PG8_GIDX_TAKE
#undef PG8_LDA
#undef PG8_LDB
#undef PG8_MMA
#undef PG8_WAIT_V
#undef PG8_WAIT_L
#undef PG8_BAR
#undef PG8_SCHED
}
template <class Epi, class Sched, bool ALIGN_EPI = false, bool SP2 = false>
__device__ __forceinline__ void gemm_phase(PG8_LAS unsigned char* lds, const Gemm g, const Sched& S, const Epi& E) {
    const int tid = opaque_tid(g.w0), wid = __builtin_amdgcn_readfirstlane(tid >> 6), lane = tid & 63, wr = wid >> 2, wc = wid & 3, fr = lane & 15, fq = lane >> 4;
    const int K = g.K, nt = K / BK;
    unsigned voffA[2], voffB[2];
#pragma unroll
    for (int i = 0; i < 2; ++i) { int R, C; stage_rc(tid * 16 + i * 8192, R, C); const int Rb = Epi::PERM ? ((R & ~31) + perm32(R & 31)) : R;
        voffA[i] = (unsigned)(R * K + C) * 2u; voffB[i] = (unsigned)(Rb * K + C) * 2u; }
    const size_t kstep = (size_t)(BK * 2);
    const size_t hstep = (size_t)HALF * K * 2;
    const size_t tstep = 2 * hstep;
    const unsigned ldsw = (unsigned)wid * 1024u;
    const int aoff = lds_byte(wr * 64 + fr, fq * 8), boff = lds_byte(wc * 32 + fr, fq * 8);
#define PG8_SA(b, h) (((b) * 2 + (h)) * HTB)
#define PG8_SB(b, h) ((4 + (b) * 2 + (h)) * HTB)
#define PG8_STAGE(bufoff, gbase, voff) do { _Pragma("unroll") for (int _i = 0; _i < 2; ++_i) \
        __builtin_amdgcn_global_load_lds((const unsigned*)((const char*)(gbase) + (voff)[_i]), (PG8_LAS unsigned*)(lds + (bufoff) + ldsw + _i * 8192), 16, 0, 0); } while (0)
#define PG8_LDA(dst, b, h) do { _Pragma("unroll") for (int m = 0; m < 4; ++m) _Pragma("unroll") for (int k = 0; k < 2; ++k) dst[m][k] = *(const PG8_LAS bf16x8*)(lds + PG8_SA(b, h) + aoff + m * 2048 + k * 1024); } while (0)
#define PG8_LDB(dst, b, h) do { _Pragma("unroll") for (int n = 0; n < 2; ++n) _Pragma("unroll") for (int k = 0; k < 2; ++k) dst[n][k] = *(const PG8_LAS bf16x8*)(lds + PG8_SB(b, h) + boff + n * 2048 + k * 1024); } while (0)
#define PG8_MMA(ai, bj, At, Bt) do { __builtin_amdgcn_s_setprio(1); _Pragma("unroll") for (int m = 0; m < 4; ++m) _Pragma("unroll") for (int n = 0; n < 2; ++n) _Pragma("unroll") for (int k = 0; k < 2; ++k) \
        acc[ai][bj][m][n] = __builtin_amdgcn_mfma_f32_16x16x32_bf16(Bt[n][k], At[m][k], acc[ai][bj][m][n], 0, 0, 0); __builtin_amdgcn_s_setprio(0); } while (0)
#define PG8_WAIT_V(n) asm volatile("s_waitcnt vmcnt(" #n ")" ::: "memory")
#define PG8_WAIT_L(n) asm volatile("s_waitcnt lgkmcnt(" #n ")" ::: "memory")
#define PG8_BAR __builtin_amdgcn_s_barrier()
#define PG8_SCHED __builtin_amdgcn_sched_barrier(0)
    Unit cur, nxt; int ui = 0;
    if (!S.next(0, cur)) return;
    f32x4 acc[2][2][4][2];
#pragma unroll
    for (int a = 0; a < 2; ++a)
#pragma unroll
        for (int b = 0; b < 2; ++b)
#pragma unroll
            for (int m = 0; m < 4; ++m)
#pragma unroll
                for (int n = 0; n < 2; ++n) acc[a][b][m][n] = (f32x4){0.f, 0.f, 0.f, 0.f};
    bf16x8 At[4][2], B0[2][2], B1[2][2];
    const char* cA = (const char*)g.A + (size_t)cur.pm * tstep; const char* cB = (const char*)g.Bt + (size_t)cur.pn * tstep;
    S.a_ready(cur);
    if constexpr (SP2) {
        PG8_STAGE(PG8_SB(0, 0), cB, voffB); PG8_STAGE(PG8_SB(0, 1), cB + hstep, voffB); PG8_STAGE(PG8_SA(0, 0), cA, voffA); PG8_STAGE(PG8_SA(0, 1), cA + hstep, voffA);
        if (wr == 1) PG8_BAR;
        PG8_WAIT_V(2); PG8_BAR;
        PG8_STAGE(PG8_SB(1, 0), cB + kstep, voffB); PG8_STAGE(PG8_SA(1, 0), cA + kstep, voffA); PG8_STAGE(PG8_SB(1, 1), cB + hstep + kstep, voffB);
        PG8_WAIT_V(6); PG8_BAR;
    } else {
        PG8_STAGE(PG8_SB(0, 0), cB, voffB); PG8_STAGE(PG8_SA(0, 0), cA, voffA); PG8_STAGE(PG8_SB(0, 1), cB + hstep, voffB); PG8_STAGE(PG8_SA(0, 1), cA + hstep, voffA);
        if (wr == 1) PG8_BAR;
        PG8_WAIT_V(4); PG8_BAR;
        PG8_STAGE(PG8_SB(1, 0), cB + kstep, voffB); PG8_STAGE(PG8_SA(1, 0), cA + kstep, voffA); PG8_STAGE(PG8_SB(1, 1), cB + hstep + kstep, voffB);
        PG8_WAIT_V(6); PG8_BAR;
    }
    for (;;) {
        const bool has_next = S.next(ui + 1, nxt);
        const char* nA = has_next ? (const char*)g.A + (size_t)nxt.pm * tstep : cA; const char* nB = has_next ? (const char*)g.Bt + (size_t)nxt.pn * tstep : cB;
        for (int t = 0; t < nt; t += 2) {
            const bool last = (t == nt - 2);
            const char* a1 = cA + (size_t)(t + 1) * kstep;
            const char* a2 = last ? nA : cA + (size_t)(t + 2) * kstep; const char* b2 = last ? nB : cB + (size_t)(t + 2) * kstep;
            const char* a3 = a2 + kstep; const char* b3 = b2 + kstep;
            if (last && has_next) S.a_ready(nxt);
            if constexpr (SP2) {
            PG8_LDB(B0, 0, 0); PG8_LDB(B1, 0, 1); PG8_SCHED; PG8_LDA(At, 0, 0); PG8_STAGE(PG8_SA(1, 1), a1 + hstep, voffA);
            PG8_WAIT_V(8); PG8_WAIT_L(0); PG8_BAR; PG8_MMA(0, 0, At, B0); PG8_MMA(0, 1, At, B1); PG8_BAR; PG8_SCHED;
            PG8_LDA(At, 0, 1); PG8_STAGE(PG8_SB(0, 0), b2, voffB); PG8_STAGE(PG8_SB(0, 1), b2 + hstep, voffB); PG8_STAGE(PG8_SA(0, 0), a2, voffA);
            PG8_WAIT_V(8); PG8_WAIT_L(0); PG8_BAR; PG8_MMA(1, 0, At, B0); PG8_MMA(1, 1, At, B1); PG8_BAR; PG8_SCHED;
            PG8_LDB(B0, 1, 0); PG8_LDB(B1, 1, 1); PG8_SCHED; PG8_LDA(At, 1, 0); PG8_STAGE(PG8_SA(0, 1), a2 + hstep, voffA);
            PG8_WAIT_V(8); PG8_WAIT_L(0); PG8_BAR; PG8_MMA(0, 0, At, B0); PG8_MMA(0, 1, At, B1); PG8_BAR; PG8_SCHED;
            PG8_LDA(At, 1, 1); PG8_STAGE(PG8_SB(1, 0), b3, voffB); PG8_STAGE(PG8_SB(1, 1), b3 + hstep, voffB); PG8_STAGE(PG8_SA(1, 0), a3, voffA);
            PG8_WAIT_V(8); PG8_WAIT_L(0); PG8_BAR; PG8_MMA(1, 0, At, B0); PG8_MMA(1, 1, At, B1); PG8_BAR; PG8_SCHED;
            } else {
            PG8_LDB(B0, 0, 0); PG8_SCHED; PG8_LDA(At, 0, 0); PG8_STAGE(PG8_SA(1, 1), a1 + hstep, voffA);
            PG8_WAIT_L(8); PG8_BAR; PG8_WAIT_L(0); PG8_MMA(0, 0, At, B0); PG8_BAR; PG8_SCHED;
            PG8_LDB(B1, 0, 1); PG8_STAGE(PG8_SB(0, 0), b2, voffB);
            PG8_BAR; PG8_WAIT_L(0); PG8_MMA(0, 1, At, B1); PG8_BAR;
            PG8_LDA(At, 0, 1); PG8_STAGE(PG8_SA(0, 0), a2, voffA);
            PG8_BAR; PG8_WAIT_L(0); PG8_MMA(1, 0, At, B0); PG8_BAR; PG8_SCHED;
            PG8_STAGE(PG8_SB(0, 1), b2 + hstep, voffB);
            PG8_WAIT_V(6); PG8_BAR; PG8_MMA(1, 1, At, B1); PG8_BAR;
            PG8_LDB(B0, 1, 0); PG8_SCHED; PG8_LDA(At, 1, 0); PG8_STAGE(PG8_SA(0, 1), a2 + hstep, voffA);
            PG8_WAIT_L(8); PG8_BAR; PG8_WAIT_L(0); PG8_MMA(0, 0, At, B0); PG8_BAR; PG8_SCHED;
            PG8_LDB(B1, 1, 1); PG8_STAGE(PG8_SB(1, 0), b3, voffB);
            PG8_BAR; PG8_WAIT_L(0); PG8_MMA(0, 1, At, B1); PG8_BAR;
            PG8_LDA(At, 1, 1); PG8_STAGE(PG8_SA(1, 0), a3, voffA);
            PG8_BAR; PG8_WAIT_L(0); PG8_MMA(1, 0, At, B0); PG8_BAR; PG8_SCHED;
            PG8_STAGE(PG8_SB(1, 1), b3 + hstep, voffB);
            PG8_WAIT_V(6); PG8_BAR; PG8_MMA(1, 1, At, B1); PG8_BAR;
            }
        }
        if constexpr (ALIGN_EPI) { if (wr == 0) PG8_BAR; }
        if constexpr (!Epi::AFTER_DRAIN) { E(acc, cur, wr, wc, fr, fq); S.done(cur); }
        if (!has_next) break;
#pragma unroll
        for (int a = 0; a < 2; ++a)
#pragma unroll
            for (int b = 0; b < 2; ++b)
#pragma unroll
                for (int m = 0; m < 4; ++m)
#pragma unroll
                    for (int n = 0; n < 2; ++n) acc[a][b][m][n] = (f32x4){0.f, 0.f, 0.f, 0.f};
        cur = nxt; cA = nA; cB = nB; ++ui;
        if constexpr (ALIGN_EPI) { if (wr == 1) PG8_BAR; }
    }
    PG8_WAIT_V(0);
    if constexpr (!ALIGN_EPI) { if (wr == 0) PG8_BAR; }
    PG8_BAR;
    if constexpr (Epi::AFTER_DRAIN) { E.fused(acc, cur, wr, wc, fr, fq, lds, wid, lane); S.done(cur); }
#undef PG8_SA
#undef PG8_SB
#undef PG8_STAGE
#undef PG8_LDA
#undef PG8_LDB
#undef PG8_MMA
#undef PG8_WAIT_V
#undef PG8_WAIT_L
#undef PG8_BAR
#undef PG8_SCHED
}
}
#define XB_TMO      128
#define XB_XCNT(j)  (256  + 64 * (j))
#define XB_XSUB(j)  (1280 + 64 * (j))
#define XB_XGEN(j)  (2304 + 64 * (j))
#define XB_TOP      3328
#define XB_TOPGEN   3392
#define XCD_BAR_WORDS 3456
#define XB_SPIN_CAP (1u << 18)

__device__ __forceinline__ unsigned xb_ld(unsigned* p)              { return __hip_atomic_load(p, __ATOMIC_RELAXED, __HIP_MEMORY_SCOPE_AGENT); }
__device__ __forceinline__ unsigned xb_add(unsigned* p, unsigned v) { return __hip_atomic_fetch_add(p, v, __ATOMIC_RELAXED, __HIP_MEMORY_SCOPE_AGENT); }
__device__ __forceinline__ unsigned xb_xcc_id() { return (unsigned)__builtin_amdgcn_s_getreg((3 << 11) | 20) & 0xFu; }
#define XB_SPIN(cond, bar) do { unsigned _sp = 0; while (cond) { __builtin_amdgcn_s_sleep(1); \
    if ((++_sp & 255u) == 0u) { if (xb_ld(&(bar)[XB_TMO])) break; if (_sp > XB_SPIN_CAP) { atomicAdd(&(bar)[XB_TMO], 1u); break; } } } } while (0)

struct XcdBarrier {
    unsigned* bar; unsigned x;
    volatile LAS unsigned* st;
};

__device__ __forceinline__ XcdBarrier xcd_barrier_post(unsigned* bar, volatile LAS unsigned* st) {
    XcdBarrier b; b.bar = bar; b.x = xb_xcc_id(); b.st = st;
    if (threadIdx.x == 0) (void)xb_add(&bar[XB_XCNT(b.x)], 1u);
    return b;
}
__device__ __forceinline__ void xcd_barrier_complete(unsigned* bar, unsigned x, unsigned& nloc, unsigned& nx) {
    const unsigned G = gridDim.x * gridDim.y * gridDim.z;
    unsigned sum, cnt, mine, sp = 0u;
    for (;;) {
        sum = 0u; cnt = 0u; mine = 0u;
#pragma unroll
        for (unsigned j = 0; j < 16; ++j) { const unsigned c = xb_ld(&bar[XB_XCNT(j)]); sum += c; cnt += (c > 0u) ? 1u : 0u; mine = (j == x) ? c : mine; }
        if (sum == G) break;
        __builtin_amdgcn_s_sleep(1);
        if ((++sp & 255u) == 0u) { if (xb_ld(&bar[XB_TMO])) break; if (sp > XB_SPIN_CAP) { atomicAdd(&bar[XB_TMO], 1u); break; } }
    }
    nloc = mine > 0u ? mine : 1u; nx = cnt > 0u ? cnt : 1u;
}

__device__ __forceinline__ void xcd_barrier(const XcdBarrier& b) {
    asm volatile("s_waitcnt vmcnt(0)" ::: "memory");
    __syncthreads();
    if (threadIdx.x == 0) {
        unsigned* bar = b.bar;
        __builtin_amdgcn_s_waitcnt(0);
        unsigned nloc = b.st[0], nx = b.st[1];
        if (nloc == 0u) { xcd_barrier_complete(bar, b.x, nloc, nx); b.st[0] = nloc; b.st[1] = nx; }
        const unsigned old = xb_add(&bar[XB_XSUB(b.x)], 1u);
        const unsigned gen = old / nloc;
        if (old + 1u == (gen + 1u) * nloc) {
            __builtin_amdgcn_fence(__ATOMIC_RELEASE, "agent");
            asm volatile("s_waitcnt vmcnt(0)" ::: "memory");
            const unsigned og = xb_add(&bar[XB_TOP], 1u);
            const unsigned tg = og / nx;
            if (og + 1u == (tg + 1u) * nx) xb_add(&bar[XB_TOPGEN], 1u);
            else XB_SPIN(xb_ld(&bar[XB_TOPGEN]) == tg, bar);
            __builtin_amdgcn_fence(__ATOMIC_ACQUIRE, "agent");
            xb_add(&bar[XB_XGEN(b.x)], 1u);
            asm volatile("s_waitcnt vmcnt(0)" ::: "memory");
        } else {
            XB_SPIN(xb_ld(&bar[XB_XGEN(b.x)]) == gen, bar);
            __builtin_amdgcn_fence(__ATOMIC_ACQUIRE, "agent");
            asm volatile("s_waitcnt vmcnt(0)" ::: "memory");
        }
    }
    __syncthreads();
}

using pg8::bf16_t; using pg8::bf16x8; using pg8::f32x4; using pg8::u32x4; using pg8::cvt_pk_bf16; using pg8::fast_exp;

#define BAR_LDS() do { asm volatile("s_waitcnt lgkmcnt(0)" ::: "memory"); __builtin_amdgcn_s_barrier(); asm volatile("" ::: "memory"); } while (0)
#define BAR_ALL() do { asm volatile("s_waitcnt vmcnt(0) lgkmcnt(0)" ::: "memory"); __builtin_amdgcn_s_barrier(); asm volatile("" ::: "memory"); } while (0)

#ifdef PROBE_SHFL
__device__ __forceinline__ float shx(float v, int mask, int lane) { (void)lane; return __shfl_xor(v, mask); }
__device__ __forceinline__ unsigned shxu(unsigned v, int mask, int lane) { (void)lane; return __shfl_xor(v, mask); }
__device__ __forceinline__ unsigned shupu(unsigned v, int d, int lane) { (void)lane; return __shfl_up(v, d); }
#else
__device__ __forceinline__ float shx(float v, int mask, int lane) { return __builtin_bit_cast(float, __builtin_amdgcn_ds_bpermute((lane ^ mask) << 2, __builtin_bit_cast(int, v))); }
__device__ __forceinline__ unsigned shxu(unsigned v, int mask, int lane) { return (unsigned)__builtin_amdgcn_ds_bpermute((lane ^ mask) << 2, (int)v); }
__device__ __forceinline__ unsigned shupu(unsigned v, int d, int lane) { return (unsigned)__builtin_amdgcn_ds_bpermute((lane - d) << 2, (int)v); }
#endif
__device__ __forceinline__ float wave_sum(float v, int lane) {
#pragma unroll
    for (int o = 1; o < 64; o <<= 1) v += shx(v, o, lane);
    return v;
}
__device__ __forceinline__ float bf_lo(unsigned u) { return __uint_as_float(u << 16); }
__device__ __forceinline__ float bf_hi(unsigned u) { return __uint_as_float(u & 0xffff0000u); }

struct Args { const float* in[18]; float* out; unsigned char* ws; };
struct Ctx { LAS unsigned char* lds; int w0;
    __device__ __forceinline__ const float* in(int i) const { return ldptr(lds, i); }
    __device__ __forceinline__ float* out() const { return (float*)ldptr(lds, 18); }
    __device__ __forceinline__ unsigned char* ws() const { return (unsigned char*)ldptr(lds, 19); } };
#define PHASE_IDS() const int tid = opaque_tid(a.w0), lane = tid & 63, wave = __builtin_amdgcn_readfirstlane(tid >> 6); (void)tid; (void)lane; (void)wave
enum { I_X = 0, I_C, I_CTX, I_CCTX, I_WADA, I_BADA, I_GMIX, I_GFFN, I_WIN, I_WOUT, I_LBL, I_ONORM, I_RDEC, I_WR, I_WEG, I_WEU, I_WED, I_GFIN };

__device__ __forceinline__ void tr_item(const float* W, int N, bf16_t* WT, int Kd, int k0, int n0, int drow0, LAS float* scr, int lane) {
    f32x4 v[16];
    const float* src = W + (size_t)(k0 + (lane >> 4)) * N + n0 + (lane & 15) * 4;
#pragma unroll
    for (int i = 0; i < 16; ++i) v[i] = *(const f32x4*)(src + (size_t)(i * 4) * N);
#pragma unroll
    for (int i = 0; i < 16; ++i) { LAS float* d = scr + (i * 4 + (lane >> 4)) * 65 + (lane & 15) * 4; d[0] = v[i][0]; d[1] = v[i][1]; d[2] = v[i][2]; d[3] = v[i][3]; }
    asm volatile("s_waitcnt lgkmcnt(0)" ::: "memory");
    const int c = lane & 7;
#pragma unroll
    for (int j = 0; j < 8; ++j) { const int n = j * 8 + (lane >> 3); const LAS float* s = scr + (8 * c) * 65 + n;
        u32x4 o; o.x = cvt_pk_bf16(s[0], s[65]); o.y = cvt_pk_bf16(s[2 * 65], s[3 * 65]); o.z = cvt_pk_bf16(s[4 * 65], s[5 * 65]); o.w = cvt_pk_bf16(s[6 * 65], s[7 * 65]);
        *(u32x4*)(WT + (size_t)(drow0 + n) * Kd + k0 + 8 * c) = o; }
    asm volatile("s_waitcnt lgkmcnt(0)" ::: "memory");
}

__device__ __forceinline__ void tr_item8(const float* W, int N, unsigned char* WT, int Kd, int k0, int n0, int drow0, LAS float* scr, int lane, float scale) {
    f32x4 v[16];
    const float* src = W + (size_t)(k0 + (lane >> 4)) * N + n0 + (lane & 15) * 4;
#pragma unroll
    for (int i = 0; i < 16; ++i) v[i] = *(const f32x4*)(src + (size_t)(i * 4) * N);
#pragma unroll
    for (int i = 0; i < 16; ++i) { LAS float* d = scr + (i * 4 + (lane >> 4)) * 65 + (lane & 15) * 4; d[0] = v[i][0] * scale; d[1] = v[i][1] * scale; d[2] = v[i][2] * scale; d[3] = v[i][3] * scale; }
    asm volatile("s_waitcnt lgkmcnt(0)" ::: "memory");
    const int c = lane & 3;
#pragma unroll
    for (int j = 0; j < 4; ++j) { const int n = j * 16 + (lane >> 2); const LAS float* s = scr + (16 * c) * 65 + n;
        u32x4 o; o.x = pg8::pk4_fp8(s[0], s[65], s[2 * 65], s[3 * 65]); o.y = pg8::pk4_fp8(s[4 * 65], s[5 * 65], s[6 * 65], s[7 * 65]);
        o.z = pg8::pk4_fp8(s[8 * 65], s[9 * 65], s[10 * 65], s[11 * 65]); o.w = pg8::pk4_fp8(s[12 * 65], s[13 * 65], s[14 * 65], s[15 * 65]);
        *(u32x4*)(WT + (size_t)(drow0 + n) * Kd + k0 + 16 * c) = o; }
    asm volatile("s_waitcnt lgkmcnt(0)" ::: "memory");
}

__device__ __forceinline__ void cvt_expert_item(const Ctx& a, unsigned char* ws, int l, int r, LAS float* scr, int lane) {
    constexpr int I_E = 512; const int le = l * 16 + r / (3 * I_E), q3 = r % (3 * I_E), kind = q3 / I_E, q = q3 % I_E;
    if (kind < 2) { const int kb = q / 32, nb = q % 32, n0 = nb * 64;
        const int drow = 256 * (n0 >> 7) + (n0 & 127) + kind * 128;
        tr_item8(a.in(kind == 0 ? I_WEG : I_WEU) + (size_t)le * D * FF, FF, (unsigned char*)(ws + WS_WGU) + (size_t)le * 4096 * D, D, kb * 64, n0, drow, scr, lane, pg8::F8_SW);
    } else { const int kb = q / 16, nb = q % 16;
        tr_item8(a.in(I_WED) + (size_t)le * FF * D, D, (unsigned char*)(ws + WS_WD) + (size_t)le * D * FF, FF, kb * 64, nb * 64, nb * 64, scr, lane, pg8::F8_SW); }
}
__device__ __forceinline__ void cvt_tail(const Ctx& a, int l_next, int first, int rank, int per) {
    PHASE_IDS(); LAS unsigned char* lds = launder_lds(a.lds); unsigned char* ws = a.ws(); LAS float* scr = (LAS float*)(lds + wave * 16640);
    const int base = first + (rank * 8 + wave) * per;
    for (int i = 0; i < per; ++i) { const int r = base + i; if (r < 24576) cvt_expert_item(a, ws, l_next, r, scr, lane); }
}

__device__ __forceinline__ void p0_prologue(const Ctx& a) {
    PHASE_IDS(); LAS unsigned char* lds = launder_lds(a.lds); unsigned char* ws = a.ws(); const float* cin_ = a.in(I_C); const float* cctx_ = a.in(I_CCTX);
    LAS float* scr = (LAS float*)(lds + wave * 16640);
    LAS float* scond = (LAS float*)(lds + 8 * 16640);
    for (int i = tid; i < 3 * D; i += 512) { const int w = i >> 10, k = i & 1023; const float cv = (w < 2) ? cin_[w * D + k] : cctx_[k]; scond[i] = cv * pg8::fast_sigmoid(cv); }
    if (blockIdx.x == 0) { const int c = tid; const float* lg = a.in(I_LBL);
        const float l0 = lg[c], l1 = lg[512 + c], l2 = lg[1024 + c], l3 = lg[1536 + c]; const float mx = fmaxf(fmaxf(l0, l1), fmaxf(l2, l3));
        const float e0 = expf(l0 - mx), e1 = expf(l1 - mx), e2 = expf(l2 - mx), e3 = expf(l3 - mx), inv = 1.0f / (e0 + e1 + e2 + e3);
        float* lbs = (float*)(ws + WS_LBS); lbs[c] = 0.f; lbs[512 + c] = e1 * inv; lbs[1024 + c] = (e1 + e2) * inv; lbs[1536 + c] = (e1 + e2 + e3) * inv; }
    if (blockIdx.x >= 1 && blockIdx.x <= 16) { const int idx = (blockIdx.x - 1) * 512 + tid, pos = idx >> 5, f = idx & 31;
        const float invf = powf(10000.0f, -(float)f / 32.0f), ang = (float)pos * invf; float* cs = (float*)(ws + WS_ROPE); cs[idx * 2] = cosf(ang); cs[idx * 2 + 1] = sinf(ang); }
    BAR_LDS();
    const int gw = blockIdx.x * 8 + wave, NGW = gridDim.x * 8;
    for (int it = gw; it < 4 * 24 * 8; it += NGW) { const int l = it / 192, r = it % 192, cg = r >> 3, ks = r & 7; const int cols = cg * 256 + lane * 4;
        const float* wp = a.in(I_WADA) + ((size_t)l * D + ks * 128) * 6144 + cols; f32x4 a0 = {0, 0, 0, 0}, a1 = a0, a2 = a0;
#pragma unroll 8
        for (int kk = 0; kk < 128; ++kk) { const f32x4 w = *(const f32x4*)(wp + (size_t)kk * 6144); const int k = ks * 128 + kk; a0 += w * scond[k]; a1 += w * scond[D + k]; a2 += w * scond[2 * D + k]; }
        float* pp = (float*)(ws + WS_MODP) + (size_t)((l * 8 + ks) * 3) * 6144 + cols; *(f32x4*)pp = a0; *(f32x4*)(pp + 6144) = a1; *(f32x4*)(pp + 2 * 6144) = a2; }
    constexpr int I_IN = 16 * 72, I_OUT = 16 * 16;
    const int n_exp = (gridDim.x == 256) ? 24576 : 4 * 24576;
    const int NIT = 4 * (I_IN + I_OUT) + n_exp;
    for (int it = gw; it < NIT; it += NGW) {
        int r = it;
        if (r < 4 * I_IN) { const int l = r / I_IN, q = r % I_IN, kb = q / 72, nb = q % 72;
            tr_item(a.in(I_WIN) + (size_t)l * D * INW, INW, (bf16_t*)(ws + WS_WIN) + (size_t)l * INW * D, D, kb * 64, nb * 64, nb * 64, scr, lane); continue; }
        r -= 4 * I_IN;
        if (r < 4 * I_OUT) { const int l = r / I_OUT, q = r % I_OUT, kb = q / 16, nb = q % 16;
            tr_item(a.in(I_WOUT) + (size_t)l * D * D, D, (bf16_t*)(ws + WS_WOUT) + (size_t)l * D * D, D, kb * 64, nb * 64, nb * 64, scr, lane); continue; }
        r -= 4 * I_OUT;
        cvt_expert_item(a, ws, r / 24576, r % 24576, scr, lane);
    }
}

__device__ __forceinline__ void p0_finalize(const Ctx& a) {
    PHASE_IDS(); unsigned char* ws = a.ws(); const float* bada = a.in(I_BADA); const float* part = (const float*)(ws + WS_MODP); float* mods = (float*)(ws + WS_MODS);
    for (int i = blockIdx.x * 512 + tid; i < 4 * 3 * 6144; i += gridDim.x * 512) { const int l = i / (3 * 6144), r = i % (3 * 6144), w = r / 6144, j = r % 6144;
        float s = bada[l * 6144 + j];
#pragma unroll
        for (int ks = 0; ks < 8; ++ks) s += part[(size_t)((l * 8 + ks) * 3 + w) * 6144 + j];
        mods[i] = s; }
}

template <int MODE>
__device__ __forceinline__ void norm1_phase(const Ctx& a, int l) {
    PHASE_IDS(); unsigned char* ws = a.ws(); const float* in_x = a.in(I_X); const float* in_ctx = a.in(I_CTX); const float* gm = (MODE != 1) ? a.in(I_GMIX) + l * D : a.in(I_GFIN); float* outp = a.out(); const int gw = blockIdx.x * 8 + wave, NGW = gridDim.x * 8;
    const float* mods = (const float*)(ws + WS_MODS); bf16_t* X = (bf16_t*)(ws + WS_X); bf16_t* H = (bf16_t*)(ws + WS_H);
    const int* inv = (const int*)(ws + WS_INV); const bf16_t* YS = (const bf16_t*)(ws + WS_YS); const float* gate = (const float*)(ws + WS_ROWMAP) + MOE_ROWS;
    constexpr int NTOT = (MODE == 1) ? NB * SEQ : MROWS;
#define N1_ROWOF(n_) ((MODE == 1) ? (((n_) >> 14) * LTOT + CTX + ((n_) & (SEQ - 1))) : (n_))
#define N1_LOADROW(n_, v_, iv_) do { const int r_ = N1_ROWOF(n_); const int b_ = r_ >= LTOT ? 1 : 0, g_ = r_ - b_ * LTOT; \
        if (l == 0) { const float* src_ = (g_ < CTX ? in_ctx + (size_t)(b_ * CTX + g_) * D : in_x + (size_t)(b_ * SEQ + g_ - CTX) * D); \
            _Pragma("unroll") for (int j = 0; j < 4; ++j) v_[j] = *(const f32x4*)(src_ + lane * 4 + 256 * j); } \
        else { const bf16_t* src_ = X + (size_t)r_ * D; _Pragma("unroll") for (int j = 0; j < 4; ++j) { const u32x2 w_ = *(const u32x2*)(src_ + lane * 4 + 256 * j); v_[j] = (f32x4){bf_lo(w_.x), bf_hi(w_.x), bf_lo(w_.y), bf_hi(w_.y)}; } \
            iv_ = inv[r_ * 16 + (lane & 15)]; } } while (0)
    f32x4 v[4]; int iv = -1; int n = gw;
    if (n < NTOT) N1_LOADROW(n, v, iv);
    for (; n < NTOT; n += NGW) {
        const int row = N1_ROWOF(n); const int b = row >= LTOT ? 1 : 0, g = row - b * LTOT; const bool isctx = g < CTX; const int which = isctx ? 2 : b;
        f32x4 vn[4]; int ivn = -1; const int nn = n + NGW;
        if (nn < NTOT) N1_LOADROW(nn, vn, ivn);
        if (l != 0) {
            unsigned vm = (unsigned)__builtin_amdgcn_ballot_w64(iv >= 0) & 0xffffu;
            f32x4 s[4] = {{0, 0, 0, 0}, {0, 0, 0, 0}, {0, 0, 0, 0}, {0, 0, 0, 0}};
            while (vm) {
                const int e0 = __builtin_ctz(vm); vm &= vm - 1; const bool has1 = vm != 0u; const int e1 = has1 ? __builtin_ctz(vm) : e0; if (has1) vm &= vm - 1;
                const int mr0 = __builtin_amdgcn_readlane(iv, e0), mr1 = __builtin_amdgcn_readlane(iv, e1);
                const float g0 = gate[mr0], g1 = has1 ? gate[mr1] : 0.f;
                const bf16_t* y0r = YS + (size_t)mr0 * D + lane * 4; const bf16_t* y1r = YS + (size_t)mr1 * D + lane * 4; u32x2 y0[4], y1[4];
#pragma unroll
                for (int j = 0; j < 4; ++j) { y0[j] = *(const u32x2*)(y0r + 256 * j); y1[j] = *(const u32x2*)(y1r + 256 * j); }
#pragma unroll
                for (int j = 0; j < 4; ++j) { s[j][0] += g0 * bf_lo(y0[j].x) + g1 * bf_lo(y1[j].x); s[j][1] += g0 * bf_hi(y0[j].x) + g1 * bf_hi(y1[j].x);
                    s[j][2] += g0 * bf_lo(y0[j].y) + g1 * bf_lo(y1[j].y); s[j][3] += g0 * bf_hi(y0[j].y) + g1 * bf_hi(y1[j].y); } }
            const float* gt2 = mods + (size_t)((l - 1) * 3 + which) * 6144 + 5 * D; bf16_t* xr = X + (size_t)row * D;
#pragma unroll
            for (int j = 0; j < 4; ++j) { v[j] += *(const f32x4*)(gt2 + lane * 4 + 256 * j) * s[j]; if (MODE == 0) { u32x2 w; w.x = cvt_pk_bf16(v[j][0], v[j][1]); w.y = cvt_pk_bf16(v[j][2], v[j][3]); *(u32x2*)(xr + lane * 4 + 256 * j) = w; } }
        }
        float ss = 0.f;
#pragma unroll
        for (int j = 0; j < 4; ++j) ss += (v[j][0] * v[j][0] + v[j][1] * v[j][1]) + (v[j][2] * v[j][2] + v[j][3] * v[j][3]);
        const float rinv = __builtin_amdgcn_rsqf(wave_sum(ss, lane) * (1.0f / D) + EPS);
        if (MODE != 1) {
            const float* sh = mods + (size_t)(l * 3 + which) * 6144; const float* sc = sh + D;
            bf16_t* hr = H + (size_t)row * D + lane * 4;
#pragma unroll
            for (int j = 0; j < 4; ++j) { const int c = lane * 4 + 256 * j; const f32x4 gg = *(const f32x4*)(gm + c), s1 = *(const f32x4*)(sc + c), s0 = *(const f32x4*)(sh + c);
                const f32x4 y = v[j] * rinv * gg * (s1 + 1.0f) + s0; u32x2 w; w.x = cvt_pk_bf16(y[0], y[1]); w.y = cvt_pk_bf16(y[2], y[3]); *(u32x2*)(hr + 256 * j) = w; }
        } else {
            float* orow = outp + (size_t)(b * SEQ + g - CTX) * D + lane * 4;
#pragma unroll
            for (int j = 0; j < 4; ++j) *(f32x4*)(orow + 256 * j) = v[j] * rinv * *(const f32x4*)(gm + lane * 4 + 256 * j);
        }
#pragma unroll
        for (int j = 0; j < 4; ++j) v[j] = vn[j];
        iv = ivn;
    }
#undef N1_ROWOF
#undef N1_LOADROW
}

__device__ __forceinline__ void norm2_phase(const Ctx& a, int l) {
    PHASE_IDS(); LAS unsigned char* lds = launder_lds(a.lds); unsigned char* ws = a.ws(); const float* gm = a.in(I_GFFN) + l * D; const int gw = blockIdx.x * 8 + wave, NGW = gridDim.x * 8;
    const float* mods = (const float*)(ws + WS_MODS); const bf16_t* X = (const bf16_t*)(ws + WS_X); unsigned char* H8 = (unsigned char*)(ws + WS_H);
    int* inv = (int*)(ws + WS_INV); float* afl = (float*)(ws + WS_AFF); float* afc = afl + 2 * 16 * SEQ;
    LAS float* wrT = (LAS float*)lds;
    { const float* src = a.in(I_WR) + (size_t)l * D * NE; for (int i = tid; i < D * NE / 4; i += 512) { const f32x4 w = *(const f32x4*)(src + i * 4); const int d = i >> 2, e0 = (i & 3) * 4;
        wrT[(e0 + 0) * D + d] = w[0]; wrT[(e0 + 1) * D + d] = w[1]; wrT[(e0 + 2) * D + d] = w[2]; wrT[(e0 + 3) * D + d] = w[3]; } }
    BAR_LDS();
    const bool last = (l == DEPTH - 1);
    const int NTOT = last ? NB * SEQ : MROWS;
#define N2_ROWOF(n_) (last ? (((n_) >> 14) * LTOT + CTX + ((n_) & (SEQ - 1))) : (n_))
    f32x4 v[4]; int n = gw;
    if (n < NTOT) { const bf16_t* xr0 = X + (size_t)N2_ROWOF(n) * D;
#pragma unroll
        for (int j = 0; j < 4; ++j) { const u32x2 w = *(const u32x2*)(xr0 + lane * 4 + 256 * j); v[j] = (f32x4){bf_lo(w.x), bf_hi(w.x), bf_lo(w.y), bf_hi(w.y)}; } }
    for (; n < NTOT; n += NGW) {
        const int row = N2_ROWOF(n); const int b = row >= LTOT ? 1 : 0, g = row - b * LTOT; const bool isctx = g < CTX; const int which = isctx ? 2 : b;
        f32x4 vn[4]; const int nn = n + NGW;
        if (nn < NTOT) { const bf16_t* xr1 = X + (size_t)N2_ROWOF(nn) * D;
#pragma unroll
            for (int j = 0; j < 4; ++j) { const u32x2 w = *(const u32x2*)(xr1 + lane * 4 + 256 * j); vn[j] = (f32x4){bf_lo(w.x), bf_hi(w.x), bf_lo(w.y), bf_hi(w.y)}; } }
        float ss = 0.f;
#pragma unroll
        for (int j = 0; j < 4; ++j) ss += (v[j][0] * v[j][0] + v[j][1] * v[j][1]) + (v[j][2] * v[j][2] + v[j][3] * v[j][3]);
        const float rinv = __builtin_amdgcn_rsqf(wave_sum(ss, lane) * (1.0f / D) + EPS);
        const float* sh = mods + (size_t)(l * 3 + which) * 6144 + 3 * D; const float* sc = sh + D;
        unsigned char* hr = H8 + (size_t)row * D + lane * 4;
        float p[16];
#pragma unroll
        for (int e = 0; e < 16; ++e) p[e] = 0.f;
#pragma unroll
        for (int j = 0; j < 4; ++j) { const int c = lane * 4 + 256 * j; const f32x4 gg = *(const f32x4*)(gm + c), s1 = *(const f32x4*)(sc + c), s0 = *(const f32x4*)(sh + c);
            const f32x4 y = v[j] * rinv * gg * (s1 + 1.0f) + s0; *(unsigned*)(hr + 256 * j) = pg8::pk4_fp8(y[0] * pg8::F8_SA, y[1] * pg8::F8_SA, y[2] * pg8::F8_SA, y[3] * pg8::F8_SA);
#pragma unroll
            for (int e = 0; e < 16; ++e) { const f32x4 w = *(const LAS f32x4*)(wrT + e * D + c); p[e] += (y[0] * w[0] + y[1] * w[1]) + (y[2] * w[2] + y[3] * w[3]); } }
        { const bool hi = (lane & 32) != 0;
#pragma unroll
          for (int i = 0; i < 8; ++i) { const float send = hi ? p[i] : p[i + 8], keep = hi ? p[i + 8] : p[i]; p[i] = keep + shx(send, 32, lane); } }
        { const bool hi = (lane & 16) != 0;
#pragma unroll
          for (int i = 0; i < 4; ++i) { const float send = hi ? p[i] : p[i + 4], keep = hi ? p[i + 4] : p[i]; p[i] = keep + shx(send, 16, lane); } }
        { const bool hi = (lane & 8) != 0;
#pragma unroll
          for (int i = 0; i < 2; ++i) { const float send = hi ? p[i] : p[i + 2], keep = hi ? p[i + 2] : p[i]; p[i] = keep + shx(send, 8, lane); } }
        { const bool hi = (lane & 4) != 0; const float send = hi ? p[0] : p[1], keep = hi ? p[1] : p[0]; p[0] = keep + shx(send, 4, lane); }
        float lg = p[0]; lg += shx(lg, 2, lane); lg += shx(lg, 1, lane);
        float mx = lg; mx = fmaxf(mx, shx(mx, 4, lane)); mx = fmaxf(mx, shx(mx, 8, lane)); mx = fmaxf(mx, shx(mx, 16, lane)); mx = fmaxf(mx, shx(mx, 32, lane));
        const float ex = expf(lg - mx); float sm = ex; sm += shx(sm, 4, lane); sm += shx(sm, 8, lane); sm += shx(sm, 16, lane); sm += shx(sm, 32, lane);
        const float aff = ex / sm; const int e = lane >> 2;
        if ((lane & 3) == 0) { if (isctx) afc[(b * 16 + e) * CTX + g] = aff; else afl[(size_t)(b * 16 + e) * SEQ + (g - CTX)] = aff; }
        if (lane < 16) inv[row * 16 + lane] = -1;
#pragma unroll
        for (int j = 0; j < 4; ++j) v[j] = vn[j];
    }
#undef N2_ROWOF
}

__device__ __forceinline__ void topk_phase(const Ctx& a, int l) {
    PHASE_IDS(); LAS unsigned char* lds = launder_lds(a.lds); unsigned char* ws = a.ws(); const float* afl = (const float*)(ws + WS_AFF); const float* afc = afl + 2 * 16 * SEQ;
    int* rowmap = (int*)(ws + WS_ROWMAP); float* gate = (float*)(ws + WS_ROWMAP) + MOE_ROWS; int* inv = (int*)(ws + WS_INV);
    LAS unsigned* wcnt = (LAS unsigned*)lds;
    const int nitems = (l == DEPTH - 1) ? 32 : 64;
    for (int it = blockIdx.x; it < nitems; it += gridDim.x) {
        const bool isctx = it >= 32; const int be = it & 31, b = be >> 4, e = be & 15;
        const int n = isctx ? CTX : SEQ, k = isctx ? CAP_CTX : CAP_LAT;
        const float* src = isctx ? afc + be * CTX : afl + (size_t)be * SEQ;
        unsigned key[32];
#pragma unroll
        for (int i = 0; i < 32; ++i) { const int idx = i * 512 + tid; key[i] = idx < n ? __float_as_uint(src[idx]) : 0u; }
        unsigned T = 0u;
        for (int bit = 30; bit >= 0; --bit) { const unsigned cand = T | (1u << bit); unsigned cnt = 0;
#pragma unroll
            for (int i = 0; i < 32; ++i) cnt += (key[i] >= cand) ? 1u : 0u;
#pragma unroll
            for (int o = 1; o < 64; o <<= 1) cnt += shxu(cnt, o, lane);
            LAS unsigned* wc = wcnt + (bit & 1) * 8; if (lane == 0) wc[wave] = cnt;
            BAR_LDS();
            unsigned tot = 0;
#pragma unroll
            for (int w = 0; w < 8; ++w) tot += wc[w];
            if (tot >= (unsigned)k) T = cand; }
        unsigned mine = 0;
#pragma unroll
        for (int i = 0; i < 32; ++i) mine += (key[i] > T ? 1u : 0u) + (key[i] == T ? 65536u : 0u);
        unsigned incl = mine;
#pragma unroll
        for (int o = 1; o < 64; o <<= 1) { const unsigned t = shupu(incl, o, lane); if (lane >= o) incl += t; }
        LAS unsigned* wt = wcnt + 16; BAR_LDS();
        if (lane == 63) wt[wave] = incl;
        BAR_LDS();
        unsigned base = 0, total = 0;
#pragma unroll
        for (int w = 0; w < 8; ++w) { const unsigned t = wt[w]; total += t; if (w < wave) base += t; }
        const unsigned excl = base + incl - mine; const unsigned cgt = total & 0xffffu; const unsigned need = (unsigned)k - cgt;
        unsigned sg = excl & 0xffffu, se = excl >> 16;
        const int mrbase = e * MOE_ROWS_E + (isctx ? 4096 + b * CAP_CTX : b * CAP_LAT);
        const int rbase = b * LTOT + (isctx ? 0 : CTX);
#pragma unroll
        for (int i = 0; i < 32; ++i) { const int idx = i * 512 + tid; const unsigned kk = key[i]; int slot = -1;
            if (kk > T) { slot = (int)sg; ++sg; } else if (kk == T) { if (se < need) slot = (int)(cgt + se); ++se; }
            if (slot >= 0) { const int mr = mrbase + slot, r = rbase + idx; rowmap[mr] = r; gate[mr] = __uint_as_float(kk); inv[r * 16 + e] = mr; } }
        if (isctx && b == 0 && tid < 192) { const int mr = e * MOE_ROWS_E + 4160 + tid; rowmap[mr] = 0; gate[mr] = 0.f; }
        BAR_LDS();
    }
}


constexpr int SC_QI = 0, SC_KI = 17408, SC_KT = 34816, SC_VT = 53248, SC_PI = 71680, SC_SM = 80896, SC_PART = 115712, SC_VA = 119808, SC_VB = 120320, SC_VM = 120832, SC_RED = 121344;
constexpr int ST_Q = 272, ST_T = 144;

__device__ __forceinline__ bf16x8 ldfrag(const LAS unsigned char* base, int row, int stride, int kelem) { return *(const LAS bf16x8*)(base + row * stride + kelem * 2); }
#define MFMA16(a, b, c) __builtin_amdgcn_mfma_f32_16x16x32_bf16((a), (b), (c), 0, 0, 0)
#ifndef SCAN_LOG2
__device__ __forceinline__ float ex2(float x) { return __builtin_amdgcn_exp2f(x * 1.4426950408889634f); }
#define LOG2E_ 1.0f
#else
__device__ __forceinline__ float ex2(float x) { return __builtin_amdgcn_exp2f(x); }
#define LOG2E_ 1.4426950408889634f
#endif

__device__ __forceinline__ void scan_write_T(LAS unsigned char* img, const unsigned (&d)[8], int cp, int to) {
    u32x4 wa, wb;
    wa.x = (d[0] & 0xffffu) | (d[1] << 16); wa.y = (d[2] & 0xffffu) | (d[3] << 16); wa.z = (d[4] & 0xffffu) | (d[5] << 16); wa.w = (d[6] & 0xffffu) | (d[7] << 16);
    wb.x = (d[0] >> 16) | (d[1] & 0xffff0000u); wb.y = (d[2] >> 16) | (d[3] & 0xffff0000u); wb.z = (d[4] >> 16) | (d[5] & 0xffff0000u); wb.w = (d[6] >> 16) | (d[7] & 0xffff0000u);
    *(LAS u32x4*)(img + (2 * cp) * ST_T + to * 16) = wa; *(LAS u32x4*)(img + (2 * cp + 1) * ST_T + to * 16) = wb;
}

template <bool FULL>
__device__ __forceinline__ void scan_estage_hg(LAS unsigned char* lds, const unsigned (&kraw)[8], const unsigned (&qraw)[8], const unsigned (&vraw)[8], int lane, int wave, float& la_out, float& lb_out) {
    const int cp = lane, to = wave;
    float ca[8], cb[8]; float ra = 0.f, rb = 0.f;
#pragma unroll
    for (int tt = 0; tt < 8; ++tt) { ra += bf_lo(kraw[tt]); rb += bf_hi(kraw[tt]); ca[tt] = ra; cb[tt] = rb; }
    *(LAS f32x2*)(lds + SC_PART + (to * 128 + 2 * cp) * 4) = (f32x2){ra, rb};
    BAR_LDS();
    float pa = 0.f, pb = 0.f, ma = 0.f, mb = 0.f, la = 0.f, lb = 0.f;
#pragma unroll
    for (int t8 = 0; t8 < 8; ++t8) { const f32x2 pp = *(const LAS f32x2*)(lds + SC_PART + (t8 * 128 + 2 * cp) * 4);
        if (t8 < to) { pa += pp.x; pb += pp.y; } if (t8 < 4) { ma += pp.x; mb += pp.y; } la += pp.x; lb += pp.y; }
    pa -= ma; pb -= mb;
    unsigned kd[8];
#pragma unroll
    for (int tt = 0; tt < 8; ++tt) { const int rr = 8 * to + tt;
        const float da = pa + ca[tt], db = pb + cb[tt];
        const float ka = 1.0f - ex2(bf_lo(kraw[tt])), kb = 1.0f - ex2(bf_hi(kraw[tt]));
        kd[tt] = cvt_pk_bf16(ka * ex2(-da), kb * ex2(-db));
        if (FULL) { *(LAS unsigned*)(lds + SC_QI + rr * ST_Q + cp * 4) = cvt_pk_bf16(bf_lo(qraw[tt]) * ex2(da), bf_hi(qraw[tt]) * ex2(db));
            *(LAS unsigned*)(lds + SC_KI + rr * ST_Q + cp * 4) = kd[tt]; } }
    scan_write_T(lds + SC_KT, kd, cp, to); scan_write_T(lds + SC_VT, vraw, cp, to);
    if (to == 0) { *(LAS f32x2*)(lds + SC_VA + 8 * cp) = (f32x2){ex2(la), ex2(lb)}; *(LAS f32x2*)(lds + SC_VB + 8 * cp) = (f32x2){ex2(la - ma), ex2(lb - mb)};
        *(LAS f32x2*)(lds + SC_VM + 8 * cp) = (f32x2){ex2(ma), ex2(mb)}; }
    la_out = la; lb_out = lb;
}
template <bool FULL>
__device__ __forceinline__ void scan_estage_ret(LAS unsigned char* lds, const unsigned (&kraw)[8], const unsigned (&qraw)[8], const unsigned (&vraw)[8], int lane, int wave, float lg2) {
    const int cp = lane, to = wave; unsigned kd[8];
#pragma unroll
    for (int tt = 0; tt < 8; ++tt) { const int rr = 8 * to + tt; const float wk = ex2((float)(63 - rr) * lg2); kd[tt] = cvt_pk_bf16(bf_lo(kraw[tt]) * wk, bf_hi(kraw[tt]) * wk);
        if (FULL) { *(LAS unsigned*)(lds + SC_QI + rr * ST_Q + cp * 4) = qraw[tt]; *(LAS unsigned*)(lds + SC_KI + rr * ST_Q + cp * 4) = kraw[tt]; } }
    scan_write_T(lds + SC_KT, kd, cp, to); scan_write_T(lds + SC_VT, vraw, cp, to);
}

template <bool RET>
__device__ __forceinline__ void scan_state_update(LAS unsigned char* lds, f32x4 (&ST)[8], int wave, int fr, int fq, float g64) {
    const bf16x8 a0 = ldfrag(lds + SC_KT, 16 * wave + fr, ST_T, 8 * fq), a1 = ldfrag(lds + SC_KT, 16 * wave + fr, ST_T, 32 + 8 * fq);
    f32x4 av = {g64, g64, g64, g64}, bv = {1.f, 1.f, 1.f, 1.f};
    if (!RET) { av = *(const LAS f32x4*)(lds + SC_VA + (16 * wave + 4 * fq) * 4); bv = *(const LAS f32x4*)(lds + SC_VB + (16 * wave + 4 * fq) * 4); }
#pragma unroll
    for (int vi = 0; vi < 8; ++vi) { const bf16x8 b0 = ldfrag(lds + SC_VT, 16 * vi + fr, ST_T, 8 * fq), b1 = ldfrag(lds + SC_VT, 16 * vi + fr, ST_T, 32 + 8 * fq);
        f32x4 u = {0.f, 0.f, 0.f, 0.f}; u = MFMA16(a0, b0, u); u = MFMA16(a1, b1, u); ST[vi] = RET ? (av * ST[vi] + u) : (av * ST[vi] + bv * u); }
}

#define SCAN_LOAD_CHUNK(crow_, dir_) do { _Pragma("unroll") for (int tt = 0; tt < 8; ++tt) { const int rr_ = 8 * wave + tt; const size_t ro_ = (size_t)((crow_) + ((dir_) ? 63 - rr_ : rr_)) * INW + 2 * lane; \
        kraw[tt] = *(const unsigned*)(P + ro_ + colk); vraw[tt] = *(const unsigned*)(P + ro_ + colv); if (LOADQ) qraw[tt] = *(const unsigned*)(P + ro_ + colq); } } while (0)
#define SCAN_STORE_STATE(slot_) do { _Pragma("unroll") for (int vi = 0; vi < 8; ++vi) { u32x2 w; w.x = cvt_pk_bf16(ST[vi][0], ST[vi][1]); w.y = cvt_pk_bf16(ST[vi][2], ST[vi][3]); \
        *(u32x2*)(UB + (size_t)(slot_) * 16384 + (size_t)(vi * 512 + tid) * 4) = w; } } while (0)

struct ScanPtrs { const bf16_t* P; const bf16_t* SB; bf16_t* UB; float* AB; bf16_t* MIX; float* OB; const float* rdec; const float* onorm; };

template <bool RET>
__device__ __forceinline__ void scan1_item(const ScanPtrs& sp, LAS unsigned char* lds, int tid, int lane, int wave, int seq, int tb) {
    const bf16_t* P = sp.P; bf16_t* UB = sp.UB; const int fr = lane & 15, fq = lane >> 4; constexpr bool LOADQ = false;
    const int b = seq >> 4, hh = (seq >> 1) & 7, dir = seq & 1, h = hh & 3;
    const int colk = RET ? 6 * 512 + h * 128 : (dir ? 2 * 512 : 512) + h * 128, colv = (RET ? 7 * 512 : 3 * 512) + h * 128, colq = 0;
    const float lg2 = RET ? -expf(sp.rdec[dir * 4 + h]) * LOG2E_ : 0.f, g64 = ex2(64.f * lg2);
    const int rowbase = b * LTOT + tb * 256;
    f32x4 ST[8];
#pragma unroll
    for (int vi = 0; vi < 8; ++vi) ST[vi] = (f32x4){0.f, 0.f, 0.f, 0.f};
    float ata = 0.f, atb = 0.f; unsigned kraw[8], qraw[8], vraw[8];
#pragma unroll
    for (int tt = 0; tt < 8; ++tt) qraw[tt] = 0u;
    SCAN_LOAD_CHUNK(rowbase + (dir ? 3 : 0) * 64, dir);
#pragma unroll 1
    for (int ci = 0; ci < 4; ++ci) {
        if (RET) scan_estage_ret<false>(lds, kraw, qraw, vraw, lane, wave, lg2);
        else { float la, lb; scan_estage_hg<false>(lds, kraw, qraw, vraw, lane, wave, la, lb); ata += la; atb += lb; }
        if (ci < 3) { const int tc = dir ? 2 - ci : ci + 1; SCAN_LOAD_CHUNK(rowbase + tc * 64, dir); }
        BAR_LDS();
        scan_state_update<RET>(lds, ST, wave, fr, fq, g64);
        BAR_LDS();
    }
    const int slot = seq * 65 + tb;
    SCAN_STORE_STATE(slot);
    if (wave == 0) *(f32x2*)(sp.AB + (size_t)slot * 128 + 2 * lane) = RET ? (f32x2){ex2(256.f * lg2), ex2(256.f * lg2)} : (f32x2){ex2(ata), ex2(atb)};
}

template <bool RET>
__device__ __forceinline__ void scan3_item(const ScanPtrs& sp, LAS unsigned char* lds, int tid, int lane, int wave, int bh, int tb, bool store_state) {
#ifdef PROBE_SKIP
    if ((PROBE_SKIP == 1 && RET) || (PROBE_SKIP == 2 && !RET)) return;
#endif
    const bf16_t* P = sp.P; bf16_t* UB = sp.UB; float* OB = sp.OB;
    const int ti = wave & 3, vh = wave >> 2; constexpr bool LOADQ = true;
    const int b = bh >> 3, hh = bh & 7, h = hh & 3;
    const int colq = (RET ? 5 * 512 : 0) + h * 128, colv = (RET ? 7 * 512 : 3 * 512) + h * 128, colg = (RET ? 8 * 512 : 4 * 512) + h * 128, mixcol = hh * 128;
    const int rowbase = b * LTOT + tb * 256;
#pragma unroll 1
    for (int dir = 1; dir >= 0; --dir) {
        const int colk = RET ? 6 * 512 + h * 128 : (dir ? 2 * 512 : 512) + h * 128;
        const float lg2 = RET ? -expf(sp.rdec[dir * 4 + h]) * LOG2E_ : 0.f, g64 = ex2(64.f * lg2);
        f32x4 ST[8];
        if (tb == 0) {
#pragma unroll
            for (int vi = 0; vi < 8; ++vi) ST[vi] = (f32x4){0.f, 0.f, 0.f, 0.f};
        } else { const size_t slot = (size_t)(bh * 2 + dir) * 65 + tb;
#pragma unroll
            for (int vi = 0; vi < 8; ++vi) { const u32x2 w = *(const u32x2*)(sp.SB + slot * 16384 + (size_t)(vi * 512 + tid) * 4); ST[vi] = (f32x4){bf_lo(w.x), bf_hi(w.x), bf_lo(w.y), bf_hi(w.y)}; } }
        float ata = 0.f, atb = 0.f; unsigned kraw[8], qraw[8], vraw[8];
        SCAN_LOAD_CHUNK(rowbase + (dir ? 3 : 0) * 64, dir);
#pragma unroll 1
        for (int ci = 0; ci < 4; ++ci) {
            const int tc = dir ? 3 - ci : ci;
            int lane_ = lane; asm volatile("" : "+v"(lane_));
            const int fr = lane_ & 15, fq = lane_ >> 4, t = 16 * ti + fr; const float gt1 = ex2((float)(t + 1) * lg2);
            if (RET) scan_estage_ret<true>(lds, kraw, qraw, vraw, lane, wave, lg2);
            else { float la, lb; scan_estage_hg<true>(lds, kraw, qraw, vraw, lane, wave, la, lb); ata += la; atb += lb; }
            if (ci < 3) { const int tcn = dir ? 2 - ci : ci + 1; SCAN_LOAD_CHUNK(rowbase + tcn * 64, dir); }
            const int tok = tc * 64 + (dir ? 63 - t : t), grow = rowbase + tok;
            f32x4 obv[4]; u32x2 gv[4];
            if (dir == 0) {
#pragma unroll
                for (int j = 0; j < 4; ++j) { obv[j] = *(const f32x4*)(OB + tok * 128 + 16 * (4 * vh + j) + 4 * fq); gv[j] = *(const u32x2*)(P + (size_t)grow * INW + colg + 16 * (4 * vh + j) + 4 * fq); } }
            if (!RET) BAR_LDS();
            { f32x4 em = {1.f, 1.f, 1.f, 1.f}; if (!RET) em = *(const LAS f32x4*)(lds + SC_VM + (16 * wave + 4 * fq) * 4);
#pragma unroll
              for (int vi = 0; vi < 8; ++vi) { const f32x4 x = RET ? ST[vi] : ST[vi] * em; u32x2 w; w.x = cvt_pk_bf16(x[0], x[1]); w.y = cvt_pk_bf16(x[2], x[3]); *(LAS u32x2*)(lds + SC_SM + (16 * vi + fr) * ST_Q + (16 * wave + 4 * fq) * 2) = w; } }
            if (RET) BAR_LDS();
#pragma unroll
            for (int sii = 0; sii < 2; ++sii) { const int si = 2 * vh + sii; f32x4 sc = {0.f, 0.f, 0.f, 0.f};
                if (si <= ti) {
#pragma unroll
                    for (int ks = 0; ks < 4; ++ks) sc = MFMA16(ldfrag(lds + SC_KI, 16 * si + fr, ST_Q, 32 * ks + 8 * fq), ldfrag(lds + SC_QI, 16 * ti + fr, ST_Q, 32 * ks + 8 * fq), sc);
                    const int s0 = 16 * si + 4 * fq;
#pragma unroll
                    for (int r = 0; r < 4; ++r) { const float dm = RET ? ex2((float)(t - s0 - r) * lg2) : 1.0f; sc[r] = (s0 + r <= t) ? sc[r] * dm : 0.f; } }
                u32x2 w; w.x = cvt_pk_bf16(sc[0], sc[1]); w.y = cvt_pk_bf16(sc[2], sc[3]); *(LAS u32x2*)(lds + SC_PI + t * ST_T + (16 * si + 4 * fq) * 2) = w; }
            BAR_LDS();
            f32x4 o[4];
#pragma unroll
            for (int j = 0; j < 4; ++j) o[j] = (f32x4){0.f, 0.f, 0.f, 0.f};
#pragma unroll
            for (int ks = 0; ks < 4; ++ks) { const bf16x8 bf = ldfrag(lds + SC_QI, 16 * ti + fr, ST_Q, 32 * ks + 8 * fq);
#pragma unroll
                for (int j = 0; j < 4; ++j) o[j] = MFMA16(ldfrag(lds + SC_SM, 16 * (4 * vh + j) + fr, ST_Q, 32 * ks + 8 * fq), bf, o[j]); }
            if (RET) {
#pragma unroll
                for (int j = 0; j < 4; ++j) o[j] *= gt1; }
#pragma unroll
            for (int ks = 0; ks < 2; ++ks) { const bf16x8 bf = ldfrag(lds + SC_PI, 16 * ti + fr, ST_T, 32 * ks + 8 * fq);
#pragma unroll
                for (int j = 0; j < 4; ++j) o[j] = MFMA16(ldfrag(lds + SC_VT, 16 * (4 * vh + j) + fr, ST_T, 32 * ks + 8 * fq), bf, o[j]); }
            scan_state_update<RET>(lds, ST, wave, fr, fq, g64);
            if (dir == 1) {
#pragma unroll
                for (int j = 0; j < 4; ++j) *(f32x4*)(OB + tok * 128 + 16 * (4 * vh + j) + 4 * fq) = o[j];
                BAR_LDS();
            } else {
                float ss = 0.f;
#pragma unroll
                for (int j = 0; j < 4; ++j) { o[j] += obv[j]; ss += (o[j][0] * o[j][0] + o[j][1] * o[j][1]) + (o[j][2] * o[j][2] + o[j][3] * o[j][3]); }
                ss += shx(ss, 16, lane_); ss += shx(ss, 32, lane_);
                if (fq == 0) *(LAS float*)(lds + SC_RED + ((ci & 1) * 128 + vh * 64 + t) * 4) = ss;
                BAR_LDS();
                const float tot = ss + *(const LAS float*)(lds + SC_RED + ((ci & 1) * 128 + (vh ^ 1) * 64 + t) * 4);
                const float rinv = __builtin_amdgcn_rsqf(tot * (1.0f / 128.0f) + EPS);
#pragma unroll
                for (int j = 0; j < 4; ++j) { const f32x4 onv = RET ? (f32x4){1.f, 1.f, 1.f, 1.f} : *(const f32x4*)(sp.onorm + 16 * (4 * vh + j) + 4 * fq);
                    const f32x4 y = o[j] * rinv * onv * (f32x4){bf_lo(gv[j].x), bf_hi(gv[j].x), bf_lo(gv[j].y), bf_hi(gv[j].y)};
                    u32x2 w; w.x = cvt_pk_bf16(y[0], y[1]); w.y = cvt_pk_bf16(y[2], y[3]); *(u32x2*)(sp.MIX + (size_t)grow * D + mixcol + 16 * (4 * vh + j) + 4 * fq) = w; }
#ifdef PROBE_BAR
                BAR_LDS();
#endif
            }
        }
        if (store_state) { const int slot = (bh * 2 + dir) * 65 + tb; SCAN_STORE_STATE(slot);
            if (wave == 0) *(f32x2*)(sp.AB + (size_t)slot * 128 + 2 * lane) = RET ? (f32x2){ex2(256.f * lg2), ex2(256.f * lg2)} : (f32x2){ex2(ata), ex2(atb)}; }
        BAR_ALL();
    }
}

__device__ __forceinline__ ScanPtrs scan_ptrs(const Ctx& a, int l) {
    unsigned char* ws = a.ws(); ScanPtrs sp; sp.P = (const bf16_t*)(ws + WS_P); sp.SB = (const bf16_t*)(ws + WS_SB); sp.UB = (bf16_t*)(ws + WS_UB); sp.AB = (float*)(ws + WS_AB); sp.MIX = (bf16_t*)(ws + WS_MIX);
    sp.OB = (float*)(ws + WS_OB) + (size_t)blockIdx.x * 32768; sp.rdec = a.in(I_RDEC) + l * 8; sp.onorm = a.in(I_ONORM) + l * 128; return sp;
}

__device__ __forceinline__ void scan1_phase(const Ctx& a, int l) {
    PHASE_IDS(); LAS unsigned char* lds = launder_lds(a.lds); const ScanPtrs sp = scan_ptrs(a, l);
#ifdef PROBE_NOMERGE
    const bool last = true; const int c = blockIdx.x, G = gridDim.x;
#else
    const bool last = (l == DEPTH - 1); const int c = blockIdx.x, G = gridDim.x;
#endif
    if (last || G < 32) {
        if (!last) for (int bh = c; bh < 16; bh += G) { if ((bh & 7) >= 4) scan3_item<true>(sp, lds, tid, lane, wave, bh, 0, true); else scan3_item<false>(sp, lds, tid, lane, wave, bh, 0, true); }
        for (int it = c; it < 2048; it += G) { const int seq = it >> 6, j = it & 63; if (!last && j == 0) continue; const int dir = seq & 1, tb = dir ? (j == 0 ? 0 : 65 - j) : j;
            if (((seq >> 1) & 7) >= 4) scan1_item<true>(sp, lds, tid, lane, wave, seq, tb); else scan1_item<false>(sp, lds, tid, lane, wave, seq, tb); }
        return;
    }
    if (c < 16) { if ((c & 7) >= 4) scan3_item<true>(sp, lds, tid, lane, wave, c, 0, true); else scan3_item<false>(sp, lds, tid, lane, wave, c, 0, true); }
    for (int k = (c < 16 ? 5 : 0);; ++k) {
        const int li = k < 5 ? k * (G - 16) + (c - 16) : 5 * (G - 16) + (k - 5) * G + c;
        if (li >= 2016) break;
        const int seq = li / 63, j = 1 + li % 63, dir = seq & 1, tb = dir ? 65 - j : j;
        if (((seq >> 1) & 7) >= 4) scan1_item<true>(sp, lds, tid, lane, wave, seq, tb); else scan1_item<false>(sp, lds, tid, lane, wave, seq, tb);
    }
}

__device__ __forceinline__ void scan2_phase(const Ctx& a) {
    PHASE_IDS(); unsigned char* ws = a.ws(); const bf16_t* UB = (const bf16_t*)(ws + WS_UB); bf16_t* SB = (bf16_t*)(ws + WS_SB); const float* AB = (const float*)(ws + WS_AB);
    const int c0 = 16 * (tid >> 6) + 4 * ((tid >> 4) & 3);
    for (int p = blockIdx.x; p < 256; p += gridDim.x) { const int seq = p >> 3, vi = p & 7, dir = seq & 1; const size_t eo = (size_t)(vi * 512 + tid) * 4;
        f32x4 s = {0.f, 0.f, 0.f, 0.f};
#pragma unroll 1
        for (int j0 = 0; j0 < 64; j0 += 8) { u32x2 u[8]; f32x4 av[8];
#pragma unroll
            for (int q = 0; q < 8; ++q) { const int j = j0 + q, tb = dir ? (j == 0 ? 0 : 65 - j) : j; const size_t slot = (size_t)seq * 65 + tb; u[q] = *(const u32x2*)(UB + slot * 16384 + eo); av[q] = *(const f32x4*)(AB + slot * 128 + c0); }
#pragma unroll
            for (int q = 0; q < 8; ++q) { const int j = j0 + q, tb = dir ? (j == 0 ? 0 : 65 - j) : j; const size_t slot = (size_t)seq * 65 + tb;
                u32x2 w; w.x = cvt_pk_bf16(s[0], s[1]); w.y = cvt_pk_bf16(s[2], s[3]); *(u32x2*)(SB + slot * 16384 + eo) = w;
                s = av[q] * s + (f32x4){bf_lo(u[q].x), bf_hi(u[q].x), bf_lo(u[q].y), bf_hi(u[q].y)}; } }
        { const int tb = dir ? 1 : 64; const size_t slot = (size_t)seq * 65 + tb; u32x2 w; w.x = cvt_pk_bf16(s[0], s[1]); w.y = cvt_pk_bf16(s[2], s[3]); *(u32x2*)(SB + slot * 16384 + eo) = w; }
    }
}

__device__ __forceinline__ void scan3_phase(const Ctx& a, int l) {
    PHASE_IDS(); LAS unsigned char* lds = launder_lds(a.lds); const ScanPtrs sp = scan_ptrs(a, l);
#ifdef PROBE_NOMERGE
    if (l != DEPTH - 1) for (int bh = blockIdx.x; bh < 16; bh += gridDim.x) { if ((bh & 7) >= 4) scan3_item<true>(sp, lds, tid, lane, wave, bh, 0, false); else scan3_item<false>(sp, lds, tid, lane, wave, bh, 0, false); }
#endif
    for (int it = blockIdx.x; it < 1024; it += gridDim.x) { const int bh = it >> 6, tb = 1 + (it & 63);
        if ((bh & 7) >= 4) scan3_item<true>(sp, lds, tid, lane, wave, bh, tb, false); else scan3_item<false>(sp, lds, tid, lane, wave, bh, tb, false); }
}

struct OutOrder {
    int nrt, skipctx, G, c;
    __device__ __forceinline__ bool next(int i, pg8::Unit& u) const {
        const int L = i * G + c; if (L >= nrt * 4) return false;
        const int r = L >> 2; u.pn = L & 3; u.pm = skipctx ? r + 1 + (r >= 64 ? 1 : 0) : r; return true;
    }
    __device__ __forceinline__ void a_ready(const pg8::Unit&) const {}
    __device__ __forceinline__ void done(const pg8::Unit&) const {}
};

#ifndef PH
#define PH 0xffff
#endif
#ifndef DBL
#define DBL 0
#endif
__global__ void __launch_bounds__(512, 2) mega_fwd(Args a) {
    extern __shared__ __attribute__((aligned(16))) unsigned char lds_raw[];
    LAS unsigned char* lds = (LAS unsigned char*)lds_raw;
    const int tid = threadIdx.x;
    const int G = gridDim.x; const int bx = blockIdx.x; const int vcu = (G % 8 == 0) ? (bx % 8) * (G / 8) + bx / 8 : bx;
    volatile LAS unsigned* MISC = (volatile LAS unsigned*)(lds + MISC_OFF);
    if (tid < 16) MISC[tid] = 0u;
    if (tid == 0) { LAS unsigned long long* pt = (LAS unsigned long long*)(lds + PTR_OFF);
#pragma unroll
        for (int i = 0; i < 18; ++i) pt[i] = (unsigned long long)a.in[i];
        pt[18] = (unsigned long long)a.out; pt[19] = (unsigned long long)a.ws; }
    __syncthreads();
    const Ctx cx{lds, __builtin_amdgcn_readfirstlane(tid >> 6)};
    XcdBarrier bar = xcd_barrier_post((unsigned*)(cx.ws() + WS_CTL) + 1024, MISC + 8);
#define GRID_BAR() do { XcdBarrier b2_ = bar; asm volatile("" : "+s"(b2_.x)); xcd_barrier(b2_); } while (0)

#if PH & 1
    p0_prologue(cx);
#endif
    GRID_BAR();
#if DBL & 1
    p0_prologue(cx);
    GRID_BAR();
#endif
#if PH & 1
    p0_finalize(cx);
#endif
    GRID_BAR();

#pragma unroll 1
    for (int l = 0; l < DEPTH; ++l) {
        const bool last = (l == DEPTH - 1); unsigned char* ws = cx.ws(); const bool bgc = (G == 256);
        static_assert(220 * 8 * 4 == 7040 && 7040 + 248 * 8 * 4 == 14976 && 14976 + 192 * 8 * 4 == 21120 && 21120 + 192 * 8 * 3 >= 24576, "background conversion covers every expert-weight item");
#if DBL & 64
        norm1_phase<2>(cx, l);
        GRID_BAR();
#endif
#if PH & 2
        norm1_phase<0>(cx, l);
#endif
        GRID_BAR();
#if PH & 4
        {
            pg8::Gemm g{(const bf16_t*)(ws + WS_H), (const bf16_t*)(ws + WS_WIN) + (size_t)l * INW * D, MROWS, INW, D, cx.w0};
            pg8::StaticOrder S; S.init(MROWS, INW, G, bx);
            pg8::EpiIn E{(bf16_t*)(ws + WS_P), (const float*)(ws + WS_LBS) + l * 512, (const float*)(ws + WS_ROPE)};
            pg8::gemm_phase<pg8::EpiIn, pg8::StaticOrder, true, true>(launder_lds(lds), g, S, E);
        }
#endif
        if (bgc && !last && bx >= 36) cvt_tail(cx, l + 1, 0, bx - 36, 4);
        GRID_BAR();
#if PH & 8
        scan1_phase(cx, l);
#endif
        GRID_BAR();
#if PH & 16
        scan2_phase(cx);
#endif
        GRID_BAR();
#if PH & 32
        scan3_phase(cx, l);
#endif
        GRID_BAR();
#if DBL & 2
        scan1_phase(cx, l);
        GRID_BAR();
        scan2_phase(cx);
        GRID_BAR();
        scan3_phase(cx, l);
        GRID_BAR();
#endif
#if DBL & 8
        scan1_phase(cx, l);
        GRID_BAR();
#endif
#if DBL & 16
        scan2_phase(cx);
        GRID_BAR();
#endif
#if DBL & 32
        scan3_phase(cx, l);
        GRID_BAR();
#endif
#if PH & 64
        {
            pg8::Gemm g{(const bf16_t*)(ws + WS_MIX), (const bf16_t*)(ws + WS_WOUT) + (size_t)l * D * D, MROWS, D, D, cx.w0};
            OutOrder S{last ? 128 : 130, last ? 1 : 0, G, vcu};
            pg8::EpiOut E{(bf16_t*)(ws + WS_X), l == 0 ? cx.in(I_X) : nullptr, l == 0 ? cx.in(I_CTX) : nullptr, (const float*)(ws + WS_MODS) + (size_t)(l * 3) * 6144 + 2 * D};
            pg8::gemm_phase<pg8::EpiOut, OutOrder, true, true>(launder_lds(lds), g, S, E);
        }
#endif
        if (bgc && !last && vcu >= 8) cvt_tail(cx, l + 1, 7040, vcu - 8, 4);
        GRID_BAR();
#if PH & 128
        norm2_phase(cx, l);
#endif
        GRID_BAR();
#if PH & 256
        topk_phase(cx, l);
#endif
        if (bgc && !last && bx >= 64) cvt_tail(cx, l + 1, 21120, bx - 64, 3);
        GRID_BAR();
#if PH & 1024
        {
            pg8::Gemm g{(const bf16_t*)(ws + WS_H), (const bf16_t*)(ws + WS_WGU + (size_t)l * 65536 * D), MOE_ROWS, 65536, D, cx.w0};
            pg8::MoeOrder S{last ? 16 : 17, 16, G, vcu};
            pg8::EpiGU E{(unsigned char*)(ws + WS_HID)};
            pg8::gemm_phase_f8<pg8::EpiGU, pg8::MoeOrder, true>(launder_lds(lds), g, S, E, (const int*)(ws + WS_ROWMAP));
        }
#endif
        GRID_BAR();
#if PH & 2048
        {
            pg8::Gemm g{(const bf16_t*)(ws + WS_HID), (const bf16_t*)(ws + WS_WD + (size_t)l * 16384 * FF), MOE_ROWS, 16384, FF, cx.w0};
            pg8::MoeOrder S{last ? 16 : 17, 4, G, vcu};
            pg8::EpiDown E{(bf16_t*)(ws + WS_YS)};
            pg8::gemm_phase_f8<pg8::EpiDown, pg8::MoeOrder, false>(launder_lds(lds), g, S, E, nullptr);
        }
#endif
        if (bgc && !last && vcu >= 64) cvt_tail(cx, l + 1, 14976, vcu - 64, 4);
        GRID_BAR();
    }
#if PH & 4096
    norm1_phase<1>(cx, DEPTH);
#endif
}

extern "C" void kernel_launch(void* const* d_in, const int* in_sizes, int n_in, void* d_out, int out_size, void* d_ws, size_t ws_size, hipStream_t stream) {
    static int grid = 0;
    if (grid == 0) {
        if (n_in != 18 || out_size != NB * SEQ * D || ws_size < WS_END) { fprintf(stderr, "kernel_launch: unexpected problem shape (n_in %d, out %d, ws %zu)\n", n_in, out_size, ws_size); grid = -1; return; }
        int dev = 0, cus = 0, per_cu = 0;
        if (hipGetDevice(&dev) != hipSuccess || hipDeviceGetAttribute(&cus, hipDeviceAttributeMultiprocessorCount, dev) != hipSuccess) { grid = -1; return; }
        if (hipFuncSetAttribute((const void*)mega_fwd, hipFuncAttributeMaxDynamicSharedMemorySize, LDS_BYTES) != hipSuccess) { fprintf(stderr, "kernel_launch: hipFuncSetAttribute failed\n"); grid = -1; return; }
        if (hipOccupancyMaxActiveBlocksPerMultiprocessor(&per_cu, (const void*)mega_fwd, 512, LDS_BYTES) != hipSuccess || per_cu < 1) { fprintf(stderr, "kernel_launch: occupancy query reports %d workgroups per CU\n", per_cu); per_cu = 1; }
        (void)hipGetLastError();
        grid = cus;
    }
    if (grid < 0) return;
    (void)in_sizes;
    if (hipMemsetAsync((char*)d_ws + WS_CTL, 0, CTL_ZERO_BYTES, stream) != hipSuccess) return;
    Args a{};
    for (int i = 0; i < 18; ++i) a.in[i] = (const float*)d_in[i];
    a.out = (float*)d_out; a.ws = (unsigned char*)d_ws;
    hipLaunchKernelGGL(mega_fwd, dim3(grid), dim3(512), LDS_BYTES, stream, a);
}
```

```cpp
#include <hip/hip_runtime.h>
#include <cstdio>
#include <cstdint>

constexpr int D = 1024, NB = 2, SEQ = 16384, CTX = 256, LTOT = SEQ + CTX, MROWS = NB * LTOT;
constexpr int DEPTH = 4, INW = 4608, NE = 16, FF = 2048;
constexpr int CAP_LAT = 2048, CAP_CTX = 32;
constexpr int MOE_ROWS_E = 4352, MOE_ROWS = NE * MOE_ROWS_E;
constexpr int NSLOT = NB * 8 * 2 * 65;
constexpr float EPS = 1e-6f;

constexpr size_t MiB = 1u << 20;
constexpr size_t WS_CTL = 0, CTL_ZERO_BYTES = 64 * 1024;
constexpr size_t WS_MODP = 1 * MiB;
constexpr size_t WS_MODS = 4 * MiB;
constexpr size_t WS_LBS = 5 * MiB;
constexpr size_t WS_ROPE = 5 * MiB + 65536;
constexpr size_t WS_WIN = 8 * MiB;
constexpr size_t WS_WOUT = 44 * MiB;
constexpr size_t WS_WGU = 52 * MiB;
constexpr size_t WS_WD = 564 * MiB;
constexpr size_t WS_X = 820 * MiB;
constexpr size_t WS_H = 950 * MiB;
constexpr size_t WS_MIX = 1015 * MiB;
constexpr size_t WS_P = 1080 * MiB;
constexpr size_t WS_XS = 1080 * MiB;
constexpr size_t WS_HID = 1216 * MiB;
constexpr size_t WS_YS = 1488 * MiB;
constexpr size_t WS_UB = 1624 * MiB;
constexpr size_t WS_SB = 1689 * MiB;
constexpr size_t WS_AB = 1754 * MiB;
constexpr size_t WS_OB = 1756 * MiB;
constexpr size_t WS_AFF = 1788 * MiB;
constexpr size_t WS_ROWMAP = 1791 * MiB;
constexpr size_t WS_INV = 1792 * MiB;
constexpr size_t WS_END = 1800 * MiB;

constexpr int LDS_BYTES = 155648;
constexpr int MISC_OFF = LDS_BYTES - 64;
constexpr int PTR_OFF = LDS_BYTES - 256;

#define GAS __attribute__((address_space(1)))
#define LAS __attribute__((address_space(3)))
typedef float f32x2 __attribute__((ext_vector_type(2)));
typedef unsigned u32x2 __attribute__((ext_vector_type(2)));

__device__ __forceinline__ int lane_id() { int l; asm volatile("v_mbcnt_lo_u32_b32 %0, -1, 0\n\tv_mbcnt_hi_u32_b32 %0, -1, %0" : "=v"(l)); return l; }
__device__ __forceinline__ int opaque_tid(int w0) { int w = w0; asm volatile("" : "+s"(w)); int t = w * 64 + lane_id(); asm volatile("" : "+v"(t)); return t; }
__device__ __forceinline__ LAS unsigned char* launder_lds(LAS unsigned char* p) { unsigned v = (unsigned)(size_t)p; asm volatile("" : "+s"(v)); return (LAS unsigned char*)(size_t)v; }
__device__ __forceinline__ const float* ldptr(LAS unsigned char* lds0, int i) {
    LAS unsigned char* lds = launder_lds(lds0);
    const u32x2 v = *(volatile LAS u32x2*)(lds + PTR_OFF + 8 * i);
    const unsigned lo = __builtin_amdgcn_readfirstlane(v.x), hi = __builtin_amdgcn_readfirstlane(v.y);
    const GAS float* g = (const GAS float*)(((unsigned long long)hi << 32) | lo);
    return (const float*)g;
}
namespace pg8 {
#define PG8_LAS __attribute__((address_space(3)))
typedef unsigned short bf16_t;
typedef short bf16x8 __attribute__((ext_vector_type(8)));
typedef float f32x4 __attribute__((ext_vector_type(4)));
typedef unsigned u32x4 __attribute__((ext_vector_type(4)));
constexpr int BM = 256, BK = 64, HALF = 128, HTB = HALF * BK * 2  , STAGE_BYTES = 8 * HTB, NXCD = 8, WGM = 8;

__host__ __device__ __forceinline__ int lds_byte(int r, int c) { const int st = (r >> 4) * 2 + (c >> 5), rr = r & 15, cc = c & 31, ob = rr * 64 + cc * 2; return st * 1024 + (ob ^ (((ob >> 9) & 1) << 5)); }
__host__ __device__ __forceinline__ void stage_rc(int b, int& R, int& C) { const int st = b / 1024, sb = b % 1024, swz = sb ^ (((sb >> 9) & 1) << 5); R = (st >> 1) * 16 + swz / 64; C = (st & 1) * 32 + (swz % 64) / 2; }
__host__ __device__ __forceinline__ int perm32(int rho) { const int n = rho >> 4, i = rho & 15; return 8 * (i >> 2) + 4 * n + (i & 3); }

struct Unit { int pm, pn; };
struct Gemm { const bf16_t* A; const bf16_t* Bt; int M, N, K, w0; };

struct StaticOrder {
    static constexpr bool PADTILES = false;
    __device__ __forceinline__ bool half_rows(const Unit&) const { return false; }
    int nM, nN, nwg, G, c;
    __host__ __device__ void init(int M, int N, int G_, int c_) { nM = M / BM; nN = N / BM; nwg = nM * nN; G = G_; c = c_; }
    __host__ __device__ bool next(int i, Unit& u) const {
        const long L = (long)i * G + c; if (L >= nwg) return false;
        int wgid = (int)L; { const int q = nwg / NXCD, r = nwg % NXCD, xcd = wgid % NXCD, off = wgid / NXCD; wgid = (xcd < r ? xcd * (q + 1) : r * (q + 1) + (xcd - r) * q) + off; }
        const int nig = WGM * nN, gid = wgid / nig, fm = gid * WGM, gsz = (nM - fm) < WGM ? (nM - fm) : WGM;
        u.pm = fm + ((wgid % nig) % gsz); u.pn = (wgid % nig) / gsz; return true;
    }
    __device__ __forceinline__ void a_ready(const Unit&) const {}
    __device__ __forceinline__ void done(const Unit&) const {}
};
__device__ __forceinline__ unsigned cvt_pk_bf16(float lo, float hi) { unsigned r; asm volatile("v_cvt_pk_bf16_f32 %0, %1, %2" : "=v"(r) : "v"(lo), "v"(hi)); return r; }

struct MoeOrder {
    static constexpr bool PADTILES = true;
    __device__ __forceinline__ bool half_rows(const Unit& u) const { return (u.pm % 17) == 16; }
    int NT, NC, G, c;
    __device__ __forceinline__ bool next(int i, Unit& u) const {
        const int L = i * G + c, per = NT * NC; if (L >= 16 * per) return false;
        const int e = L / per, q = L - e * per;
        if (NC == 16 && q < 256) { u.pm = e * 17 + (q >> 6) * 4 + (q & 3); u.pn = e * NC + ((q >> 2) & 15); }
        else { u.pm = e * 17 + q / NC; u.pn = e * NC + q % NC; }
        return true;
    }
    __device__ __forceinline__ void a_ready(const Unit&) const {}
    __device__ __forceinline__ void done(const Unit&) const {}
};

__device__ __forceinline__ float fast_exp(float x) { return __builtin_amdgcn_exp2f(x * 1.4426950408889634f); }
__device__ __forceinline__ float fast_sigmoid(float x) { return __builtin_amdgcn_rcpf(1.0f + fast_exp(-x)); }

constexpr float F8_SA = 8.0f, F8_SW = 64.0f, F8_SH = 4.0f, F8_SY = 16.0f;
template <bool PLAIN, bool F8 = false>
struct EpiInT {
    static constexpr float ASC = F8 ? 1.0f / (F8_SA * F8_SW) : 1.0f;
    static constexpr bool PERM = true, AFTER_DRAIN = false;
    bf16_t* P; const float* lb; const float* cs;
    __device__ __forceinline__ void operator()(const f32x4 (&acc)[2][2][4][2], const Unit& u, int wr, int wc, int fr, int fq) const {
        const int grp = PLAIN ? 0 : (u.pn >> 1);
        const int row0 = u.pm * BM + wr * 64 + fr, col0 = u.pn * BM + wc * 32 + 8 * fq;
        if (grp == 0 || grp == 3 || grp == 7) {
#pragma unroll
            for (int ai = 0; ai < 2; ++ai)
#pragma unroll
                for (int m = 0; m < 4; ++m) { bf16_t* rowp = P + (size_t)(row0 + ai * HALF + m * 16) * INW + col0;
#pragma unroll
                    for (int bj = 0; bj < 2; ++bj) { const f32x4 v0 = acc[ai][bj][m][0] * ASC, v1 = acc[ai][bj][m][1] * ASC;
                        u32x4 w; w.x = cvt_pk_bf16(v0[0], v0[1]); w.y = cvt_pk_bf16(v0[2], v0[3]); w.z = cvt_pk_bf16(v1[0], v1[1]); w.w = cvt_pk_bf16(v1[2], v1[3]);
#ifdef PROBE_LINSTORE
                        if (PLAIN) {
#if PROBE_LINSTORE == 2
                            *((u32x4*)P + ((size_t)blockIdx.x * 8192 + (((wr * 4 + wc) * 16 + (ai * 4 + m) * 2 + bj) * 64 + fq * 16 + fr))) = w; continue;
#else
                            *((u32x4*)P + ((size_t)(u.pm * 18 + u.pn) * 8192 + (((wr * 4 + wc) * 16 + (ai * 4 + m) * 2 + bj) * 64 + fq * 16 + fr))) = w; continue;
#endif
                        }
#endif
                        *(u32x4*)(rowp + bj * HALF) = w; } }
        } else if (grp == 1 || grp == 2) {
            const int cg = col0 - grp * 512;
            f32x4 lbv[2][2];
#pragma unroll
            for (int bj = 0; bj < 2; ++bj)
#pragma unroll
                for (int n = 0; n < 2; ++n) lbv[bj][n] = *(const f32x4*)(lb + cg + bj * HALF + 4 * n);
#pragma unroll
            for (int ai = 0; ai < 2; ++ai)
#pragma unroll
                for (int m = 0; m < 4; ++m) { bf16_t* rowp = P + (size_t)(row0 + ai * HALF + m * 16) * INW + col0;
#pragma unroll
                    for (int bj = 0; bj < 2; ++bj) { f32x4 v[2];
#pragma unroll
                        for (int n = 0; n < 2; ++n)
#pragma unroll
                            for (int h = 0; h < 2; ++h) { const f32x2 z = (f32x2){acc[ai][bj][m][n][2 * h], acc[ai][bj][m][n][2 * h + 1]} * ASC, l0 = {lbv[bj][n][2 * h], lbv[bj][n][2 * h + 1]};
                                const f32x2 x = z * (-1.4426950408889634f); const f32x2 d = (f32x2){__builtin_amdgcn_exp2f(x.x), __builtin_amdgcn_exp2f(x.y)} + 1.0f;
                                f32x2 f = l0 + ((f32x2){1.0f, 1.0f} - l0) * (f32x2){__builtin_amdgcn_rcpf(d.x), __builtin_amdgcn_rcpf(d.y)}; f = __builtin_elementwise_max(f, (f32x2){1e-30f, 1e-30f});
#ifndef SCAN_LOG2
                                const f32x2 r = (f32x2){__builtin_amdgcn_logf(f.x), __builtin_amdgcn_logf(f.y)} * 0.6931471805599453f;
#else
                                const f32x2 r = (f32x2){__builtin_amdgcn_logf(f.x), __builtin_amdgcn_logf(f.y)};
#endif
                                v[n][2 * h] = r.x; v[n][2 * h + 1] = r.y; }
                        u32x4 w; w.x = cvt_pk_bf16(v[0][0], v[0][1]); w.y = cvt_pk_bf16(v[0][2], v[0][3]); w.z = cvt_pk_bf16(v[1][0], v[1][1]); w.w = cvt_pk_bf16(v[1][2], v[1][3]);
                        *(u32x4*)(rowp + bj * HALF) = w; } }
        } else if (grp == 4 || grp == 8) {
#pragma unroll
            for (int ai = 0; ai < 2; ++ai)
#pragma unroll
                for (int m = 0; m < 4; ++m) { bf16_t* rowp = P + (size_t)(row0 + ai * HALF + m * 16) * INW + col0;
#pragma unroll
                    for (int bj = 0; bj < 2; ++bj) { f32x4 v[2];
#pragma unroll
                        for (int n = 0; n < 2; ++n)
#pragma unroll
                            for (int h = 0; h < 2; ++h) { const f32x2 z = (f32x2){acc[ai][bj][m][n][2 * h], acc[ai][bj][m][n][2 * h + 1]} * ASC; const f32x2 x = z * (-1.4426950408889634f);
                                const f32x2 d = (f32x2){__builtin_amdgcn_exp2f(x.x), __builtin_amdgcn_exp2f(x.y)} + 1.0f; const f32x2 r = z * (f32x2){__builtin_amdgcn_rcpf(d.x), __builtin_amdgcn_rcpf(d.y)};
                                v[n][2 * h] = r.x; v[n][2 * h + 1] = r.y; }
                        u32x4 w; w.x = cvt_pk_bf16(v[0][0], v[0][1]); w.y = cvt_pk_bf16(v[0][2], v[0][3]); w.z = cvt_pk_bf16(v[1][0], v[1][1]); w.w = cvt_pk_bf16(v[1][2], v[1][3]);
                        *(u32x4*)(rowp + bj * HALF) = w; } }
        } else {
            const float sc = ((grp == 6) ? 0.08838834764831845f : 1.0f) * ASC;
            const int f0 = 16 * (wc & 1) + 4 * fq;
#pragma unroll
            for (int ai = 0; ai < 2; ++ai)
#pragma unroll
                for (int m = 0; m < 4; ++m) { const int row = row0 + ai * HALF + m * 16; bf16_t* rowp = P + (size_t)row * INW + col0;
                    int g = row; if (g >= LTOT) g -= LTOT;
                    int pos = 0; if (g >= CTX) { const int nn = g - CTX; pos = (wc < 2) ? (nn >> 6) : (nn & 63); }
                    const f32x4 t0 = *(const f32x4*)(cs + (size_t)(pos * 32 + f0) * 2), t1 = *(const f32x4*)(cs + (size_t)(pos * 32 + f0) * 2 + 4);
#pragma unroll
                    for (int bj = 0; bj < 2; ++bj) { const f32x4 v0 = acc[ai][bj][m][0] * sc, v1 = acc[ai][bj][m][1] * sc;
                        const float a0 = v0[0] * t0[0] - v0[1] * t0[1], a1 = v0[0] * t0[1] + v0[1] * t0[0];
                        const float a2 = v0[2] * t0[2] - v0[3] * t0[3], a3 = v0[2] * t0[3] + v0[3] * t0[2];
                        const float b0 = v1[0] * t1[0] - v1[1] * t1[1], b1 = v1[0] * t1[1] + v1[1] * t1[0];
                        const float b2 = v1[2] * t1[2] - v1[3] * t1[3], b3 = v1[2] * t1[3] + v1[3] * t1[2];
                        u32x4 w; w.x = cvt_pk_bf16(a0, a1); w.y = cvt_pk_bf16(a2, a3); w.z = cvt_pk_bf16(b0, b1); w.w = cvt_pk_bf16(b2, b3);
                        *(u32x4*)(rowp + bj * HALF) = w; } }
        }
    }
};

using EpiIn = EpiInT<false>;
using EpiIn8 = EpiInT<false, true>;

struct EpiNull { static constexpr bool PERM = true, AFTER_DRAIN = false; float* sink;
    __device__ __forceinline__ void operator()(const f32x4 (&acc)[2][2][4][2], const Unit& u, int wr, int wc, int fr, int fq) const { f32x4 s = acc[0][0][0][0]; _Pragma("unroll") for (int a = 0; a < 2; ++a) _Pragma("unroll") for (int b = 0; b < 2; ++b) _Pragma("unroll") for (int m = 0; m < 4; ++m) _Pragma("unroll") for (int n = 0; n < 2; ++n) s += acc[a][b][m][n]; if (s[0] == 123.456f && u.pm < 0) sink[fr + fq + wr + wc] = s[1]; } };

template <bool F8>
struct EpiOutT {
    static constexpr bool PERM = true, AFTER_DRAIN = false; static constexpr float ASC = F8 ? 1.0f / (F8_SA * F8_SW) : 1.0f;
    bf16_t* X; const float* xin; const float* cin; const float* gt;
    __device__ __forceinline__ void operator()(const f32x4 (&acc)[2][2][4][2], const Unit& u, int wr, int wc, int fr, int fq) const {
        const int b = u.pm / 65, tb = u.pm - b * 65, which = (tb == 0) ? 2 : b;
        const int row0 = u.pm * BM + wr * 64 + fr, col0 = u.pn * BM + wc * 32 + 8 * fq;
        f32x4 gv[2][2];
#pragma unroll
        for (int bj = 0; bj < 2; ++bj)
#pragma unroll
            for (int n = 0; n < 2; ++n) gv[bj][n] = *(const f32x4*)(gt + which * 6144 + col0 + bj * HALF + 4 * n) * ASC;
#pragma unroll
        for (int ai = 0; ai < 2; ++ai)
#pragma unroll
            for (int m = 0; m < 4; ++m) { const int row = row0 + ai * HALF + m * 16; bf16_t* op = X + (size_t)row * D + col0;
#pragma unroll
                for (int bj = 0; bj < 2; ++bj) { f32x4 b0, b1;
                    if (xin) { const int g = row - b * LTOT; const float* bp = (g < CTX ? cin + (size_t)(b * CTX + g) * D : xin + (size_t)(b * SEQ + g - CTX) * D) + col0 + bj * HALF; b0 = *(const f32x4*)bp; b1 = *(const f32x4*)(bp + 4); }
                    else { const u32x4 w = *(const u32x4*)(op + bj * HALF); b0 = (f32x4){__uint_as_float(w.x << 16), __uint_as_float(w.x & 0xffff0000u), __uint_as_float(w.y << 16), __uint_as_float(w.y & 0xffff0000u)};
                        b1 = (f32x4){__uint_as_float(w.z << 16), __uint_as_float(w.z & 0xffff0000u), __uint_as_float(w.w << 16), __uint_as_float(w.w & 0xffff0000u)}; }
                    const f32x4 v0 = b0 + gv[bj][0] * acc[ai][bj][m][0], v1 = b1 + gv[bj][1] * acc[ai][bj][m][1];
                    u32x4 o; o.x = cvt_pk_bf16(v0[0], v0[1]); o.y = cvt_pk_bf16(v0[2], v0[3]); o.z = cvt_pk_bf16(v1[0], v1[1]); o.w = cvt_pk_bf16(v1[2], v1[3]);
                    *(u32x4*)(op + bj * HALF) = o; }
                if (F8) __builtin_amdgcn_sched_barrier(0); }
    }
};

using EpiOut = EpiOutT<false>;
using EpiOut8 = EpiOutT<true>;

__device__ __forceinline__ unsigned pk4_fp8(float a, float b, float c, float d) {
    a = __builtin_amdgcn_fmed3f(a, -448.f, 448.f); b = __builtin_amdgcn_fmed3f(b, -448.f, 448.f); c = __builtin_amdgcn_fmed3f(c, -448.f, 448.f); d = __builtin_amdgcn_fmed3f(d, -448.f, 448.f);
    unsigned w = 0; w = __builtin_amdgcn_cvt_pk_fp8_f32(a, b, w, false); w = __builtin_amdgcn_cvt_pk_fp8_f32(c, d, w, true); return w; }
struct EpiGU {
    static constexpr bool PERM = true, AFTER_DRAIN = false;
    unsigned char* HID;
    __device__ __forceinline__ void operator()(const f32x4 (&acc)[2][2][4][2], const Unit& u, int wr, int wc, int fr, int fq) const {
        const int row0 = u.pm * BM + wr * 64 + fr, col0 = (u.pn & 15) * HALF + wc * 32 + 8 * fq;
        constexpr float inv = 1.0f / (F8_SA * F8_SW);
#pragma unroll
        for (int ai = 0; ai < 2; ++ai)
#pragma unroll
            for (int m = 0; m < 4; ++m) { unsigned char* rowp = HID + (size_t)(row0 + ai * HALF + m * 16) * FF + col0; f32x4 v[2];
#pragma unroll
                for (int n = 0; n < 2; ++n)
#pragma unroll
                    for (int h = 0; h < 2; ++h) {
                        const f32x2 a0 = {acc[ai][0][m][n][2 * h], acc[ai][0][m][n][2 * h + 1]}, a1 = {acc[ai][1][m][n][2 * h], acc[ai][1][m][n][2 * h + 1]};
                        const f32x2 x = a0 * (-inv * 1.4426950408889634f); const f32x2 d = (f32x2){__builtin_amdgcn_exp2f(x.x), __builtin_amdgcn_exp2f(x.y)} + 1.0f;
                        const f32x2 r = (a0 * a1) * (inv * inv * F8_SH) * (f32x2){__builtin_amdgcn_rcpf(d.x), __builtin_amdgcn_rcpf(d.y)};
                        v[n][2 * h] = r.x; v[n][2 * h + 1] = r.y; }
                u32x2 w; w.x = pk4_fp8(v[0][0], v[0][1], v[0][2], v[0][3]); w.y = pk4_fp8(v[1][0], v[1][1], v[1][2], v[1][3]);
                *(u32x2*)rowp = w; }
    }
};

struct EpiDown {
    static constexpr bool PERM = true, AFTER_DRAIN = false;
    unsigned char* YS;
    __device__ __forceinline__ void operator()(const f32x4 (&acc)[2][2][4][2], const Unit& u, int wr, int wc, int fr, int fq) const {
        const int row0 = u.pm * BM + wr * 64 + fr, col0 = (u.pn & 3) * BM + wc * 32 + 8 * fq;
        constexpr float gg = F8_SY / (F8_SH * F8_SW);
#pragma unroll
        for (int ai = 0; ai < 2; ++ai)
#pragma unroll
            for (int m = 0; m < 4; ++m) { unsigned char* rowp = YS + (size_t)(row0 + ai * HALF + m * 16) * D + col0;
#pragma unroll
                for (int bj = 0; bj < 2; ++bj) { const f32x4 v0 = acc[ai][bj][m][0] * gg, v1 = acc[ai][bj][m][1] * gg;
                    u32x2 w; w.x = pk4_fp8(v0[0], v0[1], v0[2], v0[3]); w.y = pk4_fp8(v1[0], v1[1], v1[2], v1[3]);
                    *(u32x2*)(rowp + bj * HALF) = w; } }
    }
};

typedef int i32x4v __attribute__((ext_vector_type(4)));
typedef int i32x8v __attribute__((ext_vector_type(8)));
__device__ __forceinline__ i32x8v cat8(bf16x8 lo, bf16x8 hi) { const i32x4v a = __builtin_bit_cast(i32x4v, lo), b = __builtin_bit_cast(i32x4v, hi); return __builtin_shufflevector(a, b, 0, 1, 2, 3, 4, 5, 6, 7); }
template <class Epi, class Sched, bool GATHER>
__device__ __forceinline__ void gemm_phase_f8(PG8_LAS unsigned char* lds, const Gemm g, const Sched& S, const Epi& E, const int* rowmap) {
    const int tid = opaque_tid(g.w0), wid = __builtin_amdgcn_readfirstlane(tid >> 6), lane = tid & 63, wr = wid >> 2, wc = wid & 3, fr = lane & 15, fq = lane >> 4;
    const int rowb = g.K, nt = rowb / 128;
    unsigned vA0[2], vA1[2], voffB[2];
#pragma unroll
    for (int i = 0; i < 2; ++i) { int R, C; stage_rc(tid * 16 + i * 8192, R, C); const int Rb = Epi::PERM ? ((R & ~31) + perm32(R & 31)) : R;
        voffB[i] = (unsigned)(Rb * rowb + 2 * C); vA0[i] = (unsigned)(R * rowb + 2 * C); vA1[i] = vA0[i]; }
    const size_t kstep = 128;
    const size_t hstep = (size_t)HALF * rowb;
    const size_t tstep = 2 * hstep;
    const unsigned ldsw = (unsigned)wid * 1024u;
    const int aoff = lds_byte(wr * 64 + fr, fq * 8), boff = lds_byte(wc * 32 + fr, fq * 8);
    constexpr int GOFF = STAGE_BYTES;
#define PG8_SA(b, h) (((b) * 2 + (h)) * HTB)
#define PG8_SB(b, h) ((4 + (b) * 2 + (h)) * HTB)
#define PG8_STAGE(bufoff, gbase, voff) do { _Pragma("unroll") for (int _i = 0; _i < 2; ++_i) { unsigned _o = (voff)[_i]; asm volatile("" : "+v"(_o)); \
        __builtin_amdgcn_global_load_lds((const unsigned*)((const char*)(gbase) + _o), (PG8_LAS unsigned*)(lds + (bufoff) + ldsw + _i * 8192), 16, 0, 0); } } while (0)
#define PG8_STAGE_A(bufoff, kbase, h) do { if constexpr (GATHER) { if (h) PG8_STAGE(bufoff, kbase, vA1); else PG8_STAGE(bufoff, kbase, vA0); } else PG8_STAGE(bufoff, (kbase) + (h) * hstep, vA0); } while (0)
#define PG8_GIDX_ISSUE(pm_) do { const int _t = opaque_tid(g.w0); _Pragma("unroll") for (int _i = 0; _i < 2; ++_i) { int R, C; stage_rc(_t * 16 + _i * 8192, R, C); _Pragma("unroll") for (int _h = 0; _h < 2; ++_h) \
        __builtin_amdgcn_global_load_lds((const unsigned*)(rowmap + (pm_) * BM + _h * HALF + R), (PG8_LAS unsigned*)(lds + GOFF + ldsw + (_h * 2 + _i) * 256), 4, 0, 0); } } while (0)
#define PG8_GIDX_TAKE() do { const int _t = opaque_tid(g.w0); _Pragma("unroll") for (int _i = 0; _i < 2; ++_i) { int R, C; stage_rc(_t * 16 + _i * 8192, R, C); \
        vA0[_i] = *(const PG8_LAS unsigned*)(lds + GOFF + ldsw + (0 * 2 + _i) * 256 + (_t & 63) * 4) * (unsigned)rowb + (unsigned)(2 * C); \
        vA1[_i] = *(const PG8_LAS unsigned*)(lds + GOFF + ldsw + (1 * 2 + _i) * 256 + (_t & 63) * 4) * (unsigned)rowb + (unsigned)(2 * C); } } while (0)
#define PG8_LDA(dst, b, h) do { _Pragma("unroll") for (int m = 0; m < 4; ++m) _Pragma("unroll") for (int k = 0; k < 2; ++k) dst[m][k] = *(const PG8_LAS bf16x8*)(lds + PG8_SA(b, h) + aoff + m * 2048 + k * 1024); } while (0)
#define PG8_LDB(dst, b, h) do { _Pragma("unroll") for (int n = 0; n < 2; ++n) _Pragma("unroll") for (int k = 0; k < 2; ++k) dst[n][k] = *(const PG8_LAS bf16x8*)(lds + PG8_SB(b, h) + boff + n * 2048 + k * 1024); } while (0)
#define PG8_MMA(ai, bj, At, Bt) do { __builtin_amdgcn_s_setprio(1); _Pragma("unroll") for (int m = 0; m < 4; ++m) _Pragma("unroll") for (int n = 0; n < 2; ++n) \
        acc[ai][bj][m][n] = __builtin_amdgcn_mfma_scale_f32_16x16x128_f8f6f4(cat8(Bt[n][0], Bt[n][1]), cat8(At[m][0], At[m][1]), acc[ai][bj][m][n], 0, 0, 0, 0, 0, 0); __builtin_amdgcn_s_setprio(0); } while (0)
#define PG8_WAIT_V(n) asm volatile("s_waitcnt vmcnt(" #n ")" ::: "memory")
#define PG8_WAIT_L(n) asm volatile("s_waitcnt lgkmcnt(" #n ")" ::: "memory")
#define PG8_BAR __builtin_amdgcn_s_barrier()
#define PG8_SCHED __builtin_amdgcn_sched_barrier(0)
    Unit cur, nxt; int ui = 0;
    if (!S.next(0, cur)) return;
    bool half = Sched::PADTILES && S.half_rows(cur);
    f32x4 acc[2][2][4][2];
#pragma unroll
    for (int a = 0; a < 2; ++a)
#pragma unroll
        for (int b = 0; b < 2; ++b)
#pragma unroll
            for (int m = 0; m < 4; ++m)
#pragma unroll
                for (int n = 0; n < 2; ++n) acc[a][b][m][n] = (f32x4){0.f, 0.f, 0.f, 0.f};
    bf16x8 At[4][2], B0[2][2], B1[2][2];
    const char* cA; const char* cB = (const char*)g.Bt + (size_t)cur.pn * tstep;
    if constexpr (GATHER) { cA = (const char*)g.A; PG8_GIDX_ISSUE(cur.pm); PG8_WAIT_V(0); PG8_GIDX_TAKE(); }
    else cA = (const char*)g.A + (size_t)cur.pm * tstep;
    PG8_STAGE(PG8_SB(0, 0), cB, voffB); PG8_STAGE(PG8_SB(0, 1), cB + hstep, voffB); PG8_STAGE_A(PG8_SA(0, 0), cA, 0); PG8_STAGE_A(PG8_SA(0, 1), cA, 1);
    if (wr == 1) PG8_BAR;
    PG8_WAIT_V(2); PG8_BAR;
    PG8_STAGE(PG8_SB(1, 0), cB + kstep, voffB); PG8_STAGE_A(PG8_SA(1, 0), cA + kstep, 0); PG8_STAGE(PG8_SB(1, 1), cB + hstep + kstep, voffB);
    PG8_WAIT_V(6); PG8_BAR;
    for (;;) {
        const bool has_next = S.next(ui + 1, nxt);
        const char* nA; const char* nB = has_next ? (const char*)g.Bt + (size_t)nxt.pn * tstep : cB;
        if constexpr (GATHER) { nA = cA; if (has_next) PG8_GIDX_ISSUE(nxt.pm); }
        else nA = has_next ? (const char*)g.A + (size_t)nxt.pm * tstep : cA;
#pragma unroll 1
        for (int t = 0; t < nt; t += 2) {
            const bool last = (t == nt - 2);
            const char* a1 = cA + (size_t)(t + 1) * kstep;
            const char* a2 = last ? nA : cA + (size_t)(t + 2) * kstep; const char* b2 = last ? nB : cB + (size_t)(t + 2) * kstep;
            const char* a3 = a2 + kstep; const char* b3 = b2 + kstep;
            PG8_LDB(B0, 0, 0); PG8_LDB(B1, 0, 1); PG8_SCHED; PG8_LDA(At, 0, 0); PG8_STAGE_A(PG8_SA(1, 1), a1, 1);
            if constexpr (GATHER) { if (last && has_next) PG8_GIDX_TAKE(); }
            PG8_WAIT_V(8); PG8_WAIT_L(0); PG8_BAR; if (!(half && wr == 1)) { PG8_MMA(0, 0, At, B0); PG8_MMA(0, 1, At, B1); } PG8_BAR; PG8_SCHED;
            PG8_LDA(At, 0, 1); PG8_STAGE(PG8_SB(0, 0), b2, voffB); PG8_STAGE(PG8_SB(0, 1), b2 + hstep, voffB); PG8_STAGE_A(PG8_SA(0, 0), a2, 0);
            PG8_WAIT_V(8); PG8_WAIT_L(0); PG8_BAR; if (!half) { PG8_MMA(1, 0, At, B0); PG8_MMA(1, 1, At, B1); } PG8_BAR; PG8_SCHED;
            PG8_LDB(B0, 1, 0); PG8_LDB(B1, 1, 1); PG8_SCHED; PG8_LDA(At, 1, 0); PG8_STAGE_A(PG8_SA(0, 1), a2, 1);
            PG8_WAIT_V(8); PG8_WAIT_L(0); PG8_BAR; if (!(half && wr == 1)) { PG8_MMA(0, 0, At, B0); PG8_MMA(0, 1, At, B1); } PG8_BAR; PG8_SCHED;
            PG8_LDA(At, 1, 1); PG8_STAGE(PG8_SB(1, 0), b3, voffB); PG8_STAGE(PG8_SB(1, 1), b3 + hstep, voffB); PG8_STAGE_A(PG8_SA(1, 0), a3, 0);
            PG8_WAIT_V(8); PG8_WAIT_L(0); PG8_BAR; if (!half) { PG8_MMA(1, 0, At, B0); PG8_MMA(1, 1, At, B1); } PG8_BAR; PG8_SCHED;
        }
        if (wr == 0) PG8_BAR;
        { const int l2_ = opaque_tid(g.w0) & 63; E(acc, cur, wr, wc, l2_ & 15, l2_ >> 4); }
#ifdef G2_F8
        { const int t2_ = opaque_tid(g.w0);
#pragma unroll
          for (int i = 0; i < 2; ++i) { int R, C; stage_rc(t2_ * 16 + i * 8192, R, C); const int Rb = Epi::PERM ? ((R & ~31) + perm32(R & 31)) : R;
              voffB[i] = (unsigned)(Rb * rowb + 2 * C); if constexpr (!GATHER) { vA0[i] = (unsigned)(R * rowb + 2 * C); vA1[i] = vA0[i]; } } }
#endif
        if (!has_next) break;
#pragma unroll
        for (int a = 0; a < 2; ++a)
#pragma unroll
            for (int b = 0; b < 2; ++b)
#pragma unroll
                for (int m = 0; m < 4; ++m)
#pragma unroll
                    for (int n = 0; n < 2; ++n) acc[a][b][m][n] = (f32x4){0.f, 0.f, 0.f, 0.f};
        cur = nxt; cA = nA; cB = nB; ++ui; half = Sched::PADTILES && S.half_rows(cur);
        if (wr == 1) PG8_BAR;
    }
    PG8_WAIT_V(0);
    PG8_BAR;
#undef PG8_SA
#undef PG8_SB
#undef PG8_STAGE
#undef PG8_STAGE_A
#undef PG8_GIDX_ISSUE
#undef PG8_GIDX_TAKE
#undef PG8_LDA
#undef PG8_LDB
#undef PG8_MMA
#undef PG8_WAIT_V
#undef PG8_WAIT_L
#undef PG8_BAR
#undef PG8_SCHED
}
template <class Epi, class Sched, bool ALIGN_EPI = false, bool SP2 = false>
__device__ __forceinline__ void gemm_phase(PG8_LAS unsigned char* lds, const Gemm g, const Sched& S, const Epi& E) {
    const int tid = opaque_tid(g.w0), wid = __builtin_amdgcn_readfirstlane(tid >> 6), lane = tid & 63, wr = wid >> 2, wc = wid & 3, fr = lane & 15, fq = lane >> 4;
    const int K = g.K, nt = K / BK;
    unsigned voffA[2], voffB[2];
#pragma unroll
    for (int i = 0; i < 2; ++i) { int R, C; stage_rc(tid * 16 + i * 8192, R, C); const int Rb = Epi::PERM ? ((R & ~31) + perm32(R & 31)) : R;
        voffA[i] = (unsigned)(R * K + C) * 2u; voffB[i] = (unsigned)(Rb * K + C) * 2u; }
    const size_t kstep = (size_t)(BK * 2);
    const size_t hstep = (size_t)HALF * K * 2;
    const size_t tstep = 2 * hstep;
    const unsigned ldsw = (unsigned)wid * 1024u;
    const int aoff = lds_byte(wr * 64 + fr, fq * 8), boff = lds_byte(wc * 32 + fr, fq * 8);
#define PG8_SA(b, h) (((b) * 2 + (h)) * HTB)
#define PG8_SB(b, h) ((4 + (b) * 2 + (h)) * HTB)
#define PG8_STAGE(bufoff, gbase, voff) do { _Pragma("unroll") for (int _i = 0; _i < 2; ++_i) \
        __builtin_amdgcn_global_load_lds((const unsigned*)((const char*)(gbase) + (voff)[_i]), (PG8_LAS unsigned*)(lds + (bufoff) + ldsw + _i * 8192), 16, 0, 0); } while (0)
#define PG8_LDA(dst, b, h) do { _Pragma("unroll") for (int m = 0; m < 4; ++m) _Pragma("unroll") for (int k = 0; k < 2; ++k) dst[m][k] = *(const PG8_LAS bf16x8*)(lds + PG8_SA(b, h) + aoff + m * 2048 + k * 1024); } while (0)
#define PG8_LDB(dst, b, h) do { _Pragma("unroll") for (int n = 0; n < 2; ++n) _Pragma("unroll") for (int k = 0; k < 2; ++k) dst[n][k] = *(const PG8_LAS bf16x8*)(lds + PG8_SB(b, h) + boff + n * 2048 + k * 1024); } while (0)
#define PG8_MMA(ai, bj, At, Bt) do { __builtin_amdgcn_s_setprio(1); _Pragma("unroll") for (int m = 0; m < 4; ++m) _Pragma("unroll") for (int n = 0; n < 2; ++n) _Pragma("unroll") for (int k = 0; k < 2; ++k) \
        acc[ai][bj][m][n] = __builtin_amdgcn_mfma_f32_16x16x32_bf16(Bt[n][k], At[m][k], acc[ai][bj][m][n], 0, 0, 0); __builtin_amdgcn_s_setprio(0); } while (0)
#define PG8_WAIT_V(n) asm volatile("s_waitcnt vmcnt(" #n ")" ::: "memory")
#define PG8_WAIT_L(n) asm volatile("s_waitcnt lgkmcnt(" #n ")" ::: "memory")
#define PG8_BAR __builtin_amdgcn_s_barrier()
#define PG8_SCHED __builtin_amdgcn_sched_barrier(0)
    Unit cur, nxt; int ui = 0;
    if (!S.next(0, cur)) return;
    f32x4 acc[2][2][4][2];
#pragma unroll
    for (int a = 0; a < 2; ++a)
#pragma unroll
        for (int b = 0; b < 2; ++b)
#pragma unroll
            for (int m = 0; m < 4; ++m)
#pragma unroll
                for (int n = 0; n < 2; ++n) acc[a][b][m][n] = (f32x4){0.f, 0.f, 0.f, 0.f};
    bf16x8 At[4][2], B0[2][2], B1[2][2];
    const char* cA = (const char*)g.A + (size_t)cur.pm * tstep; const char* cB = (const char*)g.Bt + (size_t)cur.pn * tstep;
    S.a_ready(cur);
    if constexpr (SP2) {
        PG8_STAGE(PG8_SB(0, 0), cB, voffB); PG8_STAGE(PG8_SB(0, 1), cB + hstep, voffB); PG8_STAGE(PG8_SA(0, 0), cA, voffA); PG8_STAGE(PG8_SA(0, 1), cA + hstep, voffA);
        if (wr == 1) PG8_BAR;
        PG8_WAIT_V(2); PG8_BAR;
        PG8_STAGE(PG8_SB(1, 0), cB + kstep, voffB); PG8_STAGE(PG8_SA(1, 0), cA + kstep, voffA); PG8_STAGE(PG8_SB(1, 1), cB + hstep + kstep, voffB);
        PG8_WAIT_V(6); PG8_BAR;
    } else {
        PG8_STAGE(PG8_SB(0, 0), cB, voffB); PG8_STAGE(PG8_SA(0, 0), cA, voffA); PG8_STAGE(PG8_SB(0, 1), cB + hstep, voffB); PG8_STAGE(PG8_SA(0, 1), cA + hstep, voffA);
        if (wr == 1) PG8_BAR;
        PG8_WAIT_V(4); PG8_BAR;
        PG8_STAGE(PG8_SB(1, 0), cB + kstep, voffB); PG8_STAGE(PG8_SA(1, 0), cA + kstep, voffA); PG8_STAGE(PG8_SB(1, 1), cB + hstep + kstep, voffB);
        PG8_WAIT_V(6); PG8_BAR;
    }
    for (;;) {
        const bool has_next = S.next(ui + 1, nxt);
        const char* nA = has_next ? (const char*)g.A + (size_t)nxt.pm * tstep : cA; const char* nB = has_next ? (const char*)g.Bt + (size_t)nxt.pn * tstep : cB;
        for (int t = 0; t < nt; t += 2) {
            const bool last = (t == nt - 2);
            const char* a1 = cA + (size_t)(t + 1) * kstep;
            const char* a2 = last ? nA : cA + (size_t)(t + 2) * kstep; const char* b2 = last ? nB : cB + (size_t)(t + 2) * kstep;
            const char* a3 = a2 + kstep; const char* b3 = b2 + kstep;
            if (last && has_next) S.a_ready(nxt);
            if constexpr (SP2) {
            PG8_LDB(B0, 0, 0); PG8_LDB(B1, 0, 1); PG8_SCHED; PG8_LDA(At, 0, 0); PG8_STAGE(PG8_SA(1, 1), a1 + hstep, voffA);
            PG8_WAIT_V(8); PG8_WAIT_L(0); PG8_BAR; PG8_MMA(0, 0, At, B0); PG8_MMA(0, 1, At, B1); PG8_BAR; PG8_SCHED;
            PG8_LDA(At, 0, 1); PG8_STAGE(PG8_SB(0, 0), b2, voffB); PG8_STAGE(PG8_SB(0, 1), b2 + hstep, voffB); PG8_STAGE(PG8_SA(0, 0), a2, voffA);
            PG8_WAIT_V(8); PG8_WAIT_L(0); PG8_BAR; PG8_MMA(1, 0, At, B0); PG8_MMA(1, 1, At, B1); PG8_BAR; PG8_SCHED;
            PG8_LDB(B0, 1, 0); PG8_LDB(B1, 1, 1); PG8_SCHED; PG8_LDA(At, 1, 0); PG8_STAGE(PG8_SA(0, 1), a2 + hstep, voffA);
            PG8_WAIT_V(8); PG8_WAIT_L(0); PG8_BAR; PG8_MMA(0, 0, At, B0); PG8_MMA(0, 1, At, B1); PG8_BAR; PG8_SCHED;
            PG8_LDA(At, 1, 1); PG8_STAGE(PG8_SB(1, 0), b3, voffB); PG8_STAGE(PG8_SB(1, 1), b3 + hstep, voffB); PG8_STAGE(PG8_SA(1, 0), a3, voffA);
            PG8_WAIT_V(8); PG8_WAIT_L(0); PG8_BAR; PG8_MMA(1, 0, At, B0); PG8_MMA(1, 1, At, B1); PG8_BAR; PG8_SCHED;
            } else {
            PG8_LDB(B0, 0, 0); PG8_SCHED; PG8_LDA(At, 0, 0); PG8_STAGE(PG8_SA(1, 1), a1 + hstep, voffA);
            PG8_WAIT_L(8); PG8_BAR; PG8_WAIT_L(0); PG8_MMA(0, 0, At, B0); PG8_BAR; PG8_SCHED;
            PG8_LDB(B1, 0, 1); PG8_STAGE(PG8_SB(0, 0), b2, voffB);
            PG8_BAR; PG8_WAIT_L(0); PG8_MMA(0, 1, At, B1); PG8_BAR;
            PG8_LDA(At, 0, 1); PG8_STAGE(PG8_SA(0, 0), a2, voffA);
            PG8_BAR; PG8_WAIT_L(0); PG8_MMA(1, 0, At, B0); PG8_BAR; PG8_SCHED;
            PG8_STAGE(PG8_SB(0, 1), b2 + hstep, voffB);
            PG8_WAIT_V(6); PG8_BAR; PG8_MMA(1, 1, At, B1); PG8_BAR;
            PG8_LDB(B0, 1, 0); PG8_SCHED; PG8_LDA(At, 1, 0); PG8_STAGE(PG8_SA(0, 1), a2 + hstep, voffA);
            PG8_WAIT_L(8); PG8_BAR; PG8_WAIT_L(0); PG8_MMA(0, 0, At, B0); PG8_BAR; PG8_SCHED;
            PG8_LDB(B1, 1, 1); PG8_STAGE(PG8_SB(1, 0), b3, voffB);
            PG8_BAR; PG8_WAIT_L(0); PG8_MMA(0, 1, At, B1); PG8_BAR;
            PG8_LDA(At, 1, 1); PG8_STAGE(PG8_SA(1, 0), a3, voffA);
            PG8_BAR; PG8_WAIT_L(0); PG8_MMA(1, 0, At, B0); PG8_BAR; PG8_SCHED;
            PG8_STAGE(PG8_SB(1, 1), b3 + hstep, voffB);
            PG8_WAIT_V(6); PG8_BAR; PG8_MMA(1, 1, At, B1); PG8_BAR;
            }
        }
        if constexpr (ALIGN_EPI) { if (wr == 0) PG8_BAR; }
        if constexpr (!Epi::AFTER_DRAIN) { E(acc, cur, wr, wc, fr, fq); S.done(cur); }
        if (!has_next) break;
#pragma unroll
        for (int a = 0; a < 2; ++a)
#pragma unroll
            for (int b = 0; b < 2; ++b)
#pragma unroll
                for (int m = 0; m < 4; ++m)
#pragma unroll
                    for (int n = 0; n < 2; ++n) acc[a][b][m][n] = (f32x4){0.f, 0.f, 0.f, 0.f};
        cur = nxt; cA = nA; cB = nB; ++ui;
        if constexpr (ALIGN_EPI) { if (wr == 1) PG8_BAR; }
    }
    PG8_WAIT_V(0);
    if constexpr (!ALIGN_EPI) { if (wr == 0) PG8_BAR; }
    PG8_BAR;
    if constexpr (Epi::AFTER_DRAIN) { E.fused(acc, cur, wr, wc, fr, fq, lds, wid, lane); S.done(cur); }
#undef PG8_SA
#undef PG8_SB
#undef PG8_STAGE
#undef PG8_LDA
#undef PG8_LDB
#undef PG8_MMA
#undef PG8_WAIT_V
#undef PG8_WAIT_L
#undef PG8_BAR
#undef PG8_SCHED
}
}
#define XB_TMO      128
#define XB_XCNT(j)  (256  + 64 * (j))
#define XB_XSUB(j)  (1280 + 64 * (j))
#define XB_XGEN(j)  (2304 + 64 * (j))
#define XB_TOP      3328
#define XB_TOPGEN   3392
#define XCD_BAR_WORDS 3456
#define XB_SPIN_CAP (1u << 18)

__device__ __forceinline__ unsigned xb_ld(unsigned* p)              { return __hip_atomic_load(p, __ATOMIC_RELAXED, __HIP_MEMORY_SCOPE_AGENT); }
__device__ __forceinline__ unsigned xb_add(unsigned* p, unsigned v) { return __hip_atomic_fetch_add(p, v, __ATOMIC_RELAXED, __HIP_MEMORY_SCOPE_AGENT); }
__device__ __forceinline__ unsigned xb_xcc_id() { return (unsigned)__builtin_amdgcn_s_getreg((3 << 11) | 20) & 0xFu; }
#define XB_SPIN(cond, bar) do { unsigned _sp = 0; while (cond) { __builtin_amdgcn_s_sleep(1); \
    if ((++_sp & 255u) == 0u) { if (xb_ld(&(bar)[XB_TMO])) break; if (_sp > XB_SPIN_CAP) { atomicAdd(&(bar)[XB_TMO], 1u); break; } } } } while (0)

struct XcdBarrier {
    unsigned* bar; unsigned x;
    volatile LAS unsigned* st;
};

__device__ __forceinline__ XcdBarrier xcd_barrier_post(unsigned* bar, volatile LAS unsigned* st) {
    XcdBarrier b; b.bar = bar; b.x = xb_xcc_id(); b.st = st;
    if (threadIdx.x == 0) (void)xb_add(&bar[XB_XCNT(b.x)], 1u);
    return b;
}
__device__ __forceinline__ void xcd_barrier_complete(unsigned* bar, unsigned x, unsigned& nloc, unsigned& nx) {
    const unsigned G = gridDim.x * gridDim.y * gridDim.z;
    unsigned sum, cnt, mine, sp = 0u;
    for (;;) {
        sum = 0u; cnt = 0u; mine = 0u;
#pragma unroll
        for (unsigned j = 0; j < 16; ++j) { const unsigned c = xb_ld(&bar[XB_XCNT(j)]); sum += c; cnt += (c > 0u) ? 1u : 0u; mine = (j == x) ? c : mine; }
        if (sum == G) break;
        __builtin_amdgcn_s_sleep(1);
        if ((++sp & 255u) == 0u) { if (xb_ld(&bar[XB_TMO])) break; if (sp > XB_SPIN_CAP) { atomicAdd(&bar[XB_TMO], 1u); break; } }
    }
    nloc = mine > 0u ? mine : 1u; nx = cnt > 0u ? cnt : 1u;
}

__device__ __forceinline__ void xcd_barrier(const XcdBarrier& b) {
    asm volatile("s_waitcnt vmcnt(0)" ::: "memory");
    __syncthreads();
    if (threadIdx.x == 0) {
        unsigned* bar = b.bar;
        __builtin_amdgcn_s_waitcnt(0);
        unsigned nloc = b.st[0], nx = b.st[1];
        if (nloc == 0u) { xcd_barrier_complete(bar, b.x, nloc, nx); b.st[0] = nloc; b.st[1] = nx; }
        const unsigned old = xb_add(&bar[XB_XSUB(b.x)], 1u);
        const unsigned gen = old / nloc;
        if (old + 1u == (gen + 1u) * nloc) {
            __builtin_amdgcn_fence(__ATOMIC_RELEASE, "agent");
            asm volatile("s_waitcnt vmcnt(0)" ::: "memory");
            const unsigned og = xb_add(&bar[XB_TOP], 1u);
            const unsigned tg = og / nx;
            if (og + 1u == (tg + 1u) * nx) xb_add(&bar[XB_TOPGEN], 1u);
            else XB_SPIN(xb_ld(&bar[XB_TOPGEN]) == tg, bar);
            __builtin_amdgcn_fence(__ATOMIC_ACQUIRE, "agent");
            xb_add(&bar[XB_XGEN(b.x)], 1u);
            asm volatile("s_waitcnt vmcnt(0)" ::: "memory");
        } else {
            XB_SPIN(xb_ld(&bar[XB_XGEN(b.x)]) == gen, bar);
            __builtin_amdgcn_fence(__ATOMIC_ACQUIRE, "agent");
            asm volatile("s_waitcnt vmcnt(0)" ::: "memory");
        }
    }
    __syncthreads();
}

using pg8::bf16_t; using pg8::bf16x8; using pg8::f32x4; using pg8::u32x4; using pg8::cvt_pk_bf16; using pg8::fast_exp;

#define BAR_LDS() do { asm volatile("s_waitcnt lgkmcnt(0)" ::: "memory"); __builtin_amdgcn_s_barrier(); asm volatile("" ::: "memory"); } while (0)
#define BAR_ALL() do { asm volatile("s_waitcnt vmcnt(0) lgkmcnt(0)" ::: "memory"); __builtin_amdgcn_s_barrier(); asm volatile("" ::: "memory"); } while (0)

#ifdef PROBE_SHFL
__device__ __forceinline__ float shx(float v, int mask, int lane) { (void)lane; return __shfl_xor(v, mask); }
__device__ __forceinline__ unsigned shxu(unsigned v, int mask, int lane) { (void)lane; return __shfl_xor(v, mask); }
__device__ __forceinline__ unsigned shupu(unsigned v, int d, int lane) { (void)lane; return __shfl_up(v, d); }
#else
__device__ __forceinline__ float shx(float v, int mask, int lane) { return __builtin_bit_cast(float, __builtin_amdgcn_ds_bpermute((lane ^ mask) << 2, __builtin_bit_cast(int, v))); }
__device__ __forceinline__ unsigned shxu(unsigned v, int mask, int lane) { return (unsigned)__builtin_amdgcn_ds_bpermute((lane ^ mask) << 2, (int)v); }
__device__ __forceinline__ unsigned shupu(unsigned v, int d, int lane) { return (unsigned)__builtin_amdgcn_ds_bpermute((lane - d) << 2, (int)v); }
#endif
__device__ __forceinline__ float wave_sum(float v, int lane) {
#pragma unroll
    for (int o = 1; o < 64; o <<= 1) v += shx(v, o, lane);
    return v;
}
__device__ __forceinline__ float bf_lo(unsigned u) { return __uint_as_float(u << 16); }
__device__ __forceinline__ float bf_hi(unsigned u) { return __uint_as_float(u & 0xffff0000u); }

struct Args { const float* in[18]; float* out; unsigned char* ws; };
struct Ctx { LAS unsigned char* lds; int w0;
    __device__ __forceinline__ const float* in(int i) const { return ldptr(lds, i); }
    __device__ __forceinline__ float* out() const { return (float*)ldptr(lds, 18); }
    __device__ __forceinline__ unsigned char* ws() const { return (unsigned char*)ldptr(lds, 19); } };
#define PHASE_IDS() const int tid = opaque_tid(a.w0), lane = tid & 63, wave = __builtin_amdgcn_readfirstlane(tid >> 6); (void)tid; (void)lane; (void)wave
enum { I_X = 0, I_C, I_CTX, I_CCTX, I_WADA, I_BADA, I_GMIX, I_GFFN, I_WIN, I_WOUT, I_LBL, I_ONORM, I_RDEC, I_WR, I_WEG, I_WEU, I_WED, I_GFIN };

struct CvtItem { const float* src; unsigned char* dst; int N, Kd, f8; };
__device__ __forceinline__ void cvt_desc(CvtItem& it, const float* W, int N, unsigned char* WT, int Kd, int k0, int n0, int drow0, int lane, int f8) {
    const int q = lane >> 4, c = lane & 15, es = f8 ? 1 : 2;
    it.src = W + (size_t)(k0 + 16 * q) * N + n0 + 4 * c; it.N = N; it.Kd = Kd * es; it.dst = WT + ((size_t)(drow0 + 4 * c) * Kd + k0 + 16 * q) * es; it.f8 = f8;
}
__device__ __forceinline__ void cvt_load(f32x4 (&v)[16], const CvtItem& it) {
#pragma unroll
    for (int i = 0; i < 16; ++i) v[i] = *(const f32x4*)(it.src + (size_t)i * it.N);
}
__device__ __forceinline__ void cvt_store(const f32x4 (&v)[16], const CvtItem& it) {
    if (it.f8) {
#pragma unroll
        for (int j = 0; j < 4; ++j) { u32x4 o; constexpr float s = pg8::F8_SW;
            o.x = pg8::pk4_fp8(v[0][j] * s, v[1][j] * s, v[2][j] * s, v[3][j] * s); o.y = pg8::pk4_fp8(v[4][j] * s, v[5][j] * s, v[6][j] * s, v[7][j] * s);
            o.z = pg8::pk4_fp8(v[8][j] * s, v[9][j] * s, v[10][j] * s, v[11][j] * s); o.w = pg8::pk4_fp8(v[12][j] * s, v[13][j] * s, v[14][j] * s, v[15][j] * s);
            *(u32x4*)(it.dst + (size_t)j * it.Kd) = o; }
    } else {
#pragma unroll
        for (int j = 0; j < 4; ++j) { u32x4 o0, o1;
            o0.x = cvt_pk_bf16(v[0][j], v[1][j]); o0.y = cvt_pk_bf16(v[2][j], v[3][j]); o0.z = cvt_pk_bf16(v[4][j], v[5][j]); o0.w = cvt_pk_bf16(v[6][j], v[7][j]);
            o1.x = cvt_pk_bf16(v[8][j], v[9][j]); o1.y = cvt_pk_bf16(v[10][j], v[11][j]); o1.z = cvt_pk_bf16(v[12][j], v[13][j]); o1.w = cvt_pk_bf16(v[14][j], v[15][j]);
            *(u32x4*)(it.dst + (size_t)j * it.Kd) = o0; *(u32x4*)(it.dst + (size_t)j * it.Kd + 16) = o1; }
    }
}
__device__ __forceinline__ void cvt_expert_desc(CvtItem& it, const Ctx& a, unsigned char* ws, int g, int lane) {
    constexpr int I_E = 512; const int l = g / 24576, r = g % 24576; const int le = l * 16 + r / (3 * I_E), q3 = r % (3 * I_E), kind = q3 / I_E, q = q3 % I_E;
    if (kind < 2) { const int kb = q / 32, nb = q % 32, n0 = nb * 64;
        const int drow = 256 * (n0 >> 7) + (n0 & 127) + kind * 128;
        cvt_desc(it, a.in(kind == 0 ? I_WEG : I_WEU) + (size_t)le * D * FF, FF, (unsigned char*)(ws + WS_WGU) + (size_t)le * 4096 * D, D, kb * 64, n0, drow, lane, 1);
    } else { const int kb = q / 16, nb = q % 16;
        cvt_desc(it, a.in(I_WED) + (size_t)le * FF * D, D, (unsigned char*)(ws + WS_WD) + (size_t)le * D * FF, FF, kb * 64, nb * 64, nb * 64, lane, 1); }
}
constexpr int CVT_N0 = 9472, CVT_G1 = 7040, CVT_G2 = 7936, CVT_T = 4608, CVT_G4 = 6144, CVT_CYC = CVT_G1 + CVT_G2 + CVT_T + CVT_G4;
static_assert(CVT_G1 == 220 * 8 * 4 && CVT_G2 == 248 * 8 * 4 && CVT_T == 192 * 8 * 3 && CVT_G4 == 192 * 8 * 4, "slot sizes = idle workgroups x 8 waves x items per wave");
static_assert(CVT_N0 + CVT_G1 + CVT_G2 + CVT_T >= 24576 && CVT_N0 + CVT_CYC + CVT_G1 + CVT_G2 + CVT_T >= 2 * 24576 && CVT_N0 + 2 * CVT_CYC + CVT_G1 + CVT_G2 + CVT_T >= 3 * 24576 && CVT_N0 + 3 * CVT_CYC + CVT_G1 + CVT_T >= 4 * 24576, "every layer's expert weights are converted before its first expert GEMM");
__device__ __forceinline__ void cvt_tail(const Ctx& a, int first, int rank, int per, int i0, int i1) {
    PHASE_IDS(); unsigned char* ws = a.ws();
    const int base = first + (rank * 8 + wave) * per; int g = base + i0, g1 = base + i1; if (g1 > 4 * 24576) g1 = 4 * 24576;
    f32x4 va[16], vb[16]; CvtItem ia, ib;
    if (g < g1) { cvt_expert_desc(ia, a, ws, g, lane); cvt_load(va, ia); }
    while (g < g1) {
        if (g + 1 < g1) { cvt_expert_desc(ib, a, ws, g + 1, lane); cvt_load(vb, ib); }
        cvt_store(va, ia);
        if (++g >= g1) break;
        if (g + 1 < g1) { cvt_expert_desc(ia, a, ws, g + 1, lane); cvt_load(va, ia); }
        cvt_store(vb, ib);
        ++g; }
}
template <int PER>
__device__ __forceinline__ void cvt_tail(const Ctx& a, int first, int rank) { cvt_tail(a, first, rank, PER, 0, PER); }

__device__ __forceinline__ void p0_item_desc(CvtItem& it, const Ctx& a, unsigned char* ws, int r, int lane) {
    constexpr int I_IN = 16 * 72, I_OUT = 16 * 16;
    if (r < 4 * I_IN) { const int l = r / I_IN, q = r % I_IN, kb = q / 72, nb = q % 72;

#ifdef G1_F8
        cvt_desc(it, a.in(I_WIN) + (size_t)l * D * INW, INW, (unsigned char*)(ws + WS_WIN) + (size_t)l * INW * D, D, kb * 64, nb * 64, nb * 64, lane, 1); return; }
#else
        cvt_desc(it, a.in(I_WIN) + (size_t)l * D * INW, INW, (unsigned char*)((bf16_t*)(ws + WS_WIN) + (size_t)l * INW * D), D, kb * 64, nb * 64, nb * 64, lane, 0); return; }
#endif
    r -= 4 * I_IN;
    if (r < 4 * I_OUT) { const int l = r / I_OUT, q = r % I_OUT, kb = q / 16, nb = q % 16;

#ifdef G2_F8
        cvt_desc(it, a.in(I_WOUT) + (size_t)l * D * D, D, (unsigned char*)(ws + WS_WOUT) + (size_t)l * D * D, D, kb * 64, nb * 64, nb * 64, lane, 1); return; }
#else
        cvt_desc(it, a.in(I_WOUT) + (size_t)l * D * D, D, (unsigned char*)((bf16_t*)(ws + WS_WOUT) + (size_t)l * D * D), D, kb * 64, nb * 64, nb * 64, lane, 0); return; }
#endif
    r -= 4 * I_OUT;
    cvt_expert_desc(it, a, ws, r, lane);
}
__device__ __forceinline__ void p0_prologue(const Ctx& a) {
    PHASE_IDS(); LAS unsigned char* lds = launder_lds(a.lds); unsigned char* ws = a.ws(); const float* cin_ = a.in(I_C); const float* cctx_ = a.in(I_CCTX);
    LAS float* scond = (LAS float*)(lds + 8 * 16640);
    for (int i = tid; i < 3 * D; i += 512) { const int w = i >> 10, k = i & 1023; const float cv = (w < 2) ? cin_[w * D + k] : cctx_[k]; scond[i] = cv * pg8::fast_sigmoid(cv); }
    if (blockIdx.x == 0) { const int c = tid; const float* lg = a.in(I_LBL);
        const float l0 = lg[c], l1 = lg[512 + c], l2 = lg[1024 + c], l3 = lg[1536 + c]; const float mx = fmaxf(fmaxf(l0, l1), fmaxf(l2, l3));
        const float e0 = expf(l0 - mx), e1 = expf(l1 - mx), e2 = expf(l2 - mx), e3 = expf(l3 - mx), inv = 1.0f / (e0 + e1 + e2 + e3);
        float* lbs = (float*)(ws + WS_LBS); lbs[c] = 0.f; lbs[512 + c] = e1 * inv; lbs[1024 + c] = (e1 + e2) * inv; lbs[1536 + c] = (e1 + e2 + e3) * inv; }
    if (blockIdx.x >= 1 && blockIdx.x <= 16) { const int idx = (blockIdx.x - 1) * 512 + tid, pos = idx >> 5, f = idx & 31;
        const float invf = powf(10000.0f, -(float)f / 32.0f), ang = (float)pos * invf; float* cs = (float*)(ws + WS_ROPE); cs[idx * 2] = cosf(ang); cs[idx * 2 + 1] = sinf(ang); }
    BAR_LDS();
    const int gw = blockIdx.x * 8 + wave, NGW = gridDim.x * 8;
    for (int it = gw; it < 4 * 24 * 8; it += NGW) { const int l = it / 192, r = it % 192, cg = r >> 3, ks = r & 7; const int cols = cg * 256 + lane * 4;
        const float* wp = a.in(I_WADA) + ((size_t)l * D + ks * 128) * 6144 + cols; f32x4 a0 = {0, 0, 0, 0}, a1 = a0, a2 = a0;
#pragma unroll 8
        for (int kk = 0; kk < 128; ++kk) { const f32x4 w = *(const f32x4*)(wp + (size_t)kk * 6144); const int k = ks * 128 + kk; a0 += w * scond[k]; a1 += w * scond[D + k]; a2 += w * scond[2 * D + k]; }
        float* pp = (float*)(ws + WS_MODP) + (size_t)((l * 8 + ks) * 3) * 6144 + cols; *(f32x4*)pp = a0; *(f32x4*)(pp + 6144) = a1; *(f32x4*)(pp + 2 * 6144) = a2; }
#ifdef PROBE_NOBG
    const int n_exp = 4 * 24576;
#else
    const int n_exp = (gridDim.x == 256) ? CVT_N0 : 4 * 24576;
#endif
    const int NIT = 4 * (16 * 72 + 16 * 16) + n_exp;
    f32x4 va[16], vb[16]; CvtItem ia, ib; int it = gw;
    if (it < NIT) { p0_item_desc(ia, a, ws, it, lane); cvt_load(va, ia); }
    while (it < NIT) {
        int nx = it + NGW;
        if (nx < NIT) { p0_item_desc(ib, a, ws, nx, lane); cvt_load(vb, ib); }
        cvt_store(va, ia);
        it = nx; if (it >= NIT) break;
        nx = it + NGW;
        if (nx < NIT) { p0_item_desc(ia, a, ws, nx, lane); cvt_load(va, ia); }
        cvt_store(vb, ib);
        it = nx;
    }
}

__device__ __forceinline__ void p0_finalize(const Ctx& a) {
    PHASE_IDS(); unsigned char* ws = a.ws(); const float* bada = a.in(I_BADA); const float* part = (const float*)(ws + WS_MODP); float* mods = (float*)(ws + WS_MODS);
    for (int i = blockIdx.x * 512 + tid; i < 4 * 3 * 6144; i += gridDim.x * 512) { const int l = i / (3 * 6144), r = i % (3 * 6144), w = r / 6144, j = r % 6144;
        float s = bada[l * 6144 + j];
#pragma unroll
        for (int ks = 0; ks < 8; ++ks) s += part[(size_t)((l * 8 + ks) * 3 + w) * 6144 + j];
        mods[i] = s; }
}

template <int MODE>
__device__ __forceinline__ void norm1_phase(const Ctx& a, int l) {
    PHASE_IDS(); unsigned char* ws = a.ws(); const float* in_x = a.in(I_X); const float* in_ctx = a.in(I_CTX); const float* gm = (MODE != 1) ? a.in(I_GMIX) + l * D : a.in(I_GFIN); float* outp = a.out(); const int gw = blockIdx.x * 8 + wave, NGW = gridDim.x * 8;
    const float* mods = (const float*)(ws + WS_MODS); bf16_t* X = (bf16_t*)(ws + WS_X); bf16_t* H = (bf16_t*)(ws + WS_H);
    const int* inv = (const int*)(ws + WS_INV); const unsigned char* YS = (const unsigned char*)(ws + WS_YS); const float* gate = (const float*)(ws + WS_ROWMAP) + MOE_ROWS;
    constexpr int NTOT = (MODE == 1) ? NB * SEQ : MROWS;
#define N1_ROWOF(n_) ((MODE == 1) ? (((n_) >> 14) * LTOT + CTX + ((n_) & (SEQ - 1))) : (n_))
#define N1_LOADROW(n_, v_, iv_) do { const int r_ = N1_ROWOF(n_); const int b_ = r_ >= LTOT ? 1 : 0, g_ = r_ - b_ * LTOT; \
        if (l == 0) { const float* src_ = (g_ < CTX ? in_ctx + (size_t)(b_ * CTX + g_) * D : in_x + (size_t)(b_ * SEQ + g_ - CTX) * D); \
            _Pragma("unroll") for (int j = 0; j < 4; ++j) v_[j] = *(const f32x4*)(src_ + lane * 4 + 256 * j); } \
        else { const bf16_t* src_ = X + (size_t)r_ * D; _Pragma("unroll") for (int j = 0; j < 4; ++j) { const u32x2 w_ = *(const u32x2*)(src_ + lane * 4 + 256 * j); v_[j] = (f32x4){bf_lo(w_.x), bf_hi(w_.x), bf_lo(w_.y), bf_hi(w_.y)}; } \
            iv_ = inv[r_ * 16 + (lane & 15)]; } } while (0)
    f32x4 v[4]; int iv = -1; int n = gw;
    if (n < NTOT) N1_LOADROW(n, v, iv);
    for (; n < NTOT; n += NGW) {
        const int row = N1_ROWOF(n); const int b = row >= LTOT ? 1 : 0, g = row - b * LTOT; const bool isctx = g < CTX; const int which = isctx ? 2 : b;
        f32x4 vn[4]; int ivn = -1; const int nn = n + NGW;
        if (nn < NTOT) N1_LOADROW(nn, vn, ivn);
        if (l != 0) {
            unsigned vm = (unsigned)__builtin_amdgcn_ballot_w64(iv >= 0) & 0xffffu;
            f32x4 s[4] = {{0, 0, 0, 0}, {0, 0, 0, 0}, {0, 0, 0, 0}, {0, 0, 0, 0}};
            while (vm) {
                const int e0 = __builtin_ctz(vm); vm &= vm - 1; const bool has1 = vm != 0u; const int e1 = has1 ? __builtin_ctz(vm) : e0; if (has1) vm &= vm - 1;
                const int mr0 = __builtin_amdgcn_readlane(iv, e0), mr1 = __builtin_amdgcn_readlane(iv, e1);
                const float g0 = gate[mr0] * (1.0f / pg8::F8_SY), g1 = has1 ? gate[mr1] * (1.0f / pg8::F8_SY) : 0.f;
                const unsigned char* y0r = YS + (size_t)mr0 * D + lane * 4; const unsigned char* y1r = YS + (size_t)mr1 * D + lane * 4; unsigned y0[4], y1[4];
#pragma unroll
                for (int j = 0; j < 4; ++j) { y0[j] = *(const unsigned*)(y0r + 256 * j); y1[j] = *(const unsigned*)(y1r + 256 * j); }
#pragma unroll
                for (int j = 0; j < 4; ++j) { const f32x2 a01 = __builtin_amdgcn_cvt_pk_f32_fp8((int)y0[j], false), a23 = __builtin_amdgcn_cvt_pk_f32_fp8((int)y0[j], true);
                    const f32x2 b01 = __builtin_amdgcn_cvt_pk_f32_fp8((int)y1[j], false), b23 = __builtin_amdgcn_cvt_pk_f32_fp8((int)y1[j], true);
                    s[j][0] += g0 * a01.x + g1 * b01.x; s[j][1] += g0 * a01.y + g1 * b01.y; s[j][2] += g0 * a23.x + g1 * b23.x; s[j][3] += g0 * a23.y + g1 * b23.y; } }
            const float* gt2 = mods + (size_t)((l - 1) * 3 + which) * 6144 + 5 * D; bf16_t* xr = X + (size_t)row * D;
#pragma unroll
            for (int j = 0; j < 4; ++j) { v[j] += *(const f32x4*)(gt2 + lane * 4 + 256 * j) * s[j]; if (MODE == 0) { u32x2 w; w.x = cvt_pk_bf16(v[j][0], v[j][1]); w.y = cvt_pk_bf16(v[j][2], v[j][3]); *(u32x2*)(xr + lane * 4 + 256 * j) = w; } }
        }
        float ss = 0.f;
#pragma unroll
        for (int j = 0; j < 4; ++j) ss += (v[j][0] * v[j][0] + v[j][1] * v[j][1]) + (v[j][2] * v[j][2] + v[j][3] * v[j][3]);
        const float rinv = __builtin_amdgcn_rsqf(wave_sum(ss, lane) * (1.0f / D) + EPS);
        if (MODE != 1) {
            const float* sh = mods + (size_t)(l * 3 + which) * 6144; const float* sc = sh + D;
            bf16_t* hr = H + (size_t)row * D + lane * 4;
#pragma unroll
            for (int j = 0; j < 4; ++j) { const int c = lane * 4 + 256 * j; const f32x4 gg = *(const f32x4*)(gm + c), s1 = *(const f32x4*)(sc + c), s0 = *(const f32x4*)(sh + c);
                const f32x4 y = v[j] * rinv * gg * (s1 + 1.0f) + s0;
#ifdef G1_F8
                *(unsigned*)((unsigned char*)H + (size_t)row * D + c) = pg8::pk4_fp8(y[0] * pg8::F8_SA, y[1] * pg8::F8_SA, y[2] * pg8::F8_SA, y[3] * pg8::F8_SA); }
#else
                u32x2 w; w.x = cvt_pk_bf16(y[0], y[1]); w.y = cvt_pk_bf16(y[2], y[3]); *(u32x2*)(hr + 256 * j) = w; }
#endif
        } else {
            float* orow = outp + (size_t)(b * SEQ + g - CTX) * D + lane * 4;
#pragma unroll
            for (int j = 0; j < 4; ++j) *(f32x4*)(orow + 256 * j) = v[j] * rinv * *(const f32x4*)(gm + lane * 4 + 256 * j);
        }
#pragma unroll
        for (int j = 0; j < 4; ++j) v[j] = vn[j];
        iv = ivn;
    }
#undef N1_ROWOF
#undef N1_LOADROW
}

constexpr int N2_WH = 0, N2_WL = 32768, N2_CS = 65536, N2_CH = 69632, N2_CE = 73728;
typedef __bf16 bf2v __attribute__((ext_vector_type(2)));
__device__ __forceinline__ float dot2_bf16(unsigned u, float c) { const bf2v v = __builtin_bit_cast(bf2v, u); return __builtin_amdgcn_fdot2_f32_bf16(v, v, c, false); }
__device__ __forceinline__ void norm2_phase(const Ctx& a, int l) {
    PHASE_IDS(); LAS unsigned char* lds = launder_lds(a.lds); unsigned char* ws = a.ws();
    const bf16_t* X = (const bf16_t*)(ws + WS_X); unsigned char* H8 = (unsigned char*)(ws + WS_H);
    int* inv = (int*)(ws + WS_INV); float* afl = (float*)(ws + WS_AFF); float* afc = afl + 2 * 16 * SEQ;
    const bool last = (l == DEPTH - 1);
    const int NQ = last ? 2048 : 2080;
    int built = -1;
    for (int q0 = blockIdx.x * 8; q0 < NQ; q0 += gridDim.x * 8) {
        const int which = q0 < 1024 ? 0 : (q0 < 2048 ? 1 : 2);
        const int q = q0 + wave; const bool isctx = q >= 2048;
        const int b = isctx ? ((q - 2048) >> 4) : (q >> 10), g0 = isctx ? ((q - 2048) & 15) * 16 : CTX + (q & 1023) * 16;
        const int row0 = b * LTOT + g0; const int r = lane & 15, kg = lane >> 4;
        u32x4 xa[32];
        { const bf16_t* xp = X + (size_t)(row0 + r) * D + 16 * kg;
#pragma unroll
          for (int c = 0; c < 16; ++c) { xa[2 * c] = *(const u32x4*)(xp + 64 * c); xa[2 * c + 1] = *(const u32x4*)(xp + 64 * c + 8); } }
        if (which != built) {
            if (built >= 0) BAR_LDS();
            const float* wr = a.in(I_WR) + (size_t)l * D * NE; const float* gm = a.in(I_GFFN) + l * D;
            const float* sh = (const float*)(ws + WS_MODS) + (size_t)(l * 3 + which) * 6144 + 3 * D; const float* sc = sh + D;
            const int e = tid & 15; float cpart = 0.f;
#pragma unroll 1
            for (int i = 0; i < 4; ++i) { const int u = tid + 512 * i; const int s = u >> 6, kgu = (u >> 4) & 3; const int k0 = 64 * (s >> 1) + 16 * kgu + 8 * (s & 1);
                u32x4 hi4, lo4;
#pragma unroll
                for (int h = 0; h < 2; ++h) { const f32x4 gg = *(const f32x4*)(gm + k0 + 4 * h), s1 = *(const f32x4*)(sc + k0 + 4 * h), s0 = *(const f32x4*)(sh + k0 + 4 * h); const f32x4 m = gg * (s1 + 1.0f);
#pragma unroll
                    for (int jp = 0; jp < 2; ++jp) { const int j = 4 * h + 2 * jp; const float w0 = wr[(k0 + j) * 16 + e], w1 = wr[(k0 + j + 1) * 16 + e];
                        const float v0 = m[2 * jp] * w0, v1 = m[2 * jp + 1] * w1; cpart += s0[2 * jp] * w0 + s0[2 * jp + 1] * w1;
                        const unsigned ph = cvt_pk_bf16(v0, v1); const unsigned pl = cvt_pk_bf16(v0 - bf_lo(ph), v1 - bf_hi(ph));
                        hi4[2 * h + jp] = ph; lo4[2 * h + jp] = pl; } }
                *(LAS u32x4*)(lds + N2_WH + u * 16) = hi4; *(LAS u32x4*)(lds + N2_WL + u * 16) = lo4; }
            cpart += shx(cpart, 16, lane); cpart += shx(cpart, 32, lane);
            if (lane < 16) ((LAS float*)(lds + N2_CE))[wave * 16 + lane] = cpart;
            if (tid < 256) { const int k = tid * 4; const f32x4 gg = *(const f32x4*)(gm + k), s1 = *(const f32x4*)(sc + k), s0 = *(const f32x4*)(sh + k);
                *(LAS f32x4*)(lds + N2_CS + k * 4) = gg * (s1 + 1.0f) * pg8::F8_SA; *(LAS f32x4*)(lds + N2_CH + k * 4) = s0 * pg8::F8_SA; }
            BAR_LDS(); built = which;
        }
        f32x4 acc = {0.f, 0.f, 0.f, 0.f}; float ss = 0.f;
#pragma unroll
        for (int s = 0; s < 32; ++s) {
            const bf16x8 wh = *(const LAS bf16x8*)(lds + N2_WH + (s * 64 + lane) * 16), wl = *(const LAS bf16x8*)(lds + N2_WL + (s * 64 + lane) * 16);
            const bf16x8 xf = __builtin_bit_cast(bf16x8, xa[s]);
            acc = __builtin_amdgcn_mfma_f32_16x16x32_bf16(wh, xf, acc, 0, 0, 0); acc = __builtin_amdgcn_mfma_f32_16x16x32_bf16(wl, xf, acc, 0, 0, 0);
            ss = dot2_bf16(xa[s][0], ss); ss = dot2_bf16(xa[s][1], ss); ss = dot2_bf16(xa[s][2], ss); ss = dot2_bf16(xa[s][3], ss);
            if ((s & 3) == 3) __builtin_amdgcn_sched_barrier(0); }
        ss += shx(ss, 16, lane); ss += shx(ss, 32, lane);
        const float rinv = __builtin_amdgcn_rsqf(ss * (1.0f / D) + EPS);
        {
            f32x4 ce = {0.f, 0.f, 0.f, 0.f};
#pragma unroll
            for (int w = 0; w < 8; ++w) ce += *(const LAS f32x4*)(lds + N2_CE + (w * 16 + 4 * kg) * 4);
            const f32x4 lg = acc * rinv + ce;
            float mx = fmaxf(fmaxf(lg[0], lg[1]), fmaxf(lg[2], lg[3])); mx = fmaxf(mx, shx(mx, 16, lane)); mx = fmaxf(mx, shx(mx, 32, lane));
            f32x4 ex; ex[0] = expf(lg[0] - mx); ex[1] = expf(lg[1] - mx); ex[2] = expf(lg[2] - mx); ex[3] = expf(lg[3] - mx);
            float sm = (ex[0] + ex[1]) + (ex[2] + ex[3]); sm += shx(sm, 16, lane); sm += shx(sm, 32, lane);
            float* dst = isctx ? afc + (size_t)(b * 16 + 4 * kg) * CTX + g0 + r : afl + (size_t)(b * 16 + 4 * kg) * SEQ + (g0 - CTX) + r; const int estr = isctx ? CTX : SEQ;
#pragma unroll
            for (int j = 0; j < 4; ++j) dst[(size_t)j * estr] = ex[j] / sm; }
        { typedef int i32x4 __attribute__((ext_vector_type(4))); int m1 = -1; asm volatile("" : "+v"(m1)); *(i32x4*)(inv + (size_t)row0 * 16 + lane * 4) = (i32x4){m1, m1, m1, m1}; }
        unsigned char* hp = H8 + (size_t)(row0 + r) * D + 16 * kg;
#pragma unroll
        for (int c = 0; c < 16; ++c) { const LAS f32x4* cs = (const LAS f32x4*)(lds + N2_CS + (64 * c + 16 * kg) * 4); const LAS f32x4* ch = (const LAS f32x4*)(lds + N2_CH + (64 * c + 16 * kg) * 4);
            u32x4 o;
#pragma unroll
            for (int h = 0; h < 4; ++h) { const unsigned w0 = xa[2 * c + (h >> 1)][2 * (h & 1)], w1 = xa[2 * c + (h >> 1)][2 * (h & 1) + 1];
                const f32x4 xv = {bf_lo(w0), bf_hi(w0), bf_lo(w1), bf_hi(w1)}; const f32x4 y = xv * rinv * cs[h] + ch[h]; o[h] = pg8::pk4_fp8(y[0], y[1], y[2], y[3]); }
            *(u32x4*)(hp + 64 * c) = o;
            if ((c & 1) == 1) __builtin_amdgcn_sched_barrier(0); }
    }
}

__device__ __forceinline__ void topk_phase(const Ctx& a, int l) {
    PHASE_IDS(); LAS unsigned char* lds = launder_lds(a.lds); unsigned char* ws = a.ws(); const float* afl = (const float*)(ws + WS_AFF); const float* afc = afl + 2 * 16 * SEQ;
    int* rowmap = (int*)(ws + WS_ROWMAP); float* gate = (float*)(ws + WS_ROWMAP) + MOE_ROWS; int* inv = (int*)(ws + WS_INV);
    LAS unsigned* wcnt = (LAS unsigned*)lds;
    const int nitems = (l == DEPTH - 1) ? 32 : 64;
    for (int it = blockIdx.x; it < nitems; it += gridDim.x) {
        const bool isctx = it >= 32; const int be = it & 31, b = be >> 4, e = be & 15;
        const int n = isctx ? CTX : SEQ, k = isctx ? CAP_CTX : CAP_LAT;
        const float* src = isctx ? afc + be * CTX : afl + (size_t)be * SEQ;
        unsigned key[32];
#pragma unroll
        for (int i = 0; i < 32; ++i) { const int idx = i * 512 + tid; key[i] = idx < n ? __float_as_uint(src[idx]) : 0u; }
        unsigned T = 0u;
        for (int bit = 30; bit >= 0; --bit) { const unsigned cand = T | (1u << bit); unsigned cnt = 0;
#pragma unroll
            for (int i = 0; i < 32; ++i) cnt += (key[i] >= cand) ? 1u : 0u;
#pragma unroll
            for (int o = 1; o < 64; o <<= 1) cnt += shxu(cnt, o, lane);
            LAS unsigned* wc = wcnt + (bit & 1) * 8; if (lane == 0) wc[wave] = cnt;
            BAR_LDS();
            unsigned tot = 0;
#pragma unroll
            for (int w = 0; w < 8; ++w) tot += wc[w];
            if (tot >= (unsigned)k) T = cand; }
        unsigned mine = 0;
#pragma unroll
        for (int i = 0; i < 32; ++i) mine += (key[i] > T ? 1u : 0u) + (key[i] == T ? 65536u : 0u);
        unsigned incl = mine;
#pragma unroll
        for (int o = 1; o < 64; o <<= 1) { const unsigned t = shupu(incl, o, lane); if (lane >= o) incl += t; }
        LAS unsigned* wt = wcnt + 16; BAR_LDS();
        if (lane == 63) wt[wave] = incl;
        BAR_LDS();
        unsigned base = 0, total = 0;
#pragma unroll
        for (int w = 0; w < 8; ++w) { const unsigned t = wt[w]; total += t; if (w < wave) base += t; }
        const unsigned excl = base + incl - mine; const unsigned cgt = total & 0xffffu; const unsigned need = (unsigned)k - cgt;
        unsigned sg = excl & 0xffffu, se = excl >> 16;
        const int mrbase = e * MOE_ROWS_E + (isctx ? 4096 + b * CAP_CTX : b * CAP_LAT);
        const int rbase = b * LTOT + (isctx ? 0 : CTX);
#pragma unroll
        for (int i = 0; i < 32; ++i) { const int idx = i * 512 + tid; const unsigned kk = key[i]; int slot = -1;
            if (kk > T) { slot = (int)sg; ++sg; } else if (kk == T) { if (se < need) slot = (int)(cgt + se); ++se; }
            if (slot >= 0) { const int mr = mrbase + slot, r = rbase + idx; rowmap[mr] = r; gate[mr] = __uint_as_float(kk); inv[r * 16 + e] = mr; } }
        if (isctx && b == 0 && tid < 192) { const int mr = e * MOE_ROWS_E + 4160 + tid; rowmap[mr] = 0; gate[mr] = 0.f; }
        BAR_LDS();
    }
}


constexpr int SC_QI = 0, SC_KI = 16384, SC_KT = 32768, SC_VT = 49152, SC_PI = 65536, SC_SM = 73728, SC_PART = 106496, SC_VA = 110592, SC_VB = 111104, SC_VM = 111616, SC_RED = 112128;
__device__ __forceinline__ int st_off(int r, int cbytes, int ncs) { return ((r >> 4) * ncs + (cbytes >> 6)) * 1024 + (r & 15) * 64 + ((cbytes & 63) ^ ((r & 8) << 2)); }
__device__ __forceinline__ int st_lane(int fr, int fq) { return fr * 64 + ((fq * 16) ^ ((fr & 8) << 2)); }
struct ScanBufs { int kt, vt, part, va, vb, vm; };
__device__ __forceinline__ ScanBufs scan_bufs(int parity) { ScanBufs b; b.kt = parity ? SC_QI : SC_KT; b.vt = parity ? SC_KI : SC_VT; b.part = parity ? SC_PI : SC_PART; b.va = parity ? SC_PI + 4096 : SC_VA; b.vb = parity ? SC_PI + 4608 : SC_VB; b.vm = parity ? SC_PI + 5120 : SC_VM; return b; }

__device__ __forceinline__ bf16x8 ldfrag(const LAS unsigned char* img, int tile, int ks, int ncs, int lp) { return *(const LAS bf16x8*)(img + (tile * ncs + ks) * 1024 + lp); }
#define MFMA16(a, b, c) __builtin_amdgcn_mfma_f32_16x16x32_bf16((a), (b), (c), 0, 0, 0)
#ifndef SCAN_LOG2
__device__ __forceinline__ float ex2(float x) { return __builtin_amdgcn_exp2f(x * 1.4426950408889634f); }
#define LOG2E_ 1.0f
#else
__device__ __forceinline__ float ex2(float x) { return __builtin_amdgcn_exp2f(x); }
#define LOG2E_ 1.4426950408889634f
#endif

__device__ __forceinline__ void scan_write_T(LAS unsigned char* img, const unsigned (&d)[8], int cp, int to) {
    u32x4 wa, wb;
    wa.x = (d[0] & 0xffffu) | (d[1] << 16); wa.y = (d[2] & 0xffffu) | (d[3] << 16); wa.z = (d[4] & 0xffffu) | (d[5] << 16); wa.w = (d[6] & 0xffffu) | (d[7] << 16);
    wb.x = (d[0] >> 16) | (d[1] & 0xffff0000u); wb.y = (d[2] >> 16) | (d[3] & 0xffff0000u); wb.z = (d[4] >> 16) | (d[5] & 0xffff0000u); wb.w = (d[6] >> 16) | (d[7] & 0xffff0000u);
    *(LAS u32x4*)(img + st_off(2 * cp, to * 16, 2)) = wa; *(LAS u32x4*)(img + st_off(2 * cp + 1, to * 16, 2)) = wb;
}

template <bool FULL>
__device__ __forceinline__ void scan_estage_hg(LAS unsigned char* lds, const ScanBufs& B, const unsigned (&kraw)[8], const unsigned (&qraw)[8], const unsigned (&vraw)[8], int lane, int wave, float& la_out, float& lb_out) {
    const int cp = lane, to = wave;
#ifndef SCAN_LOG2
    constexpr float LS = 1.4426950408889634f;
#else
    constexpr float LS = 1.0f;
#endif
    f32x2 c2[8]; f32x2 r2 = {0.f, 0.f};
#pragma unroll
    for (int tt = 0; tt < 8; ++tt) { r2 += (f32x2){bf_lo(kraw[tt]), bf_hi(kraw[tt])}; c2[tt] = r2; }
    *(LAS f32x2*)(lds + B.part + (to * 128 + 2 * cp) * 4) = r2;
    BAR_LDS();
    f32x2 p2 = {0.f, 0.f}, m2 = {0.f, 0.f}, l2 = {0.f, 0.f};
#pragma unroll
    for (int t8 = 0; t8 < 8; ++t8) { const f32x2 pp = *(const LAS f32x2*)(lds + B.part + (t8 * 128 + 2 * cp) * 4);
        if (t8 < to) p2 += pp; if (t8 < 4) m2 += pp; l2 += pp; }
    p2 = (p2 - m2) * LS;
    unsigned kd[8];
#pragma unroll
    for (int tt = 0; tt < 8; ++tt) { const int rr = 8 * to + tt;
        f32x2 d2 = p2 + c2[tt] * LS;
        d2 = __builtin_elementwise_min(__builtin_elementwise_max(d2, (f32x2){-120.f, -120.f}), (f32x2){120.f, 120.f});
        const f32x2 lf2 = (f32x2){bf_lo(kraw[tt]), bf_hi(kraw[tt])} * LS;
        const f32x2 k2 = (f32x2){1.0f, 1.0f} - (f32x2){__builtin_amdgcn_exp2f(lf2.x), __builtin_amdgcn_exp2f(lf2.y)};
        const f32x2 kt2 = k2 * (f32x2){__builtin_amdgcn_exp2f(-d2.x), __builtin_amdgcn_exp2f(-d2.y)};
        kd[tt] = cvt_pk_bf16(kt2.x, kt2.y);
        if (FULL) { const f32x2 qt2 = (f32x2){bf_lo(qraw[tt]), bf_hi(qraw[tt])} * (f32x2){__builtin_amdgcn_exp2f(d2.x), __builtin_amdgcn_exp2f(d2.y)};
            *(LAS unsigned*)(lds + SC_QI + st_off(rr, cp * 4, 4)) = cvt_pk_bf16(qt2.x, qt2.y);
            *(LAS unsigned*)(lds + SC_KI + st_off(rr, cp * 4, 4)) = kd[tt]; } }
    scan_write_T(lds + B.kt, kd, cp, to); scan_write_T(lds + B.vt, vraw, cp, to);
    if (to == 0) { *(LAS f32x2*)(lds + B.va + 8 * cp) = (f32x2){ex2(l2.x), ex2(l2.y)}; *(LAS f32x2*)(lds + B.vb + 8 * cp) = (f32x2){ex2(l2.x - m2.x), ex2(l2.y - m2.y)};
        *(LAS f32x2*)(lds + B.vm + 8 * cp) = (f32x2){ex2(m2.x), ex2(m2.y)}; }
    la_out = l2.x; lb_out = l2.y;
}
template <bool FULL>
__device__ __forceinline__ void scan_estage_ret(LAS unsigned char* lds, const ScanBufs& B, const unsigned (&kraw)[8], const unsigned (&qraw)[8], const unsigned (&vraw)[8], int lane, int wave, float lg2) {
    const int cp = lane, to = wave; unsigned kd[8];
#pragma unroll
    for (int tt = 0; tt < 8; ++tt) { const int rr = 8 * to + tt; const float wk = ex2((float)(63 - rr) * lg2); kd[tt] = cvt_pk_bf16(bf_lo(kraw[tt]) * wk, bf_hi(kraw[tt]) * wk);
        if (FULL) { *(LAS unsigned*)(lds + SC_QI + st_off(rr, cp * 4, 4)) = qraw[tt]; *(LAS unsigned*)(lds + SC_KI + st_off(rr, cp * 4, 4)) = kraw[tt]; } }
    scan_write_T(lds + B.kt, kd, cp, to); scan_write_T(lds + B.vt, vraw, cp, to);
}

template <bool RET>
__device__ __forceinline__ void scan_state_update(LAS unsigned char* lds, const ScanBufs& B, f32x4 (&ST)[8], int wave, int fr, int fq, float g64) {
    const int lp = st_lane(fr, fq);
    const bf16x8 a0 = ldfrag(lds + B.kt, wave, 0, 2, lp), a1 = ldfrag(lds + B.kt, wave, 1, 2, lp);
    f32x4 av = {g64, g64, g64, g64}, bv = {1.f, 1.f, 1.f, 1.f};
    if (!RET) { av = *(const LAS f32x4*)(lds + B.va + (16 * wave + 4 * fq) * 4); bv = *(const LAS f32x4*)(lds + B.vb + (16 * wave + 4 * fq) * 4); }
#pragma unroll
    for (int vi = 0; vi < 8; ++vi) { const bf16x8 b0 = ldfrag(lds + B.vt, vi, 0, 2, lp), b1 = ldfrag(lds + B.vt, vi, 1, 2, lp);
        f32x4 u = {0.f, 0.f, 0.f, 0.f}; u = MFMA16(a0, b0, u); u = MFMA16(a1, b1, u); ST[vi] = RET ? (av * ST[vi] + u) : (av * ST[vi] + bv * u); }
}

#define SCAN_LOAD_CHUNK(crow_, dir_) do { _Pragma("unroll") for (int tt = 0; tt < 8; ++tt) { const int rr_ = 8 * wave + tt; const size_t ro_ = (size_t)((crow_) + ((dir_) ? 63 - rr_ : rr_)) * INW + 2 * lane; \
        kraw[tt] = *(const unsigned*)(P + ro_ + colk); vraw[tt] = *(const unsigned*)(P + ro_ + colv); if (LOADQ) qraw[tt] = *(const unsigned*)(P + ro_ + colq); } } while (0)
#define SCAN_STORE_STATE(slot_) do { _Pragma("unroll") for (int vi = 0; vi < 8; ++vi) { u32x2 w; w.x = cvt_pk_bf16(ST[vi][0], ST[vi][1]); w.y = cvt_pk_bf16(ST[vi][2], ST[vi][3]); \
        *(u32x2*)(UB + (size_t)(slot_) * 16384 + (size_t)(vi * 512 + tid) * 4) = w; } } while (0)

struct ScanPtrs { const bf16_t* P; const bf16_t* SB; bf16_t* UB; float* AB; bf16_t* MIX; float* OB; const float* rdec; const float* onorm; };

__device__ __forceinline__ void scan1_hg_A(LAS unsigned char* lds, const ScanBufs& B, const unsigned (&kraw)[8], f32x2 (&c2)[8], int lane, int wave) {
    f32x2 r2 = {0.f, 0.f};
#pragma unroll
    for (int tt = 0; tt < 8; ++tt) { r2 += (f32x2){bf_lo(kraw[tt]), bf_hi(kraw[tt])}; c2[tt] = r2; }
    *(LAS f32x2*)(lds + B.part + (wave * 128 + 2 * lane) * 4) = r2;
}
__device__ __forceinline__ void scan1_hg_B(LAS unsigned char* lds, const ScanBufs& B, const unsigned (&kraw)[8], const unsigned (&vraw)[8], const f32x2 (&c2)[8], int lane, int wave, float& la_out, float& lb_out) {
    const int cp = lane, to = wave;
#ifndef SCAN_LOG2
    constexpr float LS = 1.4426950408889634f;
#else
    constexpr float LS = 1.0f;
#endif
    f32x2 p2 = {0.f, 0.f}, m2 = {0.f, 0.f}, l2 = {0.f, 0.f};
#pragma unroll
    for (int t8 = 0; t8 < 8; ++t8) { const f32x2 pp = *(const LAS f32x2*)(lds + B.part + (t8 * 128 + 2 * cp) * 4);
        if (t8 < to) p2 += pp; if (t8 < 4) m2 += pp; l2 += pp; }
    p2 = (p2 - m2) * LS;
    unsigned kd[8];
#pragma unroll
    for (int tt = 0; tt < 8; ++tt) {
        f32x2 d2 = p2 + c2[tt] * LS;
        d2 = __builtin_elementwise_min(__builtin_elementwise_max(d2, (f32x2){-120.f, -120.f}), (f32x2){120.f, 120.f});
        const f32x2 lf2 = (f32x2){bf_lo(kraw[tt]), bf_hi(kraw[tt])} * LS;
        const f32x2 k2 = (f32x2){1.0f, 1.0f} - (f32x2){__builtin_amdgcn_exp2f(lf2.x), __builtin_amdgcn_exp2f(lf2.y)};
        const f32x2 kt2 = k2 * (f32x2){__builtin_amdgcn_exp2f(-d2.x), __builtin_amdgcn_exp2f(-d2.y)};
        kd[tt] = cvt_pk_bf16(kt2.x, kt2.y); }
    scan_write_T(lds + B.kt, kd, cp, to); scan_write_T(lds + B.vt, vraw, cp, to);
    if (to == 0) { *(LAS f32x2*)(lds + B.va + 8 * cp) = (f32x2){ex2(l2.x), ex2(l2.y)}; *(LAS f32x2*)(lds + B.vb + 8 * cp) = (f32x2){ex2(l2.x - m2.x), ex2(l2.y - m2.y)}; }
    la_out = l2.x; lb_out = l2.y;
}
template <bool RET>
__device__ __forceinline__ void scan1_item(const ScanPtrs& sp, LAS unsigned char* lds, int tid, int lane, int wave, int seq, int tb) {
    const bf16_t* P = sp.P; bf16_t* UB = sp.UB; const int fr = lane & 15, fq = lane >> 4;
    const int b = seq >> 4, hh = (seq >> 1) & 7, dir = seq & 1, h = hh & 3;
    const int colk = RET ? 6 * 512 + h * 128 : (dir ? 2 * 512 : 512) + h * 128, colv = (RET ? 7 * 512 : 3 * 512) + h * 128;
    const float lg2 = RET ? -expf(sp.rdec[dir * 4 + h]) * LOG2E_ : 0.f, g64 = ex2(64.f * lg2);
    const int rowbase = b * LTOT + tb * 256;
    f32x4 ST[8];
#pragma unroll
    for (int vi = 0; vi < 8; ++vi) ST[vi] = (f32x4){0.f, 0.f, 0.f, 0.f};
    float ata = 0.f, atb = 0.f; unsigned kr[3][8], vr[3][8], qdummy[8]; f32x2 c2[2][8];
#pragma unroll
    for (int tt = 0; tt < 8; ++tt) qdummy[tt] = 0u;
#define S1_LOAD(set_, ci_) do { const int crow_ = rowbase + (dir ? 3 - (ci_) : (ci_)) * 64; _Pragma("unroll") for (int tt = 0; tt < 8; ++tt) { const int rr_ = 8 * wave + tt; const size_t ro_ = (size_t)(crow_ + (dir ? 63 - rr_ : rr_)) * INW + 2 * lane; \
        kr[set_][tt] = *(const unsigned*)(P + ro_ + colk); vr[set_][tt] = *(const unsigned*)(P + ro_ + colv); } } while (0)
#define S1_A(ci_) do { if (!RET) scan1_hg_A(lds, scan_bufs((ci_) & 1), kr[(ci_) % 3], c2[(ci_) & 1], lane, wave); } while (0)
#define S1_B(ci_) do { const ScanBufs B_ = scan_bufs((ci_) & 1); if (RET) scan_estage_ret<false>(lds, B_, kr[(ci_) % 3], qdummy, vr[(ci_) % 3], lane, wave, lg2); \
        else { float la_, lb_; scan1_hg_B(lds, B_, kr[(ci_) % 3], vr[(ci_) % 3], c2[(ci_) & 1], lane, wave, la_, lb_); ata += la_; atb += lb_; } } while (0)
#define S1_U(ci_) scan_state_update<RET>(lds, scan_bufs((ci_) & 1), ST, wave, fr, fq, g64)
    S1_LOAD(0, 0); S1_LOAD(1, 1); S1_LOAD(2, 2);
    S1_A(0);                         BAR_LDS();
    S1_B(0); S1_LOAD(0, 3); S1_A(1); BAR_LDS();
    S1_U(0); S1_B(1); S1_A(2);       BAR_LDS();
    S1_U(1); S1_B(2); S1_A(3);       BAR_LDS();
    S1_U(2); S1_B(3);                BAR_LDS();
    S1_U(3);
#undef S1_LOAD
#undef S1_A
#undef S1_B
#undef S1_U
    const int slot = seq * 65 + tb;
    SCAN_STORE_STATE(slot);
    if (wave == 0) *(f32x2*)(sp.AB + (size_t)slot * 128 + 2 * lane) = RET ? (f32x2){ex2(256.f * lg2), ex2(256.f * lg2)} : (f32x2){ex2(ata), ex2(atb)};
}

template <bool RET>
__device__ __forceinline__ void scan3_item(const ScanPtrs& sp, LAS unsigned char* lds, int tid, int lane, int wave, int bh, int tb, bool store_state) {
#ifdef PROBE_SKIP
    if ((PROBE_SKIP == 1 && RET) || (PROBE_SKIP == 2 && !RET)) return;
#endif
    const bf16_t* P = sp.P; bf16_t* UB = sp.UB; float* OB = sp.OB;
    const int ti = wave & 3, vh = wave >> 2; constexpr bool LOADQ = true;
    const int b = bh >> 3, hh = bh & 7, h = hh & 3;
    const int colq = (RET ? 5 * 512 : 0) + h * 128, colv = (RET ? 7 * 512 : 3 * 512) + h * 128, colg = (RET ? 8 * 512 : 4 * 512) + h * 128, mixcol = hh * 128;
    const int rowbase = b * LTOT + tb * 256;
#pragma unroll 1
    for (int dir = 1; dir >= 0; --dir) {
        const int colk = RET ? 6 * 512 + h * 128 : (dir ? 2 * 512 : 512) + h * 128;
        const float lg2 = RET ? -expf(sp.rdec[dir * 4 + h]) * LOG2E_ : 0.f, g64 = ex2(64.f * lg2);
        f32x4 ST[8];
        if (tb == 0) {
#pragma unroll
            for (int vi = 0; vi < 8; ++vi) ST[vi] = (f32x4){0.f, 0.f, 0.f, 0.f};
        } else { const size_t slot = (size_t)(bh * 2 + dir) * 65 + tb;
#pragma unroll
            for (int vi = 0; vi < 8; ++vi) { const u32x2 w = *(const u32x2*)(sp.SB + slot * 16384 + (size_t)(vi * 512 + tid) * 4); ST[vi] = (f32x4){bf_lo(w.x), bf_hi(w.x), bf_lo(w.y), bf_hi(w.y)}; } }
        float ata = 0.f, atb = 0.f; unsigned kraw[8], qraw[8], vraw[8];
        SCAN_LOAD_CHUNK(rowbase + (dir ? 3 : 0) * 64, dir);
#pragma unroll 1
        for (int ci = 0; ci < 4; ++ci) {
            const int tc = dir ? 3 - ci : ci;
            int lane_ = lane; asm volatile("" : "+v"(lane_));
            const int fr = lane_ & 15, fq = lane_ >> 4, t = 16 * ti + fr; const float gt1 = ex2((float)(t + 1) * lg2);
            const ScanBufs B0 = scan_bufs(0);
            if (RET) scan_estage_ret<true>(lds, B0, kraw, qraw, vraw, lane, wave, lg2);
            else { float la, lb; scan_estage_hg<true>(lds, B0, kraw, qraw, vraw, lane, wave, la, lb); ata += la; atb += lb; }
#ifdef PROBE_S3_E2
            BAR_LDS();
            if (RET) scan_estage_ret<true>(lds, B0, kraw, qraw, vraw, lane, wave, lg2);
            else { float la, lb; scan_estage_hg<true>(lds, B0, kraw, qraw, vraw, lane, wave, la, lb); }
#endif
            if (ci < 3) { const int tcn = dir ? 2 - ci : ci + 1; SCAN_LOAD_CHUNK(rowbase + tcn * 64, dir); }
            const int tok = tc * 64 + (dir ? 63 - t : t), grow = rowbase + tok;
            u32x2 obv[4]; u32x2 gv[4];
            if (dir == 0) {
#pragma unroll
                for (int j = 0; j < 4; ++j) { obv[j] = *((const u32x2*)OB + ((((tc * 4 + ti) * 2 + vh) * 4 + j) * 64 + fq * 16 + fr)); gv[j] = *(const u32x2*)(P + (size_t)grow * INW + colg + 16 * (4 * vh + j) + 4 * fq); } }
            if (!RET) BAR_LDS();
            { f32x4 em = {1.f, 1.f, 1.f, 1.f}; if (!RET) em = *(const LAS f32x4*)(lds + SC_VM + (16 * wave + 4 * fq) * 4);
#pragma unroll
              for (int vi = 0; vi < 8; ++vi) { const f32x4 x = RET ? ST[vi] : ST[vi] * em; u32x2 w; w.x = cvt_pk_bf16(x[0], x[1]); w.y = cvt_pk_bf16(x[2], x[3]); *(LAS u32x2*)(lds + SC_SM + st_off(16 * vi + fr, 32 * wave + 8 * fq, 4)) = w; } }
            if (RET) BAR_LDS();
#pragma unroll
            for (int sii = 0; sii < 2; ++sii) { const int si = 2 * vh + sii; f32x4 sc = {0.f, 0.f, 0.f, 0.f};
                if (si <= ti) {
#pragma unroll
                    for (int ks = 0; ks < 4; ++ks) sc = MFMA16(ldfrag(lds + SC_KI, si, ks, 4, st_lane(fr, fq)), ldfrag(lds + SC_QI, ti, ks, 4, st_lane(fr, fq)), sc);
                    const int s0 = 16 * si + 4 * fq;
#pragma unroll
                    for (int r = 0; r < 4; ++r) { const float dm = RET ? ex2((float)(t - s0 - r) * lg2) : 1.0f; sc[r] = (s0 + r <= t) ? sc[r] * dm : 0.f; } }
                u32x2 w; w.x = cvt_pk_bf16(sc[0], sc[1]); w.y = cvt_pk_bf16(sc[2], sc[3]); *(LAS u32x2*)(lds + SC_PI + st_off(t, 32 * si + 8 * fq, 2)) = w; }
            BAR_LDS();
            f32x4 o[4];
#pragma unroll
            for (int j = 0; j < 4; ++j) o[j] = (f32x4){0.f, 0.f, 0.f, 0.f};
            {
                const int lp = st_lane(fr, fq);
                const LAS unsigned char* pq = lds + SC_QI + (ti * 4) * 1024 + lp;
                const LAS unsigned char* pm = lds + SC_SM + (4 * vh * 4) * 1024 + lp;
                const LAS unsigned char* pp = lds + SC_PI + (ti * 2) * 1024 + lp;
                const LAS unsigned char* pv = lds + SC_VT + (4 * vh * 2) * 1024 + lp;
                const LAS unsigned char* pk = lds + SC_KT + (wave * 2) * 1024 + lp;
                const LAS unsigned char* pw = lds + SC_VT + lp;
                f32x4 av = {g64, g64, g64, g64}, bv = {1.f, 1.f, 1.f, 1.f};
                if (!RET) { av = *(const LAS f32x4*)(lds + SC_VA + (16 * wave + 4 * fq) * 4); bv = *(const LAS f32x4*)(lds + SC_VB + (16 * wave + 4 * fq) * 4); }
#define SC_LD(p_, off_) (*(const LAS bf16x8*)((p_) + (off_)))
#define SC_FENCE() __builtin_amdgcn_sched_barrier(0)
                bf16x8 qa, ma[4], qb, mb[4], qc, mc[4];
                qa = SC_LD(pq, 0); _Pragma("unroll") for (int j = 0; j < 4; ++j) ma[j] = SC_LD(pm, 4096 * j);
                qb = SC_LD(pq, 1024); _Pragma("unroll") for (int j = 0; j < 4; ++j) mb[j] = SC_LD(pm, 4096 * j + 1024);
                SC_FENCE();
                qc = SC_LD(pq, 2048); _Pragma("unroll") for (int j = 0; j < 4; ++j) mc[j] = SC_LD(pm, 4096 * j + 2048);
                _Pragma("unroll") for (int j = 0; j < 4; ++j) o[j] = MFMA16(ma[j], qa, o[j]);
                SC_FENCE();
                qa = SC_LD(pq, 3072); _Pragma("unroll") for (int j = 0; j < 4; ++j) ma[j] = SC_LD(pm, 4096 * j + 3072);
                _Pragma("unroll") for (int j = 0; j < 4; ++j) o[j] = MFMA16(mb[j], qb, o[j]);
                SC_FENCE();
                qb = SC_LD(pp, 0); _Pragma("unroll") for (int j = 0; j < 4; ++j) mb[j] = SC_LD(pv, 2048 * j);
                _Pragma("unroll") for (int j = 0; j < 4; ++j) o[j] = MFMA16(mc[j], qc, o[j]);
                SC_FENCE();
                qc = SC_LD(pp, 1024); _Pragma("unroll") for (int j = 0; j < 4; ++j) mc[j] = SC_LD(pv, 2048 * j + 1024);
                _Pragma("unroll") for (int j = 0; j < 4; ++j) o[j] = MFMA16(ma[j], qa, o[j]);
                SC_FENCE();
                if (RET) { _Pragma("unroll") for (int j = 0; j < 4; ++j) o[j] *= gt1; }
                bf16x8 k0 = SC_LD(pk, 0), k1 = SC_LD(pk, 1024), w0[4], w1[4];
                _Pragma("unroll") for (int q = 0; q < 2; ++q) { w0[q] = SC_LD(pw, 2048 * q); w1[q] = SC_LD(pw, 2048 * q + 1024); }
                _Pragma("unroll") for (int j = 0; j < 4; ++j) o[j] = MFMA16(mb[j], qb, o[j]);
                SC_FENCE();
                _Pragma("unroll") for (int q = 2; q < 4; ++q) { w0[q] = SC_LD(pw, 2048 * q); w1[q] = SC_LD(pw, 2048 * q + 1024); }
                _Pragma("unroll") for (int j = 0; j < 4; ++j) o[j] = MFMA16(mc[j], qc, o[j]);
                SC_FENCE();
                bf16x8 x0[4], x1[4];
                _Pragma("unroll") for (int q = 0; q < 4; ++q) { x0[q] = SC_LD(pw, 2048 * (4 + q)); x1[q] = SC_LD(pw, 2048 * (4 + q) + 1024); }
                _Pragma("unroll") for (int q = 0; q < 4; ++q) { f32x4 u = {0.f, 0.f, 0.f, 0.f}; u = MFMA16(k0, w0[q], u); u = MFMA16(k1, w1[q], u); ST[q] = RET ? (av * ST[q] + u) : (av * ST[q] + bv * u); }
                SC_FENCE();
                _Pragma("unroll") for (int q = 0; q < 4; ++q) { f32x4 u = {0.f, 0.f, 0.f, 0.f}; u = MFMA16(k0, x0[q], u); u = MFMA16(k1, x1[q], u); ST[4 + q] = RET ? (av * ST[4 + q] + u) : (av * ST[4 + q] + bv * u); }
#undef SC_LD
#undef SC_FENCE
            }
            if (dir == 1) {
#pragma unroll
                for (int j = 0; j < 4; ++j) { u32x2 w; w.x = cvt_pk_bf16(o[j][0], o[j][1]); w.y = cvt_pk_bf16(o[j][2], o[j][3]); *((u32x2*)OB + ((((tc * 4 + (3 - ti)) * 2 + vh) * 4 + j) * 64 + fq * 16 + (15 - fr))) = w; }
                BAR_LDS();
            } else {
                float ss = 0.f;
#pragma unroll
                for (int j = 0; j < 4; ++j) { o[j] += (f32x4){bf_lo(obv[j].x), bf_hi(obv[j].x), bf_lo(obv[j].y), bf_hi(obv[j].y)}; ss += (o[j][0] * o[j][0] + o[j][1] * o[j][1]) + (o[j][2] * o[j][2] + o[j][3] * o[j][3]); }
                ss += shx(ss, 16, lane_); ss += shx(ss, 32, lane_);
                if (fq == 0) *(LAS float*)(lds + SC_RED + ((ci & 1) * 128 + vh * 64 + t) * 4) = ss;
                BAR_LDS();
                const float tot = ss + *(const LAS float*)(lds + SC_RED + ((ci & 1) * 128 + (vh ^ 1) * 64 + t) * 4);
                const float rinv = __builtin_amdgcn_rsqf(tot * (1.0f / 128.0f) + EPS);
#pragma unroll
                for (int j = 0; j < 4; ++j) { const f32x4 onv = RET ? (f32x4){1.f, 1.f, 1.f, 1.f} : *(const f32x4*)(sp.onorm + 16 * (4 * vh + j) + 4 * fq);
                    const f32x4 y = o[j] * rinv * onv * (f32x4){bf_lo(gv[j].x), bf_hi(gv[j].x), bf_lo(gv[j].y), bf_hi(gv[j].y)};
                    u32x2 w; w.x = cvt_pk_bf16(y[0], y[1]); w.y = cvt_pk_bf16(y[2], y[3]); *(u32x2*)(sp.MIX + (size_t)grow * D + mixcol + 16 * (4 * vh + j) + 4 * fq) = w; }
#ifdef PROBE_BAR
                BAR_LDS();
#endif
            }
        }
        if (store_state) { const int slot = (bh * 2 + dir) * 65 + tb; SCAN_STORE_STATE(slot);
            if (wave == 0) *(f32x2*)(sp.AB + (size_t)slot * 128 + 2 * lane) = RET ? (f32x2){ex2(256.f * lg2), ex2(256.f * lg2)} : (f32x2){ex2(ata), ex2(atb)}; }
        BAR_ALL();
    }
}

__device__ __forceinline__ ScanPtrs scan_ptrs(const Ctx& a, int l) {
    unsigned char* ws = a.ws(); ScanPtrs sp; sp.P = (const bf16_t*)(ws + WS_P); sp.SB = (const bf16_t*)(ws + WS_SB); sp.UB = (bf16_t*)(ws + WS_UB); sp.AB = (float*)(ws + WS_AB); sp.MIX = (bf16_t*)(ws + WS_MIX);
    sp.OB = (float*)(ws + WS_OB) + (size_t)blockIdx.x * 16384; sp.rdec = a.in(I_RDEC) + l * 8; sp.onorm = a.in(I_ONORM) + l * 128; return sp;
}

__device__ __forceinline__ void scan1_phase(const Ctx& a, int l) {
    PHASE_IDS(); LAS unsigned char* lds = launder_lds(a.lds); const ScanPtrs sp = scan_ptrs(a, l);
#ifdef PROBE_NOMERGE
    const bool last = true; const int c = blockIdx.x, G = gridDim.x;
#else
    const bool last = (l == DEPTH - 1); const int c = blockIdx.x, G = gridDim.x;
#endif
    if (last || G < 32) {
        if (!last) for (int bh = c; bh < 16; bh += G) { if ((bh & 7) >= 4) scan3_item<true>(sp, lds, tid, lane, wave, bh, 0, true); else scan3_item<false>(sp, lds, tid, lane, wave, bh, 0, true); }
        for (int it = c; it < 2048; it += G) { const int seq = it >> 6, j = it & 63; if (!last && j == 0) continue; const int dir = seq & 1, tb = dir ? (j == 0 ? 0 : 65 - j) : j;
            if (((seq >> 1) & 7) >= 4) scan1_item<true>(sp, lds, tid, lane, wave, seq, tb); else scan1_item<false>(sp, lds, tid, lane, wave, seq, tb); }
        return;
    }
    if (c < 16) { if ((c & 7) >= 4) scan3_item<true>(sp, lds, tid, lane, wave, c, 0, true); else scan3_item<false>(sp, lds, tid, lane, wave, c, 0, true); }
    constexpr int HS = 7;
    for (int k = (c < 16 ? HS : 0);; ++k) {
        const int li = k < HS ? k * (G - 16) + (c - 16) : HS * (G - 16) + (k - HS) * G + c;
        if (li >= 2016) break;
        const int seq = li / 63, j = 1 + li % 63, dir = seq & 1, tb = dir ? 65 - j : j;
        if (((seq >> 1) & 7) >= 4) scan1_item<true>(sp, lds, tid, lane, wave, seq, tb); else scan1_item<false>(sp, lds, tid, lane, wave, seq, tb);
    }
}

__device__ __forceinline__ void scan2_phase(const Ctx& a) {
    PHASE_IDS(); unsigned char* ws = a.ws(); const bf16_t* UB = (const bf16_t*)(ws + WS_UB); bf16_t* SB = (bf16_t*)(ws + WS_SB); const float* AB = (const float*)(ws + WS_AB);
    const int c0 = 16 * (tid >> 6) + 4 * ((tid >> 4) & 3);
    for (int p = blockIdx.x; p < 256; p += gridDim.x) { const int seq = p >> 3, vi = p & 7, dir = seq & 1; const size_t eo = (size_t)(vi * 512 + tid) * 4;
        f32x4 s = {0.f, 0.f, 0.f, 0.f};
#define S2_SLOT(j_) ((size_t)seq * 65 + (dir ? ((j_) == 0 ? 0 : 65 - (j_)) : (j_)))
#define S2_LOAD(u_, av_, j0_) do { _Pragma("unroll") for (int q = 0; q < 8; ++q) { const size_t slot = S2_SLOT((j0_) + q); u_[q] = *(const u32x2*)(UB + slot * 16384 + eo); av_[q] = *(const f32x4*)(AB + slot * 128 + c0); } } while (0)
#define S2_STEP(u_, av_, j0_) do { _Pragma("unroll") for (int q = 0; q < 8; ++q) { const size_t slot = S2_SLOT((j0_) + q); \
            u32x2 w; w.x = cvt_pk_bf16(s[0], s[1]); w.y = cvt_pk_bf16(s[2], s[3]); *(u32x2*)(SB + slot * 16384 + eo) = w; \
            s = av_[q] * s + (f32x4){bf_lo(u_[q].x), bf_hi(u_[q].x), bf_lo(u_[q].y), bf_hi(u_[q].y)}; } } while (0)
        u32x2 ua[8], ub[8]; f32x4 aa[8], ab[8];
        S2_LOAD(ua, aa, 0);
#pragma unroll 1
        for (int j0 = 0; j0 < 64; j0 += 16) {
            S2_LOAD(ub, ab, j0 + 8);
            S2_STEP(ua, aa, j0);
            if (j0 + 16 < 64) S2_LOAD(ua, aa, j0 + 16);
            S2_STEP(ub, ab, j0 + 8); }
        { const size_t slot = (size_t)seq * 65 + (dir ? 1 : 64); u32x2 w; w.x = cvt_pk_bf16(s[0], s[1]); w.y = cvt_pk_bf16(s[2], s[3]); *(u32x2*)(SB + slot * 16384 + eo) = w; }
#undef S2_SLOT
#undef S2_LOAD
#undef S2_STEP
    }
}

__device__ __forceinline__ void scan3_phase(const Ctx& a, int l) {
    PHASE_IDS(); LAS unsigned char* lds = launder_lds(a.lds); const ScanPtrs sp = scan_ptrs(a, l);
#ifdef PROBE_NOMERGE
    if (l != DEPTH - 1) for (int bh = blockIdx.x; bh < 16; bh += gridDim.x) { if ((bh & 7) >= 4) scan3_item<true>(sp, lds, tid, lane, wave, bh, 0, false); else scan3_item<false>(sp, lds, tid, lane, wave, bh, 0, false); }
#endif
    for (int it = blockIdx.x; it < 1024; it += gridDim.x) { const int bh = it >> 6, tb = 1 + (it & 63);
        if ((bh & 7) >= 4) scan3_item<true>(sp, lds, tid, lane, wave, bh, tb, false); else scan3_item<false>(sp, lds, tid, lane, wave, bh, tb, false); }
}

struct OutOrder {
    static constexpr bool PADTILES = false;
    __device__ __forceinline__ bool half_rows(const pg8::Unit&) const { return false; }
    int nrt, skipctx, G, c;
    __device__ __forceinline__ bool next(int i, pg8::Unit& u) const {
        const int L = i * G + c; if (L >= nrt * 4) return false;
        const int r = L >> 2; u.pn = L & 3; u.pm = skipctx ? r + 1 + (r >= 64 ? 1 : 0) : r; return true;
    }
    __device__ __forceinline__ void a_ready(const pg8::Unit&) const {}
    __device__ __forceinline__ void done(const pg8::Unit&) const {}
};

#ifndef PH
#define PH 0xffff
#endif
#ifndef DBL
#define DBL 0
#endif
__global__ void __launch_bounds__(512, 2) mega_fwd(Args a) {
    extern __shared__ __attribute__((aligned(16))) unsigned char lds_raw[];
    LAS unsigned char* lds = (LAS unsigned char*)lds_raw;
    const int tid = threadIdx.x;
    const int G = gridDim.x; const int bx = blockIdx.x; const int vcu = (G % 8 == 0) ? (bx % 8) * (G / 8) + bx / 8 : bx;
    volatile LAS unsigned* MISC = (volatile LAS unsigned*)(lds + MISC_OFF);
    if (tid < 16) MISC[tid] = 0u;
    if (tid == 0) { LAS unsigned long long* pt = (LAS unsigned long long*)(lds + PTR_OFF);
#pragma unroll
        for (int i = 0; i < 18; ++i) pt[i] = (unsigned long long)a.in[i];
        pt[18] = (unsigned long long)a.out; pt[19] = (unsigned long long)a.ws; }
    __syncthreads();
    const Ctx cx{lds, __builtin_amdgcn_readfirstlane(tid >> 6)};
    XcdBarrier bar = xcd_barrier_post((unsigned*)(cx.ws() + WS_CTL) + 1024, MISC + 8);
#define GRID_BAR() do { XcdBarrier b2_ = bar; asm volatile("" : "+s"(b2_.x)); xcd_barrier(b2_); } while (0)

#if PH & 1
    p0_prologue(cx);
#endif
    GRID_BAR();
#if DBL & 1
    p0_prologue(cx);
    GRID_BAR();
#endif
#if PH & 1
    p0_finalize(cx);
#endif
    GRID_BAR();

#pragma unroll 1
    for (int l = 0; l < DEPTH; ++l) {
        const bool last = (l == DEPTH - 1); unsigned char* ws = cx.ws();
#ifdef PROBE_NOBG
        const bool bgc = false;
#else
        const bool bgc = (G == 256);
#endif

#if DBL & 64
        norm1_phase<2>(cx, l);
        GRID_BAR();
#endif
#if PH & 2
        norm1_phase<0>(cx, l);
#endif
        GRID_BAR();
#ifdef G1_SPLIT
        const int g1k = (bgc && bx >= 36) ? ((bx >> 3) % 5) : 0;
        if (g1k > 0) cvt_tail(cx, CVT_N0 + l * CVT_CYC, bx - 36, 4, 0, g1k);
#endif
#if PH & 4
        {
#ifdef G1_F8
            pg8::Gemm g{(const bf16_t*)(ws + WS_H), (const bf16_t*)(ws + WS_WIN + (size_t)l * INW * D), MROWS, INW, D, cx.w0};
            pg8::StaticOrder S; S.init(MROWS, INW, G, bx);
            pg8::EpiIn8 E{(bf16_t*)(ws + WS_P), (const float*)(ws + WS_LBS) + l * 512, (const float*)(ws + WS_ROPE)};
            pg8::gemm_phase_f8<pg8::EpiIn8, pg8::StaticOrder, false>(launder_lds(lds), g, S, E, nullptr);
#else
            pg8::Gemm g{(const bf16_t*)(ws + WS_H), (const bf16_t*)(ws + WS_WIN) + (size_t)l * INW * D, MROWS, INW, D, cx.w0};
            pg8::StaticOrder S; S.init(MROWS, INW, G, bx);
            pg8::EpiIn E{(bf16_t*)(ws + WS_P), (const float*)(ws + WS_LBS) + l * 512, (const float*)(ws + WS_ROPE)};
#ifdef STAGGER_G1
            { const unsigned long long t0_ = __builtin_amdgcn_s_memrealtime(); const unsigned long long d_ = (unsigned long long)((bx >> 3) & 3) * STAGGER_G1; while (__builtin_amdgcn_s_memrealtime() - t0_ < d_) __builtin_amdgcn_s_sleep(8); }
#endif
            pg8::gemm_phase<pg8::EpiIn, pg8::StaticOrder, true, true>(launder_lds(lds), g, S, E);
#endif
        }
#endif
#if DBL & 1024
        GRID_BAR();
        {
            pg8::Gemm g{(const bf16_t*)(ws + WS_H), (const bf16_t*)(ws + WS_WIN) + (size_t)l * INW * D, MROWS, INW, D, cx.w0};
            pg8::StaticOrder S; S.init(MROWS, INW, G, bx);
            pg8::EpiNull E{(float*)(ws + WS_OB)};
            pg8::gemm_phase<pg8::EpiNull, pg8::StaticOrder, true, true>(launder_lds(lds), g, S, E);
        }
#endif
#if DBL & 16384
        GRID_BAR();
        {
            pg8::Gemm g{(const bf16_t*)(ws + WS_H), (const bf16_t*)(ws + WS_WIN) + (size_t)l * INW * D, MROWS, INW, D, cx.w0};
            pg8::StaticOrder S; S.init(MROWS, INW, G, bx);
            pg8::EpiInT<true> E{(bf16_t*)(ws + WS_YS), (const float*)(ws + WS_LBS) + l * 512, (const float*)(ws + WS_ROPE)};
            pg8::gemm_phase<pg8::EpiInT<true>, pg8::StaticOrder, true, true>(launder_lds(lds), g, S, E);
        }
#endif
#if DBL & 128
        GRID_BAR();
        {
            pg8::Gemm g{(const bf16_t*)(ws + WS_H), (const bf16_t*)(ws + WS_WIN) + (size_t)l * INW * D, MROWS, INW, D, cx.w0};
            pg8::StaticOrder S; S.init(MROWS, INW, G, bx);
            pg8::EpiIn E{(bf16_t*)(ws + WS_P), (const float*)(ws + WS_LBS) + l * 512, (const float*)(ws + WS_ROPE)};
            pg8::gemm_phase<pg8::EpiIn, pg8::StaticOrder, true, true>(launder_lds(lds), g, S, E);
        }
#endif
#ifdef G1_SPLIT
        if (bgc && bx >= 36) cvt_tail(cx, CVT_N0 + l * CVT_CYC, bx - 36, 4, g1k, 4);
#else
        if (bgc && bx >= 36) cvt_tail<4>(cx, CVT_N0 + l * CVT_CYC, bx - 36);
#endif
#ifdef DBLCVT
        if (bgc && bx >= 36) cvt_tail<4>(cx, CVT_N0 + l * CVT_CYC, bx - 36);
#endif
        GRID_BAR();
#if DBL & 8192
#pragma unroll 1
        for (int xb = 0; xb < 10; ++xb) GRID_BAR();
#endif
#if PH & 8
        scan1_phase(cx, l);
#endif
        GRID_BAR();
#if PH & 16
        scan2_phase(cx);
#endif
        GRID_BAR();
#if PH & 32
        scan3_phase(cx, l);
#endif
        GRID_BAR();
#if DBL & 2
        scan1_phase(cx, l);
        GRID_BAR();
        scan2_phase(cx);
        GRID_BAR();
        scan3_phase(cx, l);
        GRID_BAR();
#endif
#if DBL & 8
        scan1_phase(cx, l);
        GRID_BAR();
#endif
#if DBL & 16
        scan2_phase(cx);
        GRID_BAR();
#endif
#if DBL & 32
        scan3_phase(cx, l);
        GRID_BAR();
#endif
#if PH & 64
        {
#ifdef G2_F8
            pg8::Gemm g{(const bf16_t*)(ws + WS_MIX), (const bf16_t*)(ws + WS_WOUT + (size_t)l * D * D), MROWS, D, D, cx.w0};
            OutOrder S{last ? 128 : 130, last ? 1 : 0, G, vcu};
            pg8::EpiOut8 E{(bf16_t*)(ws + WS_X), l == 0 ? cx.in(I_X) : nullptr, l == 0 ? cx.in(I_CTX) : nullptr, (const float*)(ws + WS_MODS) + (size_t)(l * 3) * 6144 + 2 * D};
            pg8::gemm_phase_f8<pg8::EpiOut8, OutOrder, false>(launder_lds(lds), g, S, E, nullptr);
#else
            pg8::Gemm g{(const bf16_t*)(ws + WS_MIX), (const bf16_t*)(ws + WS_WOUT) + (size_t)l * D * D, MROWS, D, D, cx.w0};
            OutOrder S{last ? 128 : 130, last ? 1 : 0, G, vcu};
            pg8::EpiOut E{(bf16_t*)(ws + WS_X), l == 0 ? cx.in(I_X) : nullptr, l == 0 ? cx.in(I_CTX) : nullptr, (const float*)(ws + WS_MODS) + (size_t)(l * 3) * 6144 + 2 * D};
            pg8::gemm_phase<pg8::EpiOut, OutOrder, true, true>(launder_lds(lds), g, S, E);
#endif
        }
#endif
        if (bgc && !last && vcu >= 8) cvt_tail<4>(cx, CVT_N0 + l * CVT_CYC + CVT_G1, vcu - 8);
#ifdef DBLCVT
        if (bgc && !last && vcu >= 8) cvt_tail<4>(cx, CVT_N0 + l * CVT_CYC + CVT_G1, vcu - 8);
#endif
        GRID_BAR();
#if PH & 128
        norm2_phase(cx, l);
#endif
        GRID_BAR();
#if DBL & 4
        norm2_phase(cx, l);
        GRID_BAR();
#endif
#if PH & 256
        topk_phase(cx, l);
#endif
        if (bgc && bx >= 64) cvt_tail<3>(cx, CVT_N0 + l * CVT_CYC + CVT_G1 + (last ? 0 : CVT_G2), bx - 64);
#ifdef DBLCVT
        if (bgc && bx >= 64) cvt_tail<3>(cx, CVT_N0 + l * CVT_CYC + CVT_G1 + (last ? 0 : CVT_G2), bx - 64);
#endif
        GRID_BAR();
#if DBL & 2048
        topk_phase(cx, l);
        GRID_BAR();
#endif
#if PH & 1024
        {
            pg8::Gemm g{(const bf16_t*)(ws + WS_H), (const bf16_t*)(ws + WS_WGU + (size_t)l * 65536 * D), MOE_ROWS, 65536, D, cx.w0};
            pg8::MoeOrder S{last ? 16 : 17, 16, G, vcu};
            pg8::EpiGU E{(unsigned char*)(ws + WS_HID)};
            pg8::gemm_phase_f8<pg8::EpiGU, pg8::MoeOrder, true>(launder_lds(lds), g, S, E, (const int*)(ws + WS_ROWMAP));
        }
#endif
#if DBL & 4096
        GRID_BAR();
        {
            pg8::Gemm g{(const bf16_t*)(ws + WS_H), (const bf16_t*)(ws + WS_WGU + (size_t)l * 65536 * D), MOE_ROWS, 65536, D, cx.w0};
            pg8::MoeOrder S{last ? 16 : 17, 16, G, vcu};
            pg8::EpiNull E{(float*)(ws + WS_OB)};
            pg8::gemm_phase_f8<pg8::EpiNull, pg8::MoeOrder, true>(launder_lds(lds), g, S, E, (const int*)(ws + WS_ROWMAP));
        }
#endif
#if DBL & 256
        GRID_BAR();
        {
            pg8::Gemm g{(const bf16_t*)(ws + WS_H), (const bf16_t*)(ws + WS_WGU + (size_t)l * 65536 * D), MOE_ROWS, 65536, D, cx.w0};
            pg8::MoeOrder S{last ? 16 : 17, 16, G, vcu};
            pg8::EpiGU E{(unsigned char*)(ws + WS_HID)};
            pg8::gemm_phase_f8<pg8::EpiGU, pg8::MoeOrder, true>(launder_lds(lds), g, S, E, (const int*)(ws + WS_ROWMAP));
        }
#endif
        GRID_BAR();
#if PH & 2048
        {
            pg8::Gemm g{(const bf16_t*)(ws + WS_HID), (const bf16_t*)(ws + WS_WD + (size_t)l * 16384 * FF), MOE_ROWS, 16384, FF, cx.w0};
            pg8::MoeOrder S{last ? 16 : 17, 4, G, vcu};
            pg8::EpiDown E{(unsigned char*)(ws + WS_YS)};
            pg8::gemm_phase_f8<pg8::EpiDown, pg8::MoeOrder, false>(launder_lds(lds), g, S, E, nullptr);
        }
#endif
#if DBL & 512
        GRID_BAR();
        {
            pg8::Gemm g{(const bf16_t*)(ws + WS_HID), (const bf16_t*)(ws + WS_WD + (size_t)l * 16384 * FF), MOE_ROWS, 16384, FF, cx.w0};
            pg8::MoeOrder S{last ? 16 : 17, 4, G, vcu};
            pg8::EpiDown E{(unsigned char*)(ws + WS_YS)};
            pg8::gemm_phase_f8<pg8::EpiDown, pg8::MoeOrder, false>(launder_lds(lds), g, S, E, nullptr);
        }
#endif
        if (bgc && !last && vcu >= 64) cvt_tail<4>(cx, CVT_N0 + l * CVT_CYC + CVT_G1 + CVT_G2 + CVT_T, vcu - 64);
#ifdef DBLCVT
        if (bgc && !last && vcu >= 64) cvt_tail<4>(cx, CVT_N0 + l * CVT_CYC + CVT_G1 + CVT_G2 + CVT_T, vcu - 64);
#endif
        GRID_BAR();
    }
#if PH & 4096
    norm1_phase<1>(cx, DEPTH);
#endif
}

extern "C" void kernel_launch(void* const* d_in, const int* in_sizes, int n_in, void* d_out, int out_size, void* d_ws, size_t ws_size, hipStream_t stream) {
    static int grid = 0;
    if (grid == 0) {
        if (n_in != 18 || out_size != NB * SEQ * D || ws_size < WS_END) { fprintf(stderr, "kernel_launch: unexpected problem shape (n_in %d, out %d, ws %zu)\n", n_in, out_size, ws_size); grid = -1; return; }
        int dev = 0, cus = 0, per_cu = 0;
        if (hipGetDevice(&dev) != hipSuccess || hipDeviceGetAttribute(&cus, hipDeviceAttributeMultiprocessorCount, dev) != hipSuccess) { grid = -1; return; }
        if (hipFuncSetAttribute((const void*)mega_fwd, hipFuncAttributeMaxDynamicSharedMemorySize, LDS_BYTES) != hipSuccess) { fprintf(stderr, "kernel_launch: hipFuncSetAttribute failed\n"); grid = -1; return; }
        if (hipOccupancyMaxActiveBlocksPerMultiprocessor(&per_cu, (const void*)mega_fwd, 512, LDS_BYTES) != hipSuccess || per_cu < 1) { fprintf(stderr, "kernel_launch: occupancy query reports %d workgroups per CU\n", per_cu); per_cu = 1; }
        (void)hipGetLastError();
        grid = cus;
    }
    if (grid < 0) return;
    (void)in_sizes;
    if (hipMemsetAsync((char*)d_ws + WS_CTL, 0, CTL_ZERO_BYTES, stream) != hipSuccess) return;
    Args a{};
    for (int i = 0; i < 18; ++i) a.in[i] = (const float*)d_in[i];
    a.out = (float*)d_out; a.ws = (unsigned char*)d_ws;
    hipLaunchKernelGGL(mega_fwd, dim3(grid), dim3(512), LDS_BYTES, stream, a);
}
```

```cpp
#define SCAN_PRIO 1
#include <hip/hip_runtime.h>
#include <cstdio>
#include <cstdint>

constexpr int D = 1024, NB = 2, SEQ = 16384, CTX = 256, LTOT = SEQ + CTX, MROWS = NB * LTOT;
constexpr int DEPTH = 4, INW = 4608, NE = 16, FF = 2048;
constexpr int CAP_LAT = 2048, CAP_CTX = 32;
constexpr int MOE_ROWS_E = 4352, MOE_ROWS = NE * MOE_ROWS_E;
constexpr int NSLOT = NB * 8 * 2 * 65;
constexpr float EPS = 1e-6f;

constexpr size_t MiB = 1u << 20;
constexpr size_t WS_CTL = 0, CTL_ZERO_BYTES = 64 * 1024;
constexpr size_t WS_MODP = 1 * MiB;
constexpr size_t WS_MODS = 4 * MiB;
constexpr size_t WS_LBS = 5 * MiB;
constexpr size_t WS_ROPE = 5 * MiB + 65536;
constexpr size_t WS_WIN = 8 * MiB;
constexpr size_t WS_WOUT = 44 * MiB;
constexpr size_t WS_WGU = 52 * MiB;
constexpr size_t WS_WD = 564 * MiB;
constexpr size_t WS_X = 820 * MiB;
constexpr size_t WS_H = 950 * MiB;
constexpr size_t WS_MIX = 1015 * MiB;
constexpr size_t WS_P = 1080 * MiB;
constexpr size_t WS_XS = 1080 * MiB;
constexpr size_t WS_HID = 1216 * MiB;
constexpr size_t WS_YS = 1488 * MiB;
constexpr size_t WS_UB = 1624 * MiB;
constexpr size_t WS_SB = 1689 * MiB;
constexpr size_t WS_AB = 1754 * MiB;
constexpr size_t WS_OB = 1756 * MiB;
constexpr size_t WS_AFF = 1788 * MiB;
constexpr size_t WS_ROWMAP = 1791 * MiB;
constexpr size_t WS_INV = 1792 * MiB;
constexpr size_t WS_END = 1800 * MiB;

constexpr int LDS_BYTES = 155648;
constexpr int MISC_OFF = LDS_BYTES - 64;
constexpr int PTR_OFF = LDS_BYTES - 256;

#define GAS __attribute__((address_space(1)))
#define LAS __attribute__((address_space(3)))
typedef float f32x2 __attribute__((ext_vector_type(2)));
typedef unsigned u32x2 __attribute__((ext_vector_type(2)));

__device__ __forceinline__ int lane_id() { int l; asm volatile("v_mbcnt_lo_u32_b32 %0, -1, 0\n\tv_mbcnt_hi_u32_b32 %0, -1, %0" : "=v"(l)); return l; }
__device__ __forceinline__ int opaque_tid(int w0) { int w = w0; asm volatile("" : "+s"(w)); int t = w * 64 + lane_id(); asm volatile("" : "+v"(t)); return t; }
__device__ __forceinline__ LAS unsigned char* launder_lds(LAS unsigned char* p) { unsigned v = (unsigned)(size_t)p; asm volatile("" : "+s"(v)); return (LAS unsigned char*)(size_t)v; }
__device__ __forceinline__ const float* ldptr(LAS unsigned char* lds0, int i) {
    LAS unsigned char* lds = launder_lds(lds0);
    const u32x2 v = *(volatile LAS u32x2*)(lds + PTR_OFF + 8 * i);
    const unsigned lo = __builtin_amdgcn_readfirstlane(v.x), hi = __builtin_amdgcn_readfirstlane(v.y);
    const GAS float* g = (const GAS float*)(((unsigned long long)hi << 32) | lo);
    return (const float*)g;
}
namespace pg8 {
#define PG8_LAS __attribute__((address_space(3)))
typedef unsigned short bf16_t;
typedef short bf16x8 __attribute__((ext_vector_type(8)));
typedef float f32x4 __attribute__((ext_vector_type(4)));
typedef unsigned u32x4 __attribute__((ext_vector_type(4)));
constexpr int BM = 256, BK = 64, HALF = 128, HTB = HALF * BK * 2  , STAGE_BYTES = 8 * HTB, NXCD = 8, WGM = 8;

__host__ __device__ __forceinline__ int lds_byte(int r, int c) { const int st = (r >> 4) * 2 + (c >> 5), rr = r & 15, cc = c & 31, ob = rr * 64 + cc * 2; return st * 1024 + (ob ^ (((ob >> 9) & 1) << 5)); }
__host__ __device__ __forceinline__ void stage_rc(int b, int& R, int& C) { const int st = b / 1024, sb = b % 1024, swz = sb ^ (((sb >> 9) & 1) << 5); R = (st >> 1) * 16 + swz / 64; C = (st & 1) * 32 + (swz % 64) / 2; }
__host__ __device__ __forceinline__ int perm32(int rho) { const int n = rho >> 4, i = rho & 15; return 8 * (i >> 2) + 4 * n + (i & 3); }

struct Unit { int pm, pn; };
struct Gemm { const bf16_t* A; const bf16_t* Bt; int M, N, K, w0; };

struct StaticOrder {
    static constexpr bool PADTILES = false;
    __device__ __forceinline__ bool half_rows(const Unit&) const { return false; }
    int nM, nN, nwg, G, c;
    __host__ __device__ void init(int M, int N, int G_, int c_) { nM = M / BM; nN = N / BM; nwg = nM * nN; G = G_; c = c_; }
    __host__ __device__ bool next(int i, Unit& u) const {
        const long L = (long)i * G + c; if (L >= nwg) return false;
        int wgid = (int)L; { const int q = nwg / NXCD, r = nwg % NXCD, xcd = wgid % NXCD, off = wgid / NXCD; wgid = (xcd < r ? xcd * (q + 1) : r * (q + 1) + (xcd - r) * q) + off; }
        const int nig = WGM * nN, gid = wgid / nig, fm = gid * WGM, gsz = (nM - fm) < WGM ? (nM - fm) : WGM;
        u.pm = fm + ((wgid % nig) % gsz); u.pn = (wgid % nig) / gsz; return true;
    }
    __device__ __forceinline__ void a_ready(const Unit&) const {}
    __device__ __forceinline__ void done(const Unit&) const {}
};
__device__ __forceinline__ unsigned cvt_pk_bf16(float lo, float hi) { unsigned r; asm volatile("v_cvt_pk_bf16_f32 %0, %1, %2" : "=v"(r) : "v"(lo), "v"(hi)); return r; }

struct MoeOrder {
    static constexpr bool PADTILES = true;
    __device__ __forceinline__ bool half_rows(const Unit& u) const { return (u.pm % 17) == 16; }
    int NT, NC, G, c;
    __device__ __forceinline__ bool next(int i, Unit& u) const {
        const int L = i * G + c, per = NT * NC; if (L >= 16 * per) return false;
        const int e = L / per, q = L - e * per;
        if (NC == 16 && q < 256) { u.pm = e * 17 + (q >> 6) * 4 + (q & 3); u.pn = e * NC + ((q >> 2) & 15); }
        else { u.pm = e * 17 + q / NC; u.pn = e * NC + q % NC; }
        return true;
    }
    __device__ __forceinline__ void a_ready(const Unit&) const {}
    __device__ __forceinline__ void done(const Unit&) const {}
};

__device__ __forceinline__ float fast_exp(float x) { return __builtin_amdgcn_exp2f(x * 1.4426950408889634f); }
__device__ __forceinline__ float fast_sigmoid(float x) { return __builtin_amdgcn_rcpf(1.0f + fast_exp(-x)); }

constexpr float F8_SA = 8.0f, F8_SW = 64.0f, F8_SH = 4.0f, F8_SY = 16.0f;
#ifdef P_NT
#define PSTORE(p_, v_) __builtin_nontemporal_store((v_), (p_))
#else
#define PSTORE(p_, v_) (*(p_) = (v_))
#endif
template <bool PLAIN, bool F8 = false>
struct EpiInT {
    static constexpr float ASC = F8 ? 1.0f / (F8_SA * F8_SW) : 1.0f;
    static constexpr bool PERM = true, AFTER_DRAIN = false;
    bf16_t* P; const float* lb; const float* cs;
    __device__ __forceinline__ void operator()(const f32x4 (&acc)[2][2][4][2], const Unit& u, int wr, int wc, int fr, int fq) const {
        const int grp = PLAIN ? 0 : (u.pn >> 1);
        const int row0 = u.pm * BM + wr * 64 + fr, col0 = u.pn * BM + wc * 32 + 8 * fq;
        if (grp == 0 || grp == 3 || grp == 7) {
#pragma unroll
            for (int ai = 0; ai < 2; ++ai)
#pragma unroll
                for (int m = 0; m < 4; ++m) { bf16_t* rowp = P + (size_t)(row0 + ai * HALF + m * 16) * INW + col0;
#pragma unroll
                    for (int bj = 0; bj < 2; ++bj) { const f32x4 v0 = acc[ai][bj][m][0] * ASC, v1 = acc[ai][bj][m][1] * ASC;
                        u32x4 w; w.x = cvt_pk_bf16(v0[0], v0[1]); w.y = cvt_pk_bf16(v0[2], v0[3]); w.z = cvt_pk_bf16(v1[0], v1[1]); w.w = cvt_pk_bf16(v1[2], v1[3]);
#ifdef PROBE_LINSTORE
                        if (PLAIN) {
#if PROBE_LINSTORE == 2
                            *((u32x4*)P + ((size_t)blockIdx.x * 8192 + (((wr * 4 + wc) * 16 + (ai * 4 + m) * 2 + bj) * 64 + fq * 16 + fr))) = w; continue;
#else
                            *((u32x4*)P + ((size_t)(u.pm * 18 + u.pn) * 8192 + (((wr * 4 + wc) * 16 + (ai * 4 + m) * 2 + bj) * 64 + fq * 16 + fr))) = w; continue;
#endif
                        }
#endif
                        PSTORE((u32x4*)(rowp + bj * HALF), w); } }
        } else if (grp == 1 || grp == 2) {
            const int cg = col0 - grp * 512;
            f32x4 lbv[2][2];
#pragma unroll
            for (int bj = 0; bj < 2; ++bj)
#pragma unroll
                for (int n = 0; n < 2; ++n) lbv[bj][n] = *(const f32x4*)(lb + cg + bj * HALF + 4 * n);
#pragma unroll
            for (int ai = 0; ai < 2; ++ai)
#pragma unroll
                for (int m = 0; m < 4; ++m) { bf16_t* rowp = P + (size_t)(row0 + ai * HALF + m * 16) * INW + col0;
#pragma unroll
                    for (int bj = 0; bj < 2; ++bj) { f32x4 v[2];
#pragma unroll
                        for (int n = 0; n < 2; ++n)
#pragma unroll
                            for (int h = 0; h < 2; ++h) { const f32x2 z = (f32x2){acc[ai][bj][m][n][2 * h], acc[ai][bj][m][n][2 * h + 1]} * ASC, l0 = {lbv[bj][n][2 * h], lbv[bj][n][2 * h + 1]};
                                const f32x2 x = z * (-1.4426950408889634f); const f32x2 d = (f32x2){__builtin_amdgcn_exp2f(x.x), __builtin_amdgcn_exp2f(x.y)} + 1.0f;
                                f32x2 f = l0 + ((f32x2){1.0f, 1.0f} - l0) * (f32x2){__builtin_amdgcn_rcpf(d.x), __builtin_amdgcn_rcpf(d.y)}; f = __builtin_elementwise_max(f, (f32x2){1e-30f, 1e-30f});
#ifndef SCAN_LOG2
                                const f32x2 r = (f32x2){__builtin_amdgcn_logf(f.x), __builtin_amdgcn_logf(f.y)} * 0.6931471805599453f;
#else
                                const f32x2 r = (f32x2){__builtin_amdgcn_logf(f.x), __builtin_amdgcn_logf(f.y)};
#endif
                                v[n][2 * h] = r.x; v[n][2 * h + 1] = r.y; }
                        u32x4 w; w.x = cvt_pk_bf16(v[0][0], v[0][1]); w.y = cvt_pk_bf16(v[0][2], v[0][3]); w.z = cvt_pk_bf16(v[1][0], v[1][1]); w.w = cvt_pk_bf16(v[1][2], v[1][3]);
                        PSTORE((u32x4*)(rowp + bj * HALF), w); } }
        } else if (grp == 4 || grp == 8) {
#pragma unroll
            for (int ai = 0; ai < 2; ++ai)
#pragma unroll
                for (int m = 0; m < 4; ++m) { bf16_t* rowp = P + (size_t)(row0 + ai * HALF + m * 16) * INW + col0;
#pragma unroll
                    for (int bj = 0; bj < 2; ++bj) { f32x4 v[2];
#pragma unroll
                        for (int n = 0; n < 2; ++n)
#pragma unroll
                            for (int h = 0; h < 2; ++h) { const f32x2 z = (f32x2){acc[ai][bj][m][n][2 * h], acc[ai][bj][m][n][2 * h + 1]} * ASC; const f32x2 x = z * (-1.4426950408889634f);
                                const f32x2 d = (f32x2){__builtin_amdgcn_exp2f(x.x), __builtin_amdgcn_exp2f(x.y)} + 1.0f; const f32x2 r = z * (f32x2){__builtin_amdgcn_rcpf(d.x), __builtin_amdgcn_rcpf(d.y)};
                                v[n][2 * h] = r.x; v[n][2 * h + 1] = r.y; }
                        u32x4 w; w.x = cvt_pk_bf16(v[0][0], v[0][1]); w.y = cvt_pk_bf16(v[0][2], v[0][3]); w.z = cvt_pk_bf16(v[1][0], v[1][1]); w.w = cvt_pk_bf16(v[1][2], v[1][3]);
                        PSTORE((u32x4*)(rowp + bj * HALF), w); } }
        } else {
            const float sc = ((grp == 6) ? 0.08838834764831845f : 1.0f) * ASC;
            const int f0 = 16 * (wc & 1) + 4 * fq;
#pragma unroll
            for (int ai = 0; ai < 2; ++ai)
#pragma unroll
                for (int m = 0; m < 4; ++m) { const int row = row0 + ai * HALF + m * 16; bf16_t* rowp = P + (size_t)row * INW + col0;
                    int g = row; if (g >= LTOT) g -= LTOT;
                    int pos = 0; if (g >= CTX) { const int nn = g - CTX; pos = (wc < 2) ? (nn >> 6) : (nn & 63); }
                    const f32x4 t0 = *(const f32x4*)(cs + (size_t)(pos * 32 + f0) * 2), t1 = *(const f32x4*)(cs + (size_t)(pos * 32 + f0) * 2 + 4);
#pragma unroll
                    for (int bj = 0; bj < 2; ++bj) { const f32x4 v0 = acc[ai][bj][m][0] * sc, v1 = acc[ai][bj][m][1] * sc;
                        const float a0 = v0[0] * t0[0] - v0[1] * t0[1], a1 = v0[0] * t0[1] + v0[1] * t0[0];
                        const float a2 = v0[2] * t0[2] - v0[3] * t0[3], a3 = v0[2] * t0[3] + v0[3] * t0[2];
                        const float b0 = v1[0] * t1[0] - v1[1] * t1[1], b1 = v1[0] * t1[1] + v1[1] * t1[0];
                        const float b2 = v1[2] * t1[2] - v1[3] * t1[3], b3 = v1[2] * t1[3] + v1[3] * t1[2];
                        u32x4 w; w.x = cvt_pk_bf16(a0, a1); w.y = cvt_pk_bf16(a2, a3); w.z = cvt_pk_bf16(b0, b1); w.w = cvt_pk_bf16(b2, b3);
                        PSTORE((u32x4*)(rowp + bj * HALF), w); } }
        }
    }
};

using EpiIn = EpiInT<false>;
using EpiIn8 = EpiInT<false, true>;

struct EpiNull { static constexpr bool PERM = true, AFTER_DRAIN = false; float* sink;
    __device__ __forceinline__ void operator()(const f32x4 (&acc)[2][2][4][2], const Unit& u, int wr, int wc, int fr, int fq) const { f32x4 s = acc[0][0][0][0]; _Pragma("unroll") for (int a = 0; a < 2; ++a) _Pragma("unroll") for (int b = 0; b < 2; ++b) _Pragma("unroll") for (int m = 0; m < 4; ++m) _Pragma("unroll") for (int n = 0; n < 2; ++n) s += acc[a][b][m][n]; if (s[0] == 123.456f && u.pm < 0) sink[fr + fq + wr + wc] = s[1]; } };

template <bool F8>
struct EpiOutT {
    static constexpr bool PERM = true, AFTER_DRAIN = false; static constexpr float ASC = F8 ? 1.0f / (F8_SA * F8_SW) : 1.0f;
    bf16_t* X; const float* xin; const float* cin; const float* gt;
    __device__ __forceinline__ void operator()(const f32x4 (&acc)[2][2][4][2], const Unit& u, int wr, int wc, int fr, int fq) const {
        const int b = u.pm / 65, tb = u.pm - b * 65, which = (tb == 0) ? 2 : b;
        const int row0 = u.pm * BM + wr * 64 + fr, col0 = u.pn * BM + wc * 32 + 8 * fq;
        f32x4 gv[2][2];
#pragma unroll
        for (int bj = 0; bj < 2; ++bj)
#pragma unroll
            for (int n = 0; n < 2; ++n) gv[bj][n] = *(const f32x4*)(gt + which * 6144 + col0 + bj * HALF + 4 * n) * ASC;
#pragma unroll
        for (int ai = 0; ai < 2; ++ai)
#pragma unroll
            for (int m = 0; m < 4; ++m) { const int row = row0 + ai * HALF + m * 16; bf16_t* op = X + (size_t)row * D + col0;
#pragma unroll
                for (int bj = 0; bj < 2; ++bj) { f32x4 b0, b1;
                    if (xin) { const int g = row - b * LTOT; const float* bp = (g < CTX ? cin + (size_t)(b * CTX + g) * D : xin + (size_t)(b * SEQ + g - CTX) * D) + col0 + bj * HALF; b0 = *(const f32x4*)bp; b1 = *(const f32x4*)(bp + 4); }
                    else { const u32x4 w = *(const u32x4*)(op + bj * HALF); b0 = (f32x4){__uint_as_float(w.x << 16), __uint_as_float(w.x & 0xffff0000u), __uint_as_float(w.y << 16), __uint_as_float(w.y & 0xffff0000u)};
                        b1 = (f32x4){__uint_as_float(w.z << 16), __uint_as_float(w.z & 0xffff0000u), __uint_as_float(w.w << 16), __uint_as_float(w.w & 0xffff0000u)}; }
                    const f32x4 v0 = b0 + gv[bj][0] * acc[ai][bj][m][0], v1 = b1 + gv[bj][1] * acc[ai][bj][m][1];
                    u32x4 o; o.x = cvt_pk_bf16(v0[0], v0[1]); o.y = cvt_pk_bf16(v0[2], v0[3]); o.z = cvt_pk_bf16(v1[0], v1[1]); o.w = cvt_pk_bf16(v1[2], v1[3]);
                    *(u32x4*)(op + bj * HALF) = o; }
                if (F8) __builtin_amdgcn_sched_barrier(0); }
    }
};

using EpiOut = EpiOutT<false>;
using EpiOut8 = EpiOutT<true>;

__device__ __forceinline__ unsigned pk4_fp8(float a, float b, float c, float d) {
    a = __builtin_amdgcn_fmed3f(a, -448.f, 448.f); b = __builtin_amdgcn_fmed3f(b, -448.f, 448.f); c = __builtin_amdgcn_fmed3f(c, -448.f, 448.f); d = __builtin_amdgcn_fmed3f(d, -448.f, 448.f);
    unsigned w = 0; w = __builtin_amdgcn_cvt_pk_fp8_f32(a, b, w, false); w = __builtin_amdgcn_cvt_pk_fp8_f32(c, d, w, true); return w; }
struct EpiGU {
    static constexpr bool PERM = true, AFTER_DRAIN = false;
    unsigned char* HID;
    __device__ __forceinline__ void operator()(const f32x4 (&acc)[2][2][4][2], const Unit& u, int wr, int wc, int fr, int fq) const {
        const int row0 = u.pm * BM + wr * 64 + fr, col0 = (u.pn & 15) * HALF + wc * 32 + 8 * fq;
        constexpr float inv = 1.0f / (F8_SA * F8_SW);
#pragma unroll
        for (int ai = 0; ai < 2; ++ai)
#pragma unroll
            for (int m = 0; m < 4; ++m) { unsigned char* rowp = HID + (size_t)(row0 + ai * HALF + m * 16) * FF + col0; f32x4 v[2];
#pragma unroll
                for (int n = 0; n < 2; ++n)
#pragma unroll
                    for (int h = 0; h < 2; ++h) {
                        const f32x2 a0 = {acc[ai][0][m][n][2 * h], acc[ai][0][m][n][2 * h + 1]}, a1 = {acc[ai][1][m][n][2 * h], acc[ai][1][m][n][2 * h + 1]};
                        const f32x2 x = a0 * (-inv * 1.4426950408889634f); const f32x2 d = (f32x2){__builtin_amdgcn_exp2f(x.x), __builtin_amdgcn_exp2f(x.y)} + 1.0f;
                        const f32x2 r = (a0 * a1) * (inv * inv * F8_SH) * (f32x2){__builtin_amdgcn_rcpf(d.x), __builtin_amdgcn_rcpf(d.y)};
                        v[n][2 * h] = r.x; v[n][2 * h + 1] = r.y; }
                u32x2 w; w.x = pk4_fp8(v[0][0], v[0][1], v[0][2], v[0][3]); w.y = pk4_fp8(v[1][0], v[1][1], v[1][2], v[1][3]);
                *(u32x2*)rowp = w; }
    }
};

struct EpiDown {
    static constexpr bool PERM = true, AFTER_DRAIN = false;
    unsigned char* YS;
    __device__ __forceinline__ void operator()(const f32x4 (&acc)[2][2][4][2], const Unit& u, int wr, int wc, int fr, int fq) const {
        const int row0 = u.pm * BM + wr * 64 + fr, col0 = (u.pn & 3) * BM + wc * 32 + 8 * fq;
        constexpr float gg = F8_SY / (F8_SH * F8_SW);
#pragma unroll
        for (int ai = 0; ai < 2; ++ai)
#pragma unroll
            for (int m = 0; m < 4; ++m) { unsigned char* rowp = YS + (size_t)(row0 + ai * HALF + m * 16) * D + col0;
#pragma unroll
                for (int bj = 0; bj < 2; ++bj) { const f32x4 v0 = acc[ai][bj][m][0] * gg, v1 = acc[ai][bj][m][1] * gg;
                    u32x2 w; w.x = pk4_fp8(v0[0], v0[1], v0[2], v0[3]); w.y = pk4_fp8(v1[0], v1[1], v1[2], v1[3]);
                    *(u32x2*)(rowp + bj * HALF) = w; } }
    }
};

typedef int i32x4v __attribute__((ext_vector_type(4)));
typedef int i32x8v __attribute__((ext_vector_type(8)));
__device__ __forceinline__ i32x8v cat8(bf16x8 lo, bf16x8 hi) { const i32x4v a = __builtin_bit_cast(i32x4v, lo), b = __builtin_bit_cast(i32x4v, hi); return __builtin_shufflevector(a, b, 0, 1, 2, 3, 4, 5, 6, 7); }
template <class Epi, class Sched, bool GATHER>
__device__ __forceinline__ void gemm_phase_f8(PG8_LAS unsigned char* lds, const Gemm g, const Sched& S, const Epi& E, const int* rowmap) {
    const int tid = opaque_tid(g.w0), wid = __builtin_amdgcn_readfirstlane(tid >> 6), lane = tid & 63, wr = wid >> 2, wc = wid & 3, fr = lane & 15, fq = lane >> 4;
    const int rowb = g.K, nt = rowb / 128;
    unsigned vA0[2], vA1[2], voffB[2];
#pragma unroll
    for (int i = 0; i < 2; ++i) { int R, C; stage_rc(tid * 16 + i * 8192, R, C); const int Rb = Epi::PERM ? ((R & ~31) + perm32(R & 31)) : R;
        voffB[i] = (unsigned)(Rb * rowb + 2 * C); vA0[i] = (unsigned)(R * rowb + 2 * C); vA1[i] = vA0[i]; }
    const size_t kstep = 128;
    const size_t hstep = (size_t)HALF * rowb;
    const size_t tstep = 2 * hstep;
    const unsigned ldsw = (unsigned)wid * 1024u;
    const int aoff = lds_byte(wr * 64 + fr, fq * 8), boff = lds_byte(wc * 32 + fr, fq * 8);
    constexpr int GOFF = STAGE_BYTES;
#define PG8_SA(b, h) (((b) * 2 + (h)) * HTB)
#define PG8_SB(b, h) ((4 + (b) * 2 + (h)) * HTB)
#define PG8_STAGE(bufoff, gbase, voff) do { _Pragma("unroll") for (int _i = 0; _i < 2; ++_i) { unsigned _o = (voff)[_i]; asm volatile("" : "+v"(_o)); \
        __builtin_amdgcn_global_load_lds((const unsigned*)((const char*)(gbase) + _o), (PG8_LAS unsigned*)(lds + (bufoff) + ldsw + _i * 8192), 16, 0, 0); } } while (0)
#define PG8_STAGE_A(bufoff, kbase, h) do { if constexpr (GATHER) { if (h) PG8_STAGE(bufoff, kbase, vA1); else PG8_STAGE(bufoff, kbase, vA0); } else PG8_STAGE(bufoff, (kbase) + (h) * hstep, vA0); } while (0)
#define PG8_GIDX_ISSUE(pm_) do { const int _t = opaque_tid(g.w0); _Pragma("unroll") for (int _i = 0; _i < 2; ++_i) { int R, C; stage_rc(_t * 16 + _i * 8192, R, C); _Pragma("unroll") for (int _h = 0; _h < 2; ++_h) \
        __builtin_amdgcn_global_load_lds((const unsigned*)(rowmap + (pm_) * BM + _h * HALF + R), (PG8_LAS unsigned*)(lds + GOFF + ldsw + (_h * 2 + _i) * 256), 4, 0, 0); } } while (0)
#define PG8_GIDX_TAKE() do { const int _t = opaque_tid(g.w0); _Pragma("unroll") for (int _i = 0; _i < 2; ++_i) { int R, C; stage_rc(_t * 16 + _i * 8192, R, C); \
        vA0[_i] = *(const PG8_LAS unsigned*)(lds + GOFF + ldsw + (0 * 2 + _i) * 256 + (_t & 63) * 4) * (unsigned)rowb + (unsigned)(2 * C); \
        vA1[_i] = *(const PG8_LAS unsigned*)(lds + GOFF + ldsw + (1 * 2 + _i) * 256 + (_t & 63) * 4) * (unsigned)rowb + (unsigned)(2 * C); } } while (0)
#define PG8_LDA(dst, b, h) do { _Pragma("unroll") for (int m = 0; m < 4; ++m) _Pragma("unroll") for (int k = 0; k < 2; ++k) dst[m][k] = *(const PG8_LAS bf16x8*)(lds + PG8_SA(b, h) + aoff + m * 2048 + k * 1024); } while (0)
#define PG8_LDB(dst, b, h) do { _Pragma("unroll") for (int n = 0; n < 2; ++n) _Pragma("unroll") for (int k = 0; k < 2; ++k) dst[n][k] = *(const PG8_LAS bf16x8*)(lds + PG8_SB(b, h) + boff + n * 2048 + k * 1024); } while (0)
#define PG8_MMA(ai, bj, At, Bt) do { __builtin_amdgcn_s_setprio(1); _Pragma("unroll") for (int m = 0; m < 4; ++m) _Pragma("unroll") for (int n = 0; n < 2; ++n) \
        acc[ai][bj][m][n] = __builtin_amdgcn_mfma_scale_f32_16x16x128_f8f6f4(cat8(Bt[n][0], Bt[n][1]), cat8(At[m][0], At[m][1]), acc[ai][bj][m][n], 0, 0, 0, 0, 0, 0); __builtin_amdgcn_s_setprio(0); } while (0)
#define PG8_WAIT_V(n) asm volatile("s_waitcnt vmcnt(" #n ")" ::: "memory")
#define PG8_WAIT_L(n) asm volatile("s_waitcnt lgkmcnt(" #n ")" ::: "memory")
#define PG8_BAR __builtin_amdgcn_s_barrier()
#define PG8_SCHED __builtin_amdgcn_sched_barrier(0)
    Unit cur, nxt; int ui = 0;
    if (!S.next(0, cur)) return;
    bool half = Sched::PADTILES && S.half_rows(cur);
    f32x4 acc[2][2][4][2];
#pragma unroll
    for (int a = 0; a < 2; ++a)
#pragma unroll
        for (int b = 0; b < 2; ++b)
#pragma unroll
            for (int m = 0; m < 4; ++m)
#pragma unroll
                for (int n = 0; n < 2; ++n) acc[a][b][m][n] = (f32x4){0.f, 0.f, 0.f, 0.f};
    bf16x8 At[4][2], B0[2][2], B1[2][2];
    const char* cA; const char* cB = (const char*)g.Bt + (size_t)cur.pn * tstep;
    if constexpr (GATHER) { cA = (const char*)g.A; PG8_GIDX_ISSUE(cur.pm); PG8_WAIT_V(0); PG8_GIDX_TAKE(); }
    else cA = (const char*)g.A + (size_t)cur.pm * tstep;
    PG8_STAGE(PG8_SB(0, 0), cB, voffB); PG8_STAGE(PG8_SB(0, 1), cB + hstep, voffB); PG8_STAGE_A(PG8_SA(0, 0), cA, 0); PG8_STAGE_A(PG8_SA(0, 1), cA, 1);
    if (wr == 1) PG8_BAR;
    PG8_WAIT_V(2); PG8_BAR;
    PG8_STAGE(PG8_SB(1, 0), cB + kstep, voffB); PG8_STAGE_A(PG8_SA(1, 0), cA + kstep, 0); PG8_STAGE(PG8_SB(1, 1), cB + hstep + kstep, voffB);
    PG8_WAIT_V(6); PG8_BAR;
    for (;;) {
        const bool has_next = S.next(ui + 1, nxt);
        const char* nA; const char* nB = has_next ? (const char*)g.Bt + (size_t)nxt.pn * tstep : cB;
        if constexpr (GATHER) { nA = cA; if (has_next) PG8_GIDX_ISSUE(nxt.pm); }
        else nA = has_next ? (const char*)g.A + (size_t)nxt.pm * tstep : cA;
#pragma unroll 1
        for (int t = 0; t < nt; t += 2) {
            const bool last = (t == nt - 2);
            const char* a1 = cA + (size_t)(t + 1) * kstep;
            const char* a2 = last ? nA : cA + (size_t)(t + 2) * kstep; const char* b2 = last ? nB : cB + (size_t)(t + 2) * kstep;
            const char* a3 = a2 + kstep; const char* b3 = b2 + kstep;
            PG8_LDB(B0, 0, 0); PG8_LDB(B1, 0, 1); PG8_SCHED; PG8_LDA(At, 0, 0); PG8_STAGE_A(PG8_SA(1, 1), a1, 1);
            if constexpr (GATHER) { if (last && has_next) PG8_GIDX_TAKE(); }
            PG8_WAIT_V(8); PG8_WAIT_L(0); PG8_BAR; if (!(half && wr == 1)) { PG8_MMA(0, 0, At, B0); PG8_MMA(0, 1, At, B1); } PG8_BAR; PG8_SCHED;
            PG8_LDA(At, 0, 1); PG8_STAGE(PG8_SB(0, 0), b2, voffB); PG8_STAGE(PG8_SB(0, 1), b2 + hstep, voffB); PG8_STAGE_A(PG8_SA(0, 0), a2, 0);
            PG8_WAIT_V(8); PG8_WAIT_L(0); PG8_BAR; if (!half) { PG8_MMA(1, 0, At, B0); PG8_MMA(1, 1, At, B1); } PG8_BAR; PG8_SCHED;
            PG8_LDB(B0, 1, 0); PG8_LDB(B1, 1, 1); PG8_SCHED; PG8_LDA(At, 1, 0); PG8_STAGE_A(PG8_SA(0, 1), a2, 1);
            PG8_WAIT_V(8); PG8_WAIT_L(0); PG8_BAR; if (!(half && wr == 1)) { PG8_MMA(0, 0, At, B0); PG8_MMA(0, 1, At, B1); } PG8_BAR; PG8_SCHED;
            PG8_LDA(At, 1, 1); PG8_STAGE(PG8_SB(1, 0), b3, voffB); PG8_STAGE(PG8_SB(1, 1), b3 + hstep, voffB); PG8_STAGE_A(PG8_SA(1, 0), a3, 0);
            PG8_WAIT_V(8); PG8_WAIT_L(0); PG8_BAR; if (!half) { PG8_MMA(1, 0, At, B0); PG8_MMA(1, 1, At, B1); } PG8_BAR; PG8_SCHED;
        }
        if (wr == 0) PG8_BAR;
        { const int l2_ = opaque_tid(g.w0) & 63; E(acc, cur, wr, wc, l2_ & 15, l2_ >> 4); }
#ifdef G2_F8
        { const int t2_ = opaque_tid(g.w0);
#pragma unroll
          for (int i = 0; i < 2; ++i) { int R, C; stage_rc(t2_ * 16 + i * 8192, R, C); const int Rb = Epi::PERM ? ((R & ~31) + perm32(R & 31)) : R;
              voffB[i] = (unsigned)(Rb * rowb + 2 * C); if constexpr (!GATHER) { vA0[i] = (unsigned)(R * rowb + 2 * C); vA1[i] = vA0[i]; } } }
#endif
        if (!has_next) break;
#pragma unroll
        for (int a = 0; a < 2; ++a)
#pragma unroll
            for (int b = 0; b < 2; ++b)
#pragma unroll
                for (int m = 0; m < 4; ++m)
#pragma unroll
                    for (int n = 0; n < 2; ++n) acc[a][b][m][n] = (f32x4){0.f, 0.f, 0.f, 0.f};
        cur = nxt; cA = nA; cB = nB; ++ui; half = Sched::PADTILES && S.half_rows(cur);
        if (wr == 1) PG8_BAR;
    }
    PG8_WAIT_V(0);
    PG8_BAR;
#undef PG8_SA
#undef PG8_SB
#undef PG8_STAGE
#undef PG8_STAGE_A
#undef PG8_GIDX_ISSUE
#undef PG8_GIDX_TAKE
#undef PG8_LDA
#undef PG8_LDB
#undef PG8_MMA
#undef PG8_WAIT_V
#undef PG8_WAIT_L
#undef PG8_BAR
#undef PG8_SCHED
}
template <class Epi, class Sched, bool ALIGN_EPI = false, bool SP2 = false>
__device__ __forceinline__ void gemm_phase(PG8_LAS unsigned char* lds, const Gemm g, const Sched& S, const Epi& E) {
    const int tid = opaque_tid(g.w0), wid = __builtin_amdgcn_readfirstlane(tid >> 6), lane = tid & 63, wr = wid >> 2, wc = wid & 3, fr = lane & 15, fq = lane >> 4;
    const int K = g.K, nt = K / BK;
    unsigned voffA[2], voffB[2];
#pragma unroll
    for (int i = 0; i < 2; ++i) { int R, C; stage_rc(tid * 16 + i * 8192, R, C); const int Rb = Epi::PERM ? ((R & ~31) + perm32(R & 31)) : R;
        voffA[i] = (unsigned)(R * K + C) * 2u; voffB[i] = (unsigned)(Rb * K + C) * 2u; }
    const size_t kstep = (size_t)(BK * 2);
    const size_t hstep = (size_t)HALF * K * 2;
    const size_t tstep = 2 * hstep;
    const unsigned ldsw = (unsigned)wid * 1024u;
    const int aoff = lds_byte(wr * 64 + fr, fq * 8), boff = lds_byte(wc * 32 + fr, fq * 8);
#define PG8_SA(b, h) (((b) * 2 + (h)) * HTB)
#define PG8_SB(b, h) ((4 + (b) * 2 + (h)) * HTB)
#define PG8_STAGE(bufoff, gbase, voff) do { _Pragma("unroll") for (int _i = 0; _i < 2; ++_i) \
        __builtin_amdgcn_global_load_lds((const unsigned*)((const char*)(gbase) + (voff)[_i]), (PG8_LAS unsigned*)(lds + (bufoff) + ldsw + _i * 8192), 16, 0, 0); } while (0)
#define PG8_LDA(dst, b, h) do { _Pragma("unroll") for (int m = 0; m < 4; ++m) _Pragma("unroll") for (int k = 0; k < 2; ++k) dst[m][k] = *(const PG8_LAS bf16x8*)(lds + PG8_SA(b, h) + aoff + m * 2048 + k * 1024); } while (0)
#define PG8_LDB(dst, b, h) do { _Pragma("unroll") for (int n = 0; n < 2; ++n) _Pragma("unroll") for (int k = 0; k < 2; ++k) dst[n][k] = *(const PG8_LAS bf16x8*)(lds + PG8_SB(b, h) + boff + n * 2048 + k * 1024); } while (0)
#define PG8_MMA(ai, bj, At, Bt) do { __builtin_amdgcn_s_setprio(1); _Pragma("unroll") for (int m = 0; m < 4; ++m) _Pragma("unroll") for (int n = 0; n < 2; ++n) _Pragma("unroll") for (int k = 0; k < 2; ++k) \
        acc[ai][bj][m][n] = __builtin_amdgcn_mfma_f32_16x16x32_bf16(Bt[n][k], At[m][k], acc[ai][bj][m][n], 0, 0, 0); __builtin_amdgcn_s_setprio(0); } while (0)
#define PG8_WAIT_V(n) asm volatile("s_waitcnt vmcnt(" #n ")" ::: "memory")
#define PG8_WAIT_L(n) asm volatile("s_waitcnt lgkmcnt(" #n ")" ::: "memory")
#define PG8_BAR __builtin_amdgcn_s_barrier()
#define PG8_SCHED __builtin_amdgcn_sched_barrier(0)
    Unit cur, nxt; int ui = 0;
    if (!S.next(0, cur)) return;
    f32x4 acc[2][2][4][2];
#pragma unroll
    for (int a = 0; a < 2; ++a)
#pragma unroll
        for (int b = 0; b < 2; ++b)
#pragma unroll
            for (int m = 0; m < 4; ++m)
#pragma unroll
                for (int n = 0; n < 2; ++n) acc[a][b][m][n] = (f32x4){0.f, 0.f, 0.f, 0.f};
    bf16x8 At[4][2], B0[2][2], B1[2][2];
    const char* cA = (const char*)g.A + (size_t)cur.pm * tstep; const char* cB = (const char*)g.Bt + (size_t)cur.pn * tstep;
    S.a_ready(cur);
    if constexpr (SP2) {
        PG8_STAGE(PG8_SB(0, 0), cB, voffB); PG8_STAGE(PG8_SB(0, 1), cB + hstep, voffB); PG8_STAGE(PG8_SA(0, 0), cA, voffA); PG8_STAGE(PG8_SA(0, 1), cA + hstep, voffA);
        if (wr == 1) PG8_BAR;
        PG8_WAIT_V(2); PG8_BAR;
        PG8_STAGE(PG8_SB(1, 0), cB + kstep, voffB); PG8_STAGE(PG8_SA(1, 0), cA + kstep, voffA); PG8_STAGE(PG8_SB(1, 1), cB + hstep + kstep, voffB);
        PG8_WAIT_V(6); PG8_BAR;
    } else {
        PG8_STAGE(PG8_SB(0, 0), cB, voffB); PG8_STAGE(PG8_SA(0, 0), cA, voffA); PG8_STAGE(PG8_SB(0, 1), cB + hstep, voffB); PG8_STAGE(PG8_SA(0, 1), cA + hstep, voffA);
        if (wr == 1) PG8_BAR;
        PG8_WAIT_V(4); PG8_BAR;
        PG8_STAGE(PG8_SB(1, 0), cB + kstep, voffB); PG8_STAGE(PG8_SA(1, 0), cA + kstep, voffA); PG8_STAGE(PG8_SB(1, 1), cB + hstep + kstep, voffB);
        PG8_WAIT_V(6); PG8_BAR;
    }
    for (;;) {
        const bool has_next = S.next(ui + 1, nxt);
        const char* nA = has_next ? (const char*)g.A + (size_t)nxt.pm * tstep : cA; const char* nB = has_next ? (const char*)g.Bt + (size_t)nxt.pn * tstep : cB;
        for (int t = 0; t < nt; t += 2) {
            const bool last = (t == nt - 2);
            const char* a1 = cA + (size_t)(t + 1) * kstep;
            const char* a2 = last ? nA : cA + (size_t)(t + 2) * kstep; const char* b2 = last ? nB : cB + (size_t)(t + 2) * kstep;
            const char* a3 = a2 + kstep; const char* b3 = b2 + kstep;
            if (last && has_next) S.a_ready(nxt);
            if constexpr (SP2) {
            PG8_LDB(B0, 0, 0); PG8_LDB(B1, 0, 1); PG8_SCHED; PG8_LDA(At, 0, 0); PG8_STAGE(PG8_SA(1, 1), a1 + hstep, voffA);
            PG8_WAIT_V(8); PG8_WAIT_L(0); PG8_BAR; PG8_MMA(0, 0, At, B0); PG8_MMA(0, 1, At, B1); PG8_BAR; PG8_SCHED;
            PG8_LDA(At, 0, 1); PG8_STAGE(PG8_SB(0, 0), b2, voffB); PG8_STAGE(PG8_SB(0, 1), b2 + hstep, voffB); PG8_STAGE(PG8_SA(0, 0), a2, voffA);
            PG8_WAIT_V(8); PG8_WAIT_L(0); PG8_BAR; PG8_MMA(1, 0, At, B0); PG8_MMA(1, 1, At, B1); PG8_BAR; PG8_SCHED;
            PG8_LDB(B0, 1, 0); PG8_LDB(B1, 1, 1); PG8_SCHED; PG8_LDA(At, 1, 0); PG8_STAGE(PG8_SA(0, 1), a2 + hstep, voffA);
            PG8_WAIT_V(8); PG8_WAIT_L(0); PG8_BAR; PG8_MMA(0, 0, At, B0); PG8_MMA(0, 1, At, B1); PG8_BAR; PG8_SCHED;
            PG8_LDA(At, 1, 1); PG8_STAGE(PG8_SB(1, 0), b3, voffB); PG8_STAGE(PG8_SB(1, 1), b3 + hstep, voffB); PG8_STAGE(PG8_SA(1, 0), a3, voffA);
            PG8_WAIT_V(8); PG8_WAIT_L(0); PG8_BAR; PG8_MMA(1, 0, At, B0); PG8_MMA(1, 1, At, B1); PG8_BAR; PG8_SCHED;
            } else {
            PG8_LDB(B0, 0, 0); PG8_SCHED; PG8_LDA(At, 0, 0); PG8_STAGE(PG8_SA(1, 1), a1 + hstep, voffA);
            PG8_WAIT_L(8); PG8_BAR; PG8_WAIT_L(0); PG8_MMA(0, 0, At, B0); PG8_BAR; PG8_SCHED;
            PG8_LDB(B1, 0, 1); PG8_STAGE(PG8_SB(0, 0), b2, voffB);
            PG8_BAR; PG8_WAIT_L(0); PG8_MMA(0, 1, At, B1); PG8_BAR;
            PG8_LDA(At, 0, 1); PG8_STAGE(PG8_SA(0, 0), a2, voffA);
            PG8_BAR; PG8_WAIT_L(0); PG8_MMA(1, 0, At, B0); PG8_BAR; PG8_SCHED;
            PG8_STAGE(PG8_SB(0, 1), b2 + hstep, voffB);
            PG8_WAIT_V(6); PG8_BAR; PG8_MMA(1, 1, At, B1); PG8_BAR;
            PG8_LDB(B0, 1, 0); PG8_SCHED; PG8_LDA(At, 1, 0); PG8_STAGE(PG8_SA(0, 1), a2 + hstep, voffA);
            PG8_WAIT_L(8); PG8_BAR; PG8_WAIT_L(0); PG8_MMA(0, 0, At, B0); PG8_BAR; PG8_SCHED;
            PG8_LDB(B1, 1, 1); PG8_STAGE(PG8_SB(1, 0), b3, voffB);
            PG8_BAR; PG8_WAIT_L(0); PG8_MMA(0, 1, At, B1); PG8_BAR;
            PG8_LDA(At, 1, 1); PG8_STAGE(PG8_SA(1, 0), a3, voffA);
            PG8_BAR; PG8_WAIT_L(0); PG8_MMA(1, 0, At, B0); PG8_BAR; PG8_SCHED;
            PG8_STAGE(PG8_SB(1, 1), b3 + hstep, voffB);
            PG8_WAIT_V(6); PG8_BAR; PG8_MMA(1, 1, At, B1); PG8_BAR;
            }
        }
        if constexpr (ALIGN_EPI) { if (wr == 0) PG8_BAR; }
        if constexpr (!Epi::AFTER_DRAIN) { E(acc, cur, wr, wc, fr, fq); S.done(cur); }
        if (!has_next) break;
#pragma unroll
        for (int a = 0; a < 2; ++a)
#pragma unroll
            for (int b = 0; b < 2; ++b)
#pragma unroll
                for (int m = 0; m < 4; ++m)
#pragma unroll
                    for (int n = 0; n < 2; ++n) acc[a][b][m][n] = (f32x4){0.f, 0.f, 0.f, 0.f};
        cur = nxt; cA = nA; cB = nB; ++ui;
        if constexpr (ALIGN_EPI) { if (wr == 1) PG8_BAR; }
    }
    PG8_WAIT_V(0);
    if constexpr (!ALIGN_EPI) { if (wr == 0) PG8_BAR; }
    PG8_BAR;
    if constexpr (Epi::AFTER_DRAIN) { E.fused(acc, cur, wr, wc, fr, fq, lds, wid, lane); S.done(cur); }
#undef PG8_SA
#undef PG8_SB
#undef PG8_STAGE
#undef PG8_LDA
#undef PG8_LDB
#undef PG8_MMA
#undef PG8_WAIT_V
#undef PG8_WAIT_L
#undef PG8_BAR
#undef PG8_SCHED
}
}
#define XB_TMO      128
#define XB_XCNT(j)  (256  + 64 * (j))
#define XB_XSUB(j)  (1280 + 64 * (j))
#define XB_XGEN(j)  (2304 + 64 * (j))
#define XB_TOP      3328
#define XB_TOPGEN   3392
#define XCD_BAR_WORDS 3456
#define XB_SPIN_CAP (1u << 18)

__device__ __forceinline__ unsigned xb_ld(unsigned* p)              { return __hip_atomic_load(p, __ATOMIC_RELAXED, __HIP_MEMORY_SCOPE_AGENT); }
__device__ __forceinline__ unsigned xb_add(unsigned* p, unsigned v) { return __hip_atomic_fetch_add(p, v, __ATOMIC_RELAXED, __HIP_MEMORY_SCOPE_AGENT); }
__device__ __forceinline__ unsigned xb_xcc_id() { return (unsigned)__builtin_amdgcn_s_getreg((3 << 11) | 20) & 0xFu; }
#define XB_SPIN(cond, bar) do { unsigned _sp = 0; while (cond) { __builtin_amdgcn_s_sleep(1); \
    if ((++_sp & 255u) == 0u) { if (xb_ld(&(bar)[XB_TMO])) break; if (_sp > XB_SPIN_CAP) { atomicAdd(&(bar)[XB_TMO], 1u); break; } } } } while (0)

struct XcdBarrier {
    unsigned* bar; unsigned x;
    volatile LAS unsigned* st;
};

__device__ __forceinline__ XcdBarrier xcd_barrier_post(unsigned* bar, volatile LAS unsigned* st) {
    XcdBarrier b; b.bar = bar; b.x = xb_xcc_id(); b.st = st;
    if (threadIdx.x == 0) (void)xb_add(&bar[XB_XCNT(b.x)], 1u);
    return b;
}
__device__ __forceinline__ void xcd_barrier_complete(unsigned* bar, unsigned x, unsigned& nloc, unsigned& nx) {
    const unsigned G = gridDim.x * gridDim.y * gridDim.z;
    unsigned sum, cnt, mine, sp = 0u;
    for (;;) {
        sum = 0u; cnt = 0u; mine = 0u;
#pragma unroll
        for (unsigned j = 0; j < 16; ++j) { const unsigned c = xb_ld(&bar[XB_XCNT(j)]); sum += c; cnt += (c > 0u) ? 1u : 0u; mine = (j == x) ? c : mine; }
        if (sum == G) break;
        __builtin_amdgcn_s_sleep(1);
        if ((++sp & 255u) == 0u) { if (xb_ld(&bar[XB_TMO])) break; if (sp > XB_SPIN_CAP) { atomicAdd(&bar[XB_TMO], 1u); break; } }
    }
    nloc = mine > 0u ? mine : 1u; nx = cnt > 0u ? cnt : 1u;
}

__device__ __forceinline__ void xcd_barrier(const XcdBarrier& b) {
    asm volatile("s_waitcnt vmcnt(0)" ::: "memory");
    __syncthreads();
    if (threadIdx.x == 0) {
        unsigned* bar = b.bar;
        __builtin_amdgcn_s_waitcnt(0);
        unsigned nloc = b.st[0], nx = b.st[1];
        if (nloc == 0u) { xcd_barrier_complete(bar, b.x, nloc, nx); b.st[0] = nloc; b.st[1] = nx; }
        const unsigned old = xb_add(&bar[XB_XSUB(b.x)], 1u);
        const unsigned gen = old / nloc;
        if (old + 1u == (gen + 1u) * nloc) {
            __builtin_amdgcn_fence(__ATOMIC_RELEASE, "agent");
            asm volatile("s_waitcnt vmcnt(0)" ::: "memory");
            const unsigned og = xb_add(&bar[XB_TOP], 1u);
            const unsigned tg = og / nx;
            if (og + 1u == (tg + 1u) * nx) xb_add(&bar[XB_TOPGEN], 1u);
            else XB_SPIN(xb_ld(&bar[XB_TOPGEN]) == tg, bar);
            __builtin_amdgcn_fence(__ATOMIC_ACQUIRE, "agent");
            xb_add(&bar[XB_XGEN(b.x)], 1u);
            asm volatile("s_waitcnt vmcnt(0)" ::: "memory");
        } else {
            XB_SPIN(xb_ld(&bar[XB_XGEN(b.x)]) == gen, bar);
            __builtin_amdgcn_fence(__ATOMIC_ACQUIRE, "agent");
            asm volatile("s_waitcnt vmcnt(0)" ::: "memory");
        }
    }
    __syncthreads();
}

using pg8::bf16_t; using pg8::bf16x8; using pg8::f32x4; using pg8::u32x4; using pg8::cvt_pk_bf16; using pg8::fast_exp;

#define BAR_LDS() do { asm volatile("s_waitcnt lgkmcnt(0)" ::: "memory"); __builtin_amdgcn_s_barrier(); asm volatile("" ::: "memory"); } while (0)
#define BAR_ALL() do { asm volatile("s_waitcnt vmcnt(0) lgkmcnt(0)" ::: "memory"); __builtin_amdgcn_s_barrier(); asm volatile("" ::: "memory"); } while (0)

#ifdef PROBE_SHFL
__device__ __forceinline__ float shx(float v, int mask, int lane) { (void)lane; return __shfl_xor(v, mask); }
__device__ __forceinline__ unsigned shxu(unsigned v, int mask, int lane) { (void)lane; return __shfl_xor(v, mask); }
__device__ __forceinline__ unsigned shupu(unsigned v, int d, int lane) { (void)lane; return __shfl_up(v, d); }
#else
__device__ __forceinline__ float shx(float v, int mask, int lane) { return __builtin_bit_cast(float, __builtin_amdgcn_ds_bpermute((lane ^ mask) << 2, __builtin_bit_cast(int, v))); }
__device__ __forceinline__ unsigned shxu(unsigned v, int mask, int lane) { return (unsigned)__builtin_amdgcn_ds_bpermute((lane ^ mask) << 2, (int)v); }
__device__ __forceinline__ unsigned shupu(unsigned v, int d, int lane) { return (unsigned)__builtin_amdgcn_ds_bpermute((lane - d) << 2, (int)v); }
#endif
__device__ __forceinline__ float wave_sum(float v, int lane) {
#pragma unroll
    for (int o = 1; o < 64; o <<= 1) v += shx(v, o, lane);
    return v;
}
__device__ __forceinline__ float bf_lo(unsigned u) { return __uint_as_float(u << 16); }
__device__ __forceinline__ float bf_hi(unsigned u) { return __uint_as_float(u & 0xffff0000u); }

struct Args { const float* in[18]; float* out; unsigned char* ws; };
struct Ctx { LAS unsigned char* lds; int w0;
    __device__ __forceinline__ const float* in(int i) const { return ldptr(lds, i); }
    __device__ __forceinline__ float* out() const { return (float*)ldptr(lds, 18); }
    __device__ __forceinline__ unsigned char* ws() const { return (unsigned char*)ldptr(lds, 19); } };
#define PHASE_IDS() const int tid = opaque_tid(a.w0), lane = tid & 63, wave = __builtin_amdgcn_readfirstlane(tid >> 6); (void)tid; (void)lane; (void)wave
enum { I_X = 0, I_C, I_CTX, I_CCTX, I_WADA, I_BADA, I_GMIX, I_GFFN, I_WIN, I_WOUT, I_LBL, I_ONORM, I_RDEC, I_WR, I_WEG, I_WEU, I_WED, I_GFIN };

struct CvtItem { const float* src; unsigned char* dst; int N, Kd, f8; };
__device__ __forceinline__ void cvt_desc(CvtItem& it, const float* W, int N, unsigned char* WT, int Kd, int k0, int n0, int drow0, int lane, int f8) {
    const int q = lane >> 4, c = lane & 15, es = f8 ? 1 : 2;
    it.src = W + (size_t)(k0 + 16 * q) * N + n0 + 4 * c; it.N = N; it.Kd = Kd * es; it.dst = WT + ((size_t)(drow0 + 4 * c) * Kd + k0 + 16 * q) * es; it.f8 = f8;
}
__device__ __forceinline__ void cvt_load(f32x4 (&v)[16], const CvtItem& it) {
#pragma unroll
    for (int i = 0; i < 16; ++i) v[i] = *(const f32x4*)(it.src + (size_t)i * it.N);
}
__device__ __forceinline__ void cvt_store(const f32x4 (&v)[16], const CvtItem& it) {
    if (it.f8) {
#pragma unroll
        for (int j = 0; j < 4; ++j) { u32x4 o; constexpr float s = pg8::F8_SW;
            o.x = pg8::pk4_fp8(v[0][j] * s, v[1][j] * s, v[2][j] * s, v[3][j] * s); o.y = pg8::pk4_fp8(v[4][j] * s, v[5][j] * s, v[6][j] * s, v[7][j] * s);
            o.z = pg8::pk4_fp8(v[8][j] * s, v[9][j] * s, v[10][j] * s, v[11][j] * s); o.w = pg8::pk4_fp8(v[12][j] * s, v[13][j] * s, v[14][j] * s, v[15][j] * s);
            *(u32x4*)(it.dst + (size_t)j * it.Kd) = o; }
    } else {
#pragma unroll
        for (int j = 0; j < 4; ++j) { u32x4 o0, o1;
            o0.x = cvt_pk_bf16(v[0][j], v[1][j]); o0.y = cvt_pk_bf16(v[2][j], v[3][j]); o0.z = cvt_pk_bf16(v[4][j], v[5][j]); o0.w = cvt_pk_bf16(v[6][j], v[7][j]);
            o1.x = cvt_pk_bf16(v[8][j], v[9][j]); o1.y = cvt_pk_bf16(v[10][j], v[11][j]); o1.z = cvt_pk_bf16(v[12][j], v[13][j]); o1.w = cvt_pk_bf16(v[14][j], v[15][j]);
            *(u32x4*)(it.dst + (size_t)j * it.Kd) = o0; *(u32x4*)(it.dst + (size_t)j * it.Kd + 16) = o1; }
    }
}
__device__ __forceinline__ void cvt_expert_desc(CvtItem& it, const Ctx& a, unsigned char* ws, int g, int lane) {
    constexpr int I_E = 512; const int l = g / 24576, r = g % 24576; const int le = l * 16 + r / (3 * I_E), q3 = r % (3 * I_E), kind = q3 / I_E, q = q3 % I_E;
    if (kind < 2) { const int kb = q / 32, nb = q % 32, n0 = nb * 64;
        const int drow = 256 * (n0 >> 7) + (n0 & 127) + kind * 128;
        cvt_desc(it, a.in(kind == 0 ? I_WEG : I_WEU) + (size_t)le * D * FF, FF, (unsigned char*)(ws + WS_WGU) + (size_t)le * 4096 * D, D, kb * 64, n0, drow, lane, 1);
    } else { const int kb = q / 16, nb = q % 16;
        cvt_desc(it, a.in(I_WED) + (size_t)le * FF * D, D, (unsigned char*)(ws + WS_WD) + (size_t)le * D * FF, FF, kb * 64, nb * 64, nb * 64, lane, 1); }
}
constexpr int CVT_N0 = 9472, CVT_G1 = 7040, CVT_G2 = 7936, CVT_T = 4608, CVT_G4 = 6144, CVT_CYC = CVT_G1 + CVT_G2 + CVT_T + CVT_G4;
static_assert(CVT_G1 == 220 * 8 * 4 && CVT_G2 == 248 * 8 * 4 && CVT_T == 192 * 8 * 3 && CVT_G4 == 192 * 8 * 4, "slot sizes = idle workgroups x 8 waves x items per wave");
static_assert(CVT_N0 + CVT_G1 + CVT_G2 + CVT_T >= 24576 && CVT_N0 + CVT_CYC + CVT_G1 + CVT_G2 + CVT_T >= 2 * 24576 && CVT_N0 + 2 * CVT_CYC + CVT_G1 + CVT_G2 + CVT_T >= 3 * 24576 && CVT_N0 + 3 * CVT_CYC + CVT_G1 + CVT_T >= 4 * 24576, "every layer's expert weights are converted before its first expert GEMM");
__device__ __forceinline__ void cvt_tail(const Ctx& a, int first, int rank, int per, int i0, int i1) {
    PHASE_IDS(); unsigned char* ws = a.ws();
    const int base = first + (rank * 8 + wave) * per; int g = base + i0, g1 = base + i1; if (g1 > 4 * 24576) g1 = 4 * 24576;
    f32x4 va[16], vb[16]; CvtItem ia, ib;
    if (g < g1) { cvt_expert_desc(ia, a, ws, g, lane); cvt_load(va, ia); }
    while (g < g1) {
        if (g + 1 < g1) { cvt_expert_desc(ib, a, ws, g + 1, lane); cvt_load(vb, ib); }
        cvt_store(va, ia);
        if (++g >= g1) break;
        if (g + 1 < g1) { cvt_expert_desc(ia, a, ws, g + 1, lane); cvt_load(va, ia); }
        cvt_store(vb, ib);
        ++g; }
}
template <int PER>
__device__ __forceinline__ void cvt_tail(const Ctx& a, int first, int rank) { cvt_tail(a, first, rank, PER, 0, PER); }

__device__ __forceinline__ void p0_item_desc(CvtItem& it, const Ctx& a, unsigned char* ws, int r, int lane) {
    constexpr int I_IN = 16 * 72, I_OUT = 16 * 16;
    if (r < 4 * I_IN) { const int l = r / I_IN, q = r % I_IN, kb = q / 72, nb = q % 72;

#ifdef G1_F8
        cvt_desc(it, a.in(I_WIN) + (size_t)l * D * INW, INW, (unsigned char*)(ws + WS_WIN) + (size_t)l * INW * D, D, kb * 64, nb * 64, nb * 64, lane, 1); return; }
#else
        cvt_desc(it, a.in(I_WIN) + (size_t)l * D * INW, INW, (unsigned char*)((bf16_t*)(ws + WS_WIN) + (size_t)l * INW * D), D, kb * 64, nb * 64, nb * 64, lane, 0); return; }
#endif
    r -= 4 * I_IN;
    if (r < 4 * I_OUT) { const int l = r / I_OUT, q = r % I_OUT, kb = q / 16, nb = q % 16;

#ifdef G2_F8
        cvt_desc(it, a.in(I_WOUT) + (size_t)l * D * D, D, (unsigned char*)(ws + WS_WOUT) + (size_t)l * D * D, D, kb * 64, nb * 64, nb * 64, lane, 1); return; }
#else
        cvt_desc(it, a.in(I_WOUT) + (size_t)l * D * D, D, (unsigned char*)((bf16_t*)(ws + WS_WOUT) + (size_t)l * D * D), D, kb * 64, nb * 64, nb * 64, lane, 0); return; }
#endif
    r -= 4 * I_OUT;
    cvt_expert_desc(it, a, ws, r, lane);
}
__device__ __forceinline__ void p0_prologue(const Ctx& a) {
    PHASE_IDS(); LAS unsigned char* lds = launder_lds(a.lds); unsigned char* ws = a.ws(); const float* cin_ = a.in(I_C); const float* cctx_ = a.in(I_CCTX);
    LAS float* scond = (LAS float*)(lds + 8 * 16640);
    for (int i = tid; i < 3 * D; i += 512) { const int w = i >> 10, k = i & 1023; const float cv = (w < 2) ? cin_[w * D + k] : cctx_[k]; scond[i] = cv * pg8::fast_sigmoid(cv); }
    if (blockIdx.x == 0) { const int c = tid; const float* lg = a.in(I_LBL);
        const float l0 = lg[c], l1 = lg[512 + c], l2 = lg[1024 + c], l3 = lg[1536 + c]; const float mx = fmaxf(fmaxf(l0, l1), fmaxf(l2, l3));
        const float e0 = expf(l0 - mx), e1 = expf(l1 - mx), e2 = expf(l2 - mx), e3 = expf(l3 - mx), inv = 1.0f / (e0 + e1 + e2 + e3);
        float* lbs = (float*)(ws + WS_LBS); lbs[c] = 0.f; lbs[512 + c] = e1 * inv; lbs[1024 + c] = (e1 + e2) * inv; lbs[1536 + c] = (e1 + e2 + e3) * inv; }
    if (blockIdx.x >= 1 && blockIdx.x <= 16) { const int idx = (blockIdx.x - 1) * 512 + tid, pos = idx >> 5, f = idx & 31;
        const float invf = powf(10000.0f, -(float)f / 32.0f), ang = (float)pos * invf; float* cs = (float*)(ws + WS_ROPE); cs[idx * 2] = cosf(ang); cs[idx * 2 + 1] = sinf(ang); }
    BAR_LDS();
    const int gw = blockIdx.x * 8 + wave, NGW = gridDim.x * 8;
    for (int it = gw; it < 4 * 24 * 8; it += NGW) { const int l = it / 192, r = it % 192, cg = r >> 3, ks = r & 7; const int cols = cg * 256 + lane * 4;
        const float* wp = a.in(I_WADA) + ((size_t)l * D + ks * 128) * 6144 + cols; f32x4 a0 = {0, 0, 0, 0}, a1 = a0, a2 = a0;
#pragma unroll 8
        for (int kk = 0; kk < 128; ++kk) { const f32x4 w = *(const f32x4*)(wp + (size_t)kk * 6144); const int k = ks * 128 + kk; a0 += w * scond[k]; a1 += w * scond[D + k]; a2 += w * scond[2 * D + k]; }
        float* pp = (float*)(ws + WS_MODP) + (size_t)((l * 8 + ks) * 3) * 6144 + cols; *(f32x4*)pp = a0; *(f32x4*)(pp + 6144) = a1; *(f32x4*)(pp + 2 * 6144) = a2; }
#ifdef PROBE_NOBG
    const int n_exp = 4 * 24576;
#else
    const int n_exp = (gridDim.x == 256) ? CVT_N0 : 4 * 24576;
#endif
    const int NIT = 4 * (16 * 72 + 16 * 16) + n_exp;
    f32x4 va[16], vb[16]; CvtItem ia, ib; int it = gw;
    if (it < NIT) { p0_item_desc(ia, a, ws, it, lane); cvt_load(va, ia); }
    while (it < NIT) {
        int nx = it + NGW;
        if (nx < NIT) { p0_item_desc(ib, a, ws, nx, lane); cvt_load(vb, ib); }
        cvt_store(va, ia);
        it = nx; if (it >= NIT) break;
        nx = it + NGW;
        if (nx < NIT) { p0_item_desc(ia, a, ws, nx, lane); cvt_load(va, ia); }
        cvt_store(vb, ib);
        it = nx;
    }
}

__device__ __forceinline__ void p0_finalize(const Ctx& a) {
    PHASE_IDS(); unsigned char* ws = a.ws(); const float* bada = a.in(I_BADA); const float* part = (const float*)(ws + WS_MODP); float* mods = (float*)(ws + WS_MODS);
    for (int i = blockIdx.x * 512 + tid; i < 4 * 3 * 6144; i += gridDim.x * 512) { const int l = i / (3 * 6144), r = i % (3 * 6144), w = r / 6144, j = r % 6144;
        float s = bada[l * 6144 + j];
#pragma unroll
        for (int ks = 0; ks < 8; ++ks) s += part[(size_t)((l * 8 + ks) * 3 + w) * 6144 + j];
        mods[i] = s; }
}

template <int MODE>
__device__ __forceinline__ void norm1_phase(const Ctx& a, int l) {
    PHASE_IDS(); unsigned char* ws = a.ws(); const float* in_x = a.in(I_X); const float* in_ctx = a.in(I_CTX); const float* gm = (MODE != 1) ? a.in(I_GMIX) + l * D : a.in(I_GFIN); float* outp = a.out(); const int gw = blockIdx.x * 8 + wave, NGW = gridDim.x * 8;
    const float* mods = (const float*)(ws + WS_MODS); bf16_t* X = (bf16_t*)(ws + WS_X); bf16_t* H = (bf16_t*)(ws + WS_H);
    const int* inv = (const int*)(ws + WS_INV); const unsigned char* YS = (const unsigned char*)(ws + WS_YS); const float* gate = (const float*)(ws + WS_ROWMAP) + MOE_ROWS;
    constexpr int NTOT = (MODE == 1) ? NB * SEQ : MROWS;
#define N1_ROWOF(n_) ((MODE == 1) ? (((n_) >> 14) * LTOT + CTX + ((n_) & (SEQ - 1))) : (n_))
#define N1_LOADROW(n_, v_, iv_) do { const int r_ = N1_ROWOF(n_); const int b_ = r_ >= LTOT ? 1 : 0, g_ = r_ - b_ * LTOT; \
        if (l == 0) { const float* src_ = (g_ < CTX ? in_ctx + (size_t)(b_ * CTX + g_) * D : in_x + (size_t)(b_ * SEQ + g_ - CTX) * D); \
            _Pragma("unroll") for (int j = 0; j < 4; ++j) v_[j] = *(const f32x4*)(src_ + lane * 4 + 256 * j); } \
        else { const bf16_t* src_ = X + (size_t)r_ * D; _Pragma("unroll") for (int j = 0; j < 4; ++j) { const u32x2 w_ = *(const u32x2*)(src_ + lane * 4 + 256 * j); v_[j] = (f32x4){bf_lo(w_.x), bf_hi(w_.x), bf_lo(w_.y), bf_hi(w_.y)}; } \
            iv_ = inv[r_ * 16 + (lane & 15)]; } } while (0)
    f32x4 v[4]; int iv = -1; int n = gw;
    int curw = -1; f32x4 cgs[4], csh[4], cgt[4];
#pragma unroll
    for (int j = 0; j < 4; ++j) { cgs[j] = (f32x4){0.f, 0.f, 0.f, 0.f}; csh[j] = cgs[j]; cgt[j] = cgs[j]; }
    if (n < NTOT) N1_LOADROW(n, v, iv);
    for (; n < NTOT; n += NGW) {
        const int row = N1_ROWOF(n); const int b = row >= LTOT ? 1 : 0, g = row - b * LTOT; const bool isctx = g < CTX; const int which = isctx ? 2 : b;
        if (which != curw) { curw = which;
            if (MODE != 1) { const float* sh_ = mods + (size_t)(l * 3 + which) * 6144; const float* sc_ = sh_ + D;
#pragma unroll
                for (int j = 0; j < 4; ++j) { const int c = lane * 4 + 256 * j; cgs[j] = *(const f32x4*)(gm + c) * (*(const f32x4*)(sc_ + c) + 1.0f); csh[j] = *(const f32x4*)(sh_ + c); } }
            else {
#pragma unroll
                for (int j = 0; j < 4; ++j) cgs[j] = *(const f32x4*)(gm + lane * 4 + 256 * j); }
            if (l != 0) { const float* gt2_ = mods + (size_t)((l - 1) * 3 + which) * 6144 + 5 * D;
#pragma unroll
                for (int j = 0; j < 4; ++j) cgt[j] = *(const f32x4*)(gt2_ + lane * 4 + 256 * j); } }
        f32x4 vn[4]; int ivn = -1; const int nn = n + NGW;
        if (nn < NTOT) N1_LOADROW(nn, vn, ivn);
        if (l != 0) {
            unsigned vm = (unsigned)__builtin_amdgcn_ballot_w64(iv >= 0) & 0xffffu;
            f32x4 s[4] = {{0, 0, 0, 0}, {0, 0, 0, 0}, {0, 0, 0, 0}, {0, 0, 0, 0}};
            while (vm) {
                const int e0 = __builtin_ctz(vm); vm &= vm - 1; const bool has1 = vm != 0u; const int e1 = has1 ? __builtin_ctz(vm) : e0; if (has1) vm &= vm - 1;
                const int mr0 = __builtin_amdgcn_readlane(iv, e0), mr1 = __builtin_amdgcn_readlane(iv, e1);
                const float g0 = gate[mr0] * (1.0f / pg8::F8_SY), g1 = has1 ? gate[mr1] * (1.0f / pg8::F8_SY) : 0.f;
                const unsigned char* y0r = YS + (size_t)mr0 * D + lane * 4; const unsigned char* y1r = YS + (size_t)mr1 * D + lane * 4; unsigned y0[4], y1[4];
#pragma unroll
                for (int j = 0; j < 4; ++j) { y0[j] = *(const unsigned*)(y0r + 256 * j); y1[j] = *(const unsigned*)(y1r + 256 * j); }
#pragma unroll
                for (int j = 0; j < 4; ++j) { const f32x2 a01 = __builtin_amdgcn_cvt_pk_f32_fp8((int)y0[j], false), a23 = __builtin_amdgcn_cvt_pk_f32_fp8((int)y0[j], true);
                    const f32x2 b01 = __builtin_amdgcn_cvt_pk_f32_fp8((int)y1[j], false), b23 = __builtin_amdgcn_cvt_pk_f32_fp8((int)y1[j], true);
                    s[j][0] += g0 * a01.x + g1 * b01.x; s[j][1] += g0 * a01.y + g1 * b01.y; s[j][2] += g0 * a23.x + g1 * b23.x; s[j][3] += g0 * a23.y + g1 * b23.y; } }
            bf16_t* xr = X + (size_t)row * D;
#pragma unroll
            for (int j = 0; j < 4; ++j) { v[j] += cgt[j] * s[j]; if (MODE == 0) { u32x2 w; w.x = cvt_pk_bf16(v[j][0], v[j][1]); w.y = cvt_pk_bf16(v[j][2], v[j][3]); *(u32x2*)(xr + lane * 4 + 256 * j) = w; } }
        }
        float ss = 0.f;
#pragma unroll
        for (int j = 0; j < 4; ++j) ss += (v[j][0] * v[j][0] + v[j][1] * v[j][1]) + (v[j][2] * v[j][2] + v[j][3] * v[j][3]);
        const float rinv = __builtin_amdgcn_rsqf(wave_sum(ss, lane) * (1.0f / D) + EPS);
        if (MODE != 1) {
            bf16_t* hr = H + (size_t)row * D + lane * 4;
#pragma unroll
            for (int j = 0; j < 4; ++j) { const int c = lane * 4 + 256 * j; (void)c;
                const f32x4 y = v[j] * rinv * cgs[j] + csh[j];
#ifdef G1_F8
                *(unsigned*)((unsigned char*)H + (size_t)row * D + c) = pg8::pk4_fp8(y[0] * pg8::F8_SA, y[1] * pg8::F8_SA, y[2] * pg8::F8_SA, y[3] * pg8::F8_SA); }
#else
                u32x2 w; w.x = cvt_pk_bf16(y[0], y[1]); w.y = cvt_pk_bf16(y[2], y[3]); *(u32x2*)(hr + 256 * j) = w; }
#endif
        } else {
            float* orow = outp + (size_t)(b * SEQ + g - CTX) * D + lane * 4;
#pragma unroll
            for (int j = 0; j < 4; ++j) *(f32x4*)(orow + 256 * j) = v[j] * rinv * cgs[j];
        }
#pragma unroll
        for (int j = 0; j < 4; ++j) v[j] = vn[j];
        iv = ivn;
    }
#undef N1_ROWOF
#undef N1_LOADROW
}

constexpr int N2_WH = 0, N2_WL = 32768, N2_CS = 65536, N2_CH = 69632, N2_CE = 73728;
typedef __bf16 bf2v __attribute__((ext_vector_type(2)));
__device__ __forceinline__ float dot2_bf16(unsigned u, float c) { const bf2v v = __builtin_bit_cast(bf2v, u); return __builtin_amdgcn_fdot2_f32_bf16(v, v, c, false); }
__device__ __forceinline__ void norm2_phase(const Ctx& a, int l) {
    PHASE_IDS(); LAS unsigned char* lds = launder_lds(a.lds); unsigned char* ws = a.ws();
    const bf16_t* X = (const bf16_t*)(ws + WS_X); unsigned char* H8 = (unsigned char*)(ws + WS_H);
    int* inv = (int*)(ws + WS_INV); float* afl = (float*)(ws + WS_AFF); float* afc = afl + 2 * 16 * SEQ;
    const bool last = (l == DEPTH - 1);
    const int NQ = last ? 2048 : 2080;
    int built = -1;
    for (int q0 = blockIdx.x * 8; q0 < NQ; q0 += gridDim.x * 8) {
        const int which = q0 < 1024 ? 0 : (q0 < 2048 ? 1 : 2);
        const int q = q0 + wave; const bool isctx = q >= 2048;
        const int b = isctx ? ((q - 2048) >> 4) : (q >> 10), g0 = isctx ? ((q - 2048) & 15) * 16 : CTX + (q & 1023) * 16;
        const int row0 = b * LTOT + g0; const int r = lane & 15, kg = lane >> 4;
        u32x4 xa[32];
        { const bf16_t* xp = X + (size_t)(row0 + r) * D + 16 * kg;
#pragma unroll
          for (int c = 0; c < 16; ++c) { xa[2 * c] = *(const u32x4*)(xp + 64 * c); xa[2 * c + 1] = *(const u32x4*)(xp + 64 * c + 8); } }
        if (which != built) {
            if (built >= 0) BAR_LDS();
            const float* wr = a.in(I_WR) + (size_t)l * D * NE; const float* gm = a.in(I_GFFN) + l * D;
            const float* sh = (const float*)(ws + WS_MODS) + (size_t)(l * 3 + which) * 6144 + 3 * D; const float* sc = sh + D;
            const int e = tid & 15; float cpart = 0.f;
#pragma unroll 1
            for (int i = 0; i < 4; ++i) { const int u = tid + 512 * i; const int s = u >> 6, kgu = (u >> 4) & 3; const int k0 = 64 * (s >> 1) + 16 * kgu + 8 * (s & 1);
                u32x4 hi4, lo4;
#pragma unroll
                for (int h = 0; h < 2; ++h) { const f32x4 gg = *(const f32x4*)(gm + k0 + 4 * h), s1 = *(const f32x4*)(sc + k0 + 4 * h), s0 = *(const f32x4*)(sh + k0 + 4 * h); const f32x4 m = gg * (s1 + 1.0f);
#pragma unroll
                    for (int jp = 0; jp < 2; ++jp) { const int j = 4 * h + 2 * jp; const float w0 = wr[(k0 + j) * 16 + e], w1 = wr[(k0 + j + 1) * 16 + e];
                        const float v0 = m[2 * jp] * w0, v1 = m[2 * jp + 1] * w1; cpart += s0[2 * jp] * w0 + s0[2 * jp + 1] * w1;
                        const unsigned ph = cvt_pk_bf16(v0, v1); const unsigned pl = cvt_pk_bf16(v0 - bf_lo(ph), v1 - bf_hi(ph));
                        hi4[2 * h + jp] = ph; lo4[2 * h + jp] = pl; } }
                *(LAS u32x4*)(lds + N2_WH + u * 16) = hi4; *(LAS u32x4*)(lds + N2_WL + u * 16) = lo4; }
            cpart += shx(cpart, 16, lane); cpart += shx(cpart, 32, lane);
            if (lane < 16) ((LAS float*)(lds + N2_CE))[wave * 16 + lane] = cpart;
            if (tid < 256) { const int k = tid * 4; const f32x4 gg = *(const f32x4*)(gm + k), s1 = *(const f32x4*)(sc + k), s0 = *(const f32x4*)(sh + k);
                *(LAS f32x4*)(lds + N2_CS + k * 4) = gg * (s1 + 1.0f) * pg8::F8_SA; *(LAS f32x4*)(lds + N2_CH + k * 4) = s0 * pg8::F8_SA; }
            BAR_LDS(); built = which;
        }
        f32x4 acc = {0.f, 0.f, 0.f, 0.f}; float ss = 0.f;
#pragma unroll
        for (int s = 0; s < 32; ++s) {
            const bf16x8 wh = *(const LAS bf16x8*)(lds + N2_WH + (s * 64 + lane) * 16), wl = *(const LAS bf16x8*)(lds + N2_WL + (s * 64 + lane) * 16);
            const bf16x8 xf = __builtin_bit_cast(bf16x8, xa[s]);
            acc = __builtin_amdgcn_mfma_f32_16x16x32_bf16(wh, xf, acc, 0, 0, 0); acc = __builtin_amdgcn_mfma_f32_16x16x32_bf16(wl, xf, acc, 0, 0, 0);
            ss = dot2_bf16(xa[s][0], ss); ss = dot2_bf16(xa[s][1], ss); ss = dot2_bf16(xa[s][2], ss); ss = dot2_bf16(xa[s][3], ss);
            if ((s & 3) == 3) __builtin_amdgcn_sched_barrier(0); }
        ss += shx(ss, 16, lane); ss += shx(ss, 32, lane);
        const float rinv = __builtin_amdgcn_rsqf(ss * (1.0f / D) + EPS);
        {
            f32x4 ce = {0.f, 0.f, 0.f, 0.f};
#pragma unroll
            for (int w = 0; w < 8; ++w) ce += *(const LAS f32x4*)(lds + N2_CE + (w * 16 + 4 * kg) * 4);
            const f32x4 lg = acc * rinv + ce;
            float mx = fmaxf(fmaxf(lg[0], lg[1]), fmaxf(lg[2], lg[3])); mx = fmaxf(mx, shx(mx, 16, lane)); mx = fmaxf(mx, shx(mx, 32, lane));
            f32x4 ex; ex[0] = expf(lg[0] - mx); ex[1] = expf(lg[1] - mx); ex[2] = expf(lg[2] - mx); ex[3] = expf(lg[3] - mx);
            float sm = (ex[0] + ex[1]) + (ex[2] + ex[3]); sm += shx(sm, 16, lane); sm += shx(sm, 32, lane);
            float* dst = isctx ? afc + (size_t)(b * 16 + 4 * kg) * CTX + g0 + r : afl + (size_t)(b * 16 + 4 * kg) * SEQ + (g0 - CTX) + r; const int estr = isctx ? CTX : SEQ;
#pragma unroll
            for (int j = 0; j < 4; ++j) dst[(size_t)j * estr] = ex[j] / sm; }
        { typedef int i32x4 __attribute__((ext_vector_type(4))); int m1 = -1; asm volatile("" : "+v"(m1)); *(i32x4*)(inv + (size_t)row0 * 16 + lane * 4) = (i32x4){m1, m1, m1, m1}; }
        unsigned char* hp = H8 + (size_t)(row0 + r) * D + 16 * kg;
#pragma unroll
        for (int c = 0; c < 16; ++c) { const LAS f32x4* cs = (const LAS f32x4*)(lds + N2_CS + (64 * c + 16 * kg) * 4); const LAS f32x4* ch = (const LAS f32x4*)(lds + N2_CH + (64 * c + 16 * kg) * 4);
            u32x4 o;
#pragma unroll
            for (int h = 0; h < 4; ++h) { const unsigned w0 = xa[2 * c + (h >> 1)][2 * (h & 1)], w1 = xa[2 * c + (h >> 1)][2 * (h & 1) + 1];
                const f32x4 xv = {bf_lo(w0), bf_hi(w0), bf_lo(w1), bf_hi(w1)}; const f32x4 y = xv * rinv * cs[h] + ch[h]; o[h] = pg8::pk4_fp8(y[0], y[1], y[2], y[3]); }
            *(u32x4*)(hp + 64 * c) = o;
            if ((c & 1) == 1) __builtin_amdgcn_sched_barrier(0); }
    }
}

__device__ __forceinline__ void topk_phase(const Ctx& a, int l) {
    PHASE_IDS(); LAS unsigned char* lds = launder_lds(a.lds); unsigned char* ws = a.ws(); const float* afl = (const float*)(ws + WS_AFF); const float* afc = afl + 2 * 16 * SEQ;
    int* rowmap = (int*)(ws + WS_ROWMAP); float* gate = (float*)(ws + WS_ROWMAP) + MOE_ROWS; int* inv = (int*)(ws + WS_INV);
    LAS unsigned* wcnt = (LAS unsigned*)lds;
    const int nitems = (l == DEPTH - 1) ? 32 : 64;
    for (int it = blockIdx.x; it < nitems; it += gridDim.x) {
        const bool isctx = it >= 32; const int be = it & 31, b = be >> 4, e = be & 15;
        const int n = isctx ? CTX : SEQ, k = isctx ? CAP_CTX : CAP_LAT;
        const float* src = isctx ? afc + be * CTX : afl + (size_t)be * SEQ;
        unsigned key[32];
#pragma unroll
        for (int i = 0; i < 32; ++i) { const int idx = i * 512 + tid; key[i] = idx < n ? __float_as_uint(src[idx]) : 0u; }
        unsigned T = 0u;
        for (int bit = 30; bit >= 0; --bit) { const unsigned cand = T | (1u << bit); unsigned cnt = 0;
#pragma unroll
            for (int i = 0; i < 32; ++i) cnt += (key[i] >= cand) ? 1u : 0u;
#pragma unroll
            for (int o = 1; o < 64; o <<= 1) cnt += shxu(cnt, o, lane);
            LAS unsigned* wc = wcnt + (bit & 1) * 8; if (lane == 0) wc[wave] = cnt;
            BAR_LDS();
            unsigned tot = 0;
#pragma unroll
            for (int w = 0; w < 8; ++w) tot += wc[w];
            if (tot >= (unsigned)k) T = cand; }
        unsigned mine = 0;
#pragma unroll
        for (int i = 0; i < 32; ++i) mine += (key[i] > T ? 1u : 0u) + (key[i] == T ? 65536u : 0u);
        unsigned incl = mine;
#pragma unroll
        for (int o = 1; o < 64; o <<= 1) { const unsigned t = shupu(incl, o, lane); if (lane >= o) incl += t; }
        LAS unsigned* wt = wcnt + 16; BAR_LDS();
        if (lane == 63) wt[wave] = incl;
        BAR_LDS();
        unsigned base = 0, total = 0;
#pragma unroll
        for (int w = 0; w < 8; ++w) { const unsigned t = wt[w]; total += t; if (w < wave) base += t; }
        const unsigned excl = base + incl - mine; const unsigned cgt = total & 0xffffu; const unsigned need = (unsigned)k - cgt;
        unsigned sg = excl & 0xffffu, se = excl >> 16;
        const int mrbase = e * MOE_ROWS_E + (isctx ? 4096 + b * CAP_CTX : b * CAP_LAT);
        const int rbase = b * LTOT + (isctx ? 0 : CTX);
#pragma unroll
        for (int i = 0; i < 32; ++i) { const int idx = i * 512 + tid; const unsigned kk = key[i]; int slot = -1;
            if (kk > T) { slot = (int)sg; ++sg; } else if (kk == T) { if (se < need) slot = (int)(cgt + se); ++se; }
            if (slot >= 0) { const int mr = mrbase + slot, r = rbase + idx; rowmap[mr] = r; gate[mr] = __uint_as_float(kk); inv[r * 16 + e] = mr; } }
        if (isctx && b == 0 && tid < 192) { const int mr = e * MOE_ROWS_E + 4160 + tid; rowmap[mr] = 0; gate[mr] = 0.f; }
        BAR_LDS();
    }
}


constexpr int SC_QI = 0, SC_KI = 16384, SC_KT = 32768, SC_VT = 49152, SC_PI = 65536, SC_SM = 73728, SC_PART = 106496, SC_VA = 110592, SC_VB = 111104, SC_VM = 111616, SC_RED = 112128;
__device__ __forceinline__ int st_off(int r, int cbytes, int ncs) { return ((r >> 4) * ncs + (cbytes >> 6)) * 1024 + (r & 15) * 64 + ((cbytes & 63) ^ ((r & 8) << 2)); }
__device__ __forceinline__ int st_lane(int fr, int fq) { return fr * 64 + ((fq * 16) ^ ((fr & 8) << 2)); }
struct ScanBufs { int kt, vt, part, va, vb, vm; };
__device__ __forceinline__ ScanBufs scan_bufs(int parity) { ScanBufs b; b.kt = parity ? SC_QI : SC_KT; b.vt = parity ? SC_KI : SC_VT; b.part = parity ? SC_PI : SC_PART; b.va = parity ? SC_PI + 4096 : SC_VA; b.vb = parity ? SC_PI + 4608 : SC_VB; b.vm = parity ? SC_PI + 5120 : SC_VM; return b; }

__device__ __forceinline__ bf16x8 ldfrag(const LAS unsigned char* img, int tile, int ks, int ncs, int lp) { return *(const LAS bf16x8*)(img + (tile * ncs + ks) * 1024 + lp); }
#define MFMA16(a, b, c) __builtin_amdgcn_mfma_f32_16x16x32_bf16((a), (b), (c), 0, 0, 0)
#ifndef SCAN_LOG2
__device__ __forceinline__ float ex2(float x) { return __builtin_amdgcn_exp2f(x * 1.4426950408889634f); }
#define LOG2E_ 1.0f
#else
__device__ __forceinline__ float ex2(float x) { return __builtin_amdgcn_exp2f(x); }
#define LOG2E_ 1.4426950408889634f
#endif

__device__ __forceinline__ void scan_write_T(LAS unsigned char* img, const unsigned (&d)[8], int cp, int to) {
    u32x4 wa, wb;
    wa.x = (d[0] & 0xffffu) | (d[1] << 16); wa.y = (d[2] & 0xffffu) | (d[3] << 16); wa.z = (d[4] & 0xffffu) | (d[5] << 16); wa.w = (d[6] & 0xffffu) | (d[7] << 16);
    wb.x = (d[0] >> 16) | (d[1] & 0xffff0000u); wb.y = (d[2] >> 16) | (d[3] & 0xffff0000u); wb.z = (d[4] >> 16) | (d[5] & 0xffff0000u); wb.w = (d[6] >> 16) | (d[7] & 0xffff0000u);
    *(LAS u32x4*)(img + st_off(2 * cp, to * 16, 2)) = wa; *(LAS u32x4*)(img + st_off(2 * cp + 1, to * 16, 2)) = wb;
}

template <bool FULL>
__device__ __forceinline__ void scan_estage_hg(LAS unsigned char* lds, const ScanBufs& B, const unsigned (&kraw)[8], const unsigned (&qraw)[8], const unsigned (&vraw)[8], int lane, int wave, float& la_out, float& lb_out) {
    const int cp = lane, to = wave;
#ifndef SCAN_LOG2
    constexpr float LS = 1.4426950408889634f;
#else
    constexpr float LS = 1.0f;
#endif
    f32x2 c2[8]; f32x2 r2 = {0.f, 0.f};
#pragma unroll
    for (int tt = 0; tt < 8; ++tt) { r2 += (f32x2){bf_lo(kraw[tt]), bf_hi(kraw[tt])}; c2[tt] = r2; }
    *(LAS f32x2*)(lds + B.part + (to * 128 + 2 * cp) * 4) = r2;
    BAR_LDS();
    f32x2 p2 = {0.f, 0.f}, m2 = {0.f, 0.f}, l2 = {0.f, 0.f};
#pragma unroll
    for (int t8 = 0; t8 < 8; ++t8) { const f32x2 pp = *(const LAS f32x2*)(lds + B.part + (t8 * 128 + 2 * cp) * 4);
        if (t8 < to) p2 += pp; if (t8 < 4) m2 += pp; l2 += pp; }
    p2 = (p2 - m2) * LS;
    unsigned kd[8];
#pragma unroll
    for (int tt = 0; tt < 8; ++tt) { const int rr = 8 * to + tt;
        f32x2 d2 = p2 + c2[tt] * LS;
        d2 = __builtin_elementwise_min(__builtin_elementwise_max(d2, (f32x2){-120.f, -120.f}), (f32x2){120.f, 120.f});
        const f32x2 lf2 = (f32x2){bf_lo(kraw[tt]), bf_hi(kraw[tt])} * LS;
        const f32x2 k2 = (f32x2){1.0f, 1.0f} - (f32x2){__builtin_amdgcn_exp2f(lf2.x), __builtin_amdgcn_exp2f(lf2.y)};
        const f32x2 kt2 = k2 * (f32x2){__builtin_amdgcn_exp2f(-d2.x), __builtin_amdgcn_exp2f(-d2.y)};
        kd[tt] = cvt_pk_bf16(kt2.x, kt2.y);
        if (FULL) { const f32x2 qt2 = (f32x2){bf_lo(qraw[tt]), bf_hi(qraw[tt])} * (f32x2){__builtin_amdgcn_exp2f(d2.x), __builtin_amdgcn_exp2f(d2.y)};
            *(LAS unsigned*)(lds + SC_QI + st_off(rr, cp * 4, 4)) = cvt_pk_bf16(qt2.x, qt2.y);
            *(LAS unsigned*)(lds + SC_KI + st_off(rr, cp * 4, 4)) = kd[tt]; } }
    scan_write_T(lds + B.kt, kd, cp, to); scan_write_T(lds + B.vt, vraw, cp, to);
    if (to == 0) { *(LAS f32x2*)(lds + B.va + 8 * cp) = (f32x2){ex2(l2.x), ex2(l2.y)}; *(LAS f32x2*)(lds + B.vb + 8 * cp) = (f32x2){ex2(l2.x - m2.x), ex2(l2.y - m2.y)};
        *(LAS f32x2*)(lds + B.vm + 8 * cp) = (f32x2){ex2(m2.x), ex2(m2.y)}; }
    la_out = l2.x; lb_out = l2.y;
}
template <bool FULL>
__device__ __forceinline__ void scan_estage_ret(LAS unsigned char* lds, const ScanBufs& B, const unsigned (&kraw)[8], const unsigned (&qraw)[8], const unsigned (&vraw)[8], int lane, int wave, float lg2) {
    const int cp = lane, to = wave; unsigned kd[8];
#pragma unroll
    for (int tt = 0; tt < 8; ++tt) { const int rr = 8 * to + tt; const float wk = ex2((float)(63 - rr) * lg2); kd[tt] = cvt_pk_bf16(bf_lo(kraw[tt]) * wk, bf_hi(kraw[tt]) * wk);
        if (FULL) { *(LAS unsigned*)(lds + SC_QI + st_off(rr, cp * 4, 4)) = qraw[tt]; *(LAS unsigned*)(lds + SC_KI + st_off(rr, cp * 4, 4)) = kraw[tt]; } }
    scan_write_T(lds + B.kt, kd, cp, to); scan_write_T(lds + B.vt, vraw, cp, to);
}

template <bool RET>
__device__ __forceinline__ void scan_state_update(LAS unsigned char* lds, const ScanBufs& B, f32x4 (&ST)[8], int wave, int fr, int fq, float g64) {
    const int lp = st_lane(fr, fq);
    const bf16x8 a0 = ldfrag(lds + B.kt, wave, 0, 2, lp), a1 = ldfrag(lds + B.kt, wave, 1, 2, lp);
    f32x4 av = {g64, g64, g64, g64}, bv = {1.f, 1.f, 1.f, 1.f};
    if (!RET) { av = *(const LAS f32x4*)(lds + B.va + (16 * wave + 4 * fq) * 4); bv = *(const LAS f32x4*)(lds + B.vb + (16 * wave + 4 * fq) * 4); }
#pragma unroll
    for (int vi = 0; vi < 8; ++vi) { const bf16x8 b0 = ldfrag(lds + B.vt, vi, 0, 2, lp), b1 = ldfrag(lds + B.vt, vi, 1, 2, lp);
        f32x4 u = {0.f, 0.f, 0.f, 0.f}; u = MFMA16(a0, b0, u); u = MFMA16(a1, b1, u); ST[vi] = RET ? (av * ST[vi] + u) : (av * ST[vi] + bv * u); }
}

#define SCAN_LOAD_CHUNK(crow_, dir_) do { _Pragma("unroll") for (int tt = 0; tt < 8; ++tt) { const int rr_ = 8 * wave + tt; const size_t ro_ = (size_t)((crow_) + ((dir_) ? 63 - rr_ : rr_)) * INW + 2 * lane; \
        kraw[tt] = *(const unsigned*)(P + ro_ + colk); vraw[tt] = *(const unsigned*)(P + ro_ + colv); if (LOADQ) qraw[tt] = *(const unsigned*)(P + ro_ + colq); } } while (0)
#define SCAN_STORE_STATE(slot_) do { _Pragma("unroll") for (int vi = 0; vi < 8; ++vi) { u32x2 w; w.x = cvt_pk_bf16(ST[vi][0], ST[vi][1]); w.y = cvt_pk_bf16(ST[vi][2], ST[vi][3]); \
        *(u32x2*)(UB + (size_t)(slot_) * 16384 + (size_t)(vi * 512 + tid) * 4) = w; } } while (0)

struct ScanPtrs { const bf16_t* P; const bf16_t* SB; bf16_t* UB; float* AB; bf16_t* MIX; float* OB; const float* rdec; const float* onorm; };

__device__ __forceinline__ void scan1_hg_A(LAS unsigned char* lds, const ScanBufs& B, const unsigned (&kraw)[8], f32x2 (&c2)[8], int lane, int wave) {
    f32x2 r2 = {0.f, 0.f};
#pragma unroll
    for (int tt = 0; tt < 8; ++tt) { r2 += (f32x2){bf_lo(kraw[tt]), bf_hi(kraw[tt])}; c2[tt] = r2; }
    *(LAS f32x2*)(lds + B.part + (wave * 128 + 2 * lane) * 4) = r2;
}
__device__ __forceinline__ void scan1_hg_B(LAS unsigned char* lds, const ScanBufs& B, const unsigned (&kraw)[8], const unsigned (&vraw)[8], const f32x2 (&c2)[8], int lane, int wave, float& la_out, float& lb_out) {
    const int cp = lane, to = wave;
#ifndef SCAN_LOG2
    constexpr float LS = 1.4426950408889634f;
#else
    constexpr float LS = 1.0f;
#endif
    f32x2 p2 = {0.f, 0.f}, m2 = {0.f, 0.f}, l2 = {0.f, 0.f};
#pragma unroll
    for (int t8 = 0; t8 < 8; ++t8) { const f32x2 pp = *(const LAS f32x2*)(lds + B.part + (t8 * 128 + 2 * cp) * 4);
        if (t8 < to) p2 += pp; if (t8 < 4) m2 += pp; l2 += pp; }
    p2 = (p2 - m2) * LS;
    unsigned kd[8];
#pragma unroll
    for (int tt = 0; tt < 8; ++tt) {
        f32x2 d2 = p2 + c2[tt] * LS;
        d2 = __builtin_elementwise_min(__builtin_elementwise_max(d2, (f32x2){-120.f, -120.f}), (f32x2){120.f, 120.f});
        const f32x2 lf2 = (f32x2){bf_lo(kraw[tt]), bf_hi(kraw[tt])} * LS;
        const f32x2 k2 = (f32x2){1.0f, 1.0f} - (f32x2){__builtin_amdgcn_exp2f(lf2.x), __builtin_amdgcn_exp2f(lf2.y)};
        const f32x2 kt2 = k2 * (f32x2){__builtin_amdgcn_exp2f(-d2.x), __builtin_amdgcn_exp2f(-d2.y)};
        kd[tt] = cvt_pk_bf16(kt2.x, kt2.y); }
    scan_write_T(lds + B.kt, kd, cp, to); scan_write_T(lds + B.vt, vraw, cp, to);
    if (to == 0) { *(LAS f32x2*)(lds + B.va + 8 * cp) = (f32x2){ex2(l2.x), ex2(l2.y)}; *(LAS f32x2*)(lds + B.vb + 8 * cp) = (f32x2){ex2(l2.x - m2.x), ex2(l2.y - m2.y)}; }
    la_out = l2.x; lb_out = l2.y;
}
template <bool RET>
__device__ __forceinline__ void scan1_item(const ScanPtrs& sp, LAS unsigned char* lds, int tid, int lane, int wave, int seq, int tb) {
    const bf16_t* P = sp.P; bf16_t* UB = sp.UB; const int fr = lane & 15, fq = lane >> 4;
    const int b = seq >> 4, hh = (seq >> 1) & 7, dir = seq & 1, h = hh & 3;
    const int colk = RET ? 6 * 512 + h * 128 : (dir ? 2 * 512 : 512) + h * 128, colv = (RET ? 7 * 512 : 3 * 512) + h * 128;
    const float lg2 = RET ? -expf(sp.rdec[dir * 4 + h]) * LOG2E_ : 0.f, g64 = ex2(64.f * lg2);
    const int rowbase = b * LTOT + tb * 256;
    f32x4 ST[8];
#pragma unroll
    for (int vi = 0; vi < 8; ++vi) ST[vi] = (f32x4){0.f, 0.f, 0.f, 0.f};
    float ata = 0.f, atb = 0.f; unsigned kr[3][8], vr[3][8], qdummy[8]; f32x2 c2[2][8];
#pragma unroll
    for (int tt = 0; tt < 8; ++tt) qdummy[tt] = 0u;
#define S1_LOAD(set_, ci_) do { const int crow_ = rowbase + (dir ? 3 - (ci_) : (ci_)) * 64; _Pragma("unroll") for (int tt = 0; tt < 8; ++tt) { const int rr_ = 8 * wave + tt; const size_t ro_ = (size_t)(crow_ + (dir ? 63 - rr_ : rr_)) * INW + 2 * lane; \
        kr[set_][tt] = *(const unsigned*)(P + ro_ + colk); vr[set_][tt] = *(const unsigned*)(P + ro_ + colv); } } while (0)
#define S1_A(ci_) do { if (!RET) scan1_hg_A(lds, scan_bufs((ci_) & 1), kr[(ci_) % 3], c2[(ci_) & 1], lane, wave); } while (0)
#define S1_B(ci_) do { const ScanBufs B_ = scan_bufs((ci_) & 1); if (RET) scan_estage_ret<false>(lds, B_, kr[(ci_) % 3], qdummy, vr[(ci_) % 3], lane, wave, lg2); \
        else { float la_, lb_; scan1_hg_B(lds, B_, kr[(ci_) % 3], vr[(ci_) % 3], c2[(ci_) & 1], lane, wave, la_, lb_); ata += la_; atb += lb_; } } while (0)
#define S1_U(ci_) scan_state_update<RET>(lds, scan_bufs((ci_) & 1), ST, wave, fr, fq, g64)
    S1_LOAD(0, 0); S1_LOAD(1, 1); S1_LOAD(2, 2);
    S1_A(0);                         BAR_LDS();
    S1_B(0); S1_LOAD(0, 3); S1_A(1); BAR_LDS();
    S1_U(0); S1_B(1); S1_A(2);       BAR_LDS();
    S1_U(1); S1_B(2); S1_A(3);       BAR_LDS();
    S1_U(2); S1_B(3);                BAR_LDS();
    S1_U(3);
#undef S1_LOAD
#undef S1_A
#undef S1_B
#undef S1_U
    const int slot = seq * 65 + tb;
    SCAN_STORE_STATE(slot);
    if (wave == 0) *(f32x2*)(sp.AB + (size_t)slot * 128 + 2 * lane) = RET ? (f32x2){ex2(256.f * lg2), ex2(256.f * lg2)} : (f32x2){ex2(ata), ex2(atb)};
}

template <bool RET>
__device__ __forceinline__ void scan3_item(const ScanPtrs& sp, LAS unsigned char* lds, int tid, int lane, int wave, int bh, int tb, bool store_state) {
#ifdef PROBE_SKIP
    if ((PROBE_SKIP == 1 && RET) || (PROBE_SKIP == 2 && !RET)) return;
#endif
    const bf16_t* P = sp.P; bf16_t* UB = sp.UB; float* OB = sp.OB;
    const int ti = wave & 3, vh = wave >> 2; constexpr bool LOADQ = true;
    const int b = bh >> 3, hh = bh & 7, h = hh & 3;
    const int colq = (RET ? 5 * 512 : 0) + h * 128, colv = (RET ? 7 * 512 : 3 * 512) + h * 128, colg = (RET ? 8 * 512 : 4 * 512) + h * 128, mixcol = hh * 128;
    const int rowbase = b * LTOT + tb * 256;
#pragma unroll 1
    for (int dir = 1; dir >= 0; --dir) {
        const int colk = RET ? 6 * 512 + h * 128 : (dir ? 2 * 512 : 512) + h * 128;
        const float lg2 = RET ? -expf(sp.rdec[dir * 4 + h]) * LOG2E_ : 0.f, g64 = ex2(64.f * lg2);
        f32x4 ST[8];
        if (tb == 0) {
#pragma unroll
            for (int vi = 0; vi < 8; ++vi) ST[vi] = (f32x4){0.f, 0.f, 0.f, 0.f};
        } else { const size_t slot = (size_t)(bh * 2 + dir) * 65 + tb;
#pragma unroll
            for (int vi = 0; vi < 8; ++vi) { const u32x2 w = *(const u32x2*)(sp.SB + slot * 16384 + (size_t)(vi * 512 + tid) * 4); ST[vi] = (f32x4){bf_lo(w.x), bf_hi(w.x), bf_lo(w.y), bf_hi(w.y)}; } }
        float ata = 0.f, atb = 0.f; unsigned kraw[8], qraw[8], vraw[8];
        SCAN_LOAD_CHUNK(rowbase + (dir ? 3 : 0) * 64, dir);
#pragma unroll 1
        for (int ci = 0; ci < 4; ++ci) {
            const int tc = dir ? 3 - ci : ci;
            int lane_ = lane; asm volatile("" : "+v"(lane_));
            const int fr = lane_ & 15, fq = lane_ >> 4, t = 16 * ti + fr; const float gt1 = ex2((float)(t + 1) * lg2);
            const ScanBufs B0 = scan_bufs(0);
            if (RET) scan_estage_ret<true>(lds, B0, kraw, qraw, vraw, lane, wave, lg2);
            else { float la, lb; scan_estage_hg<true>(lds, B0, kraw, qraw, vraw, lane, wave, la, lb); ata += la; atb += lb; }
#ifdef PROBE_S3_E2
            BAR_LDS();
            if (RET) scan_estage_ret<true>(lds, B0, kraw, qraw, vraw, lane, wave, lg2);
            else { float la, lb; scan_estage_hg<true>(lds, B0, kraw, qraw, vraw, lane, wave, la, lb); }
#endif
            if (ci < 3) { const int tcn = dir ? 2 - ci : ci + 1; SCAN_LOAD_CHUNK(rowbase + tcn * 64, dir); }
            const int tok = tc * 64 + (dir ? 63 - t : t), grow = rowbase + tok;
            u32x2 obv[4]; u32x2 gv[4];
            if (dir == 0) {
#pragma unroll
                for (int j = 0; j < 4; ++j) gv[j] = *(const u32x2*)(P + (size_t)grow * INW + colg + 16 * (4 * vh + j) + 4 * fq);
#pragma unroll
                for (int jp = 0; jp < 2; ++jp) { const u32x4 w4 = *((const u32x4*)OB + ((((tc * 4 + ti) * 2 + vh) * 2 + jp) * 64 + fq * 16 + fr)); obv[2 * jp] = (u32x2){w4.x, w4.y}; obv[2 * jp + 1] = (u32x2){w4.z, w4.w}; } }
            if (!RET) BAR_LDS();
            { f32x4 em = {1.f, 1.f, 1.f, 1.f}; if (!RET) em = *(const LAS f32x4*)(lds + SC_VM + (16 * wave + 4 * fq) * 4);
#pragma unroll
              for (int vi = 0; vi < 8; ++vi) { const f32x4 x = RET ? ST[vi] : ST[vi] * em; u32x2 w; w.x = cvt_pk_bf16(x[0], x[1]); w.y = cvt_pk_bf16(x[2], x[3]); *(LAS u32x2*)(lds + SC_SM + st_off(16 * vi + fr, 32 * wave + 8 * fq, 4)) = w; } }
            if (RET) BAR_LDS();
#pragma unroll
            for (int sii = 0; sii < 2; ++sii) { const int si = 2 * vh + sii; f32x4 sc = {0.f, 0.f, 0.f, 0.f};
                if (si <= ti) {
#pragma unroll
                    for (int ks = 0; ks < 4; ++ks) sc = MFMA16(ldfrag(lds + SC_KI, si, ks, 4, st_lane(fr, fq)), ldfrag(lds + SC_QI, ti, ks, 4, st_lane(fr, fq)), sc);
                    const int s0 = 16 * si + 4 * fq;
#pragma unroll
                    for (int r = 0; r < 4; ++r) { const float dm = RET ? ex2((float)(t - s0 - r) * lg2) : 1.0f; sc[r] = (s0 + r <= t) ? sc[r] * dm : 0.f; } }
                u32x2 w; w.x = cvt_pk_bf16(sc[0], sc[1]); w.y = cvt_pk_bf16(sc[2], sc[3]); *(LAS u32x2*)(lds + SC_PI + st_off(t, 32 * si + 8 * fq, 2)) = w; }
            BAR_LDS();
            f32x4 o[4];
#pragma unroll
            for (int j = 0; j < 4; ++j) o[j] = (f32x4){0.f, 0.f, 0.f, 0.f};
            {
                const int lp = st_lane(fr, fq);
                const LAS unsigned char* pq = lds + SC_QI + (ti * 4) * 1024 + lp;
                const LAS unsigned char* pm = lds + SC_SM + (4 * vh * 4) * 1024 + lp;
                const LAS unsigned char* pp = lds + SC_PI + (ti * 2) * 1024 + lp;
                const LAS unsigned char* pv = lds + SC_VT + (4 * vh * 2) * 1024 + lp;
                const LAS unsigned char* pk = lds + SC_KT + (wave * 2) * 1024 + lp;
                const LAS unsigned char* pw = lds + SC_VT + lp;
                f32x4 av = {g64, g64, g64, g64}, bv = {1.f, 1.f, 1.f, 1.f};
                if (!RET) { av = *(const LAS f32x4*)(lds + SC_VA + (16 * wave + 4 * fq) * 4); bv = *(const LAS f32x4*)(lds + SC_VB + (16 * wave + 4 * fq) * 4); }
#define SC_LD(p_, off_) (*(const LAS bf16x8*)((p_) + (off_)))
#define SC_FENCE() __builtin_amdgcn_sched_barrier(0)
                bf16x8 qa, ma[4], qb, mb[4], qc, mc[4];
                qa = SC_LD(pq, 0); _Pragma("unroll") for (int j = 0; j < 4; ++j) ma[j] = SC_LD(pm, 4096 * j);
                qb = SC_LD(pq, 1024); _Pragma("unroll") for (int j = 0; j < 4; ++j) mb[j] = SC_LD(pm, 4096 * j + 1024);
                SC_FENCE();
                qc = SC_LD(pq, 2048); _Pragma("unroll") for (int j = 0; j < 4; ++j) mc[j] = SC_LD(pm, 4096 * j + 2048);
                _Pragma("unroll") for (int j = 0; j < 4; ++j) o[j] = MFMA16(ma[j], qa, o[j]);
                SC_FENCE();
                qa = SC_LD(pq, 3072); _Pragma("unroll") for (int j = 0; j < 4; ++j) ma[j] = SC_LD(pm, 4096 * j + 3072);
                _Pragma("unroll") for (int j = 0; j < 4; ++j) o[j] = MFMA16(mb[j], qb, o[j]);
                SC_FENCE();
                qb = SC_LD(pp, 0); _Pragma("unroll") for (int j = 0; j < 4; ++j) mb[j] = SC_LD(pv, 2048 * j);
                _Pragma("unroll") for (int j = 0; j < 4; ++j) o[j] = MFMA16(mc[j], qc, o[j]);
                SC_FENCE();
                qc = SC_LD(pp, 1024); _Pragma("unroll") for (int j = 0; j < 4; ++j) mc[j] = SC_LD(pv, 2048 * j + 1024);
                _Pragma("unroll") for (int j = 0; j < 4; ++j) o[j] = MFMA16(ma[j], qa, o[j]);
                SC_FENCE();
                if (RET) { _Pragma("unroll") for (int j = 0; j < 4; ++j) o[j] *= gt1; }
                bf16x8 k0 = SC_LD(pk, 0), k1 = SC_LD(pk, 1024), w0[4], w1[4];
                _Pragma("unroll") for (int q = 0; q < 2; ++q) { w0[q] = SC_LD(pw, 2048 * q); w1[q] = SC_LD(pw, 2048 * q + 1024); }
                _Pragma("unroll") for (int j = 0; j < 4; ++j) o[j] = MFMA16(mb[j], qb, o[j]);
                SC_FENCE();
                _Pragma("unroll") for (int q = 2; q < 4; ++q) { w0[q] = SC_LD(pw, 2048 * q); w1[q] = SC_LD(pw, 2048 * q + 1024); }
                _Pragma("unroll") for (int j = 0; j < 4; ++j) o[j] = MFMA16(mc[j], qc, o[j]);
                SC_FENCE();
                bf16x8 x0[4], x1[4];
                _Pragma("unroll") for (int q = 0; q < 4; ++q) { x0[q] = SC_LD(pw, 2048 * (4 + q)); x1[q] = SC_LD(pw, 2048 * (4 + q) + 1024); }
                _Pragma("unroll") for (int q = 0; q < 4; ++q) { f32x4 u = {0.f, 0.f, 0.f, 0.f}; u = MFMA16(k0, w0[q], u); u = MFMA16(k1, w1[q], u); ST[q] = RET ? (av * ST[q] + u) : (av * ST[q] + bv * u); }
                SC_FENCE();
                _Pragma("unroll") for (int q = 0; q < 4; ++q) { f32x4 u = {0.f, 0.f, 0.f, 0.f}; u = MFMA16(k0, x0[q], u); u = MFMA16(k1, x1[q], u); ST[4 + q] = RET ? (av * ST[4 + q] + u) : (av * ST[4 + q] + bv * u); }
#undef SC_LD
#undef SC_FENCE
            }
            if (dir == 1) {
#pragma unroll
                for (int jp = 0; jp < 2; ++jp) { u32x4 w4; w4.x = cvt_pk_bf16(o[2 * jp][0], o[2 * jp][1]); w4.y = cvt_pk_bf16(o[2 * jp][2], o[2 * jp][3]); w4.z = cvt_pk_bf16(o[2 * jp + 1][0], o[2 * jp + 1][1]); w4.w = cvt_pk_bf16(o[2 * jp + 1][2], o[2 * jp + 1][3]); *((u32x4*)OB + ((((tc * 4 + (3 - ti)) * 2 + vh) * 2 + jp) * 64 + fq * 16 + (15 - fr))) = w4; }
                BAR_LDS();
            } else {
                float ss = 0.f;
#pragma unroll
                for (int j = 0; j < 4; ++j) { o[j] += (f32x4){bf_lo(obv[j].x), bf_hi(obv[j].x), bf_lo(obv[j].y), bf_hi(obv[j].y)}; ss += (o[j][0] * o[j][0] + o[j][1] * o[j][1]) + (o[j][2] * o[j][2] + o[j][3] * o[j][3]); }
                ss += shx(ss, 16, lane_); ss += shx(ss, 32, lane_);
                if (fq == 0) *(LAS float*)(lds + SC_RED + ((ci & 1) * 128 + vh * 64 + t) * 4) = ss;
                BAR_LDS();
                const float tot = ss + *(const LAS float*)(lds + SC_RED + ((ci & 1) * 128 + (vh ^ 1) * 64 + t) * 4);
                const float rinv = __builtin_amdgcn_rsqf(tot * (1.0f / 128.0f) + EPS);
#pragma unroll
                for (int j = 0; j < 4; ++j) { const f32x4 onv = RET ? (f32x4){1.f, 1.f, 1.f, 1.f} : *(const f32x4*)(sp.onorm + 16 * (4 * vh + j) + 4 * fq);
                    const f32x4 y = o[j] * rinv * onv * (f32x4){bf_lo(gv[j].x), bf_hi(gv[j].x), bf_lo(gv[j].y), bf_hi(gv[j].y)};
                    u32x2 w; w.x = cvt_pk_bf16(y[0], y[1]); w.y = cvt_pk_bf16(y[2], y[3]); *(u32x2*)(sp.MIX + (size_t)grow * D + mixcol + 16 * (4 * vh + j) + 4 * fq) = w; }
#ifdef PROBE_BAR
                BAR_LDS();
#endif
            }
        }
        if (store_state) { const int slot = (bh * 2 + dir) * 65 + tb; SCAN_STORE_STATE(slot);
            if (wave == 0) *(f32x2*)(sp.AB + (size_t)slot * 128 + 2 * lane) = RET ? (f32x2){ex2(256.f * lg2), ex2(256.f * lg2)} : (f32x2){ex2(ata), ex2(atb)}; }
        BAR_ALL();
    }
}

__device__ __forceinline__ ScanPtrs scan_ptrs(const Ctx& a, int l) {
    unsigned char* ws = a.ws(); ScanPtrs sp; sp.P = (const bf16_t*)(ws + WS_P); sp.SB = (const bf16_t*)(ws + WS_SB); sp.UB = (bf16_t*)(ws + WS_UB); sp.AB = (float*)(ws + WS_AB); sp.MIX = (bf16_t*)(ws + WS_MIX);
    sp.OB = (float*)(ws + WS_OB) + (size_t)blockIdx.x * 16384; sp.rdec = a.in(I_RDEC) + l * 8; sp.onorm = a.in(I_ONORM) + l * 128; return sp;
}

constexpr int SW_KT = 0, SW_VT = 65536, SW_PART = 131072;
struct S1Id { int seq, tb; };
__device__ __forceinline__ void scan_write_T8(LAS unsigned char* img, const unsigned (&d)[8], int cp, int tg) {
    u32x4 wa, wb;
    wa.x = (d[0] & 0xffffu) | (d[1] << 16); wa.y = (d[2] & 0xffffu) | (d[3] << 16); wa.z = (d[4] & 0xffffu) | (d[5] << 16); wa.w = (d[6] & 0xffffu) | (d[7] << 16);
    wb.x = (d[0] >> 16) | (d[1] & 0xffff0000u); wb.y = (d[2] >> 16) | (d[3] & 0xffff0000u); wb.z = (d[4] >> 16) | (d[5] & 0xffff0000u); wb.w = (d[6] >> 16) | (d[7] & 0xffff0000u);
    *(LAS u32x4*)(img + st_off(2 * cp, tg * 16, 8)) = wa; *(LAS u32x4*)(img + st_off(2 * cp + 1, tg * 16, 8)) = wb;
}
#define S1W_LOAD(id_) do { const int seq_ = (id_).seq, hh_ = (seq_ >> 1) & 7, dir_ = seq_ & 1, h_ = hh_ & 3; const bool ret_ = hh_ >= 4; \
        const int colk_ = ret_ ? 6 * 512 + h_ * 128 : (dir_ ? 2 * 512 : 512) + h_ * 128, colv_ = (ret_ ? 7 * 512 : 3 * 512) + h_ * 128; \
        const int row0_ = (seq_ >> 4) * LTOT + (id_).tb * 256; int ln_ = lane; asm volatile("" : "+v"(ln_)); \
        _Pragma("unroll") for (int i = 0; i < 32; ++i) { const int p_ = 32 * wave + i; const size_t ro_ = (size_t)(row0_ + (dir_ ? 255 - p_ : p_)) * INW + 2 * ln_; \
            kr[i] = *(const unsigned*)(sp.P + ro_ + colk_); vr[i] = *(const unsigned*)(sp.P + ro_ + colv_); } } while (0)
__device__ __forceinline__ void scan1w_item(const ScanPtrs& sp, LAS unsigned char* lds, int lane, int wave, const S1Id id, unsigned (&kr)[32], unsigned (&vr)[32], bool have_next, const S1Id nxt) {
    asm volatile("" : "+v"(lane), "+s"(wave)); const int tid = wave * 64 + lane;
    bf16_t* UB = sp.UB; const int fr = lane & 15, fq = lane >> 4;
    const int seq = id.seq, tb = id.tb, hh = (seq >> 1) & 7, dir = seq & 1, h = hh & 3; const bool RET = hh >= 4;
    const float lg2 = RET ? -expf(sp.rdec[dir * 4 + h]) * LOG2E_ : 0.f;
#ifndef SCAN_LOG2
    constexpr float LS = 1.4426950408889634f;
#else
    constexpr float LS = 1.0f;
#endif
    if (!RET) { f32x2 t2 = {0.f, 0.f};
#pragma unroll
        for (int i = 0; i < 32; ++i) t2 += (f32x2){bf_lo(kr[i]), bf_hi(kr[i])};
        *(LAS f32x2*)(lds + SW_PART + (wave * 64 + lane) * 8) = t2; }
    BAR_LDS();
    f32x2 pw = {0.f, 0.f}, T2 = {0.f, 0.f};
    if (!RET) {
#pragma unroll
        for (int w8 = 0; w8 < 8; ++w8) { const f32x2 pp = *(const LAS f32x2*)(lds + SW_PART + (w8 * 64 + lane) * 8); if (w8 < wave) pw += pp; T2 += pp; } }
    f32x2 r2 = pw;
#pragma unroll
    for (int g = 0; g < 4; ++g) { unsigned kd[8], vv[8];
#pragma unroll
        for (int tt = 0; tt < 8; ++tt) { const int i = 8 * g + tt; vv[tt] = vr[i];
            if (RET) { const float wk = ex2((float)(255 - (32 * wave + i)) * lg2); kd[tt] = cvt_pk_bf16(bf_lo(kr[i]) * wk, bf_hi(kr[i]) * wk); }
            else { const f32x2 lf = {bf_lo(kr[i]), bf_hi(kr[i])}; r2 += lf;
                f32x2 d2 = (T2 - r2) * LS; d2 = __builtin_elementwise_max(d2, (f32x2){-120.f, -120.f});
                const f32x2 lf2 = lf * LS; const f32x2 k2 = (f32x2){1.0f, 1.0f} - (f32x2){__builtin_amdgcn_exp2f(lf2.x), __builtin_amdgcn_exp2f(lf2.y)};
                const f32x2 kt2 = k2 * (f32x2){__builtin_amdgcn_exp2f(d2.x), __builtin_amdgcn_exp2f(d2.y)}; kd[tt] = cvt_pk_bf16(kt2.x, kt2.y); } }
        scan_write_T8(lds + SW_KT, kd, lane, 4 * wave + g); scan_write_T8(lds + SW_VT, vv, lane, 4 * wave + g); }
    if (have_next) S1W_LOAD(nxt);
    BAR_LDS();
    f32x4 ST[8];
#pragma unroll
    for (int vi = 0; vi < 8; ++vi) ST[vi] = (f32x4){0.f, 0.f, 0.f, 0.f};
    { const int lp = st_lane(fr, fq);
#pragma unroll
      for (int ks = 0; ks < 8; ++ks) { const bf16x8 af = ldfrag(lds + SW_KT, wave, ks, 8, lp);
#pragma unroll
          for (int vi = 0; vi < 8; ++vi) ST[vi] = MFMA16(af, ldfrag(lds + SW_VT, vi, ks, 8, lp), ST[vi]);
          if (ks & 1) __builtin_amdgcn_sched_barrier(0); } }
    const int slot = seq * 65 + tb;
    SCAN_STORE_STATE(slot);
    if (wave == 0) *(f32x2*)(sp.AB + (size_t)slot * 128 + 2 * lane) = RET ? (f32x2){ex2(256.f * lg2), ex2(256.f * lg2)} : (f32x2){ex2(T2.x), ex2(T2.y)};
}
__device__ __forceinline__ bool s1_enum(bool modeA, bool last, int c, int G, int& k, S1Id& id) {
    constexpr int HS = 7;
    for (;; ++k) {
        if (modeA) { const int it = c + k * G; if (it >= 2048) return false; const int seq = it >> 6, j = it & 63; if (!last && j == 0) continue;
            id.seq = seq; id.tb = (seq & 1) ? (j == 0 ? 0 : 65 - j) : j; ++k; return true; }
        const int li = k < HS ? k * (G - 16) + (c - 16) : HS * (G - 16) + (k - HS) * G + c;
        if (li >= 2016) return false;
        const int seq = li / 63, j = 1 + li % 63; id.seq = seq; id.tb = (seq & 1) ? 65 - j : j; ++k; return true; }
}

__device__ __forceinline__ void scan1_phase(const Ctx& a, int l) {
    PHASE_IDS(); LAS unsigned char* lds = launder_lds(a.lds); const ScanPtrs sp = scan_ptrs(a, l);
#ifdef PROBE_NOMERGE
    const bool last = true; const int c = blockIdx.x, G = gridDim.x;
#else
    const bool last = (l == DEPTH - 1); const int c = blockIdx.x, G = gridDim.x;
#endif
#ifdef S1_WIDE
    { const bool modeA = last || G < 32;
      if (!last) { if (modeA) { for (int bh = c; bh < 16; bh += G) { if ((bh & 7) >= 4) scan3_item<true>(sp, lds, tid, lane, wave, bh, 0, true); else scan3_item<false>(sp, lds, tid, lane, wave, bh, 0, true); } }
                   else if (c < 16) { if ((c & 7) >= 4) scan3_item<true>(sp, lds, tid, lane, wave, c, 0, true); else scan3_item<false>(sp, lds, tid, lane, wave, c, 0, true); } }
      int k = (!modeA && c < 16) ? 7 : 0; S1Id id, nx; unsigned kr[32], vr[32];
      bool have = s1_enum(modeA, last, c, G, k, id);
      if (have) S1W_LOAD(id);
      while (have) { nx = id; const bool have2 = s1_enum(modeA, last, c, G, k, nx);
          scan1w_item(sp, lds, lane, wave, id, kr, vr, have2, nx);
          have = have2; id = nx; }
      BAR_LDS();
      return; }
#endif
    if (last || G < 32) {
        if (!last) for (int bh = c; bh < 16; bh += G) { if ((bh & 7) >= 4) scan3_item<true>(sp, lds, tid, lane, wave, bh, 0, true); else scan3_item<false>(sp, lds, tid, lane, wave, bh, 0, true); }
        for (int it = c; it < 2048; it += G) { const int seq = it >> 6, j = it & 63; if (!last && j == 0) continue; const int dir = seq & 1, tb = dir ? (j == 0 ? 0 : 65 - j) : j;
            if (((seq >> 1) & 7) >= 4) scan1_item<true>(sp, lds, tid, lane, wave, seq, tb); else scan1_item<false>(sp, lds, tid, lane, wave, seq, tb); }
        return;
    }
    if (c < 16) { if ((c & 7) >= 4) scan3_item<true>(sp, lds, tid, lane, wave, c, 0, true); else scan3_item<false>(sp, lds, tid, lane, wave, c, 0, true); }
    constexpr int HS = 7;
    for (int k = (c < 16 ? HS : 0);; ++k) {
        const int li = k < HS ? k * (G - 16) + (c - 16) : HS * (G - 16) + (k - HS) * G + c;
        if (li >= 2016) break;
        const int seq = li / 63, j = 1 + li % 63, dir = seq & 1, tb = dir ? 65 - j : j;
        if (((seq >> 1) & 7) >= 4) scan1_item<true>(sp, lds, tid, lane, wave, seq, tb); else scan1_item<false>(sp, lds, tid, lane, wave, seq, tb);
    }
}

__device__ __forceinline__ void scan2_phase(const Ctx& a) {
    PHASE_IDS(); unsigned char* ws = a.ws(); const bf16_t* UB = (const bf16_t*)(ws + WS_UB); bf16_t* SB = (bf16_t*)(ws + WS_SB); const float* AB = (const float*)(ws + WS_AB);
    const int c0 = 16 * (tid >> 6) + 4 * ((tid >> 4) & 3);
    for (int p = blockIdx.x; p < 256; p += gridDim.x) { const int seq = p >> 3, vi = p & 7, dir = seq & 1; const size_t eo = (size_t)(vi * 512 + tid) * 4;
        f32x4 s = {0.f, 0.f, 0.f, 0.f};
#define S2_SLOT(j_) ((size_t)seq * 65 + (dir ? ((j_) == 0 ? 0 : 65 - (j_)) : (j_)))
#define S2_LOAD(u_, av_, j0_) do { _Pragma("unroll") for (int q = 0; q < 8; ++q) { const size_t slot = S2_SLOT((j0_) + q); u_[q] = *(const u32x2*)(UB + slot * 16384 + eo); av_[q] = *(const f32x4*)(AB + slot * 128 + c0); } } while (0)
#define S2_STEP(u_, av_, j0_) do { _Pragma("unroll") for (int q = 0; q < 8; ++q) { const size_t slot = S2_SLOT((j0_) + q); \
            u32x2 w; w.x = cvt_pk_bf16(s[0], s[1]); w.y = cvt_pk_bf16(s[2], s[3]); *(u32x2*)(SB + slot * 16384 + eo) = w; \
            s = av_[q] * s + (f32x4){bf_lo(u_[q].x), bf_hi(u_[q].x), bf_lo(u_[q].y), bf_hi(u_[q].y)}; } } while (0)
        u32x2 ua[8], ub[8]; f32x4 aa[8], ab[8];
        S2_LOAD(ua, aa, 0);
#pragma unroll 1
        for (int j0 = 0; j0 < 64; j0 += 16) {
            S2_LOAD(ub, ab, j0 + 8);
            S2_STEP(ua, aa, j0);
            if (j0 + 16 < 64) S2_LOAD(ua, aa, j0 + 16);
            S2_STEP(ub, ab, j0 + 8); }
        { const size_t slot = (size_t)seq * 65 + (dir ? 1 : 64); u32x2 w; w.x = cvt_pk_bf16(s[0], s[1]); w.y = cvt_pk_bf16(s[2], s[3]); *(u32x2*)(SB + slot * 16384 + eo) = w; }
#undef S2_SLOT
#undef S2_LOAD
#undef S2_STEP
    }
}

__device__ __forceinline__ void scan3_phase(const Ctx& a, int l) {
    PHASE_IDS(); LAS unsigned char* lds = launder_lds(a.lds); const ScanPtrs sp = scan_ptrs(a, l);
#ifdef SCAN_PRIO
    if (wave >= 4) __builtin_amdgcn_s_setprio(1);
#endif
#ifdef PROBE_NOMERGE
    if (l != DEPTH - 1) for (int bh = blockIdx.x; bh < 16; bh += gridDim.x) { if ((bh & 7) >= 4) scan3_item<true>(sp, lds, tid, lane, wave, bh, 0, false); else scan3_item<false>(sp, lds, tid, lane, wave, bh, 0, false); }
#endif
    for (int it = blockIdx.x; it < 1024; it += gridDim.x) { const int bh = it >> 6, tb = 1 + (it & 63);
        if ((bh & 7) >= 4) scan3_item<true>(sp, lds, tid, lane, wave, bh, tb, false); else scan3_item<false>(sp, lds, tid, lane, wave, bh, tb, false); }
#ifdef SCAN_PRIO
    __builtin_amdgcn_s_setprio(0);
#endif
}

struct OutOrder {
    static constexpr bool PADTILES = false;
    __device__ __forceinline__ bool half_rows(const pg8::Unit&) const { return false; }
    int nrt, skipctx, G, c;
    __device__ __forceinline__ bool next(int i, pg8::Unit& u) const {
        const int L = i * G + c; if (L >= nrt * 4) return false;
        const int r = L >> 2; u.pn = L & 3; u.pm = skipctx ? r + 1 + (r >= 64 ? 1 : 0) : r; return true;
    }
    __device__ __forceinline__ void a_ready(const pg8::Unit&) const {}
    __device__ __forceinline__ void done(const pg8::Unit&) const {}
};

#ifndef PH
#define PH 0xffff
#endif
#ifndef DBL
#define DBL 0
#endif
__global__ void __launch_bounds__(512, 2) mega_fwd(Args a) {
    extern __shared__ __attribute__((aligned(16))) unsigned char lds_raw[];
    LAS unsigned char* lds = (LAS unsigned char*)lds_raw;
    const int tid = threadIdx.x;
    const int G = gridDim.x; const int bx = blockIdx.x; const int vcu = (G % 8 == 0) ? (bx % 8) * (G / 8) + bx / 8 : bx;
    volatile LAS unsigned* MISC = (volatile LAS unsigned*)(lds + MISC_OFF);
    if (tid < 16) MISC[tid] = 0u;
    if (tid == 0) { LAS unsigned long long* pt = (LAS unsigned long long*)(lds + PTR_OFF);
#pragma unroll
        for (int i = 0; i < 18; ++i) pt[i] = (unsigned long long)a.in[i];
        pt[18] = (unsigned long long)a.out; pt[19] = (unsigned long long)a.ws; }
    __syncthreads();
    const Ctx cx{lds, __builtin_amdgcn_readfirstlane(tid >> 6)};
    XcdBarrier bar = xcd_barrier_post((unsigned*)(cx.ws() + WS_CTL) + 1024, MISC + 8);
#define GRID_BAR() do { XcdBarrier b2_ = bar; asm volatile("" : "+s"(b2_.x)); xcd_barrier(b2_); } while (0)

#if PH & 1
    p0_prologue(cx);
#endif
    GRID_BAR();
#if DBL & 1
    p0_prologue(cx);
    GRID_BAR();
#endif
#if PH & 1
    p0_finalize(cx);
#endif
    GRID_BAR();

#pragma unroll 1
    for (int l = 0; l < DEPTH; ++l) {
        const bool last = (l == DEPTH - 1); unsigned char* ws = cx.ws();
#ifdef PROBE_NOBG
        const bool bgc = false;
#else
        const bool bgc = (G == 256);
#endif

#if DBL & 64
        norm1_phase<2>(cx, l);
        GRID_BAR();
#endif
#if PH & 2
        norm1_phase<0>(cx, l);
#endif
        GRID_BAR();
#ifdef G1_SPLIT
        const int g1k = (bgc && bx >= 36) ? ((bx >> 3) % 5) : 0;
        if (g1k > 0) cvt_tail(cx, CVT_N0 + l * CVT_CYC, bx - 36, 4, 0, g1k);
#endif
#if PH & 4
        {
#ifdef G1_F8
            pg8::Gemm g{(const bf16_t*)(ws + WS_H), (const bf16_t*)(ws + WS_WIN + (size_t)l * INW * D), MROWS, INW, D, cx.w0};
            pg8::StaticOrder S; S.init(MROWS, INW, G, bx);
            pg8::EpiIn8 E{(bf16_t*)(ws + WS_P), (const float*)(ws + WS_LBS) + l * 512, (const float*)(ws + WS_ROPE)};
            pg8::gemm_phase_f8<pg8::EpiIn8, pg8::StaticOrder, false>(launder_lds(lds), g, S, E, nullptr);
#else
            pg8::Gemm g{(const bf16_t*)(ws + WS_H), (const bf16_t*)(ws + WS_WIN) + (size_t)l * INW * D, MROWS, INW, D, cx.w0};
            pg8::StaticOrder S; S.init(MROWS, INW, G, bx);
            pg8::EpiIn E{(bf16_t*)(ws + WS_P), (const float*)(ws + WS_LBS) + l * 512, (const float*)(ws + WS_ROPE)};
#ifdef STAGGER_G1
            { const unsigned long long t0_ = __builtin_amdgcn_s_memrealtime(); const unsigned long long d_ = (unsigned long long)((bx >> 3) & 3) * STAGGER_G1; while (__builtin_amdgcn_s_memrealtime() - t0_ < d_) __builtin_amdgcn_s_sleep(8); }
#endif
            pg8::gemm_phase<pg8::EpiIn, pg8::StaticOrder, true, true>(launder_lds(lds), g, S, E);
#endif
        }
#endif
#if DBL & 1024
        GRID_BAR();
        {
            pg8::Gemm g{(const bf16_t*)(ws + WS_H), (const bf16_t*)(ws + WS_WIN) + (size_t)l * INW * D, MROWS, INW, D, cx.w0};
            pg8::StaticOrder S; S.init(MROWS, INW, G, bx);
            pg8::EpiNull E{(float*)(ws + WS_OB)};
            pg8::gemm_phase<pg8::EpiNull, pg8::StaticOrder, true, true>(launder_lds(lds), g, S, E);
        }
#endif
#if DBL & 16384
        GRID_BAR();
        {
            pg8::Gemm g{(const bf16_t*)(ws + WS_H), (const bf16_t*)(ws + WS_WIN) + (size_t)l * INW * D, MROWS, INW, D, cx.w0};
            pg8::StaticOrder S; S.init(MROWS, INW, G, bx);
            pg8::EpiInT<true> E{(bf16_t*)(ws + WS_YS), (const float*)(ws + WS_LBS) + l * 512, (const float*)(ws + WS_ROPE)};
            pg8::gemm_phase<pg8::EpiInT<true>, pg8::StaticOrder, true, true>(launder_lds(lds), g, S, E);
        }
#endif
#if DBL & 128
        GRID_BAR();
        {
            pg8::Gemm g{(const bf16_t*)(ws + WS_H), (const bf16_t*)(ws + WS_WIN) + (size_t)l * INW * D, MROWS, INW, D, cx.w0};
            pg8::StaticOrder S; S.init(MROWS, INW, G, bx);
            pg8::EpiIn E{(bf16_t*)(ws + WS_P), (const float*)(ws + WS_LBS) + l * 512, (const float*)(ws + WS_ROPE)};
            pg8::gemm_phase<pg8::EpiIn, pg8::StaticOrder, true, true>(launder_lds(lds), g, S, E);
        }
#endif
#ifdef G1_SPLIT
        if (bgc && bx >= 36) cvt_tail(cx, CVT_N0 + l * CVT_CYC, bx - 36, 4, g1k, 4);
#else
        if (bgc && bx >= 36) cvt_tail<4>(cx, CVT_N0 + l * CVT_CYC, bx - 36);
#endif
#ifdef DBLCVT
        if (bgc && bx >= 36) cvt_tail<4>(cx, CVT_N0 + l * CVT_CYC, bx - 36);
#endif
        GRID_BAR();
#if DBL & 8192
#pragma unroll 1
        for (int xb = 0; xb < 10; ++xb) GRID_BAR();
#endif
#if PH & 8
        scan1_phase(cx, l);
#endif
        GRID_BAR();
#if PH & 16
        scan2_phase(cx);
#endif
        GRID_BAR();
#if PH & 32
        scan3_phase(cx, l);
#endif
        GRID_BAR();
#if DBL & 2
        scan1_phase(cx, l);
        GRID_BAR();
        scan2_phase(cx);
        GRID_BAR();
        scan3_phase(cx, l);
        GRID_BAR();
#endif
#if DBL & 8
        scan1_phase(cx, l);
        GRID_BAR();
#endif
#if DBL & 16
        scan2_phase(cx);
        GRID_BAR();
#endif
#if DBL & 32
        scan3_phase(cx, l);
        GRID_BAR();
#endif
#if PH & 64
        {
#ifdef G2_F8
            pg8::Gemm g{(const bf16_t*)(ws + WS_MIX), (const bf16_t*)(ws + WS_WOUT + (size_t)l * D * D), MROWS, D, D, cx.w0};
            OutOrder S{last ? 128 : 130, last ? 1 : 0, G, vcu};
            pg8::EpiOut8 E{(bf16_t*)(ws + WS_X), l == 0 ? cx.in(I_X) : nullptr, l == 0 ? cx.in(I_CTX) : nullptr, (const float*)(ws + WS_MODS) + (size_t)(l * 3) * 6144 + 2 * D};
            pg8::gemm_phase_f8<pg8::EpiOut8, OutOrder, false>(launder_lds(lds), g, S, E, nullptr);
#else
            pg8::Gemm g{(const bf16_t*)(ws + WS_MIX), (const bf16_t*)(ws + WS_WOUT) + (size_t)l * D * D, MROWS, D, D, cx.w0};
            OutOrder S{last ? 128 : 130, last ? 1 : 0, G, vcu};
            pg8::EpiOut E{(bf16_t*)(ws + WS_X), l == 0 ? cx.in(I_X) : nullptr, l == 0 ? cx.in(I_CTX) : nullptr, (const float*)(ws + WS_MODS) + (size_t)(l * 3) * 6144 + 2 * D};
            pg8::gemm_phase<pg8::EpiOut, OutOrder, true, true>(launder_lds(lds), g, S, E);
#endif
        }
#endif
        if (bgc && !last && vcu >= 8) cvt_tail<4>(cx, CVT_N0 + l * CVT_CYC + CVT_G1, vcu - 8);
#ifdef DBLCVT
        if (bgc && !last && vcu >= 8) cvt_tail<4>(cx, CVT_N0 + l * CVT_CYC + CVT_G1, vcu - 8);
#endif
        GRID_BAR();
#if PH & 128
        norm2_phase(cx, l);
#endif
        GRID_BAR();
#if DBL & 4
        norm2_phase(cx, l);
        GRID_BAR();
#endif
#if PH & 256
        topk_phase(cx, l);
#endif
        if (bgc && bx >= 64) cvt_tail<3>(cx, CVT_N0 + l * CVT_CYC + CVT_G1 + (last ? 0 : CVT_G2), bx - 64);
#ifdef DBLCVT
        if (bgc && bx >= 64) cvt_tail<3>(cx, CVT_N0 + l * CVT_CYC + CVT_G1 + (last ? 0 : CVT_G2), bx - 64);
#endif
        GRID_BAR();
#if DBL & 2048
        topk_phase(cx, l);
        GRID_BAR();
#endif
#if PH & 1024
        {
            pg8::Gemm g{(const bf16_t*)(ws + WS_H), (const bf16_t*)(ws + WS_WGU + (size_t)l * 65536 * D), MOE_ROWS, 65536, D, cx.w0};
            pg8::MoeOrder S{last ? 16 : 17, 16, G, vcu};
            pg8::EpiGU E{(unsigned char*)(ws + WS_HID)};
            pg8::gemm_phase_f8<pg8::EpiGU, pg8::MoeOrder, true>(launder_lds(lds), g, S, E, (const int*)(ws + WS_ROWMAP));
        }
#endif
#if DBL & 4096
        GRID_BAR();
        {
            pg8::Gemm g{(const bf16_t*)(ws + WS_H), (const bf16_t*)(ws + WS_WGU + (size_t)l * 65536 * D), MOE_ROWS, 65536, D, cx.w0};
            pg8::MoeOrder S{last ? 16 : 17, 16, G, vcu};
            pg8::EpiNull E{(float*)(ws + WS_OB)};
            pg8::gemm_phase_f8<pg8::EpiNull, pg8::MoeOrder, true>(launder_lds(lds), g, S, E, (const int*)(ws + WS_ROWMAP));
        }
#endif
#if DBL & 256
        GRID_BAR();
        {
            pg8::Gemm g{(const bf16_t*)(ws + WS_H), (const bf16_t*)(ws + WS_WGU + (size_t)l * 65536 * D), MOE_ROWS, 65536, D, cx.w0};
            pg8::MoeOrder S{last ? 16 : 17, 16, G, vcu};
            pg8::EpiGU E{(unsigned char*)(ws + WS_HID)};
            pg8::gemm_phase_f8<pg8::EpiGU, pg8::MoeOrder, true>(launder_lds(lds), g, S, E, (const int*)(ws + WS_ROWMAP));
        }
#endif
        GRID_BAR();
#if PH & 2048
        {
            pg8::Gemm g{(const bf16_t*)(ws + WS_HID), (const bf16_t*)(ws + WS_WD + (size_t)l * 16384 * FF), MOE_ROWS, 16384, FF, cx.w0};
            pg8::MoeOrder S{last ? 16 : 17, 4, G, vcu};
            pg8::EpiDown E{(unsigned char*)(ws + WS_YS)};
            pg8::gemm_phase_f8<pg8::EpiDown, pg8::MoeOrder, false>(launder_lds(lds), g, S, E, nullptr);
        }
#endif
#if DBL & 512
        GRID_BAR();
        {
            pg8::Gemm g{(const bf16_t*)(ws + WS_HID), (const bf16_t*)(ws + WS_WD + (size_t)l * 16384 * FF), MOE_ROWS, 16384, FF, cx.w0};
            pg8::MoeOrder S{last ? 16 : 17, 4, G, vcu};
            pg8::EpiDown E{(unsigned char*)(ws + WS_YS)};
            pg8::gemm_phase_f8<pg8::EpiDown, pg8::MoeOrder, false>(launder_lds(lds), g, S, E, nullptr);
        }
#endif
        if (bgc && !last && vcu >= 64) cvt_tail<4>(cx, CVT_N0 + l * CVT_CYC + CVT_G1 + CVT_G2 + CVT_T, vcu - 64);
#ifdef DBLCVT
        if (bgc && !last && vcu >= 64) cvt_tail<4>(cx, CVT_N0 + l * CVT_CYC + CVT_G1 + CVT_G2 + CVT_T, vcu - 64);
#endif
        GRID_BAR();
    }
#if PH & 4096
    norm1_phase<1>(cx, DEPTH);
#endif
}

extern "C" void kernel_launch(void* const* d_in, const int* in_sizes, int n_in, void* d_out, int out_size, void* d_ws, size_t ws_size, hipStream_t stream) {
    static int grid = 0;
    if (grid == 0) {
        if (n_in != 18 || out_size != NB * SEQ * D || ws_size < WS_END) { fprintf(stderr, "kernel_launch: unexpected problem shape (n_in %d, out %d, ws %zu)\n", n_in, out_size, ws_size); grid = -1; return; }
        int dev = 0, cus = 0, per_cu = 0;
        if (hipGetDevice(&dev) != hipSuccess || hipDeviceGetAttribute(&cus, hipDeviceAttributeMultiprocessorCount, dev) != hipSuccess) { grid = -1; return; }
        if (hipFuncSetAttribute((const void*)mega_fwd, hipFuncAttributeMaxDynamicSharedMemorySize, LDS_BYTES) != hipSuccess) { fprintf(stderr, "kernel_launch: hipFuncSetAttribute failed\n"); grid = -1; return; }
        if (hipOccupancyMaxActiveBlocksPerMultiprocessor(&per_cu, (const void*)mega_fwd, 512, LDS_BYTES) != hipSuccess || per_cu < 1) { fprintf(stderr, "kernel_launch: occupancy query reports %d workgroups per CU\n", per_cu); per_cu = 1; }
        (void)hipGetLastError();
        grid = cus;
    }
    if (grid < 0) return;
    (void)in_sizes;
    if (hipMemsetAsync((char*)d_ws + WS_CTL, 0, CTL_ZERO_BYTES, stream) != hipSuccess) return;
    Args a{};
    for (int i = 0; i < 18; ++i) a.in[i] = (const float*)d_in[i];
    a.out = (float*)d_out; a.ws = (unsigned char*)d_ws;
    hipLaunchKernelGGL(mega_fwd, dim3(grid), dim3(512), LDS_BYTES, stream, a);
}
```

```cpp
#define SCAN_PRIO 1
#include <hip/hip_runtime.h>
#include <cstdio>
#include <cstdint>

constexpr int D = 1024, NB = 2, SEQ = 16384, CTX = 256, LTOT = SEQ + CTX, MROWS = NB * LTOT;
constexpr int DEPTH = 4, INW = 4608, NE = 16, FF = 2048;
constexpr int CAP_LAT = 2048, CAP_CTX = 32;
constexpr int MOE_ROWS_E = 4352, MOE_ROWS = NE * MOE_ROWS_E;
constexpr int NSLOT = NB * 8 * 2 * 65;
constexpr float EPS = 1e-6f;

constexpr size_t MiB = 1u << 20;
constexpr size_t WS_CTL = 0, CTL_ZERO_BYTES = 64 * 1024;
constexpr size_t WS_MODP = 1 * MiB;
constexpr size_t WS_MODS = 4 * MiB;
constexpr size_t WS_LBS = 5 * MiB;
constexpr size_t WS_ROPE = 5 * MiB + 65536;
constexpr size_t WS_WIN = 8 * MiB;
constexpr size_t WS_WOUT = 44 * MiB;
constexpr size_t WS_WGU = 52 * MiB;
constexpr size_t WS_WD = 564 * MiB;
constexpr size_t WS_X = 820 * MiB;
constexpr size_t WS_H = 950 * MiB;
constexpr size_t WS_MIX = 1015 * MiB;
constexpr size_t WS_P = 1080 * MiB;
constexpr size_t WS_XS = 1080 * MiB;
constexpr size_t WS_HID = 1216 * MiB;
constexpr size_t WS_YS = 1488 * MiB;
constexpr size_t WS_UB = 1624 * MiB;
constexpr size_t WS_SB = 1689 * MiB;
constexpr size_t WS_AB = 1754 * MiB;
constexpr size_t WS_OB = 1756 * MiB;
constexpr size_t WS_AFF = 1788 * MiB;
constexpr size_t WS_ROWMAP = 1791 * MiB;
constexpr size_t WS_INV = 1792 * MiB;
constexpr size_t WS_END = 1800 * MiB;

constexpr int LDS_BYTES = 155648;
constexpr int MISC_OFF = LDS_BYTES - 64;
constexpr int PTR_OFF = LDS_BYTES - 256;

#define GAS __attribute__((address_space(1)))
#define LAS __attribute__((address_space(3)))
typedef float f32x2 __attribute__((ext_vector_type(2)));
typedef unsigned u32x2 __attribute__((ext_vector_type(2)));

__device__ __forceinline__ int lane_id() { int l; asm volatile("v_mbcnt_lo_u32_b32 %0, -1, 0\n\tv_mbcnt_hi_u32_b32 %0, -1, %0" : "=v"(l)); return l; }
__device__ __forceinline__ int opaque_tid(int w0) { int w = w0; asm volatile("" : "+s"(w)); int t = w * 64 + lane_id(); asm volatile("" : "+v"(t)); return t; }
__device__ __forceinline__ LAS unsigned char* launder_lds(LAS unsigned char* p) { unsigned v = (unsigned)(size_t)p; asm volatile("" : "+s"(v)); return (LAS unsigned char*)(size_t)v; }
__device__ __forceinline__ const float* ldptr(LAS unsigned char* lds0, int i) {
    LAS unsigned char* lds = launder_lds(lds0);
    const u32x2 v = *(volatile LAS u32x2*)(lds + PTR_OFF + 8 * i);
    const unsigned lo = __builtin_amdgcn_readfirstlane(v.x), hi = __builtin_amdgcn_readfirstlane(v.y);
    const GAS float* g = (const GAS float*)(((unsigned long long)hi << 32) | lo);
    return (const float*)g;
}
namespace pg8 {
#define PG8_LAS __attribute__((address_space(3)))
typedef unsigned short bf16_t;
typedef short bf16x8 __attribute__((ext_vector_type(8)));
typedef float f32x4 __attribute__((ext_vector_type(4)));
typedef unsigned u32x4 __attribute__((ext_vector_type(4)));
constexpr int BM = 256, BK = 64, HALF = 128, HTB = HALF * BK * 2  , STAGE_BYTES = 8 * HTB, NXCD = 8, WGM = 8;

__host__ __device__ __forceinline__ int lds_byte(int r, int c) { const int st = (r >> 4) * 2 + (c >> 5), rr = r & 15, cc = c & 31, ob = rr * 64 + cc * 2; return st * 1024 + (ob ^ (((ob >> 9) & 1) << 5)); }
__host__ __device__ __forceinline__ void stage_rc(int b, int& R, int& C) { const int st = b / 1024, sb = b % 1024, swz = sb ^ (((sb >> 9) & 1) << 5); R = (st >> 1) * 16 + swz / 64; C = (st & 1) * 32 + (swz % 64) / 2; }
__host__ __device__ __forceinline__ int perm32(int rho) { const int n = rho >> 4, i = rho & 15; return 8 * (i >> 2) + 4 * n + (i & 3); }

struct Unit { int pm, pn; };
struct Gemm { const bf16_t* A; const bf16_t* Bt; int M, N, K, w0; };

struct StaticOrder {
    static constexpr bool PADTILES = false;
    __device__ __forceinline__ bool half_rows(const Unit&) const { return false; }
    int nM, nN, nwg, G, c;
    __host__ __device__ void init(int M, int N, int G_, int c_) { nM = M / BM; nN = N / BM; nwg = nM * nN; G = G_; c = c_; }
    __host__ __device__ bool next(int i, Unit& u) const {
        const long L = (long)i * G + c; if (L >= nwg) return false;
        int wgid = (int)L; { const int q = nwg / NXCD, r = nwg % NXCD, xcd = wgid % NXCD, off = wgid / NXCD; wgid = (xcd < r ? xcd * (q + 1) : r * (q + 1) + (xcd - r) * q) + off; }
        const int nig = WGM * nN, gid = wgid / nig, fm = gid * WGM, gsz = (nM - fm) < WGM ? (nM - fm) : WGM;
        u.pm = fm + ((wgid % nig) % gsz); u.pn = (wgid % nig) / gsz; return true;
    }
    __device__ __forceinline__ void a_ready(const Unit&) const {}
    __device__ __forceinline__ void done(const Unit&) const {}
};
__device__ __forceinline__ unsigned cvt_pk_bf16(float lo, float hi) { unsigned r; asm volatile("v_cvt_pk_bf16_f32 %0, %1, %2" : "=v"(r) : "v"(lo), "v"(hi)); return r; }

struct MoeOrder {
    static constexpr bool PADTILES = true;
    __device__ __forceinline__ bool half_rows(const Unit& u) const { return (u.pm % 17) == 16; }
    int NT, NC, G, c;
    __device__ __forceinline__ bool next(int i, Unit& u) const {
        const int L = i * G + c, per = NT * NC; if (L >= 16 * per) return false;
        const int e = L / per, q = L - e * per;
        if (NC == 16 && q < 256) { u.pm = e * 17 + (q >> 6) * 4 + (q & 3); u.pn = e * NC + ((q >> 2) & 15); }
        else { u.pm = e * 17 + q / NC; u.pn = e * NC + q % NC; }
        return true;
    }
    __device__ __forceinline__ void a_ready(const Unit&) const {}
    __device__ __forceinline__ void done(const Unit&) const {}
};

__device__ __forceinline__ float fast_exp(float x) { return __builtin_amdgcn_exp2f(x * 1.4426950408889634f); }
__device__ __forceinline__ float fast_sigmoid(float x) { return __builtin_amdgcn_rcpf(1.0f + fast_exp(-x)); }

constexpr float F8_SA = 8.0f, F8_SW = 64.0f, F8_SH = 4.0f, F8_SY = 16.0f;
#ifdef P_NT
#define PSTORE(p_, v_) __builtin_nontemporal_store((v_), (p_))
#else
#define PSTORE(p_, v_) (*(p_) = (v_))
#endif
template <bool PLAIN, bool F8 = false>
struct EpiInT {
    static constexpr float ASC = F8 ? 1.0f / (F8_SA * F8_SW) : 1.0f;
    static constexpr bool PERM = true, AFTER_DRAIN = false;
    bf16_t* P; const float* lb; const float* cs;
    __device__ __forceinline__ void operator()(const f32x4 (&acc)[2][2][4][2], const Unit& u, int wr, int wc, int fr, int fq) const {
        const int grp = PLAIN ? 0 : (u.pn >> 1);
        const int row0 = u.pm * BM + wr * 64 + fr, col0 = u.pn * BM + wc * 32 + 8 * fq;
        if (grp == 0 || grp == 3 || grp == 7) {
#pragma unroll
            for (int ai = 0; ai < 2; ++ai)
#pragma unroll
                for (int m = 0; m < 4; ++m) { bf16_t* rowp = P + (size_t)(row0 + ai * HALF + m * 16) * INW + col0;
#pragma unroll
                    for (int bj = 0; bj < 2; ++bj) { const f32x4 v0 = acc[ai][bj][m][0] * ASC, v1 = acc[ai][bj][m][1] * ASC;
                        u32x4 w; w.x = cvt_pk_bf16(v0[0], v0[1]); w.y = cvt_pk_bf16(v0[2], v0[3]); w.z = cvt_pk_bf16(v1[0], v1[1]); w.w = cvt_pk_bf16(v1[2], v1[3]);
#ifdef PROBE_LINSTORE
                        if (PLAIN) {
#if PROBE_LINSTORE == 2
                            *((u32x4*)P + ((size_t)blockIdx.x * 8192 + (((wr * 4 + wc) * 16 + (ai * 4 + m) * 2 + bj) * 64 + fq * 16 + fr))) = w; continue;
#else
                            *((u32x4*)P + ((size_t)(u.pm * 18 + u.pn) * 8192 + (((wr * 4 + wc) * 16 + (ai * 4 + m) * 2 + bj) * 64 + fq * 16 + fr))) = w; continue;
#endif
                        }
#endif
                        PSTORE((u32x4*)(rowp + bj * HALF), w); } }
        } else if (grp == 1 || grp == 2) {
            const int cg = col0 - grp * 512;
            f32x4 lbv[2][2];
#pragma unroll
            for (int bj = 0; bj < 2; ++bj)
#pragma unroll
                for (int n = 0; n < 2; ++n) lbv[bj][n] = *(const f32x4*)(lb + cg + bj * HALF + 4 * n);
#pragma unroll
            for (int ai = 0; ai < 2; ++ai)
#pragma unroll
                for (int m = 0; m < 4; ++m) { bf16_t* rowp = P + (size_t)(row0 + ai * HALF + m * 16) * INW + col0;
#pragma unroll
                    for (int bj = 0; bj < 2; ++bj) { f32x4 v[2];
#pragma unroll
                        for (int n = 0; n < 2; ++n)
#pragma unroll
                            for (int h = 0; h < 2; ++h) { const f32x2 z = (f32x2){acc[ai][bj][m][n][2 * h], acc[ai][bj][m][n][2 * h + 1]} * ASC, l0 = {lbv[bj][n][2 * h], lbv[bj][n][2 * h + 1]};
                                const f32x2 x = z * (-1.4426950408889634f); const f32x2 d = (f32x2){__builtin_amdgcn_exp2f(x.x), __builtin_amdgcn_exp2f(x.y)} + 1.0f;
                                f32x2 f = l0 + ((f32x2){1.0f, 1.0f} - l0) * (f32x2){__builtin_amdgcn_rcpf(d.x), __builtin_amdgcn_rcpf(d.y)}; f = __builtin_elementwise_max(f, (f32x2){1e-30f, 1e-30f});
#ifndef SCAN_LOG2
                                const f32x2 r = (f32x2){__builtin_amdgcn_logf(f.x), __builtin_amdgcn_logf(f.y)} * 0.6931471805599453f;
#else
                                const f32x2 r = (f32x2){__builtin_amdgcn_logf(f.x), __builtin_amdgcn_logf(f.y)};
#endif
                                v[n][2 * h] = r.x; v[n][2 * h + 1] = r.y; }
                        u32x4 w; w.x = cvt_pk_bf16(v[0][0], v[0][1]); w.y = cvt_pk_bf16(v[0][2], v[0][3]); w.z = cvt_pk_bf16(v[1][0], v[1][1]); w.w = cvt_pk_bf16(v[1][2], v[1][3]);
                        PSTORE((u32x4*)(rowp + bj * HALF), w); } }
        } else if (grp == 4 || grp == 8) {
#pragma unroll
            for (int ai = 0; ai < 2; ++ai)
#pragma unroll
                for (int m = 0; m < 4; ++m) { bf16_t* rowp = P + (size_t)(row0 + ai * HALF + m * 16) * INW + col0;
#pragma unroll
                    for (int bj = 0; bj < 2; ++bj) { f32x4 v[2];
#pragma unroll
                        for (int n = 0; n < 2; ++n)
#pragma unroll
                            for (int h = 0; h < 2; ++h) { const f32x2 z = (f32x2){acc[ai][bj][m][n][2 * h], acc[ai][bj][m][n][2 * h + 1]} * ASC; const f32x2 x = z * (-1.4426950408889634f);
                                const f32x2 d = (f32x2){__builtin_amdgcn_exp2f(x.x), __builtin_amdgcn_exp2f(x.y)} + 1.0f; const f32x2 r = z * (f32x2){__builtin_amdgcn_rcpf(d.x), __builtin_amdgcn_rcpf(d.y)};
                                v[n][2 * h] = r.x; v[n][2 * h + 1] = r.y; }
                        u32x4 w; w.x = cvt_pk_bf16(v[0][0], v[0][1]); w.y = cvt_pk_bf16(v[0][2], v[0][3]); w.z = cvt_pk_bf16(v[1][0], v[1][1]); w.w = cvt_pk_bf16(v[1][2], v[1][3]);
                        PSTORE((u32x4*)(rowp + bj * HALF), w); } }
        } else {
            const float sc = ((grp == 6) ? 0.08838834764831845f : 1.0f) * ASC;
            const int f0 = 16 * (wc & 1) + 4 * fq;
#pragma unroll
            for (int ai = 0; ai < 2; ++ai)
#pragma unroll
                for (int m = 0; m < 4; ++m) { const int row = row0 + ai * HALF + m * 16; bf16_t* rowp = P + (size_t)row * INW + col0;
                    int g = row; if (g >= LTOT) g -= LTOT;
                    int pos = 0; if (g >= CTX) { const int nn = g - CTX; pos = (wc < 2) ? (nn >> 6) : (nn & 63); }
                    const f32x4 t0 = *(const f32x4*)(cs + (size_t)(pos * 32 + f0) * 2), t1 = *(const f32x4*)(cs + (size_t)(pos * 32 + f0) * 2 + 4);
#pragma unroll
                    for (int bj = 0; bj < 2; ++bj) { const f32x4 v0 = acc[ai][bj][m][0] * sc, v1 = acc[ai][bj][m][1] * sc;
                        const float a0 = v0[0] * t0[0] - v0[1] * t0[1], a1 = v0[0] * t0[1] + v0[1] * t0[0];
                        const float a2 = v0[2] * t0[2] - v0[3] * t0[3], a3 = v0[2] * t0[3] + v0[3] * t0[2];
                        const float b0 = v1[0] * t1[0] - v1[1] * t1[1], b1 = v1[0] * t1[1] + v1[1] * t1[0];
                        const float b2 = v1[2] * t1[2] - v1[3] * t1[3], b3 = v1[2] * t1[3] + v1[3] * t1[2];
                        u32x4 w; w.x = cvt_pk_bf16(a0, a1); w.y = cvt_pk_bf16(a2, a3); w.z = cvt_pk_bf16(b0, b1); w.w = cvt_pk_bf16(b2, b3);
                        PSTORE((u32x4*)(rowp + bj * HALF), w); } }
        }
    }
};

using EpiIn = EpiInT<false>;
using EpiIn8 = EpiInT<false, true>;

struct EpiNull { static constexpr bool PERM = true, AFTER_DRAIN = false; float* sink;
    __device__ __forceinline__ void operator()(const f32x4 (&acc)[2][2][4][2], const Unit& u, int wr, int wc, int fr, int fq) const { f32x4 s = acc[0][0][0][0]; _Pragma("unroll") for (int a = 0; a < 2; ++a) _Pragma("unroll") for (int b = 0; b < 2; ++b) _Pragma("unroll") for (int m = 0; m < 4; ++m) _Pragma("unroll") for (int n = 0; n < 2; ++n) s += acc[a][b][m][n]; if (s[0] == 123.456f && u.pm < 0) sink[fr + fq + wr + wc] = s[1]; } };

template <bool F8>
struct EpiOutT {
    static constexpr bool PERM = true, AFTER_DRAIN = false; static constexpr float ASC = F8 ? 1.0f / (F8_SA * F8_SW) : 1.0f;
    bf16_t* X; const float* xin; const float* cin; const float* gt;
    __device__ __forceinline__ void operator()(const f32x4 (&acc)[2][2][4][2], const Unit& u, int wr, int wc, int fr, int fq) const {
        const int b = u.pm / 65, tb = u.pm - b * 65, which = (tb == 0) ? 2 : b;
        const int row0 = u.pm * BM + wr * 64 + fr, col0 = u.pn * BM + wc * 32 + 8 * fq;
        f32x4 gv[2][2];
#pragma unroll
        for (int bj = 0; bj < 2; ++bj)
#pragma unroll
            for (int n = 0; n < 2; ++n) gv[bj][n] = *(const f32x4*)(gt + which * 6144 + col0 + bj * HALF + 4 * n) * ASC;
#pragma unroll
        for (int ai = 0; ai < 2; ++ai)
#pragma unroll
            for (int m = 0; m < 4; ++m) { const int row = row0 + ai * HALF + m * 16; bf16_t* op = X + (size_t)row * D + col0;
#pragma unroll
                for (int bj = 0; bj < 2; ++bj) { f32x4 b0, b1;
                    if (xin) { const int g = row - b * LTOT; const float* bp = (g < CTX ? cin + (size_t)(b * CTX + g) * D : xin + (size_t)(b * SEQ + g - CTX) * D) + col0 + bj * HALF; b0 = *(const f32x4*)bp; b1 = *(const f32x4*)(bp + 4); }
                    else { const u32x4 w = *(const u32x4*)(op + bj * HALF); b0 = (f32x4){__uint_as_float(w.x << 16), __uint_as_float(w.x & 0xffff0000u), __uint_as_float(w.y << 16), __uint_as_float(w.y & 0xffff0000u)};
                        b1 = (f32x4){__uint_as_float(w.z << 16), __uint_as_float(w.z & 0xffff0000u), __uint_as_float(w.w << 16), __uint_as_float(w.w & 0xffff0000u)}; }
                    const f32x4 v0 = b0 + gv[bj][0] * acc[ai][bj][m][0], v1 = b1 + gv[bj][1] * acc[ai][bj][m][1];
                    u32x4 o; o.x = cvt_pk_bf16(v0[0], v0[1]); o.y = cvt_pk_bf16(v0[2], v0[3]); o.z = cvt_pk_bf16(v1[0], v1[1]); o.w = cvt_pk_bf16(v1[2], v1[3]);
                    *(u32x4*)(op + bj * HALF) = o; }
                if (F8) __builtin_amdgcn_sched_barrier(0); }
    }
};

using EpiOut = EpiOutT<false>;
using EpiOut8 = EpiOutT<true>;

__device__ __forceinline__ unsigned pk4_fp8(float a, float b, float c, float d) {
    a = __builtin_amdgcn_fmed3f(a, -448.f, 448.f); b = __builtin_amdgcn_fmed3f(b, -448.f, 448.f); c = __builtin_amdgcn_fmed3f(c, -448.f, 448.f); d = __builtin_amdgcn_fmed3f(d, -448.f, 448.f);
    unsigned w = 0; w = __builtin_amdgcn_cvt_pk_fp8_f32(a, b, w, false); w = __builtin_amdgcn_cvt_pk_fp8_f32(c, d, w, true); return w; }
struct EpiGU {
    static constexpr bool PERM = true, AFTER_DRAIN = false;
    unsigned char* HID;
    __device__ __forceinline__ void operator()(const f32x4 (&acc)[2][2][4][2], const Unit& u, int wr, int wc, int fr, int fq) const {
        const int row0 = u.pm * BM + wr * 64 + fr, col0 = (u.pn & 15) * HALF + wc * 32 + 8 * fq;
        constexpr float inv = 1.0f / (F8_SA * F8_SW);
#pragma unroll
        for (int ai = 0; ai < 2; ++ai)
#pragma unroll
            for (int m = 0; m < 4; ++m) { unsigned char* rowp = HID + (size_t)(row0 + ai * HALF + m * 16) * FF + col0; f32x4 v[2];
#pragma unroll
                for (int n = 0; n < 2; ++n)
#pragma unroll
                    for (int h = 0; h < 2; ++h) {
                        const f32x2 a0 = {acc[ai][0][m][n][2 * h], acc[ai][0][m][n][2 * h + 1]}, a1 = {acc[ai][1][m][n][2 * h], acc[ai][1][m][n][2 * h + 1]};
                        const f32x2 x = a0 * (-inv * 1.4426950408889634f); const f32x2 d = (f32x2){__builtin_amdgcn_exp2f(x.x), __builtin_amdgcn_exp2f(x.y)} + 1.0f;
                        const f32x2 r = (a0 * a1) * (inv * inv * F8_SH) * (f32x2){__builtin_amdgcn_rcpf(d.x), __builtin_amdgcn_rcpf(d.y)};
                        v[n][2 * h] = r.x; v[n][2 * h + 1] = r.y; }
                u32x2 w; w.x = pk4_fp8(v[0][0], v[0][1], v[0][2], v[0][3]); w.y = pk4_fp8(v[1][0], v[1][1], v[1][2], v[1][3]);
                *(u32x2*)rowp = w; }
    }
};

struct EpiDown {
    static constexpr bool PERM = true, AFTER_DRAIN = false;
    unsigned char* YS;
    __device__ __forceinline__ void operator()(const f32x4 (&acc)[2][2][4][2], const Unit& u, int wr, int wc, int fr, int fq) const {
        const int row0 = u.pm * BM + wr * 64 + fr, col0 = (u.pn & 3) * BM + wc * 32 + 8 * fq;
        constexpr float gg = F8_SY / (F8_SH * F8_SW);
#pragma unroll
        for (int ai = 0; ai < 2; ++ai)
#pragma unroll
            for (int m = 0; m < 4; ++m) { unsigned char* rowp = YS + (size_t)(row0 + ai * HALF + m * 16) * D + col0;
#pragma unroll
                for (int bj = 0; bj < 2; ++bj) { const f32x4 v0 = acc[ai][bj][m][0] * gg, v1 = acc[ai][bj][m][1] * gg;
                    u32x2 w; w.x = pk4_fp8(v0[0], v0[1], v0[2], v0[3]); w.y = pk4_fp8(v1[0], v1[1], v1[2], v1[3]);
                    *(u32x2*)(rowp + bj * HALF) = w; } }
    }
};

typedef int i32x4v __attribute__((ext_vector_type(4)));
typedef int i32x8v __attribute__((ext_vector_type(8)));
__device__ __forceinline__ i32x8v cat8(bf16x8 lo, bf16x8 hi) { const i32x4v a = __builtin_bit_cast(i32x4v, lo), b = __builtin_bit_cast(i32x4v, hi); return __builtin_shufflevector(a, b, 0, 1, 2, 3, 4, 5, 6, 7); }
template <class Epi, class Sched, bool GATHER>
__device__ __forceinline__ void gemm_phase_f8(PG8_LAS unsigned char* lds, const Gemm g, const Sched& S, const Epi& E, const int* rowmap) {
    const int tid = opaque_tid(g.w0), wid = __builtin_amdgcn_readfirstlane(tid >> 6), lane = tid & 63, wr = wid >> 2, wc = wid & 3, fr = lane & 15, fq = lane >> 4;
    const int rowb = g.K, nt = rowb / 128;
    unsigned vA0[2], vA1[2], voffB[2];
#pragma unroll
    for (int i = 0; i < 2; ++i) { int R, C; stage_rc(tid * 16 + i * 8192, R, C); const int Rb = Epi::PERM ? ((R & ~31) + perm32(R & 31)) : R;
        voffB[i] = (unsigned)(Rb * rowb + 2 * C); vA0[i] = (unsigned)(R * rowb + 2 * C); vA1[i] = vA0[i]; }
    const size_t kstep = 128;
    const size_t hstep = (size_t)HALF * rowb;
    const size_t tstep = 2 * hstep;
    const unsigned ldsw = (unsigned)wid * 1024u;
    const int aoff = lds_byte(wr * 64 + fr, fq * 8), boff = lds_byte(wc * 32 + fr, fq * 8);
    constexpr int GOFF = STAGE_BYTES;
#define PG8_SA(b, h) (((b) * 2 + (h)) * HTB)
#define PG8_SB(b, h) ((4 + (b) * 2 + (h)) * HTB)
#define PG8_STAGE(bufoff, gbase, voff) do { _Pragma("unroll") for (int _i = 0; _i < 2; ++_i) { unsigned _o = (voff)[_i]; asm volatile("" : "+v"(_o)); \
        __builtin_amdgcn_global_load_lds((const unsigned*)((const char*)(gbase) + _o), (PG8_LAS unsigned*)(lds + (bufoff) + ldsw + _i * 8192), 16, 0, 0); } } while (0)
#define PG8_STAGE_A(bufoff, kbase, h) do { if constexpr (GATHER) { if (h) PG8_STAGE(bufoff, kbase, vA1); else PG8_STAGE(bufoff, kbase, vA0); } else PG8_STAGE(bufoff, (kbase) + (h) * hstep, vA0); } while (0)
#define PG8_GIDX_ISSUE(pm_) do { const int _t = opaque_tid(g.w0); _Pragma("unroll") for (int _i = 0; _i < 2; ++_i) { int R, C; stage_rc(_t * 16 + _i * 8192, R, C); _Pragma("unroll") for (int _h = 0; _h < 2; ++_h) \
        __builtin_amdgcn_global_load_lds((const unsigned*)(rowmap + (pm_) * BM + _h * HALF + R), (PG8_LAS unsigned*)(lds + GOFF + ldsw + (_h * 2 + _i) * 256), 4, 0, 0); } } while (0)
#define PG8_GIDX_TAKE() do { const int _t = opaque_tid(g.w0); _Pragma("unroll") for (int _i = 0; _i < 2; ++_i) { int R, C; stage_rc(_t * 16 + _i * 8192, R, C); \
        vA0[_i] = *(const PG8_LAS unsigned*)(lds + GOFF + ldsw + (0 * 2 + _i) * 256 + (_t & 63) * 4) * (unsigned)rowb + (unsigned)(2 * C); \
        vA1[_i] = *(const PG8_LAS unsigned*)(lds + GOFF + ldsw + (1 * 2 + _i) * 256 + (_t & 63) * 4) * (unsigned)rowb + (unsigned)(2 * C); } } while (0)
#define PG8_LDA(dst, b, h) do { _Pragma("unroll") for (int m = 0; m < 4; ++m) _Pragma("unroll") for (int k = 0; k < 2; ++k) dst[m][k] = *(const PG8_LAS bf16x8*)(lds + PG8_SA(b, h) + aoff + m * 2048 + k * 1024); } while (0)
#define PG8_LDB(dst, b, h) do { _Pragma("unroll") for (int n = 0; n < 2; ++n) _Pragma("unroll") for (int k = 0; k < 2; ++k) dst[n][k] = *(const PG8_LAS bf16x8*)(lds + PG8_SB(b, h) + boff + n * 2048 + k * 1024); } while (0)
#define PG8_MMA(ai, bj, At, Bt) do { __builtin_amdgcn_s_setprio(1); _Pragma("unroll") for (int m = 0; m < 4; ++m) _Pragma("unroll") for (int n = 0; n < 2; ++n) \
        acc[ai][bj][m][n] = __builtin_amdgcn_mfma_scale_f32_16x16x128_f8f6f4(cat8(Bt[n][0], Bt[n][1]), cat8(At[m][0], At[m][1]), acc[ai][bj][m][n], 0, 0, 0, 0, 0, 0); __builtin_amdgcn_s_setprio(0); } while (0)
#define PG8_WAIT_V(n) asm volatile("s_waitcnt vmcnt(" #n ")" ::: "memory")
#define PG8_WAIT_L(n) asm volatile("s_waitcnt lgkmcnt(" #n ")" ::: "memory")
#define PG8_BAR __builtin_amdgcn_s_barrier()
#define PG8_SCHED __builtin_amdgcn_sched_barrier(0)
    Unit cur, nxt; int ui = 0;
    if (!S.next(0, cur)) return;
    bool half = Sched::PADTILES && S.half_rows(cur);
    f32x4 acc[2][2][4][2];
#pragma unroll
    for (int a = 0; a < 2; ++a)
#pragma unroll
        for (int b = 0; b < 2; ++b)
#pragma unroll
            for (int m = 0; m < 4; ++m)
#pragma unroll
                for (int n = 0; n < 2; ++n) acc[a][b][m][n] = (f32x4){0.f, 0.f, 0.f, 0.f};
    bf16x8 At[4][2], B0[2][2], B1[2][2];
    const char* cA; const char* cB = (const char*)g.Bt + (size_t)cur.pn * tstep;
    if constexpr (GATHER) { cA = (const char*)g.A; PG8_GIDX_ISSUE(cur.pm); PG8_WAIT_V(0); PG8_GIDX_TAKE(); }
    else cA = (const char*)g.A + (size_t)cur.pm * tstep;
    PG8_STAGE(PG8_SB(0, 0), cB, voffB); PG8_STAGE(PG8_SB(0, 1), cB + hstep, voffB); PG8_STAGE_A(PG8_SA(0, 0), cA, 0); PG8_STAGE_A(PG8_SA(0, 1), cA, 1);
    if (wr == 1) PG8_BAR;
    PG8_WAIT_V(2); PG8_BAR;
    PG8_STAGE(PG8_SB(1, 0), cB + kstep, voffB); PG8_STAGE_A(PG8_SA(1, 0), cA + kstep, 0); PG8_STAGE(PG8_SB(1, 1), cB + hstep + kstep, voffB);
    PG8_WAIT_V(6); PG8_BAR;
    for (;;) {
        const bool has_next = S.next(ui + 1, nxt);
        const char* nA; const char* nB = has_next ? (const char*)g.Bt + (size_t)nxt.pn * tstep : cB;
        if constexpr (GATHER) { nA = cA; if (has_next) PG8_GIDX_ISSUE(nxt.pm); }
        else nA = has_next ? (const char*)g.A + (size_t)nxt.pm * tstep : cA;
#pragma unroll 1
        for (int t = 0; t < nt; t += 2) {
            const bool last = (t == nt - 2);
            const char* a1 = cA + (size_t)(t + 1) * kstep;
            const char* a2 = last ? nA : cA + (size_t)(t + 2) * kstep; const char* b2 = last ? nB : cB + (size_t)(t + 2) * kstep;
            const char* a3 = a2 + kstep; const char* b3 = b2 + kstep;
            PG8_LDB(B0, 0, 0); PG8_LDB(B1, 0, 1); PG8_SCHED; PG8_LDA(At, 0, 0); PG8_STAGE_A(PG8_SA(1, 1), a1, 1);
            if constexpr (GATHER) { if (last && has_next) PG8_GIDX_TAKE(); }
            PG8_WAIT_V(8); PG8_WAIT_L(0); PG8_BAR; if (!(half && wr == 1)) { PG8_MMA(0, 0, At, B0); PG8_MMA(0, 1, At, B1); } PG8_BAR; PG8_SCHED;
            PG8_LDA(At, 0, 1); PG8_STAGE(PG8_SB(0, 0), b2, voffB); PG8_STAGE(PG8_SB(0, 1), b2 + hstep, voffB); PG8_STAGE_A(PG8_SA(0, 0), a2, 0);
            PG8_WAIT_V(8); PG8_WAIT_L(0); PG8_BAR; if (!half) { PG8_MMA(1, 0, At, B0); PG8_MMA(1, 1, At, B1); } PG8_BAR; PG8_SCHED;
            PG8_LDB(B0, 1, 0); PG8_LDB(B1, 1, 1); PG8_SCHED; PG8_LDA(At, 1, 0); PG8_STAGE_A(PG8_SA(0, 1), a2, 1);
            PG8_WAIT_V(8); PG8_WAIT_L(0); PG8_BAR; if (!(half && wr == 1)) { PG8_MMA(0, 0, At, B0); PG8_MMA(0, 1, At, B1); } PG8_BAR; PG8_SCHED;
            PG8_LDA(At, 1, 1); PG8_STAGE(PG8_SB(1, 0), b3, voffB); PG8_STAGE(PG8_SB(1, 1), b3 + hstep, voffB); PG8_STAGE_A(PG8_SA(1, 0), a3, 0);
            PG8_WAIT_V(8); PG8_WAIT_L(0); PG8_BAR; if (!half) { PG8_MMA(1, 0, At, B0); PG8_MMA(1, 1, At, B1); } PG8_BAR; PG8_SCHED;
        }
        if (wr == 0) PG8_BAR;
        { const int l2_ = opaque_tid(g.w0) & 63; E(acc, cur, wr, wc, l2_ & 15, l2_ >> 4); }
#ifdef G2_F8
        { const int t2_ = opaque_tid(g.w0);
#pragma unroll
          for (int i = 0; i < 2; ++i) { int R, C; stage_rc(t2_ * 16 + i * 8192, R, C); const int Rb = Epi::PERM ? ((R & ~31) + perm32(R & 31)) : R;
              voffB[i] = (unsigned)(Rb * rowb + 2 * C); if constexpr (!GATHER) { vA0[i] = (unsigned)(R * rowb + 2 * C); vA1[i] = vA0[i]; } } }
#endif
        if (!has_next) break;
#pragma unroll
        for (int a = 0; a < 2; ++a)
#pragma unroll
            for (int b = 0; b < 2; ++b)
#pragma unroll
                for (int m = 0; m < 4; ++m)
#pragma unroll
                    for (int n = 0; n < 2; ++n) acc[a][b][m][n] = (f32x4){0.f, 0.f, 0.f, 0.f};
        cur = nxt; cA = nA; cB = nB; ++ui; half = Sched::PADTILES && S.half_rows(cur);
        if (wr == 1) PG8_BAR;
    }
    PG8_WAIT_V(0);
    PG8_BAR;
#undef PG8_SA
#undef PG8_SB
#undef PG8_STAGE
#undef PG8_STAGE_A
#undef PG8_GIDX_ISSUE
#undef PG8_GIDX_TAKE
#undef PG8_LDA
#undef PG8_LDB
#undef PG8_MMA
#undef PG8_WAIT_V
#undef PG8_WAIT_L
#undef PG8_BAR
#undef PG8_SCHED
}
template <class Epi, class Sched, bool ALIGN_EPI = false, bool SP2 = false>
__device__ __forceinline__ void gemm_phase(PG8_LAS unsigned char* lds, const Gemm g, const Sched& S, const Epi& E) {
    const int tid = opaque_tid(g.w0), wid = __builtin_amdgcn_readfirstlane(tid >> 6), lane = tid & 63, wr = wid >> 2, wc = wid & 3, fr = lane & 15, fq = lane >> 4;
    const int K = g.K, nt = K / BK;
    unsigned voffA[2], voffB[2];
#pragma unroll
    for (int i = 0; i < 2; ++i) { int R, C; stage_rc(tid * 16 + i * 8192, R, C); const int Rb = Epi::PERM ? ((R & ~31) + perm32(R & 31)) : R;
        voffA[i] = (unsigned)(R * K + C) * 2u; voffB[i] = (unsigned)(Rb * K + C) * 2u; }
    const size_t kstep = (size_t)(BK * 2);
    const size_t hstep = (size_t)HALF * K * 2;
    const size_t tstep = 2 * hstep;
    const unsigned ldsw = (unsigned)wid * 1024u;
    const int aoff = lds_byte(wr * 64 + fr, fq * 8), boff = lds_byte(wc * 32 + fr, fq * 8);
#define PG8_SA(b, h) (((b) * 2 + (h)) * HTB)
#define PG8_SB(b, h) ((4 + (b) * 2 + (h)) * HTB)
#define PG8_STAGE(bufoff, gbase, voff) do { _Pragma("unroll") for (int _i = 0; _i < 2; ++_i) \
        __builtin_amdgcn_global_load_lds((const unsigned*)((const char*)(gbase) + (voff)[_i]), (PG8_LAS unsigned*)(lds + (bufoff) + ldsw + _i * 8192), 16, 0, 0); } while (0)
#define PG8_LDA(dst, b, h) do { _Pragma("unroll") for (int m = 0; m < 4; ++m) _Pragma("unroll") for (int k = 0; k < 2; ++k) dst[m][k] = *(const PG8_LAS bf16x8*)(lds + PG8_SA(b, h) + aoff + m * 2048 + k * 1024); } while (0)
#define PG8_LDB(dst, b, h) do { _Pragma("unroll") for (int n = 0; n < 2; ++n) _Pragma("unroll") for (int k = 0; k < 2; ++k) dst[n][k] = *(const PG8_LAS bf16x8*)(lds + PG8_SB(b, h) + boff + n * 2048 + k * 1024); } while (0)
#define PG8_MMA(ai, bj, At, Bt) do { __builtin_amdgcn_s_setprio(1); _Pragma("unroll") for (int m = 0; m < 4; ++m) _Pragma("unroll") for (int n = 0; n < 2; ++n) _Pragma("unroll") for (int k = 0; k < 2; ++k) \
        acc[ai][bj][m][n] = __builtin_amdgcn_mfma_f32_16x16x32_bf16(Bt[n][k], At[m][k], acc[ai][bj][m][n], 0, 0, 0); __builtin_amdgcn_s_setprio(0); } while (0)
#define PG8_WAIT_V(n) asm volatile("s_waitcnt vmcnt(" #n ")" ::: "memory")
#define PG8_WAIT_L(n) asm volatile("s_waitcnt lgkmcnt(" #n ")" ::: "memory")
#define PG8_BAR __builtin_amdgcn_s_barrier()
#define PG8_SCHED __builtin_amdgcn_sched_barrier(0)
    Unit cur, nxt; int ui = 0;
    if (!S.next(0, cur)) return;
    f32x4 acc[2][2][4][2];
#pragma unroll
    for (int a = 0; a < 2; ++a)
#pragma unroll
        for (int b = 0; b < 2; ++b)
#pragma unroll
            for (int m = 0; m < 4; ++m)
#pragma unroll
                for (int n = 0; n < 2; ++n) acc[a][b][m][n] = (f32x4){0.f, 0.f, 0.f, 0.f};
    bf16x8 At[4][2], B0[2][2], B1[2][2];
    const char* cA = (const char*)g.A + (size_t)cur.pm * tstep; const char* cB = (const char*)g.Bt + (size_t)cur.pn * tstep;
    S.a_ready(cur);
    if constexpr (SP2) {
        PG8_STAGE(PG8_SB(0, 0), cB, voffB); PG8_STAGE(PG8_SB(0, 1), cB + hstep, voffB); PG8_STAGE(PG8_SA(0, 0), cA, voffA); PG8_STAGE(PG8_SA(0, 1), cA + hstep, voffA);
        if (wr == 1) PG8_BAR;
        PG8_WAIT_V(2); PG8_BAR;
        PG8_STAGE(PG8_SB(1, 0), cB + kstep, voffB); PG8_STAGE(PG8_SA(1, 0), cA + kstep, voffA); PG8_STAGE(PG8_SB(1, 1), cB + hstep + kstep, voffB);
        PG8_WAIT_V(6); PG8_BAR;
    } else {
        PG8_STAGE(PG8_SB(0, 0), cB, voffB); PG8_STAGE(PG8_SA(0, 0), cA, voffA); PG8_STAGE(PG8_SB(0, 1), cB + hstep, voffB); PG8_STAGE(PG8_SA(0, 1), cA + hstep, voffA);
        if (wr == 1) PG8_BAR;
        PG8_WAIT_V(4); PG8_BAR;
        PG8_STAGE(PG8_SB(1, 0), cB + kstep, voffB); PG8_STAGE(PG8_SA(1, 0), cA + kstep, voffA); PG8_STAGE(PG8_SB(1, 1), cB + hstep + kstep, voffB);
        PG8_WAIT_V(6); PG8_BAR;
    }
    for (;;) {
        const bool has_next = S.next(ui + 1, nxt);
        const char* nA = has_next ? (const char*)g.A + (size_t)nxt.pm * tstep : cA; const char* nB = has_next ? (const char*)g.Bt + (size_t)nxt.pn * tstep : cB;
        for (int t = 0; t < nt; t += 2) {
            const bool last = (t == nt - 2);
            const char* a1 = cA + (size_t)(t + 1) * kstep;
            const char* a2 = last ? nA : cA + (size_t)(t + 2) * kstep; const char* b2 = last ? nB : cB + (size_t)(t + 2) * kstep;
            const char* a3 = a2 + kstep; const char* b3 = b2 + kstep;
            if (last && has_next) S.a_ready(nxt);
            if constexpr (SP2) {
            PG8_LDB(B0, 0, 0); PG8_LDB(B1, 0, 1); PG8_SCHED; PG8_LDA(At, 0, 0); PG8_STAGE(PG8_SA(1, 1), a1 + hstep, voffA);
            PG8_WAIT_V(8); PG8_WAIT_L(0); PG8_BAR; PG8_MMA(0, 0, At, B0); PG8_MMA(0, 1, At, B1); PG8_BAR; PG8_SCHED;
            PG8_LDA(At, 0, 1); PG8_STAGE(PG8_SB(0, 0), b2, voffB); PG8_STAGE(PG8_SB(0, 1), b2 + hstep, voffB); PG8_STAGE(PG8_SA(0, 0), a2, voffA);
            PG8_WAIT_V(8); PG8_WAIT_L(0); PG8_BAR; PG8_MMA(1, 0, At, B0); PG8_MMA(1, 1, At, B1); PG8_BAR; PG8_SCHED;
            PG8_LDB(B0, 1, 0); PG8_LDB(B1, 1, 1); PG8_SCHED; PG8_LDA(At, 1, 0); PG8_STAGE(PG8_SA(0, 1), a2 + hstep, voffA);
            PG8_WAIT_V(8); PG8_WAIT_L(0); PG8_BAR; PG8_MMA(0, 0, At, B0); PG8_MMA(0, 1, At, B1); PG8_BAR; PG8_SCHED;
            PG8_LDA(At, 1, 1); PG8_STAGE(PG8_SB(1, 0), b3, voffB); PG8_STAGE(PG8_SB(1, 1), b3 + hstep, voffB); PG8_STAGE(PG8_SA(1, 0), a3, voffA);
            PG8_WAIT_V(8); PG8_WAIT_L(0); PG8_BAR; PG8_MMA(1, 0, At, B0); PG8_MMA(1, 1, At, B1); PG8_BAR; PG8_SCHED;
            } else {
            PG8_LDB(B0, 0, 0); PG8_SCHED; PG8_LDA(At, 0, 0); PG8_STAGE(PG8_SA(1, 1), a1 + hstep, voffA);
            PG8_WAIT_L(8); PG8_BAR; PG8_WAIT_L(0); PG8_MMA(0, 0, At, B0); PG8_BAR; PG8_SCHED;
            PG8_LDB(B1, 0, 1); PG8_STAGE(PG8_SB(0, 0), b2, voffB);
            PG8_BAR; PG8_WAIT_L(0); PG8_MMA(0, 1, At, B1); PG8_BAR;
            PG8_LDA(At, 0, 1); PG8_STAGE(PG8_SA(0, 0), a2, voffA);
            PG8_BAR; PG8_WAIT_L(0); PG8_MMA(1, 0, At, B0); PG8_BAR; PG8_SCHED;
            PG8_STAGE(PG8_SB(0, 1), b2 + hstep, voffB);
            PG8_WAIT_V(6); PG8_BAR; PG8_MMA(1, 1, At, B1); PG8_BAR;
            PG8_LDB(B0, 1, 0); PG8_SCHED; PG8_LDA(At, 1, 0); PG8_STAGE(PG8_SA(0, 1), a2 + hstep, voffA);
            PG8_WAIT_L(8); PG8_BAR; PG8_WAIT_L(0); PG8_MMA(0, 0, At, B0); PG8_BAR; PG8_SCHED;
            PG8_LDB(B1, 1, 1); PG8_STAGE(PG8_SB(1, 0), b3, voffB);
            PG8_BAR; PG8_WAIT_L(0); PG8_MMA(0, 1, At, B1); PG8_BAR;
            PG8_LDA(At, 1, 1); PG8_STAGE(PG8_SA(1, 0), a3, voffA);
            PG8_BAR; PG8_WAIT_L(0); PG8_MMA(1, 0, At, B0); PG8_BAR; PG8_SCHED;
            PG8_STAGE(PG8_SB(1, 1), b3 + hstep, voffB);
            PG8_WAIT_V(6); PG8_BAR; PG8_MMA(1, 1, At, B1); PG8_BAR;
            }
        }
        if constexpr (ALIGN_EPI) { if (wr == 0) PG8_BAR; }
        if constexpr (!Epi::AFTER_DRAIN) { E(acc, cur, wr, wc, fr, fq); S.done(cur); }
        if (!has_next) break;
#pragma unroll
        for (int a = 0; a < 2; ++a)
#pragma unroll
            for (int b = 0; b < 2; ++b)
#pragma unroll
                for (int m = 0; m < 4; ++m)
#pragma unroll
                    for (int n = 0; n < 2; ++n) acc[a][b][m][n] = (f32x4){0.f, 0.f, 0.f, 0.f};
        cur = nxt; cA = nA; cB = nB; ++ui;
        if constexpr (ALIGN_EPI) { if (wr == 1) PG8_BAR; }
    }
    PG8_WAIT_V(0);
    if constexpr (!ALIGN_EPI) { if (wr == 0) PG8_BAR; }
    PG8_BAR;
    if constexpr (Epi::AFTER_DRAIN) { E.fused(acc, cur, wr, wc, fr, fq, lds, wid, lane); S.done(cur); }
#undef PG8_SA
#undef PG8_SB
#undef PG8_STAGE
#undef PG8_LDA
#undef PG8_LDB
#undef PG8_MMA
#undef PG8_WAIT_V
#undef PG8_WAIT_L
#undef PG8_BAR
#undef PG8_SCHED
}
}
#define XB_TMO      128
#define XB_XCNT(j)  (256  + 64 * (j))
#define XB_XSUB(j)  (1280 + 64 * (j))
#define XB_XGEN(j)  (2304 + 64 * (j))
#define XB_TOP      3328
#define XB_TOPGEN   3392
#define XCD_BAR_WORDS 3456
#define XB_SPIN_CAP (1u << 18)

__device__ __forceinline__ unsigned xb_ld(unsigned* p)              { return __hip_atomic_load(p, __ATOMIC_RELAXED, __HIP_MEMORY_SCOPE_AGENT); }
__device__ __forceinline__ unsigned xb_add(unsigned* p, unsigned v) { return __hip_atomic_fetch_add(p, v, __ATOMIC_RELAXED, __HIP_MEMORY_SCOPE_AGENT); }
__device__ __forceinline__ unsigned xb_xcc_id() { return (unsigned)__builtin_amdgcn_s_getreg((3 << 11) | 20) & 0xFu; }
#define XB_SPIN(cond, bar) do { unsigned _sp = 0; while (cond) { __builtin_amdgcn_s_sleep(1); \
    if ((++_sp & 255u) == 0u) { if (xb_ld(&(bar)[XB_TMO])) break; if (_sp > XB_SPIN_CAP) { atomicAdd(&(bar)[XB_TMO], 1u); break; } } } } while (0)

struct XcdBarrier {
    unsigned* bar; unsigned x;
    volatile LAS unsigned* st;
};

__device__ __forceinline__ XcdBarrier xcd_barrier_post(unsigned* bar, volatile LAS unsigned* st) {
    XcdBarrier b; b.bar = bar; b.x = xb_xcc_id(); b.st = st;
    if (threadIdx.x == 0) (void)xb_add(&bar[XB_XCNT(b.x)], 1u);
    return b;
}
__device__ __forceinline__ void xcd_barrier_complete(unsigned* bar, unsigned x, unsigned& nloc, unsigned& nx) {
    const unsigned G = gridDim.x * gridDim.y * gridDim.z;
    unsigned sum, cnt, mine, sp = 0u;
    for (;;) {
        sum = 0u; cnt = 0u; mine = 0u;
#pragma unroll
        for (unsigned j = 0; j < 16; ++j) { const unsigned c = xb_ld(&bar[XB_XCNT(j)]); sum += c; cnt += (c > 0u) ? 1u : 0u; mine = (j == x) ? c : mine; }
        if (sum == G) break;
        __builtin_amdgcn_s_sleep(1);
        if ((++sp & 255u) == 0u) { if (xb_ld(&bar[XB_TMO])) break; if (sp > XB_SPIN_CAP) { atomicAdd(&bar[XB_TMO], 1u); break; } }
    }
    nloc = mine > 0u ? mine : 1u; nx = cnt > 0u ? cnt : 1u;
}

__device__ __forceinline__ void xcd_barrier(const XcdBarrier& b) {
    asm volatile("s_waitcnt vmcnt(0)" ::: "memory");
    __syncthreads();
    if (threadIdx.x == 0) {
        unsigned* bar = b.bar;
        __builtin_amdgcn_s_waitcnt(0);
        unsigned nloc = b.st[0], nx = b.st[1];
        if (nloc == 0u) { xcd_barrier_complete(bar, b.x, nloc, nx); b.st[0] = nloc; b.st[1] = nx; }
        const unsigned old = xb_add(&bar[XB_XSUB(b.x)], 1u);
        const unsigned gen = old / nloc;
        if (old + 1u == (gen + 1u) * nloc) {
            __builtin_amdgcn_fence(__ATOMIC_RELEASE, "agent");
            asm volatile("s_waitcnt vmcnt(0)" ::: "memory");
            const unsigned og = xb_add(&bar[XB_TOP], 1u);
            const unsigned tg = og / nx;
            if (og + 1u == (tg + 1u) * nx) xb_add(&bar[XB_TOPGEN], 1u);
            else XB_SPIN(xb_ld(&bar[XB_TOPGEN]) == tg, bar);
            __builtin_amdgcn_fence(__ATOMIC_ACQUIRE, "agent");
            xb_add(&bar[XB_XGEN(b.x)], 1u);
            asm volatile("s_waitcnt vmcnt(0)" ::: "memory");
        } else {
            XB_SPIN(xb_ld(&bar[XB_XGEN(b.x)]) == gen, bar);
            __builtin_amdgcn_fence(__ATOMIC_ACQUIRE, "agent");
            asm volatile("s_waitcnt vmcnt(0)" ::: "memory");
        }
    }
    __syncthreads();
}

using pg8::bf16_t; using pg8::bf16x8; using pg8::f32x4; using pg8::u32x4; using pg8::cvt_pk_bf16; using pg8::fast_exp;

#define BAR_LDS() do { asm volatile("s_waitcnt lgkmcnt(0)" ::: "memory"); __builtin_amdgcn_s_barrier(); asm volatile("" ::: "memory"); } while (0)
#define BAR_ALL() do { asm volatile("s_waitcnt vmcnt(0) lgkmcnt(0)" ::: "memory"); __builtin_amdgcn_s_barrier(); asm volatile("" ::: "memory"); } while (0)

#ifdef PROBE_SHFL
__device__ __forceinline__ float shx(float v, int mask, int lane) { (void)lane; return __shfl_xor(v, mask); }
__device__ __forceinline__ unsigned shxu(unsigned v, int mask, int lane) { (void)lane; return __shfl_xor(v, mask); }
__device__ __forceinline__ unsigned shupu(unsigned v, int d, int lane) { (void)lane; return __shfl_up(v, d); }
#else
__device__ __forceinline__ float shx(float v, int mask, int lane) { return __builtin_bit_cast(float, __builtin_amdgcn_ds_bpermute((lane ^ mask) << 2, __builtin_bit_cast(int, v))); }
__device__ __forceinline__ unsigned shxu(unsigned v, int mask, int lane) { return (unsigned)__builtin_amdgcn_ds_bpermute((lane ^ mask) << 2, (int)v); }
__device__ __forceinline__ unsigned shupu(unsigned v, int d, int lane) { return (unsigned)__builtin_amdgcn_ds_bpermute((lane - d) << 2, (int)v); }
#endif
__device__ __forceinline__ float wave_sum(float v, int lane) {
#pragma unroll
    for (int o = 1; o < 64; o <<= 1) v += shx(v, o, lane);
    return v;
}
__device__ __forceinline__ float bf_lo(unsigned u) { return __uint_as_float(u << 16); }
__device__ __forceinline__ float bf_hi(unsigned u) { return __uint_as_float(u & 0xffff0000u); }

struct Args { const float* in[18]; float* out; unsigned char* ws; };
struct Ctx { LAS unsigned char* lds; int w0;
    __device__ __forceinline__ const float* in(int i) const { return ldptr(lds, i); }
    __device__ __forceinline__ float* out() const { return (float*)ldptr(lds, 18); }
    __device__ __forceinline__ unsigned char* ws() const { return (unsigned char*)ldptr(lds, 19); } };
#define PHASE_IDS() const int tid = opaque_tid(a.w0), lane = tid & 63, wave = __builtin_amdgcn_readfirstlane(tid >> 6); (void)tid; (void)lane; (void)wave
enum { I_X = 0, I_C, I_CTX, I_CCTX, I_WADA, I_BADA, I_GMIX, I_GFFN, I_WIN, I_WOUT, I_LBL, I_ONORM, I_RDEC, I_WR, I_WEG, I_WEU, I_WED, I_GFIN };

struct CvtItem { const float* src; unsigned char* dst; int N, Kd, f8; };
__device__ __forceinline__ void cvt_desc(CvtItem& it, const float* W, int N, unsigned char* WT, int Kd, int k0, int n0, int drow0, int lane, int f8) {
    const int q = lane >> 4, c = lane & 15, es = f8 ? 1 : 2;
    it.src = W + (size_t)(k0 + 16 * q) * N + n0 + 4 * c; it.N = N; it.Kd = Kd * es; it.dst = WT + ((size_t)(drow0 + 4 * c) * Kd + k0 + 16 * q) * es; it.f8 = f8;
}
__device__ __forceinline__ void cvt_load(f32x4 (&v)[16], const CvtItem& it) {
#pragma unroll
    for (int i = 0; i < 16; ++i) v[i] = *(const f32x4*)(it.src + (size_t)i * it.N);
}
__device__ __forceinline__ void cvt_store(const f32x4 (&v)[16], const CvtItem& it) {
    if (it.f8) {
#pragma unroll
        for (int j = 0; j < 4; ++j) { u32x4 o; constexpr float s = pg8::F8_SW;
            o.x = pg8::pk4_fp8(v[0][j] * s, v[1][j] * s, v[2][j] * s, v[3][j] * s); o.y = pg8::pk4_fp8(v[4][j] * s, v[5][j] * s, v[6][j] * s, v[7][j] * s);
            o.z = pg8::pk4_fp8(v[8][j] * s, v[9][j] * s, v[10][j] * s, v[11][j] * s); o.w = pg8::pk4_fp8(v[12][j] * s, v[13][j] * s, v[14][j] * s, v[15][j] * s);
            *(u32x4*)(it.dst + (size_t)j * it.Kd) = o; }
    } else {
#pragma unroll
        for (int j = 0; j < 4; ++j) { u32x4 o0, o1;
            o0.x = cvt_pk_bf16(v[0][j], v[1][j]); o0.y = cvt_pk_bf16(v[2][j], v[3][j]); o0.z = cvt_pk_bf16(v[4][j], v[5][j]); o0.w = cvt_pk_bf16(v[6][j], v[7][j]);
            o1.x = cvt_pk_bf16(v[8][j], v[9][j]); o1.y = cvt_pk_bf16(v[10][j], v[11][j]); o1.z = cvt_pk_bf16(v[12][j], v[13][j]); o1.w = cvt_pk_bf16(v[14][j], v[15][j]);
            *(u32x4*)(it.dst + (size_t)j * it.Kd) = o0; *(u32x4*)(it.dst + (size_t)j * it.Kd + 16) = o1; }
    }
}
__device__ __forceinline__ void cvt_expert_desc(CvtItem& it, const Ctx& a, unsigned char* ws, int g, int lane) {
    constexpr int I_E = 512; const int l = g / 24576, r = g % 24576; const int le = l * 16 + r / (3 * I_E), q3 = r % (3 * I_E), kind = q3 / I_E, q = q3 % I_E;
    if (kind < 2) { const int kb = q / 32, nb = q % 32, n0 = nb * 64;
        const int drow = 256 * (n0 >> 7) + (n0 & 127) + kind * 128;
        cvt_desc(it, a.in(kind == 0 ? I_WEG : I_WEU) + (size_t)le * D * FF, FF, (unsigned char*)(ws + WS_WGU) + (size_t)le * 4096 * D, D, kb * 64, n0, drow, lane, 1);
    } else { const int kb = q / 16, nb = q % 16;
        cvt_desc(it, a.in(I_WED) + (size_t)le * FF * D, D, (unsigned char*)(ws + WS_WD) + (size_t)le * D * FF, FF, kb * 64, nb * 64, nb * 64, lane, 1); }
}
constexpr int CVT_N0 = 9472, CVT_G1 = 7040, CVT_G2 = 7936, CVT_T = 4608, CVT_G4 = 6144, CVT_CYC = CVT_G1 + CVT_G2 + CVT_T + CVT_G4;
static_assert(CVT_G1 == 220 * 8 * 4 && CVT_G2 == 248 * 8 * 4 && CVT_T == 192 * 8 * 3 && CVT_G4 == 192 * 8 * 4, "slot sizes = idle workgroups x 8 waves x items per wave");
static_assert(CVT_N0 + CVT_G1 + CVT_G2 + CVT_T >= 24576 && CVT_N0 + CVT_CYC + CVT_G1 + CVT_G2 + CVT_T >= 2 * 24576 && CVT_N0 + 2 * CVT_CYC + CVT_G1 + CVT_G2 + CVT_T >= 3 * 24576 && CVT_N0 + 3 * CVT_CYC + CVT_G1 + CVT_T >= 4 * 24576, "every layer's expert weights are converted before its first expert GEMM");
__device__ __forceinline__ void cvt_tail(const Ctx& a, int first, int rank, int per, int i0, int i1) {
    PHASE_IDS(); unsigned char* ws = a.ws();
    const int base = first + (rank * 8 + wave) * per; int g = base + i0, g1 = base + i1; if (g1 > 4 * 24576) g1 = 4 * 24576;
    f32x4 va[16], vb[16]; CvtItem ia, ib;
    if (g < g1) { cvt_expert_desc(ia, a, ws, g, lane); cvt_load(va, ia); }
    while (g < g1) {
        if (g + 1 < g1) { cvt_expert_desc(ib, a, ws, g + 1, lane); cvt_load(vb, ib); }
        cvt_store(va, ia);
        if (++g >= g1) break;
        if (g + 1 < g1) { cvt_expert_desc(ia, a, ws, g + 1, lane); cvt_load(va, ia); }
        cvt_store(vb, ib);
        ++g; }
}
template <int PER>
__device__ __forceinline__ void cvt_tail(const Ctx& a, int first, int rank) { cvt_tail(a, first, rank, PER, 0, PER); }

__device__ __forceinline__ void p0_item_desc(CvtItem& it, const Ctx& a, unsigned char* ws, int r, int lane) {
    constexpr int I_IN = 16 * 72, I_OUT = 16 * 16;
    if (r < 4 * I_IN) { const int l = r / I_IN, q = r % I_IN, kb = q / 72, nb = q % 72;

#ifdef G1_F8
        cvt_desc(it, a.in(I_WIN) + (size_t)l * D * INW, INW, (unsigned char*)(ws + WS_WIN) + (size_t)l * INW * D, D, kb * 64, nb * 64, nb * 64, lane, 1); return; }
#else
        cvt_desc(it, a.in(I_WIN) + (size_t)l * D * INW, INW, (unsigned char*)((bf16_t*)(ws + WS_WIN) + (size_t)l * INW * D), D, kb * 64, nb * 64, nb * 64, lane, 0); return; }
#endif
    r -= 4 * I_IN;
    if (r < 4 * I_OUT) { const int l = r / I_OUT, q = r % I_OUT, kb = q / 16, nb = q % 16;

#ifdef G2_F8
        cvt_desc(it, a.in(I_WOUT) + (size_t)l * D * D, D, (unsigned char*)(ws + WS_WOUT) + (size_t)l * D * D, D, kb * 64, nb * 64, nb * 64, lane, 1); return; }
#else
        cvt_desc(it, a.in(I_WOUT) + (size_t)l * D * D, D, (unsigned char*)((bf16_t*)(ws + WS_WOUT) + (size_t)l * D * D), D, kb * 64, nb * 64, nb * 64, lane, 0); return; }
#endif
    r -= 4 * I_OUT;
    cvt_expert_desc(it, a, ws, r, lane);
}
__device__ __forceinline__ void p0_prologue(const Ctx& a) {
    PHASE_IDS(); LAS unsigned char* lds = launder_lds(a.lds); unsigned char* ws = a.ws(); const float* cin_ = a.in(I_C); const float* cctx_ = a.in(I_CCTX);
    LAS float* scond = (LAS float*)(lds + 8 * 16640);
    for (int i = tid; i < 3 * D; i += 512) { const int w = i >> 10, k = i & 1023; const float cv = (w < 2) ? cin_[w * D + k] : cctx_[k]; scond[i] = cv * pg8::fast_sigmoid(cv); }
    if (blockIdx.x == 0) { const int c = tid; const float* lg = a.in(I_LBL);
        const float l0 = lg[c], l1 = lg[512 + c], l2 = lg[1024 + c], l3 = lg[1536 + c]; const float mx = fmaxf(fmaxf(l0, l1), fmaxf(l2, l3));
        const float e0 = expf(l0 - mx), e1 = expf(l1 - mx), e2 = expf(l2 - mx), e3 = expf(l3 - mx), inv = 1.0f / (e0 + e1 + e2 + e3);
        float* lbs = (float*)(ws + WS_LBS); lbs[c] = 0.f; lbs[512 + c] = e1 * inv; lbs[1024 + c] = (e1 + e2) * inv; lbs[1536 + c] = (e1 + e2 + e3) * inv; }
    if (blockIdx.x >= 1 && blockIdx.x <= 16) { const int idx = (blockIdx.x - 1) * 512 + tid, pos = idx >> 5, f = idx & 31;
        const float invf = powf(10000.0f, -(float)f / 32.0f), ang = (float)pos * invf; float* cs = (float*)(ws + WS_ROPE); cs[idx * 2] = cosf(ang); cs[idx * 2 + 1] = sinf(ang); }
    BAR_LDS();
    const int gw = blockIdx.x * 8 + wave, NGW = gridDim.x * 8;
    for (int it = gw; it < 4 * 24 * 8; it += NGW) { const int l = it / 192, r = it % 192, cg = r >> 3, ks = r & 7; const int cols = cg * 256 + lane * 4;
        const float* wp = a.in(I_WADA) + ((size_t)l * D + ks * 128) * 6144 + cols; f32x4 a0 = {0, 0, 0, 0}, a1 = a0, a2 = a0;
#pragma unroll 8
        for (int kk = 0; kk < 128; ++kk) { const f32x4 w = *(const f32x4*)(wp + (size_t)kk * 6144); const int k = ks * 128 + kk; a0 += w * scond[k]; a1 += w * scond[D + k]; a2 += w * scond[2 * D + k]; }
        float* pp = (float*)(ws + WS_MODP) + (size_t)((l * 8 + ks) * 3) * 6144 + cols; *(f32x4*)pp = a0; *(f32x4*)(pp + 6144) = a1; *(f32x4*)(pp + 2 * 6144) = a2; }
#ifdef PROBE_NOBG
    const int n_exp = 4 * 24576;
#else
    const int n_exp = (gridDim.x == 256) ? CVT_N0 : 4 * 24576;
#endif
    const int NIT = 4 * (16 * 72 + 16 * 16) + n_exp;
    f32x4 va[16], vb[16]; CvtItem ia, ib; int it = gw;
    if (it < NIT) { p0_item_desc(ia, a, ws, it, lane); cvt_load(va, ia); }
    while (it < NIT) {
        int nx = it + NGW;
        if (nx < NIT) { p0_item_desc(ib, a, ws, nx, lane); cvt_load(vb, ib); }
        cvt_store(va, ia);
        it = nx; if (it >= NIT) break;
        nx = it + NGW;
        if (nx < NIT) { p0_item_desc(ia, a, ws, nx, lane); cvt_load(va, ia); }
        cvt_store(vb, ib);
        it = nx;
    }
}

__device__ __forceinline__ void p0_finalize(const Ctx& a) {
    PHASE_IDS(); unsigned char* ws = a.ws(); const float* bada = a.in(I_BADA); const float* part = (const float*)(ws + WS_MODP); float* mods = (float*)(ws + WS_MODS);
    for (int i = blockIdx.x * 512 + tid; i < 4 * 3 * 6144; i += gridDim.x * 512) { const int l = i / (3 * 6144), r = i % (3 * 6144), w = r / 6144, j = r % 6144;
        float s = bada[l * 6144 + j];
#pragma unroll
        for (int ks = 0; ks < 8; ++ks) s += part[(size_t)((l * 8 + ks) * 3 + w) * 6144 + j];
        mods[i] = s; }
}

template <int MODE>
__device__ __forceinline__ void norm1_phase(const Ctx& a, int l) {
    PHASE_IDS(); unsigned char* ws = a.ws(); const float* in_x = a.in(I_X); const float* in_ctx = a.in(I_CTX); const float* gm = (MODE != 1) ? a.in(I_GMIX) + l * D : a.in(I_GFIN); float* outp = a.out(); const int gw = blockIdx.x * 8 + wave, NGW = gridDim.x * 8;
    const float* mods = (const float*)(ws + WS_MODS); bf16_t* X = (bf16_t*)(ws + WS_X); bf16_t* H = (bf16_t*)(ws + WS_H);
    const int* inv = (const int*)(ws + WS_INV); const unsigned char* YS = (const unsigned char*)(ws + WS_YS); const float* gate = (const float*)(ws + WS_ROWMAP) + MOE_ROWS;
    constexpr int NTOT = (MODE == 1) ? NB * SEQ : MROWS;
#define N1_ROWOF(n_) ((MODE == 1) ? (((n_) >> 14) * LTOT + CTX + ((n_) & (SEQ - 1))) : (n_))
#define N1_LOADROW(n_, v_, iv_) do { const int r_ = N1_ROWOF(n_); const int b_ = r_ >= LTOT ? 1 : 0, g_ = r_ - b_ * LTOT; \
        if (l == 0) { const float* src_ = (g_ < CTX ? in_ctx + (size_t)(b_ * CTX + g_) * D : in_x + (size_t)(b_ * SEQ + g_ - CTX) * D); \
            _Pragma("unroll") for (int j = 0; j < 4; ++j) v_[j] = *(const f32x4*)(src_ + lane * 4 + 256 * j); } \
        else { const bf16_t* src_ = X + (size_t)r_ * D; _Pragma("unroll") for (int j = 0; j < 4; ++j) { const u32x2 w_ = *(const u32x2*)(src_ + lane * 4 + 256 * j); v_[j] = (f32x4){bf_lo(w_.x), bf_hi(w_.x), bf_lo(w_.y), bf_hi(w_.y)}; } \
            iv_ = inv[r_ * 16 + (lane & 15)]; } } while (0)
    f32x4 v[4]; int iv = -1; int n = gw;
    int curw = -1; f32x4 cgs[4], csh[4], cgt[4];
#pragma unroll
    for (int j = 0; j < 4; ++j) { cgs[j] = (f32x4){0.f, 0.f, 0.f, 0.f}; csh[j] = cgs[j]; cgt[j] = cgs[j]; }
    if (n < NTOT) N1_LOADROW(n, v, iv);
    for (; n < NTOT; n += NGW) {
        const int row = N1_ROWOF(n); const int b = row >= LTOT ? 1 : 0, g = row - b * LTOT; const bool isctx = g < CTX; const int which = isctx ? 2 : b;
        if (which != curw) { curw = which;
            if (MODE != 1) { const float* sh_ = mods + (size_t)(l * 3 + which) * 6144; const float* sc_ = sh_ + D;
#pragma unroll
                for (int j = 0; j < 4; ++j) { const int c = lane * 4 + 256 * j; cgs[j] = *(const f32x4*)(gm + c) * (*(const f32x4*)(sc_ + c) + 1.0f); csh[j] = *(const f32x4*)(sh_ + c); } }
            else {
#pragma unroll
                for (int j = 0; j < 4; ++j) cgs[j] = *(const f32x4*)(gm + lane * 4 + 256 * j); }
            if (l != 0) { const float* gt2_ = mods + (size_t)((l - 1) * 3 + which) * 6144 + 5 * D;
#pragma unroll
                for (int j = 0; j < 4; ++j) cgt[j] = *(const f32x4*)(gt2_ + lane * 4 + 256 * j); } }
        f32x4 vn[4]; int ivn = -1; const int nn = n + NGW;
        if (nn < NTOT) N1_LOADROW(nn, vn, ivn);
        if (l != 0) {
            unsigned vm = (unsigned)__builtin_amdgcn_ballot_w64(iv >= 0) & 0xffffu;
            f32x4 s[4] = {{0, 0, 0, 0}, {0, 0, 0, 0}, {0, 0, 0, 0}, {0, 0, 0, 0}};
            while (vm) {
                const int e0 = __builtin_ctz(vm); vm &= vm - 1; const bool has1 = vm != 0u; const int e1 = has1 ? __builtin_ctz(vm) : e0; if (has1) vm &= vm - 1;
                const int mr0 = __builtin_amdgcn_readlane(iv, e0), mr1 = __builtin_amdgcn_readlane(iv, e1);
                const float g0 = gate[mr0] * (1.0f / pg8::F8_SY), g1 = has1 ? gate[mr1] * (1.0f / pg8::F8_SY) : 0.f;
                const unsigned char* y0r = YS + (size_t)mr0 * D + lane * 4; const unsigned char* y1r = YS + (size_t)mr1 * D + lane * 4; unsigned y0[4], y1[4];
#pragma unroll
                for (int j = 0; j < 4; ++j) { y0[j] = *(const unsigned*)(y0r + 256 * j); y1[j] = *(const unsigned*)(y1r + 256 * j); }
#pragma unroll
                for (int j = 0; j < 4; ++j) { const f32x2 a01 = __builtin_amdgcn_cvt_pk_f32_fp8((int)y0[j], false), a23 = __builtin_amdgcn_cvt_pk_f32_fp8((int)y0[j], true);
                    const f32x2 b01 = __builtin_amdgcn_cvt_pk_f32_fp8((int)y1[j], false), b23 = __builtin_amdgcn_cvt_pk_f32_fp8((int)y1[j], true);
                    s[j][0] += g0 * a01.x + g1 * b01.x; s[j][1] += g0 * a01.y + g1 * b01.y; s[j][2] += g0 * a23.x + g1 * b23.x; s[j][3] += g0 * a23.y + g1 * b23.y; } }
            bf16_t* xr = X + (size_t)row * D;
#pragma unroll
            for (int j = 0; j < 4; ++j) { v[j] += cgt[j] * s[j]; if (MODE == 0) { u32x2 w; w.x = cvt_pk_bf16(v[j][0], v[j][1]); w.y = cvt_pk_bf16(v[j][2], v[j][3]); *(u32x2*)(xr + lane * 4 + 256 * j) = w; } }
        }
        float ss = 0.f;
#pragma unroll
        for (int j = 0; j < 4; ++j) ss += (v[j][0] * v[j][0] + v[j][1] * v[j][1]) + (v[j][2] * v[j][2] + v[j][3] * v[j][3]);
        const float rinv = __builtin_amdgcn_rsqf(wave_sum(ss, lane) * (1.0f / D) + EPS);
        if (MODE != 1) {
            bf16_t* hr = H + (size_t)row * D + lane * 4;
#pragma unroll
            for (int j = 0; j < 4; ++j) { const int c = lane * 4 + 256 * j; (void)c;
                const f32x4 y = v[j] * rinv * cgs[j] + csh[j];
#ifdef G1_F8
                *(unsigned*)((unsigned char*)H + (size_t)row * D + c) = pg8::pk4_fp8(y[0] * pg8::F8_SA, y[1] * pg8::F8_SA, y[2] * pg8::F8_SA, y[3] * pg8::F8_SA); }
#else
                u32x2 w; w.x = cvt_pk_bf16(y[0], y[1]); w.y = cvt_pk_bf16(y[2], y[3]); *(u32x2*)(hr + 256 * j) = w; }
#endif
        } else {
            float* orow = outp + (size_t)(b * SEQ + g - CTX) * D + lane * 4;
#pragma unroll
            for (int j = 0; j < 4; ++j) *(f32x4*)(orow + 256 * j) = v[j] * rinv * cgs[j];
        }
#pragma unroll
        for (int j = 0; j < 4; ++j) v[j] = vn[j];
        iv = ivn;
    }
#undef N1_ROWOF
#undef N1_LOADROW
}

constexpr int N2_WH = 0, N2_WL = 32768, N2_CS = 65536, N2_CH = 69632, N2_CE = 73728;
typedef __bf16 bf2v __attribute__((ext_vector_type(2)));
__device__ __forceinline__ float dot2_bf16(unsigned u, float c) { const bf2v v = __builtin_bit_cast(bf2v, u); return __builtin_amdgcn_fdot2_f32_bf16(v, v, c, false); }
__device__ __forceinline__ void norm2_phase(const Ctx& a, int l) {
    PHASE_IDS(); LAS unsigned char* lds = launder_lds(a.lds); unsigned char* ws = a.ws();
    const bf16_t* X = (const bf16_t*)(ws + WS_X); unsigned char* H8 = (unsigned char*)(ws + WS_H);
    int* inv = (int*)(ws + WS_INV); float* afl = (float*)(ws + WS_AFF); float* afc = afl + 2 * 16 * SEQ;
    const bool last = (l == DEPTH - 1);
    const int NQ = last ? 2048 : 2080;
    int built = -1;
    for (int q0 = blockIdx.x * 8; q0 < NQ; q0 += gridDim.x * 8) {
        const int which = q0 < 1024 ? 0 : (q0 < 2048 ? 1 : 2);
        const int q = q0 + wave; const bool isctx = q >= 2048;
        const int b = isctx ? ((q - 2048) >> 4) : (q >> 10), g0 = isctx ? ((q - 2048) & 15) * 16 : CTX + (q & 1023) * 16;
        const int row0 = b * LTOT + g0; const int r = lane & 15, kg = lane >> 4;
        u32x4 xa[32];
        { const bf16_t* xp = X + (size_t)(row0 + r) * D + 16 * kg;
#pragma unroll
          for (int c = 0; c < 16; ++c) { xa[2 * c] = *(const u32x4*)(xp + 64 * c); xa[2 * c + 1] = *(const u32x4*)(xp + 64 * c + 8); } }
        if (which != built) {
            if (built >= 0) BAR_LDS();
            const float* wr = a.in(I_WR) + (size_t)l * D * NE; const float* gm = a.in(I_GFFN) + l * D;
            const float* sh = (const float*)(ws + WS_MODS) + (size_t)(l * 3 + which) * 6144 + 3 * D; const float* sc = sh + D;
            const int e = tid & 15; float cpart = 0.f;
#pragma unroll 1
            for (int i = 0; i < 4; ++i) { const int u = tid + 512 * i; const int s = u >> 6, kgu = (u >> 4) & 3; const int k0 = 64 * (s >> 1) + 16 * kgu + 8 * (s & 1);
                u32x4 hi4, lo4;
#pragma unroll
                for (int h = 0; h < 2; ++h) { const f32x4 gg = *(const f32x4*)(gm + k0 + 4 * h), s1 = *(const f32x4*)(sc + k0 + 4 * h), s0 = *(const f32x4*)(sh + k0 + 4 * h); const f32x4 m = gg * (s1 + 1.0f);
#pragma unroll
                    for (int jp = 0; jp < 2; ++jp) { const int j = 4 * h + 2 * jp; const float w0 = wr[(k0 + j) * 16 + e], w1 = wr[(k0 + j + 1) * 16 + e];
                        const float v0 = m[2 * jp] * w0, v1 = m[2 * jp + 1] * w1; cpart += s0[2 * jp] * w0 + s0[2 * jp + 1] * w1;
                        const unsigned ph = cvt_pk_bf16(v0, v1); const unsigned pl = cvt_pk_bf16(v0 - bf_lo(ph), v1 - bf_hi(ph));
                        hi4[2 * h + jp] = ph; lo4[2 * h + jp] = pl; } }
                *(LAS u32x4*)(lds + N2_WH + u * 16) = hi4; *(LAS u32x4*)(lds + N2_WL + u * 16) = lo4; }
            cpart += shx(cpart, 16, lane); cpart += shx(cpart, 32, lane);
            if (lane < 16) ((LAS float*)(lds + N2_CE))[wave * 16 + lane] = cpart;
            if (tid < 256) { const int k = tid * 4; const f32x4 gg = *(const f32x4*)(gm + k), s1 = *(const f32x4*)(sc + k), s0 = *(const f32x4*)(sh + k);
                *(LAS f32x4*)(lds + N2_CS + k * 4) = gg * (s1 + 1.0f) * pg8::F8_SA; *(LAS f32x4*)(lds + N2_CH + k * 4) = s0 * pg8::F8_SA; }
            BAR_LDS(); built = which;
        }
        f32x4 acc = {0.f, 0.f, 0.f, 0.f}; float ss = 0.f;
#pragma unroll
        for (int s = 0; s < 32; ++s) {
            const bf16x8 wh = *(const LAS bf16x8*)(lds + N2_WH + (s * 64 + lane) * 16), wl = *(const LAS bf16x8*)(lds + N2_WL + (s * 64 + lane) * 16);
            const bf16x8 xf = __builtin_bit_cast(bf16x8, xa[s]);
            acc = __builtin_amdgcn_mfma_f32_16x16x32_bf16(wh, xf, acc, 0, 0, 0); acc = __builtin_amdgcn_mfma_f32_16x16x32_bf16(wl, xf, acc, 0, 0, 0);
            ss = dot2_bf16(xa[s][0], ss); ss = dot2_bf16(xa[s][1], ss); ss = dot2_bf16(xa[s][2], ss); ss = dot2_bf16(xa[s][3], ss);
            if ((s & 3) == 3) __builtin_amdgcn_sched_barrier(0); }
        ss += shx(ss, 16, lane); ss += shx(ss, 32, lane);
        const float rinv = __builtin_amdgcn_rsqf(ss * (1.0f / D) + EPS);
        {
            f32x4 ce = {0.f, 0.f, 0.f, 0.f};
#pragma unroll
            for (int w = 0; w < 8; ++w) ce += *(const LAS f32x4*)(lds + N2_CE + (w * 16 + 4 * kg) * 4);
            const f32x4 lg = acc * rinv + ce;
            float mx = fmaxf(fmaxf(lg[0], lg[1]), fmaxf(lg[2], lg[3])); mx = fmaxf(mx, shx(mx, 16, lane)); mx = fmaxf(mx, shx(mx, 32, lane));
            f32x4 ex; ex[0] = expf(lg[0] - mx); ex[1] = expf(lg[1] - mx); ex[2] = expf(lg[2] - mx); ex[3] = expf(lg[3] - mx);
            float sm = (ex[0] + ex[1]) + (ex[2] + ex[3]); sm += shx(sm, 16, lane); sm += shx(sm, 32, lane);
            float* dst = isctx ? afc + (size_t)(b * 16 + 4 * kg) * CTX + g0 + r : afl + (size_t)(b * 16 + 4 * kg) * SEQ + (g0 - CTX) + r; const int estr = isctx ? CTX : SEQ;
#pragma unroll
            for (int j = 0; j < 4; ++j) dst[(size_t)j * estr] = ex[j] / sm; }
        { typedef int i32x4 __attribute__((ext_vector_type(4))); int m1 = -1; asm volatile("" : "+v"(m1)); *(i32x4*)(inv + (size_t)row0 * 16 + lane * 4) = (i32x4){m1, m1, m1, m1}; }
        unsigned char* hp = H8 + (size_t)(row0 + r) * D + 16 * kg;
#pragma unroll
        for (int c = 0; c < 16; ++c) { const LAS f32x4* cs = (const LAS f32x4*)(lds + N2_CS + (64 * c + 16 * kg) * 4); const LAS f32x4* ch = (const LAS f32x4*)(lds + N2_CH + (64 * c + 16 * kg) * 4);
            u32x4 o;
#pragma unroll
            for (int h = 0; h < 4; ++h) { const unsigned w0 = xa[2 * c + (h >> 1)][2 * (h & 1)], w1 = xa[2 * c + (h >> 1)][2 * (h & 1) + 1];
                const f32x4 xv = {bf_lo(w0), bf_hi(w0), bf_lo(w1), bf_hi(w1)}; const f32x4 y = xv * rinv * cs[h] + ch[h]; o[h] = pg8::pk4_fp8(y[0], y[1], y[2], y[3]); }
            *(u32x4*)(hp + 64 * c) = o;
            if ((c & 1) == 1) __builtin_amdgcn_sched_barrier(0); }
    }
}

__device__ __forceinline__ void topk_phase(const Ctx& a, int l) {
    PHASE_IDS(); LAS unsigned char* lds = launder_lds(a.lds); unsigned char* ws = a.ws(); const float* afl = (const float*)(ws + WS_AFF); const float* afc = afl + 2 * 16 * SEQ;
    int* rowmap = (int*)(ws + WS_ROWMAP); float* gate = (float*)(ws + WS_ROWMAP) + MOE_ROWS; int* inv = (int*)(ws + WS_INV);
    LAS unsigned* wcnt = (LAS unsigned*)lds;
    const int nitems = (l == DEPTH - 1) ? 32 : 64;
    for (int it = blockIdx.x; it < nitems; it += gridDim.x) {
        const bool isctx = it >= 32; const int be = it & 31, b = be >> 4, e = be & 15;
        const int n = isctx ? CTX : SEQ, k = isctx ? CAP_CTX : CAP_LAT;
        const float* src = isctx ? afc + be * CTX : afl + (size_t)be * SEQ;
        unsigned key[32];
#pragma unroll
        for (int i = 0; i < 32; ++i) { const int idx = i * 512 + tid; key[i] = idx < n ? __float_as_uint(src[idx]) : 0u; }
        unsigned T = 0u;
        for (int bit = 30; bit >= 0; --bit) { const unsigned cand = T | (1u << bit); unsigned cnt = 0;
#pragma unroll
            for (int i = 0; i < 32; ++i) cnt += (key[i] >= cand) ? 1u : 0u;
#pragma unroll
            for (int o = 1; o < 64; o <<= 1) cnt += shxu(cnt, o, lane);
            LAS unsigned* wc = wcnt + (bit & 1) * 8; if (lane == 0) wc[wave] = cnt;
            BAR_LDS();
            unsigned tot = 0;
#pragma unroll
            for (int w = 0; w < 8; ++w) tot += wc[w];
            if (tot >= (unsigned)k) T = cand; }
        unsigned mine = 0;
#pragma unroll
        for (int i = 0; i < 32; ++i) mine += (key[i] > T ? 1u : 0u) + (key[i] == T ? 65536u : 0u);
        unsigned incl = mine;
#pragma unroll
        for (int o = 1; o < 64; o <<= 1) { const unsigned t = shupu(incl, o, lane); if (lane >= o) incl += t; }
        LAS unsigned* wt = wcnt + 16; BAR_LDS();
        if (lane == 63) wt[wave] = incl;
        BAR_LDS();
        unsigned base = 0, total = 0;
#pragma unroll
        for (int w = 0; w < 8; ++w) { const unsigned t = wt[w]; total += t; if (w < wave) base += t; }
        const unsigned excl = base + incl - mine; const unsigned cgt = total & 0xffffu; const unsigned need = (unsigned)k - cgt;
        unsigned sg = excl & 0xffffu, se = excl >> 16;
        const int mrbase = e * MOE_ROWS_E + (isctx ? 4096 + b * CAP_CTX : b * CAP_LAT);
        const int rbase = b * LTOT + (isctx ? 0 : CTX);
#pragma unroll
        for (int i = 0; i < 32; ++i) { const int idx = i * 512 + tid; const unsigned kk = key[i]; int slot = -1;
            if (kk > T) { slot = (int)sg; ++sg; } else if (kk == T) { if (se < need) slot = (int)(cgt + se); ++se; }
            if (slot >= 0) { const int mr = mrbase + slot, r = rbase + idx; rowmap[mr] = r; gate[mr] = __uint_as_float(kk); inv[r * 16 + e] = mr; } }
        if (isctx && b == 0 && tid < 192) { const int mr = e * MOE_ROWS_E + 4160 + tid; rowmap[mr] = 0; gate[mr] = 0.f; }
        BAR_LDS();
    }
}


constexpr int SC_QI = 0, SC_KI = 16384, SC_KT = 32768, SC_VT = 49152, SC_PI = 65536, SC_SM = 73728, SC_PART = 106496, SC_VA = 110592, SC_VB = 111104, SC_VM = 111616, SC_RED = 112128;
__device__ __forceinline__ int st_off(int r, int cbytes, int ncs) { return ((r >> 4) * ncs + (cbytes >> 6)) * 1024 + (r & 15) * 64 + ((cbytes & 63) ^ ((r & 8) << 2)); }
__device__ __forceinline__ int st_lane(int fr, int fq) { return fr * 64 + ((fq * 16) ^ ((fr & 8) << 2)); }
struct ScanBufs { int kt, vt, part, va, vb, vm; };
__device__ __forceinline__ ScanBufs scan_bufs(int parity) { ScanBufs b; b.kt = parity ? SC_QI : SC_KT; b.vt = parity ? SC_KI : SC_VT; b.part = parity ? SC_PI : SC_PART; b.va = parity ? SC_PI + 4096 : SC_VA; b.vb = parity ? SC_PI + 4608 : SC_VB; b.vm = parity ? SC_PI + 5120 : SC_VM; return b; }

__device__ __forceinline__ bf16x8 ldfrag(const LAS unsigned char* img, int tile, int ks, int ncs, int lp) { return *(const LAS bf16x8*)(img + (tile * ncs + ks) * 1024 + lp); }
#define MFMA16(a, b, c) __builtin_amdgcn_mfma_f32_16x16x32_bf16((a), (b), (c), 0, 0, 0)
#ifndef SCAN_LOG2
__device__ __forceinline__ float ex2(float x) { return __builtin_amdgcn_exp2f(x * 1.4426950408889634f); }
#define LOG2E_ 1.0f
#else
__device__ __forceinline__ float ex2(float x) { return __builtin_amdgcn_exp2f(x); }
#define LOG2E_ 1.4426950408889634f
#endif

__device__ __forceinline__ void scan_write_T(LAS unsigned char* img, const unsigned (&d)[8], int cp, int to) {
    u32x4 wa, wb;
    wa.x = (d[0] & 0xffffu) | (d[1] << 16); wa.y = (d[2] & 0xffffu) | (d[3] << 16); wa.z = (d[4] & 0xffffu) | (d[5] << 16); wa.w = (d[6] & 0xffffu) | (d[7] << 16);
    wb.x = (d[0] >> 16) | (d[1] & 0xffff0000u); wb.y = (d[2] >> 16) | (d[3] & 0xffff0000u); wb.z = (d[4] >> 16) | (d[5] & 0xffff0000u); wb.w = (d[6] >> 16) | (d[7] & 0xffff0000u);
    *(LAS u32x4*)(img + st_off(2 * cp, to * 16, 2)) = wa; *(LAS u32x4*)(img + st_off(2 * cp + 1, to * 16, 2)) = wb;
}

template <bool FULL>
__device__ __forceinline__ void scan_estage_hg(LAS unsigned char* lds, const ScanBufs& B, const unsigned (&kraw)[8], const unsigned (&qraw)[8], const unsigned (&vraw)[8], int lane, int wave, float& la_out, float& lb_out) {
    const int cp = lane, to = wave;
#ifndef SCAN_LOG2
    constexpr float LS = 1.4426950408889634f;
#else
    constexpr float LS = 1.0f;
#endif
    f32x2 c2[8]; f32x2 r2 = {0.f, 0.f};
#pragma unroll
    for (int tt = 0; tt < 8; ++tt) { r2 += (f32x2){bf_lo(kraw[tt]), bf_hi(kraw[tt])}; c2[tt] = r2; }
    *(LAS f32x2*)(lds + B.part + (to * 128 + 2 * cp) * 4) = r2;
    BAR_LDS();
    f32x2 p2 = {0.f, 0.f}, m2 = {0.f, 0.f}, l2 = {0.f, 0.f};
#pragma unroll
    for (int t8 = 0; t8 < 8; ++t8) { const f32x2 pp = *(const LAS f32x2*)(lds + B.part + (t8 * 128 + 2 * cp) * 4);
        if (t8 < to) p2 += pp; if (t8 < 4) m2 += pp; l2 += pp; }
    p2 = (p2 - m2) * LS;
    unsigned kd[8];
#pragma unroll
    for (int tt = 0; tt < 8; ++tt) { const int rr = 8 * to + tt;
        f32x2 d2 = p2 + c2[tt] * LS;
        d2 = __builtin_elementwise_min(__builtin_elementwise_max(d2, (f32x2){-120.f, -120.f}), (f32x2){120.f, 120.f});
        const f32x2 lf2 = (f32x2){bf_lo(kraw[tt]), bf_hi(kraw[tt])} * LS;
        const f32x2 k2 = (f32x2){1.0f, 1.0f} - (f32x2){__builtin_amdgcn_exp2f(lf2.x), __builtin_amdgcn_exp2f(lf2.y)};
        const f32x2 kt2 = k2 * (f32x2){__builtin_amdgcn_exp2f(-d2.x), __builtin_amdgcn_exp2f(-d2.y)};
        kd[tt] = cvt_pk_bf16(kt2.x, kt2.y);
        if (FULL) { const f32x2 qt2 = (f32x2){bf_lo(qraw[tt]), bf_hi(qraw[tt])} * (f32x2){__builtin_amdgcn_exp2f(d2.x), __builtin_amdgcn_exp2f(d2.y)};
            *(LAS unsigned*)(lds + SC_QI + st_off(rr, cp * 4, 4)) = cvt_pk_bf16(qt2.x, qt2.y);
            *(LAS unsigned*)(lds + SC_KI + st_off(rr, cp * 4, 4)) = kd[tt]; } }
    scan_write_T(lds + B.kt, kd, cp, to); scan_write_T(lds + B.vt, vraw, cp, to);
    if (to == 0) { *(LAS f32x2*)(lds + B.va + 8 * cp) = (f32x2){ex2(l2.x), ex2(l2.y)}; *(LAS f32x2*)(lds + B.vb + 8 * cp) = (f32x2){ex2(l2.x - m2.x), ex2(l2.y - m2.y)};
        *(LAS f32x2*)(lds + B.vm + 8 * cp) = (f32x2){ex2(m2.x), ex2(m2.y)}; }
    la_out = l2.x; lb_out = l2.y;
}
template <bool FULL>
__device__ __forceinline__ void scan_estage_ret(LAS unsigned char* lds, const ScanBufs& B, const unsigned (&kraw)[8], const unsigned (&qraw)[8], const unsigned (&vraw)[8], int lane, int wave, float lg2) {
    const int cp = lane, to = wave; unsigned kd[8];
#pragma unroll
    for (int tt = 0; tt < 8; ++tt) { const int rr = 8 * to + tt; const float wk = ex2((float)(63 - rr) * lg2); kd[tt] = cvt_pk_bf16(bf_lo(kraw[tt]) * wk, bf_hi(kraw[tt]) * wk);
        if (FULL) { *(LAS unsigned*)(lds + SC_QI + st_off(rr, cp * 4, 4)) = qraw[tt]; *(LAS unsigned*)(lds + SC_KI + st_off(rr, cp * 4, 4)) = kraw[tt]; } }
    scan_write_T(lds + B.kt, kd, cp, to); scan_write_T(lds + B.vt, vraw, cp, to);
}

template <bool RET>
__device__ __forceinline__ void scan_state_update(LAS unsigned char* lds, const ScanBufs& B, f32x4 (&ST)[8], int wave, int fr, int fq, float g64) {
    const int lp = st_lane(fr, fq);
    const bf16x8 a0 = ldfrag(lds + B.kt, wave, 0, 2, lp), a1 = ldfrag(lds + B.kt, wave, 1, 2, lp);
    f32x4 av = {g64, g64, g64, g64}, bv = {1.f, 1.f, 1.f, 1.f};
    if (!RET) { av = *(const LAS f32x4*)(lds + B.va + (16 * wave + 4 * fq) * 4); bv = *(const LAS f32x4*)(lds + B.vb + (16 * wave + 4 * fq) * 4); }
#pragma unroll
    for (int vi = 0; vi < 8; ++vi) { const bf16x8 b0 = ldfrag(lds + B.vt, vi, 0, 2, lp), b1 = ldfrag(lds + B.vt, vi, 1, 2, lp);
        f32x4 u = {0.f, 0.f, 0.f, 0.f}; u = MFMA16(a0, b0, u); u = MFMA16(a1, b1, u); ST[vi] = RET ? (av * ST[vi] + u) : (av * ST[vi] + bv * u); }
}

#define SCAN_LOAD_CHUNK(crow_, dir_) do { _Pragma("unroll") for (int tt = 0; tt < 8; ++tt) { const int rr_ = 8 * wave + tt; const size_t ro_ = (size_t)((crow_) + ((dir_) ? 63 - rr_ : rr_)) * INW + 2 * lane; \
        kraw[tt] = *(const unsigned*)(P + ro_ + colk); vraw[tt] = *(const unsigned*)(P + ro_ + colv); if (LOADQ) qraw[tt] = *(const unsigned*)(P + ro_ + colq); } } while (0)
#define SCAN_STORE_STATE(slot_) do { _Pragma("unroll") for (int vi = 0; vi < 8; ++vi) { u32x2 w; w.x = cvt_pk_bf16(ST[vi][0], ST[vi][1]); w.y = cvt_pk_bf16(ST[vi][2], ST[vi][3]); \
        *(u32x2*)(UB + (size_t)(slot_) * 16384 + (size_t)(vi * 512 + tid) * 4) = w; } } while (0)

struct ScanPtrs { const bf16_t* P; const bf16_t* SB; bf16_t* UB; float* AB; bf16_t* MIX; float* OB; const float* rdec; const float* onorm; };

__device__ __forceinline__ void scan1_hg_A(LAS unsigned char* lds, const ScanBufs& B, const unsigned (&kraw)[8], f32x2 (&c2)[8], int lane, int wave) {
    f32x2 r2 = {0.f, 0.f};
#pragma unroll
    for (int tt = 0; tt < 8; ++tt) { r2 += (f32x2){bf_lo(kraw[tt]), bf_hi(kraw[tt])}; c2[tt] = r2; }
    *(LAS f32x2*)(lds + B.part + (wave * 128 + 2 * lane) * 4) = r2;
}
__device__ __forceinline__ void scan1_hg_B(LAS unsigned char* lds, const ScanBufs& B, const unsigned (&kraw)[8], const unsigned (&vraw)[8], const f32x2 (&c2)[8], int lane, int wave, float& la_out, float& lb_out) {
    const int cp = lane, to = wave;
#ifndef SCAN_LOG2
    constexpr float LS = 1.4426950408889634f;
#else
    constexpr float LS = 1.0f;
#endif
    f32x2 p2 = {0.f, 0.f}, m2 = {0.f, 0.f}, l2 = {0.f, 0.f};
#pragma unroll
    for (int t8 = 0; t8 < 8; ++t8) { const f32x2 pp = *(const LAS f32x2*)(lds + B.part + (t8 * 128 + 2 * cp) * 4);
        if (t8 < to) p2 += pp; if (t8 < 4) m2 += pp; l2 += pp; }
    p2 = (p2 - m2) * LS;
    unsigned kd[8];
#pragma unroll
    for (int tt = 0; tt < 8; ++tt) {
        f32x2 d2 = p2 + c2[tt] * LS;
        d2 = __builtin_elementwise_min(__builtin_elementwise_max(d2, (f32x2){-120.f, -120.f}), (f32x2){120.f, 120.f});
        const f32x2 lf2 = (f32x2){bf_lo(kraw[tt]), bf_hi(kraw[tt])} * LS;
        const f32x2 k2 = (f32x2){1.0f, 1.0f} - (f32x2){__builtin_amdgcn_exp2f(lf2.x), __builtin_amdgcn_exp2f(lf2.y)};
        const f32x2 kt2 = k2 * (f32x2){__builtin_amdgcn_exp2f(-d2.x), __builtin_amdgcn_exp2f(-d2.y)};
        kd[tt] = cvt_pk_bf16(kt2.x, kt2.y); }
    scan_write_T(lds + B.kt, kd, cp, to); scan_write_T(lds + B.vt, vraw, cp, to);
    if (to == 0) { *(LAS f32x2*)(lds + B.va + 8 * cp) = (f32x2){ex2(l2.x), ex2(l2.y)}; *(LAS f32x2*)(lds + B.vb + 8 * cp) = (f32x2){ex2(l2.x - m2.x), ex2(l2.y - m2.y)}; }
    la_out = l2.x; lb_out = l2.y;
}
template <bool RET>
__device__ __forceinline__ void scan1_item(const ScanPtrs& sp, LAS unsigned char* lds, int tid, int lane, int wave, int seq, int tb) {
    const bf16_t* P = sp.P; bf16_t* UB = sp.UB; const int fr = lane & 15, fq = lane >> 4;
    const int b = seq >> 4, hh = (seq >> 1) & 7, dir = seq & 1, h = hh & 3;
    const int colk = RET ? 6 * 512 + h * 128 : (dir ? 2 * 512 : 512) + h * 128, colv = (RET ? 7 * 512 : 3 * 512) + h * 128;
    const float lg2 = RET ? -expf(sp.rdec[dir * 4 + h]) * LOG2E_ : 0.f, g64 = ex2(64.f * lg2);
    const int rowbase = b * LTOT + tb * 256;
    f32x4 ST[8];
#pragma unroll
    for (int vi = 0; vi < 8; ++vi) ST[vi] = (f32x4){0.f, 0.f, 0.f, 0.f};
    float ata = 0.f, atb = 0.f; unsigned kr[3][8], vr[3][8], qdummy[8]; f32x2 c2[2][8];
#pragma unroll
    for (int tt = 0; tt < 8; ++tt) qdummy[tt] = 0u;
#define S1_LOAD(set_, ci_) do { const int crow_ = rowbase + (dir ? 3 - (ci_) : (ci_)) * 64; _Pragma("unroll") for (int tt = 0; tt < 8; ++tt) { const int rr_ = 8 * wave + tt; const size_t ro_ = (size_t)(crow_ + (dir ? 63 - rr_ : rr_)) * INW + 2 * lane; \
        kr[set_][tt] = *(const unsigned*)(P + ro_ + colk); vr[set_][tt] = *(const unsigned*)(P + ro_ + colv); } } while (0)
#define S1_A(ci_) do { if (!RET) scan1_hg_A(lds, scan_bufs((ci_) & 1), kr[(ci_) % 3], c2[(ci_) & 1], lane, wave); } while (0)
#define S1_B(ci_) do { const ScanBufs B_ = scan_bufs((ci_) & 1); if (RET) scan_estage_ret<false>(lds, B_, kr[(ci_) % 3], qdummy, vr[(ci_) % 3], lane, wave, lg2); \
        else { float la_, lb_; scan1_hg_B(lds, B_, kr[(ci_) % 3], vr[(ci_) % 3], c2[(ci_) & 1], lane, wave, la_, lb_); ata += la_; atb += lb_; } } while (0)
#define S1_U(ci_) scan_state_update<RET>(lds, scan_bufs((ci_) & 1), ST, wave, fr, fq, g64)
    S1_LOAD(0, 0); S1_LOAD(1, 1); S1_LOAD(2, 2);
    S1_A(0);                         BAR_LDS();
    S1_B(0); S1_LOAD(0, 3); S1_A(1); BAR_LDS();
    S1_U(0); S1_B(1); S1_A(2);       BAR_LDS();
    S1_U(1); S1_B(2); S1_A(3);       BAR_LDS();
    S1_U(2); S1_B(3);                BAR_LDS();
    S1_U(3);
#undef S1_LOAD
#undef S1_A
#undef S1_B
#undef S1_U
    const int slot = seq * 65 + tb;
    SCAN_STORE_STATE(slot);
    if (wave == 0) *(f32x2*)(sp.AB + (size_t)slot * 128 + 2 * lane) = RET ? (f32x2){ex2(256.f * lg2), ex2(256.f * lg2)} : (f32x2){ex2(ata), ex2(atb)};
}

template <bool RET>
__device__ __forceinline__ void scan3_item(const ScanPtrs& sp, LAS unsigned char* lds, int tid, int lane, int wave, int bh, int tb, bool store_state, int nch = 4) {
#ifdef PROBE_SKIP
    if ((PROBE_SKIP == 1 && RET) || (PROBE_SKIP == 2 && !RET)) return;
#endif
    const bf16_t* P = sp.P; bf16_t* UB = sp.UB; float* OB = sp.OB;
    const int ti = wave & 3, vh = wave >> 2; constexpr bool LOADQ = true;
    const int b = bh >> 3, hh = bh & 7, h = hh & 3;
    const int colq = (RET ? 5 * 512 : 0) + h * 128, colv = (RET ? 7 * 512 : 3 * 512) + h * 128, colg = (RET ? 8 * 512 : 4 * 512) + h * 128, mixcol = hh * 128;
    const int rowbase = b * LTOT + tb * 256;
#pragma unroll 1
    for (int dir = 1; dir >= 0; --dir) {
        const int colk = RET ? 6 * 512 + h * 128 : (dir ? 2 * 512 : 512) + h * 128;
        const float lg2 = RET ? -expf(sp.rdec[dir * 4 + h]) * LOG2E_ : 0.f, g64 = ex2(64.f * lg2);
        f32x4 ST[8];
        if (tb == 0) {
#pragma unroll
            for (int vi = 0; vi < 8; ++vi) ST[vi] = (f32x4){0.f, 0.f, 0.f, 0.f};
        } else { const size_t slot = (size_t)(bh * 2 + dir) * 65 + tb + ((nch == 8 && dir) ? 1 : 0);
#pragma unroll
            for (int vi = 0; vi < 8; ++vi) { const u32x2 w = *(const u32x2*)(sp.SB + slot * 16384 + (size_t)(vi * 512 + tid) * 4); ST[vi] = (f32x4){bf_lo(w.x), bf_hi(w.x), bf_lo(w.y), bf_hi(w.y)}; } }
        float ata = 0.f, atb = 0.f; unsigned kraw[8], qraw[8], vraw[8];
        SCAN_LOAD_CHUNK(rowbase + (dir ? nch - 1 : 0) * 64, dir);
#pragma unroll 1
        for (int ci = 0; ci < nch; ++ci) {
            const int tc = dir ? nch - 1 - ci : ci;
            int lane_ = lane; asm volatile("" : "+v"(lane_));
            const int fr = lane_ & 15, fq = lane_ >> 4, t = 16 * ti + fr; const float gt1 = ex2((float)(t + 1) * lg2);
            const ScanBufs B0 = scan_bufs(0);
            if (RET) scan_estage_ret<true>(lds, B0, kraw, qraw, vraw, lane, wave, lg2);
            else { float la, lb; scan_estage_hg<true>(lds, B0, kraw, qraw, vraw, lane, wave, la, lb); ata += la; atb += lb; }
#ifdef PROBE_S3_E2
            BAR_LDS();
            if (RET) scan_estage_ret<true>(lds, B0, kraw, qraw, vraw, lane, wave, lg2);
            else { float la, lb; scan_estage_hg<true>(lds, B0, kraw, qraw, vraw, lane, wave, la, lb); }
#endif
            if (ci < nch - 1) { const int tcn = dir ? nch - 2 - ci : ci + 1; SCAN_LOAD_CHUNK(rowbase + tcn * 64, dir); }
            const int tok = tc * 64 + (dir ? 63 - t : t), grow = rowbase + tok;
            u32x2 obv[4]; u32x2 gv[4];
            if (dir == 0) {
#pragma unroll
                for (int j = 0; j < 4; ++j) gv[j] = *(const u32x2*)(P + (size_t)grow * INW + colg + 16 * (4 * vh + j) + 4 * fq);
#pragma unroll
                for (int jp = 0; jp < 2; ++jp) { const u32x4 w4 = *((const u32x4*)OB + ((((tc * 4 + ti) * 2 + vh) * 2 + jp) * 64 + fq * 16 + fr)); obv[2 * jp] = (u32x2){w4.x, w4.y}; obv[2 * jp + 1] = (u32x2){w4.z, w4.w}; } }
            if (!RET) BAR_LDS();
            { f32x4 em = {1.f, 1.f, 1.f, 1.f}; if (!RET) em = *(const LAS f32x4*)(lds + SC_VM + (16 * wave + 4 * fq) * 4);
#pragma unroll
              for (int vi = 0; vi < 8; ++vi) { const f32x4 x = RET ? ST[vi] : ST[vi] * em; u32x2 w; w.x = cvt_pk_bf16(x[0], x[1]); w.y = cvt_pk_bf16(x[2], x[3]); *(LAS u32x2*)(lds + SC_SM + st_off(16 * vi + fr, 32 * wave + 8 * fq, 4)) = w; } }
            if (RET) BAR_LDS();
#pragma unroll
            for (int sii = 0; sii < 2; ++sii) { const int si = 2 * vh + sii; f32x4 sc = {0.f, 0.f, 0.f, 0.f};
                if (si <= ti) {
#pragma unroll
                    for (int ks = 0; ks < 4; ++ks) sc = MFMA16(ldfrag(lds + SC_KI, si, ks, 4, st_lane(fr, fq)), ldfrag(lds + SC_QI, ti, ks, 4, st_lane(fr, fq)), sc);
                    const int s0 = 16 * si + 4 * fq;
#pragma unroll
                    for (int r = 0; r < 4; ++r) { const float dm = RET ? ex2((float)(t - s0 - r) * lg2) : 1.0f; sc[r] = (s0 + r <= t) ? sc[r] * dm : 0.f; } }
                u32x2 w; w.x = cvt_pk_bf16(sc[0], sc[1]); w.y = cvt_pk_bf16(sc[2], sc[3]); *(LAS u32x2*)(lds + SC_PI + st_off(t, 32 * si + 8 * fq, 2)) = w; }
            BAR_LDS();
            f32x4 o[4];
#pragma unroll
            for (int j = 0; j < 4; ++j) o[j] = (f32x4){0.f, 0.f, 0.f, 0.f};
            {
                const int lp = st_lane(fr, fq);
                const LAS unsigned char* pq = lds + SC_QI + (ti * 4) * 1024 + lp;
                const LAS unsigned char* pm = lds + SC_SM + (4 * vh * 4) * 1024 + lp;
                const LAS unsigned char* pp = lds + SC_PI + (ti * 2) * 1024 + lp;
                const LAS unsigned char* pv = lds + SC_VT + (4 * vh * 2) * 1024 + lp;
                const LAS unsigned char* pk = lds + SC_KT + (wave * 2) * 1024 + lp;
                const LAS unsigned char* pw = lds + SC_VT + lp;
                f32x4 av = {g64, g64, g64, g64}, bv = {1.f, 1.f, 1.f, 1.f};
                if (!RET) { av = *(const LAS f32x4*)(lds + SC_VA + (16 * wave + 4 * fq) * 4); bv = *(const LAS f32x4*)(lds + SC_VB + (16 * wave + 4 * fq) * 4); }
#define SC_LD(p_, off_) (*(const LAS bf16x8*)((p_) + (off_)))
#define SC_FENCE() __builtin_amdgcn_sched_barrier(0)
                bf16x8 qa, ma[4], qb, mb[4], qc, mc[4];
                qa = SC_LD(pq, 0); _Pragma("unroll") for (int j = 0; j < 4; ++j) ma[j] = SC_LD(pm, 4096 * j);
                qb = SC_LD(pq, 1024); _Pragma("unroll") for (int j = 0; j < 4; ++j) mb[j] = SC_LD(pm, 4096 * j + 1024);
                SC_FENCE();
                qc = SC_LD(pq, 2048); _Pragma("unroll") for (int j = 0; j < 4; ++j) mc[j] = SC_LD(pm, 4096 * j + 2048);
                _Pragma("unroll") for (int j = 0; j < 4; ++j) o[j] = MFMA16(ma[j], qa, o[j]);
                SC_FENCE();
                qa = SC_LD(pq, 3072); _Pragma("unroll") for (int j = 0; j < 4; ++j) ma[j] = SC_LD(pm, 4096 * j + 3072);
                _Pragma("unroll") for (int j = 0; j < 4; ++j) o[j] = MFMA16(mb[j], qb, o[j]);
                SC_FENCE();
                qb = SC_LD(pp, 0); _Pragma("unroll") for (int j = 0; j < 4; ++j) mb[j] = SC_LD(pv, 2048 * j);
                _Pragma("unroll") for (int j = 0; j < 4; ++j) o[j] = MFMA16(mc[j], qc, o[j]);
                SC_FENCE();
                qc = SC_LD(pp, 1024); _Pragma("unroll") for (int j = 0; j < 4; ++j) mc[j] = SC_LD(pv, 2048 * j + 1024);
                _Pragma("unroll") for (int j = 0; j < 4; ++j) o[j] = MFMA16(ma[j], qa, o[j]);
                SC_FENCE();
                if (RET) { _Pragma("unroll") for (int j = 0; j < 4; ++j) o[j] *= gt1; }
                bf16x8 k0 = SC_LD(pk, 0), k1 = SC_LD(pk, 1024), w0[4], w1[4];
                _Pragma("unroll") for (int q = 0; q < 2; ++q) { w0[q] = SC_LD(pw, 2048 * q); w1[q] = SC_LD(pw, 2048 * q + 1024); }
                _Pragma("unroll") for (int j = 0; j < 4; ++j) o[j] = MFMA16(mb[j], qb, o[j]);
                SC_FENCE();
                _Pragma("unroll") for (int q = 2; q < 4; ++q) { w0[q] = SC_LD(pw, 2048 * q); w1[q] = SC_LD(pw, 2048 * q + 1024); }
                _Pragma("unroll") for (int j = 0; j < 4; ++j) o[j] = MFMA16(mc[j], qc, o[j]);
                SC_FENCE();
                bf16x8 x0[4], x1[4];
                _Pragma("unroll") for (int q = 0; q < 4; ++q) { x0[q] = SC_LD(pw, 2048 * (4 + q)); x1[q] = SC_LD(pw, 2048 * (4 + q) + 1024); }
                _Pragma("unroll") for (int q = 0; q < 4; ++q) { f32x4 u = {0.f, 0.f, 0.f, 0.f}; u = MFMA16(k0, w0[q], u); u = MFMA16(k1, w1[q], u); ST[q] = RET ? (av * ST[q] + u) : (av * ST[q] + bv * u); }
                SC_FENCE();
                _Pragma("unroll") for (int q = 0; q < 4; ++q) { f32x4 u = {0.f, 0.f, 0.f, 0.f}; u = MFMA16(k0, x0[q], u); u = MFMA16(k1, x1[q], u); ST[4 + q] = RET ? (av * ST[4 + q] + u) : (av * ST[4 + q] + bv * u); }
#undef SC_LD
#undef SC_FENCE
            }
            if (dir == 1) {
#pragma unroll
                for (int jp = 0; jp < 2; ++jp) { u32x4 w4; w4.x = cvt_pk_bf16(o[2 * jp][0], o[2 * jp][1]); w4.y = cvt_pk_bf16(o[2 * jp][2], o[2 * jp][3]); w4.z = cvt_pk_bf16(o[2 * jp + 1][0], o[2 * jp + 1][1]); w4.w = cvt_pk_bf16(o[2 * jp + 1][2], o[2 * jp + 1][3]); *((u32x4*)OB + ((((tc * 4 + (3 - ti)) * 2 + vh) * 2 + jp) * 64 + fq * 16 + (15 - fr))) = w4; }
                BAR_LDS();
            } else {
                float ss = 0.f;
#pragma unroll
                for (int j = 0; j < 4; ++j) { o[j] += (f32x4){bf_lo(obv[j].x), bf_hi(obv[j].x), bf_lo(obv[j].y), bf_hi(obv[j].y)}; ss += (o[j][0] * o[j][0] + o[j][1] * o[j][1]) + (o[j][2] * o[j][2] + o[j][3] * o[j][3]); }
                ss += shx(ss, 16, lane_); ss += shx(ss, 32, lane_);
                if (fq == 0) *(LAS float*)(lds + SC_RED + ((ci & 1) * 128 + vh * 64 + t) * 4) = ss;
                BAR_LDS();
                const float tot = ss + *(const LAS float*)(lds + SC_RED + ((ci & 1) * 128 + (vh ^ 1) * 64 + t) * 4);
                const float rinv = __builtin_amdgcn_rsqf(tot * (1.0f / 128.0f) + EPS);
#pragma unroll
                for (int j = 0; j < 4; ++j) { const f32x4 onv = RET ? (f32x4){1.f, 1.f, 1.f, 1.f} : *(const f32x4*)(sp.onorm + 16 * (4 * vh + j) + 4 * fq);
                    const f32x4 y = o[j] * rinv * onv * (f32x4){bf_lo(gv[j].x), bf_hi(gv[j].x), bf_lo(gv[j].y), bf_hi(gv[j].y)};
                    u32x2 w; w.x = cvt_pk_bf16(y[0], y[1]); w.y = cvt_pk_bf16(y[2], y[3]); *(u32x2*)(sp.MIX + (size_t)grow * D + mixcol + 16 * (4 * vh + j) + 4 * fq) = w; }
#ifdef PROBE_BAR
                BAR_LDS();
#endif
            }
        }
        if (store_state) { const int slot = (bh * 2 + dir) * 65 + tb; SCAN_STORE_STATE(slot);
            if (wave == 0) *(f32x2*)(sp.AB + (size_t)slot * 128 + 2 * lane) = RET ? (f32x2){ex2(256.f * lg2), ex2(256.f * lg2)} : (f32x2){ex2(ata), ex2(atb)}; }
        BAR_ALL();
    }
}

__device__ __forceinline__ ScanPtrs scan_ptrs(const Ctx& a, int l) {
    unsigned char* ws = a.ws(); ScanPtrs sp; sp.P = (const bf16_t*)(ws + WS_P); sp.SB = (const bf16_t*)(ws + WS_SB); sp.UB = (bf16_t*)(ws + WS_UB); sp.AB = (float*)(ws + WS_AB); sp.MIX = (bf16_t*)(ws + WS_MIX);
    sp.OB = (float*)(ws + WS_OB) + (size_t)blockIdx.x * 32768; sp.rdec = a.in(I_RDEC) + l * 8; sp.onorm = a.in(I_ONORM) + l * 128; return sp;
}

constexpr int SW_KT = 0, SW_VT = 65536, SW_PART = 131072;
struct S1Id { int seq, tb; };
__device__ __forceinline__ void scan_write_T8(LAS unsigned char* img, const unsigned (&d)[8], int cp, int tg) {
    u32x4 wa, wb;
    wa.x = (d[0] & 0xffffu) | (d[1] << 16); wa.y = (d[2] & 0xffffu) | (d[3] << 16); wa.z = (d[4] & 0xffffu) | (d[5] << 16); wa.w = (d[6] & 0xffffu) | (d[7] << 16);
    wb.x = (d[0] >> 16) | (d[1] & 0xffff0000u); wb.y = (d[2] >> 16) | (d[3] & 0xffff0000u); wb.z = (d[4] >> 16) | (d[5] & 0xffff0000u); wb.w = (d[6] >> 16) | (d[7] & 0xffff0000u);
    *(LAS u32x4*)(img + st_off(2 * cp, tg * 16, 8)) = wa; *(LAS u32x4*)(img + st_off(2 * cp + 1, tg * 16, 8)) = wb;
}
#define S1W_LOAD(id_) do { const int seq_ = (id_).seq, hh_ = (seq_ >> 1) & 7, dir_ = seq_ & 1, h_ = hh_ & 3; const bool ret_ = hh_ >= 4; \
        const int colk_ = ret_ ? 6 * 512 + h_ * 128 : (dir_ ? 2 * 512 : 512) + h_ * 128, colv_ = (ret_ ? 7 * 512 : 3 * 512) + h_ * 128; \
        const int row0_ = (seq_ >> 4) * LTOT + (id_).tb * 256; int ln_ = lane; asm volatile("" : "+v"(ln_)); \
        _Pragma("unroll") for (int i = 0; i < 32; ++i) { const int p_ = 32 * wave + i; const size_t ro_ = (size_t)(row0_ + (dir_ ? 255 - p_ : p_)) * INW + 2 * ln_; \
            kr[i] = *(const unsigned*)(sp.P + ro_ + colk_); vr[i] = *(const unsigned*)(sp.P + ro_ + colv_); } } while (0)
__device__ __forceinline__ void scan1w_item(const ScanPtrs& sp, LAS unsigned char* lds, int lane, int wave, const S1Id id, unsigned (&kr)[32], unsigned (&vr)[32], bool have_next, const S1Id nxt) {
    asm volatile("" : "+v"(lane), "+s"(wave)); const int tid = wave * 64 + lane;
    bf16_t* UB = sp.UB; const int fr = lane & 15, fq = lane >> 4;
    const int seq = id.seq, tb = id.tb, hh = (seq >> 1) & 7, dir = seq & 1, h = hh & 3; const bool RET = hh >= 4;
    const float lg2 = RET ? -expf(sp.rdec[dir * 4 + h]) * LOG2E_ : 0.f;
#ifndef SCAN_LOG2
    constexpr float LS = 1.4426950408889634f;
#else
    constexpr float LS = 1.0f;
#endif
    if (!RET) { f32x2 t2 = {0.f, 0.f};
#pragma unroll
        for (int i = 0; i < 32; ++i) t2 += (f32x2){bf_lo(kr[i]), bf_hi(kr[i])};
        *(LAS f32x2*)(lds + SW_PART + (wave * 64 + lane) * 8) = t2; }
    BAR_LDS();
    f32x2 pw = {0.f, 0.f}, T2 = {0.f, 0.f};
    if (!RET) {
#pragma unroll
        for (int w8 = 0; w8 < 8; ++w8) { const f32x2 pp = *(const LAS f32x2*)(lds + SW_PART + (w8 * 64 + lane) * 8); if (w8 < wave) pw += pp; T2 += pp; } }
    f32x2 r2 = pw;
#pragma unroll
    for (int g = 0; g < 4; ++g) { unsigned kd[8], vv[8];
#pragma unroll
        for (int tt = 0; tt < 8; ++tt) { const int i = 8 * g + tt; vv[tt] = vr[i];
            if (RET) { const float wk = ex2((float)(255 - (32 * wave + i)) * lg2); kd[tt] = cvt_pk_bf16(bf_lo(kr[i]) * wk, bf_hi(kr[i]) * wk); }
            else { const f32x2 lf = {bf_lo(kr[i]), bf_hi(kr[i])}; r2 += lf;
                f32x2 d2 = (T2 - r2) * LS; d2 = __builtin_elementwise_max(d2, (f32x2){-120.f, -120.f});
                const f32x2 lf2 = lf * LS; const f32x2 k2 = (f32x2){1.0f, 1.0f} - (f32x2){__builtin_amdgcn_exp2f(lf2.x), __builtin_amdgcn_exp2f(lf2.y)};
                const f32x2 kt2 = k2 * (f32x2){__builtin_amdgcn_exp2f(d2.x), __builtin_amdgcn_exp2f(d2.y)}; kd[tt] = cvt_pk_bf16(kt2.x, kt2.y); } }
        scan_write_T8(lds + SW_KT, kd, lane, 4 * wave + g); scan_write_T8(lds + SW_VT, vv, lane, 4 * wave + g); }
    if (have_next) S1W_LOAD(nxt);
    BAR_LDS();
    f32x4 ST[8];
#pragma unroll
    for (int vi = 0; vi < 8; ++vi) ST[vi] = (f32x4){0.f, 0.f, 0.f, 0.f};
    { const int lp = st_lane(fr, fq);
#pragma unroll
      for (int ks = 0; ks < 8; ++ks) { const bf16x8 af = ldfrag(lds + SW_KT, wave, ks, 8, lp);
#pragma unroll
          for (int vi = 0; vi < 8; ++vi) ST[vi] = MFMA16(af, ldfrag(lds + SW_VT, vi, ks, 8, lp), ST[vi]);
          if (ks & 1) __builtin_amdgcn_sched_barrier(0); } }
    const int slot = seq * 65 + tb;
    SCAN_STORE_STATE(slot);
    if (wave == 0) *(f32x2*)(sp.AB + (size_t)slot * 128 + 2 * lane) = RET ? (f32x2){ex2(256.f * lg2), ex2(256.f * lg2)} : (f32x2){ex2(T2.x), ex2(T2.y)};
}
__device__ __forceinline__ bool s1_enum(bool modeA, bool last, int c, int G, int& k, S1Id& id) {
    constexpr int HS = 7;
    for (;; ++k) {
        if (modeA) { const int it = c + k * G; if (it >= 2048) return false; const int seq = it >> 6, j = it & 63; if (!last && j == 0) continue;
            id.seq = seq; id.tb = (seq & 1) ? (j == 0 ? 0 : 65 - j) : j; ++k; return true; }
        const int li = k < HS ? k * (G - 16) + (c - 16) : HS * (G - 16) + (k - HS) * G + c;
        if (li >= 2016) return false;
        const int seq = li / 63, j = 1 + li % 63; id.seq = seq; id.tb = (seq & 1) ? 65 - j : j; ++k; return true; }
}

__device__ __forceinline__ void scan1_phase(const Ctx& a, int l) {
    PHASE_IDS(); LAS unsigned char* lds = launder_lds(a.lds); const ScanPtrs sp = scan_ptrs(a, l);
#ifdef PROBE_NOMERGE
    const bool last = true; const int c = blockIdx.x, G = gridDim.x;
#else
    const bool last = (l == DEPTH - 1); const int c = blockIdx.x, G = gridDim.x;
#endif
#ifdef SCAN_PRIO1
    if (wave >= 4) __builtin_amdgcn_s_setprio(1);
#endif
#ifdef S1_WIDE
    { const bool modeA = last || G < 32;
      if (!last) { if (modeA) { for (int bh = c; bh < 16; bh += G) { if ((bh & 7) >= 4) scan3_item<true>(sp, lds, tid, lane, wave, bh, 0, true); else scan3_item<false>(sp, lds, tid, lane, wave, bh, 0, true); } }
                   else if (c < 16) { if ((c & 7) >= 4) scan3_item<true>(sp, lds, tid, lane, wave, c, 0, true); else scan3_item<false>(sp, lds, tid, lane, wave, c, 0, true); } }
      int k = (!modeA && c < 16) ? 7 : 0; S1Id id, nx; unsigned kr[32], vr[32];
      bool have = s1_enum(modeA, last, c, G, k, id);
      if (have) S1W_LOAD(id);
      while (have) { nx = id; const bool have2 = s1_enum(modeA, last, c, G, k, nx);
          scan1w_item(sp, lds, lane, wave, id, kr, vr, have2, nx);
          have = have2; id = nx; }
      BAR_LDS();
      return; }
#endif
    if (last || G < 32) {
        if (!last) for (int bh = c; bh < 16; bh += G) { if ((bh & 7) >= 4) scan3_item<true>(sp, lds, tid, lane, wave, bh, 0, true); else scan3_item<false>(sp, lds, tid, lane, wave, bh, 0, true); }
        for (int it = c; it < 2048; it += G) { const int seq = it >> 6, j = it & 63; if (!last && j == 0) continue; const int dir = seq & 1, tb = dir ? (j == 0 ? 0 : 65 - j) : j;
            if (((seq >> 1) & 7) >= 4) scan1_item<true>(sp, lds, tid, lane, wave, seq, tb); else scan1_item<false>(sp, lds, tid, lane, wave, seq, tb); }
        return;
    }
    if (c < 16) { if ((c & 7) >= 4) scan3_item<true>(sp, lds, tid, lane, wave, c, 0, true); else scan3_item<false>(sp, lds, tid, lane, wave, c, 0, true); }
    constexpr int HS = 7;
    for (int k = (c < 16 ? HS : 0);; ++k) {
        const int li = k < HS ? k * (G - 16) + (c - 16) : HS * (G - 16) + (k - HS) * G + c;
        if (li >= 2016) break;
        const int seq = li / 63, j = 1 + li % 63, dir = seq & 1, tb = dir ? 65 - j : j;
        if (((seq >> 1) & 7) >= 4) scan1_item<true>(sp, lds, tid, lane, wave, seq, tb); else scan1_item<false>(sp, lds, tid, lane, wave, seq, tb);
    }
}

__device__ __forceinline__ void scan2_phase(const Ctx& a) {
#ifdef SCAN_PRIO1
    __builtin_amdgcn_s_setprio(0);
#endif
    PHASE_IDS(); unsigned char* ws = a.ws(); const bf16_t* UB = (const bf16_t*)(ws + WS_UB); bf16_t* SB = (bf16_t*)(ws + WS_SB); const float* AB = (const float*)(ws + WS_AB);
    const int c0 = 16 * (tid >> 6) + 4 * ((tid >> 4) & 3);
    for (int p = blockIdx.x; p < 256; p += gridDim.x) { const int seq = p >> 3, vi = p & 7, dir = seq & 1; const size_t eo = (size_t)(vi * 512 + tid) * 4;
        f32x4 s = {0.f, 0.f, 0.f, 0.f};
#define S2_SLOT(j_) ((size_t)seq * 65 + (dir ? ((j_) == 0 ? 0 : 65 - (j_)) : (j_)))
#define S2_LOAD(u_, av_, j0_) do { _Pragma("unroll") for (int q = 0; q < 8; ++q) { const size_t slot = S2_SLOT((j0_) + q); u_[q] = *(const u32x2*)(UB + slot * 16384 + eo); av_[q] = *(const f32x4*)(AB + slot * 128 + c0); } } while (0)
#define S2_STEP(u_, av_, j0_) do { _Pragma("unroll") for (int q = 0; q < 8; ++q) { const size_t slot = S2_SLOT((j0_) + q); \
            if (q & 1) { u32x2 w; w.x = cvt_pk_bf16(s[0], s[1]); w.y = cvt_pk_bf16(s[2], s[3]); *(u32x2*)(SB + slot * 16384 + eo) = w; }     \
            s = av_[q] * s + (f32x4){bf_lo(u_[q].x), bf_hi(u_[q].x), bf_lo(u_[q].y), bf_hi(u_[q].y)}; } } while (0)
        u32x2 ua[8], ub[8]; f32x4 aa[8], ab[8];
        S2_LOAD(ua, aa, 0);
#pragma unroll 1
        for (int j0 = 0; j0 < 64; j0 += 16) {
            S2_LOAD(ub, ab, j0 + 8);
            S2_STEP(ua, aa, j0);
            if (j0 + 16 < 64) S2_LOAD(ua, aa, j0 + 16);
            S2_STEP(ub, ab, j0 + 8); }
#undef S2_SLOT
#undef S2_LOAD
#undef S2_STEP
    }
}

__device__ __forceinline__ void scan3_phase(const Ctx& a, int l) {
    PHASE_IDS(); LAS unsigned char* lds = launder_lds(a.lds); const ScanPtrs sp = scan_ptrs(a, l);
#ifdef SCAN_PRIO
    if (wave >= 4) __builtin_amdgcn_s_setprio(1);
#endif
#ifdef PROBE_NOMERGE
    if (l != DEPTH - 1) for (int bh = blockIdx.x; bh < 16; bh += gridDim.x) { if ((bh & 7) >= 4) scan3_item<true>(sp, lds, tid, lane, wave, bh, 0, false); else scan3_item<false>(sp, lds, tid, lane, wave, bh, 0, false); }
#endif
    for (int it = blockIdx.x; it < 512; it += gridDim.x) { const int half = it >> 8, cc = it & 255; const int bh = (cc & 15) ^ (half ? 4 : 0), tb = 1 + 2 * ((half << 4) + (cc >> 4));
        if ((bh & 7) >= 4) scan3_item<true>(sp, lds, tid, lane, wave, bh, tb, false, 8); else scan3_item<false>(sp, lds, tid, lane, wave, bh, tb, false, 8); }
#ifdef SCAN_PRIO
    __builtin_amdgcn_s_setprio(0);
#endif
}

struct OutOrder {
    static constexpr bool PADTILES = false;
    __device__ __forceinline__ bool half_rows(const pg8::Unit&) const { return false; }
    int nrt, skipctx, G, c;
    __device__ __forceinline__ bool next(int i, pg8::Unit& u) const {
        const int L = i * G + c; if (L >= nrt * 4) return false;
        const int r = L >> 2; u.pn = L & 3; u.pm = skipctx ? r + 1 + (r >= 64 ? 1 : 0) : r; return true;
    }
    __device__ __forceinline__ void a_ready(const pg8::Unit&) const {}
    __device__ __forceinline__ void done(const pg8::Unit&) const {}
};

#ifndef PH
#define PH 0xffff
#endif
#ifndef DBL
#define DBL 0
#endif
__global__ void __launch_bounds__(512, 2) mega_fwd(Args a) {
    extern __shared__ __attribute__((aligned(16))) unsigned char lds_raw[];
    LAS unsigned char* lds = (LAS unsigned char*)lds_raw;
    const int tid = threadIdx.x;
    const int G = gridDim.x; const int bx = blockIdx.x; const int vcu = (G % 8 == 0) ? (bx % 8) * (G / 8) + bx / 8 : bx;
    volatile LAS unsigned* MISC = (volatile LAS unsigned*)(lds + MISC_OFF);
    if (tid < 16) MISC[tid] = 0u;
    if (tid == 0) { LAS unsigned long long* pt = (LAS unsigned long long*)(lds + PTR_OFF);
#pragma unroll
        for (int i = 0; i < 18; ++i) pt[i] = (unsigned long long)a.in[i];
        pt[18] = (unsigned long long)a.out; pt[19] = (unsigned long long)a.ws; }
    __syncthreads();
    const Ctx cx{lds, __builtin_amdgcn_readfirstlane(tid >> 6)};
    XcdBarrier bar = xcd_barrier_post((unsigned*)(cx.ws() + WS_CTL) + 1024, MISC + 8);
#define GRID_BAR() do { XcdBarrier b2_ = bar; asm volatile("" : "+s"(b2_.x)); xcd_barrier(b2_); } while (0)

#if PH & 1
    p0_prologue(cx);
#endif
    GRID_BAR();
#if DBL & 1
    p0_prologue(cx);
    GRID_BAR();
#endif
#if PH & 1
    p0_finalize(cx);
#endif
    GRID_BAR();

#pragma unroll 1
    for (int l = 0; l < DEPTH; ++l) {
        const bool last = (l == DEPTH - 1); unsigned char* ws = cx.ws();
#ifdef PROBE_NOBG
        const bool bgc = false;
#else
        const bool bgc = (G == 256);
#endif

#if DBL & 64
        norm1_phase<2>(cx, l);
        GRID_BAR();
#endif
#if PH & 2
        norm1_phase<0>(cx, l);
#endif
        GRID_BAR();
#ifdef G1_SPLIT
        const int g1k = (bgc && bx >= 36) ? ((bx >> 3) % 5) : 0;
        if (g1k > 0) cvt_tail(cx, CVT_N0 + l * CVT_CYC, bx - 36, 4, 0, g1k);
#endif
#if PH & 4
        {
#ifdef G1_F8
            pg8::Gemm g{(const bf16_t*)(ws + WS_H), (const bf16_t*)(ws + WS_WIN + (size_t)l * INW * D), MROWS, INW, D, cx.w0};
            pg8::StaticOrder S; S.init(MROWS, INW, G, bx);
            pg8::EpiIn8 E{(bf16_t*)(ws + WS_P), (const float*)(ws + WS_LBS) + l * 512, (const float*)(ws + WS_ROPE)};
            pg8::gemm_phase_f8<pg8::EpiIn8, pg8::StaticOrder, false>(launder_lds(lds), g, S, E, nullptr);
#else
            pg8::Gemm g{(const bf16_t*)(ws + WS_H), (const bf16_t*)(ws + WS_WIN) + (size_t)l * INW * D, MROWS, INW, D, cx.w0};
            pg8::StaticOrder S; S.init(MROWS, INW, G, bx);
            pg8::EpiIn E{(bf16_t*)(ws + WS_P), (const float*)(ws + WS_LBS) + l * 512, (const float*)(ws + WS_ROPE)};
#ifdef STAGGER_G1
            { const unsigned long long t0_ = __builtin_amdgcn_s_memrealtime(); const unsigned long long d_ = (unsigned long long)((bx >> 3) & 3) * STAGGER_G1; while (__builtin_amdgcn_s_memrealtime() - t0_ < d_) __builtin_amdgcn_s_sleep(8); }
#endif
            pg8::gemm_phase<pg8::EpiIn, pg8::StaticOrder, true, true>(launder_lds(lds), g, S, E);
#endif
        }
#endif
#if DBL & 1024
        GRID_BAR();
        {
            pg8::Gemm g{(const bf16_t*)(ws + WS_H), (const bf16_t*)(ws + WS_WIN) + (size_t)l * INW * D, MROWS, INW, D, cx.w0};
            pg8::StaticOrder S; S.init(MROWS, INW, G, bx);
            pg8::EpiNull E{(float*)(ws + WS_OB)};
            pg8::gemm_phase<pg8::EpiNull, pg8::StaticOrder, true, true>(launder_lds(lds), g, S, E);
        }
#endif
#if DBL & 16384
        GRID_BAR();
        {
            pg8::Gemm g{(const bf16_t*)(ws + WS_H), (const bf16_t*)(ws + WS_WIN) + (size_t)l * INW * D, MROWS, INW, D, cx.w0};
            pg8::StaticOrder S; S.init(MROWS, INW, G, bx);
            pg8::EpiInT<true> E{(bf16_t*)(ws + WS_YS), (const float*)(ws + WS_LBS) + l * 512, (const float*)(ws + WS_ROPE)};
            pg8::gemm_phase<pg8::EpiInT<true>, pg8::StaticOrder, true, true>(launder_lds(lds), g, S, E);
        }
#endif
#if DBL & 128
        GRID_BAR();
        {
            pg8::Gemm g{(const bf16_t*)(ws + WS_H), (const bf16_t*)(ws + WS_WIN) + (size_t)l * INW * D, MROWS, INW, D, cx.w0};
            pg8::StaticOrder S; S.init(MROWS, INW, G, bx);
            pg8::EpiIn E{(bf16_t*)(ws + WS_P), (const float*)(ws + WS_LBS) + l * 512, (const float*)(ws + WS_ROPE)};
            pg8::gemm_phase<pg8::EpiIn, pg8::StaticOrder, true, true>(launder_lds(lds), g, S, E);
        }
#endif
#ifdef G1_SPLIT
        if (bgc && bx >= 36) cvt_tail(cx, CVT_N0 + l * CVT_CYC, bx - 36, 4, g1k, 4);
#else
        if (bgc && bx >= 36) cvt_tail<4>(cx, CVT_N0 + l * CVT_CYC, bx - 36);
#endif
#ifdef DBLCVT
        if (bgc && bx >= 36) cvt_tail<4>(cx, CVT_N0 + l * CVT_CYC, bx - 36);
#endif
        GRID_BAR();
#if DBL & 8192
#pragma unroll 1
        for (int xb = 0; xb < 10; ++xb) GRID_BAR();
#endif
#if PH & 8
        scan1_phase(cx, l);
#endif
        GRID_BAR();
#if PH & 16
        scan2_phase(cx);
#endif
        GRID_BAR();
#if PH & 32
        scan3_phase(cx, l);
#endif
        GRID_BAR();
#if DBL & 2
        scan1_phase(cx, l);
        GRID_BAR();
        scan2_phase(cx);
        GRID_BAR();
        scan3_phase(cx, l);
        GRID_BAR();
#endif
#if DBL & 8
        scan1_phase(cx, l);
        GRID_BAR();
#endif
#if DBL & 16
        scan2_phase(cx);
        GRID_BAR();
#endif
#if DBL & 32
        scan3_phase(cx, l);
        GRID_BAR();
#endif
#if PH & 64
        {
#ifdef G2_F8
            pg8::Gemm g{(const bf16_t*)(ws + WS_MIX), (const bf16_t*)(ws + WS_WOUT + (size_t)l * D * D), MROWS, D, D, cx.w0};
            OutOrder S{last ? 128 : 130, last ? 1 : 0, G, vcu};
            pg8::EpiOut8 E{(bf16_t*)(ws + WS_X), l == 0 ? cx.in(I_X) : nullptr, l == 0 ? cx.in(I_CTX) : nullptr, (const float*)(ws + WS_MODS) + (size_t)(l * 3) * 6144 + 2 * D};
            pg8::gemm_phase_f8<pg8::EpiOut8, OutOrder, false>(launder_lds(lds), g, S, E, nullptr);
#else
            pg8::Gemm g{(const bf16_t*)(ws + WS_MIX), (const bf16_t*)(ws + WS_WOUT) + (size_t)l * D * D, MROWS, D, D, cx.w0};
            OutOrder S{last ? 128 : 130, last ? 1 : 0, G, vcu};
            pg8::EpiOut E{(bf16_t*)(ws + WS_X), l == 0 ? cx.in(I_X) : nullptr, l == 0 ? cx.in(I_CTX) : nullptr, (const float*)(ws + WS_MODS) + (size_t)(l * 3) * 6144 + 2 * D};
            pg8::gemm_phase<pg8::EpiOut, OutOrder, true, true>(launder_lds(lds), g, S, E);
#endif
        }
#endif
        if (bgc && !last && vcu >= 8) cvt_tail<4>(cx, CVT_N0 + l * CVT_CYC + CVT_G1, vcu - 8);
#ifdef DBLCVT
        if (bgc && !last && vcu >= 8) cvt_tail<4>(cx, CVT_N0 + l * CVT_CYC + CVT_G1, vcu - 8);
#endif
        GRID_BAR();
#if PH & 128
        norm2_phase(cx, l);
#endif
        GRID_BAR();
#if DBL & 4
        norm2_phase(cx, l);
        GRID_BAR();
#endif
#if PH & 256
        topk_phase(cx, l);
#endif
        if (bgc && bx >= 64) cvt_tail<3>(cx, CVT_N0 + l * CVT_CYC + CVT_G1 + (last ? 0 : CVT_G2), bx - 64);
#ifdef DBLCVT
        if (bgc && bx >= 64) cvt_tail<3>(cx, CVT_N0 + l * CVT_CYC + CVT_G1 + (last ? 0 : CVT_G2), bx - 64);
#endif
        GRID_BAR();
#if DBL & 2048
        topk_phase(cx, l);
        GRID_BAR();
#endif
#if PH & 1024
        {
            pg8::Gemm g{(const bf16_t*)(ws + WS_H), (const bf16_t*)(ws + WS_WGU + (size_t)l * 65536 * D), MOE_ROWS, 65536, D, cx.w0};
            pg8::MoeOrder S{last ? 16 : 17, 16, G, vcu};
            pg8::EpiGU E{(unsigned char*)(ws + WS_HID)};
            pg8::gemm_phase_f8<pg8::EpiGU, pg8::MoeOrder, true>(launder_lds(lds), g, S, E, (const int*)(ws + WS_ROWMAP));
        }
#endif
#if DBL & 4096
        GRID_BAR();
        {
            pg8::Gemm g{(const bf16_t*)(ws + WS_H), (const bf16_t*)(ws + WS_WGU + (size_t)l * 65536 * D), MOE_ROWS, 65536, D, cx.w0};
            pg8::MoeOrder S{last ? 16 : 17, 16, G, vcu};
            pg8::EpiNull E{(float*)(ws + WS_OB)};
            pg8::gemm_phase_f8<pg8::EpiNull, pg8::MoeOrder, true>(launder_lds(lds), g, S, E, (const int*)(ws + WS_ROWMAP));
        }
#endif
#if DBL & 256
        GRID_BAR();
        {
            pg8::Gemm g{(const bf16_t*)(ws + WS_H), (const bf16_t*)(ws + WS_WGU + (size_t)l * 65536 * D), MOE_ROWS, 65536, D, cx.w0};
            pg8::MoeOrder S{last ? 16 : 17, 16, G, vcu};
            pg8::EpiGU E{(unsigned char*)(ws + WS_HID)};
            pg8::gemm_phase_f8<pg8::EpiGU, pg8::MoeOrder, true>(launder_lds(lds), g, S, E, (const int*)(ws + WS_ROWMAP));
        }
#endif
        GRID_BAR();
#if PH & 2048
        {
            pg8::Gemm g{(const bf16_t*)(ws + WS_HID), (const bf16_t*)(ws + WS_WD + (size_t)l * 16384 * FF), MOE_ROWS, 16384, FF, cx.w0};
            pg8::MoeOrder S{last ? 16 : 17, 4, G, vcu};
            pg8::EpiDown E{(unsigned char*)(ws + WS_YS)};
            pg8::gemm_phase_f8<pg8::EpiDown, pg8::MoeOrder, false>(launder_lds(lds), g, S, E, nullptr);
        }
#endif
#if DBL & 512
        GRID_BAR();
        {
            pg8::Gemm g{(const bf16_t*)(ws + WS_HID), (const bf16_t*)(ws + WS_WD + (size_t)l * 16384 * FF), MOE_ROWS, 16384, FF, cx.w0};
            pg8::MoeOrder S{last ? 16 : 17, 4, G, vcu};
            pg8::EpiDown E{(unsigned char*)(ws + WS_YS)};
            pg8::gemm_phase_f8<pg8::EpiDown, pg8::MoeOrder, false>(launder_lds(lds), g, S, E, nullptr);
        }
#endif
        if (bgc && !last && vcu >= 64) cvt_tail<4>(cx, CVT_N0 + l * CVT_CYC + CVT_G1 + CVT_G2 + CVT_T, vcu - 64);
#ifdef DBLCVT
        if (bgc && !last && vcu >= 64) cvt_tail<4>(cx, CVT_N0 + l * CVT_CYC + CVT_G1 + CVT_G2 + CVT_T, vcu - 64);
#endif
        GRID_BAR();
    }
#if PH & 4096
    norm1_phase<1>(cx, DEPTH);
#endif
}

extern "C" void kernel_launch(void* const* d_in, const int* in_sizes, int n_in, void* d_out, int out_size, void* d_ws, size_t ws_size, hipStream_t stream) {
    static int grid = 0;
    if (grid == 0) {
        if (n_in != 18 || out_size != NB * SEQ * D || ws_size < WS_END) { fprintf(stderr, "kernel_launch: unexpected problem shape (n_in %d, out %d, ws %zu)\n", n_in, out_size, ws_size); grid = -1; return; }
        int dev = 0, cus = 0, per_cu = 0;
        if (hipGetDevice(&dev) != hipSuccess || hipDeviceGetAttribute(&cus, hipDeviceAttributeMultiprocessorCount, dev) != hipSuccess) { grid = -1; return; }
        if (hipFuncSetAttribute((const void*)mega_fwd, hipFuncAttributeMaxDynamicSharedMemorySize, LDS_BYTES) != hipSuccess) { fprintf(stderr, "kernel_launch: hipFuncSetAttribute failed\n"); grid = -1; return; }
        if (hipOccupancyMaxActiveBlocksPerMultiprocessor(&per_cu, (const void*)mega_fwd, 512, LDS_BYTES) != hipSuccess || per_cu < 1) { fprintf(stderr, "kernel_launch: occupancy query reports %d workgroups per CU\n", per_cu); per_cu = 1; }
        (void)hipGetLastError();
        grid = cus;
    }
    if (grid < 0) return;
    (void)in_sizes;
    if (hipMemsetAsync((char*)d_ws + WS_CTL, 0, CTL_ZERO_BYTES, stream) != hipSuccess) return;
    Args a{};
    for (int i = 0; i < 18; ++i) a.in[i] = (const float*)d_in[i];
    a.out = (float*)d_out; a.ws = (unsigned char*)d_ws;
    hipLaunchKernelGGL(mega_fwd, dim3(grid), dim3(512), LDS_BYTES, stream, a);
}
```

```cpp
#define SCAN_PRIO 1
#define CVT_NT 1
#include <hip/hip_runtime.h>
#include <cstdio>
#include <cstdint>

constexpr int D = 1024, NB = 2, SEQ = 16384, CTX = 256, LTOT = SEQ + CTX, MROWS = NB * LTOT;
constexpr int DEPTH = 4, INW = 4608, NE = 16, FF = 2048;
constexpr int CAP_LAT = 2048, CAP_CTX = 32;
constexpr int MOE_ROWS_E = 4352, MOE_ROWS = NE * MOE_ROWS_E;
constexpr int NSLOT = NB * 8 * 2 * 65;
constexpr float EPS = 1e-6f;

constexpr size_t MiB = 1u << 20;
constexpr size_t WS_CTL = 0, CTL_ZERO_BYTES = 64 * 1024;
constexpr size_t WS_MODP = 1 * MiB;
constexpr size_t WS_MODS = 4 * MiB;
constexpr size_t WS_LBS = 5 * MiB;
constexpr size_t WS_ROPE = 5 * MiB + 65536;
constexpr size_t WS_WIN = 8 * MiB;
constexpr size_t WS_WOUT = 44 * MiB;
constexpr size_t WS_WGU = 52 * MiB;
constexpr size_t WS_WD = 564 * MiB;
constexpr size_t WS_X = 820 * MiB;
constexpr size_t WS_H = 950 * MiB;
constexpr size_t WS_MIX = 1015 * MiB;
constexpr size_t WS_P = 1080 * MiB;
constexpr size_t WS_XS = 1080 * MiB;
constexpr size_t WS_HID = 1216 * MiB;
constexpr size_t WS_YS = 1488 * MiB;
constexpr size_t WS_UB = 1624 * MiB;
constexpr size_t WS_SB = 1689 * MiB;
constexpr size_t WS_AB = 1754 * MiB;
constexpr size_t WS_OB = 1756 * MiB;
constexpr size_t WS_AFF = 1788 * MiB;
constexpr size_t WS_ROWMAP = 1791 * MiB;
constexpr size_t WS_INV = 1792 * MiB;
constexpr size_t WS_END = 1800 * MiB;

constexpr int LDS_BYTES = 155648;
constexpr int MISC_OFF = LDS_BYTES - 64;
constexpr int PTR_OFF = LDS_BYTES - 256;

#define GAS __attribute__((address_space(1)))
#define LAS __attribute__((address_space(3)))
typedef float f32x2 __attribute__((ext_vector_type(2)));
typedef unsigned u32x2 __attribute__((ext_vector_type(2)));

__device__ __forceinline__ int lane_id() { int l; asm volatile("v_mbcnt_lo_u32_b32 %0, -1, 0\n\tv_mbcnt_hi_u32_b32 %0, -1, %0" : "=v"(l)); return l; }
__device__ __forceinline__ int opaque_tid(int w0) { int w = w0; asm volatile("" : "+s"(w)); int t = w * 64 + lane_id(); asm volatile("" : "+v"(t)); return t; }
__device__ __forceinline__ LAS unsigned char* launder_lds(LAS unsigned char* p) { unsigned v = (unsigned)(size_t)p; asm volatile("" : "+s"(v)); return (LAS unsigned char*)(size_t)v; }
__device__ __forceinline__ const float* ldptr(LAS unsigned char* lds0, int i) {
    LAS unsigned char* lds = launder_lds(lds0);
    const u32x2 v = *(volatile LAS u32x2*)(lds + PTR_OFF + 8 * i);
    const unsigned lo = __builtin_amdgcn_readfirstlane(v.x), hi = __builtin_amdgcn_readfirstlane(v.y);
    const GAS float* g = (const GAS float*)(((unsigned long long)hi << 32) | lo);
    return (const float*)g;
}
namespace pg8 {
#define PG8_LAS __attribute__((address_space(3)))
typedef unsigned short bf16_t;
typedef short bf16x8 __attribute__((ext_vector_type(8)));
typedef float f32x4 __attribute__((ext_vector_type(4)));
typedef unsigned u32x4 __attribute__((ext_vector_type(4)));
constexpr int BM = 256, BK = 64, HALF = 128, HTB = HALF * BK * 2  , STAGE_BYTES = 8 * HTB, NXCD = 8, WGM = 8;

__host__ __device__ __forceinline__ int lds_byte(int r, int c) { const int st = (r >> 4) * 2 + (c >> 5), rr = r & 15, cc = c & 31, ob = rr * 64 + cc * 2; return st * 1024 + (ob ^ (((ob >> 9) & 1) << 5)); }
__host__ __device__ __forceinline__ void stage_rc(int b, int& R, int& C) { const int st = b / 1024, sb = b % 1024, swz = sb ^ (((sb >> 9) & 1) << 5); R = (st >> 1) * 16 + swz / 64; C = (st & 1) * 32 + (swz % 64) / 2; }
__host__ __device__ __forceinline__ int perm32(int rho) { const int n = rho >> 4, i = rho & 15; return 8 * (i >> 2) + 4 * n + (i & 3); }

struct Unit { int pm, pn; };
struct Gemm { const bf16_t* A; const bf16_t* Bt; int M, N, K, w0; };

struct StaticOrder {
    static constexpr bool PADTILES = false;
    __device__ __forceinline__ bool half_rows(const Unit&) const { return false; }
    int nM, nN, nwg, G, c;
    __host__ __device__ void init(int M, int N, int G_, int c_) { nM = M / BM; nN = N / BM; nwg = nM * nN; G = G_; c = c_; }
    __host__ __device__ bool next(int i, Unit& u) const {
        const long L = (long)i * G + c; if (L >= nwg) return false;
        int wgid = (int)L; { const int q = nwg / NXCD, r = nwg % NXCD, xcd = wgid % NXCD, off = wgid / NXCD; wgid = (xcd < r ? xcd * (q + 1) : r * (q + 1) + (xcd - r) * q) + off; }
        const int nig = WGM * nN, gid = wgid / nig, fm = gid * WGM, gsz = (nM - fm) < WGM ? (nM - fm) : WGM;
        u.pm = fm + ((wgid % nig) % gsz); u.pn = (wgid % nig) / gsz; return true;
    }
    __device__ __forceinline__ void a_ready(const Unit&) const {}
    __device__ __forceinline__ void done(const Unit&) const {}
};
__device__ __forceinline__ unsigned cvt_pk_bf16(float lo, float hi) { unsigned r; asm volatile("v_cvt_pk_bf16_f32 %0, %1, %2" : "=v"(r) : "v"(lo), "v"(hi)); return r; }

struct MoeOrder {
    static constexpr bool PADTILES = true;
    __device__ __forceinline__ bool half_rows(const Unit& u) const { return (u.pm % 17) == 16; }
    int NT, NC, G, c;
    __device__ __forceinline__ bool next(int i, Unit& u) const {
        const int L = i * G + c, per = NT * NC; if (L >= 16 * per) return false;
        const int e = L / per, q = L - e * per;
        if (NC == 16 && q < 256) { u.pm = e * 17 + (q >> 6) * 4 + (q & 3); u.pn = e * NC + ((q >> 2) & 15); }
        else { u.pm = e * 17 + q / NC; u.pn = e * NC + q % NC; }
        return true;
    }
    __device__ __forceinline__ void a_ready(const Unit&) const {}
    __device__ __forceinline__ void done(const Unit&) const {}
};

__device__ __forceinline__ float fast_exp(float x) { return __builtin_amdgcn_exp2f(x * 1.4426950408889634f); }
__device__ __forceinline__ float fast_sigmoid(float x) { return __builtin_amdgcn_rcpf(1.0f + fast_exp(-x)); }

constexpr float F8_SA = 8.0f, F8_SW = 64.0f, F8_SH = 4.0f, F8_SY = 16.0f;
#ifdef P_NT
#define PSTORE(p_, v_) __builtin_nontemporal_store((v_), (p_))
#else
#define PSTORE(p_, v_) (*(p_) = (v_))
#endif
template <bool PLAIN, bool F8 = false>
struct EpiInT {
    static constexpr float ASC = F8 ? 1.0f / (F8_SA * F8_SW) : 1.0f;
    static constexpr bool PERM = true, AFTER_DRAIN = false;
    bf16_t* P; const float* lb; const float* cs;
    __device__ __forceinline__ void operator()(const f32x4 (&acc)[2][2][4][2], const Unit& u, int wr, int wc, int fr, int fq) const {
        const int grp = PLAIN ? 0 : (u.pn >> 1);
        const int row0 = u.pm * BM + wr * 64 + fr, col0 = u.pn * BM + wc * 32 + 8 * fq;
        if (grp == 0 || grp == 3 || grp == 7) {
#pragma unroll
            for (int ai = 0; ai < 2; ++ai)
#pragma unroll
                for (int m = 0; m < 4; ++m) { bf16_t* rowp = P + (size_t)(row0 + ai * HALF + m * 16) * INW + col0;
#pragma unroll
                    for (int bj = 0; bj < 2; ++bj) { const f32x4 v0 = acc[ai][bj][m][0] * ASC, v1 = acc[ai][bj][m][1] * ASC;
                        u32x4 w; w.x = cvt_pk_bf16(v0[0], v0[1]); w.y = cvt_pk_bf16(v0[2], v0[3]); w.z = cvt_pk_bf16(v1[0], v1[1]); w.w = cvt_pk_bf16(v1[2], v1[3]);
#ifdef PROBE_LINSTORE
                        if (PLAIN) {
#if PROBE_LINSTORE == 2
                            *((u32x4*)P + ((size_t)blockIdx.x * 8192 + (((wr * 4 + wc) * 16 + (ai * 4 + m) * 2 + bj) * 64 + fq * 16 + fr))) = w; continue;
#else
                            *((u32x4*)P + ((size_t)(u.pm * 18 + u.pn) * 8192 + (((wr * 4 + wc) * 16 + (ai * 4 + m) * 2 + bj) * 64 + fq * 16 + fr))) = w; continue;
#endif
                        }
#endif
                        PSTORE((u32x4*)(rowp + bj * HALF), w); } }
        } else if (grp == 1 || grp == 2) {
            const int cg = col0 - grp * 512;
            f32x4 lbv[2][2];
#pragma unroll
            for (int bj = 0; bj < 2; ++bj)
#pragma unroll
                for (int n = 0; n < 2; ++n) lbv[bj][n] = *(const f32x4*)(lb + cg + bj * HALF + 4 * n);
#pragma unroll
            for (int ai = 0; ai < 2; ++ai)
#pragma unroll
                for (int m = 0; m < 4; ++m) { bf16_t* rowp = P + (size_t)(row0 + ai * HALF + m * 16) * INW + col0;
#pragma unroll
                    for (int bj = 0; bj < 2; ++bj) { f32x4 v[2];
#pragma unroll
                        for (int n = 0; n < 2; ++n)
#pragma unroll
                            for (int h = 0; h < 2; ++h) { const f32x2 z = (f32x2){acc[ai][bj][m][n][2 * h], acc[ai][bj][m][n][2 * h + 1]} * ASC, l0 = {lbv[bj][n][2 * h], lbv[bj][n][2 * h + 1]};
                                const f32x2 x = z * (-1.4426950408889634f); const f32x2 d = (f32x2){__builtin_amdgcn_exp2f(x.x), __builtin_amdgcn_exp2f(x.y)} + 1.0f;
                                f32x2 f = l0 + ((f32x2){1.0f, 1.0f} - l0) * (f32x2){__builtin_amdgcn_rcpf(d.x), __builtin_amdgcn_rcpf(d.y)}; f = __builtin_elementwise_max(f, (f32x2){1e-30f, 1e-30f});
#ifndef SCAN_LOG2
                                const f32x2 r = (f32x2){__builtin_amdgcn_logf(f.x), __builtin_amdgcn_logf(f.y)} * 0.6931471805599453f;
#else
                                const f32x2 r = (f32x2){__builtin_amdgcn_logf(f.x), __builtin_amdgcn_logf(f.y)};
#endif
                                v[n][2 * h] = r.x; v[n][2 * h + 1] = r.y; }
                        u32x4 w; w.x = cvt_pk_bf16(v[0][0], v[0][1]); w.y = cvt_pk_bf16(v[0][2], v[0][3]); w.z = cvt_pk_bf16(v[1][0], v[1][1]); w.w = cvt_pk_bf16(v[1][2], v[1][3]);
                        PSTORE((u32x4*)(rowp + bj * HALF), w); } }
        } else if (grp == 4 || grp == 8) {
#pragma unroll
            for (int ai = 0; ai < 2; ++ai)
#pragma unroll
                for (int m = 0; m < 4; ++m) { bf16_t* rowp = P + (size_t)(row0 + ai * HALF + m * 16) * INW + col0;
#pragma unroll
                    for (int bj = 0; bj < 2; ++bj) { f32x4 v[2];
#pragma unroll
                        for (int n = 0; n < 2; ++n)
#pragma unroll
                            for (int h = 0; h < 2; ++h) { const f32x2 z = (f32x2){acc[ai][bj][m][n][2 * h], acc[ai][bj][m][n][2 * h + 1]} * ASC; const f32x2 x = z * (-1.4426950408889634f);
                                const f32x2 d = (f32x2){__builtin_amdgcn_exp2f(x.x), __builtin_amdgcn_exp2f(x.y)} + 1.0f; const f32x2 r = z * (f32x2){__builtin_amdgcn_rcpf(d.x), __builtin_amdgcn_rcpf(d.y)};
                                v[n][2 * h] = r.x; v[n][2 * h + 1] = r.y; }
                        u32x4 w; w.x = cvt_pk_bf16(v[0][0], v[0][1]); w.y = cvt_pk_bf16(v[0][2], v[0][3]); w.z = cvt_pk_bf16(v[1][0], v[1][1]); w.w = cvt_pk_bf16(v[1][2], v[1][3]);
                        PSTORE((u32x4*)(rowp + bj * HALF), w); } }
        } else {
            const float sc = ((grp == 6) ? 0.08838834764831845f : 1.0f) * ASC;
            const int f0 = 16 * (wc & 1) + 4 * fq;
#pragma unroll
            for (int ai = 0; ai < 2; ++ai)
#pragma unroll
                for (int m = 0; m < 4; ++m) { const int row = row0 + ai * HALF + m * 16; bf16_t* rowp = P + (size_t)row * INW + col0;
                    int g = row; if (g >= LTOT) g -= LTOT;
                    int pos = 0; if (g >= CTX) { const int nn = g - CTX; pos = (wc < 2) ? (nn >> 6) : (nn & 63); }
                    const f32x4 t0 = *(const f32x4*)(cs + (size_t)(pos * 32 + f0) * 2), t1 = *(const f32x4*)(cs + (size_t)(pos * 32 + f0) * 2 + 4);
#pragma unroll
                    for (int bj = 0; bj < 2; ++bj) { const f32x4 v0 = acc[ai][bj][m][0] * sc, v1 = acc[ai][bj][m][1] * sc;
                        const float a0 = v0[0] * t0[0] - v0[1] * t0[1], a1 = v0[0] * t0[1] + v0[1] * t0[0];
                        const float a2 = v0[2] * t0[2] - v0[3] * t0[3], a3 = v0[2] * t0[3] + v0[3] * t0[2];
                        const float b0 = v1[0] * t1[0] - v1[1] * t1[1], b1 = v1[0] * t1[1] + v1[1] * t1[0];
                        const float b2 = v1[2] * t1[2] - v1[3] * t1[3], b3 = v1[2] * t1[3] + v1[3] * t1[2];
                        u32x4 w; w.x = cvt_pk_bf16(a0, a1); w.y = cvt_pk_bf16(a2, a3); w.z = cvt_pk_bf16(b0, b1); w.w = cvt_pk_bf16(b2, b3);
                        PSTORE((u32x4*)(rowp + bj * HALF), w); } }
        }
    }
};

using EpiIn = EpiInT<false>;
using EpiIn8 = EpiInT<false, true>;

struct EpiNull { static constexpr bool PERM = true, AFTER_DRAIN = false; float* sink;
    __device__ __forceinline__ void operator()(const f32x4 (&acc)[2][2][4][2], const Unit& u, int wr, int wc, int fr, int fq) const { f32x4 s = acc[0][0][0][0]; _Pragma("unroll") for (int a = 0; a < 2; ++a) _Pragma("unroll") for (int b = 0; b < 2; ++b) _Pragma("unroll") for (int m = 0; m < 4; ++m) _Pragma("unroll") for (int n = 0; n < 2; ++n) s += acc[a][b][m][n]; if (s[0] == 123.456f && u.pm < 0) sink[fr + fq + wr + wc] = s[1]; } };

template <bool F8>
struct EpiOutT {
    static constexpr bool PERM = true, AFTER_DRAIN = false; static constexpr float ASC = F8 ? 1.0f / (F8_SA * F8_SW) : 1.0f;
    bf16_t* X; const float* xin; const float* cin; const float* gt;
    __device__ __forceinline__ void operator()(const f32x4 (&acc)[2][2][4][2], const Unit& u, int wr, int wc, int fr, int fq) const {
        const int b = u.pm / 65, tb = u.pm - b * 65, which = (tb == 0) ? 2 : b;
        const int row0 = u.pm * BM + wr * 64 + fr, col0 = u.pn * BM + wc * 32 + 8 * fq;
        f32x4 gv[2][2];
#pragma unroll
        for (int bj = 0; bj < 2; ++bj)
#pragma unroll
            for (int n = 0; n < 2; ++n) gv[bj][n] = *(const f32x4*)(gt + which * 6144 + col0 + bj * HALF + 4 * n) * ASC;
#pragma unroll
        for (int ai = 0; ai < 2; ++ai)
#pragma unroll
            for (int m = 0; m < 4; ++m) { const int row = row0 + ai * HALF + m * 16; bf16_t* op = X + (size_t)row * D + col0;
#pragma unroll
                for (int bj = 0; bj < 2; ++bj) { f32x4 b0, b1;
                    if (xin) { const int g = row - b * LTOT; const float* bp = (g < CTX ? cin + (size_t)(b * CTX + g) * D : xin + (size_t)(b * SEQ + g - CTX) * D) + col0 + bj * HALF; b0 = *(const f32x4*)bp; b1 = *(const f32x4*)(bp + 4); }
                    else { const u32x4 w = *(const u32x4*)(op + bj * HALF); b0 = (f32x4){__uint_as_float(w.x << 16), __uint_as_float(w.x & 0xffff0000u), __uint_as_float(w.y << 16), __uint_as_float(w.y & 0xffff0000u)};
                        b1 = (f32x4){__uint_as_float(w.z << 16), __uint_as_float(w.z & 0xffff0000u), __uint_as_float(w.w << 16), __uint_as_float(w.w & 0xffff0000u)}; }
                    const f32x4 v0 = b0 + gv[bj][0] * acc[ai][bj][m][0], v1 = b1 + gv[bj][1] * acc[ai][bj][m][1];
                    u32x4 o; o.x = cvt_pk_bf16(v0[0], v0[1]); o.y = cvt_pk_bf16(v0[2], v0[3]); o.z = cvt_pk_bf16(v1[0], v1[1]); o.w = cvt_pk_bf16(v1[2], v1[3]);
                    *(u32x4*)(op + bj * HALF) = o; }
                if (F8) __builtin_amdgcn_sched_barrier(0); }
    }
};

using EpiOut = EpiOutT<false>;
using EpiOut8 = EpiOutT<true>;

__device__ __forceinline__ unsigned pk4_fp8(float a, float b, float c, float d) {
    a = __builtin_amdgcn_fmed3f(a, -448.f, 448.f); b = __builtin_amdgcn_fmed3f(b, -448.f, 448.f); c = __builtin_amdgcn_fmed3f(c, -448.f, 448.f); d = __builtin_amdgcn_fmed3f(d, -448.f, 448.f);
    unsigned w = 0; w = __builtin_amdgcn_cvt_pk_fp8_f32(a, b, w, false); w = __builtin_amdgcn_cvt_pk_fp8_f32(c, d, w, true); return w; }
struct EpiGU {
    static constexpr bool PERM = true, AFTER_DRAIN = false;
    unsigned char* HID;
    __device__ __forceinline__ void operator()(const f32x4 (&acc)[2][2][4][2], const Unit& u, int wr, int wc, int fr, int fq) const {
        const int row0 = u.pm * BM + wr * 64 + fr, col0 = (u.pn & 15) * HALF + wc * 32 + 8 * fq;
        constexpr float inv = 1.0f / (F8_SA * F8_SW);
#pragma unroll
        for (int ai = 0; ai < 2; ++ai)
#pragma unroll
            for (int m = 0; m < 4; ++m) { unsigned char* rowp = HID + (size_t)(row0 + ai * HALF + m * 16) * FF + col0; f32x4 v[2];
#pragma unroll
                for (int n = 0; n < 2; ++n)
#pragma unroll
                    for (int h = 0; h < 2; ++h) {
                        const f32x2 a0 = {acc[ai][0][m][n][2 * h], acc[ai][0][m][n][2 * h + 1]}, a1 = {acc[ai][1][m][n][2 * h], acc[ai][1][m][n][2 * h + 1]};
                        const f32x2 x = a0 * (-inv * 1.4426950408889634f); const f32x2 d = (f32x2){__builtin_amdgcn_exp2f(x.x), __builtin_amdgcn_exp2f(x.y)} + 1.0f;
                        const f32x2 r = (a0 * a1) * (inv * inv * F8_SH) * (f32x2){__builtin_amdgcn_rcpf(d.x), __builtin_amdgcn_rcpf(d.y)};
                        v[n][2 * h] = r.x; v[n][2 * h + 1] = r.y; }
                u32x2 w; w.x = pk4_fp8(v[0][0], v[0][1], v[0][2], v[0][3]); w.y = pk4_fp8(v[1][0], v[1][1], v[1][2], v[1][3]);
                *(u32x2*)rowp = w; }
    }
};

struct EpiDown {
    static constexpr bool PERM = true, AFTER_DRAIN = false;
    unsigned char* YS;
    __device__ __forceinline__ void operator()(const f32x4 (&acc)[2][2][4][2], const Unit& u, int wr, int wc, int fr, int fq) const {
        const int row0 = u.pm * BM + wr * 64 + fr, col0 = (u.pn & 3) * BM + wc * 32 + 8 * fq;
        constexpr float gg = F8_SY / (F8_SH * F8_SW);
#pragma unroll
        for (int ai = 0; ai < 2; ++ai)
#pragma unroll
            for (int m = 0; m < 4; ++m) { unsigned char* rowp = YS + (size_t)(row0 + ai * HALF + m * 16) * D + col0;
#pragma unroll
                for (int bj = 0; bj < 2; ++bj) { const f32x4 v0 = acc[ai][bj][m][0] * gg, v1 = acc[ai][bj][m][1] * gg;
                    u32x2 w; w.x = pk4_fp8(v0[0], v0[1], v0[2], v0[3]); w.y = pk4_fp8(v1[0], v1[1], v1[2], v1[3]);
                    *(u32x2*)(rowp + bj * HALF) = w; } }
    }
};

typedef int i32x4v __attribute__((ext_vector_type(4)));
typedef int i32x8v __attribute__((ext_vector_type(8)));
__device__ __forceinline__ i32x8v cat8(bf16x8 lo, bf16x8 hi) { const i32x4v a = __builtin_bit_cast(i32x4v, lo), b = __builtin_bit_cast(i32x4v, hi); return __builtin_shufflevector(a, b, 0, 1, 2, 3, 4, 5, 6, 7); }
template <class Epi, class Sched, bool GATHER>
__device__ __forceinline__ void gemm_phase_f8(PG8_LAS unsigned char* lds, const Gemm g, const Sched& S, const Epi& E, const int* rowmap) {
    const int tid = opaque_tid(g.w0), wid = __builtin_amdgcn_readfirstlane(tid >> 6), lane = tid & 63, wr = wid >> 2, wc = wid & 3, fr = lane & 15, fq = lane >> 4;
    const int rowb = g.K, nt = rowb / 128;
    unsigned vA0[2], vA1[2], voffB[2];
#pragma unroll
    for (int i = 0; i < 2; ++i) { int R, C; stage_rc(tid * 16 + i * 8192, R, C); const int Rb = Epi::PERM ? ((R & ~31) + perm32(R & 31)) : R;
        voffB[i] = (unsigned)(Rb * rowb + 2 * C); vA0[i] = (unsigned)(R * rowb + 2 * C); vA1[i] = vA0[i]; }
    const size_t kstep = 128;
    const size_t hstep = (size_t)HALF * rowb;
    const size_t tstep = 2 * hstep;
    const unsigned ldsw = (unsigned)wid * 1024u;
    const int aoff = lds_byte(wr * 64 + fr, fq * 8), boff = lds_byte(wc * 32 + fr, fq * 8);
    constexpr int GOFF = STAGE_BYTES;
#define PG8_SA(b, h) (((b) * 2 + (h)) * HTB)
#define PG8_SB(b, h) ((4 + (b) * 2 + (h)) * HTB)
#define PG8_STAGE(bufoff, gbase, voff) do { _Pragma("unroll") for (int _i = 0; _i < 2; ++_i) { unsigned _o = (voff)[_i]; asm volatile("" : "+v"(_o)); \
        __builtin_amdgcn_global_load_lds((const unsigned*)((const char*)(gbase) + _o), (PG8_LAS unsigned*)(lds + (bufoff) + ldsw + _i * 8192), 16, 0, 0); } } while (0)
#define PG8_STAGE_A(bufoff, kbase, h) do { if constexpr (GATHER) { if (h) PG8_STAGE(bufoff, kbase, vA1); else PG8_STAGE(bufoff, kbase, vA0); } else PG8_STAGE(bufoff, (kbase) + (h) * hstep, vA0); } while (0)
#define PG8_GIDX_ISSUE(pm_) do { const int _t = opaque_tid(g.w0); _Pragma("unroll") for (int _i = 0; _i < 2; ++_i) { int R, C; stage_rc(_t * 16 + _i * 8192, R, C); _Pragma("unroll") for (int _h = 0; _h < 2; ++_h) \
        __builtin_amdgcn_global_load_lds((const unsigned*)(rowmap + (pm_) * BM + _h * HALF + R), (PG8_LAS unsigned*)(lds + GOFF + ldsw + (_h * 2 + _i) * 256), 4, 0, 0); } } while (0)
#define PG8_GIDX_TAKE() do { const int _t = opaque_tid(g.w0); _Pragma("unroll") for (int _i = 0; _i < 2; ++_i) { int R, C; stage_rc(_t * 16 + _i * 8192, R, C); \
        vA0[_i] = *(const PG8_LAS unsigned*)(lds + GOFF + ldsw + (0 * 2 + _i) * 256 + (_t & 63) * 4) * (unsigned)rowb + (unsigned)(2 * C); \
        vA1[_i] = *(const PG8_LAS unsigned*)(lds + GOFF + ldsw + (1 * 2 + _i) * 256 + (_t & 63) * 4) * (unsigned)rowb + (unsigned)(2 * C); } } while (0)
#define PG8_LDA(dst, b, h) do { _Pragma("unroll") for (int m = 0; m < 4; ++m) _Pragma("unroll") for (int k = 0; k < 2; ++k) dst[m][k] = *(const PG8_LAS bf16x8*)(lds + PG8_SA(b, h) + aoff + m * 2048 + k * 1024); } while (0)
#define PG8_LDB(dst, b, h) do { _Pragma("unroll") for (int n = 0; n < 2; ++n) _Pragma("unroll") for (int k = 0; k < 2; ++k) dst[n][k] = *(const PG8_LAS bf16x8*)(lds + PG8_SB(b, h) + boff + n * 2048 + k * 1024); } while (0)
#define PG8_MMA(ai, bj, At, Bt) do { __builtin_amdgcn_s_setprio(1); _Pragma("unroll") for (int m = 0; m < 4; ++m) _Pragma("unroll") for (int n = 0; n < 2; ++n) \
        acc[ai][bj][m][n] = __builtin_amdgcn_mfma_scale_f32_16x16x128_f8f6f4(cat8(Bt[n][0], Bt[n][1]), cat8(At[m][0], At[m][1]), acc[ai][bj][m][n], 0, 0, 0, 0, 0, 0); __builtin_amdgcn_s_setprio(0); } while (0)
#define PG8_WAIT_V(n) asm volatile("s_waitcnt vmcnt(" #n ")" ::: "memory")
#define PG8_WAIT_L(n) asm volatile("s_waitcnt lgkmcnt(" #n ")" ::: "memory")
#define PG8_BAR __builtin_amdgcn_s_barrier()
#define PG8_SCHED __builtin_amdgcn_sched_barrier(0)
    Unit cur, nxt; int ui = 0;
    if (!S.next(0, cur)) return;
    bool half = Sched::PADTILES && S.half_rows(cur);
    f32x4 acc[2][2][4][2];
#pragma unroll
    for (int a = 0; a < 2; ++a)
#pragma unroll
        for (int b = 0; b < 2; ++b)
#pragma unroll
            for (int m = 0; m < 4; ++m)
#pragma unroll
                for (int n = 0; n < 2; ++n) acc[a][b][m][n] = (f32x4){0.f, 0.f, 0.f, 0.f};
    bf16x8 At[4][2], B0[2][2], B1[2][2];
    const char* cA; const char* cB = (const char*)g.Bt + (size_t)cur.pn * tstep;
    if constexpr (GATHER) { cA = (const char*)g.A; PG8_GIDX_ISSUE(cur.pm); PG8_WAIT_V(0); PG8_GIDX_TAKE(); }
    else cA = (const char*)g.A + (size_t)cur.pm * tstep;
    PG8_STAGE(PG8_SB(0, 0), cB, voffB); PG8_STAGE(PG8_SB(0, 1), cB + hstep, voffB); PG8_STAGE_A(PG8_SA(0, 0), cA, 0); PG8_STAGE_A(PG8_SA(0, 1), cA, 1);
    if (wr == 1) PG8_BAR;
    PG8_WAIT_V(2); PG8_BAR;
    PG8_STAGE(PG8_SB(1, 0), cB + kstep, voffB); PG8_STAGE_A(PG8_SA(1, 0), cA + kstep, 0); PG8_STAGE(PG8_SB(1, 1), cB + hstep + kstep, voffB);
    PG8_WAIT_V(6); PG8_BAR;
    for (;;) {
        const bool has_next = S.next(ui + 1, nxt);
        const char* nA; const char* nB = has_next ? (const char*)g.Bt + (size_t)nxt.pn * tstep : cB;
        if constexpr (GATHER) { nA = cA; if (has_next) PG8_GIDX_ISSUE(nxt.pm); }
        else nA = has_next ? (const char*)g.A + (size_t)nxt.pm * tstep : cA;
#pragma unroll 1
        for (int t = 0; t < nt; t += 2) {
            const bool last = (t == nt - 2);
            const char* a1 = cA + (size_t)(t + 1) * kstep;
            const char* a2 = last ? nA : cA + (size_t)(t + 2) * kstep; const char* b2 = last ? nB : cB + (size_t)(t + 2) * kstep;
            const char* a3 = a2 + kstep; const char* b3 = b2 + kstep;
            PG8_LDB(B0, 0, 0); PG8_LDB(B1, 0, 1); PG8_SCHED; PG8_LDA(At, 0, 0); PG8_STAGE_A(PG8_SA(1, 1), a1, 1);
            if constexpr (GATHER) { if (last && has_next) PG8_GIDX_TAKE(); }
            PG8_WAIT_V(8); PG8_WAIT_L(0); PG8_BAR; if (!(half && wr == 1)) { PG8_MMA(0, 0, At, B0); PG8_MMA(0, 1, At, B1); } PG8_BAR; PG8_SCHED;
            PG8_LDA(At, 0, 1); PG8_STAGE(PG8_SB(0, 0), b2, voffB); PG8_STAGE(PG8_SB(0, 1), b2 + hstep, voffB); PG8_STAGE_A(PG8_SA(0, 0), a2, 0);
            PG8_WAIT_V(8); PG8_WAIT_L(0); PG8_BAR; if (!half) { PG8_MMA(1, 0, At, B0); PG8_MMA(1, 1, At, B1); } PG8_BAR; PG8_SCHED;
            PG8_LDB(B0, 1, 0); PG8_LDB(B1, 1, 1); PG8_SCHED; PG8_LDA(At, 1, 0); PG8_STAGE_A(PG8_SA(0, 1), a2, 1);
            PG8_WAIT_V(8); PG8_WAIT_L(0); PG8_BAR; if (!(half && wr == 1)) { PG8_MMA(0, 0, At, B0); PG8_MMA(0, 1, At, B1); } PG8_BAR; PG8_SCHED;
            PG8_LDA(At, 1, 1); PG8_STAGE(PG8_SB(1, 0), b3, voffB); PG8_STAGE(PG8_SB(1, 1), b3 + hstep, voffB); PG8_STAGE_A(PG8_SA(1, 0), a3, 0);
            PG8_WAIT_V(8); PG8_WAIT_L(0); PG8_BAR; if (!half) { PG8_MMA(1, 0, At, B0); PG8_MMA(1, 1, At, B1); } PG8_BAR; PG8_SCHED;
        }
        if (wr == 0) PG8_BAR;
        { const int l2_ = opaque_tid(g.w0) & 63; E(acc, cur, wr, wc, l2_ & 15, l2_ >> 4); }
#ifdef G2_F8
        { const int t2_ = opaque_tid(g.w0);
#pragma unroll
          for (int i = 0; i < 2; ++i) { int R, C; stage_rc(t2_ * 16 + i * 8192, R, C); const int Rb = Epi::PERM ? ((R & ~31) + perm32(R & 31)) : R;
              voffB[i] = (unsigned)(Rb * rowb + 2 * C); if constexpr (!GATHER) { vA0[i] = (unsigned)(R * rowb + 2 * C); vA1[i] = vA0[i]; } } }
#endif
        if (!has_next) break;
#pragma unroll
        for (int a = 0; a < 2; ++a)
#pragma unroll
            for (int b = 0; b < 2; ++b)
#pragma unroll
                for (int m = 0; m < 4; ++m)
#pragma unroll
                    for (int n = 0; n < 2; ++n) acc[a][b][m][n] = (f32x4){0.f, 0.f, 0.f, 0.f};
        cur = nxt; cA = nA; cB = nB; ++ui; half = Sched::PADTILES && S.half_rows(cur);
        if (wr == 1) PG8_BAR;
    }
    PG8_WAIT_V(0);
    PG8_BAR;
#undef PG8_SA
#undef PG8_SB
#undef PG8_STAGE
#undef PG8_STAGE_A
#undef PG8_GIDX_ISSUE
#undef PG8_GIDX_TAKE
#undef PG8_LDA
#undef PG8_LDB
#undef PG8_MMA
#undef PG8_WAIT_V
#undef PG8_WAIT_L
#undef PG8_BAR
#undef PG8_SCHED
}
template <class Epi, class Sched, bool ALIGN_EPI = false, bool SP2 = false>
__device__ __forceinline__ void gemm_phase(PG8_LAS unsigned char* lds, const Gemm g, const Sched& S, const Epi& E) {
    const int tid = opaque_tid(g.w0), wid = __builtin_amdgcn_readfirstlane(tid >> 6), lane = tid & 63, wr = wid >> 2, wc = wid & 3, fr = lane & 15, fq = lane >> 4;
    const int K = g.K, nt = K / BK;
    unsigned voffA[2], voffB[2];
#pragma unroll
    for (int i = 0; i < 2; ++i) { int R, C; stage_rc(tid * 16 + i * 8192, R, C); const int Rb = Epi::PERM ? ((R & ~31) + perm32(R & 31)) : R;
        voffA[i] = (unsigned)(R * K + C) * 2u; voffB[i] = (unsigned)(Rb * K + C) * 2u; }
    const size_t kstep = (size_t)(BK * 2);
    const size_t hstep = (size_t)HALF * K * 2;
    const size_t tstep = 2 * hstep;
    const unsigned ldsw = (unsigned)wid * 1024u;
    const int aoff = lds_byte(wr * 64 + fr, fq * 8), boff = lds_byte(wc * 32 + fr, fq * 8);
#define PG8_SA(b, h) (((b) * 2 + (h)) * HTB)
#define PG8_SB(b, h) ((4 + (b) * 2 + (h)) * HTB)
#define PG8_STAGE(bufoff, gbase, voff) do { _Pragma("unroll") for (int _i = 0; _i < 2; ++_i) \
        __builtin_amdgcn_global_load_lds((const unsigned*)((const char*)(gbase) + (voff)[_i]), (PG8_LAS unsigned*)(lds + (bufoff) + ldsw + _i * 8192), 16, 0, 0); } while (0)
#define PG8_LDA(dst, b, h) do { _Pragma("unroll") for (int m = 0; m < 4; ++m) _Pragma("unroll") for (int k = 0; k < 2; ++k) dst[m][k] = *(const PG8_LAS bf16x8*)(lds + PG8_SA(b, h) + aoff + m * 2048 + k * 1024); } while (0)
#define PG8_LDB(dst, b, h) do { _Pragma("unroll") for (int n = 0; n < 2; ++n) _Pragma("unroll") for (int k = 0; k < 2; ++k) dst[n][k] = *(const PG8_LAS bf16x8*)(lds + PG8_SB(b, h) + boff + n * 2048 + k * 1024); } while (0)
#define PG8_MMA(ai, bj, At, Bt) do { __builtin_amdgcn_s_setprio(1); _Pragma("unroll") for (int m = 0; m < 4; ++m) _Pragma("unroll") for (int n = 0; n < 2; ++n) _Pragma("unroll") for (int k = 0; k < 2; ++k) \
        acc[ai][bj][m][n] = __builtin_amdgcn_mfma_f32_16x16x32_bf16(Bt[n][k], At[m][k], acc[ai][bj][m][n], 0, 0, 0); __builtin_amdgcn_s_setprio(0); } while (0)
#define PG8_WAIT_V(n) asm volatile("s_waitcnt vmcnt(" #n ")" ::: "memory")
#define PG8_WAIT_L(n) asm volatile("s_waitcnt lgkmcnt(" #n ")" ::: "memory")
#define PG8_BAR __builtin_amdgcn_s_barrier()
#define PG8_SCHED __builtin_amdgcn_sched_barrier(0)
    Unit cur, nxt; int ui = 0;
    if (!S.next(0, cur)) return;
    f32x4 acc[2][2][4][2];
#pragma unroll
    for (int a = 0; a < 2; ++a)
#pragma unroll
        for (int b = 0; b < 2; ++b)
#pragma unroll
            for (int m = 0; m < 4; ++m)
#pragma unroll
                for (int n = 0; n < 2; ++n) acc[a][b][m][n] = (f32x4){0.f, 0.f, 0.f, 0.f};
    bf16x8 At[4][2], B0[2][2], B1[2][2];
    const char* cA = (const char*)g.A + (size_t)cur.pm * tstep; const char* cB = (const char*)g.Bt + (size_t)cur.pn * tstep;
    S.a_ready(cur);
    if constexpr (SP2) {
        PG8_STAGE(PG8_SB(0, 0), cB, voffB); PG8_STAGE(PG8_SB(0, 1), cB + hstep, voffB); PG8_STAGE(PG8_SA(0, 0), cA, voffA); PG8_STAGE(PG8_SA(0, 1), cA + hstep, voffA);
        if (wr == 1) PG8_BAR;
        PG8_WAIT_V(2); PG8_BAR;
        PG8_STAGE(PG8_SB(1, 0), cB + kstep, voffB); PG8_STAGE(PG8_SA(1, 0), cA + kstep, voffA); PG8_STAGE(PG8_SB(1, 1), cB + hstep + kstep, voffB);
        PG8_WAIT_V(6); PG8_BAR;
    } else {
        PG8_STAGE(PG8_SB(0, 0), cB, voffB); PG8_STAGE(PG8_SA(0, 0), cA, voffA); PG8_STAGE(PG8_SB(0, 1), cB + hstep, voffB); PG8_STAGE(PG8_SA(0, 1), cA + hstep, voffA);
        if (wr == 1) PG8_BAR;
        PG8_WAIT_V(4); PG8_BAR;
        PG8_STAGE(PG8_SB(1, 0), cB + kstep, voffB); PG8_STAGE(PG8_SA(1, 0), cA + kstep, voffA); PG8_STAGE(PG8_SB(1, 1), cB + hstep + kstep, voffB);
        PG8_WAIT_V(6); PG8_BAR;
    }
    for (;;) {
        const bool has_next = S.next(ui + 1, nxt);
        const char* nA = has_next ? (const char*)g.A + (size_t)nxt.pm * tstep : cA; const char* nB = has_next ? (const char*)g.Bt + (size_t)nxt.pn * tstep : cB;
        for (int t = 0; t < nt; t += 2) {
            const bool last = (t == nt - 2);
            const char* a1 = cA + (size_t)(t + 1) * kstep;
            const char* a2 = last ? nA : cA + (size_t)(t + 2) * kstep; const char* b2 = last ? nB : cB + (size_t)(t + 2) * kstep;
            const char* a3 = a2 + kstep; const char* b3 = b2 + kstep;
            if (last && has_next) S.a_ready(nxt);
            if constexpr (SP2) {
            PG8_LDB(B0, 0, 0); PG8_LDB(B1, 0, 1); PG8_SCHED; PG8_LDA(At, 0, 0); PG8_STAGE(PG8_SA(1, 1), a1 + hstep, voffA);
            PG8_WAIT_V(8); PG8_WAIT_L(0); PG8_BAR; PG8_MMA(0, 0, At, B0); PG8_MMA(0, 1, At, B1); PG8_BAR; PG8_SCHED;
            PG8_LDA(At, 0, 1); PG8_STAGE(PG8_SB(0, 0), b2, voffB); PG8_STAGE(PG8_SB(0, 1), b2 + hstep, voffB); PG8_STAGE(PG8_SA(0, 0), a2, voffA);
            PG8_WAIT_V(8); PG8_WAIT_L(0); PG8_BAR; PG8_MMA(1, 0, At, B0); PG8_MMA(1, 1, At, B1); PG8_BAR; PG8_SCHED;
            PG8_LDB(B0, 1, 0); PG8_LDB(B1, 1, 1); PG8_SCHED; PG8_LDA(At, 1, 0); PG8_STAGE(PG8_SA(0, 1), a2 + hstep, voffA);
            PG8_WAIT_V(8); PG8_WAIT_L(0); PG8_BAR; PG8_MMA(0, 0, At, B0); PG8_MMA(0, 1, At, B1); PG8_BAR; PG8_SCHED;
            PG8_LDA(At, 1, 1); PG8_STAGE(PG8_SB(1, 0), b3, voffB); PG8_STAGE(PG8_SB(1, 1), b3 + hstep, voffB); PG8_STAGE(PG8_SA(1, 0), a3, voffA);
            PG8_WAIT_V(8); PG8_WAIT_L(0); PG8_BAR; PG8_MMA(1, 0, At, B0); PG8_MMA(1, 1, At, B1); PG8_BAR; PG8_SCHED;
            } else {
            PG8_LDB(B0, 0, 0); PG8_SCHED; PG8_LDA(At, 0, 0); PG8_STAGE(PG8_SA(1, 1), a1 + hstep, voffA);
            PG8_WAIT_L(8); PG8_BAR; PG8_WAIT_L(0); PG8_MMA(0, 0, At, B0); PG8_BAR; PG8_SCHED;
            PG8_LDB(B1, 0, 1); PG8_STAGE(PG8_SB(0, 0), b2, voffB);
            PG8_BAR; PG8_WAIT_L(0); PG8_MMA(0, 1, At, B1); PG8_BAR;
            PG8_LDA(At, 0, 1); PG8_STAGE(PG8_SA(0, 0), a2, voffA);
            PG8_BAR; PG8_WAIT_L(0); PG8_MMA(1, 0, At, B0); PG8_BAR; PG8_SCHED;
            PG8_STAGE(PG8_SB(0, 1), b2 + hstep, voffB);
            PG8_WAIT_V(6); PG8_BAR; PG8_MMA(1, 1, At, B1); PG8_BAR;
            PG8_LDB(B0, 1, 0); PG8_SCHED; PG8_LDA(At, 1, 0); PG8_STAGE(PG8_SA(0, 1), a2 + hstep, voffA);
            PG8_WAIT_L(8); PG8_BAR; PG8_WAIT_L(0); PG8_MMA(0, 0, At, B0); PG8_BAR; PG8_SCHED;
            PG8_LDB(B1, 1, 1); PG8_STAGE(PG8_SB(1, 0), b3, voffB);
            PG8_BAR; PG8_WAIT_L(0); PG8_MMA(0, 1, At, B1); PG8_BAR;
            PG8_LDA(At, 1, 1); PG8_STAGE(PG8_SA(1, 0), a3, voffA);
            PG8_BAR; PG8_WAIT_L(0); PG8_MMA(1, 0, At, B0); PG8_BAR; PG8_SCHED;
            PG8_STAGE(PG8_SB(1, 1), b3 + hstep, voffB);
            PG8_WAIT_V(6); PG8_BAR; PG8_MMA(1, 1, At, B1); PG8_BAR;
            }
        }
        if constexpr (ALIGN_EPI) { if (wr == 0) PG8_BAR; }
        if constexpr (!Epi::AFTER_DRAIN) { E(acc, cur, wr, wc, fr, fq); S.done(cur); }
        if (!has_next) break;
#pragma unroll
        for (int a = 0; a < 2; ++a)
#pragma unroll
            for (int b = 0; b < 2; ++b)
#pragma unroll
                for (int m = 0; m < 4; ++m)
#pragma unroll
                    for (int n = 0; n < 2; ++n) acc[a][b][m][n] = (f32x4){0.f, 0.f, 0.f, 0.f};
        cur = nxt; cA = nA; cB = nB; ++ui;
        if constexpr (ALIGN_EPI) { if (wr == 1) PG8_BAR; }
    }
    PG8_WAIT_V(0);
    if constexpr (!ALIGN_EPI) { if (wr == 0) PG8_BAR; }
    PG8_BAR;
    if constexpr (Epi::AFTER_DRAIN) { E.fused(acc, cur, wr, wc, fr, fq, lds, wid, lane); S.done(cur); }
#undef PG8_SA
#undef PG8_SB
#undef PG8_STAGE
#undef PG8_LDA
#undef PG8_LDB
#undef PG8_MMA
#undef PG8_WAIT_V
#undef PG8_WAIT_L
#undef PG8_BAR
#undef PG8_SCHED
}
}
#define XB_TMO      128
#define XB_XCNT(j)  (256  + 64 * (j))
#define XB_XSUB(j)  (1280 + 64 * (j))
#define XB_XGEN(j)  (2304 + 64 * (j))
#define XB_TOP      3328
#define XB_TOPGEN   3392
#define XCD_BAR_WORDS 3456
#define XB_SPIN_CAP (1u << 18)

__device__ __forceinline__ unsigned xb_ld(unsigned* p)              { return __hip_atomic_load(p, __ATOMIC_RELAXED, __HIP_MEMORY_SCOPE_AGENT); }
__device__ __forceinline__ unsigned xb_add(unsigned* p, unsigned v) { return __hip_atomic_fetch_add(p, v, __ATOMIC_RELAXED, __HIP_MEMORY_SCOPE_AGENT); }
__device__ __forceinline__ unsigned xb_xcc_id() { return (unsigned)__builtin_amdgcn_s_getreg((3 << 11) | 20) & 0xFu; }
#define XB_SPIN(cond, bar) do { unsigned _sp = 0; while (cond) { __builtin_amdgcn_s_sleep(1); \
    if ((++_sp & 255u) == 0u) { if (xb_ld(&(bar)[XB_TMO])) break; if (_sp > XB_SPIN_CAP) { atomicAdd(&(bar)[XB_TMO], 1u); break; } } } } while (0)

struct XcdBarrier {
    unsigned* bar; unsigned x;
    volatile LAS unsigned* st;
};

__device__ __forceinline__ XcdBarrier xcd_barrier_post(unsigned* bar, volatile LAS unsigned* st) {
    XcdBarrier b; b.bar = bar; b.x = xb_xcc_id(); b.st = st;
    if (threadIdx.x == 0) (void)xb_add(&bar[XB_XCNT(b.x)], 1u);
    return b;
}
__device__ __forceinline__ void xcd_barrier_complete(unsigned* bar, unsigned x, unsigned& nloc, unsigned& nx) {
    const unsigned G = gridDim.x * gridDim.y * gridDim.z;
    unsigned sum, cnt, mine, sp = 0u;
    for (;;) {
        sum = 0u; cnt = 0u; mine = 0u;
#pragma unroll
        for (unsigned j = 0; j < 16; ++j) { const unsigned c = xb_ld(&bar[XB_XCNT(j)]); sum += c; cnt += (c > 0u) ? 1u : 0u; mine = (j == x) ? c : mine; }
        if (sum == G) break;
        __builtin_amdgcn_s_sleep(1);
        if ((++sp & 255u) == 0u) { if (xb_ld(&bar[XB_TMO])) break; if (sp > XB_SPIN_CAP) { atomicAdd(&bar[XB_TMO], 1u); break; } }
    }
    nloc = mine > 0u ? mine : 1u; nx = cnt > 0u ? cnt : 1u;
}

__device__ __forceinline__ void xcd_barrier(const XcdBarrier& b) {
    asm volatile("s_waitcnt vmcnt(0)" ::: "memory");
    __syncthreads();
    if (threadIdx.x == 0) {
        unsigned* bar = b.bar;
        __builtin_amdgcn_s_waitcnt(0);
        unsigned nloc = b.st[0], nx = b.st[1];
        if (nloc == 0u) { xcd_barrier_complete(bar, b.x, nloc, nx); b.st[0] = nloc; b.st[1] = nx; }
        const unsigned old = xb_add(&bar[XB_XSUB(b.x)], 1u);
        const unsigned gen = old / nloc;
        if (old + 1u == (gen + 1u) * nloc) {
            __builtin_amdgcn_fence(__ATOMIC_RELEASE, "agent");
            asm volatile("s_waitcnt vmcnt(0)" ::: "memory");
            const unsigned og = xb_add(&bar[XB_TOP], 1u);
            const unsigned tg = og / nx;
            if (og + 1u == (tg + 1u) * nx) xb_add(&bar[XB_TOPGEN], 1u);
            else XB_SPIN(xb_ld(&bar[XB_TOPGEN]) == tg, bar);
            __builtin_amdgcn_fence(__ATOMIC_ACQUIRE, "agent");
            xb_add(&bar[XB_XGEN(b.x)], 1u);
            asm volatile("s_waitcnt vmcnt(0)" ::: "memory");
        } else {
            XB_SPIN(xb_ld(&bar[XB_XGEN(b.x)]) == gen, bar);
            __builtin_amdgcn_fence(__ATOMIC_ACQUIRE, "agent");
            asm volatile("s_waitcnt vmcnt(0)" ::: "memory");
        }
    }
    __syncthreads();
}

using pg8::bf16_t; using pg8::bf16x8; using pg8::f32x4; using pg8::u32x4; using pg8::cvt_pk_bf16; using pg8::fast_exp;

#define BAR_LDS() do { asm volatile("s_waitcnt lgkmcnt(0)" ::: "memory"); __builtin_amdgcn_s_barrier(); asm volatile("" ::: "memory"); } while (0)
#define BAR_ALL() do { asm volatile("s_waitcnt vmcnt(0) lgkmcnt(0)" ::: "memory"); __builtin_amdgcn_s_barrier(); asm volatile("" ::: "memory"); } while (0)

#ifdef PROBE_SHFL
__device__ __forceinline__ float shx(float v, int mask, int lane) { (void)lane; return __shfl_xor(v, mask); }
__device__ __forceinline__ unsigned shxu(unsigned v, int mask, int lane) { (void)lane; return __shfl_xor(v, mask); }
__device__ __forceinline__ unsigned shupu(unsigned v, int d, int lane) { (void)lane; return __shfl_up(v, d); }
#else
__device__ __forceinline__ float shx(float v, int mask, int lane) { return __builtin_bit_cast(float, __builtin_amdgcn_ds_bpermute((lane ^ mask) << 2, __builtin_bit_cast(int, v))); }
__device__ __forceinline__ unsigned shxu(unsigned v, int mask, int lane) { return (unsigned)__builtin_amdgcn_ds_bpermute((lane ^ mask) << 2, (int)v); }
__device__ __forceinline__ unsigned shupu(unsigned v, int d, int lane) { return (unsigned)__builtin_amdgcn_ds_bpermute((lane - d) << 2, (int)v); }
#endif
__device__ __forceinline__ float wave_sum(float v, int lane) {
#pragma unroll
    for (int o = 1; o < 64; o <<= 1) v += shx(v, o, lane);
    return v;
}
__device__ __forceinline__ float bf_lo(unsigned u) { return __uint_as_float(u << 16); }
__device__ __forceinline__ float bf_hi(unsigned u) { return __uint_as_float(u & 0xffff0000u); }

struct Args { const float* in[18]; float* out; unsigned char* ws; };
struct Ctx { LAS unsigned char* lds; int w0;
    __device__ __forceinline__ const float* in(int i) const { return ldptr(lds, i); }
    __device__ __forceinline__ float* out() const { return (float*)ldptr(lds, 18); }
    __device__ __forceinline__ unsigned char* ws() const { return (unsigned char*)ldptr(lds, 19); } };
#define PHASE_IDS() const int tid = opaque_tid(a.w0), lane = tid & 63, wave = __builtin_amdgcn_readfirstlane(tid >> 6); (void)tid; (void)lane; (void)wave
enum { I_X = 0, I_C, I_CTX, I_CCTX, I_WADA, I_BADA, I_GMIX, I_GFFN, I_WIN, I_WOUT, I_LBL, I_ONORM, I_RDEC, I_WR, I_WEG, I_WEU, I_WED, I_GFIN };

struct CvtItem { const float* src; unsigned char* dst; int N, Kd, f8; };
__device__ __forceinline__ void cvt_desc(CvtItem& it, const float* W, int N, unsigned char* WT, int Kd, int k0, int n0, int drow0, int lane, int f8) {
    const int q = lane >> 4, c = lane & 15, es = f8 ? 1 : 2;
    it.src = W + (size_t)(k0 + 16 * q) * N + n0 + 4 * c; it.N = N; it.Kd = Kd * es; it.dst = WT + ((size_t)(drow0 + 4 * c) * Kd + k0 + 16 * q) * es; it.f8 = f8;
}
__device__ __forceinline__ void cvt_load(f32x4 (&v)[16], const CvtItem& it) {
#pragma unroll
#ifdef CVT_NT
    for (int i = 0; i < 16; ++i) v[i] = __builtin_nontemporal_load((const f32x4*)(it.src + (size_t)i * it.N));
#else
    for (int i = 0; i < 16; ++i) v[i] = *(const f32x4*)(it.src + (size_t)i * it.N);
#endif
}
__device__ __forceinline__ void cvt_store(const f32x4 (&v)[16], const CvtItem& it) {
    if (it.f8) {
#pragma unroll
        for (int j = 0; j < 4; ++j) { u32x4 o; constexpr float s = pg8::F8_SW;
            o.x = pg8::pk4_fp8(v[0][j] * s, v[1][j] * s, v[2][j] * s, v[3][j] * s); o.y = pg8::pk4_fp8(v[4][j] * s, v[5][j] * s, v[6][j] * s, v[7][j] * s);
            o.z = pg8::pk4_fp8(v[8][j] * s, v[9][j] * s, v[10][j] * s, v[11][j] * s); o.w = pg8::pk4_fp8(v[12][j] * s, v[13][j] * s, v[14][j] * s, v[15][j] * s);
            *(u32x4*)(it.dst + (size_t)j * it.Kd) = o; }
    } else {
#pragma unroll
        for (int j = 0; j < 4; ++j) { u32x4 o0, o1;
            o0.x = cvt_pk_bf16(v[0][j], v[1][j]); o0.y = cvt_pk_bf16(v[2][j], v[3][j]); o0.z = cvt_pk_bf16(v[4][j], v[5][j]); o0.w = cvt_pk_bf16(v[6][j], v[7][j]);
            o1.x = cvt_pk_bf16(v[8][j], v[9][j]); o1.y = cvt_pk_bf16(v[10][j], v[11][j]); o1.z = cvt_pk_bf16(v[12][j], v[13][j]); o1.w = cvt_pk_bf16(v[14][j], v[15][j]);
            *(u32x4*)(it.dst + (size_t)j * it.Kd) = o0; *(u32x4*)(it.dst + (size_t)j * it.Kd + 16) = o1; }
    }
}
__device__ __forceinline__ void cvt_expert_desc(CvtItem& it, const Ctx& a, unsigned char* ws, int g, int lane) {
    constexpr int I_E = 512; const int l = g / 24576, r = g % 24576; const int le = l * 16 + r / (3 * I_E), q3 = r % (3 * I_E), kind = q3 / I_E, q = q3 % I_E;
    if (kind < 2) { const int kb = q / 32, nb = q % 32, n0 = nb * 64;
        const int drow = 256 * (n0 >> 7) + (n0 & 127) + kind * 128;
        cvt_desc(it, a.in(kind == 0 ? I_WEG : I_WEU) + (size_t)le * D * FF, FF, (unsigned char*)(ws + WS_WGU) + (size_t)le * 4096 * D, D, kb * 64, n0, drow, lane, 1);
    } else { const int kb = q / 16, nb = q % 16;
        cvt_desc(it, a.in(I_WED) + (size_t)le * FF * D, D, (unsigned char*)(ws + WS_WD) + (size_t)le * D * FF, FF, kb * 64, nb * 64, nb * 64, lane, 1); }
}
constexpr int CVT_N0 = 9472, CVT_G1 = 7040, CVT_G2 = 7936, CVT_T = 4608, CVT_G4 = 6144, CVT_CYC = CVT_G1 + CVT_G2 + CVT_T + CVT_G4;
static_assert(CVT_G1 == 220 * 8 * 4 && CVT_G2 == 248 * 8 * 4 && CVT_T == 192 * 8 * 3 && CVT_G4 == 192 * 8 * 4, "slot sizes = idle workgroups x 8 waves x items per wave");
static_assert(CVT_N0 + CVT_G1 + CVT_G2 + CVT_T >= 24576 && CVT_N0 + CVT_CYC + CVT_G1 + CVT_G2 + CVT_T >= 2 * 24576 && CVT_N0 + 2 * CVT_CYC + CVT_G1 + CVT_G2 + CVT_T >= 3 * 24576 && CVT_N0 + 3 * CVT_CYC + CVT_G1 + CVT_T >= 4 * 24576, "every layer's expert weights are converted before its first expert GEMM");
__device__ __forceinline__ void cvt_tail(const Ctx& a, int first, int rank, int per, int i0, int i1) {
    PHASE_IDS(); unsigned char* ws = a.ws();
    const int base = first + (rank * 8 + wave) * per; int g = base + i0, g1 = base + i1; if (g1 > 4 * 24576) g1 = 4 * 24576;
    f32x4 va[16], vb[16]; CvtItem ia, ib;
    if (g < g1) { cvt_expert_desc(ia, a, ws, g, lane); cvt_load(va, ia); }
    while (g < g1) {
        if (g + 1 < g1) { cvt_expert_desc(ib, a, ws, g + 1, lane); cvt_load(vb, ib); }
        cvt_store(va, ia);
        if (++g >= g1) break;
        if (g + 1 < g1) { cvt_expert_desc(ia, a, ws, g + 1, lane); cvt_load(va, ia); }
        cvt_store(vb, ib);
        ++g; }
}
template <int PER>
__device__ __forceinline__ void cvt_tail(const Ctx& a, int first, int rank) { cvt_tail(a, first, rank, PER, 0, PER); }

__device__ __forceinline__ void p0_item_desc(CvtItem& it, const Ctx& a, unsigned char* ws, int r, int lane) {
    constexpr int I_IN = 16 * 72, I_OUT = 16 * 16;
    if (r < 4 * I_IN) { const int l = r / I_IN, q = r % I_IN, kb = q / 72, nb = q % 72;

#ifdef G1_F8
        cvt_desc(it, a.in(I_WIN) + (size_t)l * D * INW, INW, (unsigned char*)(ws + WS_WIN) + (size_t)l * INW * D, D, kb * 64, nb * 64, nb * 64, lane, 1); return; }
#else
        cvt_desc(it, a.in(I_WIN) + (size_t)l * D * INW, INW, (unsigned char*)((bf16_t*)(ws + WS_WIN) + (size_t)l * INW * D), D, kb * 64, nb * 64, nb * 64, lane, 0); return; }
#endif
    r -= 4 * I_IN;
    if (r < 4 * I_OUT) { const int l = r / I_OUT, q = r % I_OUT, kb = q / 16, nb = q % 16;

#ifdef G2_F8
        cvt_desc(it, a.in(I_WOUT) + (size_t)l * D * D, D, (unsigned char*)(ws + WS_WOUT) + (size_t)l * D * D, D, kb * 64, nb * 64, nb * 64, lane, 1); return; }
#else
        cvt_desc(it, a.in(I_WOUT) + (size_t)l * D * D, D, (unsigned char*)((bf16_t*)(ws + WS_WOUT) + (size_t)l * D * D), D, kb * 64, nb * 64, nb * 64, lane, 0); return; }
#endif
    r -= 4 * I_OUT;
    cvt_expert_desc(it, a, ws, r, lane);
}
__device__ __forceinline__ void p0_prologue(const Ctx& a) {
    PHASE_IDS(); LAS unsigned char* lds = launder_lds(a.lds); unsigned char* ws = a.ws(); const float* cin_ = a.in(I_C); const float* cctx_ = a.in(I_CCTX);
    LAS float* scond = (LAS float*)(lds + 8 * 16640);
    for (int i = tid; i < 3 * D; i += 512) { const int w = i >> 10, k = i & 1023; const float cv = (w < 2) ? cin_[w * D + k] : cctx_[k]; scond[i] = cv * pg8::fast_sigmoid(cv); }
    if (blockIdx.x == 0) { const int c = tid; const float* lg = a.in(I_LBL);
        const float l0 = lg[c], l1 = lg[512 + c], l2 = lg[1024 + c], l3 = lg[1536 + c]; const float mx = fmaxf(fmaxf(l0, l1), fmaxf(l2, l3));
        const float e0 = expf(l0 - mx), e1 = expf(l1 - mx), e2 = expf(l2 - mx), e3 = expf(l3 - mx), inv = 1.0f / (e0 + e1 + e2 + e3);
        float* lbs = (float*)(ws + WS_LBS); lbs[c] = 0.f; lbs[512 + c] = e1 * inv; lbs[1024 + c] = (e1 + e2) * inv; lbs[1536 + c] = (e1 + e2 + e3) * inv; }
    if (blockIdx.x >= 1 && blockIdx.x <= 16) { const int idx = (blockIdx.x - 1) * 512 + tid, pos = idx >> 5, f = idx & 31;
        const float invf = powf(10000.0f, -(float)f / 32.0f), ang = (float)pos * invf; float* cs = (float*)(ws + WS_ROPE); cs[idx * 2] = cosf(ang); cs[idx * 2 + 1] = sinf(ang); }
    BAR_LDS();
    const int gw = blockIdx.x * 8 + wave, NGW = gridDim.x * 8;
    for (int it = gw; it < 4 * 24 * 8; it += NGW) { const int l = it / 192, r = it % 192, cg = r >> 3, ks = r & 7; const int cols = cg * 256 + lane * 4;
        const float* wp = a.in(I_WADA) + ((size_t)l * D + ks * 128) * 6144 + cols; f32x4 a0 = {0, 0, 0, 0}, a1 = a0, a2 = a0;
#pragma unroll 8
        for (int kk = 0; kk < 128; ++kk) { const f32x4 w = *(const f32x4*)(wp + (size_t)kk * 6144); const int k = ks * 128 + kk; a0 += w * scond[k]; a1 += w * scond[D + k]; a2 += w * scond[2 * D + k]; }
        float* pp = (float*)(ws + WS_MODP) + (size_t)((l * 8 + ks) * 3) * 6144 + cols; *(f32x4*)pp = a0; *(f32x4*)(pp + 6144) = a1; *(f32x4*)(pp + 2 * 6144) = a2; }
#ifdef PROBE_NOBG
    const int n_exp = 4 * 24576;
#else
    const int n_exp = (gridDim.x == 256) ? CVT_N0 : 4 * 24576;
#endif
    const int NIT = 4 * (16 * 72 + 16 * 16) + n_exp;
    f32x4 va[16], vb[16]; CvtItem ia, ib; int it = gw;
    if (it < NIT) { p0_item_desc(ia, a, ws, it, lane); cvt_load(va, ia); }
    while (it < NIT) {
        int nx = it + NGW;
        if (nx < NIT) { p0_item_desc(ib, a, ws, nx, lane); cvt_load(vb, ib); }
        cvt_store(va, ia);
        it = nx; if (it >= NIT) break;
        nx = it + NGW;
        if (nx < NIT) { p0_item_desc(ia, a, ws, nx, lane); cvt_load(va, ia); }
        cvt_store(vb, ib);
        it = nx;
    }
}

__device__ __forceinline__ void p0_finalize(const Ctx& a) {
    PHASE_IDS(); unsigned char* ws = a.ws(); const float* bada = a.in(I_BADA); const float* part = (const float*)(ws + WS_MODP); float* mods = (float*)(ws + WS_MODS);
    for (int i = blockIdx.x * 512 + tid; i < 4 * 3 * 6144; i += gridDim.x * 512) { const int l = i / (3 * 6144), r = i % (3 * 6144), w = r / 6144, j = r % 6144;
        float s = bada[l * 6144 + j];
#pragma unroll
        for (int ks = 0; ks < 8; ++ks) s += part[(size_t)((l * 8 + ks) * 3 + w) * 6144 + j];
        mods[i] = s; }
}

template <int MODE>
__device__ __forceinline__ void norm1_phase(const Ctx& a, int l) {
    PHASE_IDS(); unsigned char* ws = a.ws(); const float* in_x = a.in(I_X); const float* in_ctx = a.in(I_CTX); const float* gm = (MODE != 1) ? a.in(I_GMIX) + l * D : a.in(I_GFIN); float* outp = a.out(); const int gw = blockIdx.x * 8 + wave, NGW = gridDim.x * 8;
    const float* mods = (const float*)(ws + WS_MODS); bf16_t* X = (bf16_t*)(ws + WS_X); bf16_t* H = (bf16_t*)(ws + WS_H);
    const int* inv = (const int*)(ws + WS_INV); const unsigned char* YS = (const unsigned char*)(ws + WS_YS); const float* gate = (const float*)(ws + WS_ROWMAP) + MOE_ROWS;
    constexpr int NTOT = (MODE == 1) ? NB * SEQ : MROWS;
#define N1_ROWOF(n_) ((MODE == 1) ? (((n_) >> 14) * LTOT + CTX + ((n_) & (SEQ - 1))) : (n_))
#define N1_LOADROW(n_, v_, iv_) do { const int r_ = N1_ROWOF(n_); const int b_ = r_ >= LTOT ? 1 : 0, g_ = r_ - b_ * LTOT; \
        if (l == 0) { const float* src_ = (g_ < CTX ? in_ctx + (size_t)(b_ * CTX + g_) * D : in_x + (size_t)(b_ * SEQ + g_ - CTX) * D); \
            _Pragma("unroll") for (int j = 0; j < 4; ++j) v_[j] = *(const f32x4*)(src_ + lane * 4 + 256 * j); } \
        else { const bf16_t* src_ = X + (size_t)r_ * D; _Pragma("unroll") for (int j = 0; j < 4; ++j) { const u32x2 w_ = *(const u32x2*)(src_ + lane * 4 + 256 * j); v_[j] = (f32x4){bf_lo(w_.x), bf_hi(w_.x), bf_lo(w_.y), bf_hi(w_.y)}; } \
            iv_ = inv[r_ * 16 + (lane & 15)]; } } while (0)
    f32x4 v[4]; int iv = -1; int n = gw;
    int curw = -1; f32x4 cgs[4], csh[4], cgt[4];
#pragma unroll
    for (int j = 0; j < 4; ++j) { cgs[j] = (f32x4){0.f, 0.f, 0.f, 0.f}; csh[j] = cgs[j]; cgt[j] = cgs[j]; }
    if (n < NTOT) N1_LOADROW(n, v, iv);
    for (; n < NTOT; n += NGW) {
        const int row = N1_ROWOF(n); const int b = row >= LTOT ? 1 : 0, g = row - b * LTOT; const bool isctx = g < CTX; const int which = isctx ? 2 : b;
        if (which != curw) { curw = which;
            if (MODE != 1) { const float* sh_ = mods + (size_t)(l * 3 + which) * 6144; const float* sc_ = sh_ + D;
#pragma unroll
                for (int j = 0; j < 4; ++j) { const int c = lane * 4 + 256 * j; cgs[j] = *(const f32x4*)(gm + c) * (*(const f32x4*)(sc_ + c) + 1.0f); csh[j] = *(const f32x4*)(sh_ + c); } }
            else {
#pragma unroll
                for (int j = 0; j < 4; ++j) cgs[j] = *(const f32x4*)(gm + lane * 4 + 256 * j); }
            if (l != 0) { const float* gt2_ = mods + (size_t)((l - 1) * 3 + which) * 6144 + 5 * D;
#pragma unroll
                for (int j = 0; j < 4; ++j) cgt[j] = *(const f32x4*)(gt2_ + lane * 4 + 256 * j); } }
        f32x4 vn[4]; int ivn = -1; const int nn = n + NGW;
        if (nn < NTOT) N1_LOADROW(nn, vn, ivn);
        if (l != 0) {
            unsigned vm = (unsigned)__builtin_amdgcn_ballot_w64(iv >= 0) & 0xffffu;
            f32x4 s[4] = {{0, 0, 0, 0}, {0, 0, 0, 0}, {0, 0, 0, 0}, {0, 0, 0, 0}};
            while (vm) {
                const int e0 = __builtin_ctz(vm); vm &= vm - 1; const bool has1 = vm != 0u; const int e1 = has1 ? __builtin_ctz(vm) : e0; if (has1) vm &= vm - 1;
                const int mr0 = __builtin_amdgcn_readlane(iv, e0), mr1 = __builtin_amdgcn_readlane(iv, e1);
                const float g0 = gate[mr0] * (1.0f / pg8::F8_SY), g1 = has1 ? gate[mr1] * (1.0f / pg8::F8_SY) : 0.f;
                const unsigned char* y0r = YS + (size_t)mr0 * D + lane * 4; const unsigned char* y1r = YS + (size_t)mr1 * D + lane * 4; unsigned y0[4], y1[4];
#pragma unroll
                for (int j = 0; j < 4; ++j) { y0[j] = *(const unsigned*)(y0r + 256 * j); y1[j] = *(const unsigned*)(y1r + 256 * j); }
#pragma unroll
                for (int j = 0; j < 4; ++j) { const f32x2 a01 = __builtin_amdgcn_cvt_pk_f32_fp8((int)y0[j], false), a23 = __builtin_amdgcn_cvt_pk_f32_fp8((int)y0[j], true);
                    const f32x2 b01 = __builtin_amdgcn_cvt_pk_f32_fp8((int)y1[j], false), b23 = __builtin_amdgcn_cvt_pk_f32_fp8((int)y1[j], true);
                    s[j][0] += g0 * a01.x + g1 * b01.x; s[j][1] += g0 * a01.y + g1 * b01.y; s[j][2] += g0 * a23.x + g1 * b23.x; s[j][3] += g0 * a23.y + g1 * b23.y; } }
            bf16_t* xr = X + (size_t)row * D;
#pragma unroll
            for (int j = 0; j < 4; ++j) { v[j] += cgt[j] * s[j]; if (MODE == 0) { u32x2 w; w.x = cvt_pk_bf16(v[j][0], v[j][1]); w.y = cvt_pk_bf16(v[j][2], v[j][3]); *(u32x2*)(xr + lane * 4 + 256 * j) = w; } }
        }
        float ss = 0.f;
#pragma unroll
        for (int j = 0; j < 4; ++j) ss += (v[j][0] * v[j][0] + v[j][1] * v[j][1]) + (v[j][2] * v[j][2] + v[j][3] * v[j][3]);
        const float rinv = __builtin_amdgcn_rsqf(wave_sum(ss, lane) * (1.0f / D) + EPS);
        if (MODE != 1) {
            bf16_t* hr = H + (size_t)row * D + lane * 4;
#pragma unroll
            for (int j = 0; j < 4; ++j) { const int c = lane * 4 + 256 * j; (void)c;
                const f32x4 y = v[j] * rinv * cgs[j] + csh[j];
#ifdef G1_F8
                *(unsigned*)((unsigned char*)H + (size_t)row * D + c) = pg8::pk4_fp8(y[0] * pg8::F8_SA, y[1] * pg8::F8_SA, y[2] * pg8::F8_SA, y[3] * pg8::F8_SA); }
#else
                u32x2 w; w.x = cvt_pk_bf16(y[0], y[1]); w.y = cvt_pk_bf16(y[2], y[3]); *(u32x2*)(hr + 256 * j) = w; }
#endif
        } else {
            float* orow = outp + (size_t)(b * SEQ + g - CTX) * D + lane * 4;
#pragma unroll
            for (int j = 0; j < 4; ++j) *(f32x4*)(orow + 256 * j) = v[j] * rinv * cgs[j];
        }
#pragma unroll
        for (int j = 0; j < 4; ++j) v[j] = vn[j];
        iv = ivn;
    }
#undef N1_ROWOF
#undef N1_LOADROW
}

constexpr int N2_WH = 0, N2_WL = 32768, N2_CS = 65536, N2_CH = 69632, N2_CE = 73728;
typedef __bf16 bf2v __attribute__((ext_vector_type(2)));
__device__ __forceinline__ float dot2_bf16(unsigned u, float c) { const bf2v v = __builtin_bit_cast(bf2v, u); return __builtin_amdgcn_fdot2_f32_bf16(v, v, c, false); }
__device__ __forceinline__ void norm2_phase(const Ctx& a, int l) {
    PHASE_IDS(); LAS unsigned char* lds = launder_lds(a.lds); unsigned char* ws = a.ws();
    const bf16_t* X = (const bf16_t*)(ws + WS_X); unsigned char* H8 = (unsigned char*)(ws + WS_H);
    int* inv = (int*)(ws + WS_INV); float* afl = (float*)(ws + WS_AFF); float* afc = afl + 2 * 16 * SEQ;
    const bool last = (l == DEPTH - 1);
    const int NQ = last ? 2048 : 2080;
    int built = -1;
    for (int q0 = blockIdx.x * 8; q0 < NQ; q0 += gridDim.x * 8) {
        const int which = q0 < 1024 ? 0 : (q0 < 2048 ? 1 : 2);
        const int q = q0 + wave; const bool isctx = q >= 2048;
        const int b = isctx ? ((q - 2048) >> 4) : (q >> 10), g0 = isctx ? ((q - 2048) & 15) * 16 : CTX + (q & 1023) * 16;
        const int row0 = b * LTOT + g0; const int r = lane & 15, kg = lane >> 4;
        u32x4 xa[32];
        { const bf16_t* xp = X + (size_t)(row0 + r) * D + 16 * kg;
#pragma unroll
          for (int c = 0; c < 16; ++c) { xa[2 * c] = *(const u32x4*)(xp + 64 * c); xa[2 * c + 1] = *(const u32x4*)(xp + 64 * c + 8); } }
        if (which != built) {
            if (built >= 0) BAR_LDS();
            const float* wr = a.in(I_WR) + (size_t)l * D * NE; const float* gm = a.in(I_GFFN) + l * D;
            const float* sh = (const float*)(ws + WS_MODS) + (size_t)(l * 3 + which) * 6144 + 3 * D; const float* sc = sh + D;
            const int e = tid & 15; float cpart = 0.f;
#pragma unroll 1
            for (int i = 0; i < 4; ++i) { const int u = tid + 512 * i; const int s = u >> 6, kgu = (u >> 4) & 3; const int k0 = 64 * (s >> 1) + 16 * kgu + 8 * (s & 1);
                u32x4 hi4, lo4;
#pragma unroll
                for (int h = 0; h < 2; ++h) { const f32x4 gg = *(const f32x4*)(gm + k0 + 4 * h), s1 = *(const f32x4*)(sc + k0 + 4 * h), s0 = *(const f32x4*)(sh + k0 + 4 * h); const f32x4 m = gg * (s1 + 1.0f);
#pragma unroll
                    for (int jp = 0; jp < 2; ++jp) { const int j = 4 * h + 2 * jp; const float w0 = wr[(k0 + j) * 16 + e], w1 = wr[(k0 + j + 1) * 16 + e];
                        const float v0 = m[2 * jp] * w0, v1 = m[2 * jp + 1] * w1; cpart += s0[2 * jp] * w0 + s0[2 * jp + 1] * w1;
                        const unsigned ph = cvt_pk_bf16(v0, v1); const unsigned pl = cvt_pk_bf16(v0 - bf_lo(ph), v1 - bf_hi(ph));
                        hi4[2 * h + jp] = ph; lo4[2 * h + jp] = pl; } }
                *(LAS u32x4*)(lds + N2_WH + u * 16) = hi4; *(LAS u32x4*)(lds + N2_WL + u * 16) = lo4; }
            cpart += shx(cpart, 16, lane); cpart += shx(cpart, 32, lane);
            if (lane < 16) ((LAS float*)(lds + N2_CE))[wave * 16 + lane] = cpart;
            if (tid < 256) { const int k = tid * 4; const f32x4 gg = *(const f32x4*)(gm + k), s1 = *(const f32x4*)(sc + k), s0 = *(const f32x4*)(sh + k);
                *(LAS f32x4*)(lds + N2_CS + k * 4) = gg * (s1 + 1.0f) * pg8::F8_SA; *(LAS f32x4*)(lds + N2_CH + k * 4) = s0 * pg8::F8_SA; }
            BAR_LDS(); built = which;
        }
        f32x4 acc = {0.f, 0.f, 0.f, 0.f}; float ss = 0.f;
#pragma unroll
        for (int s = 0; s < 32; ++s) {
            const bf16x8 wh = *(const LAS bf16x8*)(lds + N2_WH + (s * 64 + lane) * 16), wl = *(const LAS bf16x8*)(lds + N2_WL + (s * 64 + lane) * 16);
            const bf16x8 xf = __builtin_bit_cast(bf16x8, xa[s]);
            acc = __builtin_amdgcn_mfma_f32_16x16x32_bf16(wh, xf, acc, 0, 0, 0); acc = __builtin_amdgcn_mfma_f32_16x16x32_bf16(wl, xf, acc, 0, 0, 0);
            ss = dot2_bf16(xa[s][0], ss); ss = dot2_bf16(xa[s][1], ss); ss = dot2_bf16(xa[s][2], ss); ss = dot2_bf16(xa[s][3], ss);
            if ((s & 3) == 3) __builtin_amdgcn_sched_barrier(0); }
        ss += shx(ss, 16, lane); ss += shx(ss, 32, lane);
        const float rinv = __builtin_amdgcn_rsqf(ss * (1.0f / D) + EPS);
        {
            f32x4 ce = {0.f, 0.f, 0.f, 0.f};
#pragma unroll
            for (int w = 0; w < 8; ++w) ce += *(const LAS f32x4*)(lds + N2_CE + (w * 16 + 4 * kg) * 4);
            const f32x4 lg = acc * rinv + ce;
            float mx = fmaxf(fmaxf(lg[0], lg[1]), fmaxf(lg[2], lg[3])); mx = fmaxf(mx, shx(mx, 16, lane)); mx = fmaxf(mx, shx(mx, 32, lane));
            f32x4 ex; ex[0] = expf(lg[0] - mx); ex[1] = expf(lg[1] - mx); ex[2] = expf(lg[2] - mx); ex[3] = expf(lg[3] - mx);
            float sm = (ex[0] + ex[1]) + (ex[2] + ex[3]); sm += shx(sm, 16, lane); sm += shx(sm, 32, lane);
            float* dst = isctx ? afc + (size_t)(b * 16 + 4 * kg) * CTX + g0 + r : afl + (size_t)(b * 16 + 4 * kg) * SEQ + (g0 - CTX) + r; const int estr = isctx ? CTX : SEQ;
#pragma unroll
            for (int j = 0; j < 4; ++j) dst[(size_t)j * estr] = ex[j] / sm; }
        { typedef int i32x4 __attribute__((ext_vector_type(4))); int m1 = -1; asm volatile("" : "+v"(m1)); *(i32x4*)(inv + (size_t)row0 * 16 + lane * 4) = (i32x4){m1, m1, m1, m1}; }
        unsigned char* hp = H8 + (size_t)(row0 + r) * D + 16 * kg;
#pragma unroll
        for (int c = 0; c < 16; ++c) { const LAS f32x4* cs = (const LAS f32x4*)(lds + N2_CS + (64 * c + 16 * kg) * 4); const LAS f32x4* ch = (const LAS f32x4*)(lds + N2_CH + (64 * c + 16 * kg) * 4);
            u32x4 o;
#pragma unroll
            for (int h = 0; h < 4; ++h) { const unsigned w0 = xa[2 * c + (h >> 1)][2 * (h & 1)], w1 = xa[2 * c + (h >> 1)][2 * (h & 1) + 1];
                const f32x4 xv = {bf_lo(w0), bf_hi(w0), bf_lo(w1), bf_hi(w1)}; const f32x4 y = xv * rinv * cs[h] + ch[h]; o[h] = pg8::pk4_fp8(y[0], y[1], y[2], y[3]); }
            *(u32x4*)(hp + 64 * c) = o;
            if ((c & 1) == 1) __builtin_amdgcn_sched_barrier(0); }
    }
}

__device__ __forceinline__ void topk_phase(const Ctx& a, int l) {
    PHASE_IDS(); LAS unsigned char* lds = launder_lds(a.lds); unsigned char* ws = a.ws(); const float* afl = (const float*)(ws + WS_AFF); const float* afc = afl + 2 * 16 * SEQ;
    int* rowmap = (int*)(ws + WS_ROWMAP); float* gate = (float*)(ws + WS_ROWMAP) + MOE_ROWS; int* inv = (int*)(ws + WS_INV);
    LAS unsigned* wcnt = (LAS unsigned*)lds;
    const int nitems = (l == DEPTH - 1) ? 32 : 64;
    for (int it = blockIdx.x; it < nitems; it += gridDim.x) {
        const bool isctx = it >= 32; const int be = it & 31, b = be >> 4, e = be & 15;
        const int n = isctx ? CTX : SEQ, k = isctx ? CAP_CTX : CAP_LAT;
        const float* src = isctx ? afc + be * CTX : afl + (size_t)be * SEQ;
        unsigned key[32];
#pragma unroll
        for (int i = 0; i < 32; ++i) { const int idx = i * 512 + tid; key[i] = idx < n ? __float_as_uint(src[idx]) : 0u; }
        unsigned T = 0u;
        for (int bit = 30; bit >= 0; --bit) { const unsigned cand = T | (1u << bit); unsigned cnt = 0;
#pragma unroll
            for (int i = 0; i < 32; ++i) cnt += (key[i] >= cand) ? 1u : 0u;
#pragma unroll
            for (int o = 1; o < 64; o <<= 1) cnt += shxu(cnt, o, lane);
            LAS unsigned* wc = wcnt + (bit & 1) * 8; if (lane == 0) wc[wave] = cnt;
            BAR_LDS();
            unsigned tot = 0;
#pragma unroll
            for (int w = 0; w < 8; ++w) tot += wc[w];
            if (tot >= (unsigned)k) T = cand; }
        unsigned mine = 0;
#pragma unroll
        for (int i = 0; i < 32; ++i) mine += (key[i] > T ? 1u : 0u) + (key[i] == T ? 65536u : 0u);
        unsigned incl = mine;
#pragma unroll
        for (int o = 1; o < 64; o <<= 1) { const unsigned t = shupu(incl, o, lane); if (lane >= o) incl += t; }
        LAS unsigned* wt = wcnt + 16; BAR_LDS();
        if (lane == 63) wt[wave] = incl;
        BAR_LDS();
        unsigned base = 0, total = 0;
#pragma unroll
        for (int w = 0; w < 8; ++w) { const unsigned t = wt[w]; total += t; if (w < wave) base += t; }
        const unsigned excl = base + incl - mine; const unsigned cgt = total & 0xffffu; const unsigned need = (unsigned)k - cgt;
        unsigned sg = excl & 0xffffu, se = excl >> 16;
        const int mrbase = e * MOE_ROWS_E + (isctx ? 4096 + b * CAP_CTX : b * CAP_LAT);
        const int rbase = b * LTOT + (isctx ? 0 : CTX);
#pragma unroll
        for (int i = 0; i < 32; ++i) { const int idx = i * 512 + tid; const unsigned kk = key[i]; int slot = -1;
            if (kk > T) { slot = (int)sg; ++sg; } else if (kk == T) { if (se < need) slot = (int)(cgt + se); ++se; }
            if (slot >= 0) { const int mr = mrbase + slot, r = rbase + idx; rowmap[mr] = r; gate[mr] = __uint_as_float(kk); inv[r * 16 + e] = mr; } }
        if (isctx && b == 0 && tid < 192) { const int mr = e * MOE_ROWS_E + 4160 + tid; rowmap[mr] = 0; gate[mr] = 0.f; }
        BAR_LDS();
    }
}


constexpr int SC_QI = 0, SC_KI = 16384, SC_KT = 32768, SC_VT = 49152, SC_PI = 65536, SC_SM = 73728, SC_PART = 106496, SC_VA = 110592, SC_VB = 111104, SC_VM = 111616, SC_RED = 112128;
__device__ __forceinline__ int st_off(int r, int cbytes, int ncs) { return ((r >> 4) * ncs + (cbytes >> 6)) * 1024 + (r & 15) * 64 + ((cbytes & 63) ^ ((r & 8) << 2)); }
__device__ __forceinline__ int st_lane(int fr, int fq) { return fr * 64 + ((fq * 16) ^ ((fr & 8) << 2)); }
struct ScanBufs { int kt, vt, part, va, vb, vm; };
__device__ __forceinline__ ScanBufs scan_bufs(int parity) { ScanBufs b; b.kt = parity ? SC_QI : SC_KT; b.vt = parity ? SC_KI : SC_VT; b.part = parity ? SC_PI : SC_PART; b.va = parity ? SC_PI + 4096 : SC_VA; b.vb = parity ? SC_PI + 4608 : SC_VB; b.vm = parity ? SC_PI + 5120 : SC_VM; return b; }

__device__ __forceinline__ bf16x8 ldfrag(const LAS unsigned char* img, int tile, int ks, int ncs, int lp) { return *(const LAS bf16x8*)(img + (tile * ncs + ks) * 1024 + lp); }
#define MFMA16(a, b, c) __builtin_amdgcn_mfma_f32_16x16x32_bf16((a), (b), (c), 0, 0, 0)
#ifndef SCAN_LOG2
__device__ __forceinline__ float ex2(float x) { return __builtin_amdgcn_exp2f(x * 1.4426950408889634f); }
#define LOG2E_ 1.0f
#else
__device__ __forceinline__ float ex2(float x) { return __builtin_amdgcn_exp2f(x); }
#define LOG2E_ 1.4426950408889634f
#endif

__device__ __forceinline__ void scan_write_T(LAS unsigned char* img, const unsigned (&d)[8], int cp, int to) {
    u32x4 wa, wb;
    wa.x = (d[0] & 0xffffu) | (d[1] << 16); wa.y = (d[2] & 0xffffu) | (d[3] << 16); wa.z = (d[4] & 0xffffu) | (d[5] << 16); wa.w = (d[6] & 0xffffu) | (d[7] << 16);
    wb.x = (d[0] >> 16) | (d[1] & 0xffff0000u); wb.y = (d[2] >> 16) | (d[3] & 0xffff0000u); wb.z = (d[4] >> 16) | (d[5] & 0xffff0000u); wb.w = (d[6] >> 16) | (d[7] & 0xffff0000u);
    *(LAS u32x4*)(img + st_off(2 * cp, to * 16, 2)) = wa; *(LAS u32x4*)(img + st_off(2 * cp + 1, to * 16, 2)) = wb;
}

template <bool FULL>
__device__ __forceinline__ void scan_estage_hg(LAS unsigned char* lds, const ScanBufs& B, const unsigned (&kraw)[8], const unsigned (&qraw)[8], const unsigned (&vraw)[8], int lane, int wave, float& la_out, float& lb_out) {
    const int cp = lane, to = wave;
#ifndef SCAN_LOG2
    constexpr float LS = 1.4426950408889634f;
#else
    constexpr float LS = 1.0f;
#endif
    f32x2 c2[8]; f32x2 r2 = {0.f, 0.f};
#pragma unroll
    for (int tt = 0; tt < 8; ++tt) { r2 += (f32x2){bf_lo(kraw[tt]), bf_hi(kraw[tt])}; c2[tt] = r2; }
    *(LAS f32x2*)(lds + B.part + (to * 128 + 2 * cp) * 4) = r2;
    BAR_LDS();
    f32x2 p2 = {0.f, 0.f}, m2 = {0.f, 0.f}, l2 = {0.f, 0.f};
#pragma unroll
    for (int t8 = 0; t8 < 8; ++t8) { const f32x2 pp = *(const LAS f32x2*)(lds + B.part + (t8 * 128 + 2 * cp) * 4);
        if (t8 < to) p2 += pp; if (t8 < 4) m2 += pp; l2 += pp; }
    p2 = (p2 - m2) * LS;
    unsigned kd[8];
#pragma unroll
    for (int tt = 0; tt < 8; ++tt) { const int rr = 8 * to + tt;
        f32x2 d2 = p2 + c2[tt] * LS;
        d2 = __builtin_elementwise_min(__builtin_elementwise_max(d2, (f32x2){-120.f, -120.f}), (f32x2){120.f, 120.f});
        const f32x2 lf2 = (f32x2){bf_lo(kraw[tt]), bf_hi(kraw[tt])} * LS;
        const f32x2 k2 = (f32x2){1.0f, 1.0f} - (f32x2){__builtin_amdgcn_exp2f(lf2.x), __builtin_amdgcn_exp2f(lf2.y)};
        const f32x2 kt2 = k2 * (f32x2){__builtin_amdgcn_exp2f(-d2.x), __builtin_amdgcn_exp2f(-d2.y)};
        kd[tt] = cvt_pk_bf16(kt2.x, kt2.y);
        if (FULL) { const f32x2 qt2 = (f32x2){bf_lo(qraw[tt]), bf_hi(qraw[tt])} * (f32x2){__builtin_amdgcn_exp2f(d2.x), __builtin_amdgcn_exp2f(d2.y)};
            *(LAS unsigned*)(lds + SC_QI + st_off(rr, cp * 4, 4)) = cvt_pk_bf16(qt2.x, qt2.y);
            *(LAS unsigned*)(lds + SC_KI + st_off(rr, cp * 4, 4)) = kd[tt]; } }
    scan_write_T(lds + B.kt, kd, cp, to); scan_write_T(lds + B.vt, vraw, cp, to);
    if (to == 0) { *(LAS f32x2*)(lds + B.va + 8 * cp) = (f32x2){ex2(l2.x), ex2(l2.y)}; *(LAS f32x2*)(lds + B.vb + 8 * cp) = (f32x2){ex2(l2.x - m2.x), ex2(l2.y - m2.y)};
        *(LAS f32x2*)(lds + B.vm + 8 * cp) = (f32x2){ex2(m2.x), ex2(m2.y)}; }
    la_out = l2.x; lb_out = l2.y;
}
template <bool FULL>
__device__ __forceinline__ void scan_estage_ret(LAS unsigned char* lds, const ScanBufs& B, const unsigned (&kraw)[8], const unsigned (&qraw)[8], const unsigned (&vraw)[8], int lane, int wave, float lg2) {
    const int cp = lane, to = wave; unsigned kd[8];
#pragma unroll
    for (int tt = 0; tt < 8; ++tt) { const int rr = 8 * to + tt; const float wk = ex2((float)(63 - rr) * lg2); kd[tt] = cvt_pk_bf16(bf_lo(kraw[tt]) * wk, bf_hi(kraw[tt]) * wk);
        if (FULL) { *(LAS unsigned*)(lds + SC_QI + st_off(rr, cp * 4, 4)) = qraw[tt]; *(LAS unsigned*)(lds + SC_KI + st_off(rr, cp * 4, 4)) = kraw[tt]; } }
    scan_write_T(lds + B.kt, kd, cp, to); scan_write_T(lds + B.vt, vraw, cp, to);
}

template <bool RET>
__device__ __forceinline__ void scan_state_update(LAS unsigned char* lds, const ScanBufs& B, f32x4 (&ST)[8], int wave, int fr, int fq, float g64) {
    const int lp = st_lane(fr, fq);
    const bf16x8 a0 = ldfrag(lds + B.kt, wave, 0, 2, lp), a1 = ldfrag(lds + B.kt, wave, 1, 2, lp);
    f32x4 av = {g64, g64, g64, g64}, bv = {1.f, 1.f, 1.f, 1.f};
    if (!RET) { av = *(const LAS f32x4*)(lds + B.va + (16 * wave + 4 * fq) * 4); bv = *(const LAS f32x4*)(lds + B.vb + (16 * wave + 4 * fq) * 4); }
#pragma unroll
    for (int vi = 0; vi < 8; ++vi) { const bf16x8 b0 = ldfrag(lds + B.vt, vi, 0, 2, lp), b1 = ldfrag(lds + B.vt, vi, 1, 2, lp);
        f32x4 u = {0.f, 0.f, 0.f, 0.f}; u = MFMA16(a0, b0, u); u = MFMA16(a1, b1, u); ST[vi] = RET ? (av * ST[vi] + u) : (av * ST[vi] + bv * u); }
}

#define SCAN_LOAD_CHUNK(crow_, dir_) do { _Pragma("unroll") for (int tt = 0; tt < 8; ++tt) { const int rr_ = 8 * wave + tt; const size_t ro_ = (size_t)((crow_) + ((dir_) ? 63 - rr_ : rr_)) * INW + 2 * lane; \
        kraw[tt] = *(const unsigned*)(P + ro_ + colk); vraw[tt] = *(const unsigned*)(P + ro_ + colv); if (LOADQ) qraw[tt] = *(const unsigned*)(P + ro_ + colq); } } while (0)
#define SCAN_STORE_STATE(slot_) do { _Pragma("unroll") for (int vi = 0; vi < 8; ++vi) { u32x2 w; w.x = cvt_pk_bf16(ST[vi][0], ST[vi][1]); w.y = cvt_pk_bf16(ST[vi][2], ST[vi][3]); \
        *(u32x2*)(UB + (size_t)(slot_) * 16384 + (size_t)(vi * 512 + tid) * 4) = w; } } while (0)

struct ScanPtrs { const bf16_t* P; const bf16_t* SB; bf16_t* UB; float* AB; bf16_t* MIX; float* OB; const float* rdec; const float* onorm; };

__device__ __forceinline__ void scan1_hg_A(LAS unsigned char* lds, const ScanBufs& B, const unsigned (&kraw)[8], f32x2 (&c2)[8], int lane, int wave) {
    f32x2 r2 = {0.f, 0.f};
#pragma unroll
    for (int tt = 0; tt < 8; ++tt) { r2 += (f32x2){bf_lo(kraw[tt]), bf_hi(kraw[tt])}; c2[tt] = r2; }
    *(LAS f32x2*)(lds + B.part + (wave * 128 + 2 * lane) * 4) = r2;
}
__device__ __forceinline__ void scan1_hg_B(LAS unsigned char* lds, const ScanBufs& B, const unsigned (&kraw)[8], const unsigned (&vraw)[8], const f32x2 (&c2)[8], int lane, int wave, float& la_out, float& lb_out) {
    const int cp = lane, to = wave;
#ifndef SCAN_LOG2
    constexpr float LS = 1.4426950408889634f;
#else
    constexpr float LS = 1.0f;
#endif
    f32x2 p2 = {0.f, 0.f}, m2 = {0.f, 0.f}, l2 = {0.f, 0.f};
#pragma unroll
    for (int t8 = 0; t8 < 8; ++t8) { const f32x2 pp = *(const LAS f32x2*)(lds + B.part + (t8 * 128 + 2 * cp) * 4);
        if (t8 < to) p2 += pp; if (t8 < 4) m2 += pp; l2 += pp; }
    p2 = (p2 - m2) * LS;
    unsigned kd[8];
#pragma unroll
    for (int tt = 0; tt < 8; ++tt) {
        f32x2 d2 = p2 + c2[tt] * LS;
        d2 = __builtin_elementwise_min(__builtin_elementwise_max(d2, (f32x2){-120.f, -120.f}), (f32x2){120.f, 120.f});
        const f32x2 lf2 = (f32x2){bf_lo(kraw[tt]), bf_hi(kraw[tt])} * LS;
        const f32x2 k2 = (f32x2){1.0f, 1.0f} - (f32x2){__builtin_amdgcn_exp2f(lf2.x), __builtin_amdgcn_exp2f(lf2.y)};
        const f32x2 kt2 = k2 * (f32x2){__builtin_amdgcn_exp2f(-d2.x), __builtin_amdgcn_exp2f(-d2.y)};
        kd[tt] = cvt_pk_bf16(kt2.x, kt2.y); }
    scan_write_T(lds + B.kt, kd, cp, to); scan_write_T(lds + B.vt, vraw, cp, to);
    if (to == 0) { *(LAS f32x2*)(lds + B.va + 8 * cp) = (f32x2){ex2(l2.x), ex2(l2.y)}; *(LAS f32x2*)(lds + B.vb + 8 * cp) = (f32x2){ex2(l2.x - m2.x), ex2(l2.y - m2.y)}; }
    la_out = l2.x; lb_out = l2.y;
}
template <bool RET>
__device__ __forceinline__ void scan1_item(const ScanPtrs& sp, LAS unsigned char* lds, int tid, int lane, int wave, int seq, int tb) {
    const bf16_t* P = sp.P; bf16_t* UB = sp.UB; const int fr = lane & 15, fq = lane >> 4;
    const int b = seq >> 4, hh = (seq >> 1) & 7, dir = seq & 1, h = hh & 3;
    const int colk = RET ? 6 * 512 + h * 128 : (dir ? 2 * 512 : 512) + h * 128, colv = (RET ? 7 * 512 : 3 * 512) + h * 128;
    const float lg2 = RET ? -expf(sp.rdec[dir * 4 + h]) * LOG2E_ : 0.f, g64 = ex2(64.f * lg2);
    const int rowbase = b * LTOT + tb * 256;
    f32x4 ST[8];
#pragma unroll
    for (int vi = 0; vi < 8; ++vi) ST[vi] = (f32x4){0.f, 0.f, 0.f, 0.f};
    float ata = 0.f, atb = 0.f; unsigned kr[3][8], vr[3][8], qdummy[8]; f32x2 c2[2][8];
#pragma unroll
    for (int tt = 0; tt < 8; ++tt) qdummy[tt] = 0u;
#define S1_LOAD(set_, ci_) do { const int crow_ = rowbase + (dir ? 3 - (ci_) : (ci_)) * 64; _Pragma("unroll") for (int tt = 0; tt < 8; ++tt) { const int rr_ = 8 * wave + tt; const size_t ro_ = (size_t)(crow_ + (dir ? 63 - rr_ : rr_)) * INW + 2 * lane; \
        kr[set_][tt] = *(const unsigned*)(P + ro_ + colk); vr[set_][tt] = *(const unsigned*)(P + ro_ + colv); } } while (0)
#define S1_A(ci_) do { if (!RET) scan1_hg_A(lds, scan_bufs((ci_) & 1), kr[(ci_) % 3], c2[(ci_) & 1], lane, wave); } while (0)
#define S1_B(ci_) do { const ScanBufs B_ = scan_bufs((ci_) & 1); if (RET) scan_estage_ret<false>(lds, B_, kr[(ci_) % 3], qdummy, vr[(ci_) % 3], lane, wave, lg2); \
        else { float la_, lb_; scan1_hg_B(lds, B_, kr[(ci_) % 3], vr[(ci_) % 3], c2[(ci_) & 1], lane, wave, la_, lb_); ata += la_; atb += lb_; } } while (0)
#define S1_U(ci_) scan_state_update<RET>(lds, scan_bufs((ci_) & 1), ST, wave, fr, fq, g64)
    S1_LOAD(0, 0); S1_LOAD(1, 1); S1_LOAD(2, 2);
    S1_A(0);                         BAR_LDS();
    S1_B(0); S1_LOAD(0, 3); S1_A(1); BAR_LDS();
    S1_U(0); S1_B(1); S1_A(2);       BAR_LDS();
    S1_U(1); S1_B(2); S1_A(3);       BAR_LDS();
    S1_U(2); S1_B(3);                BAR_LDS();
    S1_U(3);
#undef S1_LOAD
#undef S1_A
#undef S1_B
#undef S1_U
    const int slot = seq * 65 + tb;
    SCAN_STORE_STATE(slot);
    if (wave == 0) *(f32x2*)(sp.AB + (size_t)slot * 128 + 2 * lane) = RET ? (f32x2){ex2(256.f * lg2), ex2(256.f * lg2)} : (f32x2){ex2(ata), ex2(atb)};
}

template <bool RET>
__device__ __forceinline__ void scan3_item(const ScanPtrs& sp, LAS unsigned char* lds, int tid, int lane, int wave, int bh, int tb, bool store_state, int nch = 4) {
#ifdef PROBE_SKIP
    if ((PROBE_SKIP == 1 && RET) || (PROBE_SKIP == 2 && !RET)) return;
#endif
    const bf16_t* P = sp.P; bf16_t* UB = sp.UB; float* OB = sp.OB;
    const int ti = wave & 3, vh = wave >> 2; constexpr bool LOADQ = true;
    const int b = bh >> 3, hh = bh & 7, h = hh & 3;
    const int colq = (RET ? 5 * 512 : 0) + h * 128, colv = (RET ? 7 * 512 : 3 * 512) + h * 128, colg = (RET ? 8 * 512 : 4 * 512) + h * 128, mixcol = hh * 128;
    const int rowbase = b * LTOT + tb * 256;
#pragma unroll 1
    for (int dir = 1; dir >= 0; --dir) {
        const int colk = RET ? 6 * 512 + h * 128 : (dir ? 2 * 512 : 512) + h * 128;
        const float lg2 = RET ? -expf(sp.rdec[dir * 4 + h]) * LOG2E_ : 0.f, g64 = ex2(64.f * lg2);
        f32x4 ST[8];
        if (tb == 0) {
#pragma unroll
            for (int vi = 0; vi < 8; ++vi) ST[vi] = (f32x4){0.f, 0.f, 0.f, 0.f};
        } else { const size_t slot = (size_t)(bh * 2 + dir) * 65 + tb + ((nch == 8 && dir) ? 1 : 0);
#pragma unroll
            for (int vi = 0; vi < 8; ++vi) { const u32x2 w = *(const u32x2*)(sp.SB + slot * 16384 + (size_t)(vi * 512 + tid) * 4); ST[vi] = (f32x4){bf_lo(w.x), bf_hi(w.x), bf_lo(w.y), bf_hi(w.y)}; } }
        float ata = 0.f, atb = 0.f; unsigned kraw[8], qraw[8], vraw[8];
        SCAN_LOAD_CHUNK(rowbase + (dir ? nch - 1 : 0) * 64, dir);
#pragma unroll 1
        for (int ci = 0; ci < nch; ++ci) {
            const int tc = dir ? nch - 1 - ci : ci;
            int lane_ = lane; asm volatile("" : "+v"(lane_));
            const int fr = lane_ & 15, fq = lane_ >> 4, t = 16 * ti + fr; const float gt1 = ex2((float)(t + 1) * lg2);
            const ScanBufs B0 = scan_bufs(0);
            if (RET) scan_estage_ret<true>(lds, B0, kraw, qraw, vraw, lane, wave, lg2);
            else { float la, lb; scan_estage_hg<true>(lds, B0, kraw, qraw, vraw, lane, wave, la, lb); ata += la; atb += lb; }
#ifdef PROBE_S3_E2
            BAR_LDS();
            if (RET) scan_estage_ret<true>(lds, B0, kraw, qraw, vraw, lane, wave, lg2);
            else { float la, lb; scan_estage_hg<true>(lds, B0, kraw, qraw, vraw, lane, wave, la, lb); }
#endif
            if (ci < nch - 1) { const int tcn = dir ? nch - 2 - ci : ci + 1; SCAN_LOAD_CHUNK(rowbase + tcn * 64, dir); }
            const int tok = tc * 64 + (dir ? 63 - t : t), grow = rowbase + tok;
            u32x2 obv[4]; u32x2 gv[4];
            if (dir == 0) {
#pragma unroll
                for (int j = 0; j < 4; ++j) gv[j] = *(const u32x2*)(P + (size_t)grow * INW + colg + 16 * (4 * vh + j) + 4 * fq);
#pragma unroll
                for (int jp = 0; jp < 2; ++jp) { const u32x4 w4 = *((const u32x4*)OB + ((((tc * 4 + ti) * 2 + vh) * 2 + jp) * 64 + fq * 16 + fr)); obv[2 * jp] = (u32x2){w4.x, w4.y}; obv[2 * jp + 1] = (u32x2){w4.z, w4.w}; } }
            if (!RET) BAR_LDS();
            { f32x4 em = {1.f, 1.f, 1.f, 1.f}; if (!RET) em = *(const LAS f32x4*)(lds + SC_VM + (16 * wave + 4 * fq) * 4);
#pragma unroll
              for (int vi = 0; vi < 8; ++vi) { const f32x4 x = RET ? ST[vi] : ST[vi] * em; u32x2 w; w.x = cvt_pk_bf16(x[0], x[1]); w.y = cvt_pk_bf16(x[2], x[3]); *(LAS u32x2*)(lds + SC_SM + st_off(16 * vi + fr, 32 * wave + 8 * fq, 4)) = w; } }
            if (RET) BAR_LDS();
#pragma unroll
            for (int sii = 0; sii < 2; ++sii) { const int si = 2 * vh + sii; f32x4 sc = {0.f, 0.f, 0.f, 0.f};
                if (si <= ti) {
#pragma unroll
                    for (int ks = 0; ks < 4; ++ks) sc = MFMA16(ldfrag(lds + SC_KI, si, ks, 4, st_lane(fr, fq)), ldfrag(lds + SC_QI, ti, ks, 4, st_lane(fr, fq)), sc);
                    const int s0 = 16 * si + 4 * fq;
#pragma unroll
                    for (int r = 0; r < 4; ++r) { const float dm = RET ? ex2((float)(t - s0 - r) * lg2) : 1.0f; sc[r] = (s0 + r <= t) ? sc[r] * dm : 0.f; } }
                u32x2 w; w.x = cvt_pk_bf16(sc[0], sc[1]); w.y = cvt_pk_bf16(sc[2], sc[3]); *(LAS u32x2*)(lds + SC_PI + st_off(t, 32 * si + 8 * fq, 2)) = w; }
            BAR_LDS();
            f32x4 o[4];
#pragma unroll
            for (int j = 0; j < 4; ++j) o[j] = (f32x4){0.f, 0.f, 0.f, 0.f};
            {
                const int lp = st_lane(fr, fq);
                const LAS unsigned char* pq = lds + SC_QI + (ti * 4) * 1024 + lp;
                const LAS unsigned char* pm = lds + SC_SM + (4 * vh * 4) * 1024 + lp;
                const LAS unsigned char* pp = lds + SC_PI + (ti * 2) * 1024 + lp;
                const LAS unsigned char* pv = lds + SC_VT + (4 * vh * 2) * 1024 + lp;
                const LAS unsigned char* pk = lds + SC_KT + (wave * 2) * 1024 + lp;
                const LAS unsigned char* pw = lds + SC_VT + lp;
                f32x4 av = {g64, g64, g64, g64}, bv = {1.f, 1.f, 1.f, 1.f};
                if (!RET) { av = *(const LAS f32x4*)(lds + SC_VA + (16 * wave + 4 * fq) * 4); bv = *(const LAS f32x4*)(lds + SC_VB + (16 * wave + 4 * fq) * 4); }
#define SC_LD(p_, off_) (*(const LAS bf16x8*)((p_) + (off_)))
#define SC_FENCE() __builtin_amdgcn_sched_barrier(0)
                bf16x8 qa, ma[4], qb, mb[4], qc, mc[4];
                qa = SC_LD(pq, 0); _Pragma("unroll") for (int j = 0; j < 4; ++j) ma[j] = SC_LD(pm, 4096 * j);
                qb = SC_LD(pq, 1024); _Pragma("unroll") for (int j = 0; j < 4; ++j) mb[j] = SC_LD(pm, 4096 * j + 1024);
                SC_FENCE();
                qc = SC_LD(pq, 2048); _Pragma("unroll") for (int j = 0; j < 4; ++j) mc[j] = SC_LD(pm, 4096 * j + 2048);
                _Pragma("unroll") for (int j = 0; j < 4; ++j) o[j] = MFMA16(ma[j], qa, o[j]);
                SC_FENCE();
                qa = SC_LD(pq, 3072); _Pragma("unroll") for (int j = 0; j < 4; ++j) ma[j] = SC_LD(pm, 4096 * j + 3072);
                _Pragma("unroll") for (int j = 0; j < 4; ++j) o[j] = MFMA16(mb[j], qb, o[j]);
                SC_FENCE();
                qb = SC_LD(pp, 0); _Pragma("unroll") for (int j = 0; j < 4; ++j) mb[j] = SC_LD(pv, 2048 * j);
                _Pragma("unroll") for (int j = 0; j < 4; ++j) o[j] = MFMA16(mc[j], qc, o[j]);
                SC_FENCE();
                qc = SC_LD(pp, 1024); _Pragma("unroll") for (int j = 0; j < 4; ++j) mc[j] = SC_LD(pv, 2048 * j + 1024);
                _Pragma("unroll") for (int j = 0; j < 4; ++j) o[j] = MFMA16(ma[j], qa, o[j]);
                SC_FENCE();
                if (RET) { _Pragma("unroll") for (int j = 0; j < 4; ++j) o[j] *= gt1; }
                bf16x8 k0 = SC_LD(pk, 0), k1 = SC_LD(pk, 1024), w0[4], w1[4];
                _Pragma("unroll") for (int q = 0; q < 2; ++q) { w0[q] = SC_LD(pw, 2048 * q); w1[q] = SC_LD(pw, 2048 * q + 1024); }
                _Pragma("unroll") for (int j = 0; j < 4; ++j) o[j] = MFMA16(mb[j], qb, o[j]);
                SC_FENCE();
                _Pragma("unroll") for (int q = 2; q < 4; ++q) { w0[q] = SC_LD(pw, 2048 * q); w1[q] = SC_LD(pw, 2048 * q + 1024); }
                _Pragma("unroll") for (int j = 0; j < 4; ++j) o[j] = MFMA16(mc[j], qc, o[j]);
                SC_FENCE();
                bf16x8 x0[4], x1[4];
                _Pragma("unroll") for (int q = 0; q < 4; ++q) { x0[q] = SC_LD(pw, 2048 * (4 + q)); x1[q] = SC_LD(pw, 2048 * (4 + q) + 1024); }
                _Pragma("unroll") for (int q = 0; q < 4; ++q) { f32x4 u = {0.f, 0.f, 0.f, 0.f}; u = MFMA16(k0, w0[q], u); u = MFMA16(k1, w1[q], u); ST[q] = RET ? (av * ST[q] + u) : (av * ST[q] + bv * u); }
                SC_FENCE();
                _Pragma("unroll") for (int q = 0; q < 4; ++q) { f32x4 u = {0.f, 0.f, 0.f, 0.f}; u = MFMA16(k0, x0[q], u); u = MFMA16(k1, x1[q], u); ST[4 + q] = RET ? (av * ST[4 + q] + u) : (av * ST[4 + q] + bv * u); }
#undef SC_LD
#undef SC_FENCE
            }
            if (dir == 1) {
#pragma unroll
                for (int jp = 0; jp < 2; ++jp) { u32x4 w4; w4.x = cvt_pk_bf16(o[2 * jp][0], o[2 * jp][1]); w4.y = cvt_pk_bf16(o[2 * jp][2], o[2 * jp][3]); w4.z = cvt_pk_bf16(o[2 * jp + 1][0], o[2 * jp + 1][1]); w4.w = cvt_pk_bf16(o[2 * jp + 1][2], o[2 * jp + 1][3]); *((u32x4*)OB + ((((tc * 4 + (3 - ti)) * 2 + vh) * 2 + jp) * 64 + fq * 16 + (15 - fr))) = w4; }
                BAR_LDS();
            } else {
                float ss = 0.f;
#pragma unroll
                for (int j = 0; j < 4; ++j) { o[j] += (f32x4){bf_lo(obv[j].x), bf_hi(obv[j].x), bf_lo(obv[j].y), bf_hi(obv[j].y)}; ss += (o[j][0] * o[j][0] + o[j][1] * o[j][1]) + (o[j][2] * o[j][2] + o[j][3] * o[j][3]); }
                ss += shx(ss, 16, lane_); ss += shx(ss, 32, lane_);
                if (fq == 0) *(LAS float*)(lds + SC_RED + ((ci & 1) * 128 + vh * 64 + t) * 4) = ss;
                BAR_LDS();
                const float tot = ss + *(const LAS float*)(lds + SC_RED + ((ci & 1) * 128 + (vh ^ 1) * 64 + t) * 4);
                const float rinv = __builtin_amdgcn_rsqf(tot * (1.0f / 128.0f) + EPS);
#pragma unroll
                for (int j = 0; j < 4; ++j) { const f32x4 onv = RET ? (f32x4){1.f, 1.f, 1.f, 1.f} : *(const f32x4*)(sp.onorm + 16 * (4 * vh + j) + 4 * fq);
                    const f32x4 y = o[j] * rinv * onv * (f32x4){bf_lo(gv[j].x), bf_hi(gv[j].x), bf_lo(gv[j].y), bf_hi(gv[j].y)};
                    u32x2 w; w.x = cvt_pk_bf16(y[0], y[1]); w.y = cvt_pk_bf16(y[2], y[3]); *(u32x2*)(sp.MIX + (size_t)grow * D + mixcol + 16 * (4 * vh + j) + 4 * fq) = w; }
#ifdef PROBE_BAR
                BAR_LDS();
#endif
            }
        }
        if (store_state) { const int slot = (bh * 2 + dir) * 65 + tb; SCAN_STORE_STATE(slot);
            if (wave == 0) *(f32x2*)(sp.AB + (size_t)slot * 128 + 2 * lane) = RET ? (f32x2){ex2(256.f * lg2), ex2(256.f * lg2)} : (f32x2){ex2(ata), ex2(atb)}; }
        BAR_ALL();
    }
}

__device__ __forceinline__ ScanPtrs scan_ptrs(const Ctx& a, int l) {
    unsigned char* ws = a.ws(); ScanPtrs sp; sp.P = (const bf16_t*)(ws + WS_P); sp.SB = (const bf16_t*)(ws + WS_SB); sp.UB = (bf16_t*)(ws + WS_UB); sp.AB = (float*)(ws + WS_AB); sp.MIX = (bf16_t*)(ws + WS_MIX);
    sp.OB = (float*)(ws + WS_OB) + (size_t)blockIdx.x * 32768; sp.rdec = a.in(I_RDEC) + l * 8; sp.onorm = a.in(I_ONORM) + l * 128; return sp;
}

constexpr int SW_KT = 0, SW_VT = 65536, SW_PART = 131072;
struct S1Id { int seq, tb; };
__device__ __forceinline__ void scan_write_T8(LAS unsigned char* img, const unsigned (&d)[8], int cp, int tg) {
    u32x4 wa, wb;
    wa.x = (d[0] & 0xffffu) | (d[1] << 16); wa.y = (d[2] & 0xffffu) | (d[3] << 16); wa.z = (d[4] & 0xffffu) | (d[5] << 16); wa.w = (d[6] & 0xffffu) | (d[7] << 16);
    wb.x = (d[0] >> 16) | (d[1] & 0xffff0000u); wb.y = (d[2] >> 16) | (d[3] & 0xffff0000u); wb.z = (d[4] >> 16) | (d[5] & 0xffff0000u); wb.w = (d[6] >> 16) | (d[7] & 0xffff0000u);
    *(LAS u32x4*)(img + st_off(2 * cp, tg * 16, 8)) = wa; *(LAS u32x4*)(img + st_off(2 * cp + 1, tg * 16, 8)) = wb;
}
#define S1W_LOAD(id_) do { const int seq_ = (id_).seq, hh_ = (seq_ >> 1) & 7, dir_ = seq_ & 1, h_ = hh_ & 3; const bool ret_ = hh_ >= 4; \
        const int colk_ = ret_ ? 6 * 512 + h_ * 128 : (dir_ ? 2 * 512 : 512) + h_ * 128, colv_ = (ret_ ? 7 * 512 : 3 * 512) + h_ * 128; \
        const int row0_ = (seq_ >> 4) * LTOT + (id_).tb * 256; int ln_ = lane; asm volatile("" : "+v"(ln_)); \
        _Pragma("unroll") for (int i = 0; i < 32; ++i) { const int p_ = 32 * wave + i; const size_t ro_ = (size_t)(row0_ + (dir_ ? 255 - p_ : p_)) * INW + 2 * ln_; \
            kr[i] = *(const unsigned*)(sp.P + ro_ + colk_); vr[i] = *(const unsigned*)(sp.P + ro_ + colv_); } } while (0)
__device__ __forceinline__ void scan1w_item(const ScanPtrs& sp, LAS unsigned char* lds, int lane, int wave, const S1Id id, unsigned (&kr)[32], unsigned (&vr)[32], bool have_next, const S1Id nxt) {
    asm volatile("" : "+v"(lane), "+s"(wave)); const int tid = wave * 64 + lane;
    bf16_t* UB = sp.UB; const int fr = lane & 15, fq = lane >> 4;
    const int seq = id.seq, tb = id.tb, hh = (seq >> 1) & 7, dir = seq & 1, h = hh & 3; const bool RET = hh >= 4;
    const float lg2 = RET ? -expf(sp.rdec[dir * 4 + h]) * LOG2E_ : 0.f;
#ifndef SCAN_LOG2
    constexpr float LS = 1.4426950408889634f;
#else
    constexpr float LS = 1.0f;
#endif
    if (!RET) { f32x2 t2 = {0.f, 0.f};
#pragma unroll
        for (int i = 0; i < 32; ++i) t2 += (f32x2){bf_lo(kr[i]), bf_hi(kr[i])};
        *(LAS f32x2*)(lds + SW_PART + (wave * 64 + lane) * 8) = t2; }
    BAR_LDS();
    f32x2 pw = {0.f, 0.f}, T2 = {0.f, 0.f};
    if (!RET) {
#pragma unroll
        for (int w8 = 0; w8 < 8; ++w8) { const f32x2 pp = *(const LAS f32x2*)(lds + SW_PART + (w8 * 64 + lane) * 8); if (w8 < wave) pw += pp; T2 += pp; } }
    f32x2 r2 = pw;
#pragma unroll
    for (int g = 0; g < 4; ++g) { unsigned kd[8], vv[8];
#pragma unroll
        for (int tt = 0; tt < 8; ++tt) { const int i = 8 * g + tt; vv[tt] = vr[i];
            if (RET) { const float wk = ex2((float)(255 - (32 * wave + i)) * lg2); kd[tt] = cvt_pk_bf16(bf_lo(kr[i]) * wk, bf_hi(kr[i]) * wk); }
            else { const f32x2 lf = {bf_lo(kr[i]), bf_hi(kr[i])}; r2 += lf;
                f32x2 d2 = (T2 - r2) * LS; d2 = __builtin_elementwise_max(d2, (f32x2){-120.f, -120.f});
                const f32x2 lf2 = lf * LS; const f32x2 k2 = (f32x2){1.0f, 1.0f} - (f32x2){__builtin_amdgcn_exp2f(lf2.x), __builtin_amdgcn_exp2f(lf2.y)};
                const f32x2 kt2 = k2 * (f32x2){__builtin_amdgcn_exp2f(d2.x), __builtin_amdgcn_exp2f(d2.y)}; kd[tt] = cvt_pk_bf16(kt2.x, kt2.y); } }
        scan_write_T8(lds + SW_KT, kd, lane, 4 * wave + g); scan_write_T8(lds + SW_VT, vv, lane, 4 * wave + g); }
    if (have_next) S1W_LOAD(nxt);
    BAR_LDS();
    f32x4 ST[8];
#pragma unroll
    for (int vi = 0; vi < 8; ++vi) ST[vi] = (f32x4){0.f, 0.f, 0.f, 0.f};
    { const int lp = st_lane(fr, fq);
#pragma unroll
      for (int ks = 0; ks < 8; ++ks) { const bf16x8 af = ldfrag(lds + SW_KT, wave, ks, 8, lp);
#pragma unroll
          for (int vi = 0; vi < 8; ++vi) ST[vi] = MFMA16(af, ldfrag(lds + SW_VT, vi, ks, 8, lp), ST[vi]);
          if (ks & 1) __builtin_amdgcn_sched_barrier(0); } }
    const int slot = seq * 65 + tb;
    SCAN_STORE_STATE(slot);
    if (wave == 0) *(f32x2*)(sp.AB + (size_t)slot * 128 + 2 * lane) = RET ? (f32x2){ex2(256.f * lg2), ex2(256.f * lg2)} : (f32x2){ex2(T2.x), ex2(T2.y)};
}
__device__ __forceinline__ bool s1_enum(bool modeA, bool last, int c, int G, int& k, S1Id& id) {
    constexpr int HS = 7;
    for (;; ++k) {
        if (modeA) { const int it = c + k * G; if (it >= 2048) return false; const int seq = it >> 6, j = it & 63; if (!last && j == 0) continue;
            id.seq = seq; id.tb = (seq & 1) ? (j == 0 ? 0 : 65 - j) : j; ++k; return true; }
        const int li = k < HS ? k * (G - 16) + (c - 16) : HS * (G - 16) + (k - HS) * G + c;
        if (li >= 2016) return false;
        const int seq = li / 63, j = 1 + li % 63; id.seq = seq; id.tb = (seq & 1) ? 65 - j : j; ++k; return true; }
}

__device__ __forceinline__ void scan1_phase(const Ctx& a, int l) {
    PHASE_IDS(); LAS unsigned char* lds = launder_lds(a.lds); const ScanPtrs sp = scan_ptrs(a, l);
#ifdef PROBE_NOMERGE
    const bool last = true; const int c = blockIdx.x, G = gridDim.x;
#else
    const bool last = (l == DEPTH - 1); const int c = blockIdx.x, G = gridDim.x;
#endif
#ifdef SCAN_PRIO1
    if (wave >= 4) __builtin_amdgcn_s_setprio(1);
#endif
#ifdef S1_WIDE
    { const bool modeA = last || G < 32;
      if (!last) { if (modeA) { for (int bh = c; bh < 16; bh += G) { if ((bh & 7) >= 4) scan3_item<true>(sp, lds, tid, lane, wave, bh, 0, true); else scan3_item<false>(sp, lds, tid, lane, wave, bh, 0, true); } }
                   else if (c < 16) { if ((c & 7) >= 4) scan3_item<true>(sp, lds, tid, lane, wave, c, 0, true); else scan3_item<false>(sp, lds, tid, lane, wave, c, 0, true); } }
      int k = (!modeA && c < 16) ? 7 : 0; S1Id id, nx; unsigned kr[32], vr[32];
      bool have = s1_enum(modeA, last, c, G, k, id);
      if (have) S1W_LOAD(id);
      while (have) { nx = id; const bool have2 = s1_enum(modeA, last, c, G, k, nx);
          scan1w_item(sp, lds, lane, wave, id, kr, vr, have2, nx);
          have = have2; id = nx; }
      BAR_LDS();
      return; }
#endif
    if (last || G < 32) {
        if (!last) for (int bh = c; bh < 16; bh += G) { if ((bh & 7) >= 4) scan3_item<true>(sp, lds, tid, lane, wave, bh, 0, true); else scan3_item<false>(sp, lds, tid, lane, wave, bh, 0, true); }
        for (int it = c; it < 2048; it += G) { const int seq = it >> 6, j = it & 63; if (!last && j == 0) continue; const int dir = seq & 1, tb = dir ? (j == 0 ? 0 : 65 - j) : j;
            if (((seq >> 1) & 7) >= 4) scan1_item<true>(sp, lds, tid, lane, wave, seq, tb); else scan1_item<false>(sp, lds, tid, lane, wave, seq, tb); }
        return;
    }
    if (c < 16) { if ((c & 7) >= 4) scan3_item<true>(sp, lds, tid, lane, wave, c, 0, true); else scan3_item<false>(sp, lds, tid, lane, wave, c, 0, true); }
    constexpr int HS = 7;
    for (int k = (c < 16 ? HS : 0);; ++k) {
        const int li = k < HS ? k * (G - 16) + (c - 16) : HS * (G - 16) + (k - HS) * G + c;
        if (li >= 2016) break;
        const int seq = li / 63, j = 1 + li % 63, dir = seq & 1, tb = dir ? 65 - j : j;
        if (((seq >> 1) & 7) >= 4) scan1_item<true>(sp, lds, tid, lane, wave, seq, tb); else scan1_item<false>(sp, lds, tid, lane, wave, seq, tb);
    }
}

__device__ __forceinline__ void scan2_phase(const Ctx& a) {
#ifdef SCAN_PRIO1
    __builtin_amdgcn_s_setprio(0);
#endif
    PHASE_IDS(); unsigned char* ws = a.ws(); const bf16_t* UB = (const bf16_t*)(ws + WS_UB); bf16_t* SB = (bf16_t*)(ws + WS_SB); const float* AB = (const float*)(ws + WS_AB);
    const int c0 = 16 * (tid >> 6) + 4 * ((tid >> 4) & 3);
    for (int p = blockIdx.x; p < 256; p += gridDim.x) { const int seq = p >> 3, vi = p & 7, dir = seq & 1; const size_t eo = (size_t)(vi * 512 + tid) * 4;
        f32x4 s = {0.f, 0.f, 0.f, 0.f};
#define S2_SLOT(j_) ((size_t)seq * 65 + (dir ? ((j_) == 0 ? 0 : 65 - (j_)) : (j_)))
#define S2_LOAD(u_, av_, j0_) do { _Pragma("unroll") for (int q = 0; q < 8; ++q) { const size_t slot = S2_SLOT((j0_) + q); u_[q] = *(const u32x2*)(UB + slot * 16384 + eo); av_[q] = *(const f32x4*)(AB + slot * 128 + c0); } } while (0)
#define S2_STEP(u_, av_, j0_) do { _Pragma("unroll") for (int q = 0; q < 8; ++q) { const size_t slot = S2_SLOT((j0_) + q); \
            if (q & 1) { u32x2 w; w.x = cvt_pk_bf16(s[0], s[1]); w.y = cvt_pk_bf16(s[2], s[3]); *(u32x2*)(SB + slot * 16384 + eo) = w; }     \
            s = av_[q] * s + (f32x4){bf_lo(u_[q].x), bf_hi(u_[q].x), bf_lo(u_[q].y), bf_hi(u_[q].y)}; } } while (0)
        u32x2 ua[8], ub[8]; f32x4 aa[8], ab[8];
        S2_LOAD(ua, aa, 0);
#pragma unroll 1
        for (int j0 = 0; j0 < 64; j0 += 16) {
            S2_LOAD(ub, ab, j0 + 8);
            S2_STEP(ua, aa, j0);
            if (j0 + 16 < 64) S2_LOAD(ua, aa, j0 + 16);
            S2_STEP(ub, ab, j0 + 8); }
#undef S2_SLOT
#undef S2_LOAD
#undef S2_STEP
    }
}

__device__ __forceinline__ void scan3_phase(const Ctx& a, int l) {
    PHASE_IDS(); LAS unsigned char* lds = launder_lds(a.lds); const ScanPtrs sp = scan_ptrs(a, l);
#ifdef SCAN_PRIO
    if (wave >= 4) __builtin_amdgcn_s_setprio(1);
#endif
#ifdef PROBE_NOMERGE
    if (l != DEPTH - 1) for (int bh = blockIdx.x; bh < 16; bh += gridDim.x) { if ((bh & 7) >= 4) scan3_item<true>(sp, lds, tid, lane, wave, bh, 0, false); else scan3_item<false>(sp, lds, tid, lane, wave, bh, 0, false); }
#endif
    for (int it = blockIdx.x; it < 512; it += gridDim.x) { const int half = it >> 8, cc = it & 255; const int bh = (cc & 15) ^ (half ? 4 : 0), tb = 1 + 2 * ((half << 4) + (cc >> 4));
        if ((bh & 7) >= 4) scan3_item<true>(sp, lds, tid, lane, wave, bh, tb, false, 8); else scan3_item<false>(sp, lds, tid, lane, wave, bh, tb, false, 8); }
#ifdef SCAN_PRIO
    __builtin_amdgcn_s_setprio(0);
#endif
}

struct OutOrder {
    static constexpr bool PADTILES = false;
    __device__ __forceinline__ bool half_rows(const pg8::Unit&) const { return false; }
    int nrt, skipctx, G, c;
    __device__ __forceinline__ bool next(int i, pg8::Unit& u) const {
        const int L = i * G + c; if (L >= nrt * 4) return false;
        const int r = L >> 2; u.pn = L & 3; u.pm = skipctx ? r + 1 + (r >= 64 ? 1 : 0) : r; return true;
    }
    __device__ __forceinline__ void a_ready(const pg8::Unit&) const {}
    __device__ __forceinline__ void done(const pg8::Unit&) const {}
};

#ifndef PH
#define PH 0xffff
#endif
#ifndef DBL
#define DBL 0
#endif
__global__ void __launch_bounds__(512, 2) mega_fwd(Args a) {
    extern __shared__ __attribute__((aligned(16))) unsigned char lds_raw[];
    LAS unsigned char* lds = (LAS unsigned char*)lds_raw;
    const int tid = threadIdx.x;
    const int G = gridDim.x; const int bx = blockIdx.x; const int vcu = (G % 8 == 0) ? (bx % 8) * (G / 8) + bx / 8 : bx;
    volatile LAS unsigned* MISC = (volatile LAS unsigned*)(lds + MISC_OFF);
    if (tid < 16) MISC[tid] = 0u;
    if (tid == 0) { LAS unsigned long long* pt = (LAS unsigned long long*)(lds + PTR_OFF);
#pragma unroll
        for (int i = 0; i < 18; ++i) pt[i] = (unsigned long long)a.in[i];
        pt[18] = (unsigned long long)a.out; pt[19] = (unsigned long long)a.ws; }
    __syncthreads();
    const Ctx cx{lds, __builtin_amdgcn_readfirstlane(tid >> 6)};
    XcdBarrier bar = xcd_barrier_post((unsigned*)(cx.ws() + WS_CTL) + 1024, MISC + 8);
#define GRID_BAR() do { XcdBarrier b2_ = bar; asm volatile("" : "+s"(b2_.x)); xcd_barrier(b2_); } while (0)

#if PH & 1
    p0_prologue(cx);
#endif
    GRID_BAR();
#if DBL & 1
    p0_prologue(cx);
    GRID_BAR();
#endif
#if PH & 1
    p0_finalize(cx);
#endif
    GRID_BAR();

#pragma unroll 1
    for (int l = 0; l < DEPTH; ++l) {
        const bool last = (l == DEPTH - 1); unsigned char* ws = cx.ws();
#ifdef PROBE_NOBG
        const bool bgc = false;
#else
        const bool bgc = (G == 256);
#endif

#if DBL & 64
        norm1_phase<2>(cx, l);
        GRID_BAR();
#endif
#if PH & 2
        norm1_phase<0>(cx, l);
#endif
        GRID_BAR();
#ifdef G1_SPLIT
        const int g1k = (bgc && bx >= 36) ? ((bx >> 3) % 5) : 0;
        if (g1k > 0) cvt_tail(cx, CVT_N0 + l * CVT_CYC, bx - 36, 4, 0, g1k);
#endif
#if PH & 4
        {
#ifdef G1_F8
            pg8::Gemm g{(const bf16_t*)(ws + WS_H), (const bf16_t*)(ws + WS_WIN + (size_t)l * INW * D), MROWS, INW, D, cx.w0};
            pg8::StaticOrder S; S.init(MROWS, INW, G, bx);
            pg8::EpiIn8 E{(bf16_t*)(ws + WS_P), (const float*)(ws + WS_LBS) + l * 512, (const float*)(ws + WS_ROPE)};
            pg8::gemm_phase_f8<pg8::EpiIn8, pg8::StaticOrder, false>(launder_lds(lds), g, S, E, nullptr);
#else
            pg8::Gemm g{(const bf16_t*)(ws + WS_H), (const bf16_t*)(ws + WS_WIN) + (size_t)l * INW * D, MROWS, INW, D, cx.w0};
            pg8::StaticOrder S; S.init(MROWS, INW, G, bx);
            pg8::EpiIn E{(bf16_t*)(ws + WS_P), (const float*)(ws + WS_LBS) + l * 512, (const float*)(ws + WS_ROPE)};
#ifdef STAGGER_G1
            { const unsigned long long t0_ = __builtin_amdgcn_s_memrealtime(); const unsigned long long d_ = (unsigned long long)((bx >> 3) & 3) * STAGGER_G1; while (__builtin_amdgcn_s_memrealtime() - t0_ < d_) __builtin_amdgcn_s_sleep(8); }
#endif
            pg8::gemm_phase<pg8::EpiIn, pg8::StaticOrder, true, true>(launder_lds(lds), g, S, E);
#endif
        }
#endif
#if DBL & 1024
        GRID_BAR();
        {
            pg8::Gemm g{(const bf16_t*)(ws + WS_H), (const bf16_t*)(ws + WS_WIN) + (size_t)l * INW * D, MROWS, INW, D, cx.w0};
            pg8::StaticOrder S; S.init(MROWS, INW, G, bx);
            pg8::EpiNull E{(float*)(ws + WS_OB)};
            pg8::gemm_phase<pg8::EpiNull, pg8::StaticOrder, true, true>(launder_lds(lds), g, S, E);
        }
#endif
#if DBL & 16384
        GRID_BAR();
        {
            pg8::Gemm g{(const bf16_t*)(ws + WS_H), (const bf16_t*)(ws + WS_WIN) + (size_t)l * INW * D, MROWS, INW, D, cx.w0};
            pg8::StaticOrder S; S.init(MROWS, INW, G, bx);
            pg8::EpiInT<true> E{(bf16_t*)(ws + WS_YS), (const float*)(ws + WS_LBS) + l * 512, (const float*)(ws + WS_ROPE)};
            pg8::gemm_phase<pg8::EpiInT<true>, pg8::StaticOrder, true, true>(launder_lds(lds), g, S, E);
        }
#endif
#if DBL & 128
        GRID_BAR();
        {
            pg8::Gemm g{(const bf16_t*)(ws + WS_H), (const bf16_t*)(ws + WS_WIN) + (size_t)l * INW * D, MROWS, INW, D, cx.w0};
            pg8::StaticOrder S; S.init(MROWS, INW, G, bx);
            pg8::EpiIn E{(bf16_t*)(ws + WS_P), (const float*)(ws + WS_LBS) + l * 512, (const float*)(ws + WS_ROPE)};
            pg8::gemm_phase<pg8::EpiIn, pg8::StaticOrder, true, true>(launder_lds(lds), g, S, E);
        }
#endif
#ifdef G1_SPLIT
        if (bgc && bx >= 36) cvt_tail(cx, CVT_N0 + l * CVT_CYC, bx - 36, 4, g1k, 4);
#else
        if (bgc && bx >= 36) cvt_tail<4>(cx, CVT_N0 + l * CVT_CYC, bx - 36);
#endif
#ifdef DBLCVT
        if (bgc && bx >= 36) cvt_tail<4>(cx, CVT_N0 + l * CVT_CYC, bx - 36);
#endif
        GRID_BAR();
#if DBL & 8192
#pragma unroll 1
        for (int xb = 0; xb < 10; ++xb) GRID_BAR();
#endif
#if PH & 8
        scan1_phase(cx, l);
#endif
        GRID_BAR();
#if PH & 16
        scan2_phase(cx);
#endif
        GRID_BAR();
#if PH & 32
        scan3_phase(cx, l);
#endif
        GRID_BAR();
#if DBL & 2
        scan1_phase(cx, l);
        GRID_BAR();
        scan2_phase(cx);
        GRID_BAR();
        scan3_phase(cx, l);
        GRID_BAR();
#endif
#if DBL & 8
        scan1_phase(cx, l);
        GRID_BAR();
#endif
#if DBL & 16
        scan2_phase(cx);
        GRID_BAR();
#endif
#if DBL & 32
        scan3_phase(cx, l);
        GRID_BAR();
#endif
#if PH & 64
        {
#ifdef G2_F8
            pg8::Gemm g{(const bf16_t*)(ws + WS_MIX), (const bf16_t*)(ws + WS_WOUT + (size_t)l * D * D), MROWS, D, D, cx.w0};
            OutOrder S{last ? 128 : 130, last ? 1 : 0, G, vcu};
            pg8::EpiOut8 E{(bf16_t*)(ws + WS_X), l == 0 ? cx.in(I_X) : nullptr, l == 0 ? cx.in(I_CTX) : nullptr, (const float*)(ws + WS_MODS) + (size_t)(l * 3) * 6144 + 2 * D};
            pg8::gemm_phase_f8<pg8::EpiOut8, OutOrder, false>(launder_lds(lds), g, S, E, nullptr);
#else
            pg8::Gemm g{(const bf16_t*)(ws + WS_MIX), (const bf16_t*)(ws + WS_WOUT) + (size_t)l * D * D, MROWS, D, D, cx.w0};
            OutOrder S{last ? 128 : 130, last ? 1 : 0, G, vcu};
            pg8::EpiOut E{(bf16_t*)(ws + WS_X), l == 0 ? cx.in(I_X) : nullptr, l == 0 ? cx.in(I_CTX) : nullptr, (const float*)(ws + WS_MODS) + (size_t)(l * 3) * 6144 + 2 * D};
            pg8::gemm_phase<pg8::EpiOut, OutOrder, true, true>(launder_lds(lds), g, S, E);
#endif
        }
#endif
        if (bgc && !last && vcu >= 8) cvt_tail<4>(cx, CVT_N0 + l * CVT_CYC + CVT_G1, vcu - 8);
#ifdef DBLCVT
        if (bgc && !last && vcu >= 8) cvt_tail<4>(cx, CVT_N0 + l * CVT_CYC + CVT_G1, vcu - 8);
#endif
        GRID_BAR();
#if PH & 128
        norm2_phase(cx, l);
#endif
        GRID_BAR();
#if DBL & 4
        norm2_phase(cx, l);
        GRID_BAR();
#endif
#if PH & 256
        topk_phase(cx, l);
#endif
        if (bgc && bx >= 64) cvt_tail<3>(cx, CVT_N0 + l * CVT_CYC + CVT_G1 + (last ? 0 : CVT_G2), bx - 64);
#ifdef DBLCVT
        if (bgc && bx >= 64) cvt_tail<3>(cx, CVT_N0 + l * CVT_CYC + CVT_G1 + (last ? 0 : CVT_G2), bx - 64);
#endif
        GRID_BAR();
#if DBL & 2048
        topk_phase(cx, l);
        GRID_BAR();
#endif
#if PH & 1024
        {
            pg8::Gemm g{(const bf16_t*)(ws + WS_H), (const bf16_t*)(ws + WS_WGU + (size_t)l * 65536 * D), MOE_ROWS, 65536, D, cx.w0};
            pg8::MoeOrder S{last ? 16 : 17, 16, G, vcu};
            pg8::EpiGU E{(unsigned char*)(ws + WS_HID)};
            pg8::gemm_phase_f8<pg8::EpiGU, pg8::MoeOrder, true>(launder_lds(lds), g, S, E, (const int*)(ws + WS_ROWMAP));
        }
#endif
#if DBL & 4096
        GRID_BAR();
        {
            pg8::Gemm g{(const bf16_t*)(ws + WS_H), (const bf16_t*)(ws + WS_WGU + (size_t)l * 65536 * D), MOE_ROWS, 65536, D, cx.w0};
            pg8::MoeOrder S{last ? 16 : 17, 16, G, vcu};
            pg8::EpiNull E{(float*)(ws + WS_OB)};
            pg8::gemm_phase_f8<pg8::EpiNull, pg8::MoeOrder, true>(launder_lds(lds), g, S, E, (const int*)(ws + WS_ROWMAP));
        }
#endif
#if DBL & 256
        GRID_BAR();
        {
            pg8::Gemm g{(const bf16_t*)(ws + WS_H), (const bf16_t*)(ws + WS_WGU + (size_t)l * 65536 * D), MOE_ROWS, 65536, D, cx.w0};
            pg8::MoeOrder S{last ? 16 : 17, 16, G, vcu};
            pg8::EpiGU E{(unsigned char*)(ws + WS_HID)};
            pg8::gemm_phase_f8<pg8::EpiGU, pg8::MoeOrder, true>(launder_lds(lds), g, S, E, (const int*)(ws + WS_ROWMAP));
        }
#endif
        GRID_BAR();
#if PH & 2048
        {
            pg8::Gemm g{(const bf16_t*)(ws + WS_HID), (const bf16_t*)(ws + WS_WD + (size_t)l * 16384 * FF), MOE_ROWS, 16384, FF, cx.w0};
            pg8::MoeOrder S{last ? 16 : 17, 4, G, vcu};
            pg8::EpiDown E{(unsigned char*)(ws + WS_YS)};
            pg8::gemm_phase_f8<pg8::EpiDown, pg8::MoeOrder, false>(launder_lds(lds), g, S, E, nullptr);
        }
#endif
#if DBL & 512
        GRID_BAR();
        {
            pg8::Gemm g{(const bf16_t*)(ws + WS_HID), (const bf16_t*)(ws + WS_WD + (size_t)l * 16384 * FF), MOE_ROWS, 16384, FF, cx.w0};
            pg8::MoeOrder S{last ? 16 : 17, 4, G, vcu};
            pg8::EpiDown E{(unsigned char*)(ws + WS_YS)};
            pg8::gemm_phase_f8<pg8::EpiDown, pg8::MoeOrder, false>(launder_lds(lds), g, S, E, nullptr);
        }
#endif
        if (bgc && !last && vcu >= 64) cvt_tail<4>(cx, CVT_N0 + l * CVT_CYC + CVT_G1 + CVT_G2 + CVT_T, vcu - 64);
#ifdef DBLCVT
        if (bgc && !last && vcu >= 64) cvt_tail<4>(cx, CVT_N0 + l * CVT_CYC + CVT_G1 + CVT_G2 + CVT_T, vcu - 64);
#endif
        GRID_BAR();
    }
#if PH & 4096
    norm1_phase<1>(cx, DEPTH);
#endif
}

extern "C" void kernel_launch(void* const* d_in, const int* in_sizes, int n_in, void* d_out, int out_size, void* d_ws, size_t ws_size, hipStream_t stream) {
    static int grid = 0;
    if (grid == 0) {
        if (n_in != 18 || out_size != NB * SEQ * D || ws_size < WS_END) { fprintf(stderr, "kernel_launch: unexpected problem shape (n_in %d, out %d, ws %zu)\n", n_in, out_size, ws_size); grid = -1; return; }
        int dev = 0, cus = 0, per_cu = 0;
        if (hipGetDevice(&dev) != hipSuccess || hipDeviceGetAttribute(&cus, hipDeviceAttributeMultiprocessorCount, dev) != hipSuccess) { grid = -1; return; }
        if (hipFuncSetAttribute((const void*)mega_fwd, hipFuncAttributeMaxDynamicSharedMemorySize, LDS_BYTES) != hipSuccess) { fprintf(stderr, "kernel_launch: hipFuncSetAttribute failed\n"); grid = -1; return; }
        if (hipOccupancyMaxActiveBlocksPerMultiprocessor(&per_cu, (const void*)mega_fwd, 512, LDS_BYTES) != hipSuccess || per_cu < 1) { fprintf(stderr, "kernel_launch: occupancy query reports %d workgroups per CU\n", per_cu); per_cu = 1; }
        (void)hipGetLastError();
        grid = cus;
    }
    if (grid < 0) return;
    (void)in_sizes;
    if (hipMemsetAsync((char*)d_ws + WS_CTL, 0, CTL_ZERO_BYTES, stream) != hipSuccess) return;
    Args a{};
    for (int i = 0; i < 18; ++i) a.in[i] = (const float*)d_in[i];
    a.out = (float*)d_out; a.ws = (unsigned char*)d_ws;
    hipLaunchKernelGGL(mega_fwd, dim3(grid), dim3(512), LDS_BYTES, stream, a);
}
```

```cpp
#define SCAN_PRIO 1
#define CVT_NT 1
#define NT_MORE 1
#include <hip/hip_runtime.h>
#include <cstdio>
#include <cstdint>

constexpr int D = 1024, NB = 2, SEQ = 16384, CTX = 256, LTOT = SEQ + CTX, MROWS = NB * LTOT;
constexpr int DEPTH = 4, INW = 4608, NE = 16, FF = 2048;
constexpr int CAP_LAT = 2048, CAP_CTX = 32;
constexpr int MOE_ROWS_E = 4352, MOE_ROWS = NE * MOE_ROWS_E;
constexpr int NSLOT = NB * 8 * 2 * 65;
constexpr float EPS = 1e-6f;

constexpr size_t MiB = 1u << 20;
constexpr size_t WS_CTL = 0, CTL_ZERO_BYTES = 64 * 1024;
constexpr size_t WS_MODP = 1 * MiB;
constexpr size_t WS_MODS = 4 * MiB;
constexpr size_t WS_LBS = 5 * MiB;
constexpr size_t WS_ROPE = 5 * MiB + 65536;
constexpr size_t WS_WIN = 8 * MiB;
constexpr size_t WS_WOUT = 44 * MiB;
constexpr size_t WS_WGU = 52 * MiB;
constexpr size_t WS_WD = 564 * MiB;
constexpr size_t WS_X = 820 * MiB;
constexpr size_t WS_H = 950 * MiB;
constexpr size_t WS_MIX = 1015 * MiB;
constexpr size_t WS_P = 1080 * MiB;
constexpr size_t WS_XS = 1080 * MiB;
constexpr size_t WS_HID = 1216 * MiB;
constexpr size_t WS_YS = 1488 * MiB;
constexpr size_t WS_UB = 1624 * MiB;
constexpr size_t WS_SB = 1689 * MiB;
constexpr size_t WS_AB = 1754 * MiB;
constexpr size_t WS_OB = 1756 * MiB;
constexpr size_t WS_AFF = 1788 * MiB;
constexpr size_t WS_ROWMAP = 1791 * MiB;
constexpr size_t WS_INV = 1792 * MiB;
constexpr size_t WS_END = 1800 * MiB;

constexpr int LDS_BYTES = 155648;
constexpr int MISC_OFF = LDS_BYTES - 64;
constexpr int PTR_OFF = LDS_BYTES - 256;

#define GAS __attribute__((address_space(1)))
#define LAS __attribute__((address_space(3)))
typedef float f32x2 __attribute__((ext_vector_type(2)));
typedef unsigned u32x2 __attribute__((ext_vector_type(2)));

__device__ __forceinline__ int lane_id() { int l; asm volatile("v_mbcnt_lo_u32_b32 %0, -1, 0\n\tv_mbcnt_hi_u32_b32 %0, -1, %0" : "=v"(l)); return l; }
__device__ __forceinline__ int opaque_tid(int w0) { int w = w0; asm volatile("" : "+s"(w)); int t = w * 64 + lane_id(); asm volatile("" : "+v"(t)); return t; }
__device__ __forceinline__ LAS unsigned char* launder_lds(LAS unsigned char* p) { unsigned v = (unsigned)(size_t)p; asm volatile("" : "+s"(v)); return (LAS unsigned char*)(size_t)v; }
__device__ __forceinline__ const float* ldptr(LAS unsigned char* lds0, int i) {
    LAS unsigned char* lds = launder_lds(lds0);
    const u32x2 v = *(volatile LAS u32x2*)(lds + PTR_OFF + 8 * i);
    const unsigned lo = __builtin_amdgcn_readfirstlane(v.x), hi = __builtin_amdgcn_readfirstlane(v.y);
    const GAS float* g = (const GAS float*)(((unsigned long long)hi << 32) | lo);
    return (const float*)g;
}
namespace pg8 {
#define PG8_LAS __attribute__((address_space(3)))
typedef unsigned short bf16_t;
typedef short bf16x8 __attribute__((ext_vector_type(8)));
typedef float f32x4 __attribute__((ext_vector_type(4)));
typedef unsigned u32x4 __attribute__((ext_vector_type(4)));
constexpr int BM = 256, BK = 64, HALF = 128, HTB = HALF * BK * 2  , STAGE_BYTES = 8 * HTB, NXCD = 8, WGM = 8;

__host__ __device__ __forceinline__ int lds_byte(int r, int c) { const int st = (r >> 4) * 2 + (c >> 5), rr = r & 15, cc = c & 31, ob = rr * 64 + cc * 2; return st * 1024 + (ob ^ (((ob >> 9) & 1) << 5)); }
__host__ __device__ __forceinline__ void stage_rc(int b, int& R, int& C) { const int st = b / 1024, sb = b % 1024, swz = sb ^ (((sb >> 9) & 1) << 5); R = (st >> 1) * 16 + swz / 64; C = (st & 1) * 32 + (swz % 64) / 2; }
__host__ __device__ __forceinline__ int perm32(int rho) { const int n = rho >> 4, i = rho & 15; return 8 * (i >> 2) + 4 * n + (i & 3); }

struct Unit { int pm, pn; };
struct Gemm { const bf16_t* A; const bf16_t* Bt; int M, N, K, w0; };

struct StaticOrder {
    static constexpr bool PADTILES = false;
    __device__ __forceinline__ bool half_rows(const Unit&) const { return false; }
    int nM, nN, nwg, G, c;
    __host__ __device__ void init(int M, int N, int G_, int c_) { nM = M / BM; nN = N / BM; nwg = nM * nN; G = G_; c = c_; }
    __host__ __device__ bool next(int i, Unit& u) const {
        const long L = (long)i * G + c; if (L >= nwg) return false;
        int wgid = (int)L; { const int q = nwg / NXCD, r = nwg % NXCD, xcd = wgid % NXCD, off = wgid / NXCD; wgid = (xcd < r ? xcd * (q + 1) : r * (q + 1) + (xcd - r) * q) + off; }
        const int nig = WGM * nN, gid = wgid / nig, fm = gid * WGM, gsz = (nM - fm) < WGM ? (nM - fm) : WGM;
        u.pm = fm + ((wgid % nig) % gsz); u.pn = (wgid % nig) / gsz; return true;
    }
    __device__ __forceinline__ void a_ready(const Unit&) const {}
    __device__ __forceinline__ void done(const Unit&) const {}
};
__device__ __forceinline__ unsigned cvt_pk_bf16(float lo, float hi) { unsigned r; asm volatile("v_cvt_pk_bf16_f32 %0, %1, %2" : "=v"(r) : "v"(lo), "v"(hi)); return r; }

struct MoeOrder {
    static constexpr bool PADTILES = true;
    __device__ __forceinline__ bool half_rows(const Unit& u) const { return (u.pm % 17) == 16; }
    int NT, NC, G, c;
    __device__ __forceinline__ bool next(int i, Unit& u) const {
        const int L = i * G + c, per = NT * NC; if (L >= 16 * per) return false;
        const int e = L / per, q = L - e * per;
        if (NC == 16 && q < 256) { u.pm = e * 17 + (q >> 6) * 4 + (q & 3); u.pn = e * NC + ((q >> 2) & 15); }
        else { u.pm = e * 17 + q / NC; u.pn = e * NC + q % NC; }
        return true;
    }
    __device__ __forceinline__ void a_ready(const Unit&) const {}
    __device__ __forceinline__ void done(const Unit&) const {}
};

__device__ __forceinline__ float fast_exp(float x) { return __builtin_amdgcn_exp2f(x * 1.4426950408889634f); }
__device__ __forceinline__ float fast_sigmoid(float x) { return __builtin_amdgcn_rcpf(1.0f + fast_exp(-x)); }

constexpr float F8_SA = 8.0f, F8_SW = 64.0f, F8_SH = 4.0f, F8_SY = 16.0f;
#ifdef P_NT
#define PSTORE(p_, v_) __builtin_nontemporal_store((v_), (p_))
#else
#define PSTORE(p_, v_) (*(p_) = (v_))
#endif
template <bool PLAIN, bool F8 = false>
struct EpiInT {
    static constexpr float ASC = F8 ? 1.0f / (F8_SA * F8_SW) : 1.0f;
    static constexpr bool PERM = true, AFTER_DRAIN = false;
    bf16_t* P; const float* lb; const float* cs;
    __device__ __forceinline__ void operator()(const f32x4 (&acc)[2][2][4][2], const Unit& u, int wr, int wc, int fr, int fq) const {
        const int grp = PLAIN ? 0 : (u.pn >> 1);
        const int row0 = u.pm * BM + wr * 64 + fr, col0 = u.pn * BM + wc * 32 + 8 * fq;
        if (grp == 0 || grp == 3 || grp == 7) {
#pragma unroll
            for (int ai = 0; ai < 2; ++ai)
#pragma unroll
                for (int m = 0; m < 4; ++m) { bf16_t* rowp = P + (size_t)(row0 + ai * HALF + m * 16) * INW + col0;
#pragma unroll
                    for (int bj = 0; bj < 2; ++bj) { const f32x4 v0 = acc[ai][bj][m][0] * ASC, v1 = acc[ai][bj][m][1] * ASC;
                        u32x4 w; w.x = cvt_pk_bf16(v0[0], v0[1]); w.y = cvt_pk_bf16(v0[2], v0[3]); w.z = cvt_pk_bf16(v1[0], v1[1]); w.w = cvt_pk_bf16(v1[2], v1[3]);
#ifdef PROBE_LINSTORE
                        if (PLAIN) {
#if PROBE_LINSTORE == 2
                            *((u32x4*)P + ((size_t)blockIdx.x * 8192 + (((wr * 4 + wc) * 16 + (ai * 4 + m) * 2 + bj) * 64 + fq * 16 + fr))) = w; continue;
#else
                            *((u32x4*)P + ((size_t)(u.pm * 18 + u.pn) * 8192 + (((wr * 4 + wc) * 16 + (ai * 4 + m) * 2 + bj) * 64 + fq * 16 + fr))) = w; continue;
#endif
                        }
#endif
                        PSTORE((u32x4*)(rowp + bj * HALF), w); } }
        } else if (grp == 1 || grp == 2) {
            const int cg = col0 - grp * 512;
            f32x4 lbv[2][2];
#pragma unroll
            for (int bj = 0; bj < 2; ++bj)
#pragma unroll
                for (int n = 0; n < 2; ++n) lbv[bj][n] = *(const f32x4*)(lb + cg + bj * HALF + 4 * n);
#pragma unroll
            for (int ai = 0; ai < 2; ++ai)
#pragma unroll
                for (int m = 0; m < 4; ++m) { bf16_t* rowp = P + (size_t)(row0 + ai * HALF + m * 16) * INW + col0;
#pragma unroll
                    for (int bj = 0; bj < 2; ++bj) { f32x4 v[2];
#pragma unroll
                        for (int n = 0; n < 2; ++n)
#pragma unroll
                            for (int h = 0; h < 2; ++h) { const f32x2 z = (f32x2){acc[ai][bj][m][n][2 * h], acc[ai][bj][m][n][2 * h + 1]} * ASC, l0 = {lbv[bj][n][2 * h], lbv[bj][n][2 * h + 1]};
                                const f32x2 x = z * (-1.4426950408889634f); const f32x2 d = (f32x2){__builtin_amdgcn_exp2f(x.x), __builtin_amdgcn_exp2f(x.y)} + 1.0f;
                                f32x2 f = l0 + ((f32x2){1.0f, 1.0f} - l0) * (f32x2){__builtin_amdgcn_rcpf(d.x), __builtin_amdgcn_rcpf(d.y)}; f = __builtin_elementwise_max(f, (f32x2){1e-30f, 1e-30f});
#ifndef SCAN_LOG2
                                const f32x2 r = (f32x2){__builtin_amdgcn_logf(f.x), __builtin_amdgcn_logf(f.y)} * 0.6931471805599453f;
#else
                                const f32x2 r = (f32x2){__builtin_amdgcn_logf(f.x), __builtin_amdgcn_logf(f.y)};
#endif
                                v[n][2 * h] = r.x; v[n][2 * h + 1] = r.y; }
                        u32x4 w; w.x = cvt_pk_bf16(v[0][0], v[0][1]); w.y = cvt_pk_bf16(v[0][2], v[0][3]); w.z = cvt_pk_bf16(v[1][0], v[1][1]); w.w = cvt_pk_bf16(v[1][2], v[1][3]);
                        PSTORE((u32x4*)(rowp + bj * HALF), w); } }
        } else if (grp == 4 || grp == 8) {
#pragma unroll
            for (int ai = 0; ai < 2; ++ai)
#pragma unroll
                for (int m = 0; m < 4; ++m) { bf16_t* rowp = P + (size_t)(row0 + ai * HALF + m * 16) * INW + col0;
#pragma unroll
                    for (int bj = 0; bj < 2; ++bj) { f32x4 v[2];
#pragma unroll
                        for (int n = 0; n < 2; ++n)
#pragma unroll
                            for (int h = 0; h < 2; ++h) { const f32x2 z = (f32x2){acc[ai][bj][m][n][2 * h], acc[ai][bj][m][n][2 * h + 1]} * ASC; const f32x2 x = z * (-1.4426950408889634f);
                                const f32x2 d = (f32x2){__builtin_amdgcn_exp2f(x.x), __builtin_amdgcn_exp2f(x.y)} + 1.0f; const f32x2 r = z * (f32x2){__builtin_amdgcn_rcpf(d.x), __builtin_amdgcn_rcpf(d.y)};
                                v[n][2 * h] = r.x; v[n][2 * h + 1] = r.y; }
                        u32x4 w; w.x = cvt_pk_bf16(v[0][0], v[0][1]); w.y = cvt_pk_bf16(v[0][2], v[0][3]); w.z = cvt_pk_bf16(v[1][0], v[1][1]); w.w = cvt_pk_bf16(v[1][2], v[1][3]);
                        PSTORE((u32x4*)(rowp + bj * HALF), w); } }
        } else {
            const float sc = ((grp == 6) ? 0.08838834764831845f : 1.0f) * ASC;
            const int f0 = 16 * (wc & 1) + 4 * fq;
#pragma unroll
            for (int ai = 0; ai < 2; ++ai)
#pragma unroll
                for (int m = 0; m < 4; ++m) { const int row = row0 + ai * HALF + m * 16; bf16_t* rowp = P + (size_t)row * INW + col0;
                    int g = row; if (g >= LTOT) g -= LTOT;
                    int pos = 0; if (g >= CTX) { const int nn = g - CTX; pos = (wc < 2) ? (nn >> 6) : (nn & 63); }
                    const f32x4 t0 = *(const f32x4*)(cs + (size_t)(pos * 32 + f0) * 2), t1 = *(const f32x4*)(cs + (size_t)(pos * 32 + f0) * 2 + 4);
#pragma unroll
                    for (int bj = 0; bj < 2; ++bj) { const f32x4 v0 = acc[ai][bj][m][0] * sc, v1 = acc[ai][bj][m][1] * sc;
                        const float a0 = v0[0] * t0[0] - v0[1] * t0[1], a1 = v0[0] * t0[1] + v0[1] * t0[0];
                        const float a2 = v0[2] * t0[2] - v0[3] * t0[3], a3 = v0[2] * t0[3] + v0[3] * t0[2];
                        const float b0 = v1[0] * t1[0] - v1[1] * t1[1], b1 = v1[0] * t1[1] + v1[1] * t1[0];
                        const float b2 = v1[2] * t1[2] - v1[3] * t1[3], b3 = v1[2] * t1[3] + v1[3] * t1[2];
                        u32x4 w; w.x = cvt_pk_bf16(a0, a1); w.y = cvt_pk_bf16(a2, a3); w.z = cvt_pk_bf16(b0, b1); w.w = cvt_pk_bf16(b2, b3);
                        PSTORE((u32x4*)(rowp + bj * HALF), w); } }
        }
    }
};

using EpiIn = EpiInT<false>;
using EpiIn8 = EpiInT<false, true>;

struct EpiNull { static constexpr bool PERM = true, AFTER_DRAIN = false; float* sink;
    __device__ __forceinline__ void operator()(const f32x4 (&acc)[2][2][4][2], const Unit& u, int wr, int wc, int fr, int fq) const { f32x4 s = acc[0][0][0][0]; _Pragma("unroll") for (int a = 0; a < 2; ++a) _Pragma("unroll") for (int b = 0; b < 2; ++b) _Pragma("unroll") for (int m = 0; m < 4; ++m) _Pragma("unroll") for (int n = 0; n < 2; ++n) s += acc[a][b][m][n]; if (s[0] == 123.456f && u.pm < 0) sink[fr + fq + wr + wc] = s[1]; } };

template <bool F8>
struct EpiOutT {
    static constexpr bool PERM = true, AFTER_DRAIN = false; static constexpr float ASC = F8 ? 1.0f / (F8_SA * F8_SW) : 1.0f;
    bf16_t* X; const float* xin; const float* cin; const float* gt;
    __device__ __forceinline__ void operator()(const f32x4 (&acc)[2][2][4][2], const Unit& u, int wr, int wc, int fr, int fq) const {
        const int b = u.pm / 65, tb = u.pm - b * 65, which = (tb == 0) ? 2 : b;
        const int row0 = u.pm * BM + wr * 64 + fr, col0 = u.pn * BM + wc * 32 + 8 * fq;
        f32x4 gv[2][2];
#pragma unroll
        for (int bj = 0; bj < 2; ++bj)
#pragma unroll
            for (int n = 0; n < 2; ++n) gv[bj][n] = *(const f32x4*)(gt + which * 6144 + col0 + bj * HALF + 4 * n) * ASC;
#pragma unroll
        for (int ai = 0; ai < 2; ++ai)
#pragma unroll
            for (int m = 0; m < 4; ++m) { const int row = row0 + ai * HALF + m * 16; bf16_t* op = X + (size_t)row * D + col0;
#pragma unroll
                for (int bj = 0; bj < 2; ++bj) { f32x4 b0, b1;
                    if (xin) { const int g = row - b * LTOT; const float* bp = (g < CTX ? cin + (size_t)(b * CTX + g) * D : xin + (size_t)(b * SEQ + g - CTX) * D) + col0 + bj * HALF; b0 = *(const f32x4*)bp; b1 = *(const f32x4*)(bp + 4); }
                    else { const u32x4 w = *(const u32x4*)(op + bj * HALF); b0 = (f32x4){__uint_as_float(w.x << 16), __uint_as_float(w.x & 0xffff0000u), __uint_as_float(w.y << 16), __uint_as_float(w.y & 0xffff0000u)};
                        b1 = (f32x4){__uint_as_float(w.z << 16), __uint_as_float(w.z & 0xffff0000u), __uint_as_float(w.w << 16), __uint_as_float(w.w & 0xffff0000u)}; }
                    const f32x4 v0 = b0 + gv[bj][0] * acc[ai][bj][m][0], v1 = b1 + gv[bj][1] * acc[ai][bj][m][1];
                    u32x4 o; o.x = cvt_pk_bf16(v0[0], v0[1]); o.y = cvt_pk_bf16(v0[2], v0[3]); o.z = cvt_pk_bf16(v1[0], v1[1]); o.w = cvt_pk_bf16(v1[2], v1[3]);
                    *(u32x4*)(op + bj * HALF) = o; }
                if (F8) __builtin_amdgcn_sched_barrier(0); }
    }
};

using EpiOut = EpiOutT<false>;
using EpiOut8 = EpiOutT<true>;

__device__ __forceinline__ unsigned pk4_fp8(float a, float b, float c, float d) {
    a = __builtin_amdgcn_fmed3f(a, -448.f, 448.f); b = __builtin_amdgcn_fmed3f(b, -448.f, 448.f); c = __builtin_amdgcn_fmed3f(c, -448.f, 448.f); d = __builtin_amdgcn_fmed3f(d, -448.f, 448.f);
    unsigned w = 0; w = __builtin_amdgcn_cvt_pk_fp8_f32(a, b, w, false); w = __builtin_amdgcn_cvt_pk_fp8_f32(c, d, w, true); return w; }
struct EpiGU {
    static constexpr bool PERM = true, AFTER_DRAIN = false;
    unsigned char* HID;
    __device__ __forceinline__ void operator()(const f32x4 (&acc)[2][2][4][2], const Unit& u, int wr, int wc, int fr, int fq) const {
        const int row0 = u.pm * BM + wr * 64 + fr, col0 = (u.pn & 15) * HALF + wc * 32 + 8 * fq;
        constexpr float inv = 1.0f / (F8_SA * F8_SW);
#pragma unroll
        for (int ai = 0; ai < 2; ++ai)
#pragma unroll
            for (int m = 0; m < 4; ++m) { unsigned char* rowp = HID + (size_t)(row0 + ai * HALF + m * 16) * FF + col0; f32x4 v[2];
#pragma unroll
                for (int n = 0; n < 2; ++n)
#pragma unroll
                    for (int h = 0; h < 2; ++h) {
                        const f32x2 a0 = {acc[ai][0][m][n][2 * h], acc[ai][0][m][n][2 * h + 1]}, a1 = {acc[ai][1][m][n][2 * h], acc[ai][1][m][n][2 * h + 1]};
                        const f32x2 x = a0 * (-inv * 1.4426950408889634f); const f32x2 d = (f32x2){__builtin_amdgcn_exp2f(x.x), __builtin_amdgcn_exp2f(x.y)} + 1.0f;
                        const f32x2 r = (a0 * a1) * (inv * inv * F8_SH) * (f32x2){__builtin_amdgcn_rcpf(d.x), __builtin_amdgcn_rcpf(d.y)};
                        v[n][2 * h] = r.x; v[n][2 * h + 1] = r.y; }
                u32x2 w; w.x = pk4_fp8(v[0][0], v[0][1], v[0][2], v[0][3]); w.y = pk4_fp8(v[1][0], v[1][1], v[1][2], v[1][3]);
                *(u32x2*)rowp = w; }
    }
};

struct EpiDown {
    static constexpr bool PERM = true, AFTER_DRAIN = false;
    unsigned char* YS;
    __device__ __forceinline__ void operator()(const f32x4 (&acc)[2][2][4][2], const Unit& u, int wr, int wc, int fr, int fq) const {
        const int row0 = u.pm * BM + wr * 64 + fr, col0 = (u.pn & 3) * BM + wc * 32 + 8 * fq;
        constexpr float gg = F8_SY / (F8_SH * F8_SW);
#pragma unroll
        for (int ai = 0; ai < 2; ++ai)
#pragma unroll
            for (int m = 0; m < 4; ++m) { unsigned char* rowp = YS + (size_t)(row0 + ai * HALF + m * 16) * D + col0;
#pragma unroll
                for (int bj = 0; bj < 2; ++bj) { const f32x4 v0 = acc[ai][bj][m][0] * gg, v1 = acc[ai][bj][m][1] * gg;
                    u32x2 w; w.x = pk4_fp8(v0[0], v0[1], v0[2], v0[3]); w.y = pk4_fp8(v1[0], v1[1], v1[2], v1[3]);
                    *(u32x2*)(rowp + bj * HALF) = w; } }
    }
};

typedef int i32x4v __attribute__((ext_vector_type(4)));
typedef int i32x8v __attribute__((ext_vector_type(8)));
__device__ __forceinline__ i32x8v cat8(bf16x8 lo, bf16x8 hi) { const i32x4v a = __builtin_bit_cast(i32x4v, lo), b = __builtin_bit_cast(i32x4v, hi); return __builtin_shufflevector(a, b, 0, 1, 2, 3, 4, 5, 6, 7); }
template <class Epi, class Sched, bool GATHER>
__device__ __forceinline__ void gemm_phase_f8(PG8_LAS unsigned char* lds, const Gemm g, const Sched& S, const Epi& E, const int* rowmap) {
    const int tid = opaque_tid(g.w0), wid = __builtin_amdgcn_readfirstlane(tid >> 6), lane = tid & 63, wr = wid >> 2, wc = wid & 3, fr = lane & 15, fq = lane >> 4;
    const int rowb = g.K, nt = rowb / 128;
    unsigned vA0[2], vA1[2], voffB[2];
#pragma unroll
    for (int i = 0; i < 2; ++i) { int R, C; stage_rc(tid * 16 + i * 8192, R, C); const int Rb = Epi::PERM ? ((R & ~31) + perm32(R & 31)) : R;
        voffB[i] = (unsigned)(Rb * rowb + 2 * C); vA0[i] = (unsigned)(R * rowb + 2 * C); vA1[i] = vA0[i]; }
    const size_t kstep = 128;
    const size_t hstep = (size_t)HALF * rowb;
    const size_t tstep = 2 * hstep;
    const unsigned ldsw = (unsigned)wid * 1024u;
    const int aoff = lds_byte(wr * 64 + fr, fq * 8), boff = lds_byte(wc * 32 + fr, fq * 8);
    constexpr int GOFF = STAGE_BYTES;
#define PG8_SA(b, h) (((b) * 2 + (h)) * HTB)
#define PG8_SB(b, h) ((4 + (b) * 2 + (h)) * HTB)
#define PG8_STAGE(bufoff, gbase, voff) do { _Pragma("unroll") for (int _i = 0; _i < 2; ++_i) { unsigned _o = (voff)[_i]; asm volatile("" : "+v"(_o)); \
        __builtin_amdgcn_global_load_lds((const unsigned*)((const char*)(gbase) + _o), (PG8_LAS unsigned*)(lds + (bufoff) + ldsw + _i * 8192), 16, 0, 0); } } while (0)
#define PG8_STAGE_A(bufoff, kbase, h) do { if constexpr (GATHER) { if (h) PG8_STAGE(bufoff, kbase, vA1); else PG8_STAGE(bufoff, kbase, vA0); } else PG8_STAGE(bufoff, (kbase) + (h) * hstep, vA0); } while (0)
#define PG8_GIDX_ISSUE(pm_) do { const int _t = opaque_tid(g.w0); _Pragma("unroll") for (int _i = 0; _i < 2; ++_i) { int R, C; stage_rc(_t * 16 + _i * 8192, R, C); _Pragma("unroll") for (int _h = 0; _h < 2; ++_h) \
        __builtin_amdgcn_global_load_lds((const unsigned*)(rowmap + (pm_) * BM + _h * HALF + R), (PG8_LAS unsigned*)(lds + GOFF + ldsw + (_h * 2 + _i) * 256), 4, 0, 0); } } while (0)
#define PG8_GIDX_TAKE() do { const int _t = opaque_tid(g.w0); _Pragma("unroll") for (int _i = 0; _i < 2; ++_i) { int R, C; stage_rc(_t * 16 + _i * 8192, R, C); \
        vA0[_i] = *(const PG8_LAS unsigned*)(lds + GOFF + ldsw + (0 * 2 + _i) * 256 + (_t & 63) * 4) * (unsigned)rowb + (unsigned)(2 * C); \
        vA1[_i] = *(const PG8_LAS unsigned*)(lds + GOFF + ldsw + (1 * 2 + _i) * 256 + (_t & 63) * 4) * (unsigned)rowb + (unsigned)(2 * C); } } while (0)
#define PG8_LDA(dst, b, h) do { _Pragma("unroll") for (int m = 0; m < 4; ++m) _Pragma("unroll") for (int k = 0; k < 2; ++k) dst[m][k] = *(const PG8_LAS bf16x8*)(lds + PG8_SA(b, h) + aoff + m * 2048 + k * 1024); } while (0)
#define PG8_LDB(dst, b, h) do { _Pragma("unroll") for (int n = 0; n < 2; ++n) _Pragma("unroll") for (int k = 0; k < 2; ++k) dst[n][k] = *(const PG8_LAS bf16x8*)(lds + PG8_SB(b, h) + boff + n * 2048 + k * 1024); } while (0)
#define PG8_MMA(ai, bj, At, Bt) do { __builtin_amdgcn_s_setprio(1); _Pragma("unroll") for (int m = 0; m < 4; ++m) _Pragma("unroll") for (int n = 0; n < 2; ++n) \
        acc[ai][bj][m][n] = __builtin_amdgcn_mfma_scale_f32_16x16x128_f8f6f4(cat8(Bt[n][0], Bt[n][1]), cat8(At[m][0], At[m][1]), acc[ai][bj][m][n], 0, 0, 0, 0, 0, 0); __builtin_amdgcn_s_setprio(0); } while (0)
#define PG8_WAIT_V(n) asm volatile("s_waitcnt vmcnt(" #n ")" ::: "memory")
#define PG8_WAIT_L(n) asm volatile("s_waitcnt lgkmcnt(" #n ")" ::: "memory")
#define PG8_BAR __builtin_amdgcn_s_barrier()
#define PG8_SCHED __builtin_amdgcn_sched_barrier(0)
    Unit cur, nxt; int ui = 0;
    if (!S.next(0, cur)) return;
    bool half = Sched::PADTILES && S.half_rows(cur);
    f32x4 acc[2][2][4][2];
#pragma unroll
    for (int a = 0; a < 2; ++a)
#pragma unroll
        for (int b = 0; b < 2; ++b)
#pragma unroll
            for (int m = 0; m < 4; ++m)
#pragma unroll
                for (int n = 0; n < 2; ++n) acc[a][b][m][n] = (f32x4){0.f, 0.f, 0.f, 0.f};
    bf16x8 At[4][2], B0[2][2], B1[2][2];
    const char* cA; const char* cB = (const char*)g.Bt + (size_t)cur.pn * tstep;
    if constexpr (GATHER) { cA = (const char*)g.A; PG8_GIDX_ISSUE(cur.pm); PG8_WAIT_V(0); PG8_GIDX_TAKE(); }
    else cA = (const char*)g.A + (size_t)cur.pm * tstep;
    PG8_STAGE(PG8_SB(0, 0), cB, voffB); PG8_STAGE(PG8_SB(0, 1), cB + hstep, voffB); PG8_STAGE_A(PG8_SA(0, 0), cA, 0); PG8_STAGE_A(PG8_SA(0, 1), cA, 1);
    if (wr == 1) PG8_BAR;
    PG8_WAIT_V(2); PG8_BAR;
    PG8_STAGE(PG8_SB(1, 0), cB + kstep, voffB); PG8_STAGE_A(PG8_SA(1, 0), cA + kstep, 0); PG8_STAGE(PG8_SB(1, 1), cB + hstep + kstep, voffB);
    PG8_WAIT_V(6); PG8_BAR;
    for (;;) {
        const bool has_next = S.next(ui + 1, nxt);
        const char* nA; const char* nB = has_next ? (const char*)g.Bt + (size_t)nxt.pn * tstep : cB;
        if constexpr (GATHER) { nA = cA; if (has_next) PG8_GIDX_ISSUE(nxt.pm); }
        else nA = has_next ? (const char*)g.A + (size_t)nxt.pm * tstep : cA;
#pragma unroll 1
        for (int t = 0; t < nt; t += 2) {
            const bool last = (t == nt - 2);
            const char* a1 = cA + (size_t)(t + 1) * kstep;
            const char* a2 = last ? nA : cA + (size_t)(t + 2) * kstep; const char* b2 = last ? nB : cB + (size_t)(t + 2) * kstep;
            const char* a3 = a2 + kstep; const char* b3 = b2 + kstep;
            PG8_LDB(B0, 0, 0); PG8_LDB(B1, 0, 1); PG8_SCHED; PG8_LDA(At, 0, 0); PG8_STAGE_A(PG8_SA(1, 1), a1, 1);
            if constexpr (GATHER) { if (last && has_next) PG8_GIDX_TAKE(); }
            PG8_WAIT_V(8); PG8_WAIT_L(0); PG8_BAR; if (!(half && wr == 1)) { PG8_MMA(0, 0, At, B0); PG8_MMA(0, 1, At, B1); } PG8_BAR; PG8_SCHED;
            PG8_LDA(At, 0, 1); PG8_STAGE(PG8_SB(0, 0), b2, voffB); PG8_STAGE(PG8_SB(0, 1), b2 + hstep, voffB); PG8_STAGE_A(PG8_SA(0, 0), a2, 0);
            PG8_WAIT_V(8); PG8_WAIT_L(0); PG8_BAR; if (!half) { PG8_MMA(1, 0, At, B0); PG8_MMA(1, 1, At, B1); } PG8_BAR; PG8_SCHED;
            PG8_LDB(B0, 1, 0); PG8_LDB(B1, 1, 1); PG8_SCHED; PG8_LDA(At, 1, 0); PG8_STAGE_A(PG8_SA(0, 1), a2, 1);
            PG8_WAIT_V(8); PG8_WAIT_L(0); PG8_BAR; if (!(half && wr == 1)) { PG8_MMA(0, 0, At, B0); PG8_MMA(0, 1, At, B1); } PG8_BAR; PG8_SCHED;
            PG8_LDA(At, 1, 1); PG8_STAGE(PG8_SB(1, 0), b3, voffB); PG8_STAGE(PG8_SB(1, 1), b3 + hstep, voffB); PG8_STAGE_A(PG8_SA(1, 0), a3, 0);
            PG8_WAIT_V(8); PG8_WAIT_L(0); PG8_BAR; if (!half) { PG8_MMA(1, 0, At, B0); PG8_MMA(1, 1, At, B1); } PG8_BAR; PG8_SCHED;
        }
        if (wr == 0) PG8_BAR;
        { const int l2_ = opaque_tid(g.w0) & 63; E(acc, cur, wr, wc, l2_ & 15, l2_ >> 4); }
#ifdef G2_F8
        { const int t2_ = opaque_tid(g.w0);
#pragma unroll
          for (int i = 0; i < 2; ++i) { int R, C; stage_rc(t2_ * 16 + i * 8192, R, C); const int Rb = Epi::PERM ? ((R & ~31) + perm32(R & 31)) : R;
              voffB[i] = (unsigned)(Rb * rowb + 2 * C); if constexpr (!GATHER) { vA0[i] = (unsigned)(R * rowb + 2 * C); vA1[i] = vA0[i]; } } }
#endif
        if (!has_next) break;
#pragma unroll
        for (int a = 0; a < 2; ++a)
#pragma unroll
            for (int b = 0; b < 2; ++b)
#pragma unroll
                for (int m = 0; m < 4; ++m)
#pragma unroll
                    for (int n = 0; n < 2; ++n) acc[a][b][m][n] = (f32x4){0.f, 0.f, 0.f, 0.f};
        cur = nxt; cA = nA; cB = nB; ++ui; half = Sched::PADTILES && S.half_rows(cur);
        if (wr == 1) PG8_BAR;
    }
    PG8_WAIT_V(0);
    PG8_BAR;
#undef PG8_SA
#undef PG8_SB
#undef PG8_STAGE
#undef PG8_STAGE_A
#undef PG8_GIDX_ISSUE
#undef PG8_GIDX_TAKE
#undef PG8_LDA
#undef PG8_LDB
#undef PG8_MMA
#undef PG8_WAIT_V
#undef PG8_WAIT_L
#undef PG8_BAR
#undef PG8_SCHED
}
template <class Epi, class Sched, bool ALIGN_EPI = false, bool SP2 = false>
__device__ __forceinline__ void gemm_phase(PG8_LAS unsigned char* lds, const Gemm g, const Sched& S, const Epi& E) {
    const int tid = opaque_tid(g.w0), wid = __builtin_amdgcn_readfirstlane(tid >> 6), lane = tid & 63, wr = wid >> 2, wc = wid & 3, fr = lane & 15, fq = lane >> 4;
    const int K = g.K, nt = K / BK;
    unsigned voffA[2], voffB[2];
#pragma unroll
    for (int i = 0; i < 2; ++i) { int R, C; stage_rc(tid * 16 + i * 8192, R, C); const int Rb = Epi::PERM ? ((R & ~31) + perm32(R & 31)) : R;
        voffA[i] = (unsigned)(R * K + C) * 2u; voffB[i] = (unsigned)(Rb * K + C) * 2u; }
    const size_t kstep = (size_t)(BK * 2);
    const size_t hstep = (size_t)HALF * K * 2;
    const size_t tstep = 2 * hstep;
    const unsigned ldsw = (unsigned)wid * 1024u;
    const int aoff = lds_byte(wr * 64 + fr, fq * 8), boff = lds_byte(wc * 32 + fr, fq * 8);
#define PG8_SA(b, h) (((b) * 2 + (h)) * HTB)
#define PG8_SB(b, h) ((4 + (b) * 2 + (h)) * HTB)
#define PG8_STAGE(bufoff, gbase, voff) do { _Pragma("unroll") for (int _i = 0; _i < 2; ++_i) \
        __builtin_amdgcn_global_load_lds((const unsigned*)((const char*)(gbase) + (voff)[_i]), (PG8_LAS unsigned*)(lds + (bufoff) + ldsw + _i * 8192), 16, 0, 0); } while (0)
#define PG8_LDA(dst, b, h) do { _Pragma("unroll") for (int m = 0; m < 4; ++m) _Pragma("unroll") for (int k = 0; k < 2; ++k) dst[m][k] = *(const PG8_LAS bf16x8*)(lds + PG8_SA(b, h) + aoff + m * 2048 + k * 1024); } while (0)
#define PG8_LDB(dst, b, h) do { _Pragma("unroll") for (int n = 0; n < 2; ++n) _Pragma("unroll") for (int k = 0; k < 2; ++k) dst[n][k] = *(const PG8_LAS bf16x8*)(lds + PG8_SB(b, h) + boff + n * 2048 + k * 1024); } while (0)
#define PG8_MMA(ai, bj, At, Bt) do { __builtin_amdgcn_s_setprio(1); _Pragma("unroll") for (int m = 0; m < 4; ++m) _Pragma("unroll") for (int n = 0; n < 2; ++n) _Pragma("unroll") for (int k = 0; k < 2; ++k) \
        acc[ai][bj][m][n] = __builtin_amdgcn_mfma_f32_16x16x32_bf16(Bt[n][k], At[m][k], acc[ai][bj][m][n], 0, 0, 0); __builtin_amdgcn_s_setprio(0); } while (0)
#define PG8_WAIT_V(n) asm volatile("s_waitcnt vmcnt(" #n ")" ::: "memory")
#define PG8_WAIT_L(n) asm volatile("s_waitcnt lgkmcnt(" #n ")" ::: "memory")
#define PG8_BAR __builtin_amdgcn_s_barrier()
#define PG8_SCHED __builtin_amdgcn_sched_barrier(0)
    Unit cur, nxt; int ui = 0;
    if (!S.next(0, cur)) return;
    f32x4 acc[2][2][4][2];
#pragma unroll
    for (int a = 0; a < 2; ++a)
#pragma unroll
        for (int b = 0; b < 2; ++b)
#pragma unroll
            for (int m = 0; m < 4; ++m)
#pragma unroll
                for (int n = 0; n < 2; ++n) acc[a][b][m][n] = (f32x4){0.f, 0.f, 0.f, 0.f};
    bf16x8 At[4][2], B0[2][2], B1[2][2];
    const char* cA = (const char*)g.A + (size_t)cur.pm * tstep; const char* cB = (const char*)g.Bt + (size_t)cur.pn * tstep;
    S.a_ready(cur);
    if constexpr (SP2) {
        PG8_STAGE(PG8_SB(0, 0), cB, voffB); PG8_STAGE(PG8_SB(0, 1), cB + hstep, voffB); PG8_STAGE(PG8_SA(0, 0), cA, voffA); PG8_STAGE(PG8_SA(0, 1), cA + hstep, voffA);
        if (wr == 1) PG8_BAR;
        PG8_WAIT_V(2); PG8_BAR;
        PG8_STAGE(PG8_SB(1, 0), cB + kstep, voffB); PG8_STAGE(PG8_SA(1, 0), cA + kstep, voffA); PG8_STAGE(PG8_SB(1, 1), cB + hstep + kstep, voffB);
        PG8_WAIT_V(6); PG8_BAR;
    } else {
        PG8_STAGE(PG8_SB(0, 0), cB, voffB); PG8_STAGE(PG8_SA(0, 0), cA, voffA); PG8_STAGE(PG8_SB(0, 1), cB + hstep, voffB); PG8_STAGE(PG8_SA(0, 1), cA + hstep, voffA);
        if (wr == 1) PG8_BAR;
        PG8_WAIT_V(4); PG8_BAR;
        PG8_STAGE(PG8_SB(1, 0), cB + kstep, voffB); PG8_STAGE(PG8_SA(1, 0), cA + kstep, voffA); PG8_STAGE(PG8_SB(1, 1), cB + hstep + kstep, voffB);
        PG8_WAIT_V(6); PG8_BAR;
    }
    for (;;) {
        const bool has_next = S.next(ui + 1, nxt);
        const char* nA = has_next ? (const char*)g.A + (size_t)nxt.pm * tstep : cA; const char* nB = has_next ? (const char*)g.Bt + (size_t)nxt.pn * tstep : cB;
        for (int t = 0; t < nt; t += 2) {
            const bool last = (t == nt - 2);
            const char* a1 = cA + (size_t)(t + 1) * kstep;
            const char* a2 = last ? nA : cA + (size_t)(t + 2) * kstep; const char* b2 = last ? nB : cB + (size_t)(t + 2) * kstep;
            const char* a3 = a2 + kstep; const char* b3 = b2 + kstep;
            if (last && has_next) S.a_ready(nxt);
            if constexpr (SP2) {
            PG8_LDB(B0, 0, 0); PG8_LDB(B1, 0, 1); PG8_SCHED; PG8_LDA(At, 0, 0); PG8_STAGE(PG8_SA(1, 1), a1 + hstep, voffA);
            PG8_WAIT_V(8); PG8_WAIT_L(0); PG8_BAR; PG8_MMA(0, 0, At, B0); PG8_MMA(0, 1, At, B1); PG8_BAR; PG8_SCHED;
            PG8_LDA(At, 0, 1); PG8_STAGE(PG8_SB(0, 0), b2, voffB); PG8_STAGE(PG8_SB(0, 1), b2 + hstep, voffB); PG8_STAGE(PG8_SA(0, 0), a2, voffA);
            PG8_WAIT_V(8); PG8_WAIT_L(0); PG8_BAR; PG8_MMA(1, 0, At, B0); PG8_MMA(1, 1, At, B1); PG8_BAR; PG8_SCHED;
            PG8_LDB(B0, 1, 0); PG8_LDB(B1, 1, 1); PG8_SCHED; PG8_LDA(At, 1, 0); PG8_STAGE(PG8_SA(0, 1), a2 + hstep, voffA);
            PG8_WAIT_V(8); PG8_WAIT_L(0); PG8_BAR; PG8_MMA(0, 0, At, B0); PG8_MMA(0, 1, At, B1); PG8_BAR; PG8_SCHED;
            PG8_LDA(At, 1, 1); PG8_STAGE(PG8_SB(1, 0), b3, voffB); PG8_STAGE(PG8_SB(1, 1), b3 + hstep, voffB); PG8_STAGE(PG8_SA(1, 0), a3, voffA);
            PG8_WAIT_V(8); PG8_WAIT_L(0); PG8_BAR; PG8_MMA(1, 0, At, B0); PG8_MMA(1, 1, At, B1); PG8_BAR; PG8_SCHED;
            } else {
            PG8_LDB(B0, 0, 0); PG8_SCHED; PG8_LDA(At, 0, 0); PG8_STAGE(PG8_SA(1, 1), a1 + hstep, voffA);
            PG8_WAIT_L(8); PG8_BAR; PG8_WAIT_L(0); PG8_MMA(0, 0, At, B0); PG8_BAR; PG8_SCHED;
            PG8_LDB(B1, 0, 1); PG8_STAGE(PG8_SB(0, 0), b2, voffB);
            PG8_BAR; PG8_WAIT_L(0); PG8_MMA(0, 1, At, B1); PG8_BAR;
            PG8_LDA(At, 0, 1); PG8_STAGE(PG8_SA(0, 0), a2, voffA);
            PG8_BAR; PG8_WAIT_L(0); PG8_MMA(1, 0, At, B0); PG8_BAR; PG8_SCHED;
            PG8_STAGE(PG8_SB(0, 1), b2 + hstep, voffB);
            PG8_WAIT_V(6); PG8_BAR; PG8_MMA(1, 1, At, B1); PG8_BAR;
            PG8_LDB(B0, 1, 0); PG8_SCHED; PG8_LDA(At, 1, 0); PG8_STAGE(PG8_SA(0, 1), a2 + hstep, voffA);
            PG8_WAIT_L(8); PG8_BAR; PG8_WAIT_L(0); PG8_MMA(0, 0, At, B0); PG8_BAR; PG8_SCHED;
            PG8_LDB(B1, 1, 1); PG8_STAGE(PG8_SB(1, 0), b3, voffB);
            PG8_BAR; PG8_WAIT_L(0); PG8_MMA(0, 1, At, B1); PG8_BAR;
            PG8_LDA(At, 1, 1); PG8_STAGE(PG8_SA(1, 0), a3, voffA);
            PG8_BAR; PG8_WAIT_L(0); PG8_MMA(1, 0, At, B0); PG8_BAR; PG8_SCHED;
            PG8_STAGE(PG8_SB(1, 1), b3 + hstep, voffB);
            PG8_WAIT_V(6); PG8_BAR; PG8_MMA(1, 1, At, B1); PG8_BAR;
            }
        }
        if constexpr (ALIGN_EPI) { if (wr == 0) PG8_BAR; }
        if constexpr (!Epi::AFTER_DRAIN) { E(acc, cur, wr, wc, fr, fq); S.done(cur); }
        if (!has_next) break;
#pragma unroll
        for (int a = 0; a < 2; ++a)
#pragma unroll
            for (int b = 0; b < 2; ++b)
#pragma unroll
                for (int m = 0; m < 4; ++m)
#pragma unroll
                    for (int n = 0; n < 2; ++n) acc[a][b][m][n] = (f32x4){0.f, 0.f, 0.f, 0.f};
        cur = nxt; cA = nA; cB = nB; ++ui;
        if constexpr (ALIGN_EPI) { if (wr == 1) PG8_BAR; }
    }
    PG8_WAIT_V(0);
    if constexpr (!ALIGN_EPI) { if (wr == 0) PG8_BAR; }
    PG8_BAR;
    if constexpr (Epi::AFTER_DRAIN) { E.fused(acc, cur, wr, wc, fr, fq, lds, wid, lane); S.done(cur); }
#undef PG8_SA
#undef PG8_SB
#undef PG8_STAGE
#undef PG8_LDA
#undef PG8_LDB
#undef PG8_MMA
#undef PG8_WAIT_V
#undef PG8_WAIT_L
#undef PG8_BAR
#undef PG8_SCHED
}
}
#define XB_TMO      128
#define XB_XCNT(j)  (256  + 64 * (j))
#define XB_XSUB(j)  (1280 + 64 * (j))
#define XB_XGEN(j)  (2304 + 64 * (j))
#define XB_TOP      3328
#define XB_TOPGEN   3392
#define XCD_BAR_WORDS 3456
#define XB_SPIN_CAP (1u << 18)

__device__ __forceinline__ unsigned xb_ld(unsigned* p)              { return __hip_atomic_load(p, __ATOMIC_RELAXED, __HIP_MEMORY_SCOPE_AGENT); }
__device__ __forceinline__ unsigned xb_add(unsigned* p, unsigned v) { return __hip_atomic_fetch_add(p, v, __ATOMIC_RELAXED, __HIP_MEMORY_SCOPE_AGENT); }
__device__ __forceinline__ unsigned xb_xcc_id() { return (unsigned)__builtin_amdgcn_s_getreg((3 << 11) | 20) & 0xFu; }
#define XB_SPIN(cond, bar) do { unsigned _sp = 0; while (cond) { __builtin_amdgcn_s_sleep(1); \
    if ((++_sp & 255u) == 0u) { if (xb_ld(&(bar)[XB_TMO])) break; if (_sp > XB_SPIN_CAP) { atomicAdd(&(bar)[XB_TMO], 1u); break; } } } } while (0)

struct XcdBarrier {
    unsigned* bar; unsigned x;
    volatile LAS unsigned* st;
};

__device__ __forceinline__ XcdBarrier xcd_barrier_post(unsigned* bar, volatile LAS unsigned* st) {
    XcdBarrier b; b.bar = bar; b.x = xb_xcc_id(); b.st = st;
    if (threadIdx.x == 0) (void)xb_add(&bar[XB_XCNT(b.x)], 1u);
    return b;
}
__device__ __forceinline__ void xcd_barrier_complete(unsigned* bar, unsigned x, unsigned& nloc, unsigned& nx) {
    const unsigned G = gridDim.x * gridDim.y * gridDim.z;
    unsigned sum, cnt, mine, sp = 0u;
    for (;;) {
        sum = 0u; cnt = 0u; mine = 0u;
#pragma unroll
        for (unsigned j = 0; j < 16; ++j) { const unsigned c = xb_ld(&bar[XB_XCNT(j)]); sum += c; cnt += (c > 0u) ? 1u : 0u; mine = (j == x) ? c : mine; }
        if (sum == G) break;
        __builtin_amdgcn_s_sleep(1);
        if ((++sp & 255u) == 0u) { if (xb_ld(&bar[XB_TMO])) break; if (sp > XB_SPIN_CAP) { atomicAdd(&bar[XB_TMO], 1u); break; } }
    }
    nloc = mine > 0u ? mine : 1u; nx = cnt > 0u ? cnt : 1u;
}

__device__ __forceinline__ void xcd_barrier(const XcdBarrier& b) {
    asm volatile("s_waitcnt vmcnt(0)" ::: "memory");
    __syncthreads();
    if (threadIdx.x == 0) {
        unsigned* bar = b.bar;
        __builtin_amdgcn_s_waitcnt(0);
        unsigned nloc = b.st[0], nx = b.st[1];
        if (nloc == 0u) { xcd_barrier_complete(bar, b.x, nloc, nx); b.st[0] = nloc; b.st[1] = nx; }
        const unsigned old = xb_add(&bar[XB_XSUB(b.x)], 1u);
        const unsigned gen = old / nloc;
        if (old + 1u == (gen + 1u) * nloc) {
            __builtin_amdgcn_fence(__ATOMIC_RELEASE, "agent");
            asm volatile("s_waitcnt vmcnt(0)" ::: "memory");
            const unsigned og = xb_add(&bar[XB_TOP], 1u);
            const unsigned tg = og / nx;
            if (og + 1u == (tg + 1u) * nx) xb_add(&bar[XB_TOPGEN], 1u);
            else XB_SPIN(xb_ld(&bar[XB_TOPGEN]) == tg, bar);
            __builtin_amdgcn_fence(__ATOMIC_ACQUIRE, "agent");
            xb_add(&bar[XB_XGEN(b.x)], 1u);
            asm volatile("s_waitcnt vmcnt(0)" ::: "memory");
        } else {
            XB_SPIN(xb_ld(&bar[XB_XGEN(b.x)]) == gen, bar);
            __builtin_amdgcn_fence(__ATOMIC_ACQUIRE, "agent");
            asm volatile("s_waitcnt vmcnt(0)" ::: "memory");
        }
    }
    __syncthreads();
}

using pg8::bf16_t; using pg8::bf16x8; using pg8::f32x4; using pg8::u32x4; using pg8::cvt_pk_bf16; using pg8::fast_exp;
#ifdef NT_MORE
#define LDNT(p_) __builtin_nontemporal_load(p_)
#define STNT(p_, v_) __builtin_nontemporal_store((v_), (p_))
#else
#define LDNT(p_) (*(p_))
#define STNT(p_, v_) (*(p_) = (v_))
#endif

#define BAR_LDS() do { asm volatile("s_waitcnt lgkmcnt(0)" ::: "memory"); __builtin_amdgcn_s_barrier(); asm volatile("" ::: "memory"); } while (0)
#define BAR_ALL() do { asm volatile("s_waitcnt vmcnt(0) lgkmcnt(0)" ::: "memory"); __builtin_amdgcn_s_barrier(); asm volatile("" ::: "memory"); } while (0)

#ifdef PROBE_SHFL
__device__ __forceinline__ float shx(float v, int mask, int lane) { (void)lane; return __shfl_xor(v, mask); }
__device__ __forceinline__ unsigned shxu(unsigned v, int mask, int lane) { (void)lane; return __shfl_xor(v, mask); }
__device__ __forceinline__ unsigned shupu(unsigned v, int d, int lane) { (void)lane; return __shfl_up(v, d); }
#else
__device__ __forceinline__ float shx(float v, int mask, int lane) { return __builtin_bit_cast(float, __builtin_amdgcn_ds_bpermute((lane ^ mask) << 2, __builtin_bit_cast(int, v))); }
__device__ __forceinline__ unsigned shxu(unsigned v, int mask, int lane) { return (unsigned)__builtin_amdgcn_ds_bpermute((lane ^ mask) << 2, (int)v); }
__device__ __forceinline__ unsigned shupu(unsigned v, int d, int lane) { return (unsigned)__builtin_amdgcn_ds_bpermute((lane - d) << 2, (int)v); }
#endif
__device__ __forceinline__ float wave_sum(float v, int lane) {
#pragma unroll
    for (int o = 1; o < 64; o <<= 1) v += shx(v, o, lane);
    return v;
}
__device__ __forceinline__ float bf_lo(unsigned u) { return __uint_as_float(u << 16); }
__device__ __forceinline__ float bf_hi(unsigned u) { return __uint_as_float(u & 0xffff0000u); }

struct Args { const float* in[18]; float* out; unsigned char* ws; };
struct Ctx { LAS unsigned char* lds; int w0;
    __device__ __forceinline__ const float* in(int i) const { return ldptr(lds, i); }
    __device__ __forceinline__ float* out() const { return (float*)ldptr(lds, 18); }
    __device__ __forceinline__ unsigned char* ws() const { return (unsigned char*)ldptr(lds, 19); } };
#define PHASE_IDS() const int tid = opaque_tid(a.w0), lane = tid & 63, wave = __builtin_amdgcn_readfirstlane(tid >> 6); (void)tid; (void)lane; (void)wave
enum { I_X = 0, I_C, I_CTX, I_CCTX, I_WADA, I_BADA, I_GMIX, I_GFFN, I_WIN, I_WOUT, I_LBL, I_ONORM, I_RDEC, I_WR, I_WEG, I_WEU, I_WED, I_GFIN };

struct CvtItem { const float* src; unsigned char* dst; int N, Kd, f8; };
__device__ __forceinline__ void cvt_desc(CvtItem& it, const float* W, int N, unsigned char* WT, int Kd, int k0, int n0, int drow0, int lane, int f8) {
    const int q = lane >> 4, c = lane & 15, es = f8 ? 1 : 2;
    it.src = W + (size_t)(k0 + 16 * q) * N + n0 + 4 * c; it.N = N; it.Kd = Kd * es; it.dst = WT + ((size_t)(drow0 + 4 * c) * Kd + k0 + 16 * q) * es; it.f8 = f8;
}
__device__ __forceinline__ void cvt_load(f32x4 (&v)[16], const CvtItem& it) {
#pragma unroll
#ifdef CVT_NT
    for (int i = 0; i < 16; ++i) v[i] = __builtin_nontemporal_load((const f32x4*)(it.src + (size_t)i * it.N));
#else
    for (int i = 0; i < 16; ++i) v[i] = *(const f32x4*)(it.src + (size_t)i * it.N);
#endif
}
__device__ __forceinline__ void cvt_store(const f32x4 (&v)[16], const CvtItem& it) {
    if (it.f8) {
#pragma unroll
        for (int j = 0; j < 4; ++j) { u32x4 o; constexpr float s = pg8::F8_SW;
            o.x = pg8::pk4_fp8(v[0][j] * s, v[1][j] * s, v[2][j] * s, v[3][j] * s); o.y = pg8::pk4_fp8(v[4][j] * s, v[5][j] * s, v[6][j] * s, v[7][j] * s);
            o.z = pg8::pk4_fp8(v[8][j] * s, v[9][j] * s, v[10][j] * s, v[11][j] * s); o.w = pg8::pk4_fp8(v[12][j] * s, v[13][j] * s, v[14][j] * s, v[15][j] * s);
            STNT((u32x4*)(it.dst + (size_t)j * it.Kd), o); }
    } else {
#pragma unroll
        for (int j = 0; j < 4; ++j) { u32x4 o0, o1;
            o0.x = cvt_pk_bf16(v[0][j], v[1][j]); o0.y = cvt_pk_bf16(v[2][j], v[3][j]); o0.z = cvt_pk_bf16(v[4][j], v[5][j]); o0.w = cvt_pk_bf16(v[6][j], v[7][j]);
            o1.x = cvt_pk_bf16(v[8][j], v[9][j]); o1.y = cvt_pk_bf16(v[10][j], v[11][j]); o1.z = cvt_pk_bf16(v[12][j], v[13][j]); o1.w = cvt_pk_bf16(v[14][j], v[15][j]);
            STNT((u32x4*)(it.dst + (size_t)j * it.Kd), o0); STNT((u32x4*)(it.dst + (size_t)j * it.Kd + 16), o1); }
    }
}
__device__ __forceinline__ void cvt_expert_desc(CvtItem& it, const Ctx& a, unsigned char* ws, int g, int lane) {
    constexpr int I_E = 512; const int l = g / 24576, r = g % 24576; const int le = l * 16 + r / (3 * I_E), q3 = r % (3 * I_E), kind = q3 / I_E, q = q3 % I_E;
    if (kind < 2) { const int kb = q / 32, nb = q % 32, n0 = nb * 64;
        const int drow = 256 * (n0 >> 7) + (n0 & 127) + kind * 128;
        cvt_desc(it, a.in(kind == 0 ? I_WEG : I_WEU) + (size_t)le * D * FF, FF, (unsigned char*)(ws + WS_WGU) + (size_t)le * 4096 * D, D, kb * 64, n0, drow, lane, 1);
    } else { const int kb = q / 16, nb = q % 16;
        cvt_desc(it, a.in(I_WED) + (size_t)le * FF * D, D, (unsigned char*)(ws + WS_WD) + (size_t)le * D * FF, FF, kb * 64, nb * 64, nb * 64, lane, 1); }
}
constexpr int CVT_N0 = 9472, CVT_G1 = 7040, CVT_G2 = 7936, CVT_T = 4608, CVT_G4 = 6144, CVT_CYC = CVT_G1 + CVT_G2 + CVT_T + CVT_G4;
static_assert(CVT_G1 == 220 * 8 * 4 && CVT_G2 == 248 * 8 * 4 && CVT_T == 192 * 8 * 3 && CVT_G4 == 192 * 8 * 4, "slot sizes = idle workgroups x 8 waves x items per wave");
static_assert(CVT_N0 + CVT_G1 + CVT_G2 + CVT_T >= 24576 && CVT_N0 + CVT_CYC + CVT_G1 + CVT_G2 + CVT_T >= 2 * 24576 && CVT_N0 + 2 * CVT_CYC + CVT_G1 + CVT_G2 + CVT_T >= 3 * 24576 && CVT_N0 + 3 * CVT_CYC + CVT_G1 + CVT_T >= 4 * 24576, "every layer's expert weights are converted before its first expert GEMM");
__device__ __forceinline__ void cvt_tail(const Ctx& a, int first, int rank, int per, int i0, int i1) {
    PHASE_IDS(); unsigned char* ws = a.ws();
    const int base = first + (rank * 8 + wave) * per; int g = base + i0, g1 = base + i1; if (g1 > 4 * 24576) g1 = 4 * 24576;
    f32x4 va[16], vb[16]; CvtItem ia, ib;
    if (g < g1) { cvt_expert_desc(ia, a, ws, g, lane); cvt_load(va, ia); }
    while (g < g1) {
        if (g + 1 < g1) { cvt_expert_desc(ib, a, ws, g + 1, lane); cvt_load(vb, ib); }
        cvt_store(va, ia);
        if (++g >= g1) break;
        if (g + 1 < g1) { cvt_expert_desc(ia, a, ws, g + 1, lane); cvt_load(va, ia); }
        cvt_store(vb, ib);
        ++g; }
}
template <int PER>
__device__ __forceinline__ void cvt_tail(const Ctx& a, int first, int rank) { cvt_tail(a, first, rank, PER, 0, PER); }

__device__ __forceinline__ void p0_item_desc(CvtItem& it, const Ctx& a, unsigned char* ws, int r, int lane) {
    constexpr int I_IN = 16 * 72, I_OUT = 16 * 16;
    if (r < 4 * I_IN) { const int l = r / I_IN, q = r % I_IN, kb = q / 72, nb = q % 72;

#ifdef G1_F8
        cvt_desc(it, a.in(I_WIN) + (size_t)l * D * INW, INW, (unsigned char*)(ws + WS_WIN) + (size_t)l * INW * D, D, kb * 64, nb * 64, nb * 64, lane, 1); return; }
#else
        cvt_desc(it, a.in(I_WIN) + (size_t)l * D * INW, INW, (unsigned char*)((bf16_t*)(ws + WS_WIN) + (size_t)l * INW * D), D, kb * 64, nb * 64, nb * 64, lane, 0); return; }
#endif
    r -= 4 * I_IN;
    if (r < 4 * I_OUT) { const int l = r / I_OUT, q = r % I_OUT, kb = q / 16, nb = q % 16;

#ifdef G2_F8
        cvt_desc(it, a.in(I_WOUT) + (size_t)l * D * D, D, (unsigned char*)(ws + WS_WOUT) + (size_t)l * D * D, D, kb * 64, nb * 64, nb * 64, lane, 1); return; }
#else
        cvt_desc(it, a.in(I_WOUT) + (size_t)l * D * D, D, (unsigned char*)((bf16_t*)(ws + WS_WOUT) + (size_t)l * D * D), D, kb * 64, nb * 64, nb * 64, lane, 0); return; }
#endif
    r -= 4 * I_OUT;
    cvt_expert_desc(it, a, ws, r, lane);
}
__device__ __forceinline__ void p0_prologue(const Ctx& a) {
    PHASE_IDS(); LAS unsigned char* lds = launder_lds(a.lds); unsigned char* ws = a.ws(); const float* cin_ = a.in(I_C); const float* cctx_ = a.in(I_CCTX);
    LAS float* scond = (LAS float*)(lds + 8 * 16640);
    for (int i = tid; i < 3 * D; i += 512) { const int w = i >> 10, k = i & 1023; const float cv = (w < 2) ? cin_[w * D + k] : cctx_[k]; scond[i] = cv * pg8::fast_sigmoid(cv); }
    if (blockIdx.x == 0) { const int c = tid; const float* lg = a.in(I_LBL);
        const float l0 = lg[c], l1 = lg[512 + c], l2 = lg[1024 + c], l3 = lg[1536 + c]; const float mx = fmaxf(fmaxf(l0, l1), fmaxf(l2, l3));
        const float e0 = expf(l0 - mx), e1 = expf(l1 - mx), e2 = expf(l2 - mx), e3 = expf(l3 - mx), inv = 1.0f / (e0 + e1 + e2 + e3);
        float* lbs = (float*)(ws + WS_LBS); lbs[c] = 0.f; lbs[512 + c] = e1 * inv; lbs[1024 + c] = (e1 + e2) * inv; lbs[1536 + c] = (e1 + e2 + e3) * inv; }
    if (blockIdx.x >= 1 && blockIdx.x <= 16) { const int idx = (blockIdx.x - 1) * 512 + tid, pos = idx >> 5, f = idx & 31;
        const float invf = powf(10000.0f, -(float)f / 32.0f), ang = (float)pos * invf; float* cs = (float*)(ws + WS_ROPE); cs[idx * 2] = cosf(ang); cs[idx * 2 + 1] = sinf(ang); }
    BAR_LDS();
    const int gw = blockIdx.x * 8 + wave, NGW = gridDim.x * 8;
    for (int it = gw; it < 4 * 24 * 8; it += NGW) { const int l = it / 192, r = it % 192, cg = r >> 3, ks = r & 7; const int cols = cg * 256 + lane * 4;
        const float* wp = a.in(I_WADA) + ((size_t)l * D + ks * 128) * 6144 + cols; f32x4 a0 = {0, 0, 0, 0}, a1 = a0, a2 = a0;
#pragma unroll 8
        for (int kk = 0; kk < 128; ++kk) { const f32x4 w = LDNT((const f32x4*)(wp + (size_t)kk * 6144)); const int k = ks * 128 + kk; a0 += w * scond[k]; a1 += w * scond[D + k]; a2 += w * scond[2 * D + k]; }
        float* pp = (float*)(ws + WS_MODP) + (size_t)((l * 8 + ks) * 3) * 6144 + cols; *(f32x4*)pp = a0; *(f32x4*)(pp + 6144) = a1; *(f32x4*)(pp + 2 * 6144) = a2; }
#ifdef PROBE_NOBG
    const int n_exp = 4 * 24576;
#else
    const int n_exp = (gridDim.x == 256) ? CVT_N0 : 4 * 24576;
#endif
    const int NIT = 4 * (16 * 72 + 16 * 16) + n_exp;
    f32x4 va[16], vb[16]; CvtItem ia, ib; int it = gw;
    if (it < NIT) { p0_item_desc(ia, a, ws, it, lane); cvt_load(va, ia); }
    while (it < NIT) {
        int nx = it + NGW;
        if (nx < NIT) { p0_item_desc(ib, a, ws, nx, lane); cvt_load(vb, ib); }
        cvt_store(va, ia);
        it = nx; if (it >= NIT) break;
        nx = it + NGW;
        if (nx < NIT) { p0_item_desc(ia, a, ws, nx, lane); cvt_load(va, ia); }
        cvt_store(vb, ib);
        it = nx;
    }
}

__device__ __forceinline__ void p0_finalize(const Ctx& a) {
    PHASE_IDS(); unsigned char* ws = a.ws(); const float* bada = a.in(I_BADA); const float* part = (const float*)(ws + WS_MODP); float* mods = (float*)(ws + WS_MODS);
    for (int i = blockIdx.x * 512 + tid; i < 4 * 3 * 6144; i += gridDim.x * 512) { const int l = i / (3 * 6144), r = i % (3 * 6144), w = r / 6144, j = r % 6144;
        float s = bada[l * 6144 + j];
#pragma unroll
        for (int ks = 0; ks < 8; ++ks) s += part[(size_t)((l * 8 + ks) * 3 + w) * 6144 + j];
        mods[i] = s; }
}

template <int MODE>
__device__ __forceinline__ void norm1_phase(const Ctx& a, int l) {
    PHASE_IDS(); unsigned char* ws = a.ws(); const float* in_x = a.in(I_X); const float* in_ctx = a.in(I_CTX); const float* gm = (MODE != 1) ? a.in(I_GMIX) + l * D : a.in(I_GFIN); float* outp = a.out(); const int gw = blockIdx.x * 8 + wave, NGW = gridDim.x * 8;
    const float* mods = (const float*)(ws + WS_MODS); bf16_t* X = (bf16_t*)(ws + WS_X); bf16_t* H = (bf16_t*)(ws + WS_H);
    const int* inv = (const int*)(ws + WS_INV); const unsigned char* YS = (const unsigned char*)(ws + WS_YS); const float* gate = (const float*)(ws + WS_ROWMAP) + MOE_ROWS;
    constexpr int NTOT = (MODE == 1) ? NB * SEQ : MROWS;
#define N1_ROWOF(n_) ((MODE == 1) ? (((n_) >> 14) * LTOT + CTX + ((n_) & (SEQ - 1))) : (n_))
#define N1_LOADROW(n_, v_, iv_) do { const int r_ = N1_ROWOF(n_); const int b_ = r_ >= LTOT ? 1 : 0, g_ = r_ - b_ * LTOT; \
        if (l == 0) { const float* src_ = (g_ < CTX ? in_ctx + (size_t)(b_ * CTX + g_) * D : in_x + (size_t)(b_ * SEQ + g_ - CTX) * D); \
            _Pragma("unroll") for (int j = 0; j < 4; ++j) v_[j] = LDNT((const f32x4*)(src_ + lane * 4 + 256 * j)); } \
        else { const bf16_t* src_ = X + (size_t)r_ * D; _Pragma("unroll") for (int j = 0; j < 4; ++j) { const u32x2 w_ = *(const u32x2*)(src_ + lane * 4 + 256 * j); v_[j] = (f32x4){bf_lo(w_.x), bf_hi(w_.x), bf_lo(w_.y), bf_hi(w_.y)}; } \
            iv_ = inv[r_ * 16 + (lane & 15)]; } } while (0)
    f32x4 v[4]; int iv = -1; int n = gw;
    int curw = -1; f32x4 cgs[4], csh[4], cgt[4];
#pragma unroll
    for (int j = 0; j < 4; ++j) { cgs[j] = (f32x4){0.f, 0.f, 0.f, 0.f}; csh[j] = cgs[j]; cgt[j] = cgs[j]; }
    if (n < NTOT) N1_LOADROW(n, v, iv);
    for (; n < NTOT; n += NGW) {
        const int row = N1_ROWOF(n); const int b = row >= LTOT ? 1 : 0, g = row - b * LTOT; const bool isctx = g < CTX; const int which = isctx ? 2 : b;
        if (which != curw) { curw = which;
            if (MODE != 1) { const float* sh_ = mods + (size_t)(l * 3 + which) * 6144; const float* sc_ = sh_ + D;
#pragma unroll
                for (int j = 0; j < 4; ++j) { const int c = lane * 4 + 256 * j; cgs[j] = *(const f32x4*)(gm + c) * (*(const f32x4*)(sc_ + c) + 1.0f); csh[j] = *(const f32x4*)(sh_ + c); } }
            else {
#pragma unroll
                for (int j = 0; j < 4; ++j) cgs[j] = *(const f32x4*)(gm + lane * 4 + 256 * j); }
            if (l != 0) { const float* gt2_ = mods + (size_t)((l - 1) * 3 + which) * 6144 + 5 * D;
#pragma unroll
                for (int j = 0; j < 4; ++j) cgt[j] = *(const f32x4*)(gt2_ + lane * 4 + 256 * j); } }
        f32x4 vn[4]; int ivn = -1; const int nn = n + NGW;
        if (nn < NTOT) N1_LOADROW(nn, vn, ivn);
        if (l != 0) {
            unsigned vm = (unsigned)__builtin_amdgcn_ballot_w64(iv >= 0) & 0xffffu;
            f32x4 s[4] = {{0, 0, 0, 0}, {0, 0, 0, 0}, {0, 0, 0, 0}, {0, 0, 0, 0}};
            while (vm) {
                const int e0 = __builtin_ctz(vm); vm &= vm - 1; const bool has1 = vm != 0u; const int e1 = has1 ? __builtin_ctz(vm) : e0; if (has1) vm &= vm - 1;
                const int mr0 = __builtin_amdgcn_readlane(iv, e0), mr1 = __builtin_amdgcn_readlane(iv, e1);
                const float g0 = gate[mr0] * (1.0f / pg8::F8_SY), g1 = has1 ? gate[mr1] * (1.0f / pg8::F8_SY) : 0.f;
                const unsigned char* y0r = YS + (size_t)mr0 * D + lane * 4; const unsigned char* y1r = YS + (size_t)mr1 * D + lane * 4; unsigned y0[4], y1[4];
#pragma unroll
                for (int j = 0; j < 4; ++j) { y0[j] = LDNT((const unsigned*)(y0r + 256 * j)); y1[j] = LDNT((const unsigned*)(y1r + 256 * j)); }
#pragma unroll
                for (int j = 0; j < 4; ++j) { const f32x2 a01 = __builtin_amdgcn_cvt_pk_f32_fp8((int)y0[j], false), a23 = __builtin_amdgcn_cvt_pk_f32_fp8((int)y0[j], true);
                    const f32x2 b01 = __builtin_amdgcn_cvt_pk_f32_fp8((int)y1[j], false), b23 = __builtin_amdgcn_cvt_pk_f32_fp8((int)y1[j], true);
                    s[j][0] += g0 * a01.x + g1 * b01.x; s[j][1] += g0 * a01.y + g1 * b01.y; s[j][2] += g0 * a23.x + g1 * b23.x; s[j][3] += g0 * a23.y + g1 * b23.y; } }
            bf16_t* xr = X + (size_t)row * D;
#pragma unroll
            for (int j = 0; j < 4; ++j) { v[j] += cgt[j] * s[j]; if (MODE == 0) { u32x2 w; w.x = cvt_pk_bf16(v[j][0], v[j][1]); w.y = cvt_pk_bf16(v[j][2], v[j][3]); *(u32x2*)(xr + lane * 4 + 256 * j) = w; } }
        }
        float ss = 0.f;
#pragma unroll
        for (int j = 0; j < 4; ++j) ss += (v[j][0] * v[j][0] + v[j][1] * v[j][1]) + (v[j][2] * v[j][2] + v[j][3] * v[j][3]);
        const float rinv = __builtin_amdgcn_rsqf(wave_sum(ss, lane) * (1.0f / D) + EPS);
        if (MODE != 1) {
            bf16_t* hr = H + (size_t)row * D + lane * 4;
#pragma unroll
            for (int j = 0; j < 4; ++j) { const int c = lane * 4 + 256 * j; (void)c;
                const f32x4 y = v[j] * rinv * cgs[j] + csh[j];
#ifdef G1_F8
                *(unsigned*)((unsigned char*)H + (size_t)row * D + c) = pg8::pk4_fp8(y[0] * pg8::F8_SA, y[1] * pg8::F8_SA, y[2] * pg8::F8_SA, y[3] * pg8::F8_SA); }
#else
                u32x2 w; w.x = cvt_pk_bf16(y[0], y[1]); w.y = cvt_pk_bf16(y[2], y[3]); *(u32x2*)(hr + 256 * j) = w; }
#endif
        } else {
            float* orow = outp + (size_t)(b * SEQ + g - CTX) * D + lane * 4;
#pragma unroll
            for (int j = 0; j < 4; ++j) STNT((f32x4*)(orow + 256 * j), v[j] * rinv * cgs[j]);
        }
#pragma unroll
        for (int j = 0; j < 4; ++j) v[j] = vn[j];
        iv = ivn;
    }
#undef N1_ROWOF
#undef N1_LOADROW
}

constexpr int N2_WH = 0, N2_WL = 32768, N2_CS = 65536, N2_CH = 69632, N2_CE = 73728;
typedef __bf16 bf2v __attribute__((ext_vector_type(2)));
__device__ __forceinline__ float dot2_bf16(unsigned u, float c) { const bf2v v = __builtin_bit_cast(bf2v, u); return __builtin_amdgcn_fdot2_f32_bf16(v, v, c, false); }
__device__ __forceinline__ void norm2_phase(const Ctx& a, int l) {
    PHASE_IDS(); LAS unsigned char* lds = launder_lds(a.lds); unsigned char* ws = a.ws();
    const bf16_t* X = (const bf16_t*)(ws + WS_X); unsigned char* H8 = (unsigned char*)(ws + WS_H);
    int* inv = (int*)(ws + WS_INV); float* afl = (float*)(ws + WS_AFF); float* afc = afl + 2 * 16 * SEQ;
    const bool last = (l == DEPTH - 1);
    const int NQ = last ? 2048 : 2080;
    int built = -1;
    for (int q0 = blockIdx.x * 8; q0 < NQ; q0 += gridDim.x * 8) {
        const int which = q0 < 1024 ? 0 : (q0 < 2048 ? 1 : 2);
        const int q = q0 + wave; const bool isctx = q >= 2048;
        const int b = isctx ? ((q - 2048) >> 4) : (q >> 10), g0 = isctx ? ((q - 2048) & 15) * 16 : CTX + (q & 1023) * 16;
        const int row0 = b * LTOT + g0; const int r = lane & 15, kg = lane >> 4;
        u32x4 xa[32];
        { const bf16_t* xp = X + (size_t)(row0 + r) * D + 16 * kg;
#pragma unroll
          for (int c = 0; c < 16; ++c) { xa[2 * c] = *(const u32x4*)(xp + 64 * c); xa[2 * c + 1] = *(const u32x4*)(xp + 64 * c + 8); } }
        if (which != built) {
            if (built >= 0) BAR_LDS();
            const float* wr = a.in(I_WR) + (size_t)l * D * NE; const float* gm = a.in(I_GFFN) + l * D;
            const float* sh = (const float*)(ws + WS_MODS) + (size_t)(l * 3 + which) * 6144 + 3 * D; const float* sc = sh + D;
            const int e = tid & 15; float cpart = 0.f;
#pragma unroll 1
            for (int i = 0; i < 4; ++i) { const int u = tid + 512 * i; const int s = u >> 6, kgu = (u >> 4) & 3; const int k0 = 64 * (s >> 1) + 16 * kgu + 8 * (s & 1);
                u32x4 hi4, lo4;
#pragma unroll
                for (int h = 0; h < 2; ++h) { const f32x4 gg = *(const f32x4*)(gm + k0 + 4 * h), s1 = *(const f32x4*)(sc + k0 + 4 * h), s0 = *(const f32x4*)(sh + k0 + 4 * h); const f32x4 m = gg * (s1 + 1.0f);
#pragma unroll
                    for (int jp = 0; jp < 2; ++jp) { const int j = 4 * h + 2 * jp; const float w0 = wr[(k0 + j) * 16 + e], w1 = wr[(k0 + j + 1) * 16 + e];
                        const float v0 = m[2 * jp] * w0, v1 = m[2 * jp + 1] * w1; cpart += s0[2 * jp] * w0 + s0[2 * jp + 1] * w1;
                        const unsigned ph = cvt_pk_bf16(v0, v1); const unsigned pl = cvt_pk_bf16(v0 - bf_lo(ph), v1 - bf_hi(ph));
                        hi4[2 * h + jp] = ph; lo4[2 * h + jp] = pl; } }
                *(LAS u32x4*)(lds + N2_WH + u * 16) = hi4; *(LAS u32x4*)(lds + N2_WL + u * 16) = lo4; }
            cpart += shx(cpart, 16, lane); cpart += shx(cpart, 32, lane);
            if (lane < 16) ((LAS float*)(lds + N2_CE))[wave * 16 + lane] = cpart;
            if (tid < 256) { const int k = tid * 4; const f32x4 gg = *(const f32x4*)(gm + k), s1 = *(const f32x4*)(sc + k), s0 = *(const f32x4*)(sh + k);
                *(LAS f32x4*)(lds + N2_CS + k * 4) = gg * (s1 + 1.0f) * pg8::F8_SA; *(LAS f32x4*)(lds + N2_CH + k * 4) = s0 * pg8::F8_SA; }
            BAR_LDS(); built = which;
        }
        f32x4 acc = {0.f, 0.f, 0.f, 0.f}; float ss = 0.f;
#pragma unroll
        for (int s = 0; s < 32; ++s) {
            const bf16x8 wh = *(const LAS bf16x8*)(lds + N2_WH + (s * 64 + lane) * 16), wl = *(const LAS bf16x8*)(lds + N2_WL + (s * 64 + lane) * 16);
            const bf16x8 xf = __builtin_bit_cast(bf16x8, xa[s]);
            acc = __builtin_amdgcn_mfma_f32_16x16x32_bf16(wh, xf, acc, 0, 0, 0); acc = __builtin_amdgcn_mfma_f32_16x16x32_bf16(wl, xf, acc, 0, 0, 0);
            ss = dot2_bf16(xa[s][0], ss); ss = dot2_bf16(xa[s][1], ss); ss = dot2_bf16(xa[s][2], ss); ss = dot2_bf16(xa[s][3], ss);
            if ((s & 3) == 3) __builtin_amdgcn_sched_barrier(0); }
        ss += shx(ss, 16, lane); ss += shx(ss, 32, lane);
        const float rinv = __builtin_amdgcn_rsqf(ss * (1.0f / D) + EPS);
        {
            f32x4 ce = {0.f, 0.f, 0.f, 0.f};
#pragma unroll
            for (int w = 0; w < 8; ++w) ce += *(const LAS f32x4*)(lds + N2_CE + (w * 16 + 4 * kg) * 4);
            const f32x4 lg = acc * rinv + ce;
            float mx = fmaxf(fmaxf(lg[0], lg[1]), fmaxf(lg[2], lg[3])); mx = fmaxf(mx, shx(mx, 16, lane)); mx = fmaxf(mx, shx(mx, 32, lane));
            f32x4 ex; ex[0] = expf(lg[0] - mx); ex[1] = expf(lg[1] - mx); ex[2] = expf(lg[2] - mx); ex[3] = expf(lg[3] - mx);
            float sm = (ex[0] + ex[1]) + (ex[2] + ex[3]); sm += shx(sm, 16, lane); sm += shx(sm, 32, lane);
            float* dst = isctx ? afc + (size_t)(b * 16 + 4 * kg) * CTX + g0 + r : afl + (size_t)(b * 16 + 4 * kg) * SEQ + (g0 - CTX) + r; const int estr = isctx ? CTX : SEQ;
#pragma unroll
            for (int j = 0; j < 4; ++j) dst[(size_t)j * estr] = ex[j] / sm; }
        { typedef int i32x4 __attribute__((ext_vector_type(4))); int m1 = -1; asm volatile("" : "+v"(m1)); *(i32x4*)(inv + (size_t)row0 * 16 + lane * 4) = (i32x4){m1, m1, m1, m1}; }
        unsigned char* hp = H8 + (size_t)(row0 + r) * D + 16 * kg;
#pragma unroll
        for (int c = 0; c < 16; ++c) { const LAS f32x4* cs = (const LAS f32x4*)(lds + N2_CS + (64 * c + 16 * kg) * 4); const LAS f32x4* ch = (const LAS f32x4*)(lds + N2_CH + (64 * c + 16 * kg) * 4);
            u32x4 o;
#pragma unroll
            for (int h = 0; h < 4; ++h) { const unsigned w0 = xa[2 * c + (h >> 1)][2 * (h & 1)], w1 = xa[2 * c + (h >> 1)][2 * (h & 1) + 1];
                const f32x4 xv = {bf_lo(w0), bf_hi(w0), bf_lo(w1), bf_hi(w1)}; const f32x4 y = xv * rinv * cs[h] + ch[h]; o[h] = pg8::pk4_fp8(y[0], y[1], y[2], y[3]); }
            *(u32x4*)(hp + 64 * c) = o;
            if ((c & 1) == 1) __builtin_amdgcn_sched_barrier(0); }
    }
}

__device__ __forceinline__ void topk_phase(const Ctx& a, int l) {
    PHASE_IDS(); LAS unsigned char* lds = launder_lds(a.lds); unsigned char* ws = a.ws(); const float* afl = (const float*)(ws + WS_AFF); const float* afc = afl + 2 * 16 * SEQ;
    int* rowmap = (int*)(ws + WS_ROWMAP); float* gate = (float*)(ws + WS_ROWMAP) + MOE_ROWS; int* inv = (int*)(ws + WS_INV);
    LAS unsigned* wcnt = (LAS unsigned*)lds;
    const int nitems = (l == DEPTH - 1) ? 32 : 64;
    for (int it = blockIdx.x; it < nitems; it += gridDim.x) {
        const bool isctx = it >= 32; const int be = it & 31, b = be >> 4, e = be & 15;
        const int n = isctx ? CTX : SEQ, k = isctx ? CAP_CTX : CAP_LAT;
        const float* src = isctx ? afc + be * CTX : afl + (size_t)be * SEQ;
        unsigned key[32];
#pragma unroll
        for (int i = 0; i < 32; ++i) { const int idx = i * 512 + tid; key[i] = idx < n ? __float_as_uint(src[idx]) : 0u; }
        unsigned T = 0u;
        for (int bit = 30; bit >= 0; --bit) { const unsigned cand = T | (1u << bit); unsigned cnt = 0;
#pragma unroll
            for (int i = 0; i < 32; ++i) cnt += (key[i] >= cand) ? 1u : 0u;
#pragma unroll
            for (int o = 1; o < 64; o <<= 1) cnt += shxu(cnt, o, lane);
            LAS unsigned* wc = wcnt + (bit & 1) * 8; if (lane == 0) wc[wave] = cnt;
            BAR_LDS();
            unsigned tot = 0;
#pragma unroll
            for (int w = 0; w < 8; ++w) tot += wc[w];
            if (tot >= (unsigned)k) T = cand; }
        unsigned mine = 0;
#pragma unroll
        for (int i = 0; i < 32; ++i) mine += (key[i] > T ? 1u : 0u) + (key[i] == T ? 65536u : 0u);
        unsigned incl = mine;
#pragma unroll
        for (int o = 1; o < 64; o <<= 1) { const unsigned t = shupu(incl, o, lane); if (lane >= o) incl += t; }
        LAS unsigned* wt = wcnt + 16; BAR_LDS();
        if (lane == 63) wt[wave] = incl;
        BAR_LDS();
        unsigned base = 0, total = 0;
#pragma unroll
        for (int w = 0; w < 8; ++w) { const unsigned t = wt[w]; total += t; if (w < wave) base += t; }
        const unsigned excl = base + incl - mine; const unsigned cgt = total & 0xffffu; const unsigned need = (unsigned)k - cgt;
        unsigned sg = excl & 0xffffu, se = excl >> 16;
        const int mrbase = e * MOE_ROWS_E + (isctx ? 4096 + b * CAP_CTX : b * CAP_LAT);
        const int rbase = b * LTOT + (isctx ? 0 : CTX);
#pragma unroll
        for (int i = 0; i < 32; ++i) { const int idx = i * 512 + tid; const unsigned kk = key[i]; int slot = -1;
            if (kk > T) { slot = (int)sg; ++sg; } else if (kk == T) { if (se < need) slot = (int)(cgt + se); ++se; }
            if (slot >= 0) { const int mr = mrbase + slot, r = rbase + idx; rowmap[mr] = r; gate[mr] = __uint_as_float(kk); inv[r * 16 + e] = mr; } }
        if (isctx && b == 0 && tid < 192) { const int mr = e * MOE_ROWS_E + 4160 + tid; rowmap[mr] = 0; gate[mr] = 0.f; }
        BAR_LDS();
    }
}


constexpr int SC_QI = 0, SC_KI = 16384, SC_KT = 32768, SC_VT = 49152, SC_PI = 65536, SC_SM = 73728, SC_PART = 106496, SC_VA = 110592, SC_VB = 111104, SC_VM = 111616, SC_RED = 112128;
__device__ __forceinline__ int st_off(int r, int cbytes, int ncs) { return ((r >> 4) * ncs + (cbytes >> 6)) * 1024 + (r & 15) * 64 + ((cbytes & 63) ^ ((r & 8) << 2)); }
__device__ __forceinline__ int st_lane(int fr, int fq) { return fr * 64 + ((fq * 16) ^ ((fr & 8) << 2)); }
struct ScanBufs { int kt, vt, part, va, vb, vm; };
__device__ __forceinline__ ScanBufs scan_bufs(int parity) { ScanBufs b; b.kt = parity ? SC_QI : SC_KT; b.vt = parity ? SC_KI : SC_VT; b.part = parity ? SC_PI : SC_PART; b.va = parity ? SC_PI + 4096 : SC_VA; b.vb = parity ? SC_PI + 4608 : SC_VB; b.vm = parity ? SC_PI + 5120 : SC_VM; return b; }

__device__ __forceinline__ bf16x8 ldfrag(const LAS unsigned char* img, int tile, int ks, int ncs, int lp) { return *(const LAS bf16x8*)(img + (tile * ncs + ks) * 1024 + lp); }
#define MFMA16(a, b, c) __builtin_amdgcn_mfma_f32_16x16x32_bf16((a), (b), (c), 0, 0, 0)
#ifndef SCAN_LOG2
__device__ __forceinline__ float ex2(float x) { return __builtin_amdgcn_exp2f(x * 1.4426950408889634f); }
#define LOG2E_ 1.0f
#else
__device__ __forceinline__ float ex2(float x) { return __builtin_amdgcn_exp2f(x); }
#define LOG2E_ 1.4426950408889634f
#endif

__device__ __forceinline__ void scan_write_T(LAS unsigned char* img, const unsigned (&d)[8], int cp, int to) {
    u32x4 wa, wb;
    wa.x = (d[0] & 0xffffu) | (d[1] << 16); wa.y = (d[2] & 0xffffu) | (d[3] << 16); wa.z = (d[4] & 0xffffu) | (d[5] << 16); wa.w = (d[6] & 0xffffu) | (d[7] << 16);
    wb.x = (d[0] >> 16) | (d[1] & 0xffff0000u); wb.y = (d[2] >> 16) | (d[3] & 0xffff0000u); wb.z = (d[4] >> 16) | (d[5] & 0xffff0000u); wb.w = (d[6] >> 16) | (d[7] & 0xffff0000u);
    *(LAS u32x4*)(img + st_off(2 * cp, to * 16, 2)) = wa; *(LAS u32x4*)(img + st_off(2 * cp + 1, to * 16, 2)) = wb;
}

template <bool FULL>
__device__ __forceinline__ void scan_estage_hg(LAS unsigned char* lds, const ScanBufs& B, const unsigned (&kraw)[8], const unsigned (&qraw)[8], const unsigned (&vraw)[8], int lane, int wave, float& la_out, float& lb_out) {
    const int cp = lane, to = wave;
#ifndef SCAN_LOG2
    constexpr float LS = 1.4426950408889634f;
#else
    constexpr float LS = 1.0f;
#endif
    f32x2 c2[8]; f32x2 r2 = {0.f, 0.f};
#pragma unroll
    for (int tt = 0; tt < 8; ++tt) { r2 += (f32x2){bf_lo(kraw[tt]), bf_hi(kraw[tt])}; c2[tt] = r2; }
    *(LAS f32x2*)(lds + B.part + (to * 128 + 2 * cp) * 4) = r2;
    BAR_LDS();
    f32x2 p2 = {0.f, 0.f}, m2 = {0.f, 0.f}, l2 = {0.f, 0.f};
#pragma unroll
    for (int t8 = 0; t8 < 8; ++t8) { const f32x2 pp = *(const LAS f32x2*)(lds + B.part + (t8 * 128 + 2 * cp) * 4);
        if (t8 < to) p2 += pp; if (t8 < 4) m2 += pp; l2 += pp; }
    p2 = (p2 - m2) * LS;
    unsigned kd[8];
#pragma unroll
    for (int tt = 0; tt < 8; ++tt) { const int rr = 8 * to + tt;
        f32x2 d2 = p2 + c2[tt] * LS;
        d2 = __builtin_elementwise_min(__builtin_elementwise_max(d2, (f32x2){-120.f, -120.f}), (f32x2){120.f, 120.f});
        const f32x2 lf2 = (f32x2){bf_lo(kraw[tt]), bf_hi(kraw[tt])} * LS;
        const f32x2 k2 = (f32x2){1.0f, 1.0f} - (f32x2){__builtin_amdgcn_exp2f(lf2.x), __builtin_amdgcn_exp2f(lf2.y)};
        const f32x2 kt2 = k2 * (f32x2){__builtin_amdgcn_exp2f(-d2.x), __builtin_amdgcn_exp2f(-d2.y)};
        kd[tt] = cvt_pk_bf16(kt2.x, kt2.y);
        if (FULL) { const f32x2 qt2 = (f32x2){bf_lo(qraw[tt]), bf_hi(qraw[tt])} * (f32x2){__builtin_amdgcn_exp2f(d2.x), __builtin_amdgcn_exp2f(d2.y)};
            *(LAS unsigned*)(lds + SC_QI + st_off(rr, cp * 4, 4)) = cvt_pk_bf16(qt2.x, qt2.y);
            *(LAS unsigned*)(lds + SC_KI + st_off(rr, cp * 4, 4)) = kd[tt]; } }
    scan_write_T(lds + B.kt, kd, cp, to); scan_write_T(lds + B.vt, vraw, cp, to);
    if (to == 0) { *(LAS f32x2*)(lds + B.va + 8 * cp) = (f32x2){ex2(l2.x), ex2(l2.y)}; *(LAS f32x2*)(lds + B.vb + 8 * cp) = (f32x2){ex2(l2.x - m2.x), ex2(l2.y - m2.y)};
        *(LAS f32x2*)(lds + B.vm + 8 * cp) = (f32x2){ex2(m2.x), ex2(m2.y)}; }
    la_out = l2.x; lb_out = l2.y;
}
template <bool FULL>
__device__ __forceinline__ void scan_estage_ret(LAS unsigned char* lds, const ScanBufs& B, const unsigned (&kraw)[8], const unsigned (&qraw)[8], const unsigned (&vraw)[8], int lane, int wave, float lg2) {
    const int cp = lane, to = wave; unsigned kd[8];
#pragma unroll
    for (int tt = 0; tt < 8; ++tt) { const int rr = 8 * to + tt; const float wk = ex2((float)(63 - rr) * lg2); kd[tt] = cvt_pk_bf16(bf_lo(kraw[tt]) * wk, bf_hi(kraw[tt]) * wk);
        if (FULL) { *(LAS unsigned*)(lds + SC_QI + st_off(rr, cp * 4, 4)) = qraw[tt]; *(LAS unsigned*)(lds + SC_KI + st_off(rr, cp * 4, 4)) = kraw[tt]; } }
    scan_write_T(lds + B.kt, kd, cp, to); scan_write_T(lds + B.vt, vraw, cp, to);
}

template <bool RET>
__device__ __forceinline__ void scan_state_update(LAS unsigned char* lds, const ScanBufs& B, f32x4 (&ST)[8], int wave, int fr, int fq, float g64) {
    const int lp = st_lane(fr, fq);
    const bf16x8 a0 = ldfrag(lds + B.kt, wave, 0, 2, lp), a1 = ldfrag(lds + B.kt, wave, 1, 2, lp);
    f32x4 av = {g64, g64, g64, g64}, bv = {1.f, 1.f, 1.f, 1.f};
    if (!RET) { av = *(const LAS f32x4*)(lds + B.va + (16 * wave + 4 * fq) * 4); bv = *(const LAS f32x4*)(lds + B.vb + (16 * wave + 4 * fq) * 4); }
#pragma unroll
    for (int vi = 0; vi < 8; ++vi) { const bf16x8 b0 = ldfrag(lds + B.vt, vi, 0, 2, lp), b1 = ldfrag(lds + B.vt, vi, 1, 2, lp);
        f32x4 u = {0.f, 0.f, 0.f, 0.f}; u = MFMA16(a0, b0, u); u = MFMA16(a1, b1, u); ST[vi] = RET ? (av * ST[vi] + u) : (av * ST[vi] + bv * u); }
}

#define SCAN_LOAD_CHUNK(crow_, dir_) do { _Pragma("unroll") for (int tt = 0; tt < 8; ++tt) { const int rr_ = 8 * wave + tt; const size_t ro_ = (size_t)((crow_) + ((dir_) ? 63 - rr_ : rr_)) * INW + 2 * lane; \
        kraw[tt] = *(const unsigned*)(P + ro_ + colk); vraw[tt] = *(const unsigned*)(P + ro_ + colv); if (LOADQ) qraw[tt] = *(const unsigned*)(P + ro_ + colq); } } while (0)
#define SCAN_STORE_STATE(slot_) do { _Pragma("unroll") for (int vi = 0; vi < 8; ++vi) { u32x2 w; w.x = cvt_pk_bf16(ST[vi][0], ST[vi][1]); w.y = cvt_pk_bf16(ST[vi][2], ST[vi][3]); \
        *(u32x2*)(UB + (size_t)(slot_) * 16384 + (size_t)(vi * 512 + tid) * 4) = w; } } while (0)

struct ScanPtrs { const bf16_t* P; const bf16_t* SB; bf16_t* UB; float* AB; bf16_t* MIX; float* OB; const float* rdec; const float* onorm; };

__device__ __forceinline__ void scan1_hg_A(LAS unsigned char* lds, const ScanBufs& B, const unsigned (&kraw)[8], f32x2 (&c2)[8], int lane, int wave) {
    f32x2 r2 = {0.f, 0.f};
#pragma unroll
    for (int tt = 0; tt < 8; ++tt) { r2 += (f32x2){bf_lo(kraw[tt]), bf_hi(kraw[tt])}; c2[tt] = r2; }
    *(LAS f32x2*)(lds + B.part + (wave * 128 + 2 * lane) * 4) = r2;
}
__device__ __forceinline__ void scan1_hg_B(LAS unsigned char* lds, const ScanBufs& B, const unsigned (&kraw)[8], const unsigned (&vraw)[8], const f32x2 (&c2)[8], int lane, int wave, float& la_out, float& lb_out) {
    const int cp = lane, to = wave;
#ifndef SCAN_LOG2
    constexpr float LS = 1.4426950408889634f;
#else
    constexpr float LS = 1.0f;
#endif
    f32x2 p2 = {0.f, 0.f}, m2 = {0.f, 0.f}, l2 = {0.f, 0.f};
#pragma unroll
    for (int t8 = 0; t8 < 8; ++t8) { const f32x2 pp = *(const LAS f32x2*)(lds + B.part + (t8 * 128 + 2 * cp) * 4);
        if (t8 < to) p2 += pp; if (t8 < 4) m2 += pp; l2 += pp; }
    p2 = (p2 - m2) * LS;
    unsigned kd[8];
#pragma unroll
    for (int tt = 0; tt < 8; ++tt) {
        f32x2 d2 = p2 + c2[tt] * LS;
        d2 = __builtin_elementwise_min(__builtin_elementwise_max(d2, (f32x2){-120.f, -120.f}), (f32x2){120.f, 120.f});
        const f32x2 lf2 = (f32x2){bf_lo(kraw[tt]), bf_hi(kraw[tt])} * LS;
        const f32x2 k2 = (f32x2){1.0f, 1.0f} - (f32x2){__builtin_amdgcn_exp2f(lf2.x), __builtin_amdgcn_exp2f(lf2.y)};
        const f32x2 kt2 = k2 * (f32x2){__builtin_amdgcn_exp2f(-d2.x), __builtin_amdgcn_exp2f(-d2.y)};
        kd[tt] = cvt_pk_bf16(kt2.x, kt2.y); }
    scan_write_T(lds + B.kt, kd, cp, to); scan_write_T(lds + B.vt, vraw, cp, to);
    if (to == 0) { *(LAS f32x2*)(lds + B.va + 8 * cp) = (f32x2){ex2(l2.x), ex2(l2.y)}; *(LAS f32x2*)(lds + B.vb + 8 * cp) = (f32x2){ex2(l2.x - m2.x), ex2(l2.y - m2.y)}; }
    la_out = l2.x; lb_out = l2.y;
}
template <bool RET>
__device__ __forceinline__ void scan1_item(const ScanPtrs& sp, LAS unsigned char* lds, int tid, int lane, int wave, int seq, int tb) {
    const bf16_t* P = sp.P; bf16_t* UB = sp.UB; const int fr = lane & 15, fq = lane >> 4;
    const int b = seq >> 4, hh = (seq >> 1) & 7, dir = seq & 1, h = hh & 3;
    const int colk = RET ? 6 * 512 + h * 128 : (dir ? 2 * 512 : 512) + h * 128, colv = (RET ? 7 * 512 : 3 * 512) + h * 128;
    const float lg2 = RET ? -expf(sp.rdec[dir * 4 + h]) * LOG2E_ : 0.f, g64 = ex2(64.f * lg2);
    const int rowbase = b * LTOT + tb * 256;
    f32x4 ST[8];
#pragma unroll
    for (int vi = 0; vi < 8; ++vi) ST[vi] = (f32x4){0.f, 0.f, 0.f, 0.f};
    float ata = 0.f, atb = 0.f; unsigned kr[3][8], vr[3][8], qdummy[8]; f32x2 c2[2][8];
#pragma unroll
    for (int tt = 0; tt < 8; ++tt) qdummy[tt] = 0u;
#define S1_LOAD(set_, ci_) do { const int crow_ = rowbase + (dir ? 3 - (ci_) : (ci_)) * 64; _Pragma("unroll") for (int tt = 0; tt < 8; ++tt) { const int rr_ = 8 * wave + tt; const size_t ro_ = (size_t)(crow_ + (dir ? 63 - rr_ : rr_)) * INW + 2 * lane; \
        kr[set_][tt] = *(const unsigned*)(P + ro_ + colk); vr[set_][tt] = *(const unsigned*)(P + ro_ + colv); } } while (0)
#define S1_A(ci_) do { if (!RET) scan1_hg_A(lds, scan_bufs((ci_) & 1), kr[(ci_) % 3], c2[(ci_) & 1], lane, wave); } while (0)
#define S1_B(ci_) do { const ScanBufs B_ = scan_bufs((ci_) & 1); if (RET) scan_estage_ret<false>(lds, B_, kr[(ci_) % 3], qdummy, vr[(ci_) % 3], lane, wave, lg2); \
        else { float la_, lb_; scan1_hg_B(lds, B_, kr[(ci_) % 3], vr[(ci_) % 3], c2[(ci_) & 1], lane, wave, la_, lb_); ata += la_; atb += lb_; } } while (0)
#define S1_U(ci_) scan_state_update<RET>(lds, scan_bufs((ci_) & 1), ST, wave, fr, fq, g64)
    S1_LOAD(0, 0); S1_LOAD(1, 1); S1_LOAD(2, 2);
    S1_A(0);                         BAR_LDS();
    S1_B(0); S1_LOAD(0, 3); S1_A(1); BAR_LDS();
    S1_U(0); S1_B(1); S1_A(2);       BAR_LDS();
    S1_U(1); S1_B(2); S1_A(3);       BAR_LDS();
    S1_U(2); S1_B(3);                BAR_LDS();
    S1_U(3);
#undef S1_LOAD
#undef S1_A
#undef S1_B
#undef S1_U
    const int slot = seq * 65 + tb;
    SCAN_STORE_STATE(slot);
    if (wave == 0) *(f32x2*)(sp.AB + (size_t)slot * 128 + 2 * lane) = RET ? (f32x2){ex2(256.f * lg2), ex2(256.f * lg2)} : (f32x2){ex2(ata), ex2(atb)};
}

template <bool RET>
__device__ __forceinline__ void scan3_item(const ScanPtrs& sp, LAS unsigned char* lds, int tid, int lane, int wave, int bh, int tb, bool store_state, int nch = 4) {
#ifdef PROBE_SKIP
    if ((PROBE_SKIP == 1 && RET) || (PROBE_SKIP == 2 && !RET)) return;
#endif
    const bf16_t* P = sp.P; bf16_t* UB = sp.UB; float* OB = sp.OB;
    const int ti = wave & 3, vh = wave >> 2; constexpr bool LOADQ = true;
    const int b = bh >> 3, hh = bh & 7, h = hh & 3;
    const int colq = (RET ? 5 * 512 : 0) + h * 128, colv = (RET ? 7 * 512 : 3 * 512) + h * 128, colg = (RET ? 8 * 512 : 4 * 512) + h * 128, mixcol = hh * 128;
    const int rowbase = b * LTOT + tb * 256;
#pragma unroll 1
    for (int dir = 1; dir >= 0; --dir) {
        const int colk = RET ? 6 * 512 + h * 128 : (dir ? 2 * 512 : 512) + h * 128;
        const float lg2 = RET ? -expf(sp.rdec[dir * 4 + h]) * LOG2E_ : 0.f, g64 = ex2(64.f * lg2);
        f32x4 ST[8];
        if (tb == 0) {
#pragma unroll
            for (int vi = 0; vi < 8; ++vi) ST[vi] = (f32x4){0.f, 0.f, 0.f, 0.f};
        } else { const size_t slot = (size_t)(bh * 2 + dir) * 65 + tb + ((nch == 8 && dir) ? 1 : 0);
#pragma unroll
            for (int vi = 0; vi < 8; ++vi) { const u32x2 w = LDNT((const u32x2*)(sp.SB + slot * 16384 + (size_t)(vi * 512 + tid) * 4)); ST[vi] = (f32x4){bf_lo(w.x), bf_hi(w.x), bf_lo(w.y), bf_hi(w.y)}; } }
        float ata = 0.f, atb = 0.f; unsigned kraw[8], qraw[8], vraw[8];
        SCAN_LOAD_CHUNK(rowbase + (dir ? nch - 1 : 0) * 64, dir);
#pragma unroll 1
        for (int ci = 0; ci < nch; ++ci) {
            const int tc = dir ? nch - 1 - ci : ci;
            int lane_ = lane; asm volatile("" : "+v"(lane_));
            const int fr = lane_ & 15, fq = lane_ >> 4, t = 16 * ti + fr; const float gt1 = ex2((float)(t + 1) * lg2);
            const ScanBufs B0 = scan_bufs(0);
            if (RET) scan_estage_ret<true>(lds, B0, kraw, qraw, vraw, lane, wave, lg2);
            else { float la, lb; scan_estage_hg<true>(lds, B0, kraw, qraw, vraw, lane, wave, la, lb); ata += la; atb += lb; }
#ifdef PROBE_S3_E2
            BAR_LDS();
            if (RET) scan_estage_ret<true>(lds, B0, kraw, qraw, vraw, lane, wave, lg2);
            else { float la, lb; scan_estage_hg<true>(lds, B0, kraw, qraw, vraw, lane, wave, la, lb); }
#endif
            if (ci < nch - 1) { const int tcn = dir ? nch - 2 - ci : ci + 1; SCAN_LOAD_CHUNK(rowbase + tcn * 64, dir); }
            const int tok = tc * 64 + (dir ? 63 - t : t), grow = rowbase + tok;
            u32x2 obv[4]; u32x2 gv[4];
            if (dir == 0) {
#pragma unroll
                for (int j = 0; j < 4; ++j) gv[j] = *(const u32x2*)(P + (size_t)grow * INW + colg + 16 * (4 * vh + j) + 4 * fq);
#pragma unroll
                for (int jp = 0; jp < 2; ++jp) { const u32x4 w4 = *((const u32x4*)OB + ((((tc * 4 + ti) * 2 + vh) * 2 + jp) * 64 + fq * 16 + fr)); obv[2 * jp] = (u32x2){w4.x, w4.y}; obv[2 * jp + 1] = (u32x2){w4.z, w4.w}; } }
            if (!RET) BAR_LDS();
            { f32x4 em = {1.f, 1.f, 1.f, 1.f}; if (!RET) em = *(const LAS f32x4*)(lds + SC_VM + (16 * wave + 4 * fq) * 4);
#pragma unroll
              for (int vi = 0; vi < 8; ++vi) { const f32x4 x = RET ? ST[vi] : ST[vi] * em; u32x2 w; w.x = cvt_pk_bf16(x[0], x[1]); w.y = cvt_pk_bf16(x[2], x[3]); *(LAS u32x2*)(lds + SC_SM + st_off(16 * vi + fr, 32 * wave + 8 * fq, 4)) = w; } }
            if (RET) BAR_LDS();
#pragma unroll
            for (int sii = 0; sii < 2; ++sii) { const int si = 2 * vh + sii; f32x4 sc = {0.f, 0.f, 0.f, 0.f};
                if (si <= ti) {
#pragma unroll
                    for (int ks = 0; ks < 4; ++ks) sc = MFMA16(ldfrag(lds + SC_KI, si, ks, 4, st_lane(fr, fq)), ldfrag(lds + SC_QI, ti, ks, 4, st_lane(fr, fq)), sc);
                    const int s0 = 16 * si + 4 * fq;
#pragma unroll
                    for (int r = 0; r < 4; ++r) { const float dm = RET ? ex2((float)(t - s0 - r) * lg2) : 1.0f; sc[r] = (s0 + r <= t) ? sc[r] * dm : 0.f; } }
                u32x2 w; w.x = cvt_pk_bf16(sc[0], sc[1]); w.y = cvt_pk_bf16(sc[2], sc[3]); *(LAS u32x2*)(lds + SC_PI + st_off(t, 32 * si + 8 * fq, 2)) = w; }
            BAR_LDS();
            f32x4 o[4];
#pragma unroll
            for (int j = 0; j < 4; ++j) o[j] = (f32x4){0.f, 0.f, 0.f, 0.f};
            {
                const int lp = st_lane(fr, fq);
                const LAS unsigned char* pq = lds + SC_QI + (ti * 4) * 1024 + lp;
                const LAS unsigned char* pm = lds + SC_SM + (4 * vh * 4) * 1024 + lp;
                const LAS unsigned char* pp = lds + SC_PI + (ti * 2) * 1024 + lp;
                const LAS unsigned char* pv = lds + SC_VT + (4 * vh * 2) * 1024 + lp;
                const LAS unsigned char* pk = lds + SC_KT + (wave * 2) * 1024 + lp;
                const LAS unsigned char* pw = lds + SC_VT + lp;
                f32x4 av = {g64, g64, g64, g64}, bv = {1.f, 1.f, 1.f, 1.f};
                if (!RET) { av = *(const LAS f32x4*)(lds + SC_VA + (16 * wave + 4 * fq) * 4); bv = *(const LAS f32x4*)(lds + SC_VB + (16 * wave + 4 * fq) * 4); }
#define SC_LD(p_, off_) (*(const LAS bf16x8*)((p_) + (off_)))
#define SC_FENCE() __builtin_amdgcn_sched_barrier(0)
                bf16x8 qa, ma[4], qb, mb[4], qc, mc[4];
                qa = SC_LD(pq, 0); _Pragma("unroll") for (int j = 0; j < 4; ++j) ma[j] = SC_LD(pm, 4096 * j);
                qb = SC_LD(pq, 1024); _Pragma("unroll") for (int j = 0; j < 4; ++j) mb[j] = SC_LD(pm, 4096 * j + 1024);
                SC_FENCE();
                qc = SC_LD(pq, 2048); _Pragma("unroll") for (int j = 0; j < 4; ++j) mc[j] = SC_LD(pm, 4096 * j + 2048);
                _Pragma("unroll") for (int j = 0; j < 4; ++j) o[j] = MFMA16(ma[j], qa, o[j]);
                SC_FENCE();
                qa = SC_LD(pq, 3072); _Pragma("unroll") for (int j = 0; j < 4; ++j) ma[j] = SC_LD(pm, 4096 * j + 3072);
                _Pragma("unroll") for (int j = 0; j < 4; ++j) o[j] = MFMA16(mb[j], qb, o[j]);
                SC_FENCE();
                qb = SC_LD(pp, 0); _Pragma("unroll") for (int j = 0; j < 4; ++j) mb[j] = SC_LD(pv, 2048 * j);
                _Pragma("unroll") for (int j = 0; j < 4; ++j) o[j] = MFMA16(mc[j], qc, o[j]);
                SC_FENCE();
                qc = SC_LD(pp, 1024); _Pragma("unroll") for (int j = 0; j < 4; ++j) mc[j] = SC_LD(pv, 2048 * j + 1024);
                _Pragma("unroll") for (int j = 0; j < 4; ++j) o[j] = MFMA16(ma[j], qa, o[j]);
                SC_FENCE();
                if (RET) { _Pragma("unroll") for (int j = 0; j < 4; ++j) o[j] *= gt1; }
                bf16x8 k0 = SC_LD(pk, 0), k1 = SC_LD(pk, 1024), w0[4], w1[4];
                _Pragma("unroll") for (int q = 0; q < 2; ++q) { w0[q] = SC_LD(pw, 2048 * q); w1[q] = SC_LD(pw, 2048 * q + 1024); }
                _Pragma("unroll") for (int j = 0; j < 4; ++j) o[j] = MFMA16(mb[j], qb, o[j]);
                SC_FENCE();
                _Pragma("unroll") for (int q = 2; q < 4; ++q) { w0[q] = SC_LD(pw, 2048 * q); w1[q] = SC_LD(pw, 2048 * q + 1024); }
                _Pragma("unroll") for (int j = 0; j < 4; ++j) o[j] = MFMA16(mc[j], qc, o[j]);
                SC_FENCE();
                bf16x8 x0[4], x1[4];
                _Pragma("unroll") for (int q = 0; q < 4; ++q) { x0[q] = SC_LD(pw, 2048 * (4 + q)); x1[q] = SC_LD(pw, 2048 * (4 + q) + 1024); }
                _Pragma("unroll") for (int q = 0; q < 4; ++q) { f32x4 u = {0.f, 0.f, 0.f, 0.f}; u = MFMA16(k0, w0[q], u); u = MFMA16(k1, w1[q], u); ST[q] = RET ? (av * ST[q] + u) : (av * ST[q] + bv * u); }
                SC_FENCE();
                _Pragma("unroll") for (int q = 0; q < 4; ++q) { f32x4 u = {0.f, 0.f, 0.f, 0.f}; u = MFMA16(k0, x0[q], u); u = MFMA16(k1, x1[q], u); ST[4 + q] = RET ? (av * ST[4 + q] + u) : (av * ST[4 + q] + bv * u); }
#undef SC_LD
#undef SC_FENCE
            }
            if (dir == 1) {
#pragma unroll
                for (int jp = 0; jp < 2; ++jp) { u32x4 w4; w4.x = cvt_pk_bf16(o[2 * jp][0], o[2 * jp][1]); w4.y = cvt_pk_bf16(o[2 * jp][2], o[2 * jp][3]); w4.z = cvt_pk_bf16(o[2 * jp + 1][0], o[2 * jp + 1][1]); w4.w = cvt_pk_bf16(o[2 * jp + 1][2], o[2 * jp + 1][3]); *((u32x4*)OB + ((((tc * 4 + (3 - ti)) * 2 + vh) * 2 + jp) * 64 + fq * 16 + (15 - fr))) = w4; }
                BAR_LDS();
            } else {
                float ss = 0.f;
#pragma unroll
                for (int j = 0; j < 4; ++j) { o[j] += (f32x4){bf_lo(obv[j].x), bf_hi(obv[j].x), bf_lo(obv[j].y), bf_hi(obv[j].y)}; ss += (o[j][0] * o[j][0] + o[j][1] * o[j][1]) + (o[j][2] * o[j][2] + o[j][3] * o[j][3]); }
                ss += shx(ss, 16, lane_); ss += shx(ss, 32, lane_);
                if (fq == 0) *(LAS float*)(lds + SC_RED + ((ci & 1) * 128 + vh * 64 + t) * 4) = ss;
                BAR_LDS();
                const float tot = ss + *(const LAS float*)(lds + SC_RED + ((ci & 1) * 128 + (vh ^ 1) * 64 + t) * 4);
                const float rinv = __builtin_amdgcn_rsqf(tot * (1.0f / 128.0f) + EPS);
#pragma unroll
                for (int j = 0; j < 4; ++j) { const f32x4 onv = RET ? (f32x4){1.f, 1.f, 1.f, 1.f} : *(const f32x4*)(sp.onorm + 16 * (4 * vh + j) + 4 * fq);
                    const f32x4 y = o[j] * rinv * onv * (f32x4){bf_lo(gv[j].x), bf_hi(gv[j].x), bf_lo(gv[j].y), bf_hi(gv[j].y)};
                    u32x2 w; w.x = cvt_pk_bf16(y[0], y[1]); w.y = cvt_pk_bf16(y[2], y[3]); *(u32x2*)(sp.MIX + (size_t)grow * D + mixcol + 16 * (4 * vh + j) + 4 * fq) = w; }
#ifdef PROBE_BAR
                BAR_LDS();
#endif
            }
        }
        if (store_state) { const int slot = (bh * 2 + dir) * 65 + tb; SCAN_STORE_STATE(slot);
            if (wave == 0) *(f32x2*)(sp.AB + (size_t)slot * 128 + 2 * lane) = RET ? (f32x2){ex2(256.f * lg2), ex2(256.f * lg2)} : (f32x2){ex2(ata), ex2(atb)}; }
        BAR_ALL();
    }
}

__device__ __forceinline__ ScanPtrs scan_ptrs(const Ctx& a, int l) {
    unsigned char* ws = a.ws(); ScanPtrs sp; sp.P = (const bf16_t*)(ws + WS_P); sp.SB = (const bf16_t*)(ws + WS_SB); sp.UB = (bf16_t*)(ws + WS_UB); sp.AB = (float*)(ws + WS_AB); sp.MIX = (bf16_t*)(ws + WS_MIX);
    sp.OB = (float*)(ws + WS_OB) + (size_t)blockIdx.x * 32768; sp.rdec = a.in(I_RDEC) + l * 8; sp.onorm = a.in(I_ONORM) + l * 128; return sp;
}

constexpr int SW_KT = 0, SW_VT = 65536, SW_PART = 131072;
struct S1Id { int seq, tb; };
__device__ __forceinline__ void scan_write_T8(LAS unsigned char* img, const unsigned (&d)[8], int cp, int tg) {
    u32x4 wa, wb;
    wa.x = (d[0] & 0xffffu) | (d[1] << 16); wa.y = (d[2] & 0xffffu) | (d[3] << 16); wa.z = (d[4] & 0xffffu) | (d[5] << 16); wa.w = (d[6] & 0xffffu) | (d[7] << 16);
    wb.x = (d[0] >> 16) | (d[1] & 0xffff0000u); wb.y = (d[2] >> 16) | (d[3] & 0xffff0000u); wb.z = (d[4] >> 16) | (d[5] & 0xffff0000u); wb.w = (d[6] >> 16) | (d[7] & 0xffff0000u);
    *(LAS u32x4*)(img + st_off(2 * cp, tg * 16, 8)) = wa; *(LAS u32x4*)(img + st_off(2 * cp + 1, tg * 16, 8)) = wb;
}
#define S1W_LOAD(id_) do { const int seq_ = (id_).seq, hh_ = (seq_ >> 1) & 7, dir_ = seq_ & 1, h_ = hh_ & 3; const bool ret_ = hh_ >= 4; \
        const int colk_ = ret_ ? 6 * 512 + h_ * 128 : (dir_ ? 2 * 512 : 512) + h_ * 128, colv_ = (ret_ ? 7 * 512 : 3 * 512) + h_ * 128; \
        const int row0_ = (seq_ >> 4) * LTOT + (id_).tb * 256; int ln_ = lane; asm volatile("" : "+v"(ln_)); \
        _Pragma("unroll") for (int i = 0; i < 32; ++i) { const int p_ = 32 * wave + i; const size_t ro_ = (size_t)(row0_ + (dir_ ? 255 - p_ : p_)) * INW + 2 * ln_; \
            kr[i] = *(const unsigned*)(sp.P + ro_ + colk_); vr[i] = *(const unsigned*)(sp.P + ro_ + colv_); } } while (0)
__device__ __forceinline__ void scan1w_item(const ScanPtrs& sp, LAS unsigned char* lds, int lane, int wave, const S1Id id, unsigned (&kr)[32], unsigned (&vr)[32], bool have_next, const S1Id nxt) {
    asm volatile("" : "+v"(lane), "+s"(wave)); const int tid = wave * 64 + lane;
    bf16_t* UB = sp.UB; const int fr = lane & 15, fq = lane >> 4;
    const int seq = id.seq, tb = id.tb, hh = (seq >> 1) & 7, dir = seq & 1, h = hh & 3; const bool RET = hh >= 4;
    const float lg2 = RET ? -expf(sp.rdec[dir * 4 + h]) * LOG2E_ : 0.f;
#ifndef SCAN_LOG2
    constexpr float LS = 1.4426950408889634f;
#else
    constexpr float LS = 1.0f;
#endif
    if (!RET) { f32x2 t2 = {0.f, 0.f};
#pragma unroll
        for (int i = 0; i < 32; ++i) t2 += (f32x2){bf_lo(kr[i]), bf_hi(kr[i])};
        *(LAS f32x2*)(lds + SW_PART + (wave * 64 + lane) * 8) = t2; }
    BAR_LDS();
    f32x2 pw = {0.f, 0.f}, T2 = {0.f, 0.f};
    if (!RET) {
#pragma unroll
        for (int w8 = 0; w8 < 8; ++w8) { const f32x2 pp = *(const LAS f32x2*)(lds + SW_PART + (w8 * 64 + lane) * 8); if (w8 < wave) pw += pp; T2 += pp; } }
    f32x2 r2 = pw;
#pragma unroll
    for (int g = 0; g < 4; ++g) { unsigned kd[8], vv[8];
#pragma unroll
        for (int tt = 0; tt < 8; ++tt) { const int i = 8 * g + tt; vv[tt] = vr[i];
            if (RET) { const float wk = ex2((float)(255 - (32 * wave + i)) * lg2); kd[tt] = cvt_pk_bf16(bf_lo(kr[i]) * wk, bf_hi(kr[i]) * wk); }
            else { const f32x2 lf = {bf_lo(kr[i]), bf_hi(kr[i])}; r2 += lf;
                f32x2 d2 = (T2 - r2) * LS; d2 = __builtin_elementwise_max(d2, (f32x2){-120.f, -120.f});
                const f32x2 lf2 = lf * LS; const f32x2 k2 = (f32x2){1.0f, 1.0f} - (f32x2){__builtin_amdgcn_exp2f(lf2.x), __builtin_amdgcn_exp2f(lf2.y)};
                const f32x2 kt2 = k2 * (f32x2){__builtin_amdgcn_exp2f(d2.x), __builtin_amdgcn_exp2f(d2.y)}; kd[tt] = cvt_pk_bf16(kt2.x, kt2.y); } }
        scan_write_T8(lds + SW_KT, kd, lane, 4 * wave + g); scan_write_T8(lds + SW_VT, vv, lane, 4 * wave + g); }
    if (have_next) S1W_LOAD(nxt);
    BAR_LDS();
    f32x4 ST[8];
#pragma unroll
    for (int vi = 0; vi < 8; ++vi) ST[vi] = (f32x4){0.f, 0.f, 0.f, 0.f};
    { const int lp = st_lane(fr, fq);
#pragma unroll
      for (int ks = 0; ks < 8; ++ks) { const bf16x8 af = ldfrag(lds + SW_KT, wave, ks, 8, lp);
#pragma unroll
          for (int vi = 0; vi < 8; ++vi) ST[vi] = MFMA16(af, ldfrag(lds + SW_VT, vi, ks, 8, lp), ST[vi]);
          if (ks & 1) __builtin_amdgcn_sched_barrier(0); } }
    const int slot = seq * 65 + tb;
    SCAN_STORE_STATE(slot);
    if (wave == 0) *(f32x2*)(sp.AB + (size_t)slot * 128 + 2 * lane) = RET ? (f32x2){ex2(256.f * lg2), ex2(256.f * lg2)} : (f32x2){ex2(T2.x), ex2(T2.y)};
}
__device__ __forceinline__ bool s1_enum(bool modeA, bool last, int c, int G, int& k, S1Id& id) {
    constexpr int HS = 7;
    for (;; ++k) {
        if (modeA) { const int it = c + k * G; if (it >= 2048) return false; const int seq = it >> 6, j = it & 63; if (!last && j == 0) continue;
            id.seq = seq; id.tb = (seq & 1) ? (j == 0 ? 0 : 65 - j) : j; ++k; return true; }
        const int li = k < HS ? k * (G - 16) + (c - 16) : HS * (G - 16) + (k - HS) * G + c;
        if (li >= 2016) return false;
        const int seq = li / 63, j = 1 + li % 63; id.seq = seq; id.tb = (seq & 1) ? 65 - j : j; ++k; return true; }
}

__device__ __forceinline__ void scan1_phase(const Ctx& a, int l) {
    PHASE_IDS(); LAS unsigned char* lds = launder_lds(a.lds); const ScanPtrs sp = scan_ptrs(a, l);
#ifdef PROBE_NOMERGE
    const bool last = true; const int c = blockIdx.x, G = gridDim.x;
#else
    const bool last = (l == DEPTH - 1); const int c = blockIdx.x, G = gridDim.x;
#endif
#ifdef SCAN_PRIO1
    if (wave >= 4) __builtin_amdgcn_s_setprio(1);
#endif
#ifdef S1_WIDE
    { const bool modeA = last || G < 32;
      if (!last) { if (modeA) { for (int bh = c; bh < 16; bh += G) { if ((bh & 7) >= 4) scan3_item<true>(sp, lds, tid, lane, wave, bh, 0, true); else scan3_item<false>(sp, lds, tid, lane, wave, bh, 0, true); } }
                   else if (c < 16) { if ((c & 7) >= 4) scan3_item<true>(sp, lds, tid, lane, wave, c, 0, true); else scan3_item<false>(sp, lds, tid, lane, wave, c, 0, true); } }
      int k = (!modeA && c < 16) ? 7 : 0; S1Id id, nx; unsigned kr[32], vr[32];
      bool have = s1_enum(modeA, last, c, G, k, id);
      if (have) S1W_LOAD(id);
      while (have) { nx = id; const bool have2 = s1_enum(modeA, last, c, G, k, nx);
          scan1w_item(sp, lds, lane, wave, id, kr, vr, have2, nx);
          have = have2; id = nx; }
      BAR_LDS();
      return; }
#endif
    if (last || G < 32) {
        if (!last) for (int bh = c; bh < 16; bh += G) { if ((bh & 7) >= 4) scan3_item<true>(sp, lds, tid, lane, wave, bh, 0, true); else scan3_item<false>(sp, lds, tid, lane, wave, bh, 0, true); }
        for (int it = c; it < 2048; it += G) { const int seq = it >> 6, j = it & 63; if (!last && j == 0) continue; const int dir = seq & 1, tb = dir ? (j == 0 ? 0 : 65 - j) : j;
            if (((seq >> 1) & 7) >= 4) scan1_item<true>(sp, lds, tid, lane, wave, seq, tb); else scan1_item<false>(sp, lds, tid, lane, wave, seq, tb); }
        return;
    }
    if (c < 16) { if ((c & 7) >= 4) scan3_item<true>(sp, lds, tid, lane, wave, c, 0, true); else scan3_item<false>(sp, lds, tid, lane, wave, c, 0, true); }
    constexpr int HS = 7;
    for (int k = (c < 16 ? HS : 0);; ++k) {
        const int li = k < HS ? k * (G - 16) + (c - 16) : HS * (G - 16) + (k - HS) * G + c;
        if (li >= 2016) break;
        const int seq = li / 63, j = 1 + li % 63, dir = seq & 1, tb = dir ? 65 - j : j;
        if (((seq >> 1) & 7) >= 4) scan1_item<true>(sp, lds, tid, lane, wave, seq, tb); else scan1_item<false>(sp, lds, tid, lane, wave, seq, tb);
    }
}

__device__ __forceinline__ void scan2_phase(const Ctx& a) {
#ifdef SCAN_PRIO1
    __builtin_amdgcn_s_setprio(0);
#endif
    PHASE_IDS(); unsigned char* ws = a.ws(); const bf16_t* UB = (const bf16_t*)(ws + WS_UB); bf16_t* SB = (bf16_t*)(ws + WS_SB); const float* AB = (const float*)(ws + WS_AB);
    const int c0 = 16 * (tid >> 6) + 4 * ((tid >> 4) & 3);
    for (int p = blockIdx.x; p < 256; p += gridDim.x) { const int seq = p >> 3, vi = p & 7, dir = seq & 1; const size_t eo = (size_t)(vi * 512 + tid) * 4;
        f32x4 s = {0.f, 0.f, 0.f, 0.f};
#define S2_SLOT(j_) ((size_t)seq * 65 + (dir ? ((j_) == 0 ? 0 : 65 - (j_)) : (j_)))
#define S2_LOAD(u_, av_, j0_) do { _Pragma("unroll") for (int q = 0; q < 8; ++q) { const size_t slot = S2_SLOT((j0_) + q); u_[q] = LDNT((const u32x2*)(UB + slot * 16384 + eo)); av_[q] = *(const f32x4*)(AB + slot * 128 + c0); } } while (0)
#define S2_STEP(u_, av_, j0_) do { _Pragma("unroll") for (int q = 0; q < 8; ++q) { const size_t slot = S2_SLOT((j0_) + q); \
            if (q & 1) { u32x2 w; w.x = cvt_pk_bf16(s[0], s[1]); w.y = cvt_pk_bf16(s[2], s[3]); *(u32x2*)(SB + slot * 16384 + eo) = w; }     \
            s = av_[q] * s + (f32x4){bf_lo(u_[q].x), bf_hi(u_[q].x), bf_lo(u_[q].y), bf_hi(u_[q].y)}; } } while (0)
        u32x2 ua[8], ub[8]; f32x4 aa[8], ab[8];
        S2_LOAD(ua, aa, 0);
#pragma unroll 1
        for (int j0 = 0; j0 < 64; j0 += 16) {
            S2_LOAD(ub, ab, j0 + 8);
            S2_STEP(ua, aa, j0);
            if (j0 + 16 < 64) S2_LOAD(ua, aa, j0 + 16);
            S2_STEP(ub, ab, j0 + 8); }
#undef S2_SLOT
#undef S2_LOAD
#undef S2_STEP
    }
}

__device__ __forceinline__ void scan3_phase(const Ctx& a, int l) {
    PHASE_IDS(); LAS unsigned char* lds = launder_lds(a.lds); const ScanPtrs sp = scan_ptrs(a, l);
#ifdef SCAN_PRIO
    if (wave >= 4) __builtin_amdgcn_s_setprio(1);
#endif
#ifdef PROBE_NOMERGE
    if (l != DEPTH - 1) for (int bh = blockIdx.x; bh < 16; bh += gridDim.x) { if ((bh & 7) >= 4) scan3_item<true>(sp, lds, tid, lane, wave, bh, 0, false); else scan3_item<false>(sp, lds, tid, lane, wave, bh, 0, false); }
#endif
    for (int it = blockIdx.x; it < 512; it += gridDim.x) { const int half = it >> 8, cc = it & 255; const int bh = (cc & 15) ^ (half ? 4 : 0), tb = 1 + 2 * ((half << 4) + (cc >> 4));
        if ((bh & 7) >= 4) scan3_item<true>(sp, lds, tid, lane, wave, bh, tb, false, 8); else scan3_item<false>(sp, lds, tid, lane, wave, bh, tb, false, 8); }
#ifdef SCAN_PRIO
    __builtin_amdgcn_s_setprio(0);
#endif
}

struct OutOrder {
    static constexpr bool PADTILES = false;
    __device__ __forceinline__ bool half_rows(const pg8::Unit&) const { return false; }
    int nrt, skipctx, G, c;
    __device__ __forceinline__ bool next(int i, pg8::Unit& u) const {
        const int L = i * G + c; if (L >= nrt * 4) return false;
        const int r = L >> 2; u.pn = L & 3; u.pm = skipctx ? r + 1 + (r >= 64 ? 1 : 0) : r; return true;
    }
    __device__ __forceinline__ void a_ready(const pg8::Unit&) const {}
    __device__ __forceinline__ void done(const pg8::Unit&) const {}
};

#ifndef PH
#define PH 0xffff
#endif
#ifndef DBL
#define DBL 0
#endif
__global__ void __launch_bounds__(512, 2) mega_fwd(Args a) {
    extern __shared__ __attribute__((aligned(16))) unsigned char lds_raw[];
    LAS unsigned char* lds = (LAS unsigned char*)lds_raw;
    const int tid = threadIdx.x;
    const int G = gridDim.x; const int bx = blockIdx.x; const int vcu = (G % 8 == 0) ? (bx % 8) * (G / 8) + bx / 8 : bx;
    volatile LAS unsigned* MISC = (volatile LAS unsigned*)(lds + MISC_OFF);
    if (tid < 16) MISC[tid] = 0u;
    if (tid == 0) { LAS unsigned long long* pt = (LAS unsigned long long*)(lds + PTR_OFF);
#pragma unroll
        for (int i = 0; i < 18; ++i) pt[i] = (unsigned long long)a.in[i];
        pt[18] = (unsigned long long)a.out; pt[19] = (unsigned long long)a.ws; }
    __syncthreads();
    const Ctx cx{lds, __builtin_amdgcn_readfirstlane(tid >> 6)};
    XcdBarrier bar = xcd_barrier_post((unsigned*)(cx.ws() + WS_CTL) + 1024, MISC + 8);
#define GRID_BAR() do { XcdBarrier b2_ = bar; asm volatile("" : "+s"(b2_.x)); xcd_barrier(b2_); } while (0)

#if PH & 1
    p0_prologue(cx);
#endif
    GRID_BAR();
#if DBL & 1
    p0_prologue(cx);
    GRID_BAR();
#endif
#if PH & 1
    p0_finalize(cx);
#endif
    GRID_BAR();

#pragma unroll 1
    for (int l = 0; l < DEPTH; ++l) {
        const bool last = (l == DEPTH - 1); unsigned char* ws = cx.ws();
#ifdef PROBE_NOBG
        const bool bgc = false;
#else
        const bool bgc = (G == 256);
#endif

#if DBL & 64
        norm1_phase<2>(cx, l);
        GRID_BAR();
#endif
#if PH & 2
        norm1_phase<0>(cx, l);
#endif
        GRID_BAR();
#ifdef G1_SPLIT
        const int g1k = (bgc && bx >= 36) ? ((bx >> 3) % 5) : 0;
        if (g1k > 0) cvt_tail(cx, CVT_N0 + l * CVT_CYC, bx - 36, 4, 0, g1k);
#endif
#if PH & 4
        {
#ifdef G1_F8
            pg8::Gemm g{(const bf16_t*)(ws + WS_H), (const bf16_t*)(ws + WS_WIN + (size_t)l * INW * D), MROWS, INW, D, cx.w0};
            pg8::StaticOrder S; S.init(MROWS, INW, G, bx);
            pg8::EpiIn8 E{(bf16_t*)(ws + WS_P), (const float*)(ws + WS_LBS) + l * 512, (const float*)(ws + WS_ROPE)};
            pg8::gemm_phase_f8<pg8::EpiIn8, pg8::StaticOrder, false>(launder_lds(lds), g, S, E, nullptr);
#else
            pg8::Gemm g{(const bf16_t*)(ws + WS_H), (const bf16_t*)(ws + WS_WIN) + (size_t)l * INW * D, MROWS, INW, D, cx.w0};
            pg8::StaticOrder S; S.init(MROWS, INW, G, bx);
            pg8::EpiIn E{(bf16_t*)(ws + WS_P), (const float*)(ws + WS_LBS) + l * 512, (const float*)(ws + WS_ROPE)};
#ifdef STAGGER_G1
            { const unsigned long long t0_ = __builtin_amdgcn_s_memrealtime(); const unsigned long long d_ = (unsigned long long)((bx >> 3) & 3) * STAGGER_G1; while (__builtin_amdgcn_s_memrealtime() - t0_ < d_) __builtin_amdgcn_s_sleep(8); }
#endif
            pg8::gemm_phase<pg8::EpiIn, pg8::StaticOrder, true, true>(launder_lds(lds), g, S, E);
#endif
        }
#endif
#if DBL & 1024
        GRID_BAR();
        {
            pg8::Gemm g{(const bf16_t*)(ws + WS_H), (const bf16_t*)(ws + WS_WIN) + (size_t)l * INW * D, MROWS, INW, D, cx.w0};
            pg8::StaticOrder S; S.init(MROWS, INW, G, bx);
            pg8::EpiNull E{(float*)(ws + WS_OB)};
            pg8::gemm_phase<pg8::EpiNull, pg8::StaticOrder, true, true>(launder_lds(lds), g, S, E);
        }
#endif
#if DBL & 16384
        GRID_BAR();
        {
            pg8::Gemm g{(const bf16_t*)(ws + WS_H), (const bf16_t*)(ws + WS_WIN) + (size_t)l * INW * D, MROWS, INW, D, cx.w0};
            pg8::StaticOrder S; S.init(MROWS, INW, G, bx);
            pg8::EpiInT<true> E{(bf16_t*)(ws + WS_YS), (const float*)(ws + WS_LBS) + l * 512, (const float*)(ws + WS_ROPE)};
            pg8::gemm_phase<pg8::EpiInT<true>, pg8::StaticOrder, true, true>(launder_lds(lds), g, S, E);
        }
#endif
#if DBL & 128
        GRID_BAR();
        {
            pg8::Gemm g{(const bf16_t*)(ws + WS_H), (const bf16_t*)(ws + WS_WIN) + (size_t)l * INW * D, MROWS, INW, D, cx.w0};
            pg8::StaticOrder S; S.init(MROWS, INW, G, bx);
            pg8::EpiIn E{(bf16_t*)(ws + WS_P), (const float*)(ws + WS_LBS) + l * 512, (const float*)(ws + WS_ROPE)};
            pg8::gemm_phase<pg8::EpiIn, pg8::StaticOrder, true, true>(launder_lds(lds), g, S, E);
        }
#endif
#ifdef G1_SPLIT
        if (bgc && bx >= 36) cvt_tail(cx, CVT_N0 + l * CVT_CYC, bx - 36, 4, g1k, 4);
#else
        if (bgc && bx >= 36) cvt_tail<4>(cx, CVT_N0 + l * CVT_CYC, bx - 36);
#endif
#ifdef DBLCVT
        if (bgc && bx >= 36) cvt_tail<4>(cx, CVT_N0 + l * CVT_CYC, bx - 36);
#endif
        GRID_BAR();
#if DBL & 8192
#pragma unroll 1
        for (int xb = 0; xb < 10; ++xb) GRID_BAR();
#endif
#if PH & 8
        scan1_phase(cx, l);
#endif
        GRID_BAR();
#if PH & 16
        scan2_phase(cx);
#endif
        GRID_BAR();
#if PH & 32
        scan3_phase(cx, l);
#endif
        GRID_BAR();
#if DBL & 2
        scan1_phase(cx, l);
        GRID_BAR();
        scan2_phase(cx);
        GRID_BAR();
        scan3_phase(cx, l);
        GRID_BAR();
#endif
#if DBL & 8
        scan1_phase(cx, l);
        GRID_BAR();
#endif
#if DBL & 16
        scan2_phase(cx);
        GRID_BAR();
#endif
#if DBL & 32
        scan3_phase(cx, l);
        GRID_BAR();
#endif
#if PH & 64
        {
#ifdef G2_F8
            pg8::Gemm g{(const bf16_t*)(ws + WS_MIX), (const bf16_t*)(ws + WS_WOUT + (size_t)l * D * D), MROWS, D, D, cx.w0};
            OutOrder S{last ? 128 : 130, last ? 1 : 0, G, vcu};
            pg8::EpiOut8 E{(bf16_t*)(ws + WS_X), l == 0 ? cx.in(I_X) : nullptr, l == 0 ? cx.in(I_CTX) : nullptr, (const float*)(ws + WS_MODS) + (size_t)(l * 3) * 6144 + 2 * D};
            pg8::gemm_phase_f8<pg8::EpiOut8, OutOrder, false>(launder_lds(lds), g, S, E, nullptr);
#else
            pg8::Gemm g{(const bf16_t*)(ws + WS_MIX), (const bf16_t*)(ws + WS_WOUT) + (size_t)l * D * D, MROWS, D, D, cx.w0};
            OutOrder S{last ? 128 : 130, last ? 1 : 0, G, vcu};
            pg8::EpiOut E{(bf16_t*)(ws + WS_X), l == 0 ? cx.in(I_X) : nullptr, l == 0 ? cx.in(I_CTX) : nullptr, (const float*)(ws + WS_MODS) + (size_t)(l * 3) * 6144 + 2 * D};
            pg8::gemm_phase<pg8::EpiOut, OutOrder, true, true>(launder_lds(lds), g, S, E);
#endif
        }
#endif
        if (bgc && !last && vcu >= 8) cvt_tail<4>(cx, CVT_N0 + l * CVT_CYC + CVT_G1, vcu - 8);
#ifdef DBLCVT
        if (bgc && !last && vcu >= 8) cvt_tail<4>(cx, CVT_N0 + l * CVT_CYC + CVT_G1, vcu - 8);
#endif
        GRID_BAR();
#if PH & 128
        norm2_phase(cx, l);
#endif
        GRID_BAR();
#if DBL & 4
        norm2_phase(cx, l);
        GRID_BAR();
#endif
#if PH & 256
        topk_phase(cx, l);
#endif
        if (bgc && bx >= 64) cvt_tail<3>(cx, CVT_N0 + l * CVT_CYC + CVT_G1 + (last ? 0 : CVT_G2), bx - 64);
#ifdef DBLCVT
        if (bgc && bx >= 64) cvt_tail<3>(cx, CVT_N0 + l * CVT_CYC + CVT_G1 + (last ? 0 : CVT_G2), bx - 64);
#endif
        GRID_BAR();
#if DBL & 2048
        topk_phase(cx, l);
        GRID_BAR();
#endif
#if PH & 1024
        {
            pg8::Gemm g{(const bf16_t*)(ws + WS_H), (const bf16_t*)(ws + WS_WGU + (size_t)l * 65536 * D), MOE_ROWS, 65536, D, cx.w0};
            pg8::MoeOrder S{last ? 16 : 17, 16, G, vcu};
            pg8::EpiGU E{(unsigned char*)(ws + WS_HID)};
            pg8::gemm_phase_f8<pg8::EpiGU, pg8::MoeOrder, true>(launder_lds(lds), g, S, E, (const int*)(ws + WS_ROWMAP));
        }
#endif
#if DBL & 4096
        GRID_BAR();
        {
            pg8::Gemm g{(const bf16_t*)(ws + WS_H), (const bf16_t*)(ws + WS_WGU + (size_t)l * 65536 * D), MOE_ROWS, 65536, D, cx.w0};
            pg8::MoeOrder S{last ? 16 : 17, 16, G, vcu};
            pg8::EpiNull E{(float*)(ws + WS_OB)};
            pg8::gemm_phase_f8<pg8::EpiNull, pg8::MoeOrder, true>(launder_lds(lds), g, S, E, (const int*)(ws + WS_ROWMAP));
        }
#endif
#if DBL & 256
        GRID_BAR();
        {
            pg8::Gemm g{(const bf16_t*)(ws + WS_H), (const bf16_t*)(ws + WS_WGU + (size_t)l * 65536 * D), MOE_ROWS, 65536, D, cx.w0};
            pg8::MoeOrder S{last ? 16 : 17, 16, G, vcu};
            pg8::EpiGU E{(unsigned char*)(ws + WS_HID)};
            pg8::gemm_phase_f8<pg8::EpiGU, pg8::MoeOrder, true>(launder_lds(lds), g, S, E, (const int*)(ws + WS_ROWMAP));
        }
#endif
        GRID_BAR();
#if PH & 2048
        {
            pg8::Gemm g{(const bf16_t*)(ws + WS_HID), (const bf16_t*)(ws + WS_WD + (size_t)l * 16384 * FF), MOE_ROWS, 16384, FF, cx.w0};
            pg8::MoeOrder S{last ? 16 : 17, 4, G, vcu};
            pg8::EpiDown E{(unsigned char*)(ws + WS_YS)};
            pg8::gemm_phase_f8<pg8::EpiDown, pg8::MoeOrder, false>(launder_lds(lds), g, S, E, nullptr);
        }
#endif
#if DBL & 512
        GRID_BAR();
        {
            pg8::Gemm g{(const bf16_t*)(ws + WS_HID), (const bf16_t*)(ws + WS_WD + (size_t)l * 16384 * FF), MOE_ROWS, 16384, FF, cx.w0};
            pg8::MoeOrder S{last ? 16 : 17, 4, G, vcu};
            pg8::EpiDown E{(unsigned char*)(ws + WS_YS)};
            pg8::gemm_phase_f8<pg8::EpiDown, pg8::MoeOrder, false>(launder_lds(lds), g, S, E, nullptr);
        }
#endif
        if (bgc && !last && vcu >= 64) cvt_tail<4>(cx, CVT_N0 + l * CVT_CYC + CVT_G1 + CVT_G2 + CVT_T, vcu - 64);
#ifdef DBLCVT
        if (bgc && !last && vcu >= 64) cvt_tail<4>(cx, CVT_N0 + l * CVT_CYC + CVT_G1 + CVT_G2 + CVT_T, vcu - 64);
#endif
        GRID_BAR();
    }
#if PH & 4096
    norm1_phase<1>(cx, DEPTH);
#endif
}

extern "C" void kernel_launch(void* const* d_in, const int* in_sizes, int n_in, void* d_out, int out_size, void* d_ws, size_t ws_size, hipStream_t stream) {
    static int grid = 0;
    if (grid == 0) {
        if (n_in != 18 || out_size != NB * SEQ * D || ws_size < WS_END) { fprintf(stderr, "kernel_launch: unexpected problem shape (n_in %d, out %d, ws %zu)\n", n_in, out_size, ws_size); grid = -1; return; }
        int dev = 0, cus = 0, per_cu = 0;
        if (hipGetDevice(&dev) != hipSuccess || hipDeviceGetAttribute(&cus, hipDeviceAttributeMultiprocessorCount, dev) != hipSuccess) { grid = -1; return; }
        if (hipFuncSetAttribute((const void*)mega_fwd, hipFuncAttributeMaxDynamicSharedMemorySize, LDS_BYTES) != hipSuccess) { fprintf(stderr, "kernel_launch: hipFuncSetAttribute failed\n"); grid = -1; return; }
        if (hipOccupancyMaxActiveBlocksPerMultiprocessor(&per_cu, (const void*)mega_fwd, 512, LDS_BYTES) != hipSuccess || per_cu < 1) { fprintf(stderr, "kernel_launch: occupancy query reports %d workgroups per CU\n", per_cu); per_cu = 1; }
        (void)hipGetLastError();
        grid = cus;
    }
    if (grid < 0) return;
    (void)in_sizes;
    if (hipMemsetAsync((char*)d_ws + WS_CTL, 0, CTL_ZERO_BYTES, stream) != hipSuccess) return;
    Args a{};
    for (int i = 0; i < 18; ++i) a.in[i] = (const float*)d_in[i];
    a.out = (float*)d_out; a.ws = (unsigned char*)d_ws;
    hipLaunchKernelGGL(mega_fwd, dim3(grid), dim3(512), LDS_BYTES, stream, a);
}
```

```cpp
#define SCAN_PRIO 1
#define CVT_NT 1
#define NT_MORE 1
#define NT_CST 1
#define TOPK_BALLOT 1
#define CVT_N2SLOT 1
#include <hip/hip_runtime.h>
#include <cstdio>
#include <cstdint>

constexpr int D = 1024, NB = 2, SEQ = 16384, CTX = 256, LTOT = SEQ + CTX, MROWS = NB * LTOT;
constexpr int DEPTH = 4, INW = 4608, NE = 16, FF = 2048;
constexpr int CAP_LAT = 2048, CAP_CTX = 32;
constexpr int MOE_ROWS_E = 4352, MOE_ROWS = NE * MOE_ROWS_E;
constexpr int NSLOT = NB * 8 * 2 * 65;
constexpr float EPS = 1e-6f;

constexpr size_t MiB = 1u << 20;
constexpr size_t WS_CTL = 0, CTL_ZERO_BYTES = 64 * 1024;
constexpr size_t WS_MODP = 1 * MiB;
constexpr size_t WS_MODS = 4 * MiB;
constexpr size_t WS_LBS = 5 * MiB;
constexpr size_t WS_ROPE = 5 * MiB + 65536;
constexpr size_t WS_WIN = 8 * MiB;
constexpr size_t WS_WOUT = 44 * MiB;
constexpr size_t WS_WGU = 52 * MiB;
constexpr size_t WS_WD = 564 * MiB;
constexpr size_t WS_X = 820 * MiB;
constexpr size_t WS_H = 950 * MiB;
constexpr size_t WS_MIX = 1015 * MiB;
constexpr size_t WS_P = 1080 * MiB;
constexpr size_t WS_XS = 1080 * MiB;
constexpr size_t WS_HID = 1216 * MiB;
constexpr size_t WS_YS = 1488 * MiB;
constexpr size_t WS_UB = 1624 * MiB;
constexpr size_t WS_SB = 1689 * MiB;
constexpr size_t WS_AB = 1754 * MiB;
constexpr size_t WS_OB = 1756 * MiB;
constexpr size_t WS_AFF = 1788 * MiB;
constexpr size_t WS_ROWMAP = 1791 * MiB;
constexpr size_t WS_INV = 1792 * MiB;
constexpr size_t WS_END = 1800 * MiB;

constexpr int LDS_BYTES = 155648;
constexpr int MISC_OFF = LDS_BYTES - 64;
constexpr int PTR_OFF = LDS_BYTES - 256;

#define GAS __attribute__((address_space(1)))
#define LAS __attribute__((address_space(3)))
typedef float f32x2 __attribute__((ext_vector_type(2)));
typedef unsigned u32x2 __attribute__((ext_vector_type(2)));

__device__ __forceinline__ int lane_id() { int l; asm volatile("v_mbcnt_lo_u32_b32 %0, -1, 0\n\tv_mbcnt_hi_u32_b32 %0, -1, %0" : "=v"(l)); return l; }
__device__ __forceinline__ int opaque_tid(int w0) { int w = w0; asm volatile("" : "+s"(w)); int t = w * 64 + lane_id(); asm volatile("" : "+v"(t)); return t; }
__device__ __forceinline__ LAS unsigned char* launder_lds(LAS unsigned char* p) { unsigned v = (unsigned)(size_t)p; asm volatile("" : "+s"(v)); return (LAS unsigned char*)(size_t)v; }
__device__ __forceinline__ const float* ldptr(LAS unsigned char* lds0, int i) {
    LAS unsigned char* lds = launder_lds(lds0);
    const u32x2 v = *(volatile LAS u32x2*)(lds + PTR_OFF + 8 * i);
    const unsigned lo = __builtin_amdgcn_readfirstlane(v.x), hi = __builtin_amdgcn_readfirstlane(v.y);
    const GAS float* g = (const GAS float*)(((unsigned long long)hi << 32) | lo);
    return (const float*)g;
}
namespace pg8 {
#define PG8_LAS __attribute__((address_space(3)))
typedef unsigned short bf16_t;
typedef short bf16x8 __attribute__((ext_vector_type(8)));
typedef float f32x4 __attribute__((ext_vector_type(4)));
typedef unsigned u32x4 __attribute__((ext_vector_type(4)));
constexpr int BM = 256, BK = 64, HALF = 128, HTB = HALF * BK * 2  , STAGE_BYTES = 8 * HTB, NXCD = 8, WGM = 8;

__host__ __device__ __forceinline__ int lds_byte(int r, int c) { const int st = (r >> 4) * 2 + (c >> 5), rr = r & 15, cc = c & 31, ob = rr * 64 + cc * 2; return st * 1024 + (ob ^ (((ob >> 9) & 1) << 5)); }
__host__ __device__ __forceinline__ void stage_rc(int b, int& R, int& C) { const int st = b / 1024, sb = b % 1024, swz = sb ^ (((sb >> 9) & 1) << 5); R = (st >> 1) * 16 + swz / 64; C = (st & 1) * 32 + (swz % 64) / 2; }
__host__ __device__ __forceinline__ int perm32(int rho) { const int n = rho >> 4, i = rho & 15; return 8 * (i >> 2) + 4 * n + (i & 3); }

struct Unit { int pm, pn; };
struct Gemm { const bf16_t* A; const bf16_t* Bt; int M, N, K, w0; };

struct StaticOrder {
    static constexpr bool PADTILES = false;
    __device__ __forceinline__ bool half_rows(const Unit&) const { return false; }
    int nM, nN, nwg, G, c;
    __host__ __device__ void init(int M, int N, int G_, int c_) { nM = M / BM; nN = N / BM; nwg = nM * nN; G = G_; c = c_; }
    __host__ __device__ bool next(int i, Unit& u) const {
        const long L = (long)i * G + c; if (L >= nwg) return false;
        int wgid = (int)L; { const int q = nwg / NXCD, r = nwg % NXCD, xcd = wgid % NXCD, off = wgid / NXCD; wgid = (xcd < r ? xcd * (q + 1) : r * (q + 1) + (xcd - r) * q) + off; }
        const int nig = WGM * nN, gid = wgid / nig, fm = gid * WGM, gsz = (nM - fm) < WGM ? (nM - fm) : WGM;
        u.pm = fm + ((wgid % nig) % gsz); u.pn = (wgid % nig) / gsz; return true;
    }
    __device__ __forceinline__ void a_ready(const Unit&) const {}
    __device__ __forceinline__ void done(const Unit&) const {}
};
__device__ __forceinline__ unsigned cvt_pk_bf16(float lo, float hi) { unsigned r; asm volatile("v_cvt_pk_bf16_f32 %0, %1, %2" : "=v"(r) : "v"(lo), "v"(hi)); return r; }

struct MoeOrder {
    static constexpr bool PADTILES = true;
    __device__ __forceinline__ bool half_rows(const Unit& u) const { return (u.pm % 17) == 16; }
    int NT, NC, G, c;
    __device__ __forceinline__ bool next(int i, Unit& u) const {
        const int L = i * G + c, per = NT * NC; if (L >= 16 * per) return false;
        const int e = L / per, q = L - e * per;
        if (NC == 16 && q < 256) { u.pm = e * 17 + (q >> 6) * 4 + (q & 3); u.pn = e * NC + ((q >> 2) & 15); }
        else { u.pm = e * 17 + q / NC; u.pn = e * NC + q % NC; }
        return true;
    }
    __device__ __forceinline__ void a_ready(const Unit&) const {}
    __device__ __forceinline__ void done(const Unit&) const {}
};

__device__ __forceinline__ float fast_exp(float x) { return __builtin_amdgcn_exp2f(x * 1.4426950408889634f); }
__device__ __forceinline__ float fast_sigmoid(float x) { return __builtin_amdgcn_rcpf(1.0f + fast_exp(-x)); }

constexpr float F8_SA = 8.0f, F8_SW = 64.0f, F8_SH = 4.0f, F8_SY = 16.0f;
#ifdef P_NT_SEL
#define PSTORE_SEL(c_, p_, v_) do { if (c_) __builtin_nontemporal_store((v_), (p_)); else *(p_) = (v_); } while (0)
#else
#define PSTORE_SEL(c_, p_, v_) (*(p_) = (v_))
#endif
#ifdef P_NT
#define PSTORE(p_, v_) __builtin_nontemporal_store((v_), (p_))
#else
#define PSTORE(p_, v_) (*(p_) = (v_))
#endif
template <bool PLAIN, bool F8 = false>
struct EpiInT {
    static constexpr float ASC = F8 ? 1.0f / (F8_SA * F8_SW) : 1.0f;
    static constexpr bool PERM = true, AFTER_DRAIN = false, A_STREAM = false;
    bf16_t* P; const float* lb; const float* cs;
    __device__ __forceinline__ void operator()(const f32x4 (&acc)[2][2][4][2], const Unit& u, int wr, int wc, int fr, int fq) const {
        const int grp = PLAIN ? 0 : (u.pn >> 1);
        const int row0 = u.pm * BM + wr * 64 + fr, col0 = u.pn * BM + wc * 32 + 8 * fq;
        if (grp == 0 || grp == 3 || grp == 7) {
#pragma unroll
            for (int ai = 0; ai < 2; ++ai)
#pragma unroll
                for (int m = 0; m < 4; ++m) { bf16_t* rowp = P + (size_t)(row0 + ai * HALF + m * 16) * INW + col0;
#pragma unroll
                    for (int bj = 0; bj < 2; ++bj) { const f32x4 v0 = acc[ai][bj][m][0] * ASC, v1 = acc[ai][bj][m][1] * ASC;
                        u32x4 w; w.x = cvt_pk_bf16(v0[0], v0[1]); w.y = cvt_pk_bf16(v0[2], v0[3]); w.z = cvt_pk_bf16(v1[0], v1[1]); w.w = cvt_pk_bf16(v1[2], v1[3]);
#ifdef PROBE_LINSTORE
                        if (PLAIN) {
#if PROBE_LINSTORE == 2
                            *((u32x4*)P + ((size_t)blockIdx.x * 8192 + (((wr * 4 + wc) * 16 + (ai * 4 + m) * 2 + bj) * 64 + fq * 16 + fr))) = w; continue;
#else
                            *((u32x4*)P + ((size_t)(u.pm * 18 + u.pn) * 8192 + (((wr * 4 + wc) * 16 + (ai * 4 + m) * 2 + bj) * 64 + fq * 16 + fr))) = w; continue;
#endif
                        }
#endif
                        PSTORE_SEL(grp == 0, (u32x4*)(rowp + bj * HALF), w); } }
        } else if (grp == 1 || grp == 2) {
            const int cg = col0 - grp * 512;
            f32x4 lbv[2][2];
#pragma unroll
            for (int bj = 0; bj < 2; ++bj)
#pragma unroll
                for (int n = 0; n < 2; ++n) lbv[bj][n] = *(const f32x4*)(lb + cg + bj * HALF + 4 * n);
#pragma unroll
            for (int ai = 0; ai < 2; ++ai)
#pragma unroll
                for (int m = 0; m < 4; ++m) { bf16_t* rowp = P + (size_t)(row0 + ai * HALF + m * 16) * INW + col0;
#pragma unroll
                    for (int bj = 0; bj < 2; ++bj) { f32x4 v[2];
#pragma unroll
                        for (int n = 0; n < 2; ++n)
#pragma unroll
                            for (int h = 0; h < 2; ++h) { const f32x2 z = (f32x2){acc[ai][bj][m][n][2 * h], acc[ai][bj][m][n][2 * h + 1]} * ASC, l0 = {lbv[bj][n][2 * h], lbv[bj][n][2 * h + 1]};
                                const f32x2 x = z * (-1.4426950408889634f); const f32x2 d = (f32x2){__builtin_amdgcn_exp2f(x.x), __builtin_amdgcn_exp2f(x.y)} + 1.0f;
                                f32x2 f = l0 + ((f32x2){1.0f, 1.0f} - l0) * (f32x2){__builtin_amdgcn_rcpf(d.x), __builtin_amdgcn_rcpf(d.y)}; f = __builtin_elementwise_max(f, (f32x2){1e-30f, 1e-30f});
#ifndef SCAN_LOG2
                                const f32x2 r = (f32x2){__builtin_amdgcn_logf(f.x), __builtin_amdgcn_logf(f.y)} * 0.6931471805599453f;
#else
                                const f32x2 r = (f32x2){__builtin_amdgcn_logf(f.x), __builtin_amdgcn_logf(f.y)};
#endif
                                v[n][2 * h] = r.x; v[n][2 * h + 1] = r.y; }
                        u32x4 w; w.x = cvt_pk_bf16(v[0][0], v[0][1]); w.y = cvt_pk_bf16(v[0][2], v[0][3]); w.z = cvt_pk_bf16(v[1][0], v[1][1]); w.w = cvt_pk_bf16(v[1][2], v[1][3]);
                        PSTORE((u32x4*)(rowp + bj * HALF), w); } }
        } else if (grp == 4 || grp == 8) {
#pragma unroll
            for (int ai = 0; ai < 2; ++ai)
#pragma unroll
                for (int m = 0; m < 4; ++m) { bf16_t* rowp = P + (size_t)(row0 + ai * HALF + m * 16) * INW + col0;
#pragma unroll
                    for (int bj = 0; bj < 2; ++bj) { f32x4 v[2];
#pragma unroll
                        for (int n = 0; n < 2; ++n)
#pragma unroll
                            for (int h = 0; h < 2; ++h) { const f32x2 z = (f32x2){acc[ai][bj][m][n][2 * h], acc[ai][bj][m][n][2 * h + 1]} * ASC; const f32x2 x = z * (-1.4426950408889634f);
                                const f32x2 d = (f32x2){__builtin_amdgcn_exp2f(x.x), __builtin_amdgcn_exp2f(x.y)} + 1.0f; const f32x2 r = z * (f32x2){__builtin_amdgcn_rcpf(d.x), __builtin_amdgcn_rcpf(d.y)};
                                v[n][2 * h] = r.x; v[n][2 * h + 1] = r.y; }
                        u32x4 w; w.x = cvt_pk_bf16(v[0][0], v[0][1]); w.y = cvt_pk_bf16(v[0][2], v[0][3]); w.z = cvt_pk_bf16(v[1][0], v[1][1]); w.w = cvt_pk_bf16(v[1][2], v[1][3]);
                        PSTORE_SEL(true, (u32x4*)(rowp + bj * HALF), w); } }
        } else {
            const float sc = ((grp == 6) ? 0.08838834764831845f : 1.0f) * ASC;
            const int f0 = 16 * (wc & 1) + 4 * fq;
#pragma unroll
            for (int ai = 0; ai < 2; ++ai)
#pragma unroll
                for (int m = 0; m < 4; ++m) { const int row = row0 + ai * HALF + m * 16; bf16_t* rowp = P + (size_t)row * INW + col0;
                    int g = row; if (g >= LTOT) g -= LTOT;
                    int pos = 0; if (g >= CTX) { const int nn = g - CTX; pos = (wc < 2) ? (nn >> 6) : (nn & 63); }
                    const f32x4 t0 = *(const f32x4*)(cs + (size_t)(pos * 32 + f0) * 2), t1 = *(const f32x4*)(cs + (size_t)(pos * 32 + f0) * 2 + 4);
#pragma unroll
                    for (int bj = 0; bj < 2; ++bj) { const f32x4 v0 = acc[ai][bj][m][0] * sc, v1 = acc[ai][bj][m][1] * sc;
                        const float a0 = v0[0] * t0[0] - v0[1] * t0[1], a1 = v0[0] * t0[1] + v0[1] * t0[0];
                        const float a2 = v0[2] * t0[2] - v0[3] * t0[3], a3 = v0[2] * t0[3] + v0[3] * t0[2];
                        const float b0 = v1[0] * t1[0] - v1[1] * t1[1], b1 = v1[0] * t1[1] + v1[1] * t1[0];
                        const float b2 = v1[2] * t1[2] - v1[3] * t1[3], b3 = v1[2] * t1[3] + v1[3] * t1[2];
                        u32x4 w; w.x = cvt_pk_bf16(a0, a1); w.y = cvt_pk_bf16(a2, a3); w.z = cvt_pk_bf16(b0, b1); w.w = cvt_pk_bf16(b2, b3);
                        PSTORE_SEL(grp == 5, (u32x4*)(rowp + bj * HALF), w); } }
        }
    }
};

using EpiIn = EpiInT<false>;
using EpiIn8 = EpiInT<false, true>;

struct EpiNull { static constexpr bool PERM = true, AFTER_DRAIN = false, A_STREAM = false; float* sink;
    __device__ __forceinline__ void operator()(const f32x4 (&acc)[2][2][4][2], const Unit& u, int wr, int wc, int fr, int fq) const { f32x4 s = acc[0][0][0][0]; _Pragma("unroll") for (int a = 0; a < 2; ++a) _Pragma("unroll") for (int b = 0; b < 2; ++b) _Pragma("unroll") for (int m = 0; m < 4; ++m) _Pragma("unroll") for (int n = 0; n < 2; ++n) s += acc[a][b][m][n]; if (s[0] == 123.456f && u.pm < 0) sink[fr + fq + wr + wc] = s[1]; } };

#ifdef NT_MORE2
#define EPI_LDNT(p_) __builtin_nontemporal_load(p_)
#else
#define EPI_LDNT(p_) (*(p_))
#endif
template <bool F8>
struct EpiOutT {
    static constexpr bool PERM = true, AFTER_DRAIN = false, A_STREAM = true; static constexpr float ASC = F8 ? 1.0f / (F8_SA * F8_SW) : 1.0f;
    bf16_t* X; const float* xin; const float* cin; const float* gt;
    __device__ __forceinline__ void operator()(const f32x4 (&acc)[2][2][4][2], const Unit& u, int wr, int wc, int fr, int fq) const {
        const int b = u.pm / 65, tb = u.pm - b * 65, which = (tb == 0) ? 2 : b;
        const int row0 = u.pm * BM + wr * 64 + fr, col0 = u.pn * BM + wc * 32 + 8 * fq;
        f32x4 gv[2][2];
#pragma unroll
        for (int bj = 0; bj < 2; ++bj)
#pragma unroll
            for (int n = 0; n < 2; ++n) gv[bj][n] = *(const f32x4*)(gt + which * 6144 + col0 + bj * HALF + 4 * n) * ASC;
#pragma unroll
        for (int ai = 0; ai < 2; ++ai)
#pragma unroll
            for (int m = 0; m < 4; ++m) { const int row = row0 + ai * HALF + m * 16; bf16_t* op = X + (size_t)row * D + col0;
#pragma unroll
                for (int bj = 0; bj < 2; ++bj) { f32x4 b0, b1;
                    if (xin) { const int g = row - b * LTOT; const float* bp = (g < CTX ? cin + (size_t)(b * CTX + g) * D : xin + (size_t)(b * SEQ + g - CTX) * D) + col0 + bj * HALF; b0 = EPI_LDNT((const f32x4*)bp); b1 = EPI_LDNT((const f32x4*)(bp + 4)); }
                    else { const u32x4 w = EPI_LDNT((const u32x4*)(op + bj * HALF)); b0 = (f32x4){__uint_as_float(w.x << 16), __uint_as_float(w.x & 0xffff0000u), __uint_as_float(w.y << 16), __uint_as_float(w.y & 0xffff0000u)};
                        b1 = (f32x4){__uint_as_float(w.z << 16), __uint_as_float(w.z & 0xffff0000u), __uint_as_float(w.w << 16), __uint_as_float(w.w & 0xffff0000u)}; }
                    const f32x4 v0 = b0 + gv[bj][0] * acc[ai][bj][m][0], v1 = b1 + gv[bj][1] * acc[ai][bj][m][1];
                    u32x4 o; o.x = cvt_pk_bf16(v0[0], v0[1]); o.y = cvt_pk_bf16(v0[2], v0[3]); o.z = cvt_pk_bf16(v1[0], v1[1]); o.w = cvt_pk_bf16(v1[2], v1[3]);
                    *(u32x4*)(op + bj * HALF) = o; }
                if (F8) __builtin_amdgcn_sched_barrier(0); }
    }
};

using EpiOut = EpiOutT<false>;
using EpiOut8 = EpiOutT<true>;

__device__ __forceinline__ unsigned pk4_fp8(float a, float b, float c, float d) {
    a = __builtin_amdgcn_fmed3f(a, -448.f, 448.f); b = __builtin_amdgcn_fmed3f(b, -448.f, 448.f); c = __builtin_amdgcn_fmed3f(c, -448.f, 448.f); d = __builtin_amdgcn_fmed3f(d, -448.f, 448.f);
    unsigned w = 0; w = __builtin_amdgcn_cvt_pk_fp8_f32(a, b, w, false); w = __builtin_amdgcn_cvt_pk_fp8_f32(c, d, w, true); return w; }
#ifdef NT_MOE
#define MOE_ST(p_, v_) __builtin_nontemporal_store((v_), (p_))
#else
#define MOE_ST(p_, v_) (*(p_) = (v_))
#endif
struct EpiGU {
    static constexpr bool PERM = true, AFTER_DRAIN = false, A_STREAM = false;
    unsigned char* HID;
    __device__ __forceinline__ void operator()(const f32x4 (&acc)[2][2][4][2], const Unit& u, int wr, int wc, int fr, int fq) const {
        const int row0 = u.pm * BM + wr * 64 + fr, col0 = (u.pn & 15) * HALF + wc * 32 + 8 * fq;
        constexpr float inv = 1.0f / (F8_SA * F8_SW);
#pragma unroll
        for (int ai = 0; ai < 2; ++ai)
#pragma unroll
            for (int m = 0; m < 4; ++m) { unsigned char* rowp = HID + (size_t)(row0 + ai * HALF + m * 16) * FF + col0; f32x4 v[2];
#pragma unroll
                for (int n = 0; n < 2; ++n)
#pragma unroll
                    for (int h = 0; h < 2; ++h) {
                        const f32x2 a0 = {acc[ai][0][m][n][2 * h], acc[ai][0][m][n][2 * h + 1]}, a1 = {acc[ai][1][m][n][2 * h], acc[ai][1][m][n][2 * h + 1]};
                        const f32x2 x = a0 * (-inv * 1.4426950408889634f); const f32x2 d = (f32x2){__builtin_amdgcn_exp2f(x.x), __builtin_amdgcn_exp2f(x.y)} + 1.0f;
                        const f32x2 r = (a0 * a1) * (inv * inv * F8_SH) * (f32x2){__builtin_amdgcn_rcpf(d.x), __builtin_amdgcn_rcpf(d.y)};
                        v[n][2 * h] = r.x; v[n][2 * h + 1] = r.y; }
                u32x2 w; w.x = pk4_fp8(v[0][0], v[0][1], v[0][2], v[0][3]); w.y = pk4_fp8(v[1][0], v[1][1], v[1][2], v[1][3]);
                MOE_ST((u32x2*)rowp, w); }
    }
};

struct EpiDown {
    static constexpr bool PERM = true, AFTER_DRAIN = false, A_STREAM = true;
    unsigned char* YS;
    __device__ __forceinline__ void operator()(const f32x4 (&acc)[2][2][4][2], const Unit& u, int wr, int wc, int fr, int fq) const {
        const int row0 = u.pm * BM + wr * 64 + fr, col0 = (u.pn & 3) * BM + wc * 32 + 8 * fq;
        constexpr float gg = F8_SY / (F8_SH * F8_SW);
#pragma unroll
        for (int ai = 0; ai < 2; ++ai)
#pragma unroll
            for (int m = 0; m < 4; ++m) { unsigned char* rowp = YS + (size_t)(row0 + ai * HALF + m * 16) * D + col0;
#pragma unroll
                for (int bj = 0; bj < 2; ++bj) { const f32x4 v0 = acc[ai][bj][m][0] * gg, v1 = acc[ai][bj][m][1] * gg;
                    u32x2 w; w.x = pk4_fp8(v0[0], v0[1], v0[2], v0[3]); w.y = pk4_fp8(v1[0], v1[1], v1[2], v1[3]);
                    MOE_ST((u32x2*)(rowp + bj * HALF), w); } }
    }
};

typedef int i32x4v __attribute__((ext_vector_type(4)));
typedef int i32x8v __attribute__((ext_vector_type(8)));
__device__ __forceinline__ i32x8v cat8(bf16x8 lo, bf16x8 hi) { const i32x4v a = __builtin_bit_cast(i32x4v, lo), b = __builtin_bit_cast(i32x4v, hi); return __builtin_shufflevector(a, b, 0, 1, 2, 3, 4, 5, 6, 7); }
template <class Epi, class Sched, bool GATHER>
__device__ __forceinline__ void gemm_phase_f8(PG8_LAS unsigned char* lds, const Gemm g, const Sched& S, const Epi& E, const int* rowmap) {
    const int tid = opaque_tid(g.w0), wid = __builtin_amdgcn_readfirstlane(tid >> 6), lane = tid & 63, wr = wid >> 2, wc = wid & 3, fr = lane & 15, fq = lane >> 4;
    const int rowb = g.K, nt = rowb / 128;
    unsigned vA0[2], vA1[2], voffB[2];
#pragma unroll
    for (int i = 0; i < 2; ++i) { int R, C; stage_rc(tid * 16 + i * 8192, R, C); const int Rb = Epi::PERM ? ((R & ~31) + perm32(R & 31)) : R;
        voffB[i] = (unsigned)(Rb * rowb + 2 * C); vA0[i] = (unsigned)(R * rowb + 2 * C); vA1[i] = vA0[i]; }
    const size_t kstep = 128;
    const size_t hstep = (size_t)HALF * rowb;
    const size_t tstep = 2 * hstep;
    const unsigned ldsw = (unsigned)wid * 1024u;
    const int aoff = lds_byte(wr * 64 + fr, fq * 8), boff = lds_byte(wc * 32 + fr, fq * 8);
    constexpr int GOFF = STAGE_BYTES;
#define PG8_SA(b, h) (((b) * 2 + (h)) * HTB)
#define PG8_SB(b, h) ((4 + (b) * 2 + (h)) * HTB)
#define PG8_STAGE(bufoff, gbase, voff) do { _Pragma("unroll") for (int _i = 0; _i < 2; ++_i) { unsigned _o = (voff)[_i]; asm volatile("" : "+v"(_o)); \
        __builtin_amdgcn_global_load_lds((const unsigned*)((const char*)(gbase) + _o), (PG8_LAS unsigned*)(lds + (bufoff) + ldsw + _i * 8192), 16, 0, 0); } } while (0)
#ifdef A_STREAM_NT
#define PG8_STAGE_NT(bufoff, gbase, voff) do { _Pragma("unroll") for (int _i = 0; _i < 2; ++_i) { unsigned _o = (voff)[_i]; asm volatile("" : "+v"(_o)); \
        __builtin_amdgcn_global_load_lds((const unsigned*)((const char*)(gbase) + _o), (PG8_LAS unsigned*)(lds + (bufoff) + ldsw + _i * 8192), 16, 0, 2); } } while (0)
#define PG8_STAGE_A(bufoff, kbase, h) do { if constexpr (GATHER) { if (h) PG8_STAGE(bufoff, kbase, vA1); else PG8_STAGE(bufoff, kbase, vA0); } else if constexpr (Epi::A_STREAM) PG8_STAGE_NT(bufoff, (kbase) + (h) * hstep, vA0); else PG8_STAGE(bufoff, (kbase) + (h) * hstep, vA0); } while (0)
#else
#define PG8_STAGE_A(bufoff, kbase, h) do { if constexpr (GATHER) { if (h) PG8_STAGE(bufoff, kbase, vA1); else PG8_STAGE(bufoff, kbase, vA0); } else PG8_STAGE(bufoff, (kbase) + (h) * hstep, vA0); } while (0)
#endif
#define PG8_GIDX_ISSUE(pm_) do { const int _t = opaque_tid(g.w0); _Pragma("unroll") for (int _i = 0; _i < 2; ++_i) { int R, C; stage_rc(_t * 16 + _i * 8192, R, C); _Pragma("unroll") for (int _h = 0; _h < 2; ++_h) \
        __builtin_amdgcn_global_load_lds((const unsigned*)(rowmap + (pm_) * BM + _h * HALF + R), (PG8_LAS unsigned*)(lds + GOFF + ldsw + (_h * 2 + _i) * 256), 4, 0, 0); } } while (0)
#define PG8_GIDX_TAKE() do { const int _t = opaque_tid(g.w0); _Pragma("unroll") for (int _i = 0; _i < 2; ++_i) { int R, C; stage_rc(_t * 16 + _i * 8192, R, C); \
        vA0[_i] = *(const PG8_LAS unsigned*)(lds + GOFF + ldsw + (0 * 2 + _i) * 256 + (_t & 63) * 4) * (unsigned)rowb + (unsigned)(2 * C); \
        vA1[_i] = *(const PG8_LAS unsigned*)(lds + GOFF + ldsw + (1 * 2 + _i) * 256 + (_t & 63) * 4) * (unsigned)rowb + (unsigned)(2 * C); } } while (0)
#define PG8_LDA(dst, b, h) do { _Pragma("unroll") for (int m = 0; m < 4; ++m) _Pragma("unroll") for (int k = 0; k < 2; ++k) dst[m][k] = *(const PG8_LAS bf16x8*)(lds + PG8_SA(b, h) + aoff + m * 2048 + k * 1024); } while (0)
#define PG8_LDB(dst, b, h) do { _Pragma("unroll") for (int n = 0; n < 2; ++n) _Pragma("unroll") for (int k = 0; k < 2; ++k) dst[n][k] = *(const PG8_LAS bf16x8*)(lds + PG8_SB(b, h) + boff + n * 2048 + k * 1024); } while (0)
#ifdef GEMM_PRIO_EARLY
#define PG8_PRIO_EARLY() __builtin_amdgcn_s_setprio(1)
#else
#define PG8_PRIO_EARLY() do { } while (0)
#endif
#ifdef GEMM_STATIC_PRIO
#define PG8_PRIO(v_) do { } while (0)
#else
#define PG8_PRIO(v_) __builtin_amdgcn_s_setprio(v_)
#endif
#define PG8_MMA(ai, bj, At, Bt) do { PG8_PRIO(1); _Pragma("unroll") for (int m = 0; m < 4; ++m) _Pragma("unroll") for (int n = 0; n < 2; ++n) \
        acc[ai][bj][m][n] = __builtin_amdgcn_mfma_scale_f32_16x16x128_f8f6f4(cat8(Bt[n][0], Bt[n][1]), cat8(At[m][0], At[m][1]), acc[ai][bj][m][n], 0, 0, 0, 0, 0, 0); PG8_PRIO(0); } while (0)
#define PG8_WAIT_V(n) asm volatile("s_waitcnt vmcnt(" #n ")" ::: "memory")
#define PG8_WAIT_L(n) asm volatile("s_waitcnt lgkmcnt(" #n ")" ::: "memory")
#define PG8_BAR __builtin_amdgcn_s_barrier()
#define PG8_SCHED __builtin_amdgcn_sched_barrier(0)
    Unit cur, nxt; int ui = 0;
    if (!S.next(0, cur)) return;
#ifdef GEMM_STATIC_PRIO
    if (wr == 1) __builtin_amdgcn_s_setprio(1);
#endif
    bool half = Sched::PADTILES && S.half_rows(cur);
    f32x4 acc[2][2][4][2];
#pragma unroll
    for (int a = 0; a < 2; ++a)
#pragma unroll
        for (int b = 0; b < 2; ++b)
#pragma unroll
            for (int m = 0; m < 4; ++m)
#pragma unroll
                for (int n = 0; n < 2; ++n) acc[a][b][m][n] = (f32x4){0.f, 0.f, 0.f, 0.f};
    bf16x8 At[4][2], B0[2][2], B1[2][2];
    const char* cA; const char* cB = (const char*)g.Bt + (size_t)cur.pn * tstep;
    if constexpr (GATHER) { cA = (const char*)g.A; PG8_GIDX_ISSUE(cur.pm); PG8_WAIT_V(0); PG8_GIDX_TAKE(); }
    else cA = (const char*)g.A + (size_t)cur.pm * tstep;
    PG8_STAGE(PG8_SB(0, 0), cB, voffB); PG8_STAGE(PG8_SB(0, 1), cB + hstep, voffB); PG8_STAGE_A(PG8_SA(0, 0), cA, 0); PG8_STAGE_A(PG8_SA(0, 1), cA, 1);
    if (wr == 1) PG8_BAR;
    PG8_WAIT_V(2); PG8_BAR;
    PG8_STAGE(PG8_SB(1, 0), cB + kstep, voffB); PG8_STAGE_A(PG8_SA(1, 0), cA + kstep, 0); PG8_STAGE(PG8_SB(1, 1), cB + hstep + kstep, voffB);
    PG8_WAIT_V(6); PG8_BAR;
    for (;;) {
        const bool has_next = S.next(ui + 1, nxt);
        const char* nA; const char* nB = has_next ? (const char*)g.Bt + (size_t)nxt.pn * tstep : cB;
        if constexpr (GATHER) { nA = cA; if (has_next) PG8_GIDX_ISSUE(nxt.pm); }
        else nA = has_next ? (const char*)g.A + (size_t)nxt.pm * tstep : cA;
#pragma unroll 1
        for (int t = 0; t < nt; t += 2) {
            const bool last = (t == nt - 2);
            const char* a1 = cA + (size_t)(t + 1) * kstep;
            const char* a2 = last ? nA : cA + (size_t)(t + 2) * kstep; const char* b2 = last ? nB : cB + (size_t)(t + 2) * kstep;
            const char* a3 = a2 + kstep; const char* b3 = b2 + kstep;
            PG8_LDB(B0, 0, 0); PG8_LDB(B1, 0, 1); PG8_SCHED; PG8_LDA(At, 0, 0); PG8_STAGE_A(PG8_SA(1, 1), a1, 1);
            if constexpr (GATHER) { if (last && has_next) PG8_GIDX_TAKE(); }
            PG8_WAIT_V(8); PG8_WAIT_L(0); PG8_PRIO_EARLY(); PG8_BAR; if (!(half && wr == 1)) { PG8_MMA(0, 0, At, B0); PG8_MMA(0, 1, At, B1); } PG8_BAR; PG8_SCHED;
            PG8_LDA(At, 0, 1); PG8_STAGE(PG8_SB(0, 0), b2, voffB); PG8_STAGE(PG8_SB(0, 1), b2 + hstep, voffB); PG8_STAGE_A(PG8_SA(0, 0), a2, 0);
            PG8_WAIT_V(8); PG8_WAIT_L(0); PG8_PRIO_EARLY(); PG8_BAR; if (!half) { PG8_MMA(1, 0, At, B0); PG8_MMA(1, 1, At, B1); } PG8_BAR; PG8_SCHED;
            PG8_LDB(B0, 1, 0); PG8_LDB(B1, 1, 1); PG8_SCHED; PG8_LDA(At, 1, 0); PG8_STAGE_A(PG8_SA(0, 1), a2, 1);
            PG8_WAIT_V(8); PG8_WAIT_L(0); PG8_PRIO_EARLY(); PG8_BAR; if (!(half && wr == 1)) { PG8_MMA(0, 0, At, B0); PG8_MMA(0, 1, At, B1); } PG8_BAR; PG8_SCHED;
            PG8_LDA(At, 1, 1); PG8_STAGE(PG8_SB(1, 0), b3, voffB); PG8_STAGE(PG8_SB(1, 1), b3 + hstep, voffB); PG8_STAGE_A(PG8_SA(1, 0), a3, 0);
            PG8_WAIT_V(8); PG8_WAIT_L(0); PG8_PRIO_EARLY(); PG8_BAR; if (!half) { PG8_MMA(1, 0, At, B0); PG8_MMA(1, 1, At, B1); } PG8_BAR; PG8_SCHED;
        }
        if (wr == 0) PG8_BAR;
        { const int l2_ = opaque_tid(g.w0) & 63; E(acc, cur, wr, wc, l2_ & 15, l2_ >> 4); }
#ifdef G2_F8
        { const int t2_ = opaque_tid(g.w0);
#pragma unroll
          for (int i = 0; i < 2; ++i) { int R, C; stage_rc(t2_ * 16 + i * 8192, R, C); const int Rb = Epi::PERM ? ((R & ~31) + perm32(R & 31)) : R;
              voffB[i] = (unsigned)(Rb * rowb + 2 * C); if constexpr (!GATHER) { vA0[i] = (unsigned)(R * rowb + 2 * C); vA1[i] = vA0[i]; } } }
#endif
        if (!has_next) break;
#pragma unroll
        for (int a = 0; a < 2; ++a)
#pragma unroll
            for (int b = 0; b < 2; ++b)
#pragma unroll
                for (int m = 0; m < 4; ++m)
#pragma unroll
                    for (int n = 0; n < 2; ++n) acc[a][b][m][n] = (f32x4){0.f, 0.f, 0.f, 0.f};
        cur = nxt; cA = nA; cB = nB; ++ui; half = Sched::PADTILES && S.half_rows(cur);
        if (wr == 1) PG8_BAR;
    }
#ifdef GEMM_STATIC_PRIO
    __builtin_amdgcn_s_setprio(0);
#endif
    PG8_WAIT_V(0);
    PG8_BAR;
#undef PG8_SA
#undef PG8_SB
#undef PG8_STAGE
#undef PG8_STAGE_A
#ifdef A_STREAM_NT
#undef PG8_STAGE_NT
#endif
#undef PG8_GIDX_ISSUE
#undef PG8_GIDX_TAKE
#undef PG8_LDA
#undef PG8_LDB
#undef PG8_MMA
#undef PG8_PRIO
#undef PG8_PRIO_EARLY
#undef PG8_WAIT_V
#undef PG8_WAIT_L
#undef PG8_BAR
#undef PG8_SCHED
}
template <class Epi, class Sched, bool ALIGN_EPI = false, bool SP2 = false>
__device__ __forceinline__ void gemm_phase(PG8_LAS unsigned char* lds, const Gemm g, const Sched& S, const Epi& E) {
    const int tid = opaque_tid(g.w0), wid = __builtin_amdgcn_readfirstlane(tid >> 6), lane = tid & 63, wr = wid >> 2, wc = wid & 3, fr = lane & 15, fq = lane >> 4;
    const int K = g.K, nt = K / BK;
    unsigned voffA[2], voffB[2];
#pragma unroll
    for (int i = 0; i < 2; ++i) { int R, C; stage_rc(tid * 16 + i * 8192, R, C); const int Rb = Epi::PERM ? ((R & ~31) + perm32(R & 31)) : R;
        voffA[i] = (unsigned)(R * K + C) * 2u; voffB[i] = (unsigned)(Rb * K + C) * 2u; }
    const size_t kstep = (size_t)(BK * 2);
    const size_t hstep = (size_t)HALF * K * 2;
    const size_t tstep = 2 * hstep;
    const unsigned ldsw = (unsigned)wid * 1024u;
    const int aoff = lds_byte(wr * 64 + fr, fq * 8), boff = lds_byte(wc * 32 + fr, fq * 8);
#define PG8_SA(b, h) (((b) * 2 + (h)) * HTB)
#define PG8_SB(b, h) ((4 + (b) * 2 + (h)) * HTB)
#define PG8_STAGE(bufoff, gbase, voff) do { _Pragma("unroll") for (int _i = 0; _i < 2; ++_i) \
        __builtin_amdgcn_global_load_lds((const unsigned*)((const char*)(gbase) + (voff)[_i]), (PG8_LAS unsigned*)(lds + (bufoff) + ldsw + _i * 8192), 16, 0, 0); } while (0)
#ifdef A_STREAM_NT
#define PG8_STAGE_AOP(bufoff, gbase, voff) do { if constexpr (Epi::A_STREAM) { _Pragma("unroll") for (int _i = 0; _i < 2; ++_i) \
        __builtin_amdgcn_global_load_lds((const unsigned*)((const char*)(gbase) + (voff)[_i]), (PG8_LAS unsigned*)(lds + (bufoff) + ldsw + _i * 8192), 16, 0, 2); } else PG8_STAGE(bufoff, gbase, voff); } while (0)
#else
#define PG8_STAGE_AOP(bufoff, gbase, voff) PG8_STAGE(bufoff, gbase, voff)
#endif
#define PG8_LDA(dst, b, h) do { _Pragma("unroll") for (int m = 0; m < 4; ++m) _Pragma("unroll") for (int k = 0; k < 2; ++k) dst[m][k] = *(const PG8_LAS bf16x8*)(lds + PG8_SA(b, h) + aoff + m * 2048 + k * 1024); } while (0)
#define PG8_LDB(dst, b, h) do { _Pragma("unroll") for (int n = 0; n < 2; ++n) _Pragma("unroll") for (int k = 0; k < 2; ++k) dst[n][k] = *(const PG8_LAS bf16x8*)(lds + PG8_SB(b, h) + boff + n * 2048 + k * 1024); } while (0)
#ifdef GEMM_PRIO_EARLY
#define PG8_PRIO_EARLY() __builtin_amdgcn_s_setprio(1)
#else
#define PG8_PRIO_EARLY() do { } while (0)
#endif
#ifdef GEMM_STATIC_PRIO
#define PG8_PRIO(v_) do { } while (0)
#else
#define PG8_PRIO(v_) __builtin_amdgcn_s_setprio(v_)
#endif
#define PG8_MMA(ai, bj, At, Bt) do { PG8_PRIO(1); _Pragma("unroll") for (int m = 0; m < 4; ++m) _Pragma("unroll") for (int n = 0; n < 2; ++n) _Pragma("unroll") for (int k = 0; k < 2; ++k) \
        acc[ai][bj][m][n] = __builtin_amdgcn_mfma_f32_16x16x32_bf16(Bt[n][k], At[m][k], acc[ai][bj][m][n], 0, 0, 0); PG8_PRIO(0); } while (0)
#define PG8_WAIT_V(n) asm volatile("s_waitcnt vmcnt(" #n ")" ::: "memory")
#define PG8_WAIT_L(n) asm volatile("s_waitcnt lgkmcnt(" #n ")" ::: "memory")
#define PG8_BAR __builtin_amdgcn_s_barrier()
#define PG8_SCHED __builtin_amdgcn_sched_barrier(0)
    Unit cur, nxt; int ui = 0;
    if (!S.next(0, cur)) return;
#ifdef GEMM_STATIC_PRIO
    if (wr == 1) __builtin_amdgcn_s_setprio(1);
#endif
    f32x4 acc[2][2][4][2];
#pragma unroll
    for (int a = 0; a < 2; ++a)
#pragma unroll
        for (int b = 0; b < 2; ++b)
#pragma unroll
            for (int m = 0; m < 4; ++m)
#pragma unroll
                for (int n = 0; n < 2; ++n) acc[a][b][m][n] = (f32x4){0.f, 0.f, 0.f, 0.f};
    bf16x8 At[4][2], B0[2][2], B1[2][2];
    const char* cA = (const char*)g.A + (size_t)cur.pm * tstep; const char* cB = (const char*)g.Bt + (size_t)cur.pn * tstep;
    S.a_ready(cur);
    if constexpr (SP2) {
        PG8_STAGE(PG8_SB(0, 0), cB, voffB); PG8_STAGE(PG8_SB(0, 1), cB + hstep, voffB); PG8_STAGE_AOP(PG8_SA(0, 0), cA, voffA); PG8_STAGE_AOP(PG8_SA(0, 1), cA + hstep, voffA);
        if (wr == 1) PG8_BAR;
        PG8_WAIT_V(2); PG8_BAR;
        PG8_STAGE(PG8_SB(1, 0), cB + kstep, voffB); PG8_STAGE_AOP(PG8_SA(1, 0), cA + kstep, voffA); PG8_STAGE(PG8_SB(1, 1), cB + hstep + kstep, voffB);
        PG8_WAIT_V(6); PG8_BAR;
    } else {
        PG8_STAGE(PG8_SB(0, 0), cB, voffB); PG8_STAGE_AOP(PG8_SA(0, 0), cA, voffA); PG8_STAGE(PG8_SB(0, 1), cB + hstep, voffB); PG8_STAGE_AOP(PG8_SA(0, 1), cA + hstep, voffA);
        if (wr == 1) PG8_BAR;
        PG8_WAIT_V(4); PG8_BAR;
        PG8_STAGE(PG8_SB(1, 0), cB + kstep, voffB); PG8_STAGE_AOP(PG8_SA(1, 0), cA + kstep, voffA); PG8_STAGE(PG8_SB(1, 1), cB + hstep + kstep, voffB);
        PG8_WAIT_V(6); PG8_BAR;
    }
    for (;;) {
        const bool has_next = S.next(ui + 1, nxt);
        const char* nA = has_next ? (const char*)g.A + (size_t)nxt.pm * tstep : cA; const char* nB = has_next ? (const char*)g.Bt + (size_t)nxt.pn * tstep : cB;
        for (int t = 0; t < nt; t += 2) {
            const bool last = (t == nt - 2);
            const char* a1 = cA + (size_t)(t + 1) * kstep;
            const char* a2 = last ? nA : cA + (size_t)(t + 2) * kstep; const char* b2 = last ? nB : cB + (size_t)(t + 2) * kstep;
            const char* a3 = a2 + kstep; const char* b3 = b2 + kstep;
            if (last && has_next) S.a_ready(nxt);
            if constexpr (SP2) {
            PG8_LDB(B0, 0, 0); PG8_LDB(B1, 0, 1); PG8_SCHED; PG8_LDA(At, 0, 0); PG8_STAGE_AOP(PG8_SA(1, 1), a1 + hstep, voffA);
            PG8_WAIT_V(8); PG8_WAIT_L(0); PG8_PRIO_EARLY(); PG8_BAR; PG8_MMA(0, 0, At, B0); PG8_MMA(0, 1, At, B1); PG8_BAR; PG8_SCHED;
            PG8_LDA(At, 0, 1); PG8_STAGE(PG8_SB(0, 0), b2, voffB); PG8_STAGE(PG8_SB(0, 1), b2 + hstep, voffB); PG8_STAGE_AOP(PG8_SA(0, 0), a2, voffA);
            PG8_WAIT_V(8); PG8_WAIT_L(0); PG8_PRIO_EARLY(); PG8_BAR; PG8_MMA(1, 0, At, B0); PG8_MMA(1, 1, At, B1); PG8_BAR; PG8_SCHED;
            PG8_LDB(B0, 1, 0); PG8_LDB(B1, 1, 1); PG8_SCHED; PG8_LDA(At, 1, 0); PG8_STAGE_AOP(PG8_SA(0, 1), a2 + hstep, voffA);
            PG8_WAIT_V(8); PG8_WAIT_L(0); PG8_PRIO_EARLY(); PG8_BAR; PG8_MMA(0, 0, At, B0); PG8_MMA(0, 1, At, B1); PG8_BAR; PG8_SCHED;
            PG8_LDA(At, 1, 1); PG8_STAGE(PG8_SB(1, 0), b3, voffB); PG8_STAGE(PG8_SB(1, 1), b3 + hstep, voffB); PG8_STAGE_AOP(PG8_SA(1, 0), a3, voffA);
            PG8_WAIT_V(8); PG8_WAIT_L(0); PG8_PRIO_EARLY(); PG8_BAR; PG8_MMA(1, 0, At, B0); PG8_MMA(1, 1, At, B1); PG8_BAR; PG8_SCHED;
            } else {
            PG8_LDB(B0, 0, 0); PG8_SCHED; PG8_LDA(At, 0, 0); PG8_STAGE_AOP(PG8_SA(1, 1), a1 + hstep, voffA);
            PG8_WAIT_L(8); PG8_BAR; PG8_WAIT_L(0); PG8_MMA(0, 0, At, B0); PG8_BAR; PG8_SCHED;
            PG8_LDB(B1, 0, 1); PG8_STAGE(PG8_SB(0, 0), b2, voffB);
            PG8_BAR; PG8_WAIT_L(0); PG8_MMA(0, 1, At, B1); PG8_BAR;
            PG8_LDA(At, 0, 1); PG8_STAGE_AOP(PG8_SA(0, 0), a2, voffA);
            PG8_BAR; PG8_WAIT_L(0); PG8_MMA(1, 0, At, B0); PG8_BAR; PG8_SCHED;
            PG8_STAGE(PG8_SB(0, 1), b2 + hstep, voffB);
            PG8_WAIT_V(6); PG8_BAR; PG8_MMA(1, 1, At, B1); PG8_BAR;
            PG8_LDB(B0, 1, 0); PG8_SCHED; PG8_LDA(At, 1, 0); PG8_STAGE_AOP(PG8_SA(0, 1), a2 + hstep, voffA);
            PG8_WAIT_L(8); PG8_BAR; PG8_WAIT_L(0); PG8_MMA(0, 0, At, B0); PG8_BAR; PG8_SCHED;
            PG8_LDB(B1, 1, 1); PG8_STAGE(PG8_SB(1, 0), b3, voffB);
            PG8_BAR; PG8_WAIT_L(0); PG8_MMA(0, 1, At, B1); PG8_BAR;
            PG8_LDA(At, 1, 1); PG8_STAGE_AOP(PG8_SA(1, 0), a3, voffA);
            PG8_BAR; PG8_WAIT_L(0); PG8_MMA(1, 0, At, B0); PG8_BAR; PG8_SCHED;
            PG8_STAGE(PG8_SB(1, 1), b3 + hstep, voffB);
            PG8_WAIT_V(6); PG8_BAR; PG8_MMA(1, 1, At, B1); PG8_BAR;
            }
        }
        if constexpr (ALIGN_EPI) { if (wr == 0) PG8_BAR; }
        if constexpr (!Epi::AFTER_DRAIN) { E(acc, cur, wr, wc, fr, fq); S.done(cur); }
        if (!has_next) break;
#pragma unroll
        for (int a = 0; a < 2; ++a)
#pragma unroll
            for (int b = 0; b < 2; ++b)
#pragma unroll
                for (int m = 0; m < 4; ++m)
#pragma unroll
                    for (int n = 0; n < 2; ++n) acc[a][b][m][n] = (f32x4){0.f, 0.f, 0.f, 0.f};
        cur = nxt; cA = nA; cB = nB; ++ui;
        if constexpr (ALIGN_EPI) { if (wr == 1) PG8_BAR; }
    }
#ifdef GEMM_STATIC_PRIO
    __builtin_amdgcn_s_setprio(0);
#endif
    PG8_WAIT_V(0);
    if constexpr (!ALIGN_EPI) { if (wr == 0) PG8_BAR; }
    PG8_BAR;
    if constexpr (Epi::AFTER_DRAIN) { E.fused(acc, cur, wr, wc, fr, fq, lds, wid, lane); S.done(cur); }
#undef PG8_SA
#undef PG8_SB
#undef PG8_STAGE
#undef PG8_STAGE_AOP
#undef PG8_LDA
#undef PG8_LDB
#undef PG8_MMA
#undef PG8_PRIO
#undef PG8_PRIO_EARLY
#undef PG8_WAIT_V
#undef PG8_WAIT_L
#undef PG8_BAR
#undef PG8_SCHED
}
}
#define XB_TMO      128
#define XB_XCNT(j)  (256  + 64 * (j))
#define XB_XSUB(j)  (1280 + 64 * (j))
#define XB_XGEN(j)  (2304 + 64 * (j))
#define XB_TOP      3328
#define XB_TOPGEN   3392
#define XCD_BAR_WORDS 3456
#define XB_SPIN_CAP (1u << 18)

__device__ __forceinline__ unsigned xb_ld(unsigned* p)              { return __hip_atomic_load(p, __ATOMIC_RELAXED, __HIP_MEMORY_SCOPE_AGENT); }
__device__ __forceinline__ unsigned xb_add(unsigned* p, unsigned v) { return __hip_atomic_fetch_add(p, v, __ATOMIC_RELAXED, __HIP_MEMORY_SCOPE_AGENT); }
__device__ __forceinline__ unsigned xb_xcc_id() { return (unsigned)__builtin_amdgcn_s_getreg((3 << 11) | 20) & 0xFu; }
#define XB_SPIN(cond, bar) do { unsigned _sp = 0; while (cond) { __builtin_amdgcn_s_sleep(1); \
    if ((++_sp & 255u) == 0u) { if (xb_ld(&(bar)[XB_TMO])) break; if (_sp > XB_SPIN_CAP) { atomicAdd(&(bar)[XB_TMO], 1u); break; } } } } while (0)

struct XcdBarrier {
    unsigned* bar; unsigned x;
    volatile LAS unsigned* st;
};

__device__ __forceinline__ XcdBarrier xcd_barrier_post(unsigned* bar, volatile LAS unsigned* st) {
    XcdBarrier b; b.bar = bar; b.x = xb_xcc_id(); b.st = st;
    if (threadIdx.x == 0) (void)xb_add(&bar[XB_XCNT(b.x)], 1u);
    return b;
}
__device__ __forceinline__ void xcd_barrier_complete(unsigned* bar, unsigned x, unsigned& nloc, unsigned& nx) {
    const unsigned G = gridDim.x * gridDim.y * gridDim.z;
    unsigned sum, cnt, mine, sp = 0u;
    for (;;) {
        sum = 0u; cnt = 0u; mine = 0u;
#pragma unroll
        for (unsigned j = 0; j < 16; ++j) { const unsigned c = xb_ld(&bar[XB_XCNT(j)]); sum += c; cnt += (c > 0u) ? 1u : 0u; mine = (j == x) ? c : mine; }
        if (sum == G) break;
        __builtin_amdgcn_s_sleep(1);
        if ((++sp & 255u) == 0u) { if (xb_ld(&bar[XB_TMO])) break; if (sp > XB_SPIN_CAP) { atomicAdd(&bar[XB_TMO], 1u); break; } }
    }
    nloc = mine > 0u ? mine : 1u; nx = cnt > 0u ? cnt : 1u;
}

__device__ __forceinline__ void xcd_barrier(const XcdBarrier& b) {
    asm volatile("s_waitcnt vmcnt(0)" ::: "memory");
    __syncthreads();
    if (threadIdx.x == 0) {
        unsigned* bar = b.bar;
        __builtin_amdgcn_s_waitcnt(0);
        unsigned nloc = b.st[0], nx = b.st[1];
        if (nloc == 0u) { xcd_barrier_complete(bar, b.x, nloc, nx); b.st[0] = nloc; b.st[1] = nx; }
        const unsigned old = xb_add(&bar[XB_XSUB(b.x)], 1u);
        const unsigned gen = old / nloc;
        if (old + 1u == (gen + 1u) * nloc) {
            __builtin_amdgcn_fence(__ATOMIC_RELEASE, "agent");
            asm volatile("s_waitcnt vmcnt(0)" ::: "memory");
            const unsigned og = xb_add(&bar[XB_TOP], 1u);
            const unsigned tg = og / nx;
            if (og + 1u == (tg + 1u) * nx) xb_add(&bar[XB_TOPGEN], 1u);
            else XB_SPIN(xb_ld(&bar[XB_TOPGEN]) == tg, bar);
            __builtin_amdgcn_fence(__ATOMIC_ACQUIRE, "agent");
            xb_add(&bar[XB_XGEN(b.x)], 1u);
            asm volatile("s_waitcnt vmcnt(0)" ::: "memory");
        } else {
            XB_SPIN(xb_ld(&bar[XB_XGEN(b.x)]) == gen, bar);
            __builtin_amdgcn_fence(__ATOMIC_ACQUIRE, "agent");
            asm volatile("s_waitcnt vmcnt(0)" ::: "memory");
        }
    }
    __syncthreads();
}

using pg8::bf16_t; using pg8::bf16x8; using pg8::f32x4; using pg8::u32x4; using pg8::cvt_pk_bf16; using pg8::fast_exp;
#ifdef NT_MORE
#define LDNT(p_) __builtin_nontemporal_load(p_)
#define STNT(p_, v_) __builtin_nontemporal_store((v_), (p_))
#else
#define LDNT(p_) (*(p_))
#define STNT(p_, v_) (*(p_) = (v_))
#endif
#ifdef NT_CST
#define STNTC(p_, v_) __builtin_nontemporal_store((v_), (p_))
#else
#define STNTC(p_, v_) (*(p_) = (v_))
#endif
#ifdef NT_A
#define LDNTA(p_) __builtin_nontemporal_load(p_)
#define STNTA(p_, v_) __builtin_nontemporal_store((v_), (p_))
#else
#define LDNTA(p_) (*(p_))
#define STNTA(p_, v_) (*(p_) = (v_))
#endif
#ifdef NT_B
#define LDNTB(p_) __builtin_nontemporal_load(p_)
#else
#define LDNTB(p_) (*(p_))
#endif
#ifdef NT_MORE2
#define LDNT2(p_) __builtin_nontemporal_load(p_)
#define STNT2(p_, v_) __builtin_nontemporal_store((v_), (p_))
#else
#define LDNT2(p_) (*(p_))
#define STNT2(p_, v_) (*(p_) = (v_))
#endif

#define BAR_LDS() do { asm volatile("s_waitcnt lgkmcnt(0)" ::: "memory"); __builtin_amdgcn_s_barrier(); asm volatile("" ::: "memory"); } while (0)
#define BAR_ALL() do { asm volatile("s_waitcnt vmcnt(0) lgkmcnt(0)" ::: "memory"); __builtin_amdgcn_s_barrier(); asm volatile("" ::: "memory"); } while (0)

#ifdef PROBE_SHFL
__device__ __forceinline__ float shx(float v, int mask, int lane) { (void)lane; return __shfl_xor(v, mask); }
__device__ __forceinline__ unsigned shxu(unsigned v, int mask, int lane) { (void)lane; return __shfl_xor(v, mask); }
__device__ __forceinline__ unsigned shupu(unsigned v, int d, int lane) { (void)lane; return __shfl_up(v, d); }
#else
__device__ __forceinline__ float shx(float v, int mask, int lane) { return __builtin_bit_cast(float, __builtin_amdgcn_ds_bpermute((lane ^ mask) << 2, __builtin_bit_cast(int, v))); }
__device__ __forceinline__ unsigned shxu(unsigned v, int mask, int lane) { return (unsigned)__builtin_amdgcn_ds_bpermute((lane ^ mask) << 2, (int)v); }
__device__ __forceinline__ unsigned shupu(unsigned v, int d, int lane) { return (unsigned)__builtin_amdgcn_ds_bpermute((lane - d) << 2, (int)v); }
#endif
__device__ __forceinline__ float wave_sum(float v, int lane) {
#pragma unroll
    for (int o = 1; o < 64; o <<= 1) v += shx(v, o, lane);
    return v;
}
__device__ __forceinline__ float bf_lo(unsigned u) { return __uint_as_float(u << 16); }
__device__ __forceinline__ float bf_hi(unsigned u) { return __uint_as_float(u & 0xffff0000u); }

struct Args { const float* in[18]; float* out; unsigned char* ws; };
struct Ctx { LAS unsigned char* lds; int w0;
    __device__ __forceinline__ const float* in(int i) const { return ldptr(lds, i); }
    __device__ __forceinline__ float* out() const { return (float*)ldptr(lds, 18); }
    __device__ __forceinline__ unsigned char* ws() const { return (unsigned char*)ldptr(lds, 19); } };
#define PHASE_IDS() const int tid = opaque_tid(a.w0), lane = tid & 63, wave = __builtin_amdgcn_readfirstlane(tid >> 6); (void)tid; (void)lane; (void)wave
enum { I_X = 0, I_C, I_CTX, I_CCTX, I_WADA, I_BADA, I_GMIX, I_GFFN, I_WIN, I_WOUT, I_LBL, I_ONORM, I_RDEC, I_WR, I_WEG, I_WEU, I_WED, I_GFIN };

struct CvtItem { const float* src; unsigned char* dst; int N, Kd, f8; };
__device__ __forceinline__ void cvt_desc(CvtItem& it, const float* W, int N, unsigned char* WT, int Kd, int k0, int n0, int drow0, int lane, int f8) {
    const int q = lane >> 4, c = lane & 15, es = f8 ? 1 : 2;
    it.src = W + (size_t)(k0 + 16 * q) * N + n0 + 4 * c; it.N = N; it.Kd = Kd * es; it.dst = WT + ((size_t)(drow0 + 4 * c) * Kd + k0 + 16 * q) * es; it.f8 = f8;
}
__device__ __forceinline__ void cvt_load(f32x4 (&v)[16], const CvtItem& it) {
#pragma unroll
#ifdef CVT_NT
    for (int i = 0; i < 16; ++i) v[i] = __builtin_nontemporal_load((const f32x4*)(it.src + (size_t)i * it.N));
#else
    for (int i = 0; i < 16; ++i) v[i] = *(const f32x4*)(it.src + (size_t)i * it.N);
#endif
}
__device__ __forceinline__ void cvt_store(const f32x4 (&v)[16], const CvtItem& it) {
    if (it.f8) {
#pragma unroll
        for (int j = 0; j < 4; ++j) { u32x4 o; constexpr float s = pg8::F8_SW;
            o.x = pg8::pk4_fp8(v[0][j] * s, v[1][j] * s, v[2][j] * s, v[3][j] * s); o.y = pg8::pk4_fp8(v[4][j] * s, v[5][j] * s, v[6][j] * s, v[7][j] * s);
            o.z = pg8::pk4_fp8(v[8][j] * s, v[9][j] * s, v[10][j] * s, v[11][j] * s); o.w = pg8::pk4_fp8(v[12][j] * s, v[13][j] * s, v[14][j] * s, v[15][j] * s);
            STNTC((u32x4*)(it.dst + (size_t)j * it.Kd), o); }
    } else {
#pragma unroll
        for (int j = 0; j < 4; ++j) { u32x4 o0, o1;
            o0.x = cvt_pk_bf16(v[0][j], v[1][j]); o0.y = cvt_pk_bf16(v[2][j], v[3][j]); o0.z = cvt_pk_bf16(v[4][j], v[5][j]); o0.w = cvt_pk_bf16(v[6][j], v[7][j]);
            o1.x = cvt_pk_bf16(v[8][j], v[9][j]); o1.y = cvt_pk_bf16(v[10][j], v[11][j]); o1.z = cvt_pk_bf16(v[12][j], v[13][j]); o1.w = cvt_pk_bf16(v[14][j], v[15][j]);
            STNTC((u32x4*)(it.dst + (size_t)j * it.Kd), o0); STNTC((u32x4*)(it.dst + (size_t)j * it.Kd + 16), o1); }
    }
}
__device__ __forceinline__ void cvt_expert_desc(CvtItem& it, const Ctx& a, unsigned char* ws, int g, int lane) {
    constexpr int I_E = 512; const int l = g / 24576, r = g % 24576; const int le = l * 16 + r / (3 * I_E), q3 = r % (3 * I_E), kind = q3 / I_E, q = q3 % I_E;
    if (kind < 2) { const int kb = q / 32, nb = q % 32, n0 = nb * 64;
        const int drow = 256 * (n0 >> 7) + (n0 & 127) + kind * 128;
        cvt_desc(it, a.in(kind == 0 ? I_WEG : I_WEU) + (size_t)le * D * FF, FF, (unsigned char*)(ws + WS_WGU) + (size_t)le * 4096 * D, D, kb * 64, n0, drow, lane, 1);
    } else { const int kb = q / 16, nb = q % 16;
        cvt_desc(it, a.in(I_WED) + (size_t)le * FF * D, D, (unsigned char*)(ws + WS_WD) + (size_t)le * D * FF, FF, kb * 64, nb * 64, nb * 64, lane, 1); }
}
#ifdef CVT_N2SLOT
constexpr int CVT_N0 = 9568, CVT_G1 = 7040, CVT_G2 = 7936, CVT_N2 = 2016, CVT_T = 3072, CVT_G4 = 6144, CVT_CYC = CVT_G1 + CVT_G2 + CVT_N2 + CVT_T + CVT_G4;
constexpr int CVT_TPER = 2;
static_assert(CVT_G1 == 220 * 8 * 4 && CVT_G2 == 248 * 8 * 4 && CVT_N2 == 252 * 8 && CVT_T == 192 * 8 * 2 && CVT_G4 == 192 * 8 * 4, "slot sizes = idle workgroups x 8 waves x items per wave");
static_assert(CVT_N0 + CVT_G1 + CVT_G2 + CVT_N2 + CVT_T >= 24576 && CVT_N0 + CVT_CYC + CVT_G1 + CVT_G2 + CVT_N2 + CVT_T >= 2 * 24576 && CVT_N0 + 2 * CVT_CYC + CVT_G1 + CVT_G2 + CVT_N2 + CVT_T >= 3 * 24576 && CVT_N0 + 3 * CVT_CYC + CVT_G1 + CVT_T >= 4 * 24576, "every layer's expert weights are converted before its first expert GEMM");
#else
constexpr int CVT_N2 = 0, CVT_TPER = 3;
constexpr int CVT_N0 = 9472, CVT_G1 = 7040, CVT_G2 = 7936, CVT_T = 4608, CVT_G4 = 6144, CVT_CYC = CVT_G1 + CVT_G2 + CVT_T + CVT_G4;
static_assert(CVT_G1 == 220 * 8 * 4 && CVT_G2 == 248 * 8 * 4 && CVT_T == 192 * 8 * 3 && CVT_G4 == 192 * 8 * 4, "slot sizes = idle workgroups x 8 waves x items per wave");
static_assert(CVT_N0 + CVT_G1 + CVT_G2 + CVT_T >= 24576 && CVT_N0 + CVT_CYC + CVT_G1 + CVT_G2 + CVT_T >= 2 * 24576 && CVT_N0 + 2 * CVT_CYC + CVT_G1 + CVT_G2 + CVT_T >= 3 * 24576 && CVT_N0 + 3 * CVT_CYC + CVT_G1 + CVT_T >= 4 * 24576, "every layer's expert weights are converted before its first expert GEMM");
#endif
__device__ __forceinline__ void cvt_tail(const Ctx& a, int first, int rank, int per, int i0, int i1) {
    PHASE_IDS(); unsigned char* ws = a.ws();
    const int base = first + (rank * 8 + wave) * per; int g = base + i0, g1 = base + i1; if (g1 > 4 * 24576) g1 = 4 * 24576;
    f32x4 va[16], vb[16]; CvtItem ia, ib;
    if (g < g1) { cvt_expert_desc(ia, a, ws, g, lane); cvt_load(va, ia); }
    while (g < g1) {
        if (g + 1 < g1) { cvt_expert_desc(ib, a, ws, g + 1, lane); cvt_load(vb, ib); }
        cvt_store(va, ia);
        if (++g >= g1) break;
        if (g + 1 < g1) { cvt_expert_desc(ia, a, ws, g + 1, lane); cvt_load(va, ia); }
        cvt_store(vb, ib);
        ++g; }
}
template <int PER>
__device__ __forceinline__ void cvt_tail(const Ctx& a, int first, int rank) { cvt_tail(a, first, rank, PER, 0, PER); }

__device__ __forceinline__ void p0_item_desc(CvtItem& it, const Ctx& a, unsigned char* ws, int r, int lane) {
    constexpr int I_IN = 16 * 72, I_OUT = 16 * 16;
    if (r < 4 * I_IN) { const int l = r / I_IN, q = r % I_IN, kb = q / 72, nb = q % 72;

#ifdef G1_F8
        cvt_desc(it, a.in(I_WIN) + (size_t)l * D * INW, INW, (unsigned char*)(ws + WS_WIN) + (size_t)l * INW * D, D, kb * 64, nb * 64, nb * 64, lane, 1); return; }
#else
        cvt_desc(it, a.in(I_WIN) + (size_t)l * D * INW, INW, (unsigned char*)((bf16_t*)(ws + WS_WIN) + (size_t)l * INW * D), D, kb * 64, nb * 64, nb * 64, lane, 0); return; }
#endif
    r -= 4 * I_IN;
    if (r < 4 * I_OUT) { const int l = r / I_OUT, q = r % I_OUT, kb = q / 16, nb = q % 16;

#ifdef G2_F8
        cvt_desc(it, a.in(I_WOUT) + (size_t)l * D * D, D, (unsigned char*)(ws + WS_WOUT) + (size_t)l * D * D, D, kb * 64, nb * 64, nb * 64, lane, 1); return; }
#else
        cvt_desc(it, a.in(I_WOUT) + (size_t)l * D * D, D, (unsigned char*)((bf16_t*)(ws + WS_WOUT) + (size_t)l * D * D), D, kb * 64, nb * 64, nb * 64, lane, 0); return; }
#endif
    r -= 4 * I_OUT;
    cvt_expert_desc(it, a, ws, r, lane);
}
__device__ __forceinline__ void p0_prologue(const Ctx& a) {
    PHASE_IDS(); LAS unsigned char* lds = launder_lds(a.lds); unsigned char* ws = a.ws(); const float* cin_ = a.in(I_C); const float* cctx_ = a.in(I_CCTX);
    LAS float* scond = (LAS float*)(lds + 8 * 16640);
    for (int i = tid; i < 3 * D; i += 512) { const int w = i >> 10, k = i & 1023; const float cv = (w < 2) ? cin_[w * D + k] : cctx_[k]; scond[i] = cv * pg8::fast_sigmoid(cv); }
    if (blockIdx.x == 0) { const int c = tid; const float* lg = a.in(I_LBL);
        const float l0 = lg[c], l1 = lg[512 + c], l2 = lg[1024 + c], l3 = lg[1536 + c]; const float mx = fmaxf(fmaxf(l0, l1), fmaxf(l2, l3));
        const float e0 = expf(l0 - mx), e1 = expf(l1 - mx), e2 = expf(l2 - mx), e3 = expf(l3 - mx), inv = 1.0f / (e0 + e1 + e2 + e3);
        float* lbs = (float*)(ws + WS_LBS); lbs[c] = 0.f; lbs[512 + c] = e1 * inv; lbs[1024 + c] = (e1 + e2) * inv; lbs[1536 + c] = (e1 + e2 + e3) * inv; }
    if (blockIdx.x >= 1 && blockIdx.x <= 16) { const int idx = (blockIdx.x - 1) * 512 + tid, pos = idx >> 5, f = idx & 31;
        const float invf = powf(10000.0f, -(float)f / 32.0f), ang = (float)pos * invf; float* cs = (float*)(ws + WS_ROPE); cs[idx * 2] = cosf(ang); cs[idx * 2 + 1] = sinf(ang); }
    BAR_LDS();
    const int gw = blockIdx.x * 8 + wave, NGW = gridDim.x * 8;
    for (int it = gw; it < 4 * 24 * 8; it += NGW) { const int l = it / 192, r = it % 192, cg = r >> 3, ks = r & 7; const int cols = cg * 256 + lane * 4;
        const float* wp = a.in(I_WADA) + ((size_t)l * D + ks * 128) * 6144 + cols; f32x4 a0 = {0, 0, 0, 0}, a1 = a0, a2 = a0;
#pragma unroll 8
        for (int kk = 0; kk < 128; ++kk) { const f32x4 w = LDNT((const f32x4*)(wp + (size_t)kk * 6144)); const int k = ks * 128 + kk; a0 += w * scond[k]; a1 += w * scond[D + k]; a2 += w * scond[2 * D + k]; }
        float* pp = (float*)(ws + WS_MODP) + (size_t)((l * 8 + ks) * 3) * 6144 + cols; *(f32x4*)pp = a0; *(f32x4*)(pp + 6144) = a1; *(f32x4*)(pp + 2 * 6144) = a2; }
#ifdef PROBE_NOBG
    const int n_exp = 4 * 24576;
#else
    const int n_exp = (gridDim.x == 256) ? CVT_N0 : 4 * 24576;
#endif
    const int NIT = 4 * (16 * 72 + 16 * 16) + n_exp;
    f32x4 va[16], vb[16]; CvtItem ia, ib; int it = gw;
    if (it < NIT) { p0_item_desc(ia, a, ws, it, lane); cvt_load(va, ia); }
    while (it < NIT) {
        int nx = it + NGW;
        if (nx < NIT) { p0_item_desc(ib, a, ws, nx, lane); cvt_load(vb, ib); }
        cvt_store(va, ia);
        it = nx; if (it >= NIT) break;
        nx = it + NGW;
        if (nx < NIT) { p0_item_desc(ia, a, ws, nx, lane); cvt_load(va, ia); }
        cvt_store(vb, ib);
        it = nx;
    }
}

__device__ __forceinline__ void p0_finalize(const Ctx& a) {
    PHASE_IDS(); unsigned char* ws = a.ws(); const float* bada = a.in(I_BADA); const float* part = (const float*)(ws + WS_MODP); float* mods = (float*)(ws + WS_MODS);
    for (int i = blockIdx.x * 512 + tid; i < 4 * 3 * 6144; i += gridDim.x * 512) { const int l = i / (3 * 6144), r = i % (3 * 6144), w = r / 6144, j = r % 6144;
        float s = bada[l * 6144 + j];
#pragma unroll
        for (int ks = 0; ks < 8; ++ks) s += part[(size_t)((l * 8 + ks) * 3 + w) * 6144 + j];
        mods[i] = s; }
}

template <int MODE>
__device__ __forceinline__ void norm1_phase(const Ctx& a, int l) {
    PHASE_IDS(); unsigned char* ws = a.ws(); const float* in_x = a.in(I_X); const float* in_ctx = a.in(I_CTX); const float* gm = (MODE != 1) ? a.in(I_GMIX) + l * D : a.in(I_GFIN); float* outp = a.out(); const int gw = blockIdx.x * 8 + wave, NGW = gridDim.x * 8;
    const float* mods = (const float*)(ws + WS_MODS); bf16_t* X = (bf16_t*)(ws + WS_X); bf16_t* H = (bf16_t*)(ws + WS_H);
    const int* inv = (const int*)(ws + WS_INV); const unsigned char* YS = (const unsigned char*)(ws + WS_YS); const float* gate = (const float*)(ws + WS_ROWMAP) + MOE_ROWS;
    constexpr int NTOT = (MODE == 1) ? NB * SEQ : MROWS;
#define N1_ROWOF(n_) ((MODE == 1) ? (((n_) >> 14) * LTOT + CTX + ((n_) & (SEQ - 1))) : (n_))
#define N1_LOADROW(n_, v_, iv_) do { const int r_ = N1_ROWOF(n_); const int b_ = r_ >= LTOT ? 1 : 0, g_ = r_ - b_ * LTOT; \
        if (l == 0) { const float* src_ = (g_ < CTX ? in_ctx + (size_t)(b_ * CTX + g_) * D : in_x + (size_t)(b_ * SEQ + g_ - CTX) * D); \
            _Pragma("unroll") for (int j = 0; j < 4; ++j) v_[j] = LDNT((const f32x4*)(src_ + lane * 4 + 256 * j)); } \
        else { const bf16_t* src_ = X + (size_t)r_ * D; _Pragma("unroll") for (int j = 0; j < 4; ++j) { const u32x2 w_ = LDNTA((const u32x2*)(src_ + lane * 4 + 256 * j)); v_[j] = (f32x4){bf_lo(w_.x), bf_hi(w_.x), bf_lo(w_.y), bf_hi(w_.y)}; } \
            iv_ = inv[r_ * 16 + (lane & 15)]; } } while (0)
    f32x4 v[4]; int iv = -1; int n = gw;
    int curw = -1; f32x4 cgs[4], csh[4], cgt[4];
#pragma unroll
    for (int j = 0; j < 4; ++j) { cgs[j] = (f32x4){0.f, 0.f, 0.f, 0.f}; csh[j] = cgs[j]; cgt[j] = cgs[j]; }
    if (n < NTOT) N1_LOADROW(n, v, iv);
    for (; n < NTOT; n += NGW) {
        const int row = N1_ROWOF(n); const int b = row >= LTOT ? 1 : 0, g = row - b * LTOT; const bool isctx = g < CTX; const int which = isctx ? 2 : b;
        if (which != curw) { curw = which;
            if (MODE != 1) { const float* sh_ = mods + (size_t)(l * 3 + which) * 6144; const float* sc_ = sh_ + D;
#pragma unroll
                for (int j = 0; j < 4; ++j) { const int c = lane * 4 + 256 * j; cgs[j] = *(const f32x4*)(gm + c) * (*(const f32x4*)(sc_ + c) + 1.0f); csh[j] = *(const f32x4*)(sh_ + c); } }
            else {
#pragma unroll
                for (int j = 0; j < 4; ++j) cgs[j] = *(const f32x4*)(gm + lane * 4 + 256 * j); }
            if (l != 0) { const float* gt2_ = mods + (size_t)((l - 1) * 3 + which) * 6144 + 5 * D;
#pragma unroll
                for (int j = 0; j < 4; ++j) cgt[j] = *(const f32x4*)(gt2_ + lane * 4 + 256 * j); } }
        f32x4 vn[4]; int ivn = -1; const int nn = n + NGW;
        if (nn < NTOT) N1_LOADROW(nn, vn, ivn);
        if (l != 0) {
            unsigned vm = (unsigned)__builtin_amdgcn_ballot_w64(iv >= 0) & 0xffffu;
            f32x4 s[4] = {{0, 0, 0, 0}, {0, 0, 0, 0}, {0, 0, 0, 0}, {0, 0, 0, 0}};
            while (vm) {
                const int e0 = __builtin_ctz(vm); vm &= vm - 1; const bool has1 = vm != 0u; const int e1 = has1 ? __builtin_ctz(vm) : e0; if (has1) vm &= vm - 1;
                const int mr0 = __builtin_amdgcn_readlane(iv, e0), mr1 = __builtin_amdgcn_readlane(iv, e1);
                const float g0 = gate[mr0] * (1.0f / pg8::F8_SY), g1 = has1 ? gate[mr1] * (1.0f / pg8::F8_SY) : 0.f;
                const unsigned char* y0r = YS + (size_t)mr0 * D + lane * 4; const unsigned char* y1r = YS + (size_t)mr1 * D + lane * 4; unsigned y0[4], y1[4];
#pragma unroll
                for (int j = 0; j < 4; ++j) { y0[j] = LDNT((const unsigned*)(y0r + 256 * j)); y1[j] = LDNT((const unsigned*)(y1r + 256 * j)); }
#pragma unroll
                for (int j = 0; j < 4; ++j) { const f32x2 a01 = __builtin_amdgcn_cvt_pk_f32_fp8((int)y0[j], false), a23 = __builtin_amdgcn_cvt_pk_f32_fp8((int)y0[j], true);
                    const f32x2 b01 = __builtin_amdgcn_cvt_pk_f32_fp8((int)y1[j], false), b23 = __builtin_amdgcn_cvt_pk_f32_fp8((int)y1[j], true);
                    s[j][0] += g0 * a01.x + g1 * b01.x; s[j][1] += g0 * a01.y + g1 * b01.y; s[j][2] += g0 * a23.x + g1 * b23.x; s[j][3] += g0 * a23.y + g1 * b23.y; } }
            bf16_t* xr = X + (size_t)row * D;
#pragma unroll
            for (int j = 0; j < 4; ++j) { v[j] += cgt[j] * s[j]; if (MODE == 0) { u32x2 w; w.x = cvt_pk_bf16(v[j][0], v[j][1]); w.y = cvt_pk_bf16(v[j][2], v[j][3]); STNTA((u32x2*)(xr + lane * 4 + 256 * j), w); } }
        }
        float ss = 0.f;
#pragma unroll
        for (int j = 0; j < 4; ++j) ss += (v[j][0] * v[j][0] + v[j][1] * v[j][1]) + (v[j][2] * v[j][2] + v[j][3] * v[j][3]);
        const float rinv = __builtin_amdgcn_rsqf(wave_sum(ss, lane) * (1.0f / D) + EPS);
        if (MODE != 1) {
            bf16_t* hr = H + (size_t)row * D + lane * 4;
#pragma unroll
            for (int j = 0; j < 4; ++j) { const int c = lane * 4 + 256 * j; (void)c;
                const f32x4 y = v[j] * rinv * cgs[j] + csh[j];
#ifdef G1_F8
                *(unsigned*)((unsigned char*)H + (size_t)row * D + c) = pg8::pk4_fp8(y[0] * pg8::F8_SA, y[1] * pg8::F8_SA, y[2] * pg8::F8_SA, y[3] * pg8::F8_SA); }
#else
                u32x2 w; w.x = cvt_pk_bf16(y[0], y[1]); w.y = cvt_pk_bf16(y[2], y[3]); *(u32x2*)(hr + 256 * j) = w; }
#endif
        } else {
            float* orow = outp + (size_t)(b * SEQ + g - CTX) * D + lane * 4;
#pragma unroll
            for (int j = 0; j < 4; ++j) STNT((f32x4*)(orow + 256 * j), v[j] * rinv * cgs[j]);
        }
#pragma unroll
        for (int j = 0; j < 4; ++j) v[j] = vn[j];
        iv = ivn;
    }
#undef N1_ROWOF
#undef N1_LOADROW
}

constexpr int N2_WH = 0, N2_WL = 32768, N2_CS = 65536, N2_CH = 69632, N2_CE = 73728;
typedef __bf16 bf2v __attribute__((ext_vector_type(2)));
__device__ __forceinline__ float dot2_bf16(unsigned u, float c) { const bf2v v = __builtin_bit_cast(bf2v, u); return __builtin_amdgcn_fdot2_f32_bf16(v, v, c, false); }
__device__ __forceinline__ void norm2_phase(const Ctx& a, int l) {
    PHASE_IDS(); LAS unsigned char* lds = launder_lds(a.lds); unsigned char* ws = a.ws();
    const bf16_t* X = (const bf16_t*)(ws + WS_X); unsigned char* H8 = (unsigned char*)(ws + WS_H);
    int* inv = (int*)(ws + WS_INV); float* afl = (float*)(ws + WS_AFF); float* afc = afl + 2 * 16 * SEQ;
    const bool last = (l == DEPTH - 1);
    const int NQ = last ? 2048 : 2080;
    int built = -1;
    for (int q0 = blockIdx.x * 8; q0 < NQ; q0 += gridDim.x * 8) {
        const int which = q0 < 1024 ? 0 : (q0 < 2048 ? 1 : 2);
        const int q = q0 + wave; const bool isctx = q >= 2048;
        const int b = isctx ? ((q - 2048) >> 4) : (q >> 10), g0 = isctx ? ((q - 2048) & 15) * 16 : CTX + (q & 1023) * 16;
        const int row0 = b * LTOT + g0; const int r = lane & 15, kg = lane >> 4;
        u32x4 xa[32];
        { const bf16_t* xp = X + (size_t)(row0 + r) * D + 16 * kg;
#pragma unroll
          for (int c = 0; c < 16; ++c) { xa[2 * c] = LDNTB((const u32x4*)(xp + 64 * c)); xa[2 * c + 1] = LDNTB((const u32x4*)(xp + 64 * c + 8)); } }
        if (which != built) {
            if (built >= 0) BAR_LDS();
            const float* wr = a.in(I_WR) + (size_t)l * D * NE; const float* gm = a.in(I_GFFN) + l * D;
            const float* sh = (const float*)(ws + WS_MODS) + (size_t)(l * 3 + which) * 6144 + 3 * D; const float* sc = sh + D;
            const int e = tid & 15; float cpart = 0.f;
#pragma unroll 1
            for (int i = 0; i < 4; ++i) { const int u = tid + 512 * i; const int s = u >> 6, kgu = (u >> 4) & 3; const int k0 = 64 * (s >> 1) + 16 * kgu + 8 * (s & 1);
                u32x4 hi4, lo4;
#pragma unroll
                for (int h = 0; h < 2; ++h) { const f32x4 gg = *(const f32x4*)(gm + k0 + 4 * h), s1 = *(const f32x4*)(sc + k0 + 4 * h), s0 = *(const f32x4*)(sh + k0 + 4 * h); const f32x4 m = gg * (s1 + 1.0f);
#pragma unroll
                    for (int jp = 0; jp < 2; ++jp) { const int j = 4 * h + 2 * jp; const float w0 = wr[(k0 + j) * 16 + e], w1 = wr[(k0 + j + 1) * 16 + e];
                        const float v0 = m[2 * jp] * w0, v1 = m[2 * jp + 1] * w1; cpart += s0[2 * jp] * w0 + s0[2 * jp + 1] * w1;
                        const unsigned ph = cvt_pk_bf16(v0, v1); const unsigned pl = cvt_pk_bf16(v0 - bf_lo(ph), v1 - bf_hi(ph));
                        hi4[2 * h + jp] = ph; lo4[2 * h + jp] = pl; } }
                *(LAS u32x4*)(lds + N2_WH + u * 16) = hi4; *(LAS u32x4*)(lds + N2_WL + u * 16) = lo4; }
            cpart += shx(cpart, 16, lane); cpart += shx(cpart, 32, lane);
            if (lane < 16) ((LAS float*)(lds + N2_CE))[wave * 16 + lane] = cpart;
            if (tid < 256) { const int k = tid * 4; const f32x4 gg = *(const f32x4*)(gm + k), s1 = *(const f32x4*)(sc + k), s0 = *(const f32x4*)(sh + k);
                *(LAS f32x4*)(lds + N2_CS + k * 4) = gg * (s1 + 1.0f) * pg8::F8_SA; *(LAS f32x4*)(lds + N2_CH + k * 4) = s0 * pg8::F8_SA; }
            BAR_LDS(); built = which;
        }
        f32x4 acc = {0.f, 0.f, 0.f, 0.f}; float ss = 0.f;
#pragma unroll
        for (int s = 0; s < 32; ++s) {
            const bf16x8 wh = *(const LAS bf16x8*)(lds + N2_WH + (s * 64 + lane) * 16), wl = *(const LAS bf16x8*)(lds + N2_WL + (s * 64 + lane) * 16);
            const bf16x8 xf = __builtin_bit_cast(bf16x8, xa[s]);
            acc = __builtin_amdgcn_mfma_f32_16x16x32_bf16(wh, xf, acc, 0, 0, 0); acc = __builtin_amdgcn_mfma_f32_16x16x32_bf16(wl, xf, acc, 0, 0, 0);
            ss = dot2_bf16(xa[s][0], ss); ss = dot2_bf16(xa[s][1], ss); ss = dot2_bf16(xa[s][2], ss); ss = dot2_bf16(xa[s][3], ss);
            if ((s & 3) == 3) __builtin_amdgcn_sched_barrier(0); }
        ss += shx(ss, 16, lane); ss += shx(ss, 32, lane);
        const float rinv = __builtin_amdgcn_rsqf(ss * (1.0f / D) + EPS);
        {
            f32x4 ce = {0.f, 0.f, 0.f, 0.f};
#pragma unroll
            for (int w = 0; w < 8; ++w) ce += *(const LAS f32x4*)(lds + N2_CE + (w * 16 + 4 * kg) * 4);
            const f32x4 lg = acc * rinv + ce;
            float mx = fmaxf(fmaxf(lg[0], lg[1]), fmaxf(lg[2], lg[3])); mx = fmaxf(mx, shx(mx, 16, lane)); mx = fmaxf(mx, shx(mx, 32, lane));
            f32x4 ex; ex[0] = expf(lg[0] - mx); ex[1] = expf(lg[1] - mx); ex[2] = expf(lg[2] - mx); ex[3] = expf(lg[3] - mx);
            float sm = (ex[0] + ex[1]) + (ex[2] + ex[3]); sm += shx(sm, 16, lane); sm += shx(sm, 32, lane);
            float* dst = isctx ? afc + (size_t)(b * 16 + 4 * kg) * CTX + g0 + r : afl + (size_t)(b * 16 + 4 * kg) * SEQ + (g0 - CTX) + r; const int estr = isctx ? CTX : SEQ;
#pragma unroll
            for (int j = 0; j < 4; ++j) dst[(size_t)j * estr] = ex[j] / sm; }
        { typedef int i32x4 __attribute__((ext_vector_type(4))); int m1 = -1; asm volatile("" : "+v"(m1)); *(i32x4*)(inv + (size_t)row0 * 16 + lane * 4) = (i32x4){m1, m1, m1, m1}; }
        unsigned char* hp = H8 + (size_t)(row0 + r) * D + 16 * kg;
#pragma unroll
        for (int c = 0; c < 16; ++c) { const LAS f32x4* cs = (const LAS f32x4*)(lds + N2_CS + (64 * c + 16 * kg) * 4); const LAS f32x4* ch = (const LAS f32x4*)(lds + N2_CH + (64 * c + 16 * kg) * 4);
            u32x4 o;
#pragma unroll
            for (int h = 0; h < 4; ++h) { const unsigned w0 = xa[2 * c + (h >> 1)][2 * (h & 1)], w1 = xa[2 * c + (h >> 1)][2 * (h & 1) + 1];
                const f32x4 xv = {bf_lo(w0), bf_hi(w0), bf_lo(w1), bf_hi(w1)}; const f32x4 y = xv * rinv * cs[h] + ch[h]; o[h] = pg8::pk4_fp8(y[0], y[1], y[2], y[3]); }
            *(u32x4*)(hp + 64 * c) = o;
            if ((c & 1) == 1) __builtin_amdgcn_sched_barrier(0); }
    }
}

__device__ __forceinline__ void topk_phase(const Ctx& a, int l) {
    PHASE_IDS(); LAS unsigned char* lds = launder_lds(a.lds); unsigned char* ws = a.ws(); const float* afl = (const float*)(ws + WS_AFF); const float* afc = afl + 2 * 16 * SEQ;
    int* rowmap = (int*)(ws + WS_ROWMAP); float* gate = (float*)(ws + WS_ROWMAP) + MOE_ROWS; int* inv = (int*)(ws + WS_INV);
    LAS unsigned* wcnt = (LAS unsigned*)lds;
    const int nitems = (l == DEPTH - 1) ? 32 : 64;
    for (int it = blockIdx.x; it < nitems; it += gridDim.x) {
        const bool isctx = it >= 32; const int be = it & 31, b = be >> 4, e = be & 15;
        const int n = isctx ? CTX : SEQ, k = isctx ? CAP_CTX : CAP_LAT;
        const float* src = isctx ? afc + be * CTX : afl + (size_t)be * SEQ;
        unsigned key[32];
#pragma unroll
        for (int i = 0; i < 32; ++i) { const int idx = i * 512 + tid; key[i] = idx < n ? __float_as_uint(src[idx]) : 0u; }
        unsigned T = 0u;
        for (int bit = 30; bit >= 0; --bit) { const unsigned cand = T | (1u << bit); unsigned cnt = 0;
#pragma unroll
#ifdef TOPK_BALLOT
            for (int i = 0; i < 32; ++i) cnt += (unsigned)__builtin_popcountll(__builtin_amdgcn_ballot_w64(key[i] >= cand));
#else
            for (int i = 0; i < 32; ++i) cnt += (key[i] >= cand) ? 1u : 0u;
#pragma unroll
            for (int o = 1; o < 64; o <<= 1) cnt += shxu(cnt, o, lane);
#endif
            LAS unsigned* wc = wcnt + (bit & 1) * 8; if (lane == 0) wc[wave] = cnt;
            BAR_LDS();
            unsigned tot = 0;
#pragma unroll
            for (int w = 0; w < 8; ++w) tot += wc[w];
            if (tot >= (unsigned)k) T = cand; }
        unsigned mine = 0;
#pragma unroll
        for (int i = 0; i < 32; ++i) mine += (key[i] > T ? 1u : 0u) + (key[i] == T ? 65536u : 0u);
        unsigned incl = mine;
#pragma unroll
        for (int o = 1; o < 64; o <<= 1) { const unsigned t = shupu(incl, o, lane); if (lane >= o) incl += t; }
        LAS unsigned* wt = wcnt + 16; BAR_LDS();
        if (lane == 63) wt[wave] = incl;
        BAR_LDS();
        unsigned base = 0, total = 0;
#pragma unroll
        for (int w = 0; w < 8; ++w) { const unsigned t = wt[w]; total += t; if (w < wave) base += t; }
        const unsigned excl = base + incl - mine; const unsigned cgt = total & 0xffffu; const unsigned need = (unsigned)k - cgt;
        unsigned sg = excl & 0xffffu, se = excl >> 16;
        const int mrbase = e * MOE_ROWS_E + (isctx ? 4096 + b * CAP_CTX : b * CAP_LAT);
        const int rbase = b * LTOT + (isctx ? 0 : CTX);
#pragma unroll
        for (int i = 0; i < 32; ++i) { const int idx = i * 512 + tid; const unsigned kk = key[i]; int slot = -1;
            if (kk > T) { slot = (int)sg; ++sg; } else if (kk == T) { if (se < need) slot = (int)(cgt + se); ++se; }
            if (slot >= 0) { const int mr = mrbase + slot, r = rbase + idx; rowmap[mr] = r; gate[mr] = __uint_as_float(kk); inv[r * 16 + e] = mr; } }
        if (isctx && b == 0 && tid < 192) { const int mr = e * MOE_ROWS_E + 4160 + tid; rowmap[mr] = 0; gate[mr] = 0.f; }
        BAR_LDS();
    }
}


constexpr int SC_QI = 0, SC_KI = 16384, SC_KT = 32768, SC_VT = 49152, SC_PI = 65536, SC_SM = 73728, SC_PART = 106496, SC_VA = 110592, SC_VB = 111104, SC_VM = 111616, SC_RED = 112128;
__device__ __forceinline__ int st_off(int r, int cbytes, int ncs) { return ((r >> 4) * ncs + (cbytes >> 6)) * 1024 + (r & 15) * 64 + ((cbytes & 63) ^ ((r & 8) << 2)); }
__device__ __forceinline__ int st_lane(int fr, int fq) { return fr * 64 + ((fq * 16) ^ ((fr & 8) << 2)); }
struct ScanBufs { int kt, vt, part, va, vb, vm; };
__device__ __forceinline__ ScanBufs scan_bufs(int parity) { ScanBufs b; b.kt = parity ? SC_QI : SC_KT; b.vt = parity ? SC_KI : SC_VT; b.part = parity ? SC_PI : SC_PART; b.va = parity ? SC_PI + 4096 : SC_VA; b.vb = parity ? SC_PI + 4608 : SC_VB; b.vm = parity ? SC_PI + 5120 : SC_VM; return b; }

__device__ __forceinline__ bf16x8 ldfrag(const LAS unsigned char* img, int tile, int ks, int ncs, int lp) { return *(const LAS bf16x8*)(img + (tile * ncs + ks) * 1024 + lp); }
#define MFMA16(a, b, c) __builtin_amdgcn_mfma_f32_16x16x32_bf16((a), (b), (c), 0, 0, 0)
#ifndef SCAN_LOG2
__device__ __forceinline__ float ex2(float x) { return __builtin_amdgcn_exp2f(x * 1.4426950408889634f); }
#define LOG2E_ 1.0f
#else
__device__ __forceinline__ float ex2(float x) { return __builtin_amdgcn_exp2f(x); }
#define LOG2E_ 1.4426950408889634f
#endif

__device__ __forceinline__ void scan_write_T(LAS unsigned char* img, const unsigned (&d)[8], int cp, int to) {
    u32x4 wa, wb;
    wa.x = (d[0] & 0xffffu) | (d[1] << 16); wa.y = (d[2] & 0xffffu) | (d[3] << 16); wa.z = (d[4] & 0xffffu) | (d[5] << 16); wa.w = (d[6] & 0xffffu) | (d[7] << 16);
    wb.x = (d[0] >> 16) | (d[1] & 0xffff0000u); wb.y = (d[2] >> 16) | (d[3] & 0xffff0000u); wb.z = (d[4] >> 16) | (d[5] & 0xffff0000u); wb.w = (d[6] >> 16) | (d[7] & 0xffff0000u);
    *(LAS u32x4*)(img + st_off(2 * cp, to * 16, 2)) = wa; *(LAS u32x4*)(img + st_off(2 * cp + 1, to * 16, 2)) = wb;
}

template <bool FULL>
__device__ __forceinline__ void scan_estage_hg(LAS unsigned char* lds, const ScanBufs& B, const unsigned (&kraw)[8], const unsigned (&qraw)[8], const unsigned (&vraw)[8], int lane, int wave, float& la_out, float& lb_out) {
    const int cp = lane, to = wave;
#ifndef SCAN_LOG2
    constexpr float LS = 1.4426950408889634f;
#else
    constexpr float LS = 1.0f;
#endif
    f32x2 c2[8]; f32x2 r2 = {0.f, 0.f};
#pragma unroll
    for (int tt = 0; tt < 8; ++tt) { r2 += (f32x2){bf_lo(kraw[tt]), bf_hi(kraw[tt])}; c2[tt] = r2; }
    *(LAS f32x2*)(lds + B.part + (to * 128 + 2 * cp) * 4) = r2;
    BAR_LDS();
    f32x2 p2 = {0.f, 0.f}, m2 = {0.f, 0.f}, l2 = {0.f, 0.f};
#pragma unroll
    for (int t8 = 0; t8 < 8; ++t8) { const f32x2 pp = *(const LAS f32x2*)(lds + B.part + (t8 * 128 + 2 * cp) * 4);
        if (t8 < to) p2 += pp; if (t8 < 4) m2 += pp; l2 += pp; }
    p2 = (p2 - m2) * LS;
    unsigned kd[8];
#pragma unroll
    for (int tt = 0; tt < 8; ++tt) { const int rr = 8 * to + tt;
        f32x2 d2 = p2 + c2[tt] * LS;
        d2 = __builtin_elementwise_min(__builtin_elementwise_max(d2, (f32x2){-120.f, -120.f}), (f32x2){120.f, 120.f});
        const f32x2 lf2 = (f32x2){bf_lo(kraw[tt]), bf_hi(kraw[tt])} * LS;
        const f32x2 k2 = (f32x2){1.0f, 1.0f} - (f32x2){__builtin_amdgcn_exp2f(lf2.x), __builtin_amdgcn_exp2f(lf2.y)};
        const f32x2 kt2 = k2 * (f32x2){__builtin_amdgcn_exp2f(-d2.x), __builtin_amdgcn_exp2f(-d2.y)};
        kd[tt] = cvt_pk_bf16(kt2.x, kt2.y);
        if (FULL) { const f32x2 qt2 = (f32x2){bf_lo(qraw[tt]), bf_hi(qraw[tt])} * (f32x2){__builtin_amdgcn_exp2f(d2.x), __builtin_amdgcn_exp2f(d2.y)};
            *(LAS unsigned*)(lds + SC_QI + st_off(rr, cp * 4, 4)) = cvt_pk_bf16(qt2.x, qt2.y);
            *(LAS unsigned*)(lds + SC_KI + st_off(rr, cp * 4, 4)) = kd[tt]; } }
    scan_write_T(lds + B.kt, kd, cp, to); scan_write_T(lds + B.vt, vraw, cp, to);
    if (to == 0) { *(LAS f32x2*)(lds + B.va + 8 * cp) = (f32x2){ex2(l2.x), ex2(l2.y)}; *(LAS f32x2*)(lds + B.vb + 8 * cp) = (f32x2){ex2(l2.x - m2.x), ex2(l2.y - m2.y)};
        *(LAS f32x2*)(lds + B.vm + 8 * cp) = (f32x2){ex2(m2.x), ex2(m2.y)}; }
    la_out = l2.x; lb_out = l2.y;
}
template <bool FULL>
__device__ __forceinline__ void scan_estage_ret(LAS unsigned char* lds, const ScanBufs& B, const unsigned (&kraw)[8], const unsigned (&qraw)[8], const unsigned (&vraw)[8], int lane, int wave, float lg2) {
    const int cp = lane, to = wave; unsigned kd[8];
#pragma unroll
    for (int tt = 0; tt < 8; ++tt) { const int rr = 8 * to + tt; const float wk = ex2((float)(63 - rr) * lg2); kd[tt] = cvt_pk_bf16(bf_lo(kraw[tt]) * wk, bf_hi(kraw[tt]) * wk);
        if (FULL) { *(LAS unsigned*)(lds + SC_QI + st_off(rr, cp * 4, 4)) = qraw[tt]; *(LAS unsigned*)(lds + SC_KI + st_off(rr, cp * 4, 4)) = kraw[tt]; } }
    scan_write_T(lds + B.kt, kd, cp, to); scan_write_T(lds + B.vt, vraw, cp, to);
}

template <bool RET>
__device__ __forceinline__ void scan_state_update(LAS unsigned char* lds, const ScanBufs& B, f32x4 (&ST)[8], int wave, int fr, int fq, float g64) {
    const int lp = st_lane(fr, fq);
    const bf16x8 a0 = ldfrag(lds + B.kt, wave, 0, 2, lp), a1 = ldfrag(lds + B.kt, wave, 1, 2, lp);
    f32x4 av = {g64, g64, g64, g64}, bv = {1.f, 1.f, 1.f, 1.f};
    if (!RET) { av = *(const LAS f32x4*)(lds + B.va + (16 * wave + 4 * fq) * 4); bv = *(const LAS f32x4*)(lds + B.vb + (16 * wave + 4 * fq) * 4); }
#pragma unroll
    for (int vi = 0; vi < 8; ++vi) { const bf16x8 b0 = ldfrag(lds + B.vt, vi, 0, 2, lp), b1 = ldfrag(lds + B.vt, vi, 1, 2, lp);
        f32x4 u = {0.f, 0.f, 0.f, 0.f}; u = MFMA16(a0, b0, u); u = MFMA16(a1, b1, u); ST[vi] = RET ? (av * ST[vi] + u) : (av * ST[vi] + bv * u); }
}

#define SCAN_LOAD_CHUNK(crow_, dir_) do { _Pragma("unroll") for (int tt = 0; tt < 8; ++tt) { const int rr_ = 8 * wave + tt; const size_t ro_ = (size_t)((crow_) + ((dir_) ? 63 - rr_ : rr_)) * INW + 2 * lane; \
        kraw[tt] = *(const unsigned*)(P + ro_ + colk); vraw[tt] = *(const unsigned*)(P + ro_ + colv); if (LOADQ) qraw[tt] = *(const unsigned*)(P + ro_ + colq); } } while (0)
#ifdef NT_P1
#define LDNT1(p_) __builtin_nontemporal_load(p_)
#else
#define LDNT1(p_) (*(p_))
#endif
#ifdef NT_P3
#define LDNT3(p_) __builtin_nontemporal_load(p_)
#else
#define LDNT3(p_) (*(p_))
#endif
#define SCAN_LOAD_CHUNK_NT(crow_, dir_) do { _Pragma("unroll") for (int tt = 0; tt < 8; ++tt) { const int rr_ = 8 * wave + tt; const size_t ro_ = (size_t)((crow_) + ((dir_) ? 63 - rr_ : rr_)) * INW + 2 * lane; \
        kraw[tt] = LDNT3((const unsigned*)(P + ro_ + colk)); vraw[tt] = LDNT3((const unsigned*)(P + ro_ + colv)); if (LOADQ) qraw[tt] = LDNT3((const unsigned*)(P + ro_ + colq)); } } while (0)
#define SCAN_STORE_STATE(slot_) do { _Pragma("unroll") for (int vi = 0; vi < 8; ++vi) { u32x2 w; w.x = cvt_pk_bf16(ST[vi][0], ST[vi][1]); w.y = cvt_pk_bf16(ST[vi][2], ST[vi][3]); \
        *(u32x2*)(UB + (size_t)(slot_) * 16384 + (size_t)(vi * 512 + tid) * 4) = w; } } while (0)

struct ScanPtrs { const bf16_t* P; const bf16_t* SB; bf16_t* UB; float* AB; bf16_t* MIX; float* OB; const float* rdec; const float* onorm; };

__device__ __forceinline__ void scan1_hg_A(LAS unsigned char* lds, const ScanBufs& B, const unsigned (&kraw)[8], f32x2 (&c2)[8], int lane, int wave) {
    f32x2 r2 = {0.f, 0.f};
#pragma unroll
    for (int tt = 0; tt < 8; ++tt) { r2 += (f32x2){bf_lo(kraw[tt]), bf_hi(kraw[tt])}; c2[tt] = r2; }
    *(LAS f32x2*)(lds + B.part + (wave * 128 + 2 * lane) * 4) = r2;
}
__device__ __forceinline__ void scan1_hg_B(LAS unsigned char* lds, const ScanBufs& B, const unsigned (&kraw)[8], const unsigned (&vraw)[8], const f32x2 (&c2)[8], int lane, int wave, float& la_out, float& lb_out) {
    const int cp = lane, to = wave;
#ifndef SCAN_LOG2
    constexpr float LS = 1.4426950408889634f;
#else
    constexpr float LS = 1.0f;
#endif
    f32x2 p2 = {0.f, 0.f}, m2 = {0.f, 0.f}, l2 = {0.f, 0.f};
#pragma unroll
    for (int t8 = 0; t8 < 8; ++t8) { const f32x2 pp = *(const LAS f32x2*)(lds + B.part + (t8 * 128 + 2 * cp) * 4);
        if (t8 < to) p2 += pp; if (t8 < 4) m2 += pp; l2 += pp; }
    p2 = (p2 - m2) * LS;
    unsigned kd[8];
#pragma unroll
    for (int tt = 0; tt < 8; ++tt) {
        f32x2 d2 = p2 + c2[tt] * LS;
        d2 = __builtin_elementwise_min(__builtin_elementwise_max(d2, (f32x2){-120.f, -120.f}), (f32x2){120.f, 120.f});
        const f32x2 lf2 = (f32x2){bf_lo(kraw[tt]), bf_hi(kraw[tt])} * LS;
        const f32x2 k2 = (f32x2){1.0f, 1.0f} - (f32x2){__builtin_amdgcn_exp2f(lf2.x), __builtin_amdgcn_exp2f(lf2.y)};
        const f32x2 kt2 = k2 * (f32x2){__builtin_amdgcn_exp2f(-d2.x), __builtin_amdgcn_exp2f(-d2.y)};
        kd[tt] = cvt_pk_bf16(kt2.x, kt2.y); }
    scan_write_T(lds + B.kt, kd, cp, to); scan_write_T(lds + B.vt, vraw, cp, to);
    if (to == 0) { *(LAS f32x2*)(lds + B.va + 8 * cp) = (f32x2){ex2(l2.x), ex2(l2.y)}; *(LAS f32x2*)(lds + B.vb + 8 * cp) = (f32x2){ex2(l2.x - m2.x), ex2(l2.y - m2.y)}; }
    la_out = l2.x; lb_out = l2.y;
}
template <bool RET>
__device__ __forceinline__ void scan1_item(const ScanPtrs& sp, LAS unsigned char* lds, int tid, int lane, int wave, int seq, int tb) {
    const bf16_t* P = sp.P; bf16_t* UB = sp.UB; const int fr = lane & 15, fq = lane >> 4;
    const int b = seq >> 4, hh = (seq >> 1) & 7, dir = seq & 1, h = hh & 3;
    const int colk = RET ? 6 * 512 + h * 128 : (dir ? 2 * 512 : 512) + h * 128, colv = (RET ? 7 * 512 : 3 * 512) + h * 128;
    const float lg2 = RET ? -expf(sp.rdec[dir * 4 + h]) * LOG2E_ : 0.f, g64 = ex2(64.f * lg2);
    const int rowbase = b * LTOT + tb * 256;
    f32x4 ST[8];
#pragma unroll
    for (int vi = 0; vi < 8; ++vi) ST[vi] = (f32x4){0.f, 0.f, 0.f, 0.f};
    float ata = 0.f, atb = 0.f; unsigned kr[3][8], vr[3][8], qdummy[8]; f32x2 c2[2][8];
#pragma unroll
    for (int tt = 0; tt < 8; ++tt) qdummy[tt] = 0u;
#define S1_LOAD(set_, ci_) do { const int crow_ = rowbase + (dir ? 3 - (ci_) : (ci_)) * 64; _Pragma("unroll") for (int tt = 0; tt < 8; ++tt) { const int rr_ = 8 * wave + tt; const size_t ro_ = (size_t)(crow_ + (dir ? 63 - rr_ : rr_)) * INW + 2 * lane; \
        kr[set_][tt] = LDNT1((const unsigned*)(P + ro_ + colk)); vr[set_][tt] = LDNT1((const unsigned*)(P + ro_ + colv)); } } while (0)
#define S1_A(ci_) do { if (!RET) scan1_hg_A(lds, scan_bufs((ci_) & 1), kr[(ci_) % 3], c2[(ci_) & 1], lane, wave); } while (0)
#define S1_B(ci_) do { const ScanBufs B_ = scan_bufs((ci_) & 1); if (RET) scan_estage_ret<false>(lds, B_, kr[(ci_) % 3], qdummy, vr[(ci_) % 3], lane, wave, lg2); \
        else { float la_, lb_; scan1_hg_B(lds, B_, kr[(ci_) % 3], vr[(ci_) % 3], c2[(ci_) & 1], lane, wave, la_, lb_); ata += la_; atb += lb_; } } while (0)
#define S1_U(ci_) scan_state_update<RET>(lds, scan_bufs((ci_) & 1), ST, wave, fr, fq, g64)
    S1_LOAD(0, 0); S1_LOAD(1, 1); S1_LOAD(2, 2);
    S1_A(0);                         BAR_LDS();
    S1_B(0); S1_LOAD(0, 3); S1_A(1); BAR_LDS();
    S1_U(0); S1_B(1); S1_A(2);       BAR_LDS();
    S1_U(1); S1_B(2); S1_A(3);       BAR_LDS();
    S1_U(2); S1_B(3);                BAR_LDS();
    S1_U(3);
#undef S1_LOAD
#undef S1_A
#undef S1_B
#undef S1_U
    const int slot = seq * 65 + tb;
    SCAN_STORE_STATE(slot);
    if (wave == 0) *(f32x2*)(sp.AB + (size_t)slot * 128 + 2 * lane) = RET ? (f32x2){ex2(256.f * lg2), ex2(256.f * lg2)} : (f32x2){ex2(ata), ex2(atb)};
}

template <bool RET>
__device__ __forceinline__ void scan3_item(const ScanPtrs& sp, LAS unsigned char* lds, int tid, int lane, int wave, int bh, int tb, bool store_state, int nch = 4) {
#ifdef PROBE_SKIP
    if ((PROBE_SKIP == 1 && RET) || (PROBE_SKIP == 2 && !RET)) return;
#endif
    const bf16_t* P = sp.P; bf16_t* UB = sp.UB; float* OB = sp.OB;
    const int ti = wave & 3, vh = wave >> 2; constexpr bool LOADQ = true;
    const int b = bh >> 3, hh = bh & 7, h = hh & 3;
    const int colq = (RET ? 5 * 512 : 0) + h * 128, colv = (RET ? 7 * 512 : 3 * 512) + h * 128, colg = (RET ? 8 * 512 : 4 * 512) + h * 128, mixcol = hh * 128;
    const int rowbase = b * LTOT + tb * 256;
#pragma unroll 1
    for (int dir = 1; dir >= 0; --dir) {
        const int colk = RET ? 6 * 512 + h * 128 : (dir ? 2 * 512 : 512) + h * 128;
        const float lg2 = RET ? -expf(sp.rdec[dir * 4 + h]) * LOG2E_ : 0.f, g64 = ex2(64.f * lg2);
        f32x4 ST[8];
        if (tb == 0) {
#pragma unroll
            for (int vi = 0; vi < 8; ++vi) ST[vi] = (f32x4){0.f, 0.f, 0.f, 0.f};
        } else { const size_t slot = (size_t)(bh * 2 + dir) * 65 + tb + ((nch == 8 && dir) ? 1 : 0);
#pragma unroll
            for (int vi = 0; vi < 8; ++vi) { const u32x2 w = LDNT((const u32x2*)(sp.SB + slot * 16384 + (size_t)(vi * 512 + tid) * 4)); ST[vi] = (f32x4){bf_lo(w.x), bf_hi(w.x), bf_lo(w.y), bf_hi(w.y)}; } }
        float ata = 0.f, atb = 0.f; unsigned kraw[8], qraw[8], vraw[8];
        SCAN_LOAD_CHUNK_NT(rowbase + (dir ? nch - 1 : 0) * 64, dir);
#pragma unroll 1
        for (int ci = 0; ci < nch; ++ci) {
            const int tc = dir ? nch - 1 - ci : ci;
            int lane_ = lane; asm volatile("" : "+v"(lane_));
            const int fr = lane_ & 15, fq = lane_ >> 4, t = 16 * ti + fr; const float gt1 = ex2((float)(t + 1) * lg2);
            const ScanBufs B0 = scan_bufs(0);
            if (RET) scan_estage_ret<true>(lds, B0, kraw, qraw, vraw, lane, wave, lg2);
            else { float la, lb; scan_estage_hg<true>(lds, B0, kraw, qraw, vraw, lane, wave, la, lb); ata += la; atb += lb; }
#ifdef PROBE_S3_E2
            BAR_LDS();
            if (RET) scan_estage_ret<true>(lds, B0, kraw, qraw, vraw, lane, wave, lg2);
            else { float la, lb; scan_estage_hg<true>(lds, B0, kraw, qraw, vraw, lane, wave, la, lb); }
#endif
            if (ci < nch - 1) { const int tcn = dir ? nch - 2 - ci : ci + 1; SCAN_LOAD_CHUNK_NT(rowbase + tcn * 64, dir); }
            const int tok = tc * 64 + (dir ? 63 - t : t), grow = rowbase + tok;
            u32x2 obv[4]; u32x2 gv[4];
            if (dir == 0) {
#pragma unroll
                for (int j = 0; j < 4; ++j) gv[j] = LDNT2((const u32x2*)(P + (size_t)grow * INW + colg + 16 * (4 * vh + j) + 4 * fq));
#pragma unroll
                for (int jp = 0; jp < 2; ++jp) { const u32x4 w4 = *((const u32x4*)OB + ((((tc * 4 + ti) * 2 + vh) * 2 + jp) * 64 + fq * 16 + fr)); obv[2 * jp] = (u32x2){w4.x, w4.y}; obv[2 * jp + 1] = (u32x2){w4.z, w4.w}; } }
            if (!RET) BAR_LDS();
            { f32x4 em = {1.f, 1.f, 1.f, 1.f}; if (!RET) em = *(const LAS f32x4*)(lds + SC_VM + (16 * wave + 4 * fq) * 4);
#pragma unroll
              for (int vi = 0; vi < 8; ++vi) { const f32x4 x = RET ? ST[vi] : ST[vi] * em; u32x2 w; w.x = cvt_pk_bf16(x[0], x[1]); w.y = cvt_pk_bf16(x[2], x[3]); *(LAS u32x2*)(lds + SC_SM + st_off(16 * vi + fr, 32 * wave + 8 * fq, 4)) = w; } }
            if (RET) BAR_LDS();
#pragma unroll
            for (int sii = 0; sii < 2; ++sii) { const int si = 2 * vh + sii; f32x4 sc = {0.f, 0.f, 0.f, 0.f};
                if (si <= ti) {
#pragma unroll
                    for (int ks = 0; ks < 4; ++ks) sc = MFMA16(ldfrag(lds + SC_KI, si, ks, 4, st_lane(fr, fq)), ldfrag(lds + SC_QI, ti, ks, 4, st_lane(fr, fq)), sc);
                    const int s0 = 16 * si + 4 * fq;
#pragma unroll
                    for (int r = 0; r < 4; ++r) { const float dm = RET ? ex2((float)(t - s0 - r) * lg2) : 1.0f; sc[r] = (s0 + r <= t) ? sc[r] * dm : 0.f; } }
                u32x2 w; w.x = cvt_pk_bf16(sc[0], sc[1]); w.y = cvt_pk_bf16(sc[2], sc[3]); *(LAS u32x2*)(lds + SC_PI + st_off(t, 32 * si + 8 * fq, 2)) = w; }
            BAR_LDS();
            f32x4 o[4];
#pragma unroll
            for (int j = 0; j < 4; ++j) o[j] = (f32x4){0.f, 0.f, 0.f, 0.f};
            {
                const int lp = st_lane(fr, fq);
                const LAS unsigned char* pq = lds + SC_QI + (ti * 4) * 1024 + lp;
                const LAS unsigned char* pm = lds + SC_SM + (4 * vh * 4) * 1024 + lp;
                const LAS unsigned char* pp = lds + SC_PI + (ti * 2) * 1024 + lp;
                const LAS unsigned char* pv = lds + SC_VT + (4 * vh * 2) * 1024 + lp;
                const LAS unsigned char* pk = lds + SC_KT + (wave * 2) * 1024 + lp;
                const LAS unsigned char* pw = lds + SC_VT + lp;
                f32x4 av = {g64, g64, g64, g64}, bv = {1.f, 1.f, 1.f, 1.f};
                if (!RET) { av = *(const LAS f32x4*)(lds + SC_VA + (16 * wave + 4 * fq) * 4); bv = *(const LAS f32x4*)(lds + SC_VB + (16 * wave + 4 * fq) * 4); }
#define SC_LD(p_, off_) (*(const LAS bf16x8*)((p_) + (off_)))
#define SC_FENCE() __builtin_amdgcn_sched_barrier(0)
                bf16x8 qa, ma[4], qb, mb[4], qc, mc[4];
                qa = SC_LD(pq, 0); _Pragma("unroll") for (int j = 0; j < 4; ++j) ma[j] = SC_LD(pm, 4096 * j);
                qb = SC_LD(pq, 1024); _Pragma("unroll") for (int j = 0; j < 4; ++j) mb[j] = SC_LD(pm, 4096 * j + 1024);
                SC_FENCE();
                qc = SC_LD(pq, 2048); _Pragma("unroll") for (int j = 0; j < 4; ++j) mc[j] = SC_LD(pm, 4096 * j + 2048);
                _Pragma("unroll") for (int j = 0; j < 4; ++j) o[j] = MFMA16(ma[j], qa, o[j]);
                SC_FENCE();
                qa = SC_LD(pq, 3072); _Pragma("unroll") for (int j = 0; j < 4; ++j) ma[j] = SC_LD(pm, 4096 * j + 3072);
                _Pragma("unroll") for (int j = 0; j < 4; ++j) o[j] = MFMA16(mb[j], qb, o[j]);
                SC_FENCE();
                qb = SC_LD(pp, 0); _Pragma("unroll") for (int j = 0; j < 4; ++j) mb[j] = SC_LD(pv, 2048 * j);
                _Pragma("unroll") for (int j = 0; j < 4; ++j) o[j] = MFMA16(mc[j], qc, o[j]);
                SC_FENCE();
                qc = SC_LD(pp, 1024); _Pragma("unroll") for (int j = 0; j < 4; ++j) mc[j] = SC_LD(pv, 2048 * j + 1024);
                _Pragma("unroll") for (int j = 0; j < 4; ++j) o[j] = MFMA16(ma[j], qa, o[j]);
                SC_FENCE();
                if (RET) { _Pragma("unroll") for (int j = 0; j < 4; ++j) o[j] *= gt1; }
                bf16x8 k0 = SC_LD(pk, 0), k1 = SC_LD(pk, 1024), w0[4], w1[4];
                _Pragma("unroll") for (int q = 0; q < 2; ++q) { w0[q] = SC_LD(pw, 2048 * q); w1[q] = SC_LD(pw, 2048 * q + 1024); }
                _Pragma("unroll") for (int j = 0; j < 4; ++j) o[j] = MFMA16(mb[j], qb, o[j]);
                SC_FENCE();
                _Pragma("unroll") for (int q = 2; q < 4; ++q) { w0[q] = SC_LD(pw, 2048 * q); w1[q] = SC_LD(pw, 2048 * q + 1024); }
                _Pragma("unroll") for (int j = 0; j < 4; ++j) o[j] = MFMA16(mc[j], qc, o[j]);
                SC_FENCE();
                bf16x8 x0[4], x1[4];
                _Pragma("unroll") for (int q = 0; q < 4; ++q) { x0[q] = SC_LD(pw, 2048 * (4 + q)); x1[q] = SC_LD(pw, 2048 * (4 + q) + 1024); }
                _Pragma("unroll") for (int q = 0; q < 4; ++q) { f32x4 u = {0.f, 0.f, 0.f, 0.f}; u = MFMA16(k0, w0[q], u); u = MFMA16(k1, w1[q], u); ST[q] = RET ? (av * ST[q] + u) : (av * ST[q] + bv * u); }
                SC_FENCE();
                _Pragma("unroll") for (int q = 0; q < 4; ++q) { f32x4 u = {0.f, 0.f, 0.f, 0.f}; u = MFMA16(k0, x0[q], u); u = MFMA16(k1, x1[q], u); ST[4 + q] = RET ? (av * ST[4 + q] + u) : (av * ST[4 + q] + bv * u); }
#undef SC_LD
#undef SC_FENCE
            }
            if (dir == 1) {
#pragma unroll
                for (int jp = 0; jp < 2; ++jp) { u32x4 w4; w4.x = cvt_pk_bf16(o[2 * jp][0], o[2 * jp][1]); w4.y = cvt_pk_bf16(o[2 * jp][2], o[2 * jp][3]); w4.z = cvt_pk_bf16(o[2 * jp + 1][0], o[2 * jp + 1][1]); w4.w = cvt_pk_bf16(o[2 * jp + 1][2], o[2 * jp + 1][3]); *((u32x4*)OB + ((((tc * 4 + (3 - ti)) * 2 + vh) * 2 + jp) * 64 + fq * 16 + (15 - fr))) = w4; }
                BAR_LDS();
            } else {
                float ss = 0.f;
#pragma unroll
                for (int j = 0; j < 4; ++j) { o[j] += (f32x4){bf_lo(obv[j].x), bf_hi(obv[j].x), bf_lo(obv[j].y), bf_hi(obv[j].y)}; ss += (o[j][0] * o[j][0] + o[j][1] * o[j][1]) + (o[j][2] * o[j][2] + o[j][3] * o[j][3]); }
                ss += shx(ss, 16, lane_); ss += shx(ss, 32, lane_);
                if (fq == 0) *(LAS float*)(lds + SC_RED + ((ci & 1) * 128 + vh * 64 + t) * 4) = ss;
                BAR_LDS();
                const float tot = ss + *(const LAS float*)(lds + SC_RED + ((ci & 1) * 128 + (vh ^ 1) * 64 + t) * 4);
                const float rinv = __builtin_amdgcn_rsqf(tot * (1.0f / 128.0f) + EPS);
#pragma unroll
                for (int j = 0; j < 4; ++j) { const f32x4 onv = RET ? (f32x4){1.f, 1.f, 1.f, 1.f} : *(const f32x4*)(sp.onorm + 16 * (4 * vh + j) + 4 * fq);
                    const f32x4 y = o[j] * rinv * onv * (f32x4){bf_lo(gv[j].x), bf_hi(gv[j].x), bf_lo(gv[j].y), bf_hi(gv[j].y)};
                    u32x2 w; w.x = cvt_pk_bf16(y[0], y[1]); w.y = cvt_pk_bf16(y[2], y[3]); *(u32x2*)(sp.MIX + (size_t)grow * D + mixcol + 16 * (4 * vh + j) + 4 * fq) = w; }
#ifdef PROBE_BAR
                BAR_LDS();
#endif
            }
        }
        if (store_state) { const int slot = (bh * 2 + dir) * 65 + tb; SCAN_STORE_STATE(slot);
            if (wave == 0) *(f32x2*)(sp.AB + (size_t)slot * 128 + 2 * lane) = RET ? (f32x2){ex2(256.f * lg2), ex2(256.f * lg2)} : (f32x2){ex2(ata), ex2(atb)}; }
        BAR_ALL();
    }
}

__device__ __forceinline__ ScanPtrs scan_ptrs(const Ctx& a, int l) {
    unsigned char* ws = a.ws(); ScanPtrs sp; sp.P = (const bf16_t*)(ws + WS_P); sp.SB = (const bf16_t*)(ws + WS_SB); sp.UB = (bf16_t*)(ws + WS_UB); sp.AB = (float*)(ws + WS_AB); sp.MIX = (bf16_t*)(ws + WS_MIX);
    sp.OB = (float*)(ws + WS_OB) + (size_t)blockIdx.x * 32768; sp.rdec = a.in(I_RDEC) + l * 8; sp.onorm = a.in(I_ONORM) + l * 128; return sp;
}

constexpr int SW_KT = 0, SW_VT = 65536, SW_PART = 131072;
struct S1Id { int seq, tb; };
__device__ __forceinline__ void scan_write_T8(LAS unsigned char* img, const unsigned (&d)[8], int cp, int tg) {
    u32x4 wa, wb;
    wa.x = (d[0] & 0xffffu) | (d[1] << 16); wa.y = (d[2] & 0xffffu) | (d[3] << 16); wa.z = (d[4] & 0xffffu) | (d[5] << 16); wa.w = (d[6] & 0xffffu) | (d[7] << 16);
    wb.x = (d[0] >> 16) | (d[1] & 0xffff0000u); wb.y = (d[2] >> 16) | (d[3] & 0xffff0000u); wb.z = (d[4] >> 16) | (d[5] & 0xffff0000u); wb.w = (d[6] >> 16) | (d[7] & 0xffff0000u);
    *(LAS u32x4*)(img + st_off(2 * cp, tg * 16, 8)) = wa; *(LAS u32x4*)(img + st_off(2 * cp + 1, tg * 16, 8)) = wb;
}
#define S1W_LOAD(id_) do { const int seq_ = (id_).seq, hh_ = (seq_ >> 1) & 7, dir_ = seq_ & 1, h_ = hh_ & 3; const bool ret_ = hh_ >= 4; \
        const int colk_ = ret_ ? 6 * 512 + h_ * 128 : (dir_ ? 2 * 512 : 512) + h_ * 128, colv_ = (ret_ ? 7 * 512 : 3 * 512) + h_ * 128; \
        const int row0_ = (seq_ >> 4) * LTOT + (id_).tb * 256; int ln_ = lane; asm volatile("" : "+v"(ln_)); \
        _Pragma("unroll") for (int i = 0; i < 32; ++i) { const int p_ = 32 * wave + i; const size_t ro_ = (size_t)(row0_ + (dir_ ? 255 - p_ : p_)) * INW + 2 * ln_; \
            kr[i] = *(const unsigned*)(sp.P + ro_ + colk_); vr[i] = *(const unsigned*)(sp.P + ro_ + colv_); } } while (0)
__device__ __forceinline__ void scan1w_item(const ScanPtrs& sp, LAS unsigned char* lds, int lane, int wave, const S1Id id, unsigned (&kr)[32], unsigned (&vr)[32], bool have_next, const S1Id nxt) {
    asm volatile("" : "+v"(lane), "+s"(wave)); const int tid = wave * 64 + lane;
    bf16_t* UB = sp.UB; const int fr = lane & 15, fq = lane >> 4;
    const int seq = id.seq, tb = id.tb, hh = (seq >> 1) & 7, dir = seq & 1, h = hh & 3; const bool RET = hh >= 4;
    const float lg2 = RET ? -expf(sp.rdec[dir * 4 + h]) * LOG2E_ : 0.f;
#ifndef SCAN_LOG2
    constexpr float LS = 1.4426950408889634f;
#else
    constexpr float LS = 1.0f;
#endif
    if (!RET) { f32x2 t2 = {0.f, 0.f};
#pragma unroll
        for (int i = 0; i < 32; ++i) t2 += (f32x2){bf_lo(kr[i]), bf_hi(kr[i])};
        *(LAS f32x2*)(lds + SW_PART + (wave * 64 + lane) * 8) = t2; }
    BAR_LDS();
    f32x2 pw = {0.f, 0.f}, T2 = {0.f, 0.f};
    if (!RET) {
#pragma unroll
        for (int w8 = 0; w8 < 8; ++w8) { const f32x2 pp = *(const LAS f32x2*)(lds + SW_PART + (w8 * 64 + lane) * 8); if (w8 < wave) pw += pp; T2 += pp; } }
    f32x2 r2 = pw;
#pragma unroll
    for (int g = 0; g < 4; ++g) { unsigned kd[8], vv[8];
#pragma unroll
        for (int tt = 0; tt < 8; ++tt) { const int i = 8 * g + tt; vv[tt] = vr[i];
            if (RET) { const float wk = ex2((float)(255 - (32 * wave + i)) * lg2); kd[tt] = cvt_pk_bf16(bf_lo(kr[i]) * wk, bf_hi(kr[i]) * wk); }
            else { const f32x2 lf = {bf_lo(kr[i]), bf_hi(kr[i])}; r2 += lf;
                f32x2 d2 = (T2 - r2) * LS; d2 = __builtin_elementwise_max(d2, (f32x2){-120.f, -120.f});
                const f32x2 lf2 = lf * LS; const f32x2 k2 = (f32x2){1.0f, 1.0f} - (f32x2){__builtin_amdgcn_exp2f(lf2.x), __builtin_amdgcn_exp2f(lf2.y)};
                const f32x2 kt2 = k2 * (f32x2){__builtin_amdgcn_exp2f(d2.x), __builtin_amdgcn_exp2f(d2.y)}; kd[tt] = cvt_pk_bf16(kt2.x, kt2.y); } }
        scan_write_T8(lds + SW_KT, kd, lane, 4 * wave + g); scan_write_T8(lds + SW_VT, vv, lane, 4 * wave + g); }
    if (have_next) S1W_LOAD(nxt);
    BAR_LDS();
    f32x4 ST[8];
#pragma unroll
    for (int vi = 0; vi < 8; ++vi) ST[vi] = (f32x4){0.f, 0.f, 0.f, 0.f};
    { const int lp = st_lane(fr, fq);
#pragma unroll
      for (int ks = 0; ks < 8; ++ks) { const bf16x8 af = ldfrag(lds + SW_KT, wave, ks, 8, lp);
#pragma unroll
          for (int vi = 0; vi < 8; ++vi) ST[vi] = MFMA16(af, ldfrag(lds + SW_VT, vi, ks, 8, lp), ST[vi]);
          if (ks & 1) __builtin_amdgcn_sched_barrier(0); } }
    const int slot = seq * 65 + tb;
    SCAN_STORE_STATE(slot);
    if (wave == 0) *(f32x2*)(sp.AB + (size_t)slot * 128 + 2 * lane) = RET ? (f32x2){ex2(256.f * lg2), ex2(256.f * lg2)} : (f32x2){ex2(T2.x), ex2(T2.y)};
}
__device__ __forceinline__ bool s1_enum(bool modeA, bool last, int c, int G, int& k, S1Id& id) {
    constexpr int HS = 7;
    for (;; ++k) {
        if (modeA) { const int it = c + k * G; if (it >= 2048) return false; const int seq = it >> 6, j = it & 63; if (!last && j == 0) continue;
            id.seq = seq; id.tb = (seq & 1) ? (j == 0 ? 0 : 65 - j) : j; ++k; return true; }
        const int li = k < HS ? k * (G - 16) + (c - 16) : HS * (G - 16) + (k - HS) * G + c;
        if (li >= 2016) return false;
        const int seq = li / 63, j = 1 + li % 63; id.seq = seq; id.tb = (seq & 1) ? 65 - j : j; ++k; return true; }
}

__device__ __forceinline__ void scan1_phase(const Ctx& a, int l) {
    PHASE_IDS(); LAS unsigned char* lds = launder_lds(a.lds); const ScanPtrs sp = scan_ptrs(a, l);
#ifdef PROBE_NOMERGE
    const bool last = true; const int c = blockIdx.x, G = gridDim.x;
#else
    const bool last = (l == DEPTH - 1); const int c = blockIdx.x, G = gridDim.x;
#endif
#ifdef SCAN_PRIO1
    if (wave >= 4) __builtin_amdgcn_s_setprio(1);
#endif
#ifdef S1_WIDE
    { const bool modeA = last || G < 32;
      if (!last) { if (modeA) { for (int bh = c; bh < 16; bh += G) { if ((bh & 7) >= 4) scan3_item<true>(sp, lds, tid, lane, wave, bh, 0, true); else scan3_item<false>(sp, lds, tid, lane, wave, bh, 0, true); } }
                   else if (c < 16) { if ((c & 7) >= 4) scan3_item<true>(sp, lds, tid, lane, wave, c, 0, true); else scan3_item<false>(sp, lds, tid, lane, wave, c, 0, true); } }
      int k = (!modeA && c < 16) ? 7 : 0; S1Id id, nx; unsigned kr[32], vr[32];
      bool have = s1_enum(modeA, last, c, G, k, id);
      if (have) S1W_LOAD(id);
      while (have) { nx = id; const bool have2 = s1_enum(modeA, last, c, G, k, nx);
          scan1w_item(sp, lds, lane, wave, id, kr, vr, have2, nx);
          have = have2; id = nx; }
      BAR_LDS();
      return; }
#endif
    if (last || G < 32) {
        if (!last) for (int bh = c; bh < 16; bh += G) { if ((bh & 7) >= 4) scan3_item<true>(sp, lds, tid, lane, wave, bh, 0, true); else scan3_item<false>(sp, lds, tid, lane, wave, bh, 0, true); }
        for (int it = c; it < 2048; it += G) { const int seq = it >> 6, j = it & 63; if (!last && j == 0) continue; const int dir = seq & 1, tb = dir ? (j == 0 ? 0 : 65 - j) : j;
            if (((seq >> 1) & 7) >= 4) scan1_item<true>(sp, lds, tid, lane, wave, seq, tb); else scan1_item<false>(sp, lds, tid, lane, wave, seq, tb); }
        return;
    }
    if (c < 16) { if ((c & 7) >= 4) scan3_item<true>(sp, lds, tid, lane, wave, c, 0, true); else scan3_item<false>(sp, lds, tid, lane, wave, c, 0, true); }
    constexpr int HS = 7;
    for (int k = (c < 16 ? HS : 0);; ++k) {
        const int li = k < HS ? k * (G - 16) + (c - 16) : HS * (G - 16) + (k - HS) * G + c;
        if (li >= 2016) break;
        const int seq = li / 63, j = 1 + li % 63, dir = seq & 1, tb = dir ? 65 - j : j;
        if (((seq >> 1) & 7) >= 4) scan1_item<true>(sp, lds, tid, lane, wave, seq, tb); else scan1_item<false>(sp, lds, tid, lane, wave, seq, tb);
    }
}

__device__ __forceinline__ void scan2_phase(const Ctx& a) {
#ifdef SCAN_PRIO1
    __builtin_amdgcn_s_setprio(0);
#endif
    PHASE_IDS(); unsigned char* ws = a.ws(); const bf16_t* UB = (const bf16_t*)(ws + WS_UB); bf16_t* SB = (bf16_t*)(ws + WS_SB); const float* AB = (const float*)(ws + WS_AB);
    const int c0 = 16 * (tid >> 6) + 4 * ((tid >> 4) & 3);
    for (int p = blockIdx.x; p < 256; p += gridDim.x) { const int seq = p >> 3, vi = p & 7, dir = seq & 1; const size_t eo = (size_t)(vi * 512 + tid) * 4;
        f32x4 s = {0.f, 0.f, 0.f, 0.f};
#define S2_SLOT(j_) ((size_t)seq * 65 + (dir ? ((j_) == 0 ? 0 : 65 - (j_)) : (j_)))
#define S2_LOAD(u_, av_, j0_) do { _Pragma("unroll") for (int q = 0; q < 8; ++q) { const size_t slot = S2_SLOT((j0_) + q); u_[q] = LDNT((const u32x2*)(UB + slot * 16384 + eo)); av_[q] = *(const f32x4*)(AB + slot * 128 + c0); } } while (0)
#define S2_STEP(u_, av_, j0_) do { _Pragma("unroll") for (int q = 0; q < 8; ++q) { const size_t slot = S2_SLOT((j0_) + q); \
            if (q & 1) { u32x2 w; w.x = cvt_pk_bf16(s[0], s[1]); w.y = cvt_pk_bf16(s[2], s[3]); *(u32x2*)(SB + slot * 16384 + eo) = w; }     \
            s = av_[q] * s + (f32x4){bf_lo(u_[q].x), bf_hi(u_[q].x), bf_lo(u_[q].y), bf_hi(u_[q].y)}; } } while (0)
        u32x2 ua[8], ub[8]; f32x4 aa[8], ab[8];
        S2_LOAD(ua, aa, 0);
#pragma unroll 1
        for (int j0 = 0; j0 < 64; j0 += 16) {
            S2_LOAD(ub, ab, j0 + 8);
            S2_STEP(ua, aa, j0);
            if (j0 + 16 < 64) S2_LOAD(ua, aa, j0 + 16);
            S2_STEP(ub, ab, j0 + 8); }
#undef S2_SLOT
#undef S2_LOAD
#undef S2_STEP
    }
}

__device__ __forceinline__ void scan3_phase(const Ctx& a, int l) {
    PHASE_IDS(); LAS unsigned char* lds = launder_lds(a.lds); const ScanPtrs sp = scan_ptrs(a, l);
#ifdef SCAN_PRIO
    if (wave >= 4) __builtin_amdgcn_s_setprio(1);
#endif
#ifdef PROBE_NOMERGE
    if (l != DEPTH - 1) for (int bh = blockIdx.x; bh < 16; bh += gridDim.x) { if ((bh & 7) >= 4) scan3_item<true>(sp, lds, tid, lane, wave, bh, 0, false); else scan3_item<false>(sp, lds, tid, lane, wave, bh, 0, false); }
#endif
    for (int it = blockIdx.x; it < 512; it += gridDim.x) { const int half = it >> 8, cc = it & 255; const int bh = (cc & 15) ^ (half ? 4 : 0), tb = 1 + 2 * ((half << 4) + (cc >> 4));
        if ((bh & 7) >= 4) scan3_item<true>(sp, lds, tid, lane, wave, bh, tb, false, 8); else scan3_item<false>(sp, lds, tid, lane, wave, bh, tb, false, 8); }
#ifdef SCAN_PRIO
    __builtin_amdgcn_s_setprio(0);
#endif
}

struct OutOrder {
    static constexpr bool PADTILES = false;
    __device__ __forceinline__ bool half_rows(const pg8::Unit&) const { return false; }
    int nrt, skipctx, G, c;
    __device__ __forceinline__ bool next(int i, pg8::Unit& u) const {
        const int L = i * G + c; if (L >= nrt * 4) return false;
        const int r = L >> 2; u.pn = L & 3; u.pm = skipctx ? r + 1 + (r >= 64 ? 1 : 0) : r; return true;
    }
    __device__ __forceinline__ void a_ready(const pg8::Unit&) const {}
    __device__ __forceinline__ void done(const pg8::Unit&) const {}
};

#ifndef PH
#define PH 0xffff
#endif
#ifndef DBL
#define DBL 0
#endif
__global__ void __launch_bounds__(512, 2) mega_fwd(Args a) {
    extern __shared__ __attribute__((aligned(16))) unsigned char lds_raw[];
    LAS unsigned char* lds = (LAS unsigned char*)lds_raw;
    const int tid = threadIdx.x;
    const int G = gridDim.x; const int bx = blockIdx.x; const int vcu = (G % 8 == 0) ? (bx % 8) * (G / 8) + bx / 8 : bx;
    volatile LAS unsigned* MISC = (volatile LAS unsigned*)(lds + MISC_OFF);
    if (tid < 16) MISC[tid] = 0u;
    if (tid == 0) { LAS unsigned long long* pt = (LAS unsigned long long*)(lds + PTR_OFF);
#pragma unroll
        for (int i = 0; i < 18; ++i) pt[i] = (unsigned long long)a.in[i];
        pt[18] = (unsigned long long)a.out; pt[19] = (unsigned long long)a.ws; }
    __syncthreads();
    const Ctx cx{lds, __builtin_amdgcn_readfirstlane(tid >> 6)};
    XcdBarrier bar = xcd_barrier_post((unsigned*)(cx.ws() + WS_CTL) + 1024, MISC + 8);
#define GRID_BAR() do { XcdBarrier b2_ = bar; asm volatile("" : "+s"(b2_.x)); xcd_barrier(b2_); } while (0)

#if PH & 1
    p0_prologue(cx);
#endif
    GRID_BAR();
#if DBL & 1
    p0_prologue(cx);
    GRID_BAR();
#endif
#if PH & 1
    p0_finalize(cx);
#endif
    GRID_BAR();

#pragma unroll 1
    for (int l = 0; l < DEPTH; ++l) {
        const bool last = (l == DEPTH - 1); unsigned char* ws = cx.ws();
#ifdef PROBE_NOBG
        const bool bgc = false;
#else
        const bool bgc = (G == 256);
#endif

#if DBL & 64
        norm1_phase<2>(cx, l);
        GRID_BAR();
#endif
#if PH & 2
        norm1_phase<0>(cx, l);
#endif
        GRID_BAR();
#ifdef G1_SPLIT
        const int g1k = (bgc && bx >= 36) ? ((bx >> 3) % 5) : 0;
        if (g1k > 0) cvt_tail(cx, CVT_N0 + l * CVT_CYC, bx - 36, 4, 0, g1k);
#endif
#if PH & 4
        {
#ifdef G1_F8
            pg8::Gemm g{(const bf16_t*)(ws + WS_H), (const bf16_t*)(ws + WS_WIN + (size_t)l * INW * D), MROWS, INW, D, cx.w0};
            pg8::StaticOrder S; S.init(MROWS, INW, G, bx);
            pg8::EpiIn8 E{(bf16_t*)(ws + WS_P), (const float*)(ws + WS_LBS) + l * 512, (const float*)(ws + WS_ROPE)};
            pg8::gemm_phase_f8<pg8::EpiIn8, pg8::StaticOrder, false>(launder_lds(lds), g, S, E, nullptr);
#else
            pg8::Gemm g{(const bf16_t*)(ws + WS_H), (const bf16_t*)(ws + WS_WIN) + (size_t)l * INW * D, MROWS, INW, D, cx.w0};
            pg8::StaticOrder S; S.init(MROWS, INW, G, bx);
            pg8::EpiIn E{(bf16_t*)(ws + WS_P), (const float*)(ws + WS_LBS) + l * 512, (const float*)(ws + WS_ROPE)};
#ifdef STAGGER_G1
            { const unsigned long long t0_ = __builtin_amdgcn_s_memrealtime(); const unsigned long long d_ = (unsigned long long)((bx >> 3) & 3) * STAGGER_G1; while (__builtin_amdgcn_s_memrealtime() - t0_ < d_) __builtin_amdgcn_s_sleep(8); }
#endif
            pg8::gemm_phase<pg8::EpiIn, pg8::StaticOrder, true, true>(launder_lds(lds), g, S, E);
#endif
        }
#endif
#if DBL & 1024
        GRID_BAR();
        {
            pg8::Gemm g{(const bf16_t*)(ws + WS_H), (const bf16_t*)(ws + WS_WIN) + (size_t)l * INW * D, MROWS, INW, D, cx.w0};
            pg8::StaticOrder S; S.init(MROWS, INW, G, bx);
            pg8::EpiNull E{(float*)(ws + WS_OB)};
            pg8::gemm_phase<pg8::EpiNull, pg8::StaticOrder, true, true>(launder_lds(lds), g, S, E);
        }
#endif
#if DBL & 16384
        GRID_BAR();
        {
            pg8::Gemm g{(const bf16_t*)(ws + WS_H), (const bf16_t*)(ws + WS_WIN) + (size_t)l * INW * D, MROWS, INW, D, cx.w0};
            pg8::StaticOrder S; S.init(MROWS, INW, G, bx);
            pg8::EpiInT<true> E{(bf16_t*)(ws + WS_YS), (const float*)(ws + WS_LBS) + l * 512, (const float*)(ws + WS_ROPE)};
            pg8::gemm_phase<pg8::EpiInT<true>, pg8::StaticOrder, true, true>(launder_lds(lds), g, S, E);
        }
#endif
#if DBL & 128
        GRID_BAR();
        {
            pg8::Gemm g{(const bf16_t*)(ws + WS_H), (const bf16_t*)(ws + WS_WIN) + (size_t)l * INW * D, MROWS, INW, D, cx.w0};
            pg8::StaticOrder S; S.init(MROWS, INW, G, bx);
            pg8::EpiIn E{(bf16_t*)(ws + WS_P), (const float*)(ws + WS_LBS) + l * 512, (const float*)(ws + WS_ROPE)};
            pg8::gemm_phase<pg8::EpiIn, pg8::StaticOrder, true, true>(launder_lds(lds), g, S, E);
        }
#endif
#ifdef G1_SPLIT
        if (bgc && bx >= 36) cvt_tail(cx, CVT_N0 + l * CVT_CYC, bx - 36, 4, g1k, 4);
#else
        if (bgc && bx >= 36) cvt_tail<4>(cx, CVT_N0 + l * CVT_CYC, bx - 36);
#endif
#ifdef DBLCVT
        if (bgc && bx >= 36) cvt_tail<4>(cx, CVT_N0 + l * CVT_CYC, bx - 36);
#endif
        GRID_BAR();
#if DBL & 8192
#pragma unroll 1
        for (int xb = 0; xb < 10; ++xb) GRID_BAR();
#endif
#if PH & 8
        scan1_phase(cx, l);
#endif
        GRID_BAR();
#if PH & 16
        scan2_phase(cx);
#endif
        GRID_BAR();
#if PH & 32
        scan3_phase(cx, l);
#endif
        GRID_BAR();
#if DBL & 2
        scan1_phase(cx, l);
        GRID_BAR();
        scan2_phase(cx);
        GRID_BAR();
        scan3_phase(cx, l);
        GRID_BAR();
#endif
#if DBL & 8
        scan1_phase(cx, l);
        GRID_BAR();
#endif
#if DBL & 16
        scan2_phase(cx);
        GRID_BAR();
#endif
#if DBL & 32
        scan3_phase(cx, l);
        GRID_BAR();
#endif
#if PH & 64
        {
#ifdef G2_F8
            pg8::Gemm g{(const bf16_t*)(ws + WS_MIX), (const bf16_t*)(ws + WS_WOUT + (size_t)l * D * D), MROWS, D, D, cx.w0};
            OutOrder S{last ? 128 : 130, last ? 1 : 0, G, vcu};
            pg8::EpiOut8 E{(bf16_t*)(ws + WS_X), l == 0 ? cx.in(I_X) : nullptr, l == 0 ? cx.in(I_CTX) : nullptr, (const float*)(ws + WS_MODS) + (size_t)(l * 3) * 6144 + 2 * D};
            pg8::gemm_phase_f8<pg8::EpiOut8, OutOrder, false>(launder_lds(lds), g, S, E, nullptr);
#else
            pg8::Gemm g{(const bf16_t*)(ws + WS_MIX), (const bf16_t*)(ws + WS_WOUT) + (size_t)l * D * D, MROWS, D, D, cx.w0};
            OutOrder S{last ? 128 : 130, last ? 1 : 0, G, vcu};
            pg8::EpiOut E{(bf16_t*)(ws + WS_X), l == 0 ? cx.in(I_X) : nullptr, l == 0 ? cx.in(I_CTX) : nullptr, (const float*)(ws + WS_MODS) + (size_t)(l * 3) * 6144 + 2 * D};
            pg8::gemm_phase<pg8::EpiOut, OutOrder, true, true>(launder_lds(lds), g, S, E);
#endif
        }
#endif
        if (bgc && !last && vcu >= 8) cvt_tail<4>(cx, CVT_N0 + l * CVT_CYC + CVT_G1, vcu - 8);
#ifdef DBLCVT
        if (bgc && !last && vcu >= 8) cvt_tail<4>(cx, CVT_N0 + l * CVT_CYC + CVT_G1, vcu - 8);
#endif
        GRID_BAR();
#if PH & 128
        norm2_phase(cx, l);
#endif
#ifdef CVT_N2SLOT
        if (bgc && !last && bx >= 4) cvt_tail<1>(cx, CVT_N0 + l * CVT_CYC + CVT_G1 + CVT_G2, bx - 4);
#endif
        GRID_BAR();
#if DBL & 4
        norm2_phase(cx, l);
        GRID_BAR();
#endif
#if PH & 256
        topk_phase(cx, l);
#endif
        if (bgc && bx >= 64) cvt_tail<CVT_TPER>(cx, CVT_N0 + l * CVT_CYC + CVT_G1 + (last ? 0 : CVT_G2 + CVT_N2), bx - 64);
#ifdef DBLCVT
        if (bgc && bx >= 64) cvt_tail<CVT_TPER>(cx, CVT_N0 + l * CVT_CYC + CVT_G1 + (last ? 0 : CVT_G2 + CVT_N2), bx - 64);
#endif
        GRID_BAR();
#if DBL & 2048
        topk_phase(cx, l);
        GRID_BAR();
#endif
#if PH & 1024
        {
            pg8::Gemm g{(const bf16_t*)(ws + WS_H), (const bf16_t*)(ws + WS_WGU + (size_t)l * 65536 * D), MOE_ROWS, 65536, D, cx.w0};
            pg8::MoeOrder S{last ? 16 : 17, 16, G, vcu};
            pg8::EpiGU E{(unsigned char*)(ws + WS_HID)};
            pg8::gemm_phase_f8<pg8::EpiGU, pg8::MoeOrder, true>(launder_lds(lds), g, S, E, (const int*)(ws + WS_ROWMAP));
        }
#endif
#if DBL & 4096
        GRID_BAR();
        {
            pg8::Gemm g{(const bf16_t*)(ws + WS_H), (const bf16_t*)(ws + WS_WGU + (size_t)l * 65536 * D), MOE_ROWS, 65536, D, cx.w0};
            pg8::MoeOrder S{last ? 16 : 17, 16, G, vcu};
            pg8::EpiNull E{(float*)(ws + WS_OB)};
            pg8::gemm_phase_f8<pg8::EpiNull, pg8::MoeOrder, true>(launder_lds(lds), g, S, E, (const int*)(ws + WS_ROWMAP));
        }
#endif
#if DBL & 256
        GRID_BAR();
        {
            pg8::Gemm g{(const bf16_t*)(ws + WS_H), (const bf16_t*)(ws + WS_WGU + (size_t)l * 65536 * D), MOE_ROWS, 65536, D, cx.w0};
            pg8::MoeOrder S{last ? 16 : 17, 16, G, vcu};
            pg8::EpiGU E{(unsigned char*)(ws + WS_HID)};
            pg8::gemm_phase_f8<pg8::EpiGU, pg8::MoeOrder, true>(launder_lds(lds), g, S, E, (const int*)(ws + WS_ROWMAP));
        }
#endif
        GRID_BAR();
#if PH & 2048
        {
            pg8::Gemm g{(const bf16_t*)(ws + WS_HID), (const bf16_t*)(ws + WS_WD + (size_t)l * 16384 * FF), MOE_ROWS, 16384, FF, cx.w0};
            pg8::MoeOrder S{last ? 16 : 17, 4, G, vcu};
            pg8::EpiDown E{(unsigned char*)(ws + WS_YS)};
            pg8::gemm_phase_f8<pg8::EpiDown, pg8::MoeOrder, false>(launder_lds(lds), g, S, E, nullptr);
        }
#endif
#if DBL & 512
        GRID_BAR();
        {
            pg8::Gemm g{(const bf16_t*)(ws + WS_HID), (const bf16_t*)(ws + WS_WD + (size_t)l * 16384 * FF), MOE_ROWS, 16384, FF, cx.w0};
            pg8::MoeOrder S{last ? 16 : 17, 4, G, vcu};
            pg8::EpiDown E{(unsigned char*)(ws + WS_YS)};
            pg8::gemm_phase_f8<pg8::EpiDown, pg8::MoeOrder, false>(launder_lds(lds), g, S, E, nullptr);
        }
#endif
        if (bgc && !last && vcu >= 64) cvt_tail<4>(cx, CVT_N0 + l * CVT_CYC + CVT_G1 + CVT_G2 + CVT_N2 + CVT_T, vcu - 64);
#ifdef DBLCVT
        if (bgc && !last && vcu >= 64) cvt_tail<4>(cx, CVT_N0 + l * CVT_CYC + CVT_G1 + CVT_G2 + CVT_N2 + CVT_T, vcu - 64);
#endif
        GRID_BAR();
    }
#if PH & 4096
    norm1_phase<1>(cx, DEPTH);
#endif
}

extern "C" void kernel_launch(void* const* d_in, const int* in_sizes, int n_in, void* d_out, int out_size, void* d_ws, size_t ws_size, hipStream_t stream) {
    static int grid = 0;
    if (grid == 0) {
        if (n_in != 18 || out_size != NB * SEQ * D || ws_size < WS_END) { fprintf(stderr, "kernel_launch: unexpected problem shape (n_in %d, out %d, ws %zu)\n", n_in, out_size, ws_size); grid = -1; return; }
        int dev = 0, cus = 0, per_cu = 0;
        if (hipGetDevice(&dev) != hipSuccess || hipDeviceGetAttribute(&cus, hipDeviceAttributeMultiprocessorCount, dev) != hipSuccess) { grid = -1; return; }
        if (hipFuncSetAttribute((const void*)mega_fwd, hipFuncAttributeMaxDynamicSharedMemorySize, LDS_BYTES) != hipSuccess) { fprintf(stderr, "kernel_launch: hipFuncSetAttribute failed\n"); grid = -1; return; }
        if (hipOccupancyMaxActiveBlocksPerMultiprocessor(&per_cu, (const void*)mega_fwd, 512, LDS_BYTES) != hipSuccess || per_cu < 1) { fprintf(stderr, "kernel_launch: occupancy query reports %d workgroups per CU\n", per_cu); per_cu = 1; }
        (void)hipGetLastError();
        grid = cus;
    }
    if (grid < 0) return;
    (void)in_sizes;
    if (hipMemsetAsync((char*)d_ws + WS_CTL, 0, CTL_ZERO_BYTES, stream) != hipSuccess) return;
    Args a{};
    for (int i = 0; i < 18; ++i) a.in[i] = (const float*)d_in[i];
    a.out = (float*)d_out; a.ws = (unsigned char*)d_ws;
    hipLaunchKernelGGL(mega_fwd, dim3(grid), dim3(512), LDS_BYTES, stream, a);
}
```
